# Optimizing an MI355X kernel written in HIP

```python
import jax, jax.numpy as jnp
from jax import lax
import numpy as np

D_MODEL = 1024
BATCH = 8
SEQ = 8192
DEPTH = 2

GRID_W = 64
CTX_LEN = 256
EPS = 1e-6
GLA_HEADS = 4
GLA_DK = 128
GLA_DV = 256
GLA_LOWRANK = 16
GLA_GATE_NORM = 16.0
GLA_CHUNK = 64
FNET_GROUPS = 4
FNET_GROUP_W = 128
CONF_W = 512
CONF_KERNEL = 31
SCONV_W = 512
SCONV_KERNEL = 3
N_EXPERTS = 32
TOP_K = 4
D_FF_EXPERT = D_MODEL
SWIGLU_LIMIT = 7.0
SWIGLU_ALPHA = 1.702
MOE_BLOCK = 512

GLA_KW = GLA_HEADS * GLA_DK
GLA_VW = GLA_HEADS * GLA_DV
FNET_W = FNET_GROUPS * FNET_GROUP_W
EVEN_SPLITS = (GLA_KW, GLA_KW, GLA_VW, GLA_VW, GLA_LOWRANK, GLA_LOWRANK, FNET_W)
EVEN_IN = sum(EVEN_SPLITS)
EVEN_OUT = GLA_VW + FNET_W
ODD_SPLITS = (CONF_W, CONF_W, SCONV_W, SCONV_W, SCONV_W)
ODD_IN = sum(ODD_SPLITS)
ODD_OUT = CONF_W + SCONV_W

kernel_name = 'hybrid_gla_fnet_conformer_shortconv_moe_dit'


def _split(t, widths):
    cuts = [int(v) for v in np.cumsum(widths)[:-1]]
    return jnp.split(t, cuts, axis=-1)


def _heads(t, n):
    b_, l_, w_ = t.shape
    return t.reshape(b_, l_, n, w_ // n).transpose(0, 2, 1, 3)


def rms_norm(x, g):
    xf = x.astype(jnp.float32)
    y = xf * lax.rsqrt(jnp.mean(xf * xf, axis=-1, keepdims=True) + EPS)
    return (y * g.astype(jnp.float32)).astype(x.dtype)


def layer_norm(x, g, b):
    xf = x.astype(jnp.float32)
    mu = jnp.mean(xf, axis=-1, keepdims=True)
    xc = xf - mu
    y = xc * lax.rsqrt(jnp.mean(xc * xc, axis=-1, keepdims=True) + EPS)
    return (y * g.astype(jnp.float32) + b.astype(jnp.float32)).astype(x.dtype)


def adaln(cond, w, b):
    return jnp.split(jax.nn.silu(cond) @ w + b, 6, axis=-1)


def gla_log_decay(lr, up, bias):
    g = jax.nn.log_sigmoid(lr.astype(jnp.float32) @ up.astype(jnp.float32) + bias.astype(jnp.float32))
    return _heads(g / GLA_GATE_NORM, GLA_HEADS)


def gla_chunk_scan(q, k, v, g, s0):
    b_, h_, l_, dk = q.shape
    dv = v.shape[-1]
    n = l_ // GLA_CHUNK

    def to_chunks(t):
        return jnp.moveaxis(t.reshape(b_, h_, n, GLA_CHUNK, t.shape[-1]), 2, 0)

    lower = jnp.tril(jnp.ones((GLA_CHUNK, GLA_CHUNK), bool))[:, :, None]

    def step(s, inp):
        qi, ki, vi, gi = inp
        bcum = jnp.cumsum(gi, axis=-2)
        diff = bcum[..., :, None, :] - bcum[..., None, :, :]
        decay = jnp.exp(jnp.where(lower, diff, -jnp.inf))
        scores = jnp.einsum('bhid,bhjd,bhijd->bhij', qi, ki, decay)
        o = jnp.einsum('bhij,bhjv->bhiv', scores, vi) + jnp.einsum('bhid,bhdv->bhiv', qi * jnp.exp(bcum), s)
        b_last = bcum[..., -1:, :]
        s_new = jnp.exp(b_last)[..., 0, :, None] * s + jnp.einsum('bhjd,bhjv->bhdv', ki * jnp.exp(b_last - bcum), vi)
        return s_new, o

    s_fin, o = lax.scan(step, s0.astype(jnp.float32), tuple(to_chunks(t) for t in (q, k, v, g)))
    o = jnp.moveaxis(o, 0, 2).reshape(b_, h_, l_, dv)
    return o, s_fin


def gla_final_state(k, v, g):
    bcum = jnp.cumsum(g, axis=2)
    w = jnp.exp(bcum[:, :, -1:, :] - bcum)
    return jnp.einsum('bhld,bhlv->bhdv', k * w, v)


def fourier_mix(f):
    b_, l_, _ = f.shape
    fg = f.astype(jnp.float32).reshape(b_, l_, FNET_GROUPS, FNET_GROUP_W).transpose(0, 2, 1, 3)
    out = jnp.fft.fft2(fg, norm='ortho').real
    return out.transpose(0, 2, 1, 3).reshape(b_, l_, FNET_W).astype(f.dtype)


def even_mixer(p, gk_up, gk_b, gnorm, w_out, s_fwd, s_bwd):
    b_, l_, _ = p.shape
    q, k, v, r, lf, lb, f = _split(p, EVEN_SPLITS)
    q = _heads(q, GLA_HEADS).astype(jnp.float32) * (GLA_DK ** -0.5)
    k = _heads(k, GLA_HEADS).astype(jnp.float32)
    v = _heads(v, GLA_HEADS).astype(jnp.float32)
    g_f = gla_log_decay(lf, gk_up[0], gk_b[0])
    g_b = gla_log_decay(lb, gk_up[1], gk_b[1])
    o_f, s_f = gla_chunk_scan(q, k, v, g_f, s_fwd)
    o_b, s_b = gla_chunk_scan(jnp.flip(q, 2), jnp.flip(k, 2), jnp.flip(v, 2), jnp.flip(g_b, 2), s_bwd)
    o = (o_f + jnp.flip(o_b, 2)).transpose(0, 2, 1, 3)
    o = rms_norm(o, gnorm) * jax.nn.silu(r.astype(jnp.float32)).reshape(b_, l_, GLA_HEADS, GLA_DV)
    o = o.reshape(b_, l_, GLA_VW).astype(p.dtype)
    y = jnp.concatenate([o, fourier_mix(f)], axis=-1) @ w_out
    return y, s_f, s_b


def gla_context_states(pc, gk_up, gk_b):
    _, k, v, _, lf, lb, _ = _split(pc, EVEN_SPLITS)
    k = _heads(k, GLA_HEADS).astype(jnp.float32)
    v = _heads(v, GLA_HEADS).astype(jnp.float32)
    g_f = gla_log_decay(lf, gk_up[0], gk_b[0])
    g_b = gla_log_decay(lb, gk_up[1], gk_b[1])
    s_f = gla_final_state(k, v, g_f)
    s_b = gla_final_state(jnp.flip(k, 2), jnp.flip(v, 2), jnp.flip(g_b, 2))
    return s_f, s_b


def depthwise_conv_seq(x, w):
    pad = w.shape[0] // 2
    return lax.conv_general_dilated(x, w[:, None, :].astype(x.dtype), (1,), [(pad, pad)],
                                    dimension_numbers=('NWC', 'WIO', 'NWC'), feature_group_count=x.shape[-1])


def depthwise_conv_columns(x, w, rows):
    b_, l_, ch = x.shape
    pad = w.shape[0] // 2
    xg = x.reshape(b_, rows, GRID_W, ch)
    y = lax.conv_general_dilated(xg, w[:, None, None, :].astype(x.dtype), (1, 1), [(pad, pad), (0, 0)],
                                 dimension_numbers=('NHWC', 'HWIO', 'NHWC'), feature_group_count=ch)
    return y.reshape(b_, l_, ch)


def odd_mixer(p, conf_dw, conf_dw_b, ln_g, ln_b, sconv_w, w_out, rows):
    a, a_gate, gate_b, gate_c, u = _split(p, ODD_SPLITS)
    hc = a * jax.nn.sigmoid(a_gate)
    hc = depthwise_conv_seq(hc, conf_dw) + conf_dw_b.astype(hc.dtype)
    hc = jax.nn.silu(layer_norm(hc, ln_g, ln_b))
    z = gate_c * u
    z = depthwise_conv_seq(z, sconv_w) if rows is None else depthwise_conv_columns(z, sconv_w, rows)
    z = gate_b * z
    return jnp.concatenate([hc, z], axis=-1) @ w_out


def moe_ffn(h, router_w, router_b, w_gu, b_gu, w_down, b_down):
    t_, d_ = h.shape
    logits = h.astype(jnp.float32) @ router_w.astype(jnp.float32) + router_b.astype(jnp.float32)
    top_val, top_idx = lax.top_k(logits, TOP_K)
    gate = jax.nn.softmax(top_val, axis=-1)
    n_slots = t_ * TOP_K
    flat_e = top_idx.reshape(-1)
    order = jnp.argsort(flat_e)
    sorted_e = flat_e[order]
    slot_tok = order // TOP_K
    counts = jnp.zeros((N_EXPERTS,), jnp.int32).at[flat_e].add(1)
    padded = (counts + MOE_BLOCK - 1) // MOE_BLOCK * MOE_BLOCK
    start_sorted = jnp.cumsum(counts) - counts
    pad_end = jnp.cumsum(padded)
    start_pad = pad_end - padded
    dest = start_pad[sorted_e] + jnp.arange(n_slots, dtype=jnp.int32) - start_sorted[sorted_e]
    n_blocks = (n_slots + N_EXPERTS * (MOE_BLOCK - 1) + MOE_BLOCK - 1) // MOE_BLOCK
    buf_tok = jnp.zeros((n_blocks * MOE_BLOCK,), jnp.int32).at[dest].set(slot_tok)
    block_e = jnp.minimum(jnp.searchsorted(pad_end, jnp.arange(n_blocks, dtype=jnp.int32) * MOE_BLOCK, side='right'),
                          N_EXPERTS - 1)
    xb = h[buf_tok].reshape(n_blocks, MOE_BLOCK, d_)

    def expert_block(args):
        xblk, e = args
        gu = xblk @ w_gu[e] + b_gu[e]
        g, u = gu[..., :D_FF_EXPERT], gu[..., D_FF_EXPERT:]
        g = jnp.minimum(g, SWIGLU_LIMIT)
        u = jnp.clip(u, -SWIGLU_LIMIT, SWIGLU_LIMIT)
        act = (u + 1) * (g * jax.nn.sigmoid(SWIGLU_ALPHA * g))
        return act @ w_down[e] + b_down[e]

    yb = lax.map(expert_block, (xb, block_e)).reshape(n_blocks * MOE_BLOCK, d_)
    y_slot = yb[dest] * gate.reshape(-1)[order][:, None].astype(yb.dtype)
    return jax.ops.segment_sum(y_slot, slot_tok, num_segments=t_)


def ffn_sublayer(x, shift, scale, gate, g_pre, g_post, rw, rb, wgu, bgu, wd, bd):
    b_, l_, d_ = x.shape
    h = rms_norm(x, g_pre) * (1 + scale) + shift
    f = moe_ffn(h.reshape(b_ * l_, d_), rw, rb, wgu, bgu, wd, bd).reshape(b_, l_, d_)
    return x + gate * rms_norm(f, g_post)


def setup_inputs(seed: int = 0) -> dict:
    key = jax.random.key(seed)
    ks = iter(jax.random.split(key, 40))

    def nrm(shape, s):
        return s * jax.random.normal(next(ks), shape, jnp.float32)

    n_even = (DEPTH + 1) // 2
    n_odd = DEPTH // 2
    d = D_MODEL
    return {
        'x': nrm((BATCH, SEQ, d), 1.0),
        'c': nrm((BATCH, d), 1.0),
        'ctx': nrm((BATCH, CTX_LEN, d), 1.0),
        'c_ctx': nrm((d,), 1.0),
        'mod_w': nrm((DEPTH, d, 6 * d), 0.5 * d ** -0.5),
        'mod_b': nrm((DEPTH, 6 * d), 0.02),
        'norm_mix_pre': 1.0 + nrm((DEPTH, d), 0.05),
        'norm_mix_post': 1.0 + nrm((DEPTH, d), 0.05),
        'norm_ffn_pre': 1.0 + nrm((DEPTH, d), 0.05),
        'norm_ffn_post': 1.0 + nrm((DEPTH, d), 0.05),
        'ev_w_in': nrm((n_even, d, EVEN_IN), d ** -0.5),
        'ev_gk_up': nrm((n_even, 2, GLA_LOWRANK, GLA_KW), GLA_LOWRANK ** -0.5),
        'ev_gk_b': nrm((n_even, 2, GLA_KW), 0.1),
        'ev_gnorm': 1.0 + nrm((n_even, GLA_DV), 0.05),
        'ev_w_out': nrm((n_even, EVEN_OUT, d), EVEN_OUT ** -0.5),
        'od_w_in': nrm((n_odd, d, ODD_IN), d ** -0.5),
        'od_conf_dw': nrm((n_odd, CONF_KERNEL, CONF_W), CONF_KERNEL ** -0.5),
        'od_conf_dw_b': nrm((n_odd, CONF_W), 0.02),
        'od_conf_ln_g': 1.0 + nrm((n_odd, CONF_W), 0.05),
        'od_conf_ln_b': nrm((n_odd, CONF_W), 0.02),
        'od_sconv': nrm((n_odd, SCONV_KERNEL, SCONV_W), SCONV_KERNEL ** -0.5),
        'od_w_out': nrm((n_odd, ODD_OUT, d), ODD_OUT ** -0.5),
        'router_w': nrm((DEPTH, d, N_EXPERTS), d ** -0.5),
        'router_b': nrm((DEPTH, N_EXPERTS), 0.01),
        'exp_w_gu': nrm((DEPTH, N_EXPERTS, d, 2 * D_FF_EXPERT), d ** -0.5),
        'exp_b_gu': nrm((DEPTH, N_EXPERTS, 2 * D_FF_EXPERT), 0.02),
        'exp_w_down': nrm((DEPTH, N_EXPERTS, D_FF_EXPERT, d), D_FF_EXPERT ** -0.5),
        'exp_b_down': nrm((DEPTH, N_EXPERTS, d), 0.02),
    }


def reference(x, c, ctx, c_ctx, mod_w, mod_b, norm_mix_pre, norm_mix_post, norm_ffn_pre, norm_ffn_post,
              ev_w_in, ev_gk_up, ev_gk_b, ev_gnorm, ev_w_out,
              od_w_in, od_conf_dw, od_conf_dw_b, od_conf_ln_g, od_conf_ln_b, od_sconv, od_w_out,
              router_w, router_b, exp_w_gu, exp_b_gu, exp_w_down, exp_b_down):
    b_, l_, _ = x.shape
    rows = l_ // GRID_W
    for layer in range(DEPTH):
        ctx_carry = any(j % 2 == 0 for j in range(layer + 1, DEPTH))
        sm, cm, gm, sf, cf, gf = [m[:, None, :] for m in adaln(c, mod_w[layer], mod_b[layer])]
        h = rms_norm(x, norm_mix_pre[layer]) * (1 + cm) + sm
        need_ctx = (layer % 2 == 0) or ctx_carry
        if need_ctx:
            c_sm, c_cm, c_gm, c_sf, c_cf, c_gf = adaln(c_ctx, mod_w[layer], mod_b[layer])
            hc = rms_norm(ctx, norm_mix_pre[layer]) * (1 + c_cm) + c_sm
        if layer % 2 == 0:
            e = layer // 2
            pc = hc @ ev_w_in[e]
            if ctx_carry:
                zero = jnp.zeros((b_, GLA_HEADS, GLA_DK, GLA_DV), jnp.float32)
                yc, s_f, s_b = even_mixer(pc, ev_gk_up[e], ev_gk_b[e], ev_gnorm[e], ev_w_out[e], zero, zero)
            else:
                s_f, s_b = gla_context_states(pc, ev_gk_up[e], ev_gk_b[e])
            y, _, _ = even_mixer(h @ ev_w_in[e], ev_gk_up[e], ev_gk_b[e], ev_gnorm[e], ev_w_out[e], s_f, s_b)
        else:
            o = layer // 2
            odd_p = (od_conf_dw[o], od_conf_dw_b[o], od_conf_ln_g[o], od_conf_ln_b[o], od_sconv[o], od_w_out[o])
            y = odd_mixer(h @ od_w_in[o], *odd_p, rows)
            if ctx_carry:
                yc = odd_mixer(hc @ od_w_in[o], *odd_p, None)
        x = x + gm * rms_norm(y, norm_mix_post[layer])
        x = ffn_sublayer(x, sf, cf, gf, norm_ffn_pre[layer], norm_ffn_post[layer], router_w[layer], router_b[layer],
                         exp_w_gu[layer], exp_b_gu[layer], exp_w_down[layer], exp_b_down[layer])
        if ctx_carry:
            ctx = ctx + c_gm * rms_norm(yc, norm_mix_post[layer])
            ctx = ffn_sublayer(ctx, c_sf, c_cf, c_gf, norm_ffn_pre[layer], norm_ffn_post[layer], router_w[layer],
                               router_b[layer], exp_w_gu[layer], exp_b_gu[layer], exp_w_down[layer], exp_b_down[layer])
    return x
```

```cpp
#include <hip/hip_runtime.h>
#include <cstdio>
#include <cstdint>

#ifndef N_LAUNCH_MODE
#define N_LAUNCH_MODE 1
#endif

#ifndef F8_IN0
#define F8_IN0 0
#endif
#ifndef F8_OUT0
#define F8_OUT0 0
#endif
#ifndef F8_IN1
#define F8_IN1 1
#endif
#ifndef F8_OUT1
#define F8_OUT1 1
#endif
#define LAS __attribute__((address_space(3)))
typedef unsigned short bf16;
typedef short bf16x8 __attribute__((ext_vector_type(8)));
typedef short s16x4 __attribute__((ext_vector_type(4)));
typedef float f32x4 __attribute__((ext_vector_type(4)));
typedef float f32x16 __attribute__((ext_vector_type(16)));
typedef unsigned u32x4 __attribute__((ext_vector_type(4)));
typedef unsigned u32x2 __attribute__((ext_vector_type(2)));

constexpr int D = 1024, NB = 8, SEQ = 8192, CTXL = 256;
constexpr int MTOK = NB * SEQ;
constexpr int MCTX = NB * CTXL;
constexpr int MALL = MTOK + MCTX;
constexpr int NE = 32, TOPK = 4;
constexpr int NSLOT_PAD = MTOK * TOPK + NE * 256;
constexpr int N_IN0 = 4352;
constexpr int N_IN1 = 2560;
constexpr float EPS = 1e-6f;

constexpr size_t MiB = 1u << 20;
constexpr size_t WS_CTL = 0, CTL_ZERO_BYTES = 65536;
constexpr size_t WS_MOD = 1 * MiB;
constexpr size_t WS_F1 = 2 * MiB;
constexpr size_t WS_F2 = 2 * MiB + 65536;
constexpr size_t WS_CNTBLK = 3 * MiB;
constexpr size_t WS_MOEINFO = 3 * MiB + 65536;
constexpr size_t WS_TOPK = 4 * MiB;
constexpr size_t WS_GATE = 5 * MiB;
constexpr size_t WS_SLOTPOS = 6 * MiB;
constexpr size_t WS_SLOTTOK = 7 * MiB;
constexpr size_t WS_WIN0 = 10 * MiB;
constexpr size_t WS_WOUT0 = 19 * MiB;
constexpr size_t WS_WIN1 = 22 * MiB;
constexpr size_t WS_WOUT1 = 27 * MiB;
constexpr size_t WS_WGU = 32 * MiB;
constexpr size_t WS_WD = 288 * MiB;
constexpr size_t WS_HN = 416 * MiB;
constexpr size_t WS_B = 548 * MiB;
constexpr size_t WS_ACT = WS_B;
constexpr size_t WS_YSLOT = WS_B + 528 * MiB;
constexpr size_t WS_Q = WS_B, WS_K = WS_B + 64 * MiB, WS_V = WS_B + 130 * MiB, WS_R = WS_B + 262 * MiB;
constexpr size_t WS_ZC = WS_B + 390 * MiB, WS_ZS = WS_B + 454 * MiB, WS_LR = WS_B + 518 * MiB;
constexpr size_t WS_OF = WS_B + 528 * MiB, WS_OB = WS_B + 656 * MiB, WS_YR = WS_B + 784 * MiB, WS_YI = WS_B + 848 * MiB;
constexpr size_t WS_A2 = WS_B;
constexpr size_t WS_Y = WS_B + 528 * MiB;
constexpr size_t WS_H2 = WS_B + 656 * MiB;
constexpr size_t WS_GLU = WS_B, WS_ZC1 = WS_B + 64 * MiB, WS_GB = WS_B + 128 * MiB, WS_A2B = WS_B + 192 * MiB;
constexpr size_t WS_XS = WS_B + 1056 * MiB;
constexpr size_t WS_GQP = WS_B + 1056 * MiB;
constexpr size_t WS_GKPP = WS_GQP + 132 * MiB;
constexpr size_t WS_GSC = WS_GKPP + 132 * MiB;
constexpr size_t WS_GEL = WS_GSC + 66 * MiB;
constexpr size_t WS_END = WS_GEL + 6 * MiB;

constexpr int LDS_BYTES = 155648;
constexpr int MISC_OFF = LDS_BYTES - 256;

__device__ __forceinline__ float bf_lo(unsigned u) { return __uint_as_float(u << 16); }
__device__ __forceinline__ float bf_hi(unsigned u) { return __uint_as_float(u & 0xffff0000u); }
typedef __bf16 bf16v2_t __attribute__((ext_vector_type(2)));
typedef float f32v2_t __attribute__((ext_vector_type(2)));
__device__ __forceinline__ unsigned cvt_pk(float lo, float hi) { const f32v2_t v = {lo, hi}; const bf16v2_t r = __builtin_convertvector(v, bf16v2_t); return __builtin_bit_cast(unsigned, r); }
__device__ __forceinline__ unsigned f2bf(float f) { unsigned u = __float_as_uint(f); return (u + 0x7fffu + ((u >> 16) & 1u)) >> 16; }
__device__ __forceinline__ float wave_sum(float v) {
#pragma unroll
    for (int o = 1; o < 64; o <<= 1) v += __shfl_xor(v, o);
    return v;
}
__device__ __forceinline__ unsigned pk4_fp8(float a, float b, float c, float d, float sc) {
    int w = 0;
    w = __builtin_amdgcn_cvt_pk_fp8_f32(__builtin_amdgcn_fmed3f(a * sc, -440.f, 440.f), __builtin_amdgcn_fmed3f(b * sc, -440.f, 440.f), w, false);
    w = __builtin_amdgcn_cvt_pk_fp8_f32(__builtin_amdgcn_fmed3f(c * sc, -440.f, 440.f), __builtin_amdgcn_fmed3f(d * sc, -440.f, 440.f), w, true);
    return (unsigned)w;
}
__device__ __forceinline__ float sigmoidf_(float x) { return __builtin_amdgcn_rcpf(1.0f + __builtin_amdgcn_exp2f(x * -1.4426950408889634f)); }
__device__ __forceinline__ float siluf_(float x) { return x * sigmoidf_(x); }

#define XB_TMO      128
#define XB_XCNT(j)  (256  + 64 * (j))
#define XB_XSUB(j)  (1280 + 64 * (j))
#define XB_XGEN(j)  (2304 + 64 * (j))
#define XB_TOP      3328
#define XB_TOPGEN   3392
#define XCD_BAR_WORDS 3456
#define XB_SPIN_CAP (1u << 18)
__device__ __forceinline__ unsigned xb_ld(unsigned* p)              { return __hip_atomic_load(p, __ATOMIC_RELAXED, __HIP_MEMORY_SCOPE_AGENT); }
__device__ __forceinline__ unsigned xb_add(unsigned* p, unsigned v) { return __hip_atomic_fetch_add(p, v, __ATOMIC_RELAXED, __HIP_MEMORY_SCOPE_AGENT); }
__device__ __forceinline__ unsigned xb_xcc_id() { return (unsigned)__builtin_amdgcn_s_getreg((3 << 11) | 20) & 0xFu; }
#define XB_SPIN(cond, bar) do { unsigned _sp = 0; while (cond) { __builtin_amdgcn_s_sleep(1); \
    if ((++_sp & 255u) == 0u) { if (xb_ld(&(bar)[XB_TMO])) break; if (_sp > XB_SPIN_CAP) { atomicAdd(&(bar)[XB_TMO], 1u); break; } } } } while (0)
struct XcdBarrier { unsigned* bar; unsigned x; volatile LAS unsigned* st; };
__device__ __forceinline__ XcdBarrier xcd_barrier_post(unsigned* bar, volatile LAS unsigned* st) {
    XcdBarrier b; b.bar = bar; b.x = xb_xcc_id(); b.st = st;
    if (threadIdx.x == 0) (void)xb_add(&bar[XB_XCNT(b.x)], 1u);
    return b;
}
__device__ __forceinline__ void xcd_barrier_complete(unsigned* bar, unsigned x, unsigned& nloc, unsigned& nx) {
    const unsigned G = gridDim.x * gridDim.y * gridDim.z;
    unsigned sum, cnt, mine, sp = 0u;
    for (;;) {
        sum = 0u; cnt = 0u; mine = 0u;
#pragma unroll
        for (unsigned j = 0; j < 16; ++j) { const unsigned c = xb_ld(&bar[XB_XCNT(j)]); sum += c; cnt += (c > 0u) ? 1u : 0u; mine = (j == x) ? c : mine; }
        if (sum == G) break;
        __builtin_amdgcn_s_sleep(1);
        if ((++sp & 255u) == 0u) { if (xb_ld(&bar[XB_TMO])) break; if (sp > XB_SPIN_CAP) { atomicAdd(&bar[XB_TMO], 1u); break; } }
    }
    nloc = mine > 0u ? mine : 1u; nx = cnt > 0u ? cnt : 1u;
}
__device__ __forceinline__ void xcd_barrier(const XcdBarrier& b) {
    asm volatile("s_waitcnt vmcnt(0)" ::: "memory");
    __syncthreads();
    if (threadIdx.x == 0) {
        unsigned* bar = b.bar;
        __builtin_amdgcn_s_waitcnt(0);
        unsigned nloc = b.st[0], nx = b.st[1];
        if (nloc == 0u) { xcd_barrier_complete(bar, b.x, nloc, nx); b.st[0] = nloc; b.st[1] = nx; }
        const unsigned old = xb_add(&bar[XB_XSUB(b.x)], 1u);
        const unsigned gen = old / nloc;
        if (old + 1u == (gen + 1u) * nloc) {
            __builtin_amdgcn_fence(__ATOMIC_RELEASE, "agent");
            asm volatile("s_waitcnt vmcnt(0)" ::: "memory");
            const unsigned og = xb_add(&bar[XB_TOP], 1u);
            const unsigned tg = og / nx;
            if (og + 1u == (tg + 1u) * nx) xb_add(&bar[XB_TOPGEN], 1u);
            else XB_SPIN(xb_ld(&bar[XB_TOPGEN]) == tg, bar);
            __builtin_amdgcn_fence(__ATOMIC_ACQUIRE, "agent");
            xb_add(&bar[XB_XGEN(b.x)], 1u);
            asm volatile("s_waitcnt vmcnt(0)" ::: "memory");
        } else {
            XB_SPIN(xb_ld(&bar[XB_XGEN(b.x)]) == gen, bar);
            __builtin_amdgcn_fence(__ATOMIC_ACQUIRE, "agent");
            asm volatile("s_waitcnt vmcnt(0)" ::: "memory");
        }
    }
    __syncthreads();
}

struct Args {
    const float* in[28];
    float* out;
    unsigned char* ws;
    int ph_lo, ph_hi;
};
struct Ctx {
    LAS unsigned char* lds;
    int G;
    const Args* a;
    unsigned char* ws;
};
__device__ __forceinline__ int otid() { int t = (int)threadIdx.x; asm volatile("" : "+v"(t)); return t; }
__device__ __forceinline__ int vzero() { int z = 0; asm volatile("" : "+v"(z)); return z; }
#define PH_IDS const int tid = otid(), lane = tid & 63, wave = __builtin_amdgcn_readfirstlane(tid >> 6); (void)tid; (void)lane; (void)wave
#define IN_X 0
#define IN_C 1
#define IN_CTX 2
#define IN_CCTX 3
#define IN_MODW 4
#define IN_MODB 5
#define IN_NMPRE 6
#define IN_NMPOST 7
#define IN_NFPRE 8
#define IN_NFPOST 9
#define IN_EVWIN 10
#define IN_EVGKUP 11
#define IN_EVGKB 12
#define IN_EVGNORM 13
#define IN_EVWOUT 14
#define IN_ODWIN 15
#define IN_ODDW 16
#define IN_ODDWB 17
#define IN_ODLNG 18
#define IN_ODLNB 19
#define IN_ODSCONV 20
#define IN_ODWOUT 21
#define IN_RW 22
#define IN_RB 23
#define IN_WGU 24
#define IN_BGU 25
#define IN_WD 26
#define IN_BD 27

namespace gm {
constexpr int BM = 256, BK = 64, HALF = 128, HTB = HALF * BK * 2, STAGE_BYTES = 8 * HTB, NXCD = 8, WGM = 8;
constexpr int XT_OFF = 131072;
constexpr int XB_OFF = XT_OFF + 16384;
__device__ __forceinline__ int lds_byte(int r, int c) { const int st = (r >> 4) * 2 + (c >> 5), rr = r & 15, cc = c & 31, ob = rr * 64 + cc * 2; return st * 1024 + (ob ^ (((ob >> 9) & 1) << 5)); }
__device__ __forceinline__ void stage_rc(int b, int& R, int& C) { const int st = b / 1024, sb = b % 1024, swz = sb ^ (((sb >> 9) & 1) << 5); R = (st >> 1) * 16 + swz / 64; C = (st & 1) * 32 + (swz % 64) / 2; }
__device__ __forceinline__ int perm32(int rho) { const int n = rho >> 4, i = rho & 15; return 8 * (i >> 2) + 4 * n + (i & 3); }
struct Unit { int pm, pn, e; };

__device__ __forceinline__ void dense_map(int L, int nM, int nN, int& pm, int& pn) {
    const int nwg = nM * nN; int wgid = L;
    { const int q = nwg / NXCD, r = nwg % NXCD, xcd = wgid % NXCD, off = wgid / NXCD; wgid = (xcd < r ? xcd * (q + 1) : r * (q + 1) + (xcd - r) * q) + off; }
    const int nig = WGM * nN, gid = wgid / nig, fm = gid * WGM, gsz = (nM - fm) < WGM ? (nM - fm) : WGM;
    pm = fm + ((wgid % nig) % gsz); pn = (wgid % nig) / gsz;
}

typedef int i32x8 __attribute__((ext_vector_type(8)));
typedef int i32x4_ __attribute__((ext_vector_type(4)));
template <bool F8, class Epi, class Sched>
__device__ __forceinline__ void gemm_phase(LAS unsigned char* lds, const int RP, const Sched& S, const Epi& E, const int SCA = 0x7F7F7F7F, const int SCB = 0x7F7F7F7F) {
    const int tid = otid(), wid = __builtin_amdgcn_readfirstlane(tid >> 6), lane = tid & 63, wr = wid >> 2, wc = wid & 3, fr = lane & 15, fq = lane >> 4;
    const int nt = RP / 128;
    unsigned voffB[2];
#pragma unroll
    for (int i = 0; i < 2; ++i) { int R, C; stage_rc(tid * 16 + i * 8192, R, C); const int Rb = (R & ~31) + perm32(R & 31); voffB[i] = (unsigned)(Rb * RP + C * 2); }
    const size_t kstep = (size_t)128;
    const size_t hstepB = (size_t)HALF * RP;
    const unsigned ldsw = (unsigned)wid * 1024u;
    const int aoff = F8 ? lds_byte(wr * 64 + fr, (fq >> 1) * 32 + (fq & 1) * 16) : lds_byte(wr * 64 + fr, fq * 8);
    const int boff = F8 ? lds_byte(wc * 32 + fr, (fq >> 1) * 32 + (fq & 1) * 16) : lds_byte(wc * 32 + fr, fq * 8);
    constexpr int KOFF = F8 ? 16 : 1024;
#define G_SA(b, h) (((b) * 2 + (h)) * HTB)
#define G_SB(b, h) ((4 + (b) * 2 + (h)) * HTB)
#define G_STAGEB(bufoff, gbase) do { _Pragma("unroll") for (int _i = 0; _i < 2; ++_i) \
        __builtin_amdgcn_global_load_lds((const unsigned*)((const char*)(gbase) + voffB[_i]), (LAS unsigned*)(lds + (bufoff) + ldsw + _i * 8192), 16, 0, 0); } while (0)
#define G_STAGEA(bufoff, offs, h, kb) do { _Pragma("unroll") for (int _i = 0; _i < 2; ++_i) \
        __builtin_amdgcn_global_load_lds((const unsigned*)(S.abase() + (size_t)(offs)[h][_i] + (kb)), (LAS unsigned*)(lds + (bufoff) + ldsw + _i * 8192), 16, 0, 0); } while (0)
#define G_LDA(dst, b, h) do { _Pragma("unroll") for (int m = 0; m < 4; ++m) _Pragma("unroll") for (int k = 0; k < 2; ++k) dst[m][k] = *(const LAS bf16x8*)(lds + G_SA(b, h) + aoff + m * 2048 + k * KOFF); } while (0)
#define G_LDB(dst, b, h) do { _Pragma("unroll") for (int n = 0; n < 2; ++n) _Pragma("unroll") for (int k = 0; k < 2; ++k) dst[n][k] = *(const LAS bf16x8*)(lds + G_SB(b, h) + boff + n * 2048 + k * KOFF); } while (0)
#define G_CAT8(x) __builtin_shufflevector(__builtin_bit_cast(i32x4_, (x)[0]), __builtin_bit_cast(i32x4_, (x)[1]), 0, 1, 2, 3, 4, 5, 6, 7)
#define G_MMA(ai, bj, At, Bt) do { __builtin_amdgcn_s_setprio(1); \
        if constexpr (F8) { _Pragma("unroll") for (int m = 0; m < 4; ++m) _Pragma("unroll") for (int n = 0; n < 2; ++n) \
            acc[ai][bj][m][n] = __builtin_amdgcn_mfma_scale_f32_16x16x128_f8f6f4(G_CAT8(Bt[n]), G_CAT8(At[m]), acc[ai][bj][m][n], 0, 0, 0, SCB, 0, SCA); } \
        else { _Pragma("unroll") for (int m = 0; m < 4; ++m) _Pragma("unroll") for (int n = 0; n < 2; ++n) _Pragma("unroll") for (int k = 0; k < 2; ++k) \
            acc[ai][bj][m][n] = __builtin_amdgcn_mfma_f32_16x16x32_bf16(Bt[n][k], At[m][k], acc[ai][bj][m][n], 0, 0, 0); } \
        __builtin_amdgcn_s_setprio(0); } while (0)
#define G_WAIT_V(n) asm volatile("s_waitcnt vmcnt(" #n ")" ::: "memory")
#define G_WAIT_L(n) asm volatile("s_waitcnt lgkmcnt(" #n ")" ::: "memory")
#define G_BAR __builtin_amdgcn_s_barrier()
#define G_SCHED __builtin_amdgcn_sched_barrier(0)
    Unit cur, nxt; int ui = 0;
    if (!S.next(0, cur)) return;
    f32x4 acc[2][2][4][2];
#pragma unroll
    for (int a = 0; a < 2; ++a)
#pragma unroll
        for (int b = 0; b < 2; ++b)
#pragma unroll
            for (int m = 0; m < 4; ++m)
#pragma unroll
                for (int n = 0; n < 2; ++n) acc[a][b][m][n] = (f32x4){0.f, 0.f, 0.f, 0.f};
    bf16x8 At[4][2], B0[2][2], B1[2][2];
    unsigned cAo[2][2];
    S.a_off(cur, cAo);
    const char* cB = S.b_ptr(cur);
    S.prefetch_bias(cur, lds, 0, wid, lane, wc);
    G_STAGEB(G_SB(0, 0), cB); G_STAGEA(G_SA(0, 0), cAo, 0, 0); G_STAGEB(G_SB(0, 1), cB + hstepB); G_STAGEA(G_SA(0, 1), cAo, 1, 0);
    if (wr == 1) G_BAR;
    G_WAIT_V(4); G_BAR;
    G_STAGEB(G_SB(1, 0), cB + kstep); G_STAGEA(G_SA(1, 0), cAo, 0, kstep); G_STAGEB(G_SB(1, 1), cB + hstepB + kstep);
    G_WAIT_V(6); G_BAR;
    for (;;) {
        const bool has_next = S.next(ui + 1, nxt);
        const char* nB = cB;
        if (has_next) { S.prefetch_rows(nxt, lds, (ui + 1) & 1, wid, lane); S.prefetch_bias(nxt, lds, (ui + 1) & 1, wid, lane, wc); nB = S.b_ptr(nxt); }
        for (int t = 0; t < nt; t += 2) {
            const bool last = (t == nt - 2);
            const size_t k1 = (size_t)(t + 1) * kstep;
            G_LDB(B0, 0, 0); G_SCHED; G_LDA(At, 0, 0); G_STAGEA(G_SA(1, 1), cAo, 1, k1);
            if (last) { if (has_next) S.a_off_lds(nxt, lds, (ui + 1) & 1, wid, lane, cAo); cB = nB; }
            const size_t k2 = last ? 0 : (size_t)(t + 2) * kstep;
            const size_t k3 = k2 + kstep;
            const char* b2 = cB + k2; const char* b3 = b2 + kstep;
            G_WAIT_L(8); G_BAR; G_WAIT_L(0); G_MMA(0, 0, At, B0); G_BAR; G_SCHED;
            G_LDB(B1, 0, 1); G_STAGEB(G_SB(0, 0), b2);
            G_BAR; G_WAIT_L(0); G_MMA(0, 1, At, B1); G_BAR;
            G_LDA(At, 0, 1); G_STAGEA(G_SA(0, 0), cAo, 0, k2);
            G_BAR; G_WAIT_L(0); G_MMA(1, 0, At, B0); G_BAR; G_SCHED;
            G_STAGEB(G_SB(0, 1), b2 + hstepB);
            G_WAIT_V(6); G_BAR; G_MMA(1, 1, At, B1); G_BAR;
            G_LDB(B0, 1, 0); G_SCHED; G_LDA(At, 1, 0); G_STAGEA(G_SA(0, 1), cAo, 1, k2);
            G_WAIT_L(8); G_BAR; G_WAIT_L(0); G_MMA(0, 0, At, B0); G_BAR; G_SCHED;
            G_LDB(B1, 1, 1); G_STAGEB(G_SB(1, 0), b3);
            G_BAR; G_WAIT_L(0); G_MMA(0, 1, At, B1); G_BAR;
            G_LDA(At, 1, 1); G_STAGEA(G_SA(1, 0), cAo, 0, k3);
            G_BAR; G_WAIT_L(0); G_MMA(1, 0, At, B0); G_BAR; G_SCHED;
            G_STAGEB(G_SB(1, 1), b3 + hstepB);
            G_WAIT_V(6); G_BAR; G_MMA(1, 1, At, B1); G_BAR;
        }
        E(acc, cur, wr, wc, fr, fq, (const LAS float*)(lds + XB_OFF + ((ui & 1) * 8 + wid) * 256));
        if (!has_next) break;
#pragma unroll
        for (int a = 0; a < 2; ++a)
#pragma unroll
            for (int b = 0; b < 2; ++b)
#pragma unroll
                for (int m = 0; m < 4; ++m)
#pragma unroll
                    for (int n = 0; n < 2; ++n) acc[a][b][m][n] = (f32x4){0.f, 0.f, 0.f, 0.f};
        cur = nxt; ++ui;
    }
    G_WAIT_V(0);
    if (wr == 0) G_BAR;
    G_BAR;
#undef G_SA
#undef G_SB
#undef G_STAGEA
#undef G_STAGEB
#undef G_LDA
#undef G_LDB
#undef G_MMA
#undef G_CAT8
#undef G_WAIT_V
#undef G_WAIT_L
#undef G_BAR
#undef G_SCHED
}

__device__ __forceinline__ void lane_rc(int i, int& R, int& Cb) { int C; stage_rc(otid() * 16 + i * 8192, R, C); Cb = C * 2; }

struct SchedDense {
    const char* A; const char* B; int RP, nM, nN, G, c;
    __device__ __forceinline__ const char* abase() const { return A; }
    __device__ __forceinline__ bool next(int i, Unit& u) const { const long L = (long)i * G + c; if (L >= (long)nM * nN) return false; dense_map((int)L, nM, nN, u.pm, u.pn); u.e = 0; return true; }
    __device__ __forceinline__ void a_off(const Unit& u, unsigned (&o)[2][2]) const {
#pragma unroll
        for (int i = 0; i < 2; ++i) { int R, Cb; lane_rc(i, R, Cb);
#pragma unroll
            for (int h = 0; h < 2; ++h) o[h][i] = (unsigned)(u.pm * BM + h * HALF + R) * (unsigned)RP + (unsigned)Cb; }
    }
    __device__ __forceinline__ void prefetch_rows(const Unit&, LAS unsigned char*, int, int, int) const {}
    __device__ __forceinline__ void prefetch_bias(const Unit&, LAS unsigned char*, int, int, int, int) const {}
    __device__ __forceinline__ void a_off_lds(const Unit& u, LAS unsigned char*, int, int, int, unsigned (&o)[2][2]) const { a_off(u, o); }
    __device__ __forceinline__ const char* b_ptr(const Unit& u) const { return B + (size_t)u.pn * BM * RP; }
};
struct SchedIn0 {
    const char* A; const char* B; int G, c;
    __device__ __forceinline__ const char* abase() const { return A; }
    __device__ __forceinline__ bool next(int i, Unit& u) const {
        const long L = (long)i * G + c; u.e = 0;
        if (L < 256 * 17) { dense_map((int)L, 256, 17, u.pm, u.pn); return true; }
        const int r = (int)(L - 256 * 17); if (r >= 56) return false;
        u.pm = 256 + r / 7; const int q = r % 7; u.pn = (q < 6) ? (2 + q) : 16; return true;
    }
    __device__ __forceinline__ void a_off(const Unit& u, unsigned (&o)[2][2]) const {
#pragma unroll
        for (int i = 0; i < 2; ++i) { int R, Cb; lane_rc(i, R, Cb);
#pragma unroll
            for (int h = 0; h < 2; ++h) o[h][i] = (unsigned)(u.pm * BM + h * HALF + R) * (F8_IN0 ? 1024u : 2048u) + (unsigned)Cb; }
    }
    __device__ __forceinline__ void prefetch_rows(const Unit&, LAS unsigned char*, int, int, int) const {}
    __device__ __forceinline__ void prefetch_bias(const Unit&, LAS unsigned char*, int, int, int, int) const {}
    __device__ __forceinline__ void a_off_lds(const Unit& u, LAS unsigned char*, int, int, int, unsigned (&o)[2][2]) const { a_off(u, o); }
    __device__ __forceinline__ const char* b_ptr(const Unit& u) const { return B + (size_t)u.pn * BM * (F8_IN0 ? 1024 : 2048); }
};
struct SchedMoE {
    const char* A; const char* B; const int* slot_tok; int ts; int RT; int nct; int G, c; size_t bstride_e; bool gather; const float* bias;
    __device__ __forceinline__ const char* abase() const { return A; }
    __device__ __forceinline__ bool next(int i, Unit& u) const {
        const int x = c & 7, j = c >> 3; int rt, ct;
        if (nct == 8) { rt = 32 * i + 4 * x + (j & 3); ct = j >> 2; } else { rt = 64 * i + 8 * x + (j & 7); ct = j >> 3; }
        if (rt >= RT) return false;
        const unsigned long long m = __ballot(((otid() & 63) < 32) && ts <= rt);
        u.pm = rt; u.pn = ct; u.e = __builtin_amdgcn_readfirstlane(__popcll(m)) - 1; return true;
    }
    __device__ __forceinline__ void a_off(const Unit& u, unsigned (&o)[2][2]) const {
#pragma unroll
        for (int i = 0; i < 2; ++i) { int R, Cb; lane_rc(i, R, Cb);
#pragma unroll
            for (int h = 0; h < 2; ++h) { const int row = u.pm * BM + h * HALF + R; const unsigned rr = gather ? (unsigned)slot_tok[row] : (unsigned)row; o[h][i] = rr * 1024u + (unsigned)Cb; } }
    }
    __device__ __forceinline__ const char* b_ptr(const Unit& u) const { return B + (size_t)u.e * bstride_e + (size_t)u.pn * BM * 1024; }
    __device__ __forceinline__ void prefetch_rows(const Unit& u, LAS unsigned char* lds, int par, int wid, int lane) const {
        if (!gather) return;
#pragma unroll
        for (int i = 0; i < 2; ++i) { int R, Cb; lane_rc(i, R, Cb);
#pragma unroll
            for (int h = 0; h < 2; ++h) __builtin_amdgcn_global_load_lds((const unsigned*)(slot_tok + (u.pm * BM + h * HALF + R)), (LAS unsigned*)(lds + XT_OFF + ((par * 8 + wid) * 4 + h * 2 + i) * 256), 4, 0, 0); }
    }
    __device__ __forceinline__ void prefetch_bias(const Unit& u, LAS unsigned char* lds, int par, int wid, int lane, int wc) const {
        const float* src = (nct == 8) ? bias + (size_t)u.e * 2048 + (lane >> 5) * 1024 + u.pn * 128 + wc * 32 + (lane & 31)
                                      : bias + (size_t)u.e * 1024 + u.pn * 256 + (lane >> 5) * 128 + wc * 32 + (lane & 31);
        __builtin_amdgcn_global_load_lds((const unsigned*)src, (LAS unsigned*)(lds + XB_OFF + (par * 8 + wid) * 256), 4, 0, 0);
    }
    __device__ __forceinline__ void a_off_lds(const Unit& u, LAS unsigned char* lds, int par, int wid, int lane, unsigned (&o)[2][2]) const {
#pragma unroll
        for (int i = 0; i < 2; ++i) { int R, Cb; lane_rc(i, R, Cb);
#pragma unroll
            for (int h = 0; h < 2; ++h) { const unsigned rr = gather ? *(const LAS unsigned*)(lds + XT_OFF + ((par * 8 + wid) * 4 + h * 2 + i) * 256 + lane * 4) : (unsigned)(u.pm * BM + h * HALF + R); o[h][i] = rr * 1024u + (unsigned)Cb; } }
    }
};

__device__ __forceinline__ void store8(bf16* p, const f32x4& v0, const f32x4& v1) {
    u32x4 w; w.x = cvt_pk(v0[0], v0[1]); w.y = cvt_pk(v0[2], v0[3]); w.z = cvt_pk(v1[0], v1[1]); w.w = cvt_pk(v1[2], v1[3]);
    *(u32x4*)p = w;
}
struct EpiPlain {
    bf16* O; int ldc;
    __device__ __forceinline__ void operator()(const f32x4 (&acc)[2][2][4][2], const Unit& u, int wr, int wc, int fr, int fq, const LAS float* lb) const {
        const int row0 = u.pm * BM + wr * 64 + fr, col0 = u.pn * BM + wc * 32 + 8 * fq;
#pragma unroll
        for (int ai = 0; ai < 2; ++ai)
#pragma unroll
            for (int m = 0; m < 4; ++m) { bf16* rowp = O + (size_t)(row0 + ai * HALF + m * 16) * ldc + col0;
#pragma unroll
                for (int bj = 0; bj < 2; ++bj) store8(rowp + bj * HALF, acc[ai][bj][m][0], acc[ai][bj][m][1]); }
    }
};
struct EpiIn0 {
    unsigned char* ws;
    __device__ __forceinline__ void operator()(const f32x4 (&acc)[2][2][4][2], const Unit& u, int wr, int wc, int fr, int fq, const LAS float* lb) const {
        const int pn = u.pn; bf16* base; int ldc, c0;
        if (pn < 2) { base = (bf16*)(ws + WS_Q); ldc = 512; c0 = pn * 256; }
        else if (pn < 4) { base = (bf16*)(ws + WS_K); ldc = 512; c0 = (pn - 2) * 256; }
        else if (pn < 8) { base = (bf16*)(ws + WS_V); ldc = 1024; c0 = (pn - 4) * 256; }
        else if (pn < 12) { base = (bf16*)(ws + WS_R); ldc = 1024; c0 = (pn - 8) * 256; }
        else if (pn < 14) { base = (bf16*)(ws + WS_ZC); ldc = 512; c0 = (pn - 12) * 256; }
        else if (pn < 16) { base = (bf16*)(ws + WS_ZS); ldc = 512; c0 = (pn - 14) * 256; }
        else { base = (bf16*)(ws + WS_LR); ldc = 32; c0 = 0; }
        const int row0 = u.pm * BM + wr * 64 + fr, col0 = c0 + wc * 32 + 8 * fq;
        const bool lr = (pn == 16);
        if (lr && wc != 0) return;
        const float qs = (pn < 2) ? 0.08838834764831845f : 1.0f;
#pragma unroll
        for (int ai = 0; ai < 2; ++ai)
#pragma unroll
            for (int m = 0; m < 4; ++m) { bf16* rowp = base + (size_t)(row0 + ai * HALF + m * 16) * ldc + col0;
                store8(rowp, acc[ai][0][m][0] * qs, acc[ai][0][m][1] * qs);
                if (!lr) store8(rowp + HALF, acc[ai][1][m][0] * qs, acc[ai][1][m][1] * qs); }
    }
};
struct EpiIn1 {
    unsigned char* ws;
    __device__ __forceinline__ void operator()(const f32x4 (&acc)[2][2][4][2], const Unit& u, int wr, int wc, int fr, int fq, const LAS float* lb) const {
        const int pn = u.pn; const int row0 = u.pm * BM + wr * 64 + fr;
        if (pn >= 8) { bf16* O = (bf16*)(ws + WS_GB); const int col0 = (pn - 8) * 256 + wc * 32 + 8 * fq;
#pragma unroll
            for (int ai = 0; ai < 2; ++ai)
#pragma unroll
                for (int m = 0; m < 4; ++m) { bf16* rowp = O + (size_t)(row0 + ai * HALF + m * 16) * 512 + col0;
#pragma unroll
                    for (int bj = 0; bj < 2; ++bj) store8(rowp + bj * HALF, acc[ai][bj][m][0], acc[ai][bj][m][1]); }
            return; }
        const bool glu = pn < 4; bf16* O = (bf16*)(ws + (glu ? WS_GLU : WS_ZC1)); const int col0 = (pn & 3) * 128 + wc * 32 + 8 * fq;
#pragma unroll
        for (int ai = 0; ai < 2; ++ai)
#pragma unroll
            for (int m = 0; m < 4; ++m) { f32x4 o[2];
#pragma unroll
                for (int n = 0; n < 2; ++n)
#pragma unroll
                    for (int i = 0; i < 4; i += 2) { const f32v2_t a = (f32v2_t){acc[ai][0][m][n][i], acc[ai][0][m][n][i + 1]}, b = (f32v2_t){acc[ai][1][m][n][i], acc[ai][1][m][n][i + 1]};
                        f32v2_t ov;
                        if (glu) { const f32v2_t ea = b * -1.4426950408889634f; f32v2_t e; e.x = __builtin_amdgcn_exp2f(ea.x); e.y = __builtin_amdgcn_exp2f(ea.y);
                            const f32v2_t d = e + 1.0f; f32v2_t r; r.x = __builtin_amdgcn_rcpf(d.x); r.y = __builtin_amdgcn_rcpf(d.y); ov = a * r; }
                        else ov = a * b;
                        o[n][i] = ov.x; o[n][i + 1] = ov.y; }
                store8(O + (size_t)(row0 + ai * HALF + m * 16) * 512 + col0, o[0], o[1]); }
    }
};
struct EpiGU {
    unsigned char* O; const float* bgu; int probe;
    __device__ __forceinline__ void operator()(const f32x4 (&acc)[2][2][4][2], const Unit& u, int wr, int wc, int fr, int fq, const LAS float* lb) const {
        if (probe) {
#pragma unroll
            for (int a = 0; a < 2; ++a)
#pragma unroll
                for (int b = 0; b < 2; ++b)
#pragma unroll
                    for (int m = 0; m < 4; ++m)
#pragma unroll
                        for (int n = 0; n < 2; ++n) asm volatile("" :: "v"(acc[a][b][m][n]));
            return; }
        const int row0 = u.pm * BM + wr * 64 + fr, col0 = u.pn * 128 + wc * 32 + 8 * fq;
        f32x4 bgv[2], buv[2];
#pragma unroll
        for (int n = 0; n < 2; ++n) { bgv[n] = *(const LAS f32x4*)(lb + 8 * fq + 4 * n); buv[n] = *(const LAS f32x4*)(lb + 32 + 8 * fq + 4 * n); }
#pragma unroll
        for (int ai = 0; ai < 2; ++ai)
#pragma unroll
            for (int m = 0; m < 4; ++m) { f32x4 o[2];
#pragma unroll
                for (int n = 0; n < 2; ++n)
#pragma unroll
                    for (int i = 0; i < 4; i += 2) {
                        f32v2_t g = (f32v2_t){acc[ai][0][m][n][i], acc[ai][0][m][n][i + 1]} + (f32v2_t){bgv[n][i], bgv[n][i + 1]};
                        f32v2_t uu = (f32v2_t){acc[ai][1][m][n][i], acc[ai][1][m][n][i + 1]} + (f32v2_t){buv[n][i], buv[n][i + 1]};
                        g.x = fminf(g.x, 7.0f); g.y = fminf(g.y, 7.0f);
                        uu.x = __builtin_amdgcn_fmed3f(uu.x, -7.0f, 7.0f); uu.y = __builtin_amdgcn_fmed3f(uu.y, -7.0f, 7.0f);
                        const f32v2_t ea = g * (-1.702f * 1.4426950408889634f);
                        f32v2_t e; e.x = __builtin_amdgcn_exp2f(ea.x); e.y = __builtin_amdgcn_exp2f(ea.y);
                        const f32v2_t d = e + 1.0f;
                        f32v2_t r; r.x = __builtin_amdgcn_rcpf(d.x); r.y = __builtin_amdgcn_rcpf(d.y);
                        const f32v2_t t4 = uu * 4.0f + 4.0f;
                        const f32v2_t ov = (g * r) * t4;
                        o[n][i] = ov.x; o[n][i + 1] = ov.y; }
                int w0 = 0, w1 = 0;
                w0 = __builtin_amdgcn_cvt_pk_fp8_f32(o[0][0], o[0][1], w0, false); w0 = __builtin_amdgcn_cvt_pk_fp8_f32(o[0][2], o[0][3], w0, true);
                w1 = __builtin_amdgcn_cvt_pk_fp8_f32(o[1][0], o[1][1], w1, false); w1 = __builtin_amdgcn_cvt_pk_fp8_f32(o[1][2], o[1][3], w1, true);
                *(u32x2*)(O + (size_t)(row0 + ai * HALF + m * 16) * 1024 + col0) = (u32x2){(unsigned)w0, (unsigned)w1}; }
    }
};
struct EpiDown {
    unsigned char* O; const float* bd;
    __device__ __forceinline__ void operator()(const f32x4 (&acc)[2][2][4][2], const Unit& u, int wr, int wc, int fr, int fq, const LAS float* lb) const {
        const int row0 = u.pm * BM + wr * 64 + fr, col0 = u.pn * BM + wc * 32 + 8 * fq;
        f32x4 bv[2][2];
#pragma unroll
        for (int bj = 0; bj < 2; ++bj)
#pragma unroll
            for (int n = 0; n < 2; ++n) bv[bj][n] = *(const LAS f32x4*)(lb + 32 * bj + 8 * fq + 4 * n) * 16.0f;
#pragma unroll
        for (int ai = 0; ai < 2; ++ai)
#pragma unroll
            for (int m = 0; m < 4; ++m) { unsigned char* rowp = O + (size_t)(row0 + ai * HALF + m * 16) * 1024 + col0;
#pragma unroll
                for (int bj = 0; bj < 2; ++bj) { const f32x4 v0 = acc[ai][bj][m][0] * 16.0f + bv[bj][0], v1 = acc[ai][bj][m][1] * 16.0f + bv[bj][1];
                    int w0 = 0, w1 = 0;
                    w0 = __builtin_amdgcn_cvt_pk_fp8_f32(fminf(fmaxf(v0[0], -440.f), 440.f), fminf(fmaxf(v0[1], -440.f), 440.f), w0, false); w0 = __builtin_amdgcn_cvt_pk_fp8_f32(fminf(fmaxf(v0[2], -440.f), 440.f), fminf(fmaxf(v0[3], -440.f), 440.f), w0, true);
                    w1 = __builtin_amdgcn_cvt_pk_fp8_f32(fminf(fmaxf(v1[0], -440.f), 440.f), fminf(fmaxf(v1[1], -440.f), 440.f), w1, false); w1 = __builtin_amdgcn_cvt_pk_fp8_f32(fminf(fmaxf(v1[2], -440.f), 440.f), fminf(fmaxf(v1[3], -440.f), 440.f), w1, true);
                    *(u32x2*)(rowp + bj * HALF) = (u32x2){(unsigned)w0, (unsigned)w1}; } }
    }
};
}

__device__ __forceinline__ void p0_adaln(const Ctx& C) {
    PH_IDS;
    LAS float* s = (LAS float*)C.lds;
    LAS float* red = (LAS float*)(C.lds + 36864);
    const float* cc = C.a->in[IN_C]; const float* cx = C.a->in[IN_CCTX];
    { float tmpc[18];
#pragma unroll
      for (int q = 0; q < 18; ++q) { const int i = tid + 512 * q; const int b = i >> 10, k = i & 1023; tmpc[q] = (b < 8) ? cc[b * 1024 + k] : cx[k]; }
#pragma unroll
      for (int q = 0; q < 18; ++q) s[tid + 512 * q] = siluf_(tmpc[q]); }
    __syncthreads();
    float* MOD = (float*)(C.ws + WS_MOD);
    for (int item = blockIdx.x; item < 192; item += C.G) {
        const int l = item / 96, cb = item % 96, col = cb * 64 + lane;
        const float* W = C.a->in[IN_MODW] + (size_t)l * 1024 * 6144 + col;
        float acc[9];
#pragma unroll
        for (int b = 0; b < 9; ++b) acc[b] = 0.f;
        const int k0 = wave * 128;
#pragma unroll 8
        for (int k = k0; k < k0 + 128; ++k) { const float w = W[(size_t)k * 6144];
#pragma unroll
            for (int b = 0; b < 9; ++b) acc[b] += s[b * 1024 + k] * w; }
#pragma unroll
        for (int b = 0; b < 9; ++b) red[(wave * 9 + b) * 64 + lane] = acc[b];
        __syncthreads();
        for (int i = tid; i < 576; i += 512) { const int b = i >> 6, ln = i & 63; float v = 0.f;
#pragma unroll
            for (int w = 0; w < 8; ++w) v += red[(w * 9 + b) * 64 + ln];
            v += C.a->in[IN_MODB][l * 6144 + cb * 64 + ln];
            MOD[(size_t)(l * 9 + b) * 6144 + cb * 64 + ln] = v; }
        __syncthreads();
    }
}
__device__ __forceinline__ void p0_tr_item(const float* W, int ldw, int sc0, int k0, bf16* WT, int Kd, int dr0, float scale, LAS float* scr, int lane) {
#pragma unroll 8
    for (int i = 0; i < 32; ++i) { const int kk = 2 * i + (lane >> 5); scr[kk * 33 + (lane & 31)] = W[(size_t)(k0 + kk) * ldw + sc0 + (lane & 31)]; }
    asm volatile("s_waitcnt lgkmcnt(0)" ::: "memory");
    const int c = lane & 7;
#pragma unroll
    for (int j = 0; j < 4; ++j) { const int n = (lane >> 3) + 8 * j; const LAS float* sp = scr + (8 * c) * 33 + n;
        u32x4 o; o.x = cvt_pk(sp[0 * 33] * scale, sp[1 * 33] * scale); o.y = cvt_pk(sp[2 * 33] * scale, sp[3 * 33] * scale);
        o.z = cvt_pk(sp[4 * 33] * scale, sp[5 * 33] * scale); o.w = cvt_pk(sp[6 * 33] * scale, sp[7 * 33] * scale);
        *(u32x4*)(WT + (size_t)(dr0 + n) * Kd + k0 + 8 * c) = o; }
    asm volatile("s_waitcnt lgkmcnt(0)" ::: "memory");
}
__device__ __forceinline__ void p0_tr_item8(const float* W, int ldw, int sc0, int k0, unsigned char* WT, int Kd, int dr0, float scale, LAS float* scr, int lane) {
#pragma unroll 8
    for (int i = 0; i < 64; ++i) { const int kk = 2 * i + (lane >> 5); scr[kk * 33 + (lane & 31)] = W[(size_t)(k0 + kk) * ldw + sc0 + (lane & 31)]; }
    asm volatile("s_waitcnt lgkmcnt(0)" ::: "memory");
    const int c = lane & 7;
#pragma unroll
    for (int j = 0; j < 4; ++j) { const int n = (lane >> 3) + 8 * j; const LAS float* sp = scr + (16 * c) * 33 + n;
        int w[4];
#pragma unroll
        for (int q = 0; q < 4; ++q) { int x = 0;
            x = __builtin_amdgcn_cvt_pk_fp8_f32(sp[(4 * q) * 33] * scale, sp[(4 * q + 1) * 33] * scale, x, false);
            x = __builtin_amdgcn_cvt_pk_fp8_f32(sp[(4 * q + 2) * 33] * scale, sp[(4 * q + 3) * 33] * scale, x, true); w[q] = x; }
        *(u32x4*)(WT + (size_t)(dr0 + n) * Kd + k0 + 16 * c) = (u32x4){(unsigned)w[0], (unsigned)w[1], (unsigned)w[2], (unsigned)w[3]}; }
    asm volatile("s_waitcnt lgkmcnt(0)" ::: "memory");
}
__device__ __forceinline__ int gu_src_col(int dr0) { const int pn = dr0 >> 8, bj = (dr0 >> 7) & 1, t0 = dr0 & 127; return bj * 1024 + 128 * pn + t0; }
__device__ __forceinline__ int in1_src_col(int dr0) {
    const int pn = dr0 >> 8, bj = (dr0 >> 7) & 1, t0 = dr0 & 127;
    if (pn < 4) return bj * 512 + 128 * pn + t0;
    if (pn < 8) return (bj ? 2048 : 1536) + 128 * (pn - 4) + t0;
    return 1024 + (dr0 - 2048);
}
__device__ __forceinline__ void p0_convert(const Ctx& C) {
    PH_IDS;
    LAS float* scr = (LAS float*)(C.lds + wave * 16896);
    const int gw = blockIdx.x * 8 + wave, NGW = C.G * 8;
    constexpr int KB_IN0 = F8_IN0 ? 8 : 16, KB_OUT0 = F8_OUT0 ? 12 : 24, KB_IN1 = F8_IN1 ? 8 : 16, KB_OUT1 = F8_OUT1 ? 8 : 16;
    constexpr int I_IN0 = 97 * KB_IN0, I_OUT0 = 32 * KB_OUT0, I_IN1 = 80 * KB_IN1, I_OUT1 = 32 * KB_OUT1, I_GU = 64 * 64 * 8, I_D = 64 * 32 * 8;
    constexpr int NITEMS = I_IN0 + I_OUT0 + I_IN1 + I_OUT1 + I_GU + I_D;
    for (int it = gw; it < NITEMS; it += NGW) {
        int r = it;
        if (r < I_IN0) { const int nb = r / KB_IN0, kb = r % KB_IN0; int dr0, sc0;
            if (nb < 96) { dr0 = nb * 32; sc0 = dr0; } else { dr0 = 4096; sc0 = 3072; }
            if (F8_IN0) p0_tr_item8(C.a->in[IN_EVWIN], 3616, sc0, kb * 128, (unsigned char*)(C.ws + WS_WIN0), 1024, dr0, 32.f, scr, lane);
            else p0_tr_item(C.a->in[IN_EVWIN], 3616, sc0, kb * 64, (bf16*)(C.ws + WS_WIN0), 1024, dr0, 1.f, scr, lane);
            continue; }
        r -= I_IN0;
        if (r < I_OUT0) { const int nb = r / KB_OUT0, kb = r % KB_OUT0;
            if (F8_OUT0) p0_tr_item8(C.a->in[IN_EVWOUT], 1024, nb * 32, kb * 128, (unsigned char*)(C.ws + WS_WOUT0), 1536, nb * 32, 32.f, scr, lane);
            else p0_tr_item(C.a->in[IN_EVWOUT], 1024, nb * 32, kb * 64, (bf16*)(C.ws + WS_WOUT0), 1536, nb * 32, 1.f, scr, lane);
            continue; }
        r -= I_OUT0;
        if (r < I_IN1) { const int nb = r / KB_IN1, kb = r % KB_IN1;
            if (F8_IN1) p0_tr_item8(C.a->in[IN_ODWIN], 2560, in1_src_col(nb * 32), kb * 128, (unsigned char*)(C.ws + WS_WIN1), 1024, nb * 32, 32.f, scr, lane);
            else p0_tr_item(C.a->in[IN_ODWIN], 2560, in1_src_col(nb * 32), kb * 64, (bf16*)(C.ws + WS_WIN1), 1024, nb * 32, 1.f, scr, lane);
            continue; }
        r -= I_IN1;
        if (r < I_OUT1) { const int nb = r / KB_OUT1, kb = r % KB_OUT1;
            if (F8_OUT1) p0_tr_item8(C.a->in[IN_ODWOUT], 1024, nb * 32, kb * 128, (unsigned char*)(C.ws + WS_WOUT1), 1024, nb * 32, 32.f, scr, lane);
            else p0_tr_item(C.a->in[IN_ODWOUT], 1024, nb * 32, kb * 64, (bf16*)(C.ws + WS_WOUT1), 1024, nb * 32, 1.f, scr, lane);
            continue; }
        r -= I_OUT1;
        if (r < I_GU) { const int le = r >> 9, q = r & 511, nb = q >> 3, kb = q & 7;
            p0_tr_item8(C.a->in[IN_WGU] + (size_t)le * 1024 * 2048, 2048, gu_src_col(nb * 32), kb * 128, (unsigned char*)(C.ws + WS_WGU) + (size_t)le * 2048 * 1024, 1024, nb * 32, 32.f, scr, lane); continue; }
        r -= I_GU;
        { const int le = r >> 8, q = r & 255, nb = q >> 3, kb = q & 7;
            p0_tr_item8(C.a->in[IN_WD] + (size_t)le * 1024 * 1024, 1024, nb * 32, kb * 128, (unsigned char*)(C.ws + WS_WD) + (size_t)le * 1024 * 1024, 1024, nb * 32, 32.f, scr, lane); }
    }
    { u32x4* z = (u32x4*)((unsigned char*)(C.ws + WS_WIN0) + (size_t)4128 * 1024 * (F8_IN0 ? 1 : 2)); const int n16 = 224 * 1024 * (F8_IN0 ? 1 : 2) / 16;
      for (int i = blockIdx.x * 512 + tid; i < n16; i += C.G * 512) z[i] = (u32x4){0u, 0u, 0u, 0u}; }
    { bf16* F1 = (bf16*)(C.ws + WS_F1); bf16* F2 = (bf16*)(C.ws + WS_F2);
      for (int i = blockIdx.x * 512 + tid; i < 128 * 128 + 128 * 256; i += C.G * 512) {
          if (i < 128 * 128) { const int m = i >> 7, k = i & 127; const int mb = m >> 5, rr = m & 31, g = rr >> 3, hh = (rr >> 2) & 1, ii = rr & 3;
              const int part = g & 1, ap = 16 * mb + 8 * (g >> 1) + 4 * hh + ii, pin = k >> 6, a = k & 63;
              const float th = 6.283185307179586f * (float)((a * ap) & 63) * (1.0f / 64.0f); const float cs = cosf(th), sn = sinf(th);
              const float v = (part == 0) ? (pin == 0 ? cs : -sn) : (pin == 0 ? -sn : -cs);
              F1[i] = (bf16)f2bf(v); }
          else { const int q = i - 128 * 128, m = q >> 8, k = q & 255, pin = k >> 7, b = k & 127;
              const float ps = 6.283185307179586f * (float)((b * m) & 127) * (1.0f / 128.0f);
              F2[q] = (bf16)f2bf(pin == 0 ? cosf(ps) : sinf(ps)); } } }
    __syncthreads();
}
__device__ __forceinline__ void p0_fourier_fold(const Ctx& C) {
    PH_IDS;
    LAS float* Wl = (LAS float*)C.lds;
    LAS float* tab = (LAS float*)(C.lds + 32768);
    unsigned char* WT = (unsigned char*)(C.ws + WS_WIN0);
    for (int item = (C.G >= 256) ? (int)blockIdx.x - 192 : (int)blockIdx.x; item >= 0 && item < 64; item += C.G) {
        const int kb = item >> 2, g = item & 3;
        __syncthreads();
        if (tid < 128) tab[tid] = cosf(6.283185307179586f * (float)tid * (1.0f / 128.0f));
        for (int i = tid; i < 64 * 128; i += 512) { const int kk = i >> 7, c = i & 127; Wl[i] = C.a->in[IN_EVWIN][(size_t)(kb * 64 + kk) * 3616 + 3104 + g * 128 + c]; }
        __syncthreads();
        const int cp = tid & 127, kq = tid >> 7;
        float ac[16], as[16];
#pragma unroll
        for (int i = 0; i < 16; ++i) { ac[i] = 0.f; as[i] = 0.f; }
        for (int c = 0; c < 128; ++c) { const int ph = (c * cp) & 127; const float cs = tab[ph], sn = tab[(ph + 96) & 127];
#pragma unroll
            for (int i = 0; i < 16; ++i) { const float w = Wl[(kq * 16 + i) * 128 + c]; ac[i] += w * cs; as[i] += w * sn; } }
        if (F8_IN0) {
            unsigned char* pc = WT + (size_t)(3072 + g * 128 + cp) * 1024 + kb * 64 + kq * 16;
            unsigned char* ps = WT + (size_t)(3584 + g * 128 + cp) * 1024 + kb * 64 + kq * 16;
            *(u32x4*)pc = (u32x4){pk4_fp8(ac[0], ac[1], ac[2], ac[3], 32.f), pk4_fp8(ac[4], ac[5], ac[6], ac[7], 32.f), pk4_fp8(ac[8], ac[9], ac[10], ac[11], 32.f), pk4_fp8(ac[12], ac[13], ac[14], ac[15], 32.f)};
            *(u32x4*)ps = (u32x4){pk4_fp8(as[0], as[1], as[2], as[3], 32.f), pk4_fp8(as[4], as[5], as[6], as[7], 32.f), pk4_fp8(as[8], as[9], as[10], as[11], 32.f), pk4_fp8(as[12], as[13], as[14], as[15], 32.f)};
        } else {
            bf16* pc = (bf16*)WT + (size_t)(3072 + g * 128 + cp) * 1024 + kb * 64 + kq * 16;
            bf16* ps = (bf16*)WT + (size_t)(3584 + g * 128 + cp) * 1024 + kb * 64 + kq * 16;
            *(u32x4*)pc = (u32x4){cvt_pk(ac[0], ac[1]), cvt_pk(ac[2], ac[3]), cvt_pk(ac[4], ac[5]), cvt_pk(ac[6], ac[7])}; *(u32x4*)(pc + 8) = (u32x4){cvt_pk(ac[8], ac[9]), cvt_pk(ac[10], ac[11]), cvt_pk(ac[12], ac[13]), cvt_pk(ac[14], ac[15])};
            *(u32x4*)ps = (u32x4){cvt_pk(as[0], as[1]), cvt_pk(as[2], as[3]), cvt_pk(as[4], as[5]), cvt_pk(as[6], as[7])}; *(u32x4*)(ps + 8) = (u32x4){cvt_pk(as[8], as[9]), cvt_pk(as[10], as[11]), cvt_pk(as[12], as[13]), cvt_pk(as[14], as[15])};
        }
    }
    __syncthreads();
}

__device__ __forceinline__ void p_norm0(const Ctx& C) {
    PH_IDS;
    const int gw = blockIdx.x * 8 + wave, NGW = C.G * 8;
    const int per = (MALL + NGW - 1) / NGW;
    const int r0 = gw * per, r1 = (r0 + per < MALL) ? r0 + per : MALL;
    const float* MOD = (const float*)(C.ws + WS_MOD);
    const float* g = C.a->in[IN_NMPRE];
    unsigned char* HN = (unsigned char*)(C.ws + WS_HN);
    int curb = -1; f32x4 A[4], B[4];
    for (int r = r0; r < r1; ++r) {
        const int b = (r < MTOK) ? (r >> 13) : 8;
        if (b != curb) { curb = b;
#pragma unroll
            for (int j = 0; j < 4; ++j) { const int c = 4 * lane + 256 * j;
                const f32x4 gg = *(const f32x4*)(g + c), sc = *(const f32x4*)(MOD + (size_t)b * 6144 + 1024 + c), sh = *(const f32x4*)(MOD + (size_t)b * 6144 + c);
                A[j] = gg * (sc + 1.0f); B[j] = sh; } }
        const float* xr = (r < MTOK) ? (C.a->in[IN_X] + (size_t)r * 1024) : (C.a->in[IN_CTX] + (size_t)(r - MTOK) * 1024);
        f32x4 v[4]; float ss = 0.f;
#pragma unroll
        for (int j = 0; j < 4; ++j) { v[j] = *(const f32x4*)(xr + 4 * lane + 256 * j); ss += v[j][0] * v[j][0] + v[j][1] * v[j][1] + v[j][2] * v[j][2] + v[j][3] * v[j][3]; }
        const float rstd = rsqrtf(wave_sum(ss) * (1.0f / 1024.0f) + EPS);
#pragma unroll
        for (int j = 0; j < 4; ++j) { const f32x4 h = v[j] * rstd * A[j] + B[j];
            if (F8_IN0) *(unsigned*)(HN + (size_t)r * 1024 + 4 * lane + 256 * j) = pk4_fp8(h[0], h[1], h[2], h[3], 8.f);
            else *(u32x2*)((bf16*)HN + (size_t)r * 1024 + 4 * lane + 256 * j) = (u32x2){cvt_pk(h[0], h[1]), cvt_pk(h[2], h[3])}; }
    }
}

namespace glap {
constexpr int H_BYTES = 72704;
constexpr int O_RAW = 0, O_BC = 2048, O_TOT = 34816, O_QP = 36864, O_KP = 54272;
constexpr int NUNIT = 2 * 4 * 8 * 132;
}
__device__ __forceinline__ int gla_row(int bt, int dir, int s, int i) {
    const int ii = dir ? 63 - i : i;
    if (s < 4) { const int ci = dir ? 3 - s : s; return MTOK + bt * CTXL + ci * 64 + ii; }
    const int n = s - 4, ci = dir ? 127 - n : n; return bt * SEQ + ci * 64 + ii;
}
__device__ __forceinline__ void p_gla_prep(const Ctx& C) {
    PH_IDS;
    using namespace glap;
    const int half = tid >> 8, th = tid & 255, wh = wave & 3;
    LAS unsigned char* L = C.lds + half * H_BYTES;
    const bf16* Qg = (const bf16*)(C.ws + WS_Q); const bf16* Kg = (const bf16*)(C.ws + WS_K); const bf16* LRg = (const bf16*)(C.ws + WS_LR);
    bf16* QPg = (bf16*)(C.ws + WS_GQP); bf16* KPPg = (bf16*)(C.ws + WS_GKPP); bf16* SCg = (bf16*)(C.ws + WS_GSC); float* ELg = (float*)(C.ws + WS_GEL);
    const int niter = (NUNIT + 2 * C.G - 1) / (2 * C.G);
    const int lj = th >> 2, part = th & 3;
    u32x4 nq[4], nk[4], nlr; float nup[8], nbias;
    auto unit_of = [&](int itn) -> int { const int U = (itn * C.G + (int)blockIdx.x) * 2 + half; return U < NUNIT ? U : NUNIT - 1; };
    auto issue_loads = [&](int Uc) {
        const int sstep = Uc % 132, bt = (Uc / 132) & 7, hd = (Uc / (132 * 8)) & 3, dir = Uc / (132 * 32);
#pragma unroll
        for (int q = 0; q < 4; ++q) { const int c = th + 256 * q; const int row = gla_row(bt, dir, sstep, c >> 4);
            nk[q] = *(const u32x4*)(Kg + (size_t)row * 512 + hd * 128 + (c & 15) * 8);
            nq[q] = *(const u32x4*)(Qg + (size_t)(sstep >= 4 ? row : 0) * 512 + hd * 128 + (c & 15) * 8); }
        if (th < 128) { const int r2 = gla_row(bt, dir, sstep, th >> 1); nlr = *(const u32x4*)(LRg + (size_t)r2 * 32 + dir * 16 + (th & 1) * 8); }
        const float* up = C.a->in[IN_EVGKUP] + (size_t)dir * 16 * 512 + hd * 128 + 32 * wh + (lane & 31);
#pragma unroll
        for (int q = 0; q < 8; ++q) nup[q] = up[(size_t)(8 * (lane >> 5) + q) * 512];
        nbias = C.a->in[IN_EVGKB][dir * 512 + hd * 128 + 32 * wh + (lane & 31)]; };
    issue_loads(unit_of(0));
    for (int itn = 0; itn < niter; ++itn) {
        const int U = (itn * C.G + (int)blockIdx.x) * 2 + half;
        const bool act = U < NUNIT;
        const int Uc = act ? U : NUNIT - 1;
        const int sstep = Uc % 132;
        const bool latent = sstep >= 4;
        u32x4 rq[4], rk[4], rlr = nlr;
#pragma unroll
        for (int q = 0; q < 4; ++q) { rq[q] = nq[q]; rk[q] = nk[q]; }
        bf16x8 upf; const float gbias = nbias;
        { unsigned short tmp[8];
#pragma unroll
          for (int q = 0; q < 8; ++q) tmp[q] = (unsigned short)f2bf(nup[q]);
          upf = (bf16x8){(short)tmp[0], (short)tmp[1], (short)tmp[2], (short)tmp[3], (short)tmp[4], (short)tmp[5], (short)tmp[6], (short)tmp[7]}; }
        if (itn + 1 < niter) issue_loads(unit_of(itn + 1));
        __syncthreads();
        if (th < 128) *(LAS u32x4*)(L + O_RAW + (th >> 1) * 32 + (th & 1) * 16) = rlr;
        __syncthreads();
#pragma unroll
        for (int jb = 0; jb < 2; ++jb) {
            const bf16x8 af = *(const LAS bf16x8*)(L + O_RAW + (32 * jb + (lane & 31)) * 32 + (lane >> 5) * 16);
            f32x16 z;
#pragma unroll
            for (int i = 0; i < 16; ++i) z[i] = 0.f;
            z = __builtin_amdgcn_mfma_f32_32x32x16_bf16(af, upf, z, 0, 0, 0);
#pragma unroll
            for (int r = 0; r < 16; ++r) { const int j = 32 * jb + (r & 3) + 8 * (r >> 2) + 4 * (lane >> 5); const float zz = z[r] + gbias;
                const float ls = fminf(zz, 0.f) - __logf(1.0f + __expf(-fabsf(zz)));
                *(LAS float*)(L + O_BC + (j * 128 + 32 * wh + (lane & 31)) * 4) = ls * 0.0625f; } }
        __syncthreads();
        { const int dk = th & 127;
          float run0 = 0.f, run1 = 0.f; const int g0 = th >> 7, g1 = g0 + 2;
          float v0[16], v1[16];
#pragma unroll
          for (int q = 0; q < 16; ++q) { v0[q] = *(const LAS float*)(L + O_BC + ((16 * g0 + q) * 128 + dk) * 4); v1[q] = *(const LAS float*)(L + O_BC + ((16 * g1 + q) * 128 + dk) * 4); }
#pragma unroll
          for (int q = 0; q < 16; ++q) { run0 += v0[q]; run1 += v1[q];
              *(LAS float*)(L + O_BC + ((16 * g0 + q) * 128 + dk) * 4) = run0; *(LAS float*)(L + O_BC + ((16 * g1 + q) * 128 + dk) * 4) = run1; }
          *(LAS float*)(L + O_TOT + (g0 * 128 + dk) * 4) = run0; *(LAS float*)(L + O_TOT + (g1 * 128 + dk) * 4) = run1; }
        __syncthreads();
        {
#pragma unroll
          for (int q8 = 0; q8 < 4; ++q8) {
              const int c = th + 256 * q8, cj = c >> 4, jg = cj >> 4, dkc = (c & 15) * 8;
              u32x4 oq, okpp;
#pragma unroll
              for (int hq = 0; hq < 2; ++hq) {
                  const int dk0 = dkc + 4 * hq;
                  f32x4 b = *(const LAS f32x4*)(L + O_BC + (cj * 128 + dk0) * 4), tt = (f32x4){0.f, 0.f, 0.f, 0.f};
#pragma unroll
                  for (int g2 = 0; g2 < 4; ++g2) { const f32x4 tv = *(const LAS f32x4*)(L + O_TOT + (g2 * 128 + dk0) * 4); tt += tv; if (g2 < jg) b += tv; }
                  f32x4 e1, e2, e3;
#pragma unroll
                  for (int i = 0; i < 4; ++i) { e1[i] = __expf(b[i]); e2[i] = __expf(-b[i]); e3[i] = __expf(tt[i] - b[i]); }
                  if (cj == 0 && act) { f32x4 el;
#pragma unroll
                      for (int i = 0; i < 4; ++i) el[i] = __expf(tt[i]);
                      *(f32x4*)(ELg + (size_t)Uc * 128 + dk0) = el; }
                  const unsigned qa = hq ? rq[q8].z : rq[q8].x, qb = hq ? rq[q8].w : rq[q8].y;
                  const unsigned ka = hq ? rk[q8].z : rk[q8].x, kb = hq ? rk[q8].w : rk[q8].y;
                  const float q0 = bf_lo(qa), q1 = bf_hi(qa), q2 = bf_lo(qb), q3 = bf_hi(qb);
                  const float k0 = bf_lo(ka), k1 = bf_hi(ka), k2 = bf_lo(kb), k3 = bf_hi(kb);
                  u32x2 o;
                  o.x = cvt_pk(q0 * e1[0], q1 * e1[1]); o.y = cvt_pk(q2 * e1[2], q3 * e1[3]); *(LAS u32x2*)(L + O_QP + cj * 272 + dk0 * 2) = o;
                  if (hq) { oq.z = o.x; oq.w = o.y; } else { oq.x = o.x; oq.y = o.y; }
                  o.x = cvt_pk(k0 * e2[0], k1 * e2[1]); o.y = cvt_pk(k2 * e2[2], k3 * e2[3]); *(LAS u32x2*)(L + O_KP + cj * 272 + dk0 * 2) = o;
                  o.x = cvt_pk(k0 * e3[0], k1 * e3[1]); o.y = cvt_pk(k2 * e3[2], k3 * e3[3]);
                  if (hq) { okpp.z = o.x; okpp.w = o.y; } else { okpp.x = o.x; okpp.y = o.y; }
              }
              if (act) { *(u32x4*)(KPPg + (size_t)Uc * 8192 + c * 8) = okpp; if (latent) *(u32x4*)(QPg + (size_t)Uc * 8192 + c * 8) = oq; }
          } }
        __syncthreads();
        if (latent && act) {
            const int ib = wh;
            for (int jb16 = 0; jb16 <= ib; ++jb16) {
                f32x4 d = (f32x4){0.f, 0.f, 0.f, 0.f};
#pragma unroll
                for (int ks = 0; ks < 4; ++ks) {
                    const bf16x8 a = *(const LAS bf16x8*)(L + O_KP + (16 * jb16 + (lane & 15)) * 272 + (32 * ks + 8 * (lane >> 4)) * 2);
                    const bf16x8 bq = *(const LAS bf16x8*)(L + O_QP + (16 * ib + (lane & 15)) * 272 + (32 * ks + 8 * (lane >> 4)) * 2);
                    d = __builtin_amdgcn_mfma_f32_16x16x32_bf16(a, bq, d, 0, 0, 0); }
                const int i = 16 * ib + (lane & 15), j0 = 16 * jb16 + 4 * (lane >> 4);
#pragma unroll
                for (int r = 0; r < 4; ++r) if (j0 + r > i) d[r] = 0.f;
                u32x2 o; o.x = cvt_pk(d[0], d[1]); o.y = cvt_pk(d[2], d[3]);
                *(u32x2*)(SCg + (size_t)Uc * 4096 + i * 64 + j0) = o;
            }
            for (int jb16 = ib + 1; jb16 < 4; ++jb16) { const int i = 16 * ib + (lane & 15), j0 = 16 * jb16 + 4 * (lane >> 4);
                *(u32x2*)(SCg + (size_t)Uc * 4096 + i * 64 + j0) = (u32x2){0u, 0u}; }
        }
    }
    __syncthreads();
}
namespace gla {
constexpr int O_EL = 0, O_QP = 512, O_KPP = 17920, O_V = 38400, O_SC = 50688, IMG_BYTES = 59904, O_ST = 2 * IMG_BYTES;
constexpr int P_QP = 272, P_KPP = 320, P_V = 192, P_SC = 144, P_ST = 272, ST_BYTES = 64 * 272;
__device__ __forceinline__ bf16x8 tr8(LAS unsigned char* p0, LAS unsigned char* p1) {
    const s16x4 a = __builtin_amdgcn_ds_read_tr16_b64_v4i16((LAS s16x4*)p0);
    const s16x4 b = __builtin_amdgcn_ds_read_tr16_b64_v4i16((LAS s16x4*)p1);
    return (bf16x8){a[0], a[1], a[2], a[3], b[0], b[1], b[2], b[3]};
}
}
__device__ __forceinline__ void p_gla(const Ctx& C, const int probe = 0) {
    PH_IDS;
    using namespace gla;
    LAS unsigned char* L = C.lds;
    const int t = tid, w = wave;
    const bf16* Vg = (const bf16*)(C.ws + WS_V);
    const bf16* QPg = (const bf16*)(C.ws + WS_GQP); const bf16* KPPg = (const bf16*)(C.ws + WS_GKPP); const bf16* SCg = (const bf16*)(C.ws + WS_GSC); const float* ELg = (const float*)(C.ws + WS_GEL);
    for (int it = blockIdx.x; it < 256; it += C.G) {
        const int xx = it & 7, jj_ = it >> 3, scan = xx * 8 + (jj_ >> 2), dvs = jj_ & 3;
        const int bt = scan >> 3, hd = (scan >> 1) & 3, dir = scan & 1;
        const int ubase = ((dir * 4 + hd) * 8 + bt) * 132;
        bf16* Og = (bf16*)(C.ws + (probe ? WS_HN : (dir ? WS_OB : WS_OF)));
        __syncthreads();
        for (int i = t; i < ST_BYTES / 16; i += 512) *(LAS u32x4*)(L + O_ST + i * 16) = (u32x4){0u, 0u, 0u, 0u};
        f32x16 S;
#pragma unroll
        for (int i = 0; i < 16; ++i) S[i] = 0.f;
        const int lj = t >> 3, part = t & 7;
        u32x4 rsc, rqp0, rqp1, rkp0, rkp1, rv; f32x4 rel;
        u32x4 nsc, nqp0, nqp1, nkp0, nkp1, nv; f32x4 nel;
        auto load_step = [&](int s_) {
            const int s = probe ? 4 + (s_ & 1) : s_;
            const size_t U = (size_t)(ubase + s);
            const int row = gla_row(bt, dir, s, lj);
            nv = *(const u32x4*)(Vg + (size_t)row * 1024 + hd * 256 + dvs * 64 + part * 8);
            const bf16* kp = KPPg + U * 8192 + t * 8; nkp0 = *(const u32x4*)kp; nkp1 = *(const u32x4*)(kp + 4096);
            if (t < 32) nel = *(const f32x4*)(ELg + U * 128 + t * 4);
            if (s >= 4) { const bf16* qp = QPg + U * 8192 + t * 8; nqp0 = *(const u32x4*)qp; nqp1 = *(const u32x4*)(qp + 4096);
                nsc = *(const u32x4*)(SCg + U * 4096 + lj * 64 + part * 8); } };
        auto shift_regs = [&]() { rsc = nsc; rqp0 = nqp0; rqp1 = nqp1; rkp0 = nkp0; rkp1 = nkp1; rv = nv; rel = nel; };
        auto write_images = [&](int s, int ib_) {
            LAS unsigned char* I = L + ib_ * IMG_BYTES;
            *(LAS u32x4*)(I + O_V + lj * P_V + part * 16) = rv;
            *(LAS u32x4*)(I + O_KPP + (t >> 4) * P_KPP + (t & 15) * 16) = rkp0; *(LAS u32x4*)(I + O_KPP + (32 + (t >> 4)) * P_KPP + (t & 15) * 16) = rkp1;
            if (t < 32) *(LAS f32x4*)(I + O_EL + t * 16) = rel;
            if (s >= 4) { *(LAS u32x4*)(I + O_QP + (t >> 4) * P_QP + (t & 15) * 16) = rqp0; *(LAS u32x4*)(I + O_QP + (32 + (t >> 4)) * P_QP + (t & 15) * 16) = rqp1;
                *(LAS u32x4*)(I + O_SC + lj * P_SC + part * 16) = rsc; } };
        load_step(0); shift_regs(); write_images(0, 0);
        load_step(1); shift_regs();
        load_step(2);
        for (int s = 0; s < 132; ++s) {
            const int cur = s & 1, nx = cur ^ 1;
            const bool latent = (s >= 4);
            LAS unsigned char* I = L + cur * IMG_BYTES;
            __syncthreads();
            if (s + 1 < 132) write_images(s + 1, nx);
            shift_regs();
            if (s + 3 < 132) load_step(s + 3);
            if (latent) {
                const int ib = w >> 1;
                const int g4 = lane >> 4, q4 = (lane & 15) >> 2, p4 = lane & 3;
                const int orow = gla_row(bt, dir, s, 16 * ib + (lane & 15));
#pragma unroll
                for (int cc = 0; cc < 2; ++cc) {
                    const int c = 2 * (w & 1) + cc;
                    f32x4 d = (f32x4){0.f, 0.f, 0.f, 0.f};
#pragma unroll
                    for (int ks = 0; ks < 2; ++ks) {
                        LAS unsigned char* pa = I + O_V + (32 * ks + 8 * g4 + q4) * P_V + (16 * c + 4 * p4) * 2;
                        const bf16x8 a = gla::tr8(pa, pa + 4 * P_V);
                        const bf16x8 b = *(const LAS bf16x8*)(I + O_SC + (16 * ib + (lane & 15)) * P_SC + (32 * ks + 8 * g4) * 2);
                        d = __builtin_amdgcn_mfma_f32_16x16x32_bf16(a, b, d, 0, 0, 0); }
#pragma unroll
                    for (int ks = 0; ks < 4; ++ks) {
                        const bf16x8 a = *(const LAS bf16x8*)(L + O_ST + cur * ST_BYTES + (16 * c + (lane & 15)) * P_ST + (32 * ks + 8 * g4) * 2);
                        const bf16x8 b = *(const LAS bf16x8*)(I + O_QP + (16 * ib + (lane & 15)) * P_QP + (32 * ks + 8 * g4) * 2);
                        d = __builtin_amdgcn_mfma_f32_16x16x32_bf16(a, b, d, 0, 0, 0); }
                    u32x2 o; o.x = cvt_pk(d[0], d[1]); o.y = cvt_pk(d[2], d[3]);
                    *(u32x2*)(Og + (size_t)orow * 1024 + hd * 256 + dvs * 64 + 16 * c + 4 * g4) = o;
                }
            }
            { const int dbS = w & 3, dvb = w >> 2, hh = lane >> 5, blk = (lane >> 4) & 1, q4 = (lane & 15) >> 2, p4 = lane & 3;
#pragma unroll
              for (int g = 0; g < 4; ++g) { const f32x4 el = *(const LAS f32x4*)(I + O_EL + (32 * dbS + 8 * g + 4 * hh) * 4);
#pragma unroll
                  for (int i = 0; i < 4; ++i) S[4 * g + i] *= el[i]; }
#pragma unroll
              for (int ks = 0; ks < 4; ++ks) {
                  LAS unsigned char* pa = I + O_KPP + (16 * ks + 8 * hh + q4) * P_KPP + (32 * dbS + 16 * blk + 4 * p4) * 2;
                  LAS unsigned char* pb = I + O_V + (16 * ks + 8 * hh + q4) * P_V + (32 * dvb + 16 * blk + 4 * p4) * 2;
                  const bf16x8 a = gla::tr8(pa, pa + 4 * P_KPP);
                  const bf16x8 b = gla::tr8(pb, pb + 4 * P_V);
                  S = __builtin_amdgcn_mfma_f32_32x32x16_bf16(a, b, S, 0, 0, 0); }
#pragma unroll
              for (int g = 0; g < 4; ++g) { u32x2 o; o.x = cvt_pk(S[4 * g], S[4 * g + 1]); o.y = cvt_pk(S[4 * g + 2], S[4 * g + 3]);
                  *(LAS u32x2*)(L + O_ST + nx * ST_BYTES + (32 * dvb + (lane & 31)) * P_ST + (32 * dbS + 8 * g + 4 * hh) * 2) = o; } }
        }
    }
}

__device__ __forceinline__ void p_fft1(const Ctx& C) {
    PH_IDS;
    LAS unsigned char* L = C.lds;
    const int t = tid, w = wave, mb = w & 3, nh = w >> 2, hh = lane >> 5;
    const bf16* F1 = (const bf16*)(C.ws + WS_F1);
    bf16x8 af[8];
#pragma unroll
    for (int ks = 0; ks < 8; ++ks) af[ks] = *(const bf16x8*)(F1 + (32 * mb + (lane & 31)) * 128 + 16 * ks + 8 * hh);
    const bf16* ZC = (const bf16*)(C.ws + WS_ZC); const bf16* ZS = (const bf16*)(C.ws + WS_ZS);
    bf16* YR = (bf16*)(C.ws + WS_YR); bf16* YI = (bf16*)(C.ws + WS_YI);
    const int blk = (lane >> 4) & 1, q4 = (lane & 15) >> 2, p4 = lane & 3;
    u32x4 pv[8];
    auto fetch1 = [&](int unit) { const int bt = unit >> 8, b = (unit >> 1) & 127, chh = unit & 1; const int row = t >> 2, quarter = t & 3, pin = row >> 6, a = row & 63;
        const bf16* src = (pin ? ZS : ZC) + (size_t)(bt * SEQ + 128 * a + b) * 512 + chh * 256 + quarter * 64;
#pragma unroll
        for (int i = 0; i < 8; ++i) pv[i] = *(const u32x4*)(src + 8 * i); };
    if ((int)blockIdx.x < 2048) fetch1(blockIdx.x);
    for (int unit = blockIdx.x; unit < 2048; unit += C.G) {
        const int bt = unit >> 8, b = (unit >> 1) & 127, chh = unit & 1;
        __syncthreads();
        { const int row = t >> 2, quarter = t & 3;
#pragma unroll
          for (int i = 0; i < 8; ++i) *(LAS u32x4*)(L + row * 576 + quarter * 128 + i * 16) = pv[i]; }
        __syncthreads();
        if (unit + C.G < 2048) fetch1(unit + C.G);
#pragma unroll 1
        for (int nb = 0; nb < 4; ++nb) {
            const int c = 4 * nh + nb;
            f32x16 acc;
#pragma unroll
            for (int i = 0; i < 16; ++i) acc[i] = 0.f;
#pragma unroll
            for (int ks = 0; ks < 8; ++ks) {
                LAS unsigned char* pb = L + (16 * ks + 8 * hh + q4) * 576 + (32 * c + 16 * blk + 4 * p4) * 2;
                const bf16x8 bfr = gla::tr8(pb, pb + 4 * 576);
                acc = __builtin_amdgcn_mfma_f32_32x32x16_bf16(af[ks], bfr, acc, 0, 0, 0); }
#pragma unroll
            for (int gp = 0; gp < 2; ++gp)
#pragma unroll
                for (int i = 0; i < 4; ++i) { const int ap = 16 * mb + 8 * gp + 4 * hh + i; const float re = acc[8 * gp + i], im = acc[8 * gp + 4 + i];
                    const float ph = (float)((b * ap) & 8191) * (1.0f / 8192.0f); const float cs = __builtin_amdgcn_cosf(ph), sn = __builtin_amdgcn_sinf(ph);
                    const int so = ap * 528 + (32 * c + (lane & 31)) * 2;
                    *(LAS unsigned short*)(L + 73728 + so) = (unsigned short)f2bf(re * cs + im * sn);
                    *(LAS unsigned short*)(L + 73728 + 64 * 528 + so) = (unsigned short)f2bf(im * cs - re * sn); }
        }
        __syncthreads();
        { const int orow = t >> 2, quarter = t & 3, plane = orow >> 6, ap = orow & 63;
          bf16* dst = (plane ? YI : YR) + ((size_t)(bt * 64 + ap) * 128 + b) * 512 + chh * 256 + quarter * 64;
#pragma unroll
          for (int i = 0; i < 8; ++i) *(u32x4*)(dst + 8 * i) = *(const LAS u32x4*)(L + 73728 + orow * 528 + quarter * 128 + i * 16); }
    }
    __syncthreads();
}
__device__ __forceinline__ void p_fft2(const Ctx& C) {
    PH_IDS;
    LAS unsigned char* L = C.lds;
    const int t = tid, w = wave, mb = w & 3, nh = w >> 2, hh = lane >> 5;
    const bf16* F2 = (const bf16*)(C.ws + WS_F2);
    bf16x8 af[16];
#pragma unroll
    for (int ks = 0; ks < 16; ++ks) af[ks] = *(const bf16x8*)(F2 + (32 * mb + (lane & 31)) * 256 + 16 * ks + 8 * hh);
    const bf16* YR = (const bf16*)(C.ws + WS_YR); const bf16* YI = (const bf16*)(C.ws + WS_YI);
    unsigned char* A2 = (unsigned char*)(C.ws + WS_A2);
    const int blk = (lane >> 4) & 1, q4 = (lane & 15) >> 2, p4 = lane & 3;
    u32x4 pv[8];
    auto fetch2 = [&](int unit) { const int bt = unit >> 8, ap = (unit >> 2) & 63, cht = unit & 3; const int row = t >> 1, half = t & 1, pin = row >> 7, b = row & 127;
        const bf16* src = (pin ? YI : YR) + ((size_t)(bt * 64 + ap) * 128 + b) * 512 + cht * 128 + half * 64;
#pragma unroll
        for (int i = 0; i < 8; ++i) pv[i] = *(const u32x4*)(src + 8 * i); };
    if ((int)blockIdx.x < 2048) fetch2(blockIdx.x);
    for (int unit = blockIdx.x; unit < 2048; unit += C.G) {
        const int bt = unit >> 8, ap = (unit >> 2) & 63, cht = unit & 3;
        __syncthreads();
        { const int row = t >> 1, half = t & 1;
#pragma unroll
          for (int i = 0; i < 8; ++i) *(LAS u32x4*)(L + row * 320 + half * 128 + i * 16) = pv[i]; }
        __syncthreads();
        if (unit + C.G < 2048) fetch2(unit + C.G);
#pragma unroll 1
        for (int nb = 0; nb < 2; ++nb) {
            const int c = 2 * nh + nb;
            f32x16 acc;
#pragma unroll
            for (int i = 0; i < 16; ++i) acc[i] = 0.f;
#pragma unroll
            for (int ks = 0; ks < 16; ++ks) {
                LAS unsigned char* pb = L + (16 * ks + 8 * hh + q4) * 320 + (32 * c + 16 * blk + 4 * p4) * 2;
                const bf16x8 bfr = gla::tr8(pb, pb + 4 * 320);
                acc = __builtin_amdgcn_mfma_f32_32x32x16_bf16(af[ks], bfr, acc, 0, 0, 0); }
#pragma unroll
            for (int r = 0; r < 16; ++r) { const int bp = 32 * mb + (r & 3) + 8 * (r >> 2) + 4 * hh;
                if (F8_OUT0) *(LAS unsigned char*)(L + 81920 + bp * 144 + 32 * c + (lane & 31)) = (unsigned char)(pk4_fp8(acc[r], 0.f, 0.f, 0.f, 8.0f / 1024.0f) & 0xffu);
                else *(LAS unsigned short*)(L + 81920 + bp * 272 + (32 * c + (lane & 31)) * 2) = (unsigned short)f2bf(acc[r] * (1.0f / 1024.0f)); }
        }
        __syncthreads();
        { const int bp = t >> 2, quarter = t & 3; const size_t tok = (size_t)bt * SEQ + ap + 64 * bp;
          if (F8_OUT0) { unsigned char* dst = A2 + tok * 1536 + 1024 + cht * 128 + quarter * 32;
#pragma unroll
              for (int i = 0; i < 2; ++i) *(u32x4*)(dst + 16 * i) = *(const LAS u32x4*)(L + 81920 + bp * 144 + quarter * 32 + i * 16); }
          else { bf16* dst = (bf16*)A2 + tok * 1536 + 1024 + cht * 128 + quarter * 32;
#pragma unroll
              for (int i = 0; i < 4; ++i) *(u32x4*)(dst + 8 * i) = *(const LAS u32x4*)(L + 81920 + bp * 272 + quarter * 64 + i * 16); } }
    }
    __syncthreads();
}
__device__ __forceinline__ void p_gla_out(const Ctx& C) {
    PH_IDS;
    const int gw = blockIdx.x * 8 + wave, NGW = C.G * 8;
    const bf16* OF = (const bf16*)(C.ws + WS_OF); const bf16* OB = (const bf16*)(C.ws + WS_OB); const bf16* Rg = (const bf16*)(C.ws + WS_R);
    unsigned char* A2 = (unsigned char*)(C.ws + WS_A2);
    float gn[16];
#pragma unroll
    for (int i = 0; i < 16; ++i) gn[i] = C.a->in[IN_EVGNORM][16 * (lane & 15) + i];
    for (int r = gw; r < MTOK; r += NGW) {
        const u32x4 f0 = *(const u32x4*)(OF + (size_t)r * 1024 + 16 * lane), f1 = *(const u32x4*)(OF + (size_t)r * 1024 + 16 * lane + 8);
        const u32x4 b0 = *(const u32x4*)(OB + (size_t)r * 1024 + 16 * lane), b1 = *(const u32x4*)(OB + (size_t)r * 1024 + 16 * lane + 8);
        const u32x4 g0 = *(const u32x4*)(Rg + (size_t)r * 1024 + 16 * lane), g1 = *(const u32x4*)(Rg + (size_t)r * 1024 + 16 * lane + 8);
        float o[16], rr[16];
#pragma unroll
        for (int i = 0; i < 4; ++i) { const unsigned fa = f0[i], fb = f1[i], ba = b0[i], bb = b1[i], ga = g0[i], gb = g1[i];
            o[2 * i] = bf_lo(fa) + bf_lo(ba); o[2 * i + 1] = bf_hi(fa) + bf_hi(ba); o[8 + 2 * i] = bf_lo(fb) + bf_lo(bb); o[8 + 2 * i + 1] = bf_hi(fb) + bf_hi(bb);
            rr[2 * i] = bf_lo(ga); rr[2 * i + 1] = bf_hi(ga); rr[8 + 2 * i] = bf_lo(gb); rr[8 + 2 * i + 1] = bf_hi(gb); }
        float ss = 0.f;
#pragma unroll
        for (int i = 0; i < 16; ++i) ss += o[i] * o[i];
        ss += __shfl_xor(ss, 1); ss += __shfl_xor(ss, 2); ss += __shfl_xor(ss, 4); ss += __shfl_xor(ss, 8);
        const float rstd = rsqrtf(ss * (1.0f / 256.0f) + EPS);
        float y[16];
#pragma unroll
        for (int i = 0; i < 16; ++i) y[i] = o[i] * rstd * gn[i] * siluf_(rr[i]);
        if (F8_OUT0) *(u32x4*)(A2 + (size_t)r * 1536 + 16 * lane) = (u32x4){pk4_fp8(y[0], y[1], y[2], y[3], 8.f), pk4_fp8(y[4], y[5], y[6], y[7], 8.f), pk4_fp8(y[8], y[9], y[10], y[11], 8.f), pk4_fp8(y[12], y[13], y[14], y[15], 8.f)};
        else { bf16* a2 = (bf16*)A2 + (size_t)r * 1536 + 16 * lane;
            *(u32x4*)a2 = (u32x4){cvt_pk(y[0], y[1]), cvt_pk(y[2], y[3]), cvt_pk(y[4], y[5]), cvt_pk(y[6], y[7])}; *(u32x4*)(a2 + 8) = (u32x4){cvt_pk(y[8], y[9]), cvt_pk(y[10], y[11]), cvt_pk(y[12], y[13]), cvt_pk(y[14], y[15])}; }
    }
}

__device__ __forceinline__ void p_postmix(const Ctx& C, const int layer) {
    PH_IDS;
    LAS float* WR = (LAS float*)C.lds;
    LAS int* hist = (LAS int*)(C.lds + 131072);
    LAS float* Lg = (LAS float*)(C.lds + 131584 + wave * 2112);
    const float* rw = C.a->in[IN_RW] + (size_t)layer * 1024 * 32;
    __syncthreads();
    for (int it0 = 0; it0 < 64; it0 += 16) {
        float tmpw[16];
#pragma unroll
        for (int q = 0; q < 16; ++q) tmpw[q] = rw[tid + 512 * (it0 + q)];
#pragma unroll
        for (int q = 0; q < 16; ++q) { const int idx = tid + 512 * (it0 + q); const int c = idx >> 5, e = idx & 31; const int ln = (c & 255) >> 2, j = c >> 8, i = c & 3;
            WR[(((j * 4 + i) * 8 + (e >> 2)) * 64 + ln) * 4 + (e & 3)] = tmpw[q]; } }
    if (tid < 32) hist[tid] = 0;
    __syncthreads();
    const float* MOD = (const float*)(C.ws + WS_MOD) + (size_t)layer * 9 * 6144;
    const float* gpost = C.a->in[IN_NMPOST] + layer * 1024; const float* gffn = C.a->in[IN_NFPRE] + layer * 1024;
    const bf16* Y = (const bf16*)(C.ws + WS_Y);
    const float* xin = C.a->in[IN_X];
    bf16* XS = (bf16*)(C.ws + WS_XS);
    unsigned char* H2 = (unsigned char*)(C.ws + WS_H2);
    int* TK = (int*)(C.ws + WS_TOPK); float* GT = (float*)(C.ws + WS_GATE);
    const int rows_per_blk = MTOK / C.G, rows_per_wave = rows_per_blk / 8;
    const int r0 = blockIdx.x * rows_per_blk + wave * rows_per_wave;
    const int b = r0 >> 13;
    const float rbias = C.a->in[IN_RB][layer * 32 + ((lane >> 1) & 31)];
    float cA1[16], cA2[16], cB2[16];
#pragma unroll
    for (int j = 0; j < 4; ++j) { const int c = 4 * lane + 256 * j;
        const f32x4 gp = *(const f32x4*)(gpost + c), gm = *(const f32x4*)(MOD + (size_t)b * 6144 + 2048 + c);
        const f32x4 gf = *(const f32x4*)(gffn + c), sc = *(const f32x4*)(MOD + (size_t)b * 6144 + 4096 + c), sh = *(const f32x4*)(MOD + (size_t)b * 6144 + 3072 + c);
#pragma unroll
        for (int i = 0; i < 4; ++i) { cA1[4 * j + i] = gp[i] * gm[i]; cA2[4 * j + i] = gf[i] * (1.0f + sc[i]); cB2[4 * j + i] = sh[i]; } }
    auto ldx = [&](int r, int j) -> f32x4 {
        if (layer == 0) return *(const f32x4*)(xin + (size_t)r * 1024 + 4 * lane + 256 * j);
        const u32x2 v = *(const u32x2*)(XS + (size_t)r * 1024 + 4 * lane + 256 * j); return (f32x4){bf_lo(v.x), bf_hi(v.x), bf_lo(v.y), bf_hi(v.y)}; };
    u32x2 ny[4]; f32x4 nx[4];
#pragma unroll
    for (int j = 0; j < 4; ++j) { ny[j] = *(const u32x2*)(Y + (size_t)r0 * 1024 + 4 * lane + 256 * j); nx[j] = ldx(r0, j); }
    for (int r = r0; r < r0 + rows_per_wave; ++r) {
        float h[16];
        u32x2 cy[4]; f32x4 cx[4];
#pragma unroll
        for (int j = 0; j < 4; ++j) { cy[j] = ny[j]; cx[j] = nx[j]; }
        if (r + 1 < r0 + rows_per_wave) {
#pragma unroll
            for (int j = 0; j < 4; ++j) { ny[j] = *(const u32x2*)(Y + (size_t)(r + 1) * 1024 + 4 * lane + 256 * j); nx[j] = ldx(r + 1, j); } }
        { float ssy = 0.f; float yv[16];
#pragma unroll
          for (int j = 0; j < 4; ++j) { const u32x2 yy = cy[j];
              yv[4 * j] = bf_lo(yy.x); yv[4 * j + 1] = bf_hi(yy.x); yv[4 * j + 2] = bf_lo(yy.y); yv[4 * j + 3] = bf_hi(yy.y); }
#pragma unroll
          for (int i = 0; i < 16; ++i) ssy += yv[i] * yv[i];
          const float rstd = rsqrtf(wave_sum(ssy) * (1.0f / 1024.0f) + EPS);
          float ss1 = 0.f;
#pragma unroll
          for (int j = 0; j < 4; ++j) { const int c = 4 * lane + 256 * j;
              const f32x4 xv = cx[j];
              f32x4 o;
#pragma unroll
              for (int i = 0; i < 4; ++i) { o[i] = xv[i] + cA1[4 * j + i] * (yv[4 * j + i] * rstd); h[4 * j + i] = o[i]; ss1 += o[i] * o[i]; }
              { u32x2 xw; xw.x = cvt_pk(o[0], o[1]); xw.y = cvt_pk(o[2], o[3]); *(u32x2*)(XS + (size_t)r * 1024 + c) = xw; } }
          const float rstd1 = rsqrtf(wave_sum(ss1) * (1.0f / 1024.0f) + EPS);
#pragma unroll
          for (int j = 0; j < 4; ++j) { const int c = 4 * lane + 256 * j;
#pragma unroll
              for (int i = 0; i < 4; ++i) h[4 * j + i] = h[4 * j + i] * rstd1 * cA2[4 * j + i] + cB2[4 * j + i];
              int wv = 0;
              wv = __builtin_amdgcn_cvt_pk_fp8_f32(fminf(fmaxf(h[4 * j] * 8.0f, -440.f), 440.f), fminf(fmaxf(h[4 * j + 1] * 8.0f, -440.f), 440.f), wv, false);
              wv = __builtin_amdgcn_cvt_pk_fp8_f32(fminf(fmaxf(h[4 * j + 2] * 8.0f, -440.f), 440.f), fminf(fmaxf(h[4 * j + 3] * 8.0f, -440.f), 440.f), wv, true);
              *(int*)(H2 + (size_t)r * 1024 + c) = wv; } }
        float p[32];
#pragma unroll
        for (int e = 0; e < 32; ++e) p[e] = 0.f;
#pragma unroll
        for (int jj = 0; jj < 16; ++jj) {
#pragma unroll
            for (int eq = 0; eq < 8; ++eq) { const f32x4 wv = *(const LAS f32x4*)(WR + ((jj * 8 + eq) * 64 + lane) * 4);
#pragma unroll
                for (int i = 0; i < 4; ++i) p[4 * eq + i] += h[jj] * wv[i]; }
            asm volatile("" ::: "memory"); }
        float q16[16], q8[8], q4v[4], q2[2], q1;
        { const bool hi = (lane & 32) != 0;
#pragma unroll
          for (int k = 0; k < 16; ++k) { const float send = hi ? p[k] : p[16 + k], keep = hi ? p[16 + k] : p[k]; q16[k] = keep + __shfl_xor(send, 32); } }
        { const bool hi = (lane & 16) != 0;
#pragma unroll
          for (int k = 0; k < 8; ++k) { const float send = hi ? q16[k] : q16[8 + k], keep = hi ? q16[8 + k] : q16[k]; q8[k] = keep + __shfl_xor(send, 16); } }
        { const bool hi = (lane & 8) != 0;
#pragma unroll
          for (int k = 0; k < 4; ++k) { const float send = hi ? q8[k] : q8[4 + k], keep = hi ? q8[4 + k] : q8[k]; q4v[k] = keep + __shfl_xor(send, 8); } }
        { const bool hi = (lane & 4) != 0;
#pragma unroll
          for (int k = 0; k < 2; ++k) { const float send = hi ? q4v[k] : q4v[2 + k], keep = hi ? q4v[2 + k] : q4v[k]; q2[k] = keep + __shfl_xor(send, 4); } }
        { const bool hi = (lane & 2) != 0; const float send = hi ? q2[0] : q2[1], keep = hi ? q2[1] : q2[0]; q1 = keep + __shfl_xor(send, 2); }
        q1 += __shfl_xor(q1, 1);
        const int rl = (r - r0) & 15;
        if (!(lane & 1)) Lg[rl * 33 + (lane >> 1)] = q1 + rbias;
        if (rl == 15) {
            asm volatile("s_waitcnt lgkmcnt(0)" ::: "memory");
            if (lane < 16) {
                float v0 = -3.0e38f, v1 = -3.0e38f, v2 = -3.0e38f, v3 = -3.0e38f; int i0 = 0, i1 = 0, i2 = 0, i3 = 0;
#pragma unroll
                for (int e = 0; e < 32; ++e) { const float x = Lg[lane * 33 + e];
                    const bool c0 = x > v0, c1 = x > v1, c2 = x > v2, c3 = x > v3;
                    v3 = c3 ? (c2 ? v2 : x) : v3; i3 = c3 ? (c2 ? i2 : e) : i3;
                    v2 = c2 ? (c1 ? v1 : x) : v2; i2 = c2 ? (c1 ? i1 : e) : i2;
                    v1 = c1 ? (c0 ? v0 : x) : v1; i1 = c1 ? (c0 ? i0 : e) : i1;
                    v0 = c0 ? x : v0; i0 = c0 ? e : i0; }
                const float e1 = __expf(v1 - v0), e2 = __expf(v2 - v0), e3 = __expf(v3 - v0); const float inv = 1.0f / (1.0f + e1 + e2 + e3);
                const int rr = r - 15 + lane;
                *(int4*)(TK + (size_t)rr * 4) = make_int4(i0, i1, i2, i3); *(f32x4*)(GT + (size_t)rr * 4) = (f32x4){inv, e1 * inv, e2 * inv, e3 * inv};
                __hip_atomic_fetch_add(&hist[i0], 1, __ATOMIC_RELAXED, __HIP_MEMORY_SCOPE_WORKGROUP); __hip_atomic_fetch_add(&hist[i1], 1, __ATOMIC_RELAXED, __HIP_MEMORY_SCOPE_WORKGROUP);
                __hip_atomic_fetch_add(&hist[i2], 1, __ATOMIC_RELAXED, __HIP_MEMORY_SCOPE_WORKGROUP); __hip_atomic_fetch_add(&hist[i3], 1, __ATOMIC_RELAXED, __HIP_MEMORY_SCOPE_WORKGROUP);
            }
            asm volatile("s_waitcnt lgkmcnt(0)" ::: "memory");
        }
    }
    __syncthreads();
    if (tid < 32) ((int*)(C.ws + WS_CNTBLK))[blockIdx.x * 32 + tid] = hist[tid];
    __syncthreads();
}
__device__ __forceinline__ void p_assign(const Ctx& C) {
    PH_IDS;
    LAS int* red = (LAS int*)C.lds;
    LAS int* base = (LAS int*)(C.lds + 4096);
    LAS int* total = (LAS int*)(C.lds + 4224);
    LAS int* segrow = (LAS int*)(C.lds + 4352);
    LAS int* run = (LAS int*)(C.lds + 4608);
    const int* cnt = (const int*)(C.ws + WS_CNTBLK);
    const int b = blockIdx.x;
    __syncthreads();
    { const int e = tid & 31, part = tid >> 5; int slt = 0, sall = 0;
      int vv[16];
#pragma unroll
      for (int q = 0; q < 16; ++q) vv[q] = __hip_atomic_load(cnt + (part * 16 + q) * 32 + e, __ATOMIC_RELAXED, __HIP_MEMORY_SCOPE_AGENT);
#pragma unroll
      for (int q = 0; q < 16; ++q) { sall += vv[q]; if (part * 16 + q < b) slt += vv[q]; }
      red[part * 32 + e] = slt; red[512 + part * 32 + e] = sall; }
    __syncthreads();
    if (tid < 32) { int s0 = 0, s1 = 0;
#pragma unroll
        for (int q = 0; q < 16; ++q) { s0 += red[q * 32 + tid]; s1 += red[512 + q * 32 + tid]; }
        base[tid] = s0; total[tid] = s1; run[tid] = 0; }
    __syncthreads();
    if (tid == 0) { int acc = 0; for (int e = 0; e < 32; ++e) { segrow[e] = acc * 256; if (b == 0) ((int*)(C.ws + WS_MOEINFO))[e] = acc; acc += (total[e] + 255) >> 8; } segrow[32] = acc * 256; if (b == 0) ((int*)(C.ws + WS_MOEINFO))[32] = acc; }
    __syncthreads();
    int* SP = (int*)(C.ws + WS_SLOTPOS); int* ST = (int*)(C.ws + WS_SLOTTOK); const int* TK = (const int*)(C.ws + WS_TOPK);
    const int rows_per_blk = MTOK / C.G;
    LAS int* gc = (LAS int*)(C.lds + 5120);
    int ge[2], grk[2], grow[2];
#pragma unroll
    for (int q = 0; q < 2; ++q) {
        const int g = 2 * wave + q, sidx = g * 64 + lane; grow[q] = b * rows_per_blk + (sidx >> 2);
        ge[q] = TK[(size_t)grow[q] * 4 + (sidx & 3)];
        int rk = 0, myc = 0;
        for (int ee = 0; ee < 32; ++ee) { const unsigned long long m = __ballot(ge[q] == ee);
            if (ge[q] == ee) rk = __popcll(m & ((1ull << lane) - 1ull));
            if (lane == ee) myc = __popcll(m); }
        grk[q] = rk;
        if (lane < 32) gc[g * 32 + lane] = myc;
    }
    __syncthreads();
#pragma unroll
    for (int q = 0; q < 2; ++q) {
        const int g = 2 * wave + q, sidx = g * 64 + lane; int off = 0;
        for (int gp = 0; gp < g; ++gp) off += gc[gp * 32 + ge[q]];
        const int pos = segrow[ge[q]] + base[ge[q]] + off + grk[q];
        SP[(size_t)grow[q] * 4 + (sidx & 3)] = pos; ST[pos] = grow[q];
    }
    if (b < 32) { const int e = b, tot = total[e], first = segrow[e] + tot, last = segrow[e + 1];
        for (int p = first + tid; p < last; p += 512) ST[p] = 0; }
    __syncthreads();
}

__device__ __forceinline__ void p_combine(const Ctx& C, const int layer) {
    PH_IDS;
    const int gw = blockIdx.x * 8 + wave, NGW = C.G * 8;
    const int per = MTOK / NGW;
    const float* MOD = (const float*)(C.ws + WS_MOD) + (size_t)layer * 9 * 6144;
    const float* MODN = (const float*)(C.ws + WS_MOD) + (size_t)9 * 6144;
    const float* gpost = C.a->in[IN_NFPOST] + layer * 1024; const float* gpre1 = C.a->in[IN_NMPRE] + 1024;
    const unsigned char* YS = (const unsigned char*)(C.ws + WS_YSLOT); const int* SP = (const int*)(C.ws + WS_SLOTPOS); const float* GT = (const float*)(C.ws + WS_GATE);
    float* OUT = C.a->out; bf16* XS = (bf16*)(C.ws + WS_XS); unsigned char* HN = (unsigned char*)(C.ws + WS_HN);
    int curb = -1; float cA1[16], cA2[16], cB2[16]; const int vz = vzero();
    const int rbeg = gw * per, rend = gw * per + per;
    int4 npos = *(const int4*)(SP + (size_t)(rbeg + vz) * 4); f32x4 ngt = *(const f32x4*)(GT + (size_t)(rbeg + vz) * 4);
    unsigned nys[4][4]; u32x2 nxv[4]; f32x4 cgt = ngt;
    { const int pp[4] = {npos.x, npos.y, npos.z, npos.w};
#pragma unroll
      for (int k = 0; k < 4; ++k)
#pragma unroll
          for (int j = 0; j < 4; ++j) nys[k][j] = *(const unsigned*)(YS + (size_t)pp[k] * 1024 + 4 * lane + 256 * j);
#pragma unroll
      for (int j = 0; j < 4; ++j) nxv[j] = *(const u32x2*)(XS + (size_t)rbeg * 1024 + 4 * lane + 256 * j); }
    if (rbeg + 1 < rend) { npos = *(const int4*)(SP + (size_t)(rbeg + 1 + vz) * 4); ngt = *(const f32x4*)(GT + (size_t)(rbeg + 1 + vz) * 4); }
    for (int r = rbeg; r < rend; ++r) {
        const int b = r >> 13;
        if (b != curb) { curb = b;
#pragma unroll
            for (int j = 0; j < 4; ++j) { const int c = 4 * lane + 256 * j;
                const f32x4 gp = *(const f32x4*)(gpost + c), gf = *(const f32x4*)(MOD + (size_t)b * 6144 + 5120 + c);
                const f32x4 gg = *(const f32x4*)(gpre1 + c), sc = *(const f32x4*)(MODN + (size_t)b * 6144 + 1024 + c), sh = *(const f32x4*)(MODN + (size_t)b * 6144 + c);
#pragma unroll
                for (int i = 0; i < 4; ++i) { cA1[4 * j + i] = gp[i] * gf[i]; cA2[4 * j + i] = gg[i] * (1.0f + sc[i]); cB2[4 * j + i] = sh[i]; } } }
        unsigned ys[4][4]; u32x2 xc[4]; const f32x4 gt = cgt;
#pragma unroll
        for (int k = 0; k < 4; ++k)
#pragma unroll
            for (int j = 0; j < 4; ++j) ys[k][j] = nys[k][j];
#pragma unroll
        for (int j = 0; j < 4; ++j) xc[j] = nxv[j];
        if (r + 1 < rend) {
            const int pp[4] = {npos.x, npos.y, npos.z, npos.w}; cgt = ngt;
#pragma unroll
            for (int k = 0; k < 4; ++k)
#pragma unroll
                for (int j = 0; j < 4; ++j) nys[k][j] = *(const unsigned*)(YS + (size_t)pp[k] * 1024 + 4 * lane + 256 * j);
#pragma unroll
            for (int j = 0; j < 4; ++j) nxv[j] = *(const u32x2*)(XS + (size_t)(r + 1) * 1024 + 4 * lane + 256 * j);
            if (r + 2 < rend) { npos = *(const int4*)(SP + (size_t)(r + 2 + vz) * 4); ngt = *(const f32x4*)(GT + (size_t)(r + 2 + vz) * 4); } }
        float f[16];
#pragma unroll
        for (int i = 0; i < 16; ++i) f[i] = 0.f;
#pragma unroll
        for (int k = 0; k < 4; ++k) { const float gk = gt[k] * 0.0625f;
#pragma unroll
            for (int j = 0; j < 4; ++j) { const f32v2_t lo = __builtin_amdgcn_cvt_pk_f32_fp8((int)ys[k][j], false), hi = __builtin_amdgcn_cvt_pk_f32_fp8((int)ys[k][j], true);
                f[4 * j] += gk * lo[0]; f[4 * j + 1] += gk * lo[1]; f[4 * j + 2] += gk * hi[0]; f[4 * j + 3] += gk * hi[1]; } }
        float ss = 0.f;
#pragma unroll
        for (int i = 0; i < 16; ++i) ss += f[i] * f[i];
        const float rstd = rsqrtf(wave_sum(ss) * (1.0f / 1024.0f) + EPS);
        float x2[16]; float ss2 = 0.f;
#pragma unroll
        for (int j = 0; j < 4; ++j) { const int c = 4 * lane + 256 * j;
            const f32x4 xv = (f32x4){bf_lo(xc[j].x), bf_hi(xc[j].x), bf_lo(xc[j].y), bf_hi(xc[j].y)};
            f32x4 o;
#pragma unroll
            for (int i = 0; i < 4; ++i) { o[i] = xv[i] + cA1[4 * j + i] * (f[4 * j + i] * rstd); x2[4 * j + i] = o[i]; ss2 += o[i] * o[i]; }
            if (layer == 0) { u32x2 xw; xw.x = cvt_pk(o[0], o[1]); xw.y = cvt_pk(o[2], o[3]); *(u32x2*)(XS + (size_t)r * 1024 + c) = xw; }
            else *(f32x4*)(OUT + (size_t)r * 1024 + c) = o; }
        if (layer == 0) {
            const float rstd2 = rsqrtf(wave_sum(ss2) * (1.0f / 1024.0f) + EPS);
#pragma unroll
            for (int j = 0; j < 4; ++j) { const int c = 4 * lane + 256 * j;
                float hv[4];
#pragma unroll
                for (int i = 0; i < 4; ++i) hv[i] = x2[4 * j + i] * rstd2 * cA2[4 * j + i] + cB2[4 * j + i];
                if (F8_IN1) *(unsigned*)(HN + (size_t)r * 1024 + c) = pk4_fp8(hv[0], hv[1], hv[2], hv[3], 8.f);
                else *(u32x2*)((bf16*)HN + (size_t)r * 1024 + c) = (u32x2){cvt_pk(hv[0], hv[1]), cvt_pk(hv[2], hv[3])}; }
        }
    }
}

__device__ __forceinline__ void p_conv(const Ctx& C) {
    PH_IDS;
    LAS unsigned char* L = C.lds;
    constexpr int O_X = 0;
    constexpr int O_W = 63488;
    const int w = wave;
    const bf16* GLU = (const bf16*)(C.ws + WS_GLU); const bf16* ZC1 = (const bf16*)(C.ws + WS_ZC1); const bf16* GB = (const bf16*)(C.ws + WS_GB);
    unsigned char* A2 = (unsigned char*)(C.ws + WS_A2B);
    __syncthreads();
    { float tmpw[31];
#pragma unroll
      for (int q = 0; q < 31; ++q) tmpw[q] = C.a->in[IN_ODDW][tid + 512 * q];
#pragma unroll
      for (int q = 0; q < 31; ++q) { const int i = tid + 512 * q; const int tap = i >> 9, c = i & 511; const int ln = c >> 3, half = (c >> 2) & 1, qq = c & 3;
          *(LAS float*)(L + O_W + (((tap * 2 + half) * 64 + ln) * 4 + qq) * 4) = tmpw[q]; } }
    float cb[8], lg[8], lb[8], sw0[8], sw1[8], sw2[8];
#pragma unroll
    for (int i = 0; i < 8; ++i) { const int c = 8 * lane + i; cb[i] = C.a->in[IN_ODDWB][c]; lg[i] = C.a->in[IN_ODLNG][c]; lb[i] = C.a->in[IN_ODLNB][c];
        sw0[i] = C.a->in[IN_ODSCONV][c]; sw1[i] = C.a->in[IN_ODSCONV][512 + c]; sw2[i] = C.a->in[IN_ODSCONV][1024 + c]; }
    u32x4 px[8];
    auto fetchx = [&](int unit) { const int bt = unit >> 8, t0 = (unit & 255) * 32;
#pragma unroll
        for (int q = 0; q < 8; ++q) { const int i = tid + 512 * q; const int rr = i >> 6, cc = i & 63; const int tl = t0 - 15 + rr;
            px[q] = (u32x4){0u, 0u, 0u, 0u};
            if (i < 62 * 64 && tl >= 0 && tl < SEQ) px[q] = *(const u32x4*)(GLU + (size_t)(bt * SEQ + tl) * 512 + cc * 8); } };
    if ((int)blockIdx.x < 2048) fetchx(blockIdx.x);
    for (int unit = blockIdx.x; unit < 2048; unit += C.G) {
        const int bt = unit >> 8, t0 = (unit & 255) * 32;
        __syncthreads();
#pragma unroll
        for (int q = 0; q < 8; ++q) { const int i = tid + 512 * q; if (i < 62 * 64) *(LAS u32x4*)(L + O_X + (i >> 6) * 1024 + (i & 63) * 16) = px[q]; }
        __syncthreads();
        if (unit + C.G < 2048) fetchx(unit + C.G);
        u32x4 sz0[4], sz1[4], sz2[4], sgb[4];
#pragma unroll
        for (int o = 0; o < 4; ++o) { const int tl = t0 + 4 * w + o; const size_t tok = (size_t)bt * SEQ + tl;
            sz1[o] = *(const u32x4*)(ZC1 + tok * 512 + 8 * lane); sz0[o] = (u32x4){0u, 0u, 0u, 0u}; sz2[o] = (u32x4){0u, 0u, 0u, 0u};
            if (tl >= 64) sz0[o] = *(const u32x4*)(ZC1 + (tok - 64) * 512 + 8 * lane);
            if (tl + 64 < SEQ) sz2[o] = *(const u32x4*)(ZC1 + (tok + 64) * 512 + 8 * lane);
            sgb[o] = *(const u32x4*)(GB + tok * 512 + 8 * lane); }
        float acc[4][8];
#pragma unroll
        for (int o = 0; o < 4; ++o)
#pragma unroll
            for (int i = 0; i < 8; ++i) acc[o][i] = 0.f;
#pragma unroll 1
        for (int tap = 0; tap < 31; ++tap) {
            const f32x4 w0 = *(const LAS f32x4*)(L + O_W + ((tap * 2 + 0) * 64 + lane) * 16), w1 = *(const LAS f32x4*)(L + O_W + ((tap * 2 + 1) * 64 + lane) * 16);
#pragma unroll
            for (int o = 0; o < 4; ++o) {
                const u32x4 xr = *(const LAS u32x4*)(L + O_X + (4 * w + o + tap) * 1024 + lane * 16);
                acc[o][0] += bf_lo(xr[0]) * w0[0]; acc[o][1] += bf_hi(xr[0]) * w0[1]; acc[o][2] += bf_lo(xr[1]) * w0[2]; acc[o][3] += bf_hi(xr[1]) * w0[3];
                acc[o][4] += bf_lo(xr[2]) * w1[0]; acc[o][5] += bf_hi(xr[2]) * w1[1]; acc[o][6] += bf_lo(xr[3]) * w1[2]; acc[o][7] += bf_hi(xr[3]) * w1[3]; }
        }
#pragma unroll
        for (int o = 0; o < 4; ++o) {
            const int tl = t0 + 4 * w + o; const size_t tok = (size_t)bt * SEQ + tl;
            float v[8]; float s = 0.f;
#pragma unroll
            for (int i = 0; i < 8; ++i) { v[i] = acc[o][i] + cb[i]; s += v[i]; }
            const float mu = wave_sum(s) * (1.0f / 512.0f); float q = 0.f;
#pragma unroll
            for (int i = 0; i < 8; ++i) { v[i] -= mu; q += v[i] * v[i]; }
            const float rstd = rsqrtf(wave_sum(q) * (1.0f / 512.0f) + EPS);
            float y[8];
#pragma unroll
            for (int i = 0; i < 8; ++i) y[i] = siluf_(v[i] * rstd * lg[i] + lb[i]);
            if (F8_OUT1) *(u32x2*)(A2 + tok * 1024 + 8 * lane) = (u32x2){pk4_fp8(y[0], y[1], y[2], y[3], 4.f), pk4_fp8(y[4], y[5], y[6], y[7], 4.f)};
            else *(u32x4*)((bf16*)A2 + tok * 1024 + 8 * lane) = (u32x4){cvt_pk(y[0], y[1]), cvt_pk(y[2], y[3]), cvt_pk(y[4], y[5]), cvt_pk(y[6], y[7])};
            const u32x4 z1 = sz1[o], z0 = sz0[o], z2 = sz2[o], gb = sgb[o];
            float zz[8];
#pragma unroll
            for (int i = 0; i < 4; ++i) {
                zz[2 * i] = (sw0[2 * i] * bf_lo(z0[i]) + sw1[2 * i] * bf_lo(z1[i]) + sw2[2 * i] * bf_lo(z2[i])) * bf_lo(gb[i]);
                zz[2 * i + 1] = (sw0[2 * i + 1] * bf_hi(z0[i]) + sw1[2 * i + 1] * bf_hi(z1[i]) + sw2[2 * i + 1] * bf_hi(z2[i])) * bf_hi(gb[i]); }
            if (F8_OUT1) *(u32x2*)(A2 + tok * 1024 + 512 + 8 * lane) = (u32x2){pk4_fp8(zz[0], zz[1], zz[2], zz[3], 4.f), pk4_fp8(zz[4], zz[5], zz[6], zz[7], 4.f)};
            else *(u32x4*)((bf16*)A2 + tok * 1024 + 512 + 8 * lane) = (u32x4){cvt_pk(zz[0], zz[1]), cvt_pk(zz[2], zz[3]), cvt_pk(zz[4], zz[5]), cvt_pk(zz[6], zz[7])};
        }
    }
    __syncthreads();
}

constexpr int NPHASE = 19;
#ifndef RUN_HI
#define RUN_HI NPHASE
#endif
__global__ void __launch_bounds__(512, 2) fwd_kernel(Args args) {
    extern __shared__ __attribute__((aligned(16))) unsigned char lds_raw[];
    Ctx C; C.lds = (LAS unsigned char*)lds_raw;
    C.G = gridDim.x; C.a = &args; C.ws = args.ws;
    volatile LAS unsigned* MISC = (volatile LAS unsigned*)(C.lds + MISC_OFF);
    if (threadIdx.x < 16) MISC[threadIdx.x] = 0u;
    __syncthreads();
    const int lo = args.ph_lo, hi = args.ph_hi;
    const bool multi = (hi - lo) > 1;
    XcdBarrier bar; bar.bar = (unsigned*)(C.ws + WS_CTL) + 4096; bar.x = 0; bar.st = MISC;
    if (multi) bar = xcd_barrier_post((unsigned*)(C.ws + WS_CTL) + 4096, MISC);
#ifndef PH_MASK
#define PH_MASK 0x7FFFF
#endif
#define IN(k) (((PH_MASK >> (k)) & 1) && lo <= (k) && (k) < hi)
#ifndef DUP_MASK
#define DUP_MASK 0
#endif
#ifndef GLA_PROBE
#define GLA_PROBE 0
#endif
#ifndef PROBE_NOEPI
#define PROBE_NOEPI 0
#endif
#define DUPN(k) (((DUP_MASK >> (k)) & 1) ? 2 : 1)
#define SEAM(k) do { if (IN(k) && IN((k) + 1)) xcd_barrier(bar); } while (0)
    LAS unsigned char* ring = C.lds;
    const int cid = blockIdx.x;

    if (IN(0)) for (int rep_ = 0; rep_ < DUPN(0); ++rep_) { p0_adaln(C); p0_fourier_fold(C); p0_convert(C); } SEAM(0);
    if (IN(1)) for (int rep_ = 0; rep_ < DUPN(1); ++rep_) { p_norm0(C); } SEAM(1);
    if (IN(2)) for (int rep_ = 0; rep_ < DUPN(2); ++rep_) { gm::SchedIn0 S{(const char*)(C.ws + WS_HN), (const char*)(C.ws + WS_WIN0), C.G, cid}; gm::EpiIn0 E{C.ws}; gm::gemm_phase<F8_IN0 != 0>(ring, F8_IN0 ? 1024 : 2048, S, E, 0x7C7C7C7C, 0x7A7A7A7A); } SEAM(2);
    if (IN(3)) for (int rep_ = 0; rep_ < DUPN(3); ++rep_) { p_gla_prep(C); if (GLA_PROBE == 1) p_gla_prep(C); p_fft1(C); if (GLA_PROBE == 2) p_fft1(C); xcd_barrier(bar); p_gla(C); if (GLA_PROBE == 3) p_gla(C); if (GLA_PROBE == 4) p_gla(C, 1); } SEAM(3);
    if (IN(4)) for (int rep_ = 0; rep_ < DUPN(4); ++rep_) { p_fft2(C); p_gla_out(C); } SEAM(4);
    if (IN(5)) for (int rep_ = 0; rep_ < DUPN(5); ++rep_) { gm::SchedDense S{(const char*)(C.ws + WS_A2), (const char*)(C.ws + WS_WOUT0), F8_OUT0 ? 1536 : 3072, 256, 4, C.G, cid}; gm::EpiPlain E{(bf16*)(C.ws + WS_Y), 1024}; gm::gemm_phase<F8_OUT0 != 0>(ring, F8_OUT0 ? 1536 : 3072, S, E, 0x7C7C7C7C, 0x7A7A7A7A); } SEAM(5);
    if (IN(6)) for (int rep_ = 0; rep_ < DUPN(6); ++rep_) { p_postmix(C, 0); } SEAM(6);
    if (IN(7)) { p_assign(C); } SEAM(7);
    if (IN(8)) for (int rep_ = 0; rep_ < DUPN(8); ++rep_) { const int* tsp = (const int*)(C.ws + WS_MOEINFO); const int ln_ = otid() & 63; const int ts = __hip_atomic_load(tsp + (ln_ < 32 ? ln_ : 32), __ATOMIC_RELAXED, __HIP_MEMORY_SCOPE_AGENT);
        gm::SchedMoE S{(const char*)(C.ws + WS_H2), (const char*)(C.ws + WS_WGU), (const int*)(C.ws + WS_SLOTTOK), ts, __builtin_amdgcn_readlane(ts, 32), 8, C.G, cid, (size_t)2048 * 1024, true, args.in[IN_BGU]};
        gm::EpiGU E{(unsigned char*)(C.ws + WS_ACT), args.in[IN_BGU], PROBE_NOEPI ? rep_ : 0}; gm::gemm_phase<true>(ring, 1024, S, E, 0x7C7C7C7C, 0x7A7A7A7A); } SEAM(8);
    if (IN(9)) for (int rep_ = 0; rep_ < DUPN(9); ++rep_) { const int* tsp = (const int*)(C.ws + WS_MOEINFO); const int ln_ = otid() & 63; const int ts = __hip_atomic_load(tsp + (ln_ < 32 ? ln_ : 32), __ATOMIC_RELAXED, __HIP_MEMORY_SCOPE_AGENT);
        gm::SchedMoE S{(const char*)(C.ws + WS_ACT), (const char*)(C.ws + WS_WD), nullptr, ts, __builtin_amdgcn_readlane(ts, 32), 4, C.G, cid, (size_t)1024 * 1024, false, args.in[IN_BD]};
        gm::EpiDown E{(unsigned char*)(C.ws + WS_YSLOT), args.in[IN_BD]}; gm::gemm_phase<true>(ring, 1024, S, E, 0x7D7D7D7D, 0x7A7A7A7A); } SEAM(9);
    if (IN(10)) { p_combine(C, 0); } SEAM(10);
    if (IN(11)) for (int rep_ = 0; rep_ < DUPN(11); ++rep_) { gm::SchedDense S{(const char*)(C.ws + WS_HN), (const char*)(C.ws + WS_WIN1), F8_IN1 ? 1024 : 2048, 256, 10, C.G, cid}; gm::EpiIn1 E{C.ws}; gm::gemm_phase<F8_IN1 != 0>(ring, F8_IN1 ? 1024 : 2048, S, E, 0x7C7C7C7C, 0x7A7A7A7A); } SEAM(11);
    if (IN(12)) for (int rep_ = 0; rep_ < DUPN(12); ++rep_) { p_conv(C); } SEAM(12);
    if (IN(13)) for (int rep_ = 0; rep_ < DUPN(13); ++rep_) { gm::SchedDense S{(const char*)(C.ws + WS_A2B), (const char*)(C.ws + WS_WOUT1), F8_OUT1 ? 1024 : 2048, 256, 4, C.G, cid}; gm::EpiPlain E{(bf16*)(C.ws + WS_Y), 1024}; gm::gemm_phase<F8_OUT1 != 0>(ring, F8_OUT1 ? 1024 : 2048, S, E, 0x7D7D7D7D, 0x7A7A7A7A); } SEAM(13);
    if (IN(14)) { p_postmix(C, 1); } SEAM(14);
    if (IN(15)) { p_assign(C); } SEAM(15);
    if (IN(16)) for (int rep_ = 0; rep_ < DUPN(16); ++rep_) { const int* tsp = (const int*)(C.ws + WS_MOEINFO); const int ln_ = otid() & 63; const int ts = __hip_atomic_load(tsp + (ln_ < 32 ? ln_ : 32), __ATOMIC_RELAXED, __HIP_MEMORY_SCOPE_AGENT);
        gm::SchedMoE S{(const char*)(C.ws + WS_H2), (const char*)(C.ws + WS_WGU) + (size_t)32 * 2048 * 1024, (const int*)(C.ws + WS_SLOTTOK), ts, __builtin_amdgcn_readlane(ts, 32), 8, C.G, cid, (size_t)2048 * 1024, true, args.in[IN_BGU] + 32 * 2048};
        gm::EpiGU E{(unsigned char*)(C.ws + WS_ACT), args.in[IN_BGU] + 32 * 2048, 0}; gm::gemm_phase<true>(ring, 1024, S, E, 0x7C7C7C7C, 0x7A7A7A7A); } SEAM(16);
    if (IN(17)) for (int rep_ = 0; rep_ < DUPN(17); ++rep_) { const int* tsp = (const int*)(C.ws + WS_MOEINFO); const int ln_ = otid() & 63; const int ts = __hip_atomic_load(tsp + (ln_ < 32 ? ln_ : 32), __ATOMIC_RELAXED, __HIP_MEMORY_SCOPE_AGENT);
        gm::SchedMoE S{(const char*)(C.ws + WS_ACT), (const char*)(C.ws + WS_WD) + (size_t)32 * 1024 * 1024, nullptr, ts, __builtin_amdgcn_readlane(ts, 32), 4, C.G, cid, (size_t)1024 * 1024, false, args.in[IN_BD] + 32 * 1024};
        gm::EpiDown E{(unsigned char*)(C.ws + WS_YSLOT), args.in[IN_BD] + 32 * 1024}; gm::gemm_phase<true>(ring, 1024, S, E, 0x7D7D7D7D, 0x7A7A7A7A); } SEAM(17);
    if (IN(18)) { p_combine(C, 1); }
#ifdef DBG_COPY_OFF
    if (lo == 99) { const bf16* src = (const bf16*)(C.ws + (size_t)DBG_COPY_OFF); float* dst = args.out;
        for (size_t i = (size_t)blockIdx.x * 512 + threadIdx.x; i < (size_t)MTOK * 1024; i += (size_t)gridDim.x * 512) dst[i] = bf_lo((unsigned)src[i]); }
#endif
#undef IN
#undef SEAM
}

extern "C" void kernel_launch(void* const* d_in, const int* in_sizes, int n_in, void* d_out, int out_size, void* d_ws, size_t ws_size, hipStream_t stream) {
    static int grid = 0;
    if (grid == 0) {
        if (n_in != 28 || out_size != MTOK * D || ws_size < WS_END) { fprintf(stderr, "kernel_launch: unexpected problem (n_in %d out %d ws %zu need %zu)\n", n_in, out_size, ws_size, (size_t)WS_END); grid = -1; return; }
        int dev = 0, cus = 0, per_cu = 0;
        (void)hipGetDevice(&dev); (void)hipDeviceGetAttribute(&cus, hipDeviceAttributeMultiprocessorCount, dev);
        if (hipFuncSetAttribute((const void*)fwd_kernel, hipFuncAttributeMaxDynamicSharedMemorySize, LDS_BYTES) != hipSuccess) { fprintf(stderr, "kernel_launch: hipFuncSetAttribute failed\n"); grid = -1; return; }
        (void)hipOccupancyMaxActiveBlocksPerMultiprocessor(&per_cu, (const void*)fwd_kernel, 512, LDS_BYTES);
        (void)hipGetLastError();
        grid = cus;
        if (grid != 256 || per_cu < 1) { fprintf(stderr, "kernel_launch: needs a 256-CU device with one resident workgroup per CU (cus %d, per_cu %d)\n", cus, per_cu); grid = -1; return; }
    }
    if (grid < 0) return;
    (void)hipMemsetAsync((char*)d_ws + WS_CTL, 0, CTL_ZERO_BYTES, stream);
    Args a{};
    for (int i = 0; i < 28; ++i) a.in[i] = (const float*)d_in[i];
    a.out = (float*)d_out; a.ws = (unsigned char*)d_ws;
#if N_LAUNCH_MODE == 1
    a.ph_lo = 0; a.ph_hi = NPHASE;
    hipLaunchKernelGGL(fwd_kernel, dim3(grid), dim3(512), LDS_BYTES, stream, a);
#else
    for (int p = 0; p < RUN_HI; ++p) { a.ph_lo = p; a.ph_hi = p + 1; hipLaunchKernelGGL(fwd_kernel, dim3(grid), dim3(512), LDS_BYTES, stream, a); }
#ifdef DBG_COPY_OFF
    a.ph_lo = 99; a.ph_hi = 100; hipLaunchKernelGGL(fwd_kernel, dim3(grid), dim3(512), LDS_BYTES, stream, a);
#endif
#endif
}
```

```cpp
#include <hip/hip_runtime.h>
#include <cstdio>
#include <cstdint>

#ifndef N_LAUNCH_MODE
#define N_LAUNCH_MODE 1
#endif

#ifndef F8_IN0
#define F8_IN0 0
#endif
#ifndef F8_OUT0
#define F8_OUT0 0
#endif
#ifndef F8_IN1
#define F8_IN1 1
#endif
#ifndef F8_OUT1
#define F8_OUT1 1
#endif
#define LAS __attribute__((address_space(3)))
typedef unsigned short bf16;
typedef short bf16x8 __attribute__((ext_vector_type(8)));
typedef short s16x4 __attribute__((ext_vector_type(4)));
typedef float f32x4 __attribute__((ext_vector_type(4)));
typedef float f32x16 __attribute__((ext_vector_type(16)));
typedef unsigned u32x4 __attribute__((ext_vector_type(4)));
typedef unsigned u32x2 __attribute__((ext_vector_type(2)));

constexpr int D = 1024, NB = 8, SEQ = 8192, CTXL = 256;
constexpr int MTOK = NB * SEQ;
constexpr int MCTX = NB * CTXL;
constexpr int MALL = MTOK + MCTX;
constexpr int NE = 32, TOPK = 4;
constexpr int NSLOT_PAD = MTOK * TOPK + NE * 256;
constexpr int N_IN0 = 4352;
constexpr int N_IN1 = 2560;
constexpr float EPS = 1e-6f;

constexpr size_t MiB = 1u << 20;
constexpr size_t WS_CTL = 0, CTL_ZERO_BYTES = 65536;
constexpr size_t WS_MOD = 1 * MiB;
constexpr size_t WS_F1 = 2 * MiB;
constexpr size_t WS_F2 = 2 * MiB + 65536;
constexpr size_t WS_CNTBLK = 3 * MiB;
constexpr size_t WS_MOEINFO = 3 * MiB + 65536;
constexpr size_t WS_TOPK = 4 * MiB;
constexpr size_t WS_GATE = 5 * MiB;
constexpr size_t WS_SLOTPOS = 6 * MiB;
constexpr size_t WS_SLOTTOK = 7 * MiB;
constexpr size_t WS_WIN0 = 10 * MiB;
constexpr size_t WS_WOUT0 = 19 * MiB;
constexpr size_t WS_WIN1 = 22 * MiB;
constexpr size_t WS_WOUT1 = 27 * MiB;
constexpr size_t WS_WGU = 32 * MiB;
constexpr size_t WS_WD = 288 * MiB;
constexpr size_t WS_HN = 416 * MiB;
constexpr size_t WS_B = 548 * MiB;
constexpr size_t WS_ACT = WS_B;
constexpr size_t WS_YSLOT = WS_B + 528 * MiB;
constexpr size_t WS_Q = WS_B, WS_K = WS_B + 64 * MiB, WS_V = WS_B + 130 * MiB, WS_R = WS_B + 262 * MiB;
constexpr size_t WS_ZC = WS_B + 390 * MiB, WS_ZS = WS_B + 454 * MiB, WS_LR = WS_B + 518 * MiB;
constexpr size_t WS_OF = WS_B + 528 * MiB, WS_OB = WS_B + 656 * MiB, WS_YR = WS_B + 784 * MiB, WS_YI = WS_B + 848 * MiB;
constexpr size_t WS_A2 = WS_B;
constexpr size_t WS_Y = WS_B + 528 * MiB;
constexpr size_t WS_H2 = WS_B + 656 * MiB;
constexpr size_t WS_GLU = WS_B, WS_ZC1 = WS_B + 64 * MiB, WS_GB = WS_B + 128 * MiB, WS_A2B = WS_B + 192 * MiB;
constexpr size_t WS_XS = WS_B + 1056 * MiB;
constexpr size_t WS_GQP = WS_B + 1056 * MiB;
constexpr size_t WS_GKPP = WS_GQP + 132 * MiB;
constexpr size_t WS_GSC = WS_GKPP + 132 * MiB;
constexpr size_t WS_GEL = WS_GSC + 66 * MiB;
constexpr size_t WS_END = WS_GEL + 6 * MiB;

constexpr int LDS_BYTES = 155648;
constexpr int MISC_OFF = LDS_BYTES - 256;

__device__ __forceinline__ float bf_lo(unsigned u) { return __uint_as_float(u << 16); }
__device__ __forceinline__ float bf_hi(unsigned u) { return __uint_as_float(u & 0xffff0000u); }
typedef __bf16 bf16v2_t __attribute__((ext_vector_type(2)));
typedef float f32v2_t __attribute__((ext_vector_type(2)));
__device__ __forceinline__ unsigned cvt_pk(float lo, float hi) { const f32v2_t v = {lo, hi}; const bf16v2_t r = __builtin_convertvector(v, bf16v2_t); return __builtin_bit_cast(unsigned, r); }
__device__ __forceinline__ unsigned f2bf(float f) { unsigned u = __float_as_uint(f); return (u + 0x7fffu + ((u >> 16) & 1u)) >> 16; }
__device__ __forceinline__ float swap32_sum(float a, float b) {
    const auto r = __builtin_amdgcn_permlane32_swap(__builtin_bit_cast(unsigned, a), __builtin_bit_cast(unsigned, b), false, false);
    unsigned x = r[0], y = r[1]; asm volatile("" : "+v"(x), "+v"(y));
    return __builtin_bit_cast(float, x) + __builtin_bit_cast(float, y);
}
__device__ __forceinline__ float swap16_sum(float a, float b) {
    const auto r = __builtin_amdgcn_permlane16_swap(__builtin_bit_cast(unsigned, a), __builtin_bit_cast(unsigned, b), false, false);
    unsigned x = r[0], y = r[1]; asm volatile("" : "+v"(x), "+v"(y));
    return __builtin_bit_cast(float, x) + __builtin_bit_cast(float, y);
}
__device__ __forceinline__ float row16_sum(float v) {
    v += __builtin_bit_cast(float, __builtin_amdgcn_update_dpp(0, __builtin_bit_cast(int, v), 0xB1, 0xF, 0xF, true));
    v += __builtin_bit_cast(float, __builtin_amdgcn_update_dpp(0, __builtin_bit_cast(int, v), 0x4E, 0xF, 0xF, true));
    v += __builtin_bit_cast(float, __builtin_amdgcn_update_dpp(0, __builtin_bit_cast(int, v), 0x141, 0xF, 0xF, true));
    v += __builtin_bit_cast(float, __builtin_amdgcn_update_dpp(0, __builtin_bit_cast(int, v), 0x140, 0xF, 0xF, true));
    return v;
}
__device__ __forceinline__ float wave_sum(float v) {
    v = row16_sum(v);
    const int iv = __builtin_bit_cast(int, v);
    const float a = __builtin_bit_cast(float, __builtin_amdgcn_readlane(iv, 0)), b = __builtin_bit_cast(float, __builtin_amdgcn_readlane(iv, 16));
    const float c = __builtin_bit_cast(float, __builtin_amdgcn_readlane(iv, 32)), d = __builtin_bit_cast(float, __builtin_amdgcn_readlane(iv, 48));
    return (a + b) + (c + d);
}
__device__ __forceinline__ unsigned pk4_fp8(float a, float b, float c, float d, float sc) {
    int w = 0;
    w = __builtin_amdgcn_cvt_pk_fp8_f32(__builtin_amdgcn_fmed3f(a * sc, -440.f, 440.f), __builtin_amdgcn_fmed3f(b * sc, -440.f, 440.f), w, false);
    w = __builtin_amdgcn_cvt_pk_fp8_f32(__builtin_amdgcn_fmed3f(c * sc, -440.f, 440.f), __builtin_amdgcn_fmed3f(d * sc, -440.f, 440.f), w, true);
    return (unsigned)w;
}
__device__ __forceinline__ float sigmoidf_(float x) { return __builtin_amdgcn_rcpf(1.0f + __builtin_amdgcn_exp2f(x * -1.4426950408889634f)); }
__device__ __forceinline__ float siluf_(float x) { return x * sigmoidf_(x); }

#define XB_TMO      128
#define XB_XCNT(j)  (256  + 64 * (j))
#define XB_XSUB(j)  (1280 + 64 * (j))
#define XB_XGEN(j)  (2304 + 64 * (j))
#define XB_TOP      3328
#define XB_TOPGEN   3392
#define XCD_BAR_WORDS 3456
#define XB_SPIN_CAP (1u << 18)
__device__ __forceinline__ unsigned xb_ld(unsigned* p)              { return __hip_atomic_load(p, __ATOMIC_RELAXED, __HIP_MEMORY_SCOPE_AGENT); }
__device__ __forceinline__ unsigned xb_add(unsigned* p, unsigned v) { return __hip_atomic_fetch_add(p, v, __ATOMIC_RELAXED, __HIP_MEMORY_SCOPE_AGENT); }
__device__ __forceinline__ unsigned xb_xcc_id() { return (unsigned)__builtin_amdgcn_s_getreg((3 << 11) | 20) & 0xFu; }
#define XB_SPIN(cond, bar) do { unsigned _sp = 0; while (cond) { __builtin_amdgcn_s_sleep(1); \
    if ((++_sp & 255u) == 0u) { if (xb_ld(&(bar)[XB_TMO])) break; if (_sp > XB_SPIN_CAP) { atomicAdd(&(bar)[XB_TMO], 1u); break; } } } } while (0)
struct XcdBarrier { unsigned* bar; unsigned x; volatile LAS unsigned* st; };
__device__ __forceinline__ XcdBarrier xcd_barrier_post(unsigned* bar, volatile LAS unsigned* st) {
    XcdBarrier b; b.bar = bar; b.x = xb_xcc_id(); b.st = st;
    if (threadIdx.x == 0) (void)xb_add(&bar[XB_XCNT(b.x)], 1u);
    return b;
}
__device__ __forceinline__ void xcd_barrier_complete(unsigned* bar, unsigned x, unsigned& nloc, unsigned& nx) {
    const unsigned G = gridDim.x * gridDim.y * gridDim.z;
    unsigned sum, cnt, mine, sp = 0u;
    for (;;) {
        sum = 0u; cnt = 0u; mine = 0u;
#pragma unroll
        for (unsigned j = 0; j < 16; ++j) { const unsigned c = xb_ld(&bar[XB_XCNT(j)]); sum += c; cnt += (c > 0u) ? 1u : 0u; mine = (j == x) ? c : mine; }
        if (sum == G) break;
        __builtin_amdgcn_s_sleep(1);
        if ((++sp & 255u) == 0u) { if (xb_ld(&bar[XB_TMO])) break; if (sp > XB_SPIN_CAP) { atomicAdd(&bar[XB_TMO], 1u); break; } }
    }
    nloc = mine > 0u ? mine : 1u; nx = cnt > 0u ? cnt : 1u;
}
__device__ __forceinline__ void xcd_barrier(const XcdBarrier& b) {
    asm volatile("s_waitcnt vmcnt(0)" ::: "memory");
    __syncthreads();
    if (threadIdx.x == 0) {
        unsigned* bar = b.bar;
        __builtin_amdgcn_s_waitcnt(0);
        unsigned nloc = b.st[0], nx = b.st[1];
        if (nloc == 0u) { xcd_barrier_complete(bar, b.x, nloc, nx); b.st[0] = nloc; b.st[1] = nx; }
        const unsigned old = xb_add(&bar[XB_XSUB(b.x)], 1u);
        const unsigned gen = old / nloc;
        if (old + 1u == (gen + 1u) * nloc) {
            __builtin_amdgcn_fence(__ATOMIC_RELEASE, "agent");
            asm volatile("s_waitcnt vmcnt(0)" ::: "memory");
            const unsigned og = xb_add(&bar[XB_TOP], 1u);
            const unsigned tg = og / nx;
            if (og + 1u == (tg + 1u) * nx) xb_add(&bar[XB_TOPGEN], 1u);
            else XB_SPIN(xb_ld(&bar[XB_TOPGEN]) == tg, bar);
            __builtin_amdgcn_fence(__ATOMIC_ACQUIRE, "agent");
            xb_add(&bar[XB_XGEN(b.x)], 1u);
            asm volatile("s_waitcnt vmcnt(0)" ::: "memory");
        } else {
            XB_SPIN(xb_ld(&bar[XB_XGEN(b.x)]) == gen, bar);
            __builtin_amdgcn_fence(__ATOMIC_ACQUIRE, "agent");
            asm volatile("s_waitcnt vmcnt(0)" ::: "memory");
        }
    }
    __syncthreads();
}

struct Args {
    const float* in[28];
    float* out;
    unsigned char* ws;
    int ph_lo, ph_hi;
};
struct Ctx {
    LAS unsigned char* lds;
    int G;
    const Args* a;
    unsigned char* ws;
};
__device__ __forceinline__ int otid() { int t = (int)threadIdx.x; asm volatile("" : "+v"(t)); return t; }
__device__ __forceinline__ int vzero() { int z = 0; asm volatile("" : "+v"(z)); return z; }
#define PH_IDS const int tid = otid(), lane = tid & 63, wave = __builtin_amdgcn_readfirstlane(tid >> 6); (void)tid; (void)lane; (void)wave
#define IN_X 0
#define IN_C 1
#define IN_CTX 2
#define IN_CCTX 3
#define IN_MODW 4
#define IN_MODB 5
#define IN_NMPRE 6
#define IN_NMPOST 7
#define IN_NFPRE 8
#define IN_NFPOST 9
#define IN_EVWIN 10
#define IN_EVGKUP 11
#define IN_EVGKB 12
#define IN_EVGNORM 13
#define IN_EVWOUT 14
#define IN_ODWIN 15
#define IN_ODDW 16
#define IN_ODDWB 17
#define IN_ODLNG 18
#define IN_ODLNB 19
#define IN_ODSCONV 20
#define IN_ODWOUT 21
#define IN_RW 22
#define IN_RB 23
#define IN_WGU 24
#define IN_BGU 25
#define IN_WD 26
#define IN_BD 27

namespace gm {
constexpr int BM = 256, BK = 64, HALF = 128, HTB = HALF * BK * 2, STAGE_BYTES = 8 * HTB, NXCD = 8, WGM = 8;
constexpr int XT_OFF = 131072;
constexpr int XB_OFF = XT_OFF + 16384;
__device__ __forceinline__ int lds_byte(int r, int c) { const int st = (r >> 4) * 2 + (c >> 5), rr = r & 15, cc = c & 31, ob = rr * 64 + cc * 2; return st * 1024 + (ob ^ (((ob >> 9) & 1) << 5)); }
__device__ __forceinline__ void stage_rc(int b, int& R, int& C) { const int st = b / 1024, sb = b % 1024, swz = sb ^ (((sb >> 9) & 1) << 5); R = (st >> 1) * 16 + swz / 64; C = (st & 1) * 32 + (swz % 64) / 2; }
__device__ __forceinline__ int perm32(int rho) { const int n = rho >> 4, i = rho & 15; return 8 * (i >> 2) + 4 * n + (i & 3); }
struct Unit { int pm, pn, e; };

__device__ __forceinline__ void dense_map(int L, int nM, int nN, int& pm, int& pn) {
    const int nwg = nM * nN; int wgid = L;
    { const int q = nwg / NXCD, r = nwg % NXCD, xcd = wgid % NXCD, off = wgid / NXCD; wgid = (xcd < r ? xcd * (q + 1) : r * (q + 1) + (xcd - r) * q) + off; }
    const int nig = WGM * nN, gid = wgid / nig, fm = gid * WGM, gsz = (nM - fm) < WGM ? (nM - fm) : WGM;
    pm = fm + ((wgid % nig) % gsz); pn = (wgid % nig) / gsz;
}

typedef int i32x8 __attribute__((ext_vector_type(8)));
typedef int i32x4_ __attribute__((ext_vector_type(4)));
template <bool F8, class Epi, class Sched>
__device__ __forceinline__ void gemm_phase(LAS unsigned char* lds, const int RP, const Sched& S, const Epi& E, const int SCA = 0x7F7F7F7F, const int SCB = 0x7F7F7F7F) {
    const int tid = otid(), wid = __builtin_amdgcn_readfirstlane(tid >> 6), lane = tid & 63, wr = wid >> 2, wc = wid & 3, fr = lane & 15, fq = lane >> 4;
    const int nt = RP / 128;
    unsigned voffB[2];
#pragma unroll
    for (int i = 0; i < 2; ++i) { int R, C; stage_rc(tid * 16 + i * 8192, R, C); const int Rb = (R & ~31) + perm32(R & 31); voffB[i] = (unsigned)(Rb * RP + C * 2); }
    const size_t kstep = (size_t)128;
    const size_t hstepB = (size_t)HALF * RP;
    const unsigned ldsw = (unsigned)wid * 1024u;
    const int aoff = F8 ? lds_byte(wr * 64 + fr, (fq >> 1) * 32 + (fq & 1) * 16) : lds_byte(wr * 64 + fr, fq * 8);
    const int boff = F8 ? lds_byte(wc * 32 + fr, (fq >> 1) * 32 + (fq & 1) * 16) : lds_byte(wc * 32 + fr, fq * 8);
    constexpr int KOFF = F8 ? 16 : 1024;
#define G_SA(b, h) (((b) * 2 + (h)) * HTB)
#define G_SB(b, h) ((4 + (b) * 2 + (h)) * HTB)
#define G_STAGEB(bufoff, gbase) do { _Pragma("unroll") for (int _i = 0; _i < 2; ++_i) \
        __builtin_amdgcn_global_load_lds((const unsigned*)((const char*)(gbase) + voffB[_i]), (LAS unsigned*)(lds + (bufoff) + ldsw + _i * 8192), 16, 0, 0); } while (0)
#define G_STAGEA(bufoff, offs, h, kb) do { _Pragma("unroll") for (int _i = 0; _i < 2; ++_i) \
        __builtin_amdgcn_global_load_lds((const unsigned*)(S.abase() + (size_t)(offs)[h][_i] + (kb)), (LAS unsigned*)(lds + (bufoff) + ldsw + _i * 8192), 16, 0, 0); } while (0)
#define G_LDA(dst, b, h) do { _Pragma("unroll") for (int m = 0; m < 4; ++m) _Pragma("unroll") for (int k = 0; k < 2; ++k) dst[m][k] = *(const LAS bf16x8*)(lds + G_SA(b, h) + aoff + m * 2048 + k * KOFF); } while (0)
#define G_LDB(dst, b, h) do { _Pragma("unroll") for (int n = 0; n < 2; ++n) _Pragma("unroll") for (int k = 0; k < 2; ++k) dst[n][k] = *(const LAS bf16x8*)(lds + G_SB(b, h) + boff + n * 2048 + k * KOFF); } while (0)
#define G_CAT8(x) __builtin_shufflevector(__builtin_bit_cast(i32x4_, (x)[0]), __builtin_bit_cast(i32x4_, (x)[1]), 0, 1, 2, 3, 4, 5, 6, 7)
#define G_MMA(ai, bj, At, Bt) do { __builtin_amdgcn_s_setprio(1); \
        if constexpr (F8) { _Pragma("unroll") for (int m = 0; m < 4; ++m) _Pragma("unroll") for (int n = 0; n < 2; ++n) \
            acc[ai][bj][m][n] = __builtin_amdgcn_mfma_scale_f32_16x16x128_f8f6f4(G_CAT8(Bt[n]), G_CAT8(At[m]), acc[ai][bj][m][n], 0, 0, 0, SCB, 0, SCA); } \
        else { _Pragma("unroll") for (int m = 0; m < 4; ++m) _Pragma("unroll") for (int n = 0; n < 2; ++n) _Pragma("unroll") for (int k = 0; k < 2; ++k) \
            acc[ai][bj][m][n] = __builtin_amdgcn_mfma_f32_16x16x32_bf16(Bt[n][k], At[m][k], acc[ai][bj][m][n], 0, 0, 0); } \
        __builtin_amdgcn_s_setprio(0); } while (0)
#define G_WAIT_V(n) asm volatile("s_waitcnt vmcnt(" #n ")" ::: "memory")
#define G_WAIT_L(n) asm volatile("s_waitcnt lgkmcnt(" #n ")" ::: "memory")
#define G_BAR __builtin_amdgcn_s_barrier()
#define G_SCHED __builtin_amdgcn_sched_barrier(0)
    Unit cur, nxt; int ui = 0;
    if (!S.next(0, cur)) return;
    f32x4 acc[2][2][4][2];
#pragma unroll
    for (int a = 0; a < 2; ++a)
#pragma unroll
        for (int b = 0; b < 2; ++b)
#pragma unroll
            for (int m = 0; m < 4; ++m)
#pragma unroll
                for (int n = 0; n < 2; ++n) acc[a][b][m][n] = (f32x4){0.f, 0.f, 0.f, 0.f};
    bf16x8 At[4][2], B0[2][2], B1[2][2];
    unsigned cAo[2][2];
    S.a_off(cur, cAo);
    const char* cB = S.b_ptr(cur);
    S.prefetch_bias(cur, lds, 0, wid, lane, wc);
    G_STAGEB(G_SB(0, 0), cB); G_STAGEA(G_SA(0, 0), cAo, 0, 0); G_STAGEB(G_SB(0, 1), cB + hstepB); G_STAGEA(G_SA(0, 1), cAo, 1, 0);
    if (wr == 1) G_BAR;
    G_WAIT_V(4); G_BAR;
    G_STAGEB(G_SB(1, 0), cB + kstep); G_STAGEA(G_SA(1, 0), cAo, 0, kstep); G_STAGEB(G_SB(1, 1), cB + hstepB + kstep);
    G_WAIT_V(6); G_BAR;
    for (;;) {
        const bool has_next = S.next(ui + 1, nxt);
        const char* nB = cB;
        if (has_next) { S.prefetch_rows(nxt, lds, (ui + 1) & 1, wid, lane); S.prefetch_bias(nxt, lds, (ui + 1) & 1, wid, lane, wc); nB = S.b_ptr(nxt); }
        for (int t = 0; t < nt; t += 2) {
            const bool last = (t == nt - 2);
            const size_t k1 = (size_t)(t + 1) * kstep;
            G_LDB(B0, 0, 0); G_SCHED; G_LDA(At, 0, 0); G_STAGEA(G_SA(1, 1), cAo, 1, k1);
            if (last) { if (has_next) S.a_off_lds(nxt, lds, (ui + 1) & 1, wid, lane, cAo); cB = nB; }
            const size_t k2 = last ? 0 : (size_t)(t + 2) * kstep;
            const size_t k3 = k2 + kstep;
            const char* b2 = cB + k2; const char* b3 = b2 + kstep;
            G_WAIT_L(8); G_BAR; G_WAIT_L(0); G_MMA(0, 0, At, B0); G_BAR; G_SCHED;
            G_LDB(B1, 0, 1); G_STAGEB(G_SB(0, 0), b2);
            G_BAR; G_WAIT_L(0); G_MMA(0, 1, At, B1); G_BAR;
            G_LDA(At, 0, 1); G_STAGEA(G_SA(0, 0), cAo, 0, k2);
            G_BAR; G_WAIT_L(0); G_MMA(1, 0, At, B0); G_BAR; G_SCHED;
            G_STAGEB(G_SB(0, 1), b2 + hstepB);
            G_WAIT_V(6); G_BAR; G_MMA(1, 1, At, B1); G_BAR;
            G_LDB(B0, 1, 0); G_SCHED; G_LDA(At, 1, 0); G_STAGEA(G_SA(0, 1), cAo, 1, k2);
            G_WAIT_L(8); G_BAR; G_WAIT_L(0); G_MMA(0, 0, At, B0); G_BAR; G_SCHED;
            G_LDB(B1, 1, 1); G_STAGEB(G_SB(1, 0), b3);
            G_BAR; G_WAIT_L(0); G_MMA(0, 1, At, B1); G_BAR;
            G_LDA(At, 1, 1); G_STAGEA(G_SA(1, 0), cAo, 0, k3);
            G_BAR; G_WAIT_L(0); G_MMA(1, 0, At, B0); G_BAR; G_SCHED;
            G_STAGEB(G_SB(1, 1), b3 + hstepB);
            G_WAIT_V(6); G_BAR; G_MMA(1, 1, At, B1); G_BAR;
        }
        E(acc, cur, wr, wc, fr, fq, (const LAS float*)(lds + XB_OFF + ((ui & 1) * 8 + wid) * 256));
        if (!has_next) break;
#pragma unroll
        for (int a = 0; a < 2; ++a)
#pragma unroll
            for (int b = 0; b < 2; ++b)
#pragma unroll
                for (int m = 0; m < 4; ++m)
#pragma unroll
                    for (int n = 0; n < 2; ++n) acc[a][b][m][n] = (f32x4){0.f, 0.f, 0.f, 0.f};
        cur = nxt; ++ui;
    }
    G_WAIT_V(0);
    if (wr == 0) G_BAR;
    G_BAR;
#undef G_SA
#undef G_SB
#undef G_STAGEA
#undef G_STAGEB
#undef G_LDA
#undef G_LDB
#undef G_MMA
#undef G_CAT8
#undef G_WAIT_V
#undef G_WAIT_L
#undef G_BAR
#undef G_SCHED
}

__device__ __forceinline__ void lane_rc(int i, int& R, int& Cb) { int C; stage_rc(otid() * 16 + i * 8192, R, C); Cb = C * 2; }

struct SchedDense {
    const char* A; const char* B; int RP, nM, nN, G, c;
    __device__ __forceinline__ const char* abase() const { return A; }
    __device__ __forceinline__ bool next(int i, Unit& u) const { const long L = (long)i * G + c; if (L >= (long)nM * nN) return false; dense_map((int)L, nM, nN, u.pm, u.pn); u.e = 0; return true; }
    __device__ __forceinline__ void a_off(const Unit& u, unsigned (&o)[2][2]) const {
#pragma unroll
        for (int i = 0; i < 2; ++i) { int R, Cb; lane_rc(i, R, Cb);
#pragma unroll
            for (int h = 0; h < 2; ++h) o[h][i] = (unsigned)(u.pm * BM + h * HALF + R) * (unsigned)RP + (unsigned)Cb; }
    }
    __device__ __forceinline__ void prefetch_rows(const Unit&, LAS unsigned char*, int, int, int) const {}
    __device__ __forceinline__ void prefetch_bias(const Unit&, LAS unsigned char*, int, int, int, int) const {}
    __device__ __forceinline__ void a_off_lds(const Unit& u, LAS unsigned char*, int, int, int, unsigned (&o)[2][2]) const { a_off(u, o); }
    __device__ __forceinline__ const char* b_ptr(const Unit& u) const { return B + (size_t)u.pn * BM * RP; }
};
struct SchedIn0 {
    const char* A; const char* B; int G, c;
    __device__ __forceinline__ const char* abase() const { return A; }
    __device__ __forceinline__ bool next(int i, Unit& u) const {
        const long L = (long)i * G + c; u.e = 0;
        if (L < 256 * 17) { dense_map((int)L, 256, 17, u.pm, u.pn); return true; }
        const int r = (int)(L - 256 * 17); if (r >= 56) return false;
        u.pm = 256 + r / 7; const int q = r % 7; u.pn = (q < 6) ? (2 + q) : 16; return true;
    }
    __device__ __forceinline__ void a_off(const Unit& u, unsigned (&o)[2][2]) const {
#pragma unroll
        for (int i = 0; i < 2; ++i) { int R, Cb; lane_rc(i, R, Cb);
#pragma unroll
            for (int h = 0; h < 2; ++h) o[h][i] = (unsigned)(u.pm * BM + h * HALF + R) * (F8_IN0 ? 1024u : 2048u) + (unsigned)Cb; }
    }
    __device__ __forceinline__ void prefetch_rows(const Unit&, LAS unsigned char*, int, int, int) const {}
    __device__ __forceinline__ void prefetch_bias(const Unit&, LAS unsigned char*, int, int, int, int) const {}
    __device__ __forceinline__ void a_off_lds(const Unit& u, LAS unsigned char*, int, int, int, unsigned (&o)[2][2]) const { a_off(u, o); }
    __device__ __forceinline__ const char* b_ptr(const Unit& u) const { return B + (size_t)u.pn * BM * (F8_IN0 ? 1024 : 2048); }
};
struct SchedMoE {
    const char* A; const char* B; const int* slot_tok; int ts; int RT; int nct; int G, c; size_t bstride_e; bool gather; const float* bias;
    __device__ __forceinline__ const char* abase() const { return A; }
    __device__ __forceinline__ bool next(int i, Unit& u) const {
        const int x = c & 7, j = c >> 3; int rt, ct;
        if (nct == 8) { rt = 32 * i + 4 * x + (j & 3); ct = j >> 2; } else { rt = 64 * i + 8 * x + (j & 7); ct = j >> 3; }
        if (rt >= RT) return false;
        const unsigned long long m = __ballot(((otid() & 63) < 32) && ts <= rt);
        u.pm = rt; u.pn = ct; u.e = __builtin_amdgcn_readfirstlane(__popcll(m)) - 1; return true;
    }
    __device__ __forceinline__ void a_off(const Unit& u, unsigned (&o)[2][2]) const {
#pragma unroll
        for (int i = 0; i < 2; ++i) { int R, Cb; lane_rc(i, R, Cb);
#pragma unroll
            for (int h = 0; h < 2; ++h) { const int row = u.pm * BM + h * HALF + R; const unsigned rr = gather ? (unsigned)slot_tok[row] : (unsigned)row; o[h][i] = rr * 1024u + (unsigned)Cb; } }
    }
    __device__ __forceinline__ const char* b_ptr(const Unit& u) const { return B + (size_t)u.e * bstride_e + (size_t)u.pn * BM * 1024; }
    __device__ __forceinline__ void prefetch_rows(const Unit& u, LAS unsigned char* lds, int par, int wid, int lane) const {
        if (!gather) return;
#pragma unroll
        for (int i = 0; i < 2; ++i) { int R, Cb; lane_rc(i, R, Cb);
#pragma unroll
            for (int h = 0; h < 2; ++h) __builtin_amdgcn_global_load_lds((const unsigned*)(slot_tok + (u.pm * BM + h * HALF + R)), (LAS unsigned*)(lds + XT_OFF + ((par * 8 + wid) * 4 + h * 2 + i) * 256), 4, 0, 0); }
    }
    __device__ __forceinline__ void prefetch_bias(const Unit& u, LAS unsigned char* lds, int par, int wid, int lane, int wc) const {
        const float* src = (nct == 8) ? bias + (size_t)u.e * 2048 + (lane >> 5) * 1024 + u.pn * 128 + wc * 32 + (lane & 31)
                                      : bias + (size_t)u.e * 1024 + u.pn * 256 + (lane >> 5) * 128 + wc * 32 + (lane & 31);
        __builtin_amdgcn_global_load_lds((const unsigned*)src, (LAS unsigned*)(lds + XB_OFF + (par * 8 + wid) * 256), 4, 0, 0);
    }
    __device__ __forceinline__ void a_off_lds(const Unit& u, LAS unsigned char* lds, int par, int wid, int lane, unsigned (&o)[2][2]) const {
#pragma unroll
        for (int i = 0; i < 2; ++i) { int R, Cb; lane_rc(i, R, Cb);
#pragma unroll
            for (int h = 0; h < 2; ++h) { const unsigned rr = gather ? *(const LAS unsigned*)(lds + XT_OFF + ((par * 8 + wid) * 4 + h * 2 + i) * 256 + lane * 4) : (unsigned)(u.pm * BM + h * HALF + R); o[h][i] = rr * 1024u + (unsigned)Cb; } }
    }
};

__device__ __forceinline__ void store8(bf16* p, const f32x4& v0, const f32x4& v1) {
    u32x4 w; w.x = cvt_pk(v0[0], v0[1]); w.y = cvt_pk(v0[2], v0[3]); w.z = cvt_pk(v1[0], v1[1]); w.w = cvt_pk(v1[2], v1[3]);
    *(u32x4*)p = w;
}
struct EpiPlain {
    bf16* O; int ldc;
    __device__ __forceinline__ void operator()(const f32x4 (&acc)[2][2][4][2], const Unit& u, int wr, int wc, int fr, int fq, const LAS float* lb) const {
        const int row0 = u.pm * BM + wr * 64 + fr, col0 = u.pn * BM + wc * 32 + 8 * fq;
#pragma unroll
        for (int ai = 0; ai < 2; ++ai)
#pragma unroll
            for (int m = 0; m < 4; ++m) { bf16* rowp = O + (size_t)(row0 + ai * HALF + m * 16) * ldc + col0;
#pragma unroll
                for (int bj = 0; bj < 2; ++bj) store8(rowp + bj * HALF, acc[ai][bj][m][0], acc[ai][bj][m][1]); }
    }
};
struct EpiIn0 {
    unsigned char* ws;
    __device__ __forceinline__ void operator()(const f32x4 (&acc)[2][2][4][2], const Unit& u, int wr, int wc, int fr, int fq, const LAS float* lb) const {
        const int pn = u.pn; bf16* base; int ldc, c0;
        if (pn < 2) { base = (bf16*)(ws + WS_Q); ldc = 512; c0 = pn * 256; }
        else if (pn < 4) { base = (bf16*)(ws + WS_K); ldc = 512; c0 = (pn - 2) * 256; }
        else if (pn < 8) { base = (bf16*)(ws + WS_V); ldc = 1024; c0 = (pn - 4) * 256; }
        else if (pn < 12) { base = (bf16*)(ws + WS_R); ldc = 1024; c0 = (pn - 8) * 256; }
        else if (pn < 14) { base = (bf16*)(ws + WS_ZC); ldc = 512; c0 = (pn - 12) * 256; }
        else if (pn < 16) { base = (bf16*)(ws + WS_ZS); ldc = 512; c0 = (pn - 14) * 256; }
        else { base = (bf16*)(ws + WS_LR); ldc = 32; c0 = 0; }
        const int row0 = u.pm * BM + wr * 64 + fr, col0 = c0 + wc * 32 + 8 * fq;
        const bool lr = (pn == 16);
        if (lr && wc != 0) return;
        const float qs = (pn < 2) ? 0.08838834764831845f : 1.0f;
#pragma unroll
        for (int ai = 0; ai < 2; ++ai)
#pragma unroll
            for (int m = 0; m < 4; ++m) { bf16* rowp = base + (size_t)(row0 + ai * HALF + m * 16) * ldc + col0;
                store8(rowp, acc[ai][0][m][0] * qs, acc[ai][0][m][1] * qs);
                if (!lr) store8(rowp + HALF, acc[ai][1][m][0] * qs, acc[ai][1][m][1] * qs); }
    }
};
struct EpiIn1 {
    unsigned char* ws;
    __device__ __forceinline__ void operator()(const f32x4 (&acc)[2][2][4][2], const Unit& u, int wr, int wc, int fr, int fq, const LAS float* lb) const {
        const int pn = u.pn; const int row0 = u.pm * BM + wr * 64 + fr;
        if (pn >= 8) { bf16* O = (bf16*)(ws + WS_GB); const int col0 = (pn - 8) * 256 + wc * 32 + 8 * fq;
#pragma unroll
            for (int ai = 0; ai < 2; ++ai)
#pragma unroll
                for (int m = 0; m < 4; ++m) { bf16* rowp = O + (size_t)(row0 + ai * HALF + m * 16) * 512 + col0;
#pragma unroll
                    for (int bj = 0; bj < 2; ++bj) store8(rowp + bj * HALF, acc[ai][bj][m][0], acc[ai][bj][m][1]); }
            return; }
        const bool glu = pn < 4; bf16* O = (bf16*)(ws + (glu ? WS_GLU : WS_ZC1)); const int col0 = (pn & 3) * 128 + wc * 32 + 8 * fq;
#pragma unroll
        for (int ai = 0; ai < 2; ++ai)
#pragma unroll
            for (int m = 0; m < 4; ++m) { f32x4 o[2];
#pragma unroll
                for (int n = 0; n < 2; ++n)
#pragma unroll
                    for (int i = 0; i < 4; i += 2) { const f32v2_t a = (f32v2_t){acc[ai][0][m][n][i], acc[ai][0][m][n][i + 1]}, b = (f32v2_t){acc[ai][1][m][n][i], acc[ai][1][m][n][i + 1]};
                        f32v2_t ov;
                        if (glu) { const f32v2_t ea = b * -1.4426950408889634f; f32v2_t e; e.x = __builtin_amdgcn_exp2f(ea.x); e.y = __builtin_amdgcn_exp2f(ea.y);
                            const f32v2_t d = e + 1.0f; f32v2_t r; r.x = __builtin_amdgcn_rcpf(d.x); r.y = __builtin_amdgcn_rcpf(d.y); ov = a * r; }
                        else ov = a * b;
                        o[n][i] = ov.x; o[n][i + 1] = ov.y; }
                store8(O + (size_t)(row0 + ai * HALF + m * 16) * 512 + col0, o[0], o[1]); }
    }
};
struct EpiGU {
    unsigned char* O; const float* bgu; int probe;
    __device__ __forceinline__ void operator()(const f32x4 (&acc)[2][2][4][2], const Unit& u, int wr, int wc, int fr, int fq, const LAS float* lb) const {
        if (probe) {
#pragma unroll
            for (int a = 0; a < 2; ++a)
#pragma unroll
                for (int b = 0; b < 2; ++b)
#pragma unroll
                    for (int m = 0; m < 4; ++m)
#pragma unroll
                        for (int n = 0; n < 2; ++n) asm volatile("" :: "v"(acc[a][b][m][n]));
            return; }
        const int row0 = u.pm * BM + wr * 64 + fr, col0 = u.pn * 128 + wc * 32 + 8 * fq;
        f32x4 bgv[2], buv[2];
#pragma unroll
        for (int n = 0; n < 2; ++n) { bgv[n] = *(const LAS f32x4*)(lb + 8 * fq + 4 * n); buv[n] = *(const LAS f32x4*)(lb + 32 + 8 * fq + 4 * n); }
#pragma unroll
        for (int ai = 0; ai < 2; ++ai)
#pragma unroll
            for (int m = 0; m < 4; ++m) { f32x4 o[2];
#pragma unroll
                for (int n = 0; n < 2; ++n)
#pragma unroll
                    for (int i = 0; i < 4; i += 2) {
                        f32v2_t g = (f32v2_t){acc[ai][0][m][n][i], acc[ai][0][m][n][i + 1]} + (f32v2_t){bgv[n][i], bgv[n][i + 1]};
                        f32v2_t uu = (f32v2_t){acc[ai][1][m][n][i], acc[ai][1][m][n][i + 1]} + (f32v2_t){buv[n][i], buv[n][i + 1]};
                        g.x = fminf(g.x, 7.0f); g.y = fminf(g.y, 7.0f);
                        uu.x = __builtin_amdgcn_fmed3f(uu.x, -7.0f, 7.0f); uu.y = __builtin_amdgcn_fmed3f(uu.y, -7.0f, 7.0f);
                        const f32v2_t ea = g * (-1.702f * 1.4426950408889634f);
                        f32v2_t e; e.x = __builtin_amdgcn_exp2f(ea.x); e.y = __builtin_amdgcn_exp2f(ea.y);
                        const f32v2_t d = e + 1.0f;
                        f32v2_t r; r.x = __builtin_amdgcn_rcpf(d.x); r.y = __builtin_amdgcn_rcpf(d.y);
                        const f32v2_t t4 = uu * 4.0f + 4.0f;
                        const f32v2_t ov = (g * r) * t4;
                        o[n][i] = ov.x; o[n][i + 1] = ov.y; }
                int w0 = 0, w1 = 0;
                w0 = __builtin_amdgcn_cvt_pk_fp8_f32(o[0][0], o[0][1], w0, false); w0 = __builtin_amdgcn_cvt_pk_fp8_f32(o[0][2], o[0][3], w0, true);
                w1 = __builtin_amdgcn_cvt_pk_fp8_f32(o[1][0], o[1][1], w1, false); w1 = __builtin_amdgcn_cvt_pk_fp8_f32(o[1][2], o[1][3], w1, true);
                *(u32x2*)(O + (size_t)(row0 + ai * HALF + m * 16) * 1024 + col0) = (u32x2){(unsigned)w0, (unsigned)w1}; }
    }
};
struct EpiDown {
    unsigned char* O; const float* bd;
    __device__ __forceinline__ void operator()(const f32x4 (&acc)[2][2][4][2], const Unit& u, int wr, int wc, int fr, int fq, const LAS float* lb) const {
        const int row0 = u.pm * BM + wr * 64 + fr, col0 = u.pn * BM + wc * 32 + 8 * fq;
        f32x4 bv[2][2];
#pragma unroll
        for (int bj = 0; bj < 2; ++bj)
#pragma unroll
            for (int n = 0; n < 2; ++n) bv[bj][n] = *(const LAS f32x4*)(lb + 32 * bj + 8 * fq + 4 * n) * 16.0f;
#pragma unroll
        for (int ai = 0; ai < 2; ++ai)
#pragma unroll
            for (int m = 0; m < 4; ++m) { unsigned char* rowp = O + (size_t)(row0 + ai * HALF + m * 16) * 1024 + col0;
#pragma unroll
                for (int bj = 0; bj < 2; ++bj) { const f32x4 v0 = acc[ai][bj][m][0] * 16.0f + bv[bj][0], v1 = acc[ai][bj][m][1] * 16.0f + bv[bj][1];
                    int w0 = 0, w1 = 0;
                    w0 = __builtin_amdgcn_cvt_pk_fp8_f32(fminf(fmaxf(v0[0], -440.f), 440.f), fminf(fmaxf(v0[1], -440.f), 440.f), w0, false); w0 = __builtin_amdgcn_cvt_pk_fp8_f32(fminf(fmaxf(v0[2], -440.f), 440.f), fminf(fmaxf(v0[3], -440.f), 440.f), w0, true);
                    w1 = __builtin_amdgcn_cvt_pk_fp8_f32(fminf(fmaxf(v1[0], -440.f), 440.f), fminf(fmaxf(v1[1], -440.f), 440.f), w1, false); w1 = __builtin_amdgcn_cvt_pk_fp8_f32(fminf(fmaxf(v1[2], -440.f), 440.f), fminf(fmaxf(v1[3], -440.f), 440.f), w1, true);
                    *(u32x2*)(rowp + bj * HALF) = (u32x2){(unsigned)w0, (unsigned)w1}; } }
    }
};
}

__device__ __forceinline__ void p0_adaln(const Ctx& C) {
    PH_IDS;
    LAS float* s = (LAS float*)C.lds;
    LAS float* red = (LAS float*)(C.lds + 36864);
    const float* cc = C.a->in[IN_C]; const float* cx = C.a->in[IN_CCTX];
    { float tmpc[18];
#pragma unroll
      for (int q = 0; q < 18; ++q) { const int i = tid + 512 * q; const int b = i >> 10, k = i & 1023; tmpc[q] = (b < 8) ? cc[b * 1024 + k] : cx[k]; }
#pragma unroll
      for (int q = 0; q < 18; ++q) s[tid + 512 * q] = siluf_(tmpc[q]); }
    __syncthreads();
    float* MOD = (float*)(C.ws + WS_MOD);
    for (int item = blockIdx.x; item < 192; item += C.G) {
        const int l = item / 96, cb = item % 96, col = cb * 64 + lane;
        const float* W = C.a->in[IN_MODW] + (size_t)l * 1024 * 6144 + col;
        float acc[9];
#pragma unroll
        for (int b = 0; b < 9; ++b) acc[b] = 0.f;
        const int k0 = wave * 128;
#pragma unroll 8
        for (int k = k0; k < k0 + 128; ++k) { const float w = W[(size_t)k * 6144];
#pragma unroll
            for (int b = 0; b < 9; ++b) acc[b] += s[b * 1024 + k] * w; }
#pragma unroll
        for (int b = 0; b < 9; ++b) red[(wave * 9 + b) * 64 + lane] = acc[b];
        __syncthreads();
        for (int i = tid; i < 576; i += 512) { const int b = i >> 6, ln = i & 63; float v = 0.f;
#pragma unroll
            for (int w = 0; w < 8; ++w) v += red[(w * 9 + b) * 64 + ln];
            v += C.a->in[IN_MODB][l * 6144 + cb * 64 + ln];
            MOD[(size_t)(l * 9 + b) * 6144 + cb * 64 + ln] = v; }
        __syncthreads();
    }
}
__device__ __forceinline__ void p0_tr_item(const float* W, int ldw, int sc0, int k0, bf16* WT, int Kd, int dr0, float scale, LAS float* scr, int lane) {
#pragma unroll 8
    for (int i = 0; i < 32; ++i) { const int kk = 2 * i + (lane >> 5); scr[kk * 33 + (lane & 31)] = W[(size_t)(k0 + kk) * ldw + sc0 + (lane & 31)]; }
    asm volatile("s_waitcnt lgkmcnt(0)" ::: "memory");
    const int c = lane & 7;
#pragma unroll
    for (int j = 0; j < 4; ++j) { const int n = (lane >> 3) + 8 * j; const LAS float* sp = scr + (8 * c) * 33 + n;
        u32x4 o; o.x = cvt_pk(sp[0 * 33] * scale, sp[1 * 33] * scale); o.y = cvt_pk(sp[2 * 33] * scale, sp[3 * 33] * scale);
        o.z = cvt_pk(sp[4 * 33] * scale, sp[5 * 33] * scale); o.w = cvt_pk(sp[6 * 33] * scale, sp[7 * 33] * scale);
        *(u32x4*)(WT + (size_t)(dr0 + n) * Kd + k0 + 8 * c) = o; }
    asm volatile("s_waitcnt lgkmcnt(0)" ::: "memory");
}
__device__ __forceinline__ void p0_tr_item8(const float* W, int ldw, int sc0, int k0, unsigned char* WT, int Kd, int dr0, float scale, LAS float* scr, int lane) {
#pragma unroll 8
    for (int i = 0; i < 64; ++i) { const int kk = 2 * i + (lane >> 5); scr[kk * 33 + (lane & 31)] = W[(size_t)(k0 + kk) * ldw + sc0 + (lane & 31)]; }
    asm volatile("s_waitcnt lgkmcnt(0)" ::: "memory");
    const int c = lane & 7;
#pragma unroll
    for (int j = 0; j < 4; ++j) { const int n = (lane >> 3) + 8 * j; const LAS float* sp = scr + (16 * c) * 33 + n;
        int w[4];
#pragma unroll
        for (int q = 0; q < 4; ++q) { int x = 0;
            x = __builtin_amdgcn_cvt_pk_fp8_f32(sp[(4 * q) * 33] * scale, sp[(4 * q + 1) * 33] * scale, x, false);
            x = __builtin_amdgcn_cvt_pk_fp8_f32(sp[(4 * q + 2) * 33] * scale, sp[(4 * q + 3) * 33] * scale, x, true); w[q] = x; }
        *(u32x4*)(WT + (size_t)(dr0 + n) * Kd + k0 + 16 * c) = (u32x4){(unsigned)w[0], (unsigned)w[1], (unsigned)w[2], (unsigned)w[3]}; }
    asm volatile("s_waitcnt lgkmcnt(0)" ::: "memory");
}
__device__ __forceinline__ int gu_src_col(int dr0) { const int pn = dr0 >> 8, bj = (dr0 >> 7) & 1, t0 = dr0 & 127; return bj * 1024 + 128 * pn + t0; }
__device__ __forceinline__ int in1_src_col(int dr0) {
    const int pn = dr0 >> 8, bj = (dr0 >> 7) & 1, t0 = dr0 & 127;
    if (pn < 4) return bj * 512 + 128 * pn + t0;
    if (pn < 8) return (bj ? 2048 : 1536) + 128 * (pn - 4) + t0;
    return 1024 + (dr0 - 2048);
}
__device__ __forceinline__ void p0_convert(const Ctx& C) {
    PH_IDS;
    LAS float* scr = (LAS float*)(C.lds + wave * 16896);
    const int gw = blockIdx.x * 8 + wave, NGW = C.G * 8;
    constexpr int KB_IN0 = F8_IN0 ? 8 : 16, KB_OUT0 = F8_OUT0 ? 12 : 24, KB_IN1 = F8_IN1 ? 8 : 16, KB_OUT1 = F8_OUT1 ? 8 : 16;
    constexpr int I_IN0 = 97 * KB_IN0, I_OUT0 = 32 * KB_OUT0, I_IN1 = 80 * KB_IN1, I_OUT1 = 32 * KB_OUT1, I_GU = 64 * 64 * 8, I_D = 64 * 32 * 8;
    constexpr int NITEMS = I_IN0 + I_OUT0 + I_IN1 + I_OUT1 + I_GU + I_D;
    for (int it = gw; it < NITEMS; it += NGW) {
        int r = it;
        if (r < I_IN0) { const int nb = r / KB_IN0, kb = r % KB_IN0; int dr0, sc0;
            if (nb < 96) { dr0 = nb * 32; sc0 = dr0; } else { dr0 = 4096; sc0 = 3072; }
            if (F8_IN0) p0_tr_item8(C.a->in[IN_EVWIN], 3616, sc0, kb * 128, (unsigned char*)(C.ws + WS_WIN0), 1024, dr0, 32.f, scr, lane);
            else p0_tr_item(C.a->in[IN_EVWIN], 3616, sc0, kb * 64, (bf16*)(C.ws + WS_WIN0), 1024, dr0, 1.f, scr, lane);
            continue; }
        r -= I_IN0;
        if (r < I_OUT0) { const int nb = r / KB_OUT0, kb = r % KB_OUT0;
            if (F8_OUT0) p0_tr_item8(C.a->in[IN_EVWOUT], 1024, nb * 32, kb * 128, (unsigned char*)(C.ws + WS_WOUT0), 1536, nb * 32, 32.f, scr, lane);
            else p0_tr_item(C.a->in[IN_EVWOUT], 1024, nb * 32, kb * 64, (bf16*)(C.ws + WS_WOUT0), 1536, nb * 32, 1.f, scr, lane);
            continue; }
        r -= I_OUT0;
        if (r < I_IN1) { const int nb = r / KB_IN1, kb = r % KB_IN1;
            if (F8_IN1) p0_tr_item8(C.a->in[IN_ODWIN], 2560, in1_src_col(nb * 32), kb * 128, (unsigned char*)(C.ws + WS_WIN1), 1024, nb * 32, 32.f, scr, lane);
            else p0_tr_item(C.a->in[IN_ODWIN], 2560, in1_src_col(nb * 32), kb * 64, (bf16*)(C.ws + WS_WIN1), 1024, nb * 32, 1.f, scr, lane);
            continue; }
        r -= I_IN1;
        if (r < I_OUT1) { const int nb = r / KB_OUT1, kb = r % KB_OUT1;
            if (F8_OUT1) p0_tr_item8(C.a->in[IN_ODWOUT], 1024, nb * 32, kb * 128, (unsigned char*)(C.ws + WS_WOUT1), 1024, nb * 32, 32.f, scr, lane);
            else p0_tr_item(C.a->in[IN_ODWOUT], 1024, nb * 32, kb * 64, (bf16*)(C.ws + WS_WOUT1), 1024, nb * 32, 1.f, scr, lane);
            continue; }
        r -= I_OUT1;
        if (r < I_GU) { const int le = r >> 9, q = r & 511, nb = q >> 3, kb = q & 7;
            p0_tr_item8(C.a->in[IN_WGU] + (size_t)le * 1024 * 2048, 2048, gu_src_col(nb * 32), kb * 128, (unsigned char*)(C.ws + WS_WGU) + (size_t)le * 2048 * 1024, 1024, nb * 32, 32.f, scr, lane); continue; }
        r -= I_GU;
        { const int le = r >> 8, q = r & 255, nb = q >> 3, kb = q & 7;
            p0_tr_item8(C.a->in[IN_WD] + (size_t)le * 1024 * 1024, 1024, nb * 32, kb * 128, (unsigned char*)(C.ws + WS_WD) + (size_t)le * 1024 * 1024, 1024, nb * 32, 32.f, scr, lane); }
    }
    { u32x4* z = (u32x4*)((unsigned char*)(C.ws + WS_WIN0) + (size_t)4128 * 1024 * (F8_IN0 ? 1 : 2)); const int n16 = 224 * 1024 * (F8_IN0 ? 1 : 2) / 16;
      for (int i = blockIdx.x * 512 + tid; i < n16; i += C.G * 512) z[i] = (u32x4){0u, 0u, 0u, 0u}; }
    { bf16* F1 = (bf16*)(C.ws + WS_F1); bf16* F2 = (bf16*)(C.ws + WS_F2);
      for (int i = blockIdx.x * 512 + tid; i < 128 * 128 + 128 * 256; i += C.G * 512) {
          if (i < 128 * 128) { const int m = i >> 7, k = i & 127; const int mb = m >> 5, rr = m & 31, g = rr >> 3, hh = (rr >> 2) & 1, ii = rr & 3;
              const int part = g & 1, ap = 16 * mb + 8 * (g >> 1) + 4 * hh + ii, pin = k >> 6, a = k & 63;
              const float th = 6.283185307179586f * (float)((a * ap) & 63) * (1.0f / 64.0f); const float cs = cosf(th), sn = sinf(th);
              const float v = (part == 0) ? (pin == 0 ? cs : -sn) : (pin == 0 ? -sn : -cs);
              F1[i] = (bf16)f2bf(v); }
          else { const int q = i - 128 * 128, m = q >> 8, k = q & 255, pin = k >> 7, b = k & 127;
              const float ps = 6.283185307179586f * (float)((b * m) & 127) * (1.0f / 128.0f);
              F2[q] = (bf16)f2bf(pin == 0 ? cosf(ps) : sinf(ps)); } } }
    __syncthreads();
}
__device__ __forceinline__ void p0_fourier_fold(const Ctx& C) {
    PH_IDS;
    LAS float* Wl = (LAS float*)C.lds;
    LAS float* tab = (LAS float*)(C.lds + 32768);
    unsigned char* WT = (unsigned char*)(C.ws + WS_WIN0);
    for (int item = blockIdx.x; item < 64; item += C.G) {
        const int kb = item >> 2, g = item & 3;
        __syncthreads();
        if (tid < 128) tab[tid] = cosf(6.283185307179586f * (float)tid * (1.0f / 128.0f));
        for (int i = tid; i < 64 * 128; i += 512) { const int kk = i >> 7, c = i & 127; Wl[i] = C.a->in[IN_EVWIN][(size_t)(kb * 64 + kk) * 3616 + 3104 + g * 128 + c]; }
        __syncthreads();
        const int cp = tid & 127, kq = tid >> 7;
        float ac[16], as[16];
#pragma unroll
        for (int i = 0; i < 16; ++i) { ac[i] = 0.f; as[i] = 0.f; }
        for (int c = 0; c < 128; ++c) { const int ph = (c * cp) & 127; const float cs = tab[ph], sn = tab[(ph + 96) & 127];
#pragma unroll
            for (int i = 0; i < 16; ++i) { const float w = Wl[(kq * 16 + i) * 128 + c]; ac[i] += w * cs; as[i] += w * sn; } }
        if (F8_IN0) {
            unsigned char* pc = WT + (size_t)(3072 + g * 128 + cp) * 1024 + kb * 64 + kq * 16;
            unsigned char* ps = WT + (size_t)(3584 + g * 128 + cp) * 1024 + kb * 64 + kq * 16;
            *(u32x4*)pc = (u32x4){pk4_fp8(ac[0], ac[1], ac[2], ac[3], 32.f), pk4_fp8(ac[4], ac[5], ac[6], ac[7], 32.f), pk4_fp8(ac[8], ac[9], ac[10], ac[11], 32.f), pk4_fp8(ac[12], ac[13], ac[14], ac[15], 32.f)};
            *(u32x4*)ps = (u32x4){pk4_fp8(as[0], as[1], as[2], as[3], 32.f), pk4_fp8(as[4], as[5], as[6], as[7], 32.f), pk4_fp8(as[8], as[9], as[10], as[11], 32.f), pk4_fp8(as[12], as[13], as[14], as[15], 32.f)};
        } else {
            bf16* pc = (bf16*)WT + (size_t)(3072 + g * 128 + cp) * 1024 + kb * 64 + kq * 16;
            bf16* ps = (bf16*)WT + (size_t)(3584 + g * 128 + cp) * 1024 + kb * 64 + kq * 16;
            *(u32x4*)pc = (u32x4){cvt_pk(ac[0], ac[1]), cvt_pk(ac[2], ac[3]), cvt_pk(ac[4], ac[5]), cvt_pk(ac[6], ac[7])}; *(u32x4*)(pc + 8) = (u32x4){cvt_pk(ac[8], ac[9]), cvt_pk(ac[10], ac[11]), cvt_pk(ac[12], ac[13]), cvt_pk(ac[14], ac[15])};
            *(u32x4*)ps = (u32x4){cvt_pk(as[0], as[1]), cvt_pk(as[2], as[3]), cvt_pk(as[4], as[5]), cvt_pk(as[6], as[7])}; *(u32x4*)(ps + 8) = (u32x4){cvt_pk(as[8], as[9]), cvt_pk(as[10], as[11]), cvt_pk(as[12], as[13]), cvt_pk(as[14], as[15])};
        }
    }
    __syncthreads();
}

__device__ __forceinline__ void p_norm0(const Ctx& C) {
    PH_IDS;
    const int gw = blockIdx.x * 8 + wave, NGW = C.G * 8;
    const int per = (MALL + NGW - 1) / NGW;
    const int r0 = gw * per, r1 = (r0 + per < MALL) ? r0 + per : MALL;
    const float* MOD = (const float*)(C.ws + WS_MOD);
    const float* g = C.a->in[IN_NMPRE];
    unsigned char* HN = (unsigned char*)(C.ws + WS_HN);
    int curb = -1; f32x4 A[4], B[4];
    for (int r = r0; r < r1; ++r) {
        const int b = (r < MTOK) ? (r >> 13) : 8;
        if (b != curb) { curb = b;
#pragma unroll
            for (int j = 0; j < 4; ++j) { const int c = 4 * lane + 256 * j;
                const f32x4 gg = *(const f32x4*)(g + c), sc = *(const f32x4*)(MOD + (size_t)b * 6144 + 1024 + c), sh = *(const f32x4*)(MOD + (size_t)b * 6144 + c);
                A[j] = gg * (sc + 1.0f); B[j] = sh; } }
        const float* xr = (r < MTOK) ? (C.a->in[IN_X] + (size_t)r * 1024) : (C.a->in[IN_CTX] + (size_t)(r - MTOK) * 1024);
        f32x4 v[4]; float ss = 0.f;
#pragma unroll
        for (int j = 0; j < 4; ++j) { v[j] = *(const f32x4*)(xr + 4 * lane + 256 * j); ss += v[j][0] * v[j][0] + v[j][1] * v[j][1] + v[j][2] * v[j][2] + v[j][3] * v[j][3]; }
        const float rstd = rsqrtf(wave_sum(ss) * (1.0f / 1024.0f) + EPS);
#pragma unroll
        for (int j = 0; j < 4; ++j) { const f32x4 h = v[j] * rstd * A[j] + B[j];
            if (F8_IN0) *(unsigned*)(HN + (size_t)r * 1024 + 4 * lane + 256 * j) = pk4_fp8(h[0], h[1], h[2], h[3], 8.f);
            else *(u32x2*)((bf16*)HN + (size_t)r * 1024 + 4 * lane + 256 * j) = (u32x2){cvt_pk(h[0], h[1]), cvt_pk(h[2], h[3])}; }
    }
}

namespace glap {
constexpr int H_BYTES = 72704;
constexpr int O_RAW = 0, O_BC = 2048, O_TOT = 34816, O_QP = 36864, O_KP = 54272;
constexpr int NUNIT = 2 * 4 * 8 * 132;
}
__device__ __forceinline__ int gla_row(int bt, int dir, int s, int i) {
    const int ii = dir ? 63 - i : i;
    if (s < 4) { const int ci = dir ? 3 - s : s; return MTOK + bt * CTXL + ci * 64 + ii; }
    const int n = s - 4, ci = dir ? 127 - n : n; return bt * SEQ + ci * 64 + ii;
}
__device__ __forceinline__ void p_gla_prep(const Ctx& C, const int pv = 0) {
    PH_IDS;
    using namespace glap;
    const int half = tid >> 8, th = tid & 255, wh = wave & 3;
    LAS unsigned char* L = C.lds + half * H_BYTES;
    const bf16* Qg = (const bf16*)(C.ws + WS_Q); const bf16* Kg = (const bf16*)(C.ws + WS_K); const bf16* LRg = (const bf16*)(C.ws + WS_LR);
    bf16* QPg = (bf16*)(C.ws + WS_GQP); bf16* KPPg = (bf16*)(C.ws + WS_GKPP); bf16* SCg = (bf16*)(C.ws + WS_GSC); float* ELg = (float*)(C.ws + WS_GEL);
    const int niter = (NUNIT + 2 * C.G - 1) / (2 * C.G);
    const int lj = th >> 2, part = th & 3;
    u32x4 nq[4], nk[4], nlr; float nup[8], nbias;
    auto unit_of = [&](int itn) -> int { const int U = (itn * C.G + (int)blockIdx.x) * 2 + half; return U < NUNIT ? U : NUNIT - 1; };
    auto issue_loads = [&](int Uc) {
        const int sstep = Uc % 132, bt = (Uc / 132) & 7, hd = (Uc / (132 * 8)) & 3, dir = Uc / (132 * 32);
#pragma unroll
        for (int q = 0; q < 4; ++q) { const int c = th + 256 * q; const int row = gla_row(bt, dir, sstep, c >> 4);
            nk[q] = *(const u32x4*)(Kg + (size_t)row * 512 + hd * 128 + (c & 15) * 8);
            nq[q] = *(const u32x4*)(Qg + (size_t)(sstep >= 4 ? row : 0) * 512 + hd * 128 + (c & 15) * 8); }
        if (th < 128) { const int r2 = gla_row(bt, dir, sstep, th >> 1); nlr = *(const u32x4*)(LRg + (size_t)r2 * 32 + dir * 16 + (th & 1) * 8); }
        const float* up = C.a->in[IN_EVGKUP] + (size_t)dir * 16 * 512 + hd * 128 + 32 * wh + (lane & 31);
#pragma unroll
        for (int q = 0; q < 8; ++q) nup[q] = up[(size_t)(8 * (lane >> 5) + q) * 512];
        nbias = C.a->in[IN_EVGKB][dir * 512 + hd * 128 + 32 * wh + (lane & 31)]; };
    issue_loads(unit_of(0));
    for (int itn = 0; itn < niter; ++itn) {
        const int U = (itn * C.G + (int)blockIdx.x) * 2 + half;
        const bool act = U < NUNIT;
        const int Uc = act ? U : NUNIT - 1;
        const int sstep = Uc % 132;
        const bool latent = sstep >= 4;
        u32x4 rq[4], rk[4], rlr = nlr;
#pragma unroll
        for (int q = 0; q < 4; ++q) { rq[q] = nq[q]; rk[q] = nk[q]; }
        bf16x8 upf; const float gbias = nbias;
        { unsigned short tmp[8];
#pragma unroll
          for (int q = 0; q < 8; ++q) tmp[q] = (unsigned short)f2bf(nup[q]);
          upf = (bf16x8){(short)tmp[0], (short)tmp[1], (short)tmp[2], (short)tmp[3], (short)tmp[4], (short)tmp[5], (short)tmp[6], (short)tmp[7]}; }
        if (itn + 1 < niter) issue_loads(unit_of(itn + 1));
        __syncthreads();
        if (th < 128) *(LAS u32x4*)(L + O_RAW + (th >> 1) * 32 + (th & 1) * 16) = rlr;
        __syncthreads();
#pragma unroll
        for (int jb = 0; jb < 2; ++jb) {
            const bf16x8 af = *(const LAS bf16x8*)(L + O_RAW + (32 * jb + (lane & 31)) * 32 + (lane >> 5) * 16);
            f32x16 z;
#pragma unroll
            for (int i = 0; i < 16; ++i) z[i] = 0.f;
            z = __builtin_amdgcn_mfma_f32_32x32x16_bf16(af, upf, z, 0, 0, 0);
#pragma unroll
            for (int r = 0; r < 16; ++r) { const int j = 32 * jb + (r & 3) + 8 * (r >> 2) + 4 * (lane >> 5); const float zz = z[r] + gbias;
                const float ls = fminf(zz, 0.f) - __logf(1.0f + __expf(-fabsf(zz)));
                *(LAS float*)(L + O_BC + (j * 128 + 32 * wh + (lane & 31)) * 4) = ls * 0.0625f; } }
        __syncthreads();
        { const int dk = th & 127;
          float run0 = 0.f, run1 = 0.f; const int g0 = th >> 7, g1 = g0 + 2;
          float v0[16], v1[16];
#pragma unroll
          for (int q = 0; q < 16; ++q) { v0[q] = *(const LAS float*)(L + O_BC + ((16 * g0 + q) * 128 + dk) * 4); v1[q] = *(const LAS float*)(L + O_BC + ((16 * g1 + q) * 128 + dk) * 4); }
#pragma unroll
          for (int q = 0; q < 16; ++q) { run0 += v0[q]; run1 += v1[q];
              *(LAS float*)(L + O_BC + ((16 * g0 + q) * 128 + dk) * 4) = run0; *(LAS float*)(L + O_BC + ((16 * g1 + q) * 128 + dk) * 4) = run1; }
          *(LAS float*)(L + O_TOT + (g0 * 128 + dk) * 4) = run0; *(LAS float*)(L + O_TOT + (g1 * 128 + dk) * 4) = run1; }
        __syncthreads();
        {
#pragma unroll
          for (int q8 = 0; q8 < 4; ++q8) {
              const int c = th + 256 * q8, cj = c >> 4, jg = cj >> 4, dkc = (c & 15) * 8;
              u32x4 oq, okpp;
#pragma unroll
              for (int hq = 0; hq < 2; ++hq) {
                  const int dk0 = dkc + 4 * hq;
                  f32x4 b = *(const LAS f32x4*)(L + O_BC + (cj * 128 + dk0) * 4), tt = (f32x4){0.f, 0.f, 0.f, 0.f};
#pragma unroll
                  for (int g2 = 0; g2 < 4; ++g2) { const f32x4 tv = *(const LAS f32x4*)(L + O_TOT + (g2 * 128 + dk0) * 4); tt += tv; if (g2 < jg) b += tv; }
                  f32x4 e1, e2, e3;
#pragma unroll
                  for (int i = 0; i < 4; ++i) { if (pv & 4) { e1[i] = b[i]; e2[i] = -b[i]; e3[i] = tt[i] - b[i]; } else { e1[i] = __expf(b[i]); e2[i] = __expf(-b[i]); e3[i] = __expf(tt[i] - b[i]); } }
                  if (cj == 0 && act && !(pv & 1)) { f32x4 el;
#pragma unroll
                      for (int i = 0; i < 4; ++i) el[i] = __expf(tt[i]);
                      *(f32x4*)(ELg + (size_t)Uc * 128 + dk0) = el; }
                  const unsigned qa = hq ? rq[q8].z : rq[q8].x, qb = hq ? rq[q8].w : rq[q8].y;
                  const unsigned ka = hq ? rk[q8].z : rk[q8].x, kb = hq ? rk[q8].w : rk[q8].y;
                  const float q0 = bf_lo(qa), q1 = bf_hi(qa), q2 = bf_lo(qb), q3 = bf_hi(qb);
                  const float k0 = bf_lo(ka), k1 = bf_hi(ka), k2 = bf_lo(kb), k3 = bf_hi(kb);
                  u32x2 o;
                  o.x = cvt_pk(q0 * e1[0], q1 * e1[1]); o.y = cvt_pk(q2 * e1[2], q3 * e1[3]); *(LAS u32x2*)(L + O_QP + cj * 272 + dk0 * 2) = o;
                  if (hq) { oq.z = o.x; oq.w = o.y; } else { oq.x = o.x; oq.y = o.y; }
                  o.x = cvt_pk(k0 * e2[0], k1 * e2[1]); o.y = cvt_pk(k2 * e2[2], k3 * e2[3]); *(LAS u32x2*)(L + O_KP + cj * 272 + dk0 * 2) = o;
                  o.x = cvt_pk(k0 * e3[0], k1 * e3[1]); o.y = cvt_pk(k2 * e3[2], k3 * e3[3]);
                  if (hq) { okpp.z = o.x; okpp.w = o.y; } else { okpp.x = o.x; okpp.y = o.y; }
              }
              if (act && !(pv & 1)) { *(u32x4*)(KPPg + (size_t)Uc * 8192 + c * 8) = okpp; if (latent) *(u32x4*)(QPg + (size_t)Uc * 8192 + c * 8) = oq; }
              else asm volatile("" :: "v"(okpp), "v"(oq));
          } }
        __syncthreads();
        if (latent && act && !(pv & 2)) {
            const int ib = wh;
            for (int jb16 = 0; jb16 <= ib; ++jb16) {
                f32x4 d = (f32x4){0.f, 0.f, 0.f, 0.f};
#pragma unroll
                for (int ks = 0; ks < 4; ++ks) {
                    const bf16x8 a = *(const LAS bf16x8*)(L + O_KP + (16 * jb16 + (lane & 15)) * 272 + (32 * ks + 8 * (lane >> 4)) * 2);
                    const bf16x8 bq = *(const LAS bf16x8*)(L + O_QP + (16 * ib + (lane & 15)) * 272 + (32 * ks + 8 * (lane >> 4)) * 2);
                    d = __builtin_amdgcn_mfma_f32_16x16x32_bf16(a, bq, d, 0, 0, 0); }
                const int i = 16 * ib + (lane & 15), j0 = 16 * jb16 + 4 * (lane >> 4);
#pragma unroll
                for (int r = 0; r < 4; ++r) if (j0 + r > i) d[r] = 0.f;
                u32x2 o; o.x = cvt_pk(d[0], d[1]); o.y = cvt_pk(d[2], d[3]);
                if (!(pv & 1)) *(u32x2*)(SCg + (size_t)Uc * 4096 + i * 64 + j0) = o; else asm volatile("" :: "v"(o));
            }
            for (int jb16 = ib + 1; jb16 < 4; ++jb16) { const int i = 16 * ib + (lane & 15), j0 = 16 * jb16 + 4 * (lane >> 4);
                if (!(pv & 1)) *(u32x2*)(SCg + (size_t)Uc * 4096 + i * 64 + j0) = (u32x2){0u, 0u}; }
        }
    }
    __syncthreads();
}
namespace gla {
constexpr int O_EL = 0, O_QP = 512, O_KPP = 17920, O_V = 38400, O_SC = 50688, IMG_BYTES = 59904, O_ST = 2 * IMG_BYTES;
constexpr int P_QP = 272, P_KPP = 320, P_V = 192, P_SC = 144, P_ST = 272, ST_BYTES = 64 * 272;
__device__ __forceinline__ bf16x8 tr8(LAS unsigned char* p0, LAS unsigned char* p1) {
    const s16x4 a = __builtin_amdgcn_ds_read_tr16_b64_v4i16((LAS s16x4*)p0);
    const s16x4 b = __builtin_amdgcn_ds_read_tr16_b64_v4i16((LAS s16x4*)p1);
    return (bf16x8){a[0], a[1], a[2], a[3], b[0], b[1], b[2], b[3]};
}
}
__device__ __forceinline__ void p_gla(const Ctx& C, const int probe = 0) {
    PH_IDS;
    using namespace gla;
    LAS unsigned char* L = C.lds;
    const int t = tid, w = wave;
    const bf16* Vg = (const bf16*)(C.ws + WS_V);
    const bf16* QPg = (const bf16*)(C.ws + WS_GQP); const bf16* KPPg = (const bf16*)(C.ws + WS_GKPP); const bf16* SCg = (const bf16*)(C.ws + WS_GSC); const float* ELg = (const float*)(C.ws + WS_GEL);
    for (int it = blockIdx.x; it < 256; it += C.G) {
        const int xx = it & 7, jj_ = it >> 3, scan = xx * 8 + (jj_ >> 2), dvs = jj_ & 3;
        const int bt = scan >> 3, hd = (scan >> 1) & 3, dir = scan & 1;
        const int ubase = ((dir * 4 + hd) * 8 + bt) * 132;
        bf16* Og = (bf16*)(C.ws + (probe ? WS_HN : (dir ? WS_OB : WS_OF)));
        __syncthreads();
        for (int i = t; i < ST_BYTES / 16; i += 512) *(LAS u32x4*)(L + O_ST + i * 16) = (u32x4){0u, 0u, 0u, 0u};
        f32x16 S;
#pragma unroll
        for (int i = 0; i < 16; ++i) S[i] = 0.f;
        const int lj = t >> 3, part = t & 7;
        u32x4 rsc, rqp0, rqp1, rkp0, rkp1, rv; f32x4 rel;
        u32x4 nsc, nqp0, nqp1, nkp0, nkp1, nv; f32x4 nel;
        auto load_step = [&](int s_) {
            const int s = probe ? 4 + (s_ & 1) : s_;
            const size_t U = (size_t)(ubase + s);
            const int row = gla_row(bt, dir, s, lj);
            nv = *(const u32x4*)(Vg + (size_t)row * 1024 + hd * 256 + dvs * 64 + part * 8);
            const bf16* kp = KPPg + U * 8192 + t * 8; nkp0 = *(const u32x4*)kp; nkp1 = *(const u32x4*)(kp + 4096);
            if (t < 32) nel = *(const f32x4*)(ELg + U * 128 + t * 4);
            if (s >= 4) { const bf16* qp = QPg + U * 8192 + t * 8; nqp0 = *(const u32x4*)qp; nqp1 = *(const u32x4*)(qp + 4096);
                nsc = *(const u32x4*)(SCg + U * 4096 + lj * 64 + part * 8); } };
        auto shift_regs = [&]() { rsc = nsc; rqp0 = nqp0; rqp1 = nqp1; rkp0 = nkp0; rkp1 = nkp1; rv = nv; rel = nel; };
        auto write_images = [&](int s, int ib_) {
            LAS unsigned char* I = L + ib_ * IMG_BYTES;
            *(LAS u32x4*)(I + O_V + lj * P_V + part * 16) = rv;
            *(LAS u32x4*)(I + O_KPP + (t >> 4) * P_KPP + (t & 15) * 16) = rkp0; *(LAS u32x4*)(I + O_KPP + (32 + (t >> 4)) * P_KPP + (t & 15) * 16) = rkp1;
            if (t < 32) *(LAS f32x4*)(I + O_EL + t * 16) = rel;
            if (s >= 4) { *(LAS u32x4*)(I + O_QP + (t >> 4) * P_QP + (t & 15) * 16) = rqp0; *(LAS u32x4*)(I + O_QP + (32 + (t >> 4)) * P_QP + (t & 15) * 16) = rqp1;
                *(LAS u32x4*)(I + O_SC + lj * P_SC + part * 16) = rsc; } };
        load_step(0); shift_regs(); write_images(0, 0);
        load_step(1); shift_regs();
        load_step(2);
        for (int s = 0; s < 132; ++s) {
            const int cur = s & 1, nx = cur ^ 1;
            const bool latent = (s >= 4);
            LAS unsigned char* I = L + cur * IMG_BYTES;
            __syncthreads();
            if (s + 1 < 132) write_images(s + 1, nx);
            shift_regs();
            if (s + 3 < 132) load_step(s + 3);
            if (latent) {
                const int ib = w >> 1;
                const int g4 = lane >> 4, q4 = (lane & 15) >> 2, p4 = lane & 3;
                const int orow = gla_row(bt, dir, s, 16 * ib + (lane & 15));
#pragma unroll
                for (int cc = 0; cc < 2; ++cc) {
                    const int c = 2 * (w & 1) + cc;
                    f32x4 d = (f32x4){0.f, 0.f, 0.f, 0.f};
#pragma unroll
                    for (int ks = 0; ks < 2; ++ks) {
                        LAS unsigned char* pa = I + O_V + (32 * ks + 8 * g4 + q4) * P_V + (16 * c + 4 * p4) * 2;
                        const bf16x8 a = gla::tr8(pa, pa + 4 * P_V);
                        const bf16x8 b = *(const LAS bf16x8*)(I + O_SC + (16 * ib + (lane & 15)) * P_SC + (32 * ks + 8 * g4) * 2);
                        d = __builtin_amdgcn_mfma_f32_16x16x32_bf16(a, b, d, 0, 0, 0); }
#pragma unroll
                    for (int ks = 0; ks < 4; ++ks) {
                        const bf16x8 a = *(const LAS bf16x8*)(L + O_ST + cur * ST_BYTES + (16 * c + (lane & 15)) * P_ST + (32 * ks + 8 * g4) * 2);
                        const bf16x8 b = *(const LAS bf16x8*)(I + O_QP + (16 * ib + (lane & 15)) * P_QP + (32 * ks + 8 * g4) * 2);
                        d = __builtin_amdgcn_mfma_f32_16x16x32_bf16(a, b, d, 0, 0, 0); }
                    u32x2 o; o.x = cvt_pk(d[0], d[1]); o.y = cvt_pk(d[2], d[3]);
                    *(u32x2*)(Og + (size_t)orow * 1024 + hd * 256 + dvs * 64 + 16 * c + 4 * g4) = o;
                }
            }
            { const int dbS = w & 3, dvb = w >> 2, hh = lane >> 5, blk = (lane >> 4) & 1, q4 = (lane & 15) >> 2, p4 = lane & 3;
#pragma unroll
              for (int g = 0; g < 4; ++g) { const f32x4 el = *(const LAS f32x4*)(I + O_EL + (32 * dbS + 8 * g + 4 * hh) * 4);
#pragma unroll
                  for (int i = 0; i < 4; ++i) S[4 * g + i] *= el[i]; }
#pragma unroll
              for (int ks = 0; ks < 4; ++ks) {
                  LAS unsigned char* pa = I + O_KPP + (16 * ks + 8 * hh + q4) * P_KPP + (32 * dbS + 16 * blk + 4 * p4) * 2;
                  LAS unsigned char* pb = I + O_V + (16 * ks + 8 * hh + q4) * P_V + (32 * dvb + 16 * blk + 4 * p4) * 2;
                  const bf16x8 a = gla::tr8(pa, pa + 4 * P_KPP);
                  const bf16x8 b = gla::tr8(pb, pb + 4 * P_V);
                  S = __builtin_amdgcn_mfma_f32_32x32x16_bf16(a, b, S, 0, 0, 0); }
#pragma unroll
              for (int g = 0; g < 4; ++g) { u32x2 o; o.x = cvt_pk(S[4 * g], S[4 * g + 1]); o.y = cvt_pk(S[4 * g + 2], S[4 * g + 3]);
                  *(LAS u32x2*)(L + O_ST + nx * ST_BYTES + (32 * dvb + (lane & 31)) * P_ST + (32 * dbS + 8 * g + 4 * hh) * 2) = o; } }
        }
    }
}

__device__ __forceinline__ void p_fft1(const Ctx& C) {
    PH_IDS;
    LAS unsigned char* L = C.lds;
    const int t = tid, w = wave, mb = w & 3, nh = w >> 2, hh = lane >> 5;
    const bf16* F1 = (const bf16*)(C.ws + WS_F1);
    bf16x8 af[8];
#pragma unroll
    for (int ks = 0; ks < 8; ++ks) af[ks] = *(const bf16x8*)(F1 + (32 * mb + (lane & 31)) * 128 + 16 * ks + 8 * hh);
    const bf16* ZC = (const bf16*)(C.ws + WS_ZC); const bf16* ZS = (const bf16*)(C.ws + WS_ZS);
    bf16* YR = (bf16*)(C.ws + WS_YR); bf16* YI = (bf16*)(C.ws + WS_YI);
    const int blk = (lane >> 4) & 1, q4 = (lane & 15) >> 2, p4 = lane & 3;
    u32x4 pv[8];
    auto fetch1 = [&](int unit) { const int bt = unit >> 8, b = (unit >> 1) & 127, chh = unit & 1; const int row = t >> 2, quarter = t & 3, pin = row >> 6, a = row & 63;
        const bf16* src = (pin ? ZS : ZC) + (size_t)(bt * SEQ + 128 * a + b) * 512 + chh * 256 + quarter * 64;
#pragma unroll
        for (int i = 0; i < 8; ++i) pv[i] = *(const u32x4*)(src + 8 * i); };
    if ((int)blockIdx.x < 2048) fetch1(blockIdx.x);
    for (int unit = blockIdx.x; unit < 2048; unit += C.G) {
        const int bt = unit >> 8, b = (unit >> 1) & 127, chh = unit & 1;
        __syncthreads();
        { const int row = t >> 2, quarter = t & 3;
#pragma unroll
          for (int i = 0; i < 8; ++i) *(LAS u32x4*)(L + row * 576 + quarter * 128 + i * 16) = pv[i]; }
        __syncthreads();
        if (unit + C.G < 2048) fetch1(unit + C.G);
#pragma unroll 1
        for (int nb = 0; nb < 4; ++nb) {
            const int c = 4 * nh + nb;
            f32x16 acc;
#pragma unroll
            for (int i = 0; i < 16; ++i) acc[i] = 0.f;
#pragma unroll
            for (int ks = 0; ks < 8; ++ks) {
                LAS unsigned char* pb = L + (16 * ks + 8 * hh + q4) * 576 + (32 * c + 16 * blk + 4 * p4) * 2;
                const bf16x8 bfr = gla::tr8(pb, pb + 4 * 576);
                acc = __builtin_amdgcn_mfma_f32_32x32x16_bf16(af[ks], bfr, acc, 0, 0, 0); }
#pragma unroll
            for (int gp = 0; gp < 2; ++gp)
#pragma unroll
                for (int i = 0; i < 4; ++i) { const int ap = 16 * mb + 8 * gp + 4 * hh + i; const float re = acc[8 * gp + i], im = acc[8 * gp + 4 + i];
                    const float ph = (float)((b * ap) & 8191) * (1.0f / 8192.0f); const float cs = __builtin_amdgcn_cosf(ph), sn = __builtin_amdgcn_sinf(ph);
                    const int so = ap * 528 + (32 * c + (lane & 31)) * 2;
                    *(LAS unsigned short*)(L + 73728 + so) = (unsigned short)f2bf(re * cs + im * sn);
                    *(LAS unsigned short*)(L + 73728 + 64 * 528 + so) = (unsigned short)f2bf(im * cs - re * sn); }
        }
        __syncthreads();
        { const int orow = t >> 2, quarter = t & 3, plane = orow >> 6, ap = orow & 63;
          bf16* dst = (plane ? YI : YR) + ((size_t)(bt * 64 + ap) * 128 + b) * 512 + chh * 256 + quarter * 64;
#pragma unroll
          for (int i = 0; i < 8; ++i) *(u32x4*)(dst + 8 * i) = *(const LAS u32x4*)(L + 73728 + orow * 528 + quarter * 128 + i * 16); }
    }
    __syncthreads();
}
__device__ __forceinline__ void p_fft2(const Ctx& C) {
    PH_IDS;
    LAS unsigned char* L = C.lds;
    const int t = tid, w = wave, mb = w & 3, nh = w >> 2, hh = lane >> 5;
    const bf16* F2 = (const bf16*)(C.ws + WS_F2);
    bf16x8 af[16];
#pragma unroll
    for (int ks = 0; ks < 16; ++ks) af[ks] = *(const bf16x8*)(F2 + (32 * mb + (lane & 31)) * 256 + 16 * ks + 8 * hh);
    const bf16* YR = (const bf16*)(C.ws + WS_YR); const bf16* YI = (const bf16*)(C.ws + WS_YI);
    unsigned char* A2 = (unsigned char*)(C.ws + WS_A2);
    const int blk = (lane >> 4) & 1, q4 = (lane & 15) >> 2, p4 = lane & 3;
    u32x4 pv[8];
    auto fetch2 = [&](int unit) { const int bt = unit >> 8, ap = (unit >> 2) & 63, cht = unit & 3; const int row = t >> 1, half = t & 1, pin = row >> 7, b = row & 127;
        const bf16* src = (pin ? YI : YR) + ((size_t)(bt * 64 + ap) * 128 + b) * 512 + cht * 128 + half * 64;
#pragma unroll
        for (int i = 0; i < 8; ++i) pv[i] = *(const u32x4*)(src + 8 * i); };
    if ((int)blockIdx.x < 2048) fetch2(blockIdx.x);
    for (int unit = blockIdx.x; unit < 2048; unit += C.G) {
        const int bt = unit >> 8, ap = (unit >> 2) & 63, cht = unit & 3;
        __syncthreads();
        { const int row = t >> 1, half = t & 1;
#pragma unroll
          for (int i = 0; i < 8; ++i) *(LAS u32x4*)(L + row * 320 + half * 128 + i * 16) = pv[i]; }
        __syncthreads();
        if (unit + C.G < 2048) fetch2(unit + C.G);
#pragma unroll 1
        for (int nb = 0; nb < 2; ++nb) {
            const int c = 2 * nh + nb;
            f32x16 acc;
#pragma unroll
            for (int i = 0; i < 16; ++i) acc[i] = 0.f;
#pragma unroll
            for (int ks = 0; ks < 16; ++ks) {
                LAS unsigned char* pb = L + (16 * ks + 8 * hh + q4) * 320 + (32 * c + 16 * blk + 4 * p4) * 2;
                const bf16x8 bfr = gla::tr8(pb, pb + 4 * 320);
                acc = __builtin_amdgcn_mfma_f32_32x32x16_bf16(af[ks], bfr, acc, 0, 0, 0); }
#pragma unroll
            for (int r = 0; r < 16; ++r) { const int bp = 32 * mb + (r & 3) + 8 * (r >> 2) + 4 * hh;
                if (F8_OUT0) *(LAS unsigned char*)(L + 81920 + bp * 144 + 32 * c + (lane & 31)) = (unsigned char)(pk4_fp8(acc[r], 0.f, 0.f, 0.f, 8.0f / 1024.0f) & 0xffu);
                else *(LAS unsigned short*)(L + 81920 + bp * 272 + (32 * c + (lane & 31)) * 2) = (unsigned short)f2bf(acc[r] * (1.0f / 1024.0f)); }
        }
        __syncthreads();
        { const int bp = t >> 2, quarter = t & 3; const size_t tok = (size_t)bt * SEQ + ap + 64 * bp;
          if (F8_OUT0) { unsigned char* dst = A2 + tok * 1536 + 1024 + cht * 128 + quarter * 32;
#pragma unroll
              for (int i = 0; i < 2; ++i) *(u32x4*)(dst + 16 * i) = *(const LAS u32x4*)(L + 81920 + bp * 144 + quarter * 32 + i * 16); }
          else { bf16* dst = (bf16*)A2 + tok * 1536 + 1024 + cht * 128 + quarter * 32;
#pragma unroll
              for (int i = 0; i < 4; ++i) *(u32x4*)(dst + 8 * i) = *(const LAS u32x4*)(L + 81920 + bp * 272 + quarter * 64 + i * 16); } }
    }
    __syncthreads();
}
__device__ __forceinline__ void p_gla_out(const Ctx& C) {
    PH_IDS;
    const int gw = blockIdx.x * 8 + wave, NGW = C.G * 8;
    const bf16* OF = (const bf16*)(C.ws + WS_OF); const bf16* OB = (const bf16*)(C.ws + WS_OB); const bf16* Rg = (const bf16*)(C.ws + WS_R);
    unsigned char* A2 = (unsigned char*)(C.ws + WS_A2);
    float gn[16];
#pragma unroll
    for (int i = 0; i < 16; ++i) gn[i] = C.a->in[IN_EVGNORM][16 * (lane & 15) + i];
    for (int r = gw; r < MTOK; r += NGW) {
        const u32x4 f0 = *(const u32x4*)(OF + (size_t)r * 1024 + 16 * lane), f1 = *(const u32x4*)(OF + (size_t)r * 1024 + 16 * lane + 8);
        const u32x4 b0 = *(const u32x4*)(OB + (size_t)r * 1024 + 16 * lane), b1 = *(const u32x4*)(OB + (size_t)r * 1024 + 16 * lane + 8);
        const u32x4 g0 = *(const u32x4*)(Rg + (size_t)r * 1024 + 16 * lane), g1 = *(const u32x4*)(Rg + (size_t)r * 1024 + 16 * lane + 8);
        float o[16], rr[16];
#pragma unroll
        for (int i = 0; i < 4; ++i) { const unsigned fa = f0[i], fb = f1[i], ba = b0[i], bb = b1[i], ga = g0[i], gb = g1[i];
            o[2 * i] = bf_lo(fa) + bf_lo(ba); o[2 * i + 1] = bf_hi(fa) + bf_hi(ba); o[8 + 2 * i] = bf_lo(fb) + bf_lo(bb); o[8 + 2 * i + 1] = bf_hi(fb) + bf_hi(bb);
            rr[2 * i] = bf_lo(ga); rr[2 * i + 1] = bf_hi(ga); rr[8 + 2 * i] = bf_lo(gb); rr[8 + 2 * i + 1] = bf_hi(gb); }
        float ss = 0.f;
#pragma unroll
        for (int i = 0; i < 16; ++i) ss += o[i] * o[i];
        ss = row16_sum(ss);
        const float rstd = rsqrtf(ss * (1.0f / 256.0f) + EPS);
        float y[16];
#pragma unroll
        for (int i = 0; i < 16; ++i) y[i] = o[i] * rstd * gn[i] * siluf_(rr[i]);
        if (F8_OUT0) *(u32x4*)(A2 + (size_t)r * 1536 + 16 * lane) = (u32x4){pk4_fp8(y[0], y[1], y[2], y[3], 8.f), pk4_fp8(y[4], y[5], y[6], y[7], 8.f), pk4_fp8(y[8], y[9], y[10], y[11], 8.f), pk4_fp8(y[12], y[13], y[14], y[15], 8.f)};
        else { bf16* a2 = (bf16*)A2 + (size_t)r * 1536 + 16 * lane;
            *(u32x4*)a2 = (u32x4){cvt_pk(y[0], y[1]), cvt_pk(y[2], y[3]), cvt_pk(y[4], y[5]), cvt_pk(y[6], y[7])}; *(u32x4*)(a2 + 8) = (u32x4){cvt_pk(y[8], y[9]), cvt_pk(y[10], y[11]), cvt_pk(y[12], y[13]), cvt_pk(y[14], y[15])}; }
    }
}

__device__ __forceinline__ void p_postmix(const Ctx& C, const int layer) {
    PH_IDS;
    LAS float* WR = (LAS float*)C.lds;
    LAS int* hist = (LAS int*)(C.lds + 131072);
    LAS float* Lg = (LAS float*)(C.lds + 131584 + wave * 2112);
    const float* rw = C.a->in[IN_RW] + (size_t)layer * 1024 * 32;
    __syncthreads();
    for (int it0 = 0; it0 < 64; it0 += 16) {
        float tmpw[16];
#pragma unroll
        for (int q = 0; q < 16; ++q) tmpw[q] = rw[tid + 512 * (it0 + q)];
#pragma unroll
        for (int q = 0; q < 16; ++q) { const int idx = tid + 512 * (it0 + q); const int c = idx >> 5, e = idx & 31; const int ln = (c & 255) >> 2, j = c >> 8, i = c & 3;
            WR[(((j * 4 + i) * 8 + (e >> 2)) * 64 + ln) * 4 + (e & 3)] = tmpw[q]; } }
    if (tid < 32) hist[tid] = 0;
    __syncthreads();
    const float* MOD = (const float*)(C.ws + WS_MOD) + (size_t)layer * 9 * 6144;
    const float* gpost = C.a->in[IN_NMPOST] + layer * 1024; const float* gffn = C.a->in[IN_NFPRE] + layer * 1024;
    const bf16* Y = (const bf16*)(C.ws + WS_Y);
    const float* xin = C.a->in[IN_X];
    bf16* XS = (bf16*)(C.ws + WS_XS);
    unsigned char* H2 = (unsigned char*)(C.ws + WS_H2);
    int* TK = (int*)(C.ws + WS_TOPK); float* GT = (float*)(C.ws + WS_GATE);
    const int rows_per_blk = MTOK / C.G, rows_per_wave = rows_per_blk / 8;
    const int r0 = blockIdx.x * rows_per_blk + wave * rows_per_wave;
    const int b = r0 >> 13;
    const float rbias = C.a->in[IN_RB][layer * 32 + ((lane >> 1) & 31)];
    float cA1[16], cA2[16], cB2[16];
#pragma unroll
    for (int j = 0; j < 4; ++j) { const int c = 4 * lane + 256 * j;
        const f32x4 gp = *(const f32x4*)(gpost + c), gm = *(const f32x4*)(MOD + (size_t)b * 6144 + 2048 + c);
        const f32x4 gf = *(const f32x4*)(gffn + c), sc = *(const f32x4*)(MOD + (size_t)b * 6144 + 4096 + c), sh = *(const f32x4*)(MOD + (size_t)b * 6144 + 3072 + c);
#pragma unroll
        for (int i = 0; i < 4; ++i) { cA1[4 * j + i] = gp[i] * gm[i]; cA2[4 * j + i] = gf[i] * (1.0f + sc[i]); cB2[4 * j + i] = sh[i]; } }
    auto ldx = [&](int r, int j) -> f32x4 {
        if (layer == 0) return *(const f32x4*)(xin + (size_t)r * 1024 + 4 * lane + 256 * j);
        const u32x2 v = *(const u32x2*)(XS + (size_t)r * 1024 + 4 * lane + 256 * j); return (f32x4){bf_lo(v.x), bf_hi(v.x), bf_lo(v.y), bf_hi(v.y)}; };
    u32x2 ny[4]; f32x4 nx[4];
#pragma unroll
    for (int j = 0; j < 4; ++j) { ny[j] = *(const u32x2*)(Y + (size_t)r0 * 1024 + 4 * lane + 256 * j); nx[j] = ldx(r0, j); }
    for (int r = r0; r < r0 + rows_per_wave; ++r) {
        float h[16];
        u32x2 cy[4]; f32x4 cx[4];
#pragma unroll
        for (int j = 0; j < 4; ++j) { cy[j] = ny[j]; cx[j] = nx[j]; }
        if (r + 1 < r0 + rows_per_wave) {
#pragma unroll
            for (int j = 0; j < 4; ++j) { ny[j] = *(const u32x2*)(Y + (size_t)(r + 1) * 1024 + 4 * lane + 256 * j); nx[j] = ldx(r + 1, j); } }
        { float ssy = 0.f; float yv[16];
#pragma unroll
          for (int j = 0; j < 4; ++j) { const u32x2 yy = cy[j];
              yv[4 * j] = bf_lo(yy.x); yv[4 * j + 1] = bf_hi(yy.x); yv[4 * j + 2] = bf_lo(yy.y); yv[4 * j + 3] = bf_hi(yy.y); }
#pragma unroll
          for (int i = 0; i < 16; ++i) ssy += yv[i] * yv[i];
          const float rstd = rsqrtf(wave_sum(ssy) * (1.0f / 1024.0f) + EPS);
          float ss1 = 0.f;
#pragma unroll
          for (int j = 0; j < 4; ++j) { const int c = 4 * lane + 256 * j;
              const f32x4 xv = cx[j];
              f32x4 o;
#pragma unroll
              for (int i = 0; i < 4; ++i) { o[i] = xv[i] + cA1[4 * j + i] * (yv[4 * j + i] * rstd); h[4 * j + i] = o[i]; ss1 += o[i] * o[i]; }
              { u32x2 xw; xw.x = cvt_pk(o[0], o[1]); xw.y = cvt_pk(o[2], o[3]); *(u32x2*)(XS + (size_t)r * 1024 + c) = xw; } }
          const float rstd1 = rsqrtf(wave_sum(ss1) * (1.0f / 1024.0f) + EPS);
#pragma unroll
          for (int j = 0; j < 4; ++j) { const int c = 4 * lane + 256 * j;
#pragma unroll
              for (int i = 0; i < 4; ++i) h[4 * j + i] = h[4 * j + i] * rstd1 * cA2[4 * j + i] + cB2[4 * j + i];
              int wv = 0;
              wv = __builtin_amdgcn_cvt_pk_fp8_f32(fminf(fmaxf(h[4 * j] * 8.0f, -440.f), 440.f), fminf(fmaxf(h[4 * j + 1] * 8.0f, -440.f), 440.f), wv, false);
              wv = __builtin_amdgcn_cvt_pk_fp8_f32(fminf(fmaxf(h[4 * j + 2] * 8.0f, -440.f), 440.f), fminf(fmaxf(h[4 * j + 3] * 8.0f, -440.f), 440.f), wv, true);
              *(int*)(H2 + (size_t)r * 1024 + c) = wv; } }
        float p[32];
#pragma unroll
        for (int e = 0; e < 32; ++e) p[e] = 0.f;
#pragma unroll
        for (int jj = 0; jj < 16; ++jj) {
#pragma unroll
            for (int eq = 0; eq < 8; ++eq) { const f32x4 wv = *(const LAS f32x4*)(WR + ((jj * 8 + eq) * 64 + lane) * 4);
#pragma unroll
                for (int i = 0; i < 4; ++i) p[4 * eq + i] += h[jj] * wv[i]; }
            asm volatile("" ::: "memory"); }
        float q16[16], q8[8], q4v[4], q2[2], q1;
#pragma unroll
        for (int k = 0; k < 16; ++k) q16[k] = swap32_sum(p[k], p[16 + k]);
#pragma unroll
        for (int k = 0; k < 8; ++k) q8[k] = swap16_sum(q16[k], q16[8 + k]);
        { const bool hi = (lane & 8) != 0;
#pragma unroll
          for (int k = 0; k < 4; ++k) { const float send = hi ? q8[k] : q8[4 + k], keep = hi ? q8[4 + k] : q8[k];
              q4v[k] = keep + __builtin_bit_cast(float, __builtin_amdgcn_update_dpp(0, __builtin_bit_cast(int, send), 0x128, 0xF, 0xF, true)); } }
        { const bool hi = (lane & 4) != 0;
#pragma unroll
          for (int k = 0; k < 2; ++k) { const float send = hi ? q4v[k] : q4v[2 + k], keep = hi ? q4v[2 + k] : q4v[k];
              int rv = __builtin_amdgcn_update_dpp(0, __builtin_bit_cast(int, send), 0x104, 0xF, 0x5, false);
              rv = __builtin_amdgcn_update_dpp(rv, __builtin_bit_cast(int, send), 0x114, 0xF, 0xA, false);
              q2[k] = keep + __builtin_bit_cast(float, rv); } }
        { const bool hi = (lane & 2) != 0; const float send = hi ? q2[0] : q2[1], keep = hi ? q2[1] : q2[0];
          q1 = keep + __builtin_bit_cast(float, __builtin_amdgcn_update_dpp(0, __builtin_bit_cast(int, send), 0x4E, 0xF, 0xF, true)); }
        q1 += __builtin_bit_cast(float, __builtin_amdgcn_update_dpp(0, __builtin_bit_cast(int, q1), 0xB1, 0xF, 0xF, true));
        const int rl = (r - r0) & 15;
        if (!(lane & 1)) Lg[rl * 33 + (lane >> 1)] = q1 + rbias;
        if (rl == 15) {
            asm volatile("s_waitcnt lgkmcnt(0)" ::: "memory");
            if (lane < 16) {
                float v0 = -3.0e38f, v1 = -3.0e38f, v2 = -3.0e38f, v3 = -3.0e38f; int i0 = 0, i1 = 0, i2 = 0, i3 = 0;
#pragma unroll
                for (int e = 0; e < 32; ++e) { const float x = Lg[lane * 33 + e];
                    const bool c0 = x > v0, c1 = x > v1, c2 = x > v2, c3 = x > v3;
                    v3 = c3 ? (c2 ? v2 : x) : v3; i3 = c3 ? (c2 ? i2 : e) : i3;
                    v2 = c2 ? (c1 ? v1 : x) : v2; i2 = c2 ? (c1 ? i1 : e) : i2;
                    v1 = c1 ? (c0 ? v0 : x) : v1; i1 = c1 ? (c0 ? i0 : e) : i1;
                    v0 = c0 ? x : v0; i0 = c0 ? e : i0; }
                const float e1 = __expf(v1 - v0), e2 = __expf(v2 - v0), e3 = __expf(v3 - v0); const float inv = 1.0f / (1.0f + e1 + e2 + e3);
                const int rr = r - 15 + lane;
                *(int4*)(TK + (size_t)rr * 4) = make_int4(i0, i1, i2, i3); *(f32x4*)(GT + (size_t)rr * 4) = (f32x4){inv, e1 * inv, e2 * inv, e3 * inv};
                __hip_atomic_fetch_add(&hist[i0], 1, __ATOMIC_RELAXED, __HIP_MEMORY_SCOPE_WORKGROUP); __hip_atomic_fetch_add(&hist[i1], 1, __ATOMIC_RELAXED, __HIP_MEMORY_SCOPE_WORKGROUP);
                __hip_atomic_fetch_add(&hist[i2], 1, __ATOMIC_RELAXED, __HIP_MEMORY_SCOPE_WORKGROUP); __hip_atomic_fetch_add(&hist[i3], 1, __ATOMIC_RELAXED, __HIP_MEMORY_SCOPE_WORKGROUP);
            }
            asm volatile("s_waitcnt lgkmcnt(0)" ::: "memory");
        }
    }
    __syncthreads();
    if (tid < 32) ((int*)(C.ws + WS_CNTBLK))[blockIdx.x * 32 + tid] = hist[tid];
    __syncthreads();
}
__device__ __forceinline__ void p_assign(const Ctx& C) {
    PH_IDS;
    LAS int* red = (LAS int*)C.lds;
    LAS int* base = (LAS int*)(C.lds + 4096);
    LAS int* total = (LAS int*)(C.lds + 4224);
    LAS int* segrow = (LAS int*)(C.lds + 4352);
    LAS int* run = (LAS int*)(C.lds + 4608);
    const int* cnt = (const int*)(C.ws + WS_CNTBLK);
    const int b = blockIdx.x;
    __syncthreads();
    { const int e = tid & 31, part = tid >> 5; int slt = 0, sall = 0;
      int vv[16];
#pragma unroll
      for (int q = 0; q < 16; ++q) vv[q] = __hip_atomic_load(cnt + (part * 16 + q) * 32 + e, __ATOMIC_RELAXED, __HIP_MEMORY_SCOPE_AGENT);
#pragma unroll
      for (int q = 0; q < 16; ++q) { sall += vv[q]; if (part * 16 + q < b) slt += vv[q]; }
      red[part * 32 + e] = slt; red[512 + part * 32 + e] = sall; }
    __syncthreads();
    if (tid < 32) { int s0 = 0, s1 = 0;
#pragma unroll
        for (int q = 0; q < 16; ++q) { s0 += red[q * 32 + tid]; s1 += red[512 + q * 32 + tid]; }
        base[tid] = s0; total[tid] = s1; run[tid] = 0; }
    __syncthreads();
    if (tid == 0) { int acc = 0; for (int e = 0; e < 32; ++e) { segrow[e] = acc * 256; if (b == 0) ((int*)(C.ws + WS_MOEINFO))[e] = acc; acc += (total[e] + 255) >> 8; } segrow[32] = acc * 256; if (b == 0) ((int*)(C.ws + WS_MOEINFO))[32] = acc; }
    __syncthreads();
    int* SP = (int*)(C.ws + WS_SLOTPOS); int* ST = (int*)(C.ws + WS_SLOTTOK); const int* TK = (const int*)(C.ws + WS_TOPK);
    const int rows_per_blk = MTOK / C.G;
    LAS int* gc = (LAS int*)(C.lds + 5120);
    int ge[2], grk[2], grow[2];
#pragma unroll
    for (int q = 0; q < 2; ++q) {
        const int g = 2 * wave + q, sidx = g * 64 + lane; grow[q] = b * rows_per_blk + (sidx >> 2);
        ge[q] = TK[(size_t)grow[q] * 4 + (sidx & 3)];
        int rk = 0, myc = 0;
        for (int ee = 0; ee < 32; ++ee) { const unsigned long long m = __ballot(ge[q] == ee);
            if (ge[q] == ee) rk = __popcll(m & ((1ull << lane) - 1ull));
            if (lane == ee) myc = __popcll(m); }
        grk[q] = rk;
        if (lane < 32) gc[g * 32 + lane] = myc;
    }
    __syncthreads();
#pragma unroll
    for (int q = 0; q < 2; ++q) {
        const int g = 2 * wave + q, sidx = g * 64 + lane; int off = 0;
        for (int gp = 0; gp < g; ++gp) off += gc[gp * 32 + ge[q]];
        const int pos = segrow[ge[q]] + base[ge[q]] + off + grk[q];
        SP[(size_t)grow[q] * 4 + (sidx & 3)] = pos; ST[pos] = grow[q];
    }
    if (b < 32) { const int e = b, tot = total[e], first = segrow[e] + tot, last = segrow[e + 1];
        for (int p = first + tid; p < last; p += 512) ST[p] = 0; }
    __syncthreads();
}

__device__ __forceinline__ void p_combine(const Ctx& C, const int layer) {
    PH_IDS;
    const int gw = blockIdx.x * 8 + wave, NGW = C.G * 8;
    const int per = MTOK / NGW;
    const float* MOD = (const float*)(C.ws + WS_MOD) + (size_t)layer * 9 * 6144;
    const float* MODN = (const float*)(C.ws + WS_MOD) + (size_t)9 * 6144;
    const float* gpost = C.a->in[IN_NFPOST] + layer * 1024; const float* gpre1 = C.a->in[IN_NMPRE] + 1024;
    const unsigned char* YS = (const unsigned char*)(C.ws + WS_YSLOT); const int* SP = (const int*)(C.ws + WS_SLOTPOS); const float* GT = (const float*)(C.ws + WS_GATE);
    float* OUT = C.a->out; bf16* XS = (bf16*)(C.ws + WS_XS); unsigned char* HN = (unsigned char*)(C.ws + WS_HN);
    int curb = -1; float cA1[16], cA2[16], cB2[16]; const int vz = vzero();
    const int rbeg = gw * per, rend = gw * per + per;
    int4 npos = *(const int4*)(SP + (size_t)(rbeg + vz) * 4); f32x4 ngt = *(const f32x4*)(GT + (size_t)(rbeg + vz) * 4);
    unsigned nys[4][4]; u32x2 nxv[4]; f32x4 cgt = ngt;
    { const int pp[4] = {npos.x, npos.y, npos.z, npos.w};
#pragma unroll
      for (int k = 0; k < 4; ++k)
#pragma unroll
          for (int j = 0; j < 4; ++j) nys[k][j] = *(const unsigned*)(YS + (size_t)pp[k] * 1024 + 4 * lane + 256 * j);
#pragma unroll
      for (int j = 0; j < 4; ++j) nxv[j] = *(const u32x2*)(XS + (size_t)rbeg * 1024 + 4 * lane + 256 * j); }
    if (rbeg + 1 < rend) { npos = *(const int4*)(SP + (size_t)(rbeg + 1 + vz) * 4); ngt = *(const f32x4*)(GT + (size_t)(rbeg + 1 + vz) * 4); }
    for (int r = rbeg; r < rend; ++r) {
        const int b = r >> 13;
        if (b != curb) { curb = b;
#pragma unroll
            for (int j = 0; j < 4; ++j) { const int c = 4 * lane + 256 * j;
                const f32x4 gp = *(const f32x4*)(gpost + c), gf = *(const f32x4*)(MOD + (size_t)b * 6144 + 5120 + c);
                const f32x4 gg = *(const f32x4*)(gpre1 + c), sc = *(const f32x4*)(MODN + (size_t)b * 6144 + 1024 + c), sh = *(const f32x4*)(MODN + (size_t)b * 6144 + c);
#pragma unroll
                for (int i = 0; i < 4; ++i) { cA1[4 * j + i] = gp[i] * gf[i]; cA2[4 * j + i] = gg[i] * (1.0f + sc[i]); cB2[4 * j + i] = sh[i]; } } }
        unsigned ys[4][4]; u32x2 xc[4]; const f32x4 gt = cgt;
#pragma unroll
        for (int k = 0; k < 4; ++k)
#pragma unroll
            for (int j = 0; j < 4; ++j) ys[k][j] = nys[k][j];
#pragma unroll
        for (int j = 0; j < 4; ++j) xc[j] = nxv[j];
        if (r + 1 < rend) {
            const int pp[4] = {npos.x, npos.y, npos.z, npos.w}; cgt = ngt;
#pragma unroll
            for (int k = 0; k < 4; ++k)
#pragma unroll
                for (int j = 0; j < 4; ++j) nys[k][j] = *(const unsigned*)(YS + (size_t)pp[k] * 1024 + 4 * lane + 256 * j);
#pragma unroll
            for (int j = 0; j < 4; ++j) nxv[j] = *(const u32x2*)(XS + (size_t)(r + 1) * 1024 + 4 * lane + 256 * j);
            if (r + 2 < rend) { npos = *(const int4*)(SP + (size_t)(r + 2 + vz) * 4); ngt = *(const f32x4*)(GT + (size_t)(r + 2 + vz) * 4); } }
        float f[16];
#pragma unroll
        for (int i = 0; i < 16; ++i) f[i] = 0.f;
#pragma unroll
        for (int k = 0; k < 4; ++k) { const float gk = gt[k] * 0.0625f;
#pragma unroll
            for (int j = 0; j < 4; ++j) { const f32v2_t lo = __builtin_amdgcn_cvt_pk_f32_fp8((int)ys[k][j], false), hi = __builtin_amdgcn_cvt_pk_f32_fp8((int)ys[k][j], true);
                f[4 * j] += gk * lo[0]; f[4 * j + 1] += gk * lo[1]; f[4 * j + 2] += gk * hi[0]; f[4 * j + 3] += gk * hi[1]; } }
        float ss = 0.f;
#pragma unroll
        for (int i = 0; i < 16; ++i) ss += f[i] * f[i];
        const float rstd = rsqrtf(wave_sum(ss) * (1.0f / 1024.0f) + EPS);
        float x2[16]; float ss2 = 0.f;
#pragma unroll
        for (int j = 0; j < 4; ++j) { const int c = 4 * lane + 256 * j;
            const f32x4 xv = (f32x4){bf_lo(xc[j].x), bf_hi(xc[j].x), bf_lo(xc[j].y), bf_hi(xc[j].y)};
            f32x4 o;
#pragma unroll
            for (int i = 0; i < 4; ++i) { o[i] = xv[i] + cA1[4 * j + i] * (f[4 * j + i] * rstd); x2[4 * j + i] = o[i]; ss2 += o[i] * o[i]; }
            if (layer == 0) { u32x2 xw; xw.x = cvt_pk(o[0], o[1]); xw.y = cvt_pk(o[2], o[3]); *(u32x2*)(XS + (size_t)r * 1024 + c) = xw; }
            else *(f32x4*)(OUT + (size_t)r * 1024 + c) = o; }
        if (layer == 0) {
            const float rstd2 = rsqrtf(wave_sum(ss2) * (1.0f / 1024.0f) + EPS);
#pragma unroll
            for (int j = 0; j < 4; ++j) { const int c = 4 * lane + 256 * j;
                float hv[4];
#pragma unroll
                for (int i = 0; i < 4; ++i) hv[i] = x2[4 * j + i] * rstd2 * cA2[4 * j + i] + cB2[4 * j + i];
                if (F8_IN1) *(unsigned*)(HN + (size_t)r * 1024 + c) = pk4_fp8(hv[0], hv[1], hv[2], hv[3], 8.f);
                else *(u32x2*)((bf16*)HN + (size_t)r * 1024 + c) = (u32x2){cvt_pk(hv[0], hv[1]), cvt_pk(hv[2], hv[3])}; }
        }
    }
}

__device__ __forceinline__ void p_conv(const Ctx& C) {
    PH_IDS;
    LAS unsigned char* L = C.lds;
    constexpr int O_X = 0;
    constexpr int O_W = 63488;
    const int w = wave;
    const bf16* GLU = (const bf16*)(C.ws + WS_GLU); const bf16* ZC1 = (const bf16*)(C.ws + WS_ZC1); const bf16* GB = (const bf16*)(C.ws + WS_GB);
    unsigned char* A2 = (unsigned char*)(C.ws + WS_A2B);
    __syncthreads();
    { float tmpw[31];
#pragma unroll
      for (int q = 0; q < 31; ++q) tmpw[q] = C.a->in[IN_ODDW][tid + 512 * q];
#pragma unroll
      for (int q = 0; q < 31; ++q) { const int i = tid + 512 * q; const int tap = i >> 9, c = i & 511; const int ln = c >> 3, half = (c >> 2) & 1, qq = c & 3;
          *(LAS float*)(L + O_W + (((tap * 2 + half) * 64 + ln) * 4 + qq) * 4) = tmpw[q]; } }
    float cb[8], lg[8], lb[8], sw0[8], sw1[8], sw2[8];
#pragma unroll
    for (int i = 0; i < 8; ++i) { const int c = 8 * lane + i; cb[i] = C.a->in[IN_ODDWB][c]; lg[i] = C.a->in[IN_ODLNG][c]; lb[i] = C.a->in[IN_ODLNB][c];
        sw0[i] = C.a->in[IN_ODSCONV][c]; sw1[i] = C.a->in[IN_ODSCONV][512 + c]; sw2[i] = C.a->in[IN_ODSCONV][1024 + c]; }
    u32x4 px[8];
    auto fetchx = [&](int unit) { const int bt = unit >> 8, t0 = (unit & 255) * 32;
#pragma unroll
        for (int q = 0; q < 8; ++q) { const int i = tid + 512 * q; const int rr = i >> 6, cc = i & 63; const int tl = t0 - 15 + rr;
            px[q] = (u32x4){0u, 0u, 0u, 0u};
            if (i < 62 * 64 && tl >= 0 && tl < SEQ) px[q] = *(const u32x4*)(GLU + (size_t)(bt * SEQ + tl) * 512 + cc * 8); } };
    if ((int)blockIdx.x < 2048) fetchx(blockIdx.x);
    for (int unit = blockIdx.x; unit < 2048; unit += C.G) {
        const int bt = unit >> 8, t0 = (unit & 255) * 32;
        __syncthreads();
#pragma unroll
        for (int q = 0; q < 8; ++q) { const int i = tid + 512 * q; if (i < 62 * 64) *(LAS u32x4*)(L + O_X + (i >> 6) * 1024 + (i & 63) * 16) = px[q]; }
        __syncthreads();
        if (unit + C.G < 2048) fetchx(unit + C.G);
        u32x4 sz0[4], sz1[4], sz2[4], sgb[4];
#pragma unroll
        for (int o = 0; o < 4; ++o) { const int tl = t0 + 4 * w + o; const size_t tok = (size_t)bt * SEQ + tl;
            sz1[o] = *(const u32x4*)(ZC1 + tok * 512 + 8 * lane); sz0[o] = (u32x4){0u, 0u, 0u, 0u}; sz2[o] = (u32x4){0u, 0u, 0u, 0u};
            if (tl >= 64) sz0[o] = *(const u32x4*)(ZC1 + (tok - 64) * 512 + 8 * lane);
            if (tl + 64 < SEQ) sz2[o] = *(const u32x4*)(ZC1 + (tok + 64) * 512 + 8 * lane);
            sgb[o] = *(const u32x4*)(GB + tok * 512 + 8 * lane); }
        float acc[4][8];
#pragma unroll
        for (int o = 0; o < 4; ++o)
#pragma unroll
            for (int i = 0; i < 8; ++i) acc[o][i] = 0.f;
#pragma unroll 1
        for (int tap = 0; tap < 31; ++tap) {
            const f32x4 w0 = *(const LAS f32x4*)(L + O_W + ((tap * 2 + 0) * 64 + lane) * 16), w1 = *(const LAS f32x4*)(L + O_W + ((tap * 2 + 1) * 64 + lane) * 16);
#pragma unroll
            for (int o = 0; o < 4; ++o) {
                const u32x4 xr = *(const LAS u32x4*)(L + O_X + (4 * w + o + tap) * 1024 + lane * 16);
                acc[o][0] += bf_lo(xr[0]) * w0[0]; acc[o][1] += bf_hi(xr[0]) * w0[1]; acc[o][2] += bf_lo(xr[1]) * w0[2]; acc[o][3] += bf_hi(xr[1]) * w0[3];
                acc[o][4] += bf_lo(xr[2]) * w1[0]; acc[o][5] += bf_hi(xr[2]) * w1[1]; acc[o][6] += bf_lo(xr[3]) * w1[2]; acc[o][7] += bf_hi(xr[3]) * w1[3]; }
        }
#pragma unroll
        for (int o = 0; o < 4; ++o) {
            const int tl = t0 + 4 * w + o; const size_t tok = (size_t)bt * SEQ + tl;
            float v[8]; float s = 0.f;
#pragma unroll
            for (int i = 0; i < 8; ++i) { v[i] = acc[o][i] + cb[i]; s += v[i]; }
            const float mu = wave_sum(s) * (1.0f / 512.0f); float q = 0.f;
#pragma unroll
            for (int i = 0; i < 8; ++i) { v[i] -= mu; q += v[i] * v[i]; }
            const float rstd = rsqrtf(wave_sum(q) * (1.0f / 512.0f) + EPS);
            float y[8];
#pragma unroll
            for (int i = 0; i < 8; ++i) y[i] = siluf_(v[i] * rstd * lg[i] + lb[i]);
            if (F8_OUT1) *(u32x2*)(A2 + tok * 1024 + 8 * lane) = (u32x2){pk4_fp8(y[0], y[1], y[2], y[3], 4.f), pk4_fp8(y[4], y[5], y[6], y[7], 4.f)};
            else *(u32x4*)((bf16*)A2 + tok * 1024 + 8 * lane) = (u32x4){cvt_pk(y[0], y[1]), cvt_pk(y[2], y[3]), cvt_pk(y[4], y[5]), cvt_pk(y[6], y[7])};
            const u32x4 z1 = sz1[o], z0 = sz0[o], z2 = sz2[o], gb = sgb[o];
            float zz[8];
#pragma unroll
            for (int i = 0; i < 4; ++i) {
                zz[2 * i] = (sw0[2 * i] * bf_lo(z0[i]) + sw1[2 * i] * bf_lo(z1[i]) + sw2[2 * i] * bf_lo(z2[i])) * bf_lo(gb[i]);
                zz[2 * i + 1] = (sw0[2 * i + 1] * bf_hi(z0[i]) + sw1[2 * i + 1] * bf_hi(z1[i]) + sw2[2 * i + 1] * bf_hi(z2[i])) * bf_hi(gb[i]); }
            if (F8_OUT1) *(u32x2*)(A2 + tok * 1024 + 512 + 8 * lane) = (u32x2){pk4_fp8(zz[0], zz[1], zz[2], zz[3], 4.f), pk4_fp8(zz[4], zz[5], zz[6], zz[7], 4.f)};
            else *(u32x4*)((bf16*)A2 + tok * 1024 + 512 + 8 * lane) = (u32x4){cvt_pk(zz[0], zz[1]), cvt_pk(zz[2], zz[3]), cvt_pk(zz[4], zz[5]), cvt_pk(zz[6], zz[7])};
        }
    }
    __syncthreads();
}

constexpr int NPHASE = 19;
#ifndef RUN_HI
#define RUN_HI NPHASE
#endif
__global__ void __launch_bounds__(512, 2) fwd_kernel(Args args) {
    extern __shared__ __attribute__((aligned(16))) unsigned char lds_raw[];
    Ctx C; C.lds = (LAS unsigned char*)lds_raw;
    C.G = gridDim.x; C.a = &args; C.ws = args.ws;
    volatile LAS unsigned* MISC = (volatile LAS unsigned*)(C.lds + MISC_OFF);
    if (threadIdx.x < 16) MISC[threadIdx.x] = 0u;
    __syncthreads();
    const int lo = args.ph_lo, hi = args.ph_hi;
    const bool multi = (hi - lo) > 1;
    XcdBarrier bar; bar.bar = (unsigned*)(C.ws + WS_CTL) + 4096; bar.x = 0; bar.st = MISC;
    if (multi) bar = xcd_barrier_post((unsigned*)(C.ws + WS_CTL) + 4096, MISC);
#ifndef PH_MASK
#define PH_MASK 0x7FFFF
#endif
#define IN(k) (((PH_MASK >> (k)) & 1) && lo <= (k) && (k) < hi)
#ifndef DUP_MASK
#define DUP_MASK 0
#endif
#ifndef GLA_PROBE
#define GLA_PROBE 0
#endif
#ifndef PROBE_NOEPI
#define PROBE_NOEPI 0
#endif
#define DUPN(k) (((DUP_MASK >> (k)) & 1) ? 2 : 1)
#define SEAM(k) do { if (IN(k) && IN((k) + 1)) xcd_barrier(bar); } while (0)
    LAS unsigned char* ring = C.lds;
    const int cid = blockIdx.x;

    if (IN(0)) for (int rep_ = 0; rep_ < DUPN(0); ++rep_) { p0_adaln(C); p0_fourier_fold(C); p0_convert(C); } SEAM(0);
    if (IN(1)) for (int rep_ = 0; rep_ < DUPN(1); ++rep_) { p_norm0(C); } SEAM(1);
    if (IN(2)) for (int rep_ = 0; rep_ < DUPN(2); ++rep_) { gm::SchedIn0 S{(const char*)(C.ws + WS_HN), (const char*)(C.ws + WS_WIN0), C.G, cid}; gm::EpiIn0 E{C.ws}; gm::gemm_phase<F8_IN0 != 0>(ring, F8_IN0 ? 1024 : 2048, S, E, 0x7C7C7C7C, 0x7A7A7A7A); } SEAM(2);
    if (IN(3)) for (int rep_ = 0; rep_ < DUPN(3); ++rep_) { p_gla_prep(C); if (GLA_PROBE == 1) p_gla_prep(C); if (GLA_PROBE >= 10) p_gla_prep(C, GLA_PROBE - 10); p_fft1(C); if (GLA_PROBE == 2) p_fft1(C); xcd_barrier(bar); p_gla(C); if (GLA_PROBE == 3) p_gla(C); if (GLA_PROBE == 4) p_gla(C, 1); } SEAM(3);
    if (IN(4)) for (int rep_ = 0; rep_ < DUPN(4); ++rep_) { p_fft2(C); p_gla_out(C); } SEAM(4);
    if (IN(5)) for (int rep_ = 0; rep_ < DUPN(5); ++rep_) { gm::SchedDense S{(const char*)(C.ws + WS_A2), (const char*)(C.ws + WS_WOUT0), F8_OUT0 ? 1536 : 3072, 256, 4, C.G, cid}; gm::EpiPlain E{(bf16*)(C.ws + WS_Y), 1024}; gm::gemm_phase<F8_OUT0 != 0>(ring, F8_OUT0 ? 1536 : 3072, S, E, 0x7C7C7C7C, 0x7A7A7A7A); } SEAM(5);
    if (IN(6)) for (int rep_ = 0; rep_ < DUPN(6); ++rep_) { p_postmix(C, 0); } SEAM(6);
    if (IN(7)) { p_assign(C); } SEAM(7);
    if (IN(8)) for (int rep_ = 0; rep_ < DUPN(8); ++rep_) { const int* tsp = (const int*)(C.ws + WS_MOEINFO); const int ln_ = otid() & 63; const int ts = __hip_atomic_load(tsp + (ln_ < 32 ? ln_ : 32), __ATOMIC_RELAXED, __HIP_MEMORY_SCOPE_AGENT);
        gm::SchedMoE S{(const char*)(C.ws + WS_H2), (const char*)(C.ws + WS_WGU), (const int*)(C.ws + WS_SLOTTOK), ts, __builtin_amdgcn_readlane(ts, 32), 8, C.G, cid, (size_t)2048 * 1024, true, args.in[IN_BGU]};
        gm::EpiGU E{(unsigned char*)(C.ws + WS_ACT), args.in[IN_BGU], PROBE_NOEPI ? rep_ : 0}; gm::gemm_phase<true>(ring, 1024, S, E, 0x7C7C7C7C, 0x7A7A7A7A); } SEAM(8);
    if (IN(9)) for (int rep_ = 0; rep_ < DUPN(9); ++rep_) { const int* tsp = (const int*)(C.ws + WS_MOEINFO); const int ln_ = otid() & 63; const int ts = __hip_atomic_load(tsp + (ln_ < 32 ? ln_ : 32), __ATOMIC_RELAXED, __HIP_MEMORY_SCOPE_AGENT);
        gm::SchedMoE S{(const char*)(C.ws + WS_ACT), (const char*)(C.ws + WS_WD), nullptr, ts, __builtin_amdgcn_readlane(ts, 32), 4, C.G, cid, (size_t)1024 * 1024, false, args.in[IN_BD]};
        gm::EpiDown E{(unsigned char*)(C.ws + WS_YSLOT), args.in[IN_BD]}; gm::gemm_phase<true>(ring, 1024, S, E, 0x7D7D7D7D, 0x7A7A7A7A); } SEAM(9);
    if (IN(10)) { p_combine(C, 0); } SEAM(10);
    if (IN(11)) for (int rep_ = 0; rep_ < DUPN(11); ++rep_) { gm::SchedDense S{(const char*)(C.ws + WS_HN), (const char*)(C.ws + WS_WIN1), F8_IN1 ? 1024 : 2048, 256, 10, C.G, cid}; gm::EpiIn1 E{C.ws}; gm::gemm_phase<F8_IN1 != 0>(ring, F8_IN1 ? 1024 : 2048, S, E, 0x7C7C7C7C, 0x7A7A7A7A); } SEAM(11);
    if (IN(12)) for (int rep_ = 0; rep_ < DUPN(12); ++rep_) { p_conv(C); } SEAM(12);
    if (IN(13)) for (int rep_ = 0; rep_ < DUPN(13); ++rep_) { gm::SchedDense S{(const char*)(C.ws + WS_A2B), (const char*)(C.ws + WS_WOUT1), F8_OUT1 ? 1024 : 2048, 256, 4, C.G, cid}; gm::EpiPlain E{(bf16*)(C.ws + WS_Y), 1024}; gm::gemm_phase<F8_OUT1 != 0>(ring, F8_OUT1 ? 1024 : 2048, S, E, 0x7D7D7D7D, 0x7A7A7A7A); } SEAM(13);
    if (IN(14)) { p_postmix(C, 1); } SEAM(14);
    if (IN(15)) { p_assign(C); } SEAM(15);
    if (IN(16)) for (int rep_ = 0; rep_ < DUPN(16); ++rep_) { const int* tsp = (const int*)(C.ws + WS_MOEINFO); const int ln_ = otid() & 63; const int ts = __hip_atomic_load(tsp + (ln_ < 32 ? ln_ : 32), __ATOMIC_RELAXED, __HIP_MEMORY_SCOPE_AGENT);
        gm::SchedMoE S{(const char*)(C.ws + WS_H2), (const char*)(C.ws + WS_WGU) + (size_t)32 * 2048 * 1024, (const int*)(C.ws + WS_SLOTTOK), ts, __builtin_amdgcn_readlane(ts, 32), 8, C.G, cid, (size_t)2048 * 1024, true, args.in[IN_BGU] + 32 * 2048};
        gm::EpiGU E{(unsigned char*)(C.ws + WS_ACT), args.in[IN_BGU] + 32 * 2048, 0}; gm::gemm_phase<true>(ring, 1024, S, E, 0x7C7C7C7C, 0x7A7A7A7A); } SEAM(16);
    if (IN(17)) for (int rep_ = 0; rep_ < DUPN(17); ++rep_) { const int* tsp = (const int*)(C.ws + WS_MOEINFO); const int ln_ = otid() & 63; const int ts = __hip_atomic_load(tsp + (ln_ < 32 ? ln_ : 32), __ATOMIC_RELAXED, __HIP_MEMORY_SCOPE_AGENT);
        gm::SchedMoE S{(const char*)(C.ws + WS_ACT), (const char*)(C.ws + WS_WD) + (size_t)32 * 1024 * 1024, nullptr, ts, __builtin_amdgcn_readlane(ts, 32), 4, C.G, cid, (size_t)1024 * 1024, false, args.in[IN_BD] + 32 * 1024};
        gm::EpiDown E{(unsigned char*)(C.ws + WS_YSLOT), args.in[IN_BD] + 32 * 1024}; gm::gemm_phase<true>(ring, 1024, S, E, 0x7D7D7D7D, 0x7A7A7A7A); } SEAM(17);
    if (IN(18)) { p_combine(C, 1); }
#ifdef DBG_COPY_OFF
    if (lo == 99) { const bf16* src = (const bf16*)(C.ws + (size_t)DBG_COPY_OFF); float* dst = args.out;
        for (size_t i = (size_t)blockIdx.x * 512 + threadIdx.x; i < (size_t)MTOK * 1024; i += (size_t)gridDim.x * 512) dst[i] = bf_lo((unsigned)src[i]); }
#endif
#undef IN
#undef SEAM
}

extern "C" void kernel_launch(void* const* d_in, const int* in_sizes, int n_in, void* d_out, int out_size, void* d_ws, size_t ws_size, hipStream_t stream) {
    static int grid = 0;
    if (grid == 0) {
        if (n_in != 28 || out_size != MTOK * D || ws_size < WS_END) { fprintf(stderr, "kernel_launch: unexpected problem (n_in %d out %d ws %zu need %zu)\n", n_in, out_size, ws_size, (size_t)WS_END); grid = -1; return; }
        int dev = 0, cus = 0, per_cu = 0;
        (void)hipGetDevice(&dev); (void)hipDeviceGetAttribute(&cus, hipDeviceAttributeMultiprocessorCount, dev);
        if (hipFuncSetAttribute((const void*)fwd_kernel, hipFuncAttributeMaxDynamicSharedMemorySize, LDS_BYTES) != hipSuccess) { fprintf(stderr, "kernel_launch: hipFuncSetAttribute failed\n"); grid = -1; return; }
        (void)hipOccupancyMaxActiveBlocksPerMultiprocessor(&per_cu, (const void*)fwd_kernel, 512, LDS_BYTES);
        (void)hipGetLastError();
        grid = cus;
        if (grid != 256 || per_cu < 1) { fprintf(stderr, "kernel_launch: needs a 256-CU device with one resident workgroup per CU (cus %d, per_cu %d)\n", cus, per_cu); grid = -1; return; }
    }
    if (grid < 0) return;
    (void)hipMemsetAsync((char*)d_ws + WS_CTL, 0, CTL_ZERO_BYTES, stream);
    Args a{};
    for (int i = 0; i < 28; ++i) a.in[i] = (const float*)d_in[i];
    a.out = (float*)d_out; a.ws = (unsigned char*)d_ws;
#if N_LAUNCH_MODE == 1
    a.ph_lo = 0; a.ph_hi = NPHASE;
    hipLaunchKernelGGL(fwd_kernel, dim3(grid), dim3(512), LDS_BYTES, stream, a);
#else
    for (int p = 0; p < RUN_HI; ++p) { a.ph_lo = p; a.ph_hi = p + 1; hipLaunchKernelGGL(fwd_kernel, dim3(grid), dim3(512), LDS_BYTES, stream, a); }
#ifdef DBG_COPY_OFF
    a.ph_lo = 99; a.ph_hi = 100; hipLaunchKernelGGL(fwd_kernel, dim3(grid), dim3(512), LDS_BYTES, stream, a);
#endif
#endif
}
```

```cpp
#include <hip/hip_runtime.h>
#include <cstdio>
#include <cstdint>

#ifndef N_LAUNCH_MODE
#define N_LAUNCH_MODE 1
#endif

#ifndef F8_IN0
#define F8_IN0 0
#endif
#ifndef F8_OUT0
#define F8_OUT0 0
#endif
#ifndef F8_IN1
#define F8_IN1 1
#endif
#ifndef F8_OUT1
#define F8_OUT1 1
#endif
#define LAS __attribute__((address_space(3)))
typedef unsigned short bf16;
typedef short bf16x8 __attribute__((ext_vector_type(8)));
typedef short s16x4 __attribute__((ext_vector_type(4)));
typedef float f32x4 __attribute__((ext_vector_type(4)));
typedef float f32x16 __attribute__((ext_vector_type(16)));
typedef unsigned u32x4 __attribute__((ext_vector_type(4)));
typedef unsigned u32x2 __attribute__((ext_vector_type(2)));

constexpr int D = 1024, NB = 8, SEQ = 8192, CTXL = 256;
constexpr int MTOK = NB * SEQ;
constexpr int MCTX = NB * CTXL;
constexpr int MALL = MTOK + MCTX;
constexpr int NE = 32, TOPK = 4;
constexpr int NSLOT_PAD = MTOK * TOPK + NE * 256;
constexpr int N_IN0 = 4352;
constexpr int N_IN1 = 2560;
constexpr float EPS = 1e-6f;

constexpr size_t MiB = 1u << 20;
constexpr size_t WS_CTL = 0, CTL_ZERO_BYTES = 65536;
constexpr size_t WS_MOD = 1 * MiB;
constexpr size_t WS_F1 = 2 * MiB;
constexpr size_t WS_F2 = 2 * MiB + 65536;
constexpr size_t WS_CNTBLK = 3 * MiB;
constexpr size_t WS_MOEINFO = 3 * MiB + 65536;
constexpr size_t WS_TOPK = 4 * MiB;
constexpr size_t WS_GATE = 5 * MiB;
constexpr size_t WS_SLOTPOS = 6 * MiB;
constexpr size_t WS_SLOTTOK = 7 * MiB;
constexpr size_t WS_WIN0 = 10 * MiB;
constexpr size_t WS_WOUT0 = 19 * MiB;
constexpr size_t WS_WIN1 = 22 * MiB;
constexpr size_t WS_WOUT1 = 27 * MiB;
constexpr size_t WS_WGU = 32 * MiB;
constexpr size_t WS_WD = 288 * MiB;
constexpr size_t WS_HN = 416 * MiB;
constexpr size_t WS_B = 548 * MiB;
constexpr size_t WS_ACT = WS_B;
constexpr size_t WS_YSLOT = WS_B + 528 * MiB;
constexpr size_t WS_Q = WS_B, WS_K = WS_B + 64 * MiB, WS_V = WS_B + 130 * MiB, WS_R = WS_B + 262 * MiB;
constexpr size_t WS_ZC = WS_B + 390 * MiB, WS_ZS = WS_B + 454 * MiB, WS_LR = WS_B + 518 * MiB;
constexpr size_t WS_OF = WS_B + 528 * MiB, WS_OB = WS_B + 656 * MiB, WS_YR = WS_B + 784 * MiB, WS_YI = WS_B + 848 * MiB;
constexpr size_t WS_A2 = WS_B;
constexpr size_t WS_Y = WS_B + 528 * MiB;
constexpr size_t WS_H2 = WS_B + 656 * MiB;
constexpr size_t WS_GLU = WS_B, WS_ZC1 = WS_B + 64 * MiB, WS_GB = WS_B + 128 * MiB, WS_A2B = WS_B + 192 * MiB;
constexpr size_t WS_XS = WS_B + 1056 * MiB;
constexpr size_t WS_GQP = WS_B + 1056 * MiB;
constexpr size_t WS_GKPP = WS_GQP + 132 * MiB;
constexpr size_t WS_GSC = WS_GKPP + 132 * MiB;
constexpr size_t WS_GEL = WS_GSC + 66 * MiB;
constexpr size_t WS_END = WS_GEL + 6 * MiB;

constexpr int LDS_BYTES = 155648;
constexpr int MISC_OFF = LDS_BYTES - 256;

__device__ __forceinline__ float bf_lo(unsigned u) { return __uint_as_float(u << 16); }
__device__ __forceinline__ float bf_hi(unsigned u) { return __uint_as_float(u & 0xffff0000u); }
typedef __bf16 bf16v2_t __attribute__((ext_vector_type(2)));
typedef float f32v2_t __attribute__((ext_vector_type(2)));
__device__ __forceinline__ unsigned cvt_pk(float lo, float hi) { const f32v2_t v = {lo, hi}; const bf16v2_t r = __builtin_convertvector(v, bf16v2_t); return __builtin_bit_cast(unsigned, r); }
__device__ __forceinline__ unsigned f2bf(float f) { unsigned u = __float_as_uint(f); return (u + 0x7fffu + ((u >> 16) & 1u)) >> 16; }
__device__ __forceinline__ float swap32_sum(float a, float b) {
    const auto r = __builtin_amdgcn_permlane32_swap(__builtin_bit_cast(unsigned, a), __builtin_bit_cast(unsigned, b), false, false);
    unsigned x = r[0], y = r[1]; asm volatile("" : "+v"(x), "+v"(y));
    return __builtin_bit_cast(float, x) + __builtin_bit_cast(float, y);
}
__device__ __forceinline__ float swap16_sum(float a, float b) {
    const auto r = __builtin_amdgcn_permlane16_swap(__builtin_bit_cast(unsigned, a), __builtin_bit_cast(unsigned, b), false, false);
    unsigned x = r[0], y = r[1]; asm volatile("" : "+v"(x), "+v"(y));
    return __builtin_bit_cast(float, x) + __builtin_bit_cast(float, y);
}
__device__ __forceinline__ float row16_sum(float v) {
    v += __builtin_bit_cast(float, __builtin_amdgcn_update_dpp(0, __builtin_bit_cast(int, v), 0xB1, 0xF, 0xF, true));
    v += __builtin_bit_cast(float, __builtin_amdgcn_update_dpp(0, __builtin_bit_cast(int, v), 0x4E, 0xF, 0xF, true));
    v += __builtin_bit_cast(float, __builtin_amdgcn_update_dpp(0, __builtin_bit_cast(int, v), 0x141, 0xF, 0xF, true));
    v += __builtin_bit_cast(float, __builtin_amdgcn_update_dpp(0, __builtin_bit_cast(int, v), 0x140, 0xF, 0xF, true));
    return v;
}
__device__ __forceinline__ float wave_sum(float v) {
    v = row16_sum(v);
    const int iv = __builtin_bit_cast(int, v);
    const float a = __builtin_bit_cast(float, __builtin_amdgcn_readlane(iv, 0)), b = __builtin_bit_cast(float, __builtin_amdgcn_readlane(iv, 16));
    const float c = __builtin_bit_cast(float, __builtin_amdgcn_readlane(iv, 32)), d = __builtin_bit_cast(float, __builtin_amdgcn_readlane(iv, 48));
    return (a + b) + (c + d);
}
__device__ __forceinline__ unsigned pk4_fp8(float a, float b, float c, float d, float sc) {
    int w = 0;
    w = __builtin_amdgcn_cvt_pk_fp8_f32(__builtin_amdgcn_fmed3f(a * sc, -440.f, 440.f), __builtin_amdgcn_fmed3f(b * sc, -440.f, 440.f), w, false);
    w = __builtin_amdgcn_cvt_pk_fp8_f32(__builtin_amdgcn_fmed3f(c * sc, -440.f, 440.f), __builtin_amdgcn_fmed3f(d * sc, -440.f, 440.f), w, true);
    return (unsigned)w;
}
__device__ __forceinline__ float sigmoidf_(float x) { return __builtin_amdgcn_rcpf(1.0f + __builtin_amdgcn_exp2f(x * -1.4426950408889634f)); }
__device__ __forceinline__ float siluf_(float x) { return x * sigmoidf_(x); }

#define XB_TMO      128
#define XB_XCNT(j)  (256  + 64 * (j))
#define XB_XSUB(j)  (1280 + 64 * (j))
#define XB_XGEN(j)  (2304 + 64 * (j))
#define XB_TOP      3328
#define XB_TOPGEN   3392
#define XCD_BAR_WORDS 3456
#define XB_SPIN_CAP (1u << 18)
__device__ __forceinline__ unsigned xb_ld(unsigned* p)              { return __hip_atomic_load(p, __ATOMIC_RELAXED, __HIP_MEMORY_SCOPE_AGENT); }
__device__ __forceinline__ unsigned xb_add(unsigned* p, unsigned v) { return __hip_atomic_fetch_add(p, v, __ATOMIC_RELAXED, __HIP_MEMORY_SCOPE_AGENT); }
__device__ __forceinline__ unsigned xb_xcc_id() { return (unsigned)__builtin_amdgcn_s_getreg((3 << 11) | 20) & 0xFu; }
#define XB_SPIN(cond, bar) do { unsigned _sp = 0; while (cond) { __builtin_amdgcn_s_sleep(1); \
    if ((++_sp & 255u) == 0u) { if (xb_ld(&(bar)[XB_TMO])) break; if (_sp > XB_SPIN_CAP) { atomicAdd(&(bar)[XB_TMO], 1u); break; } } } } while (0)
struct XcdBarrier { unsigned* bar; unsigned x; volatile LAS unsigned* st; };
__device__ __forceinline__ XcdBarrier xcd_barrier_post(unsigned* bar, volatile LAS unsigned* st) {
    XcdBarrier b; b.bar = bar; b.x = xb_xcc_id(); b.st = st;
    if (threadIdx.x == 0) (void)xb_add(&bar[XB_XCNT(b.x)], 1u);
    return b;
}
__device__ __forceinline__ void xcd_barrier_complete(unsigned* bar, unsigned x, unsigned& nloc, unsigned& nx) {
    const unsigned G = gridDim.x * gridDim.y * gridDim.z;
    unsigned sum, cnt, mine, sp = 0u;
    for (;;) {
        sum = 0u; cnt = 0u; mine = 0u;
#pragma unroll
        for (unsigned j = 0; j < 16; ++j) { const unsigned c = xb_ld(&bar[XB_XCNT(j)]); sum += c; cnt += (c > 0u) ? 1u : 0u; mine = (j == x) ? c : mine; }
        if (sum == G) break;
        __builtin_amdgcn_s_sleep(1);
        if ((++sp & 255u) == 0u) { if (xb_ld(&bar[XB_TMO])) break; if (sp > XB_SPIN_CAP) { atomicAdd(&bar[XB_TMO], 1u); break; } }
    }
    nloc = mine > 0u ? mine : 1u; nx = cnt > 0u ? cnt : 1u;
}
__device__ __forceinline__ void xcd_barrier(const XcdBarrier& b) {
    asm volatile("s_waitcnt vmcnt(0)" ::: "memory");
    __syncthreads();
    if (threadIdx.x == 0) {
        unsigned* bar = b.bar;
        __builtin_amdgcn_s_waitcnt(0);
        unsigned nloc = b.st[0], nx = b.st[1];
        if (nloc == 0u) { xcd_barrier_complete(bar, b.x, nloc, nx); b.st[0] = nloc; b.st[1] = nx; }
        const unsigned old = xb_add(&bar[XB_XSUB(b.x)], 1u);
        const unsigned gen = old / nloc;
        if (old + 1u == (gen + 1u) * nloc) {
            __builtin_amdgcn_fence(__ATOMIC_RELEASE, "agent");
            asm volatile("s_waitcnt vmcnt(0)" ::: "memory");
            const unsigned og = xb_add(&bar[XB_TOP], 1u);
            const unsigned tg = og / nx;
            if (og + 1u == (tg + 1u) * nx) xb_add(&bar[XB_TOPGEN], 1u);
            else XB_SPIN(xb_ld(&bar[XB_TOPGEN]) == tg, bar);
            __builtin_amdgcn_fence(__ATOMIC_ACQUIRE, "agent");
            xb_add(&bar[XB_XGEN(b.x)], 1u);
            asm volatile("s_waitcnt vmcnt(0)" ::: "memory");
        } else {
            XB_SPIN(xb_ld(&bar[XB_XGEN(b.x)]) == gen, bar);
            __builtin_amdgcn_fence(__ATOMIC_ACQUIRE, "agent");
            asm volatile("s_waitcnt vmcnt(0)" ::: "memory");
        }
    }
    __syncthreads();
}

struct Args {
    const float* in[28];
    float* out;
    unsigned char* ws;
    int ph_lo, ph_hi;
};
struct Ctx {
    LAS unsigned char* lds;
    int G;
    const Args* a;
    unsigned char* ws;
};
__device__ __forceinline__ int otid() { int t = (int)threadIdx.x; asm volatile("" : "+v"(t)); return t; }
__device__ __forceinline__ int vzero() { int z = 0; asm volatile("" : "+v"(z)); return z; }
#define PH_IDS const int tid = otid(), lane = tid & 63, wave = __builtin_amdgcn_readfirstlane(tid >> 6); (void)tid; (void)lane; (void)wave
#define IN_X 0
#define IN_C 1
#define IN_CTX 2
#define IN_CCTX 3
#define IN_MODW 4
#define IN_MODB 5
#define IN_NMPRE 6
#define IN_NMPOST 7
#define IN_NFPRE 8
#define IN_NFPOST 9
#define IN_EVWIN 10
#define IN_EVGKUP 11
#define IN_EVGKB 12
#define IN_EVGNORM 13
#define IN_EVWOUT 14
#define IN_ODWIN 15
#define IN_ODDW 16
#define IN_ODDWB 17
#define IN_ODLNG 18
#define IN_ODLNB 19
#define IN_ODSCONV 20
#define IN_ODWOUT 21
#define IN_RW 22
#define IN_RB 23
#define IN_WGU 24
#define IN_BGU 25
#define IN_WD 26
#define IN_BD 27

namespace gm {
constexpr int BM = 256, BK = 64, HALF = 128, HTB = HALF * BK * 2, STAGE_BYTES = 8 * HTB, NXCD = 8, WGM = 8;
constexpr int XT_OFF = 131072;
constexpr int XB_OFF = XT_OFF + 16384;
__device__ __forceinline__ int lds_byte(int r, int c) { const int st = (r >> 4) * 2 + (c >> 5), rr = r & 15, cc = c & 31, ob = rr * 64 + cc * 2; return st * 1024 + (ob ^ (((ob >> 9) & 1) << 5)); }
__device__ __forceinline__ void stage_rc(int b, int& R, int& C) { const int st = b / 1024, sb = b % 1024, swz = sb ^ (((sb >> 9) & 1) << 5); R = (st >> 1) * 16 + swz / 64; C = (st & 1) * 32 + (swz % 64) / 2; }
__device__ __forceinline__ int perm32(int rho) { const int n = rho >> 4, i = rho & 15; return 8 * (i >> 2) + 4 * n + (i & 3); }
struct Unit { int pm, pn, e; };

__device__ __forceinline__ void dense_map(int L, int nM, int nN, int& pm, int& pn) {
    const int nwg = nM * nN; int wgid = L;
    { const int q = nwg / NXCD, r = nwg % NXCD, xcd = wgid % NXCD, off = wgid / NXCD; wgid = (xcd < r ? xcd * (q + 1) : r * (q + 1) + (xcd - r) * q) + off; }
    const int nig = WGM * nN, gid = wgid / nig, fm = gid * WGM, gsz = (nM - fm) < WGM ? (nM - fm) : WGM;
    pm = fm + ((wgid % nig) % gsz); pn = (wgid % nig) / gsz;
}

typedef int i32x8 __attribute__((ext_vector_type(8)));
typedef int i32x4_ __attribute__((ext_vector_type(4)));
template <bool F8, class Epi, class Sched>
__device__ __forceinline__ void gemm_phase(LAS unsigned char* lds, const int RP, const Sched& S, const Epi& E, const int SCA = 0x7F7F7F7F, const int SCB = 0x7F7F7F7F) {
    const int tid = otid(), wid = __builtin_amdgcn_readfirstlane(tid >> 6), lane = tid & 63, wr = wid >> 2, wc = wid & 3, fr = lane & 15, fq = lane >> 4;
    const int nt = RP / 128;
    unsigned voffB[2];
#pragma unroll
    for (int i = 0; i < 2; ++i) { int R, C; stage_rc(tid * 16 + i * 8192, R, C); const int Rb = (R & ~31) + perm32(R & 31); voffB[i] = (unsigned)(Rb * RP + C * 2); }
    const size_t kstep = (size_t)128;
    const size_t hstepB = (size_t)HALF * RP;
    const unsigned ldsw = (unsigned)wid * 1024u;
    const int aoff = F8 ? lds_byte(wr * 64 + fr, (fq >> 1) * 32 + (fq & 1) * 16) : lds_byte(wr * 64 + fr, fq * 8);
    const int boff = F8 ? lds_byte(wc * 32 + fr, (fq >> 1) * 32 + (fq & 1) * 16) : lds_byte(wc * 32 + fr, fq * 8);
    constexpr int KOFF = F8 ? 16 : 1024;
#define G_SA(b, h) (((b) * 2 + (h)) * HTB)
#define G_SB(b, h) ((4 + (b) * 2 + (h)) * HTB)
#define G_STAGEB(bufoff, gbase) do { _Pragma("unroll") for (int _i = 0; _i < 2; ++_i) \
        __builtin_amdgcn_global_load_lds((const unsigned*)((const char*)(gbase) + voffB[_i]), (LAS unsigned*)(lds + (bufoff) + ldsw + _i * 8192), 16, 0, 0); } while (0)
#define G_STAGEA(bufoff, offs, h, kb) do { _Pragma("unroll") for (int _i = 0; _i < 2; ++_i) \
        __builtin_amdgcn_global_load_lds((const unsigned*)(S.abase() + (size_t)(offs)[h][_i] + (kb)), (LAS unsigned*)(lds + (bufoff) + ldsw + _i * 8192), 16, 0, 0); } while (0)
#define G_LDA(dst, b, h) do { _Pragma("unroll") for (int m = 0; m < 4; ++m) _Pragma("unroll") for (int k = 0; k < 2; ++k) dst[m][k] = *(const LAS bf16x8*)(lds + G_SA(b, h) + aoff + m * 2048 + k * KOFF); } while (0)
#define G_LDB(dst, b, h) do { _Pragma("unroll") for (int n = 0; n < 2; ++n) _Pragma("unroll") for (int k = 0; k < 2; ++k) dst[n][k] = *(const LAS bf16x8*)(lds + G_SB(b, h) + boff + n * 2048 + k * KOFF); } while (0)
#define G_CAT8(x) __builtin_shufflevector(__builtin_bit_cast(i32x4_, (x)[0]), __builtin_bit_cast(i32x4_, (x)[1]), 0, 1, 2, 3, 4, 5, 6, 7)
#define G_MMA(ai, bj, At, Bt) do { __builtin_amdgcn_s_setprio(1); \
        if constexpr (F8) { _Pragma("unroll") for (int m = 0; m < 4; ++m) _Pragma("unroll") for (int n = 0; n < 2; ++n) \
            acc[ai][bj][m][n] = __builtin_amdgcn_mfma_scale_f32_16x16x128_f8f6f4(G_CAT8(Bt[n]), G_CAT8(At[m]), acc[ai][bj][m][n], 0, 0, 0, SCB, 0, SCA); } \
        else { _Pragma("unroll") for (int m = 0; m < 4; ++m) _Pragma("unroll") for (int n = 0; n < 2; ++n) _Pragma("unroll") for (int k = 0; k < 2; ++k) \
            acc[ai][bj][m][n] = __builtin_amdgcn_mfma_f32_16x16x32_bf16(Bt[n][k], At[m][k], acc[ai][bj][m][n], 0, 0, 0); } \
        __builtin_amdgcn_s_setprio(0); } while (0)
#define G_WAIT_V(n) asm volatile("s_waitcnt vmcnt(" #n ")" ::: "memory")
#define G_WAIT_L(n) asm volatile("s_waitcnt lgkmcnt(" #n ")" ::: "memory")
#define G_BAR __builtin_amdgcn_s_barrier()
#define G_SCHED __builtin_amdgcn_sched_barrier(0)
    Unit cur, nxt; int ui = 0;
    if (!S.next(0, cur)) return;
    f32x4 acc[2][2][4][2];
#pragma unroll
    for (int a = 0; a < 2; ++a)
#pragma unroll
        for (int b = 0; b < 2; ++b)
#pragma unroll
            for (int m = 0; m < 4; ++m)
#pragma unroll
                for (int n = 0; n < 2; ++n) acc[a][b][m][n] = (f32x4){0.f, 0.f, 0.f, 0.f};
    bf16x8 At[4][2], B0[2][2], B1[2][2];
    unsigned cAo[2][2];
    S.a_off(cur, cAo);
    const char* cB = S.b_ptr(cur);
    S.prefetch_bias(cur, lds, 0, wid, lane, wc);
    G_STAGEB(G_SB(0, 0), cB); G_STAGEA(G_SA(0, 0), cAo, 0, 0); G_STAGEB(G_SB(0, 1), cB + hstepB); G_STAGEA(G_SA(0, 1), cAo, 1, 0);
    if (wr == 1) G_BAR;
    G_WAIT_V(4); G_BAR;
    G_STAGEB(G_SB(1, 0), cB + kstep); G_STAGEA(G_SA(1, 0), cAo, 0, kstep); G_STAGEB(G_SB(1, 1), cB + hstepB + kstep);
    G_WAIT_V(6); G_BAR;
    for (;;) {
        const bool has_next = S.next(ui + 1, nxt);
        const char* nB = cB;
        if (has_next) { S.prefetch_rows(nxt, lds, (ui + 1) & 1, wid, lane); S.prefetch_bias(nxt, lds, (ui + 1) & 1, wid, lane, wc); nB = S.b_ptr(nxt); }
        for (int t = 0; t < nt; t += 2) {
            const bool last = (t == nt - 2);
            const size_t k1 = (size_t)(t + 1) * kstep;
            G_LDB(B0, 0, 0); G_SCHED; G_LDA(At, 0, 0); G_STAGEA(G_SA(1, 1), cAo, 1, k1);
            if (last) { if (has_next) S.a_off_lds(nxt, lds, (ui + 1) & 1, wid, lane, cAo); cB = nB; }
            const size_t k2 = last ? 0 : (size_t)(t + 2) * kstep;
            const size_t k3 = k2 + kstep;
            const char* b2 = cB + k2; const char* b3 = b2 + kstep;
            G_WAIT_L(8); G_BAR; G_WAIT_L(0); G_MMA(0, 0, At, B0); G_BAR; G_SCHED;
            G_LDB(B1, 0, 1); G_STAGEB(G_SB(0, 0), b2);
            G_BAR; G_WAIT_L(0); G_MMA(0, 1, At, B1); G_BAR;
            G_LDA(At, 0, 1); G_STAGEA(G_SA(0, 0), cAo, 0, k2);
            G_BAR; G_WAIT_L(0); G_MMA(1, 0, At, B0); G_BAR; G_SCHED;
            G_STAGEB(G_SB(0, 1), b2 + hstepB);
            G_WAIT_V(6); G_BAR; G_MMA(1, 1, At, B1); G_BAR;
            G_LDB(B0, 1, 0); G_SCHED; G_LDA(At, 1, 0); G_STAGEA(G_SA(0, 1), cAo, 1, k2);
            G_WAIT_L(8); G_BAR; G_WAIT_L(0); G_MMA(0, 0, At, B0); G_BAR; G_SCHED;
            G_LDB(B1, 1, 1); G_STAGEB(G_SB(1, 0), b3);
            G_BAR; G_WAIT_L(0); G_MMA(0, 1, At, B1); G_BAR;
            G_LDA(At, 1, 1); G_STAGEA(G_SA(1, 0), cAo, 0, k3);
            G_BAR; G_WAIT_L(0); G_MMA(1, 0, At, B0); G_BAR; G_SCHED;
            G_STAGEB(G_SB(1, 1), b3 + hstepB);
            G_WAIT_V(6); G_BAR; G_MMA(1, 1, At, B1); G_BAR;
        }
        E(acc, cur, wr, wc, fr, fq, (const LAS float*)(lds + XB_OFF + ((ui & 1) * 8 + wid) * 256));
        if (!has_next) break;
#pragma unroll
        for (int a = 0; a < 2; ++a)
#pragma unroll
            for (int b = 0; b < 2; ++b)
#pragma unroll
                for (int m = 0; m < 4; ++m)
#pragma unroll
                    for (int n = 0; n < 2; ++n) acc[a][b][m][n] = (f32x4){0.f, 0.f, 0.f, 0.f};
        cur = nxt; ++ui;
    }
    G_WAIT_V(0);
    if (wr == 0) G_BAR;
    G_BAR;
#undef G_SA
#undef G_SB
#undef G_STAGEA
#undef G_STAGEB
#undef G_LDA
#undef G_LDB
#undef G_MMA
#undef G_CAT8
#undef G_WAIT_V
#undef G_WAIT_L
#undef G_BAR
#undef G_SCHED
}

__device__ __forceinline__ void lane_rc(int i, int& R, int& Cb) { int C; stage_rc(otid() * 16 + i * 8192, R, C); Cb = C * 2; }

struct SchedDense {
    const char* A; const char* B; int RP, nM, nN, G, c;
    __device__ __forceinline__ const char* abase() const { return A; }
    __device__ __forceinline__ bool next(int i, Unit& u) const { const long L = (long)i * G + c; if (L >= (long)nM * nN) return false; dense_map((int)L, nM, nN, u.pm, u.pn); u.e = 0; return true; }
    __device__ __forceinline__ void a_off(const Unit& u, unsigned (&o)[2][2]) const {
#pragma unroll
        for (int i = 0; i < 2; ++i) { int R, Cb; lane_rc(i, R, Cb);
#pragma unroll
            for (int h = 0; h < 2; ++h) o[h][i] = (unsigned)(u.pm * BM + h * HALF + R) * (unsigned)RP + (unsigned)Cb; }
    }
    __device__ __forceinline__ void prefetch_rows(const Unit&, LAS unsigned char*, int, int, int) const {}
    __device__ __forceinline__ void prefetch_bias(const Unit&, LAS unsigned char*, int, int, int, int) const {}
    __device__ __forceinline__ void a_off_lds(const Unit& u, LAS unsigned char*, int, int, int, unsigned (&o)[2][2]) const { a_off(u, o); }
    __device__ __forceinline__ const char* b_ptr(const Unit& u) const { return B + (size_t)u.pn * BM * RP; }
};
struct SchedIn0 {
    const char* A; const char* B; int G, c;
    __device__ __forceinline__ const char* abase() const { return A; }
    __device__ __forceinline__ bool next(int i, Unit& u) const {
        const long L = (long)i * G + c; u.e = 0;
        if (L < 256 * 17) { dense_map((int)L, 256, 17, u.pm, u.pn); return true; }
        const int r = (int)(L - 256 * 17); if (r >= 56) return false;
        u.pm = 256 + r / 7; const int q = r % 7; u.pn = (q < 6) ? (2 + q) : 16; return true;
    }
    __device__ __forceinline__ void a_off(const Unit& u, unsigned (&o)[2][2]) const {
#pragma unroll
        for (int i = 0; i < 2; ++i) { int R, Cb; lane_rc(i, R, Cb);
#pragma unroll
            for (int h = 0; h < 2; ++h) o[h][i] = (unsigned)(u.pm * BM + h * HALF + R) * (F8_IN0 ? 1024u : 2048u) + (unsigned)Cb; }
    }
    __device__ __forceinline__ void prefetch_rows(const Unit&, LAS unsigned char*, int, int, int) const {}
    __device__ __forceinline__ void prefetch_bias(const Unit&, LAS unsigned char*, int, int, int, int) const {}
    __device__ __forceinline__ void a_off_lds(const Unit& u, LAS unsigned char*, int, int, int, unsigned (&o)[2][2]) const { a_off(u, o); }
    __device__ __forceinline__ const char* b_ptr(const Unit& u) const { return B + (size_t)u.pn * BM * (F8_IN0 ? 1024 : 2048); }
};
struct SchedMoE {
    const char* A; const char* B; const int* slot_tok; int ts; int RT; int nct; int G, c; size_t bstride_e; bool gather; const float* bias;
    __device__ __forceinline__ const char* abase() const { return A; }
    __device__ __forceinline__ bool next(int i, Unit& u) const {
        const int x = c & 7, j = c >> 3; int rt, ct;
        if (nct == 8) { rt = 32 * i + 4 * x + (j & 3); ct = j >> 2; } else { rt = 64 * i + 8 * x + (j & 7); ct = j >> 3; }
        if (rt >= RT) return false;
        const unsigned long long m = __ballot(((otid() & 63) < 32) && ts <= rt);
        u.pm = rt; u.pn = ct; u.e = __builtin_amdgcn_readfirstlane(__popcll(m)) - 1; return true;
    }
    __device__ __forceinline__ void a_off(const Unit& u, unsigned (&o)[2][2]) const {
#pragma unroll
        for (int i = 0; i < 2; ++i) { int R, Cb; lane_rc(i, R, Cb);
#pragma unroll
            for (int h = 0; h < 2; ++h) { const int row = u.pm * BM + h * HALF + R; const unsigned rr = gather ? (unsigned)slot_tok[row] : (unsigned)row; o[h][i] = rr * 1024u + (unsigned)Cb; } }
    }
    __device__ __forceinline__ const char* b_ptr(const Unit& u) const { return B + (size_t)u.e * bstride_e + (size_t)u.pn * BM * 1024; }
    __device__ __forceinline__ void prefetch_rows(const Unit& u, LAS unsigned char* lds, int par, int wid, int lane) const {
        if (!gather) return;
#pragma unroll
        for (int i = 0; i < 2; ++i) { int R, Cb; lane_rc(i, R, Cb);
#pragma unroll
            for (int h = 0; h < 2; ++h) __builtin_amdgcn_global_load_lds((const unsigned*)(slot_tok + (u.pm * BM + h * HALF + R)), (LAS unsigned*)(lds + XT_OFF + ((par * 8 + wid) * 4 + h * 2 + i) * 256), 4, 0, 0); }
    }
    __device__ __forceinline__ void prefetch_bias(const Unit& u, LAS unsigned char* lds, int par, int wid, int lane, int wc) const {
        const float* src = (nct == 8) ? bias + (size_t)u.e * 2048 + (lane >> 5) * 1024 + u.pn * 128 + wc * 32 + (lane & 31)
                                      : bias + (size_t)u.e * 1024 + u.pn * 256 + (lane >> 5) * 128 + wc * 32 + (lane & 31);
        __builtin_amdgcn_global_load_lds((const unsigned*)src, (LAS unsigned*)(lds + XB_OFF + (par * 8 + wid) * 256), 4, 0, 0);
    }
    __device__ __forceinline__ void a_off_lds(const Unit& u, LAS unsigned char* lds, int par, int wid, int lane, unsigned (&o)[2][2]) const {
#pragma unroll
        for (int i = 0; i < 2; ++i) { int R, Cb; lane_rc(i, R, Cb);
#pragma unroll
            for (int h = 0; h < 2; ++h) { const unsigned rr = gather ? *(const LAS unsigned*)(lds + XT_OFF + ((par * 8 + wid) * 4 + h * 2 + i) * 256 + lane * 4) : (unsigned)(u.pm * BM + h * HALF + R); o[h][i] = rr * 1024u + (unsigned)Cb; } }
    }
};

__device__ __forceinline__ void store8(bf16* p, const f32x4& v0, const f32x4& v1) {
    u32x4 w; w.x = cvt_pk(v0[0], v0[1]); w.y = cvt_pk(v0[2], v0[3]); w.z = cvt_pk(v1[0], v1[1]); w.w = cvt_pk(v1[2], v1[3]);
    *(u32x4*)p = w;
}
struct EpiPlain {
    bf16* O; int ldc;
    __device__ __forceinline__ void operator()(const f32x4 (&acc)[2][2][4][2], const Unit& u, int wr, int wc, int fr, int fq, const LAS float* lb) const {
        const int row0 = u.pm * BM + wr * 64 + fr, col0 = u.pn * BM + wc * 32 + 8 * fq;
#pragma unroll
        for (int ai = 0; ai < 2; ++ai)
#pragma unroll
            for (int m = 0; m < 4; ++m) { bf16* rowp = O + (size_t)(row0 + ai * HALF + m * 16) * ldc + col0;
#pragma unroll
                for (int bj = 0; bj < 2; ++bj) store8(rowp + bj * HALF, acc[ai][bj][m][0], acc[ai][bj][m][1]); }
    }
};
struct EpiIn0 {
    unsigned char* ws;
    __device__ __forceinline__ void operator()(const f32x4 (&acc)[2][2][4][2], const Unit& u, int wr, int wc, int fr, int fq, const LAS float* lb) const {
        const int pn = u.pn; bf16* base; int ldc, c0;
        if (pn < 2) { base = (bf16*)(ws + WS_Q); ldc = 512; c0 = pn * 256; }
        else if (pn < 4) { base = (bf16*)(ws + WS_K); ldc = 512; c0 = (pn - 2) * 256; }
        else if (pn < 8) { base = (bf16*)(ws + WS_V); ldc = 1024; c0 = (pn - 4) * 256; }
        else if (pn < 12) { base = (bf16*)(ws + WS_R); ldc = 1024; c0 = (pn - 8) * 256; }
        else if (pn < 14) { base = (bf16*)(ws + WS_ZC); ldc = 512; c0 = (pn - 12) * 256; }
        else if (pn < 16) { base = (bf16*)(ws + WS_ZS); ldc = 512; c0 = (pn - 14) * 256; }
        else { base = (bf16*)(ws + WS_LR); ldc = 32; c0 = 0; }
        const int row0 = u.pm * BM + wr * 64 + fr, col0 = c0 + wc * 32 + 8 * fq;
        const bool lr = (pn == 16);
        if (lr && wc != 0) return;
        const float qs = (pn < 2) ? 0.08838834764831845f : 1.0f;
#pragma unroll
        for (int ai = 0; ai < 2; ++ai)
#pragma unroll
            for (int m = 0; m < 4; ++m) { bf16* rowp = base + (size_t)(row0 + ai * HALF + m * 16) * ldc + col0;
                store8(rowp, acc[ai][0][m][0] * qs, acc[ai][0][m][1] * qs);
                if (!lr) store8(rowp + HALF, acc[ai][1][m][0] * qs, acc[ai][1][m][1] * qs); }
    }
};
struct EpiIn1 {
    unsigned char* ws;
    __device__ __forceinline__ void operator()(const f32x4 (&acc)[2][2][4][2], const Unit& u, int wr, int wc, int fr, int fq, const LAS float* lb) const {
        const int pn = u.pn; const int row0 = u.pm * BM + wr * 64 + fr;
        if (pn >= 8) { bf16* O = (bf16*)(ws + WS_GB); const int col0 = (pn - 8) * 256 + wc * 32 + 8 * fq;
#pragma unroll
            for (int ai = 0; ai < 2; ++ai)
#pragma unroll
                for (int m = 0; m < 4; ++m) { bf16* rowp = O + (size_t)(row0 + ai * HALF + m * 16) * 512 + col0;
#pragma unroll
                    for (int bj = 0; bj < 2; ++bj) store8(rowp + bj * HALF, acc[ai][bj][m][0], acc[ai][bj][m][1]); }
            return; }
        const bool glu = pn < 4; bf16* O = (bf16*)(ws + (glu ? WS_GLU : WS_ZC1)); const int col0 = (pn & 3) * 128 + wc * 32 + 8 * fq;
#pragma unroll
        for (int ai = 0; ai < 2; ++ai)
#pragma unroll
            for (int m = 0; m < 4; ++m) { f32x4 o[2];
#pragma unroll
                for (int n = 0; n < 2; ++n)
#pragma unroll
                    for (int i = 0; i < 4; i += 2) { const f32v2_t a = (f32v2_t){acc[ai][0][m][n][i], acc[ai][0][m][n][i + 1]}, b = (f32v2_t){acc[ai][1][m][n][i], acc[ai][1][m][n][i + 1]};
                        f32v2_t ov;
                        if (glu) { const f32v2_t ea = b * -1.4426950408889634f; f32v2_t e; e.x = __builtin_amdgcn_exp2f(ea.x); e.y = __builtin_amdgcn_exp2f(ea.y);
                            const f32v2_t d = e + 1.0f; f32v2_t r; r.x = __builtin_amdgcn_rcpf(d.x); r.y = __builtin_amdgcn_rcpf(d.y); ov = a * r; }
                        else ov = a * b;
                        o[n][i] = ov.x; o[n][i + 1] = ov.y; }
                store8(O + (size_t)(row0 + ai * HALF + m * 16) * 512 + col0, o[0], o[1]); }
    }
};
struct EpiGU {
    unsigned char* O; const float* bgu; int probe;
    __device__ __forceinline__ void operator()(const f32x4 (&acc)[2][2][4][2], const Unit& u, int wr, int wc, int fr, int fq, const LAS float* lb) const {
        if (probe) {
#pragma unroll
            for (int a = 0; a < 2; ++a)
#pragma unroll
                for (int b = 0; b < 2; ++b)
#pragma unroll
                    for (int m = 0; m < 4; ++m)
#pragma unroll
                        for (int n = 0; n < 2; ++n) asm volatile("" :: "v"(acc[a][b][m][n]));
            return; }
        const int row0 = u.pm * BM + wr * 64 + fr, col0 = u.pn * 128 + wc * 32 + 8 * fq;
        f32x4 bgv[2], buv[2];
#pragma unroll
        for (int n = 0; n < 2; ++n) { bgv[n] = *(const LAS f32x4*)(lb + 8 * fq + 4 * n); buv[n] = *(const LAS f32x4*)(lb + 32 + 8 * fq + 4 * n); }
#pragma unroll
        for (int ai = 0; ai < 2; ++ai)
#pragma unroll
            for (int m = 0; m < 4; ++m) { f32x4 o[2];
#pragma unroll
                for (int n = 0; n < 2; ++n)
#pragma unroll
                    for (int i = 0; i < 4; i += 2) {
                        f32v2_t g = (f32v2_t){acc[ai][0][m][n][i], acc[ai][0][m][n][i + 1]} + (f32v2_t){bgv[n][i], bgv[n][i + 1]};
                        f32v2_t uu = (f32v2_t){acc[ai][1][m][n][i], acc[ai][1][m][n][i + 1]} + (f32v2_t){buv[n][i], buv[n][i + 1]};
                        g.x = fminf(g.x, 7.0f); g.y = fminf(g.y, 7.0f);
                        uu.x = __builtin_amdgcn_fmed3f(uu.x, -7.0f, 7.0f); uu.y = __builtin_amdgcn_fmed3f(uu.y, -7.0f, 7.0f);
                        const f32v2_t ea = g * (-1.702f * 1.4426950408889634f);
                        f32v2_t e; e.x = __builtin_amdgcn_exp2f(ea.x); e.y = __builtin_amdgcn_exp2f(ea.y);
                        const f32v2_t d = e + 1.0f;
                        f32v2_t r; r.x = __builtin_amdgcn_rcpf(d.x); r.y = __builtin_amdgcn_rcpf(d.y);
                        const f32v2_t t4 = uu * 4.0f + 4.0f;
                        const f32v2_t ov = (g * r) * t4;
                        o[n][i] = ov.x; o[n][i + 1] = ov.y; }
                int w0 = 0, w1 = 0;
                w0 = __builtin_amdgcn_cvt_pk_fp8_f32(o[0][0], o[0][1], w0, false); w0 = __builtin_amdgcn_cvt_pk_fp8_f32(o[0][2], o[0][3], w0, true);
                w1 = __builtin_amdgcn_cvt_pk_fp8_f32(o[1][0], o[1][1], w1, false); w1 = __builtin_amdgcn_cvt_pk_fp8_f32(o[1][2], o[1][3], w1, true);
                *(u32x2*)(O + (size_t)(row0 + ai * HALF + m * 16) * 1024 + col0) = (u32x2){(unsigned)w0, (unsigned)w1}; }
    }
};
struct EpiDown {
    unsigned char* O; const float* bd;
    __device__ __forceinline__ void operator()(const f32x4 (&acc)[2][2][4][2], const Unit& u, int wr, int wc, int fr, int fq, const LAS float* lb) const {
        const int row0 = u.pm * BM + wr * 64 + fr, col0 = u.pn * BM + wc * 32 + 8 * fq;
        f32x4 bv[2][2];
#pragma unroll
        for (int bj = 0; bj < 2; ++bj)
#pragma unroll
            for (int n = 0; n < 2; ++n) bv[bj][n] = *(const LAS f32x4*)(lb + 32 * bj + 8 * fq + 4 * n) * 16.0f;
#pragma unroll
        for (int ai = 0; ai < 2; ++ai)
#pragma unroll
            for (int m = 0; m < 4; ++m) { unsigned char* rowp = O + (size_t)(row0 + ai * HALF + m * 16) * 1024 + col0;
#pragma unroll
                for (int bj = 0; bj < 2; ++bj) { const f32x4 v0 = acc[ai][bj][m][0] * 16.0f + bv[bj][0], v1 = acc[ai][bj][m][1] * 16.0f + bv[bj][1];
                    int w0 = 0, w1 = 0;
                    w0 = __builtin_amdgcn_cvt_pk_fp8_f32(fminf(fmaxf(v0[0], -440.f), 440.f), fminf(fmaxf(v0[1], -440.f), 440.f), w0, false); w0 = __builtin_amdgcn_cvt_pk_fp8_f32(fminf(fmaxf(v0[2], -440.f), 440.f), fminf(fmaxf(v0[3], -440.f), 440.f), w0, true);
                    w1 = __builtin_amdgcn_cvt_pk_fp8_f32(fminf(fmaxf(v1[0], -440.f), 440.f), fminf(fmaxf(v1[1], -440.f), 440.f), w1, false); w1 = __builtin_amdgcn_cvt_pk_fp8_f32(fminf(fmaxf(v1[2], -440.f), 440.f), fminf(fmaxf(v1[3], -440.f), 440.f), w1, true);
                    *(u32x2*)(rowp + bj * HALF) = (u32x2){(unsigned)w0, (unsigned)w1}; } }
    }
};
}

__device__ __forceinline__ void p0_adaln(const Ctx& C) {
    PH_IDS;
    LAS float* s = (LAS float*)C.lds;
    LAS float* red = (LAS float*)(C.lds + 36864);
    const float* cc = C.a->in[IN_C]; const float* cx = C.a->in[IN_CCTX];
    { float tmpc[18];
#pragma unroll
      for (int q = 0; q < 18; ++q) { const int i = tid + 512 * q; const int b = i >> 10, k = i & 1023; tmpc[q] = (b < 8) ? cc[b * 1024 + k] : cx[k]; }
#pragma unroll
      for (int q = 0; q < 18; ++q) s[tid + 512 * q] = siluf_(tmpc[q]); }
    __syncthreads();
    float* MOD = (float*)(C.ws + WS_MOD);
    for (int item = blockIdx.x; item < 192; item += C.G) {
        const int l = item / 96, cb = item % 96, col = cb * 64 + lane;
        const float* W = C.a->in[IN_MODW] + (size_t)l * 1024 * 6144 + col;
        float acc[9];
#pragma unroll
        for (int b = 0; b < 9; ++b) acc[b] = 0.f;
        const int k0 = wave * 128;
#pragma unroll 8
        for (int k = k0; k < k0 + 128; ++k) { const float w = W[(size_t)k * 6144];
#pragma unroll
            for (int b = 0; b < 9; ++b) acc[b] += s[b * 1024 + k] * w; }
#pragma unroll
        for (int b = 0; b < 9; ++b) red[(wave * 9 + b) * 64 + lane] = acc[b];
        __syncthreads();
        for (int i = tid; i < 576; i += 512) { const int b = i >> 6, ln = i & 63; float v = 0.f;
#pragma unroll
            for (int w = 0; w < 8; ++w) v += red[(w * 9 + b) * 64 + ln];
            v += C.a->in[IN_MODB][l * 6144 + cb * 64 + ln];
            MOD[(size_t)(l * 9 + b) * 6144 + cb * 64 + ln] = v; }
        __syncthreads();
    }
}
__device__ __forceinline__ void p0_tr_item(const float* W, int ldw, int sc0, int k0, bf16* WT, int Kd, int dr0, float scale, LAS float* scr, int lane) {
#pragma unroll 8
    for (int i = 0; i < 32; ++i) { const int kk = 2 * i + (lane >> 5); scr[kk * 33 + (lane & 31)] = W[(size_t)(k0 + kk) * ldw + sc0 + (lane & 31)]; }
    asm volatile("s_waitcnt lgkmcnt(0)" ::: "memory");
    const int c = lane & 7;
#pragma unroll
    for (int j = 0; j < 4; ++j) { const int n = (lane >> 3) + 8 * j; const LAS float* sp = scr + (8 * c) * 33 + n;
        u32x4 o; o.x = cvt_pk(sp[0 * 33] * scale, sp[1 * 33] * scale); o.y = cvt_pk(sp[2 * 33] * scale, sp[3 * 33] * scale);
        o.z = cvt_pk(sp[4 * 33] * scale, sp[5 * 33] * scale); o.w = cvt_pk(sp[6 * 33] * scale, sp[7 * 33] * scale);
        *(u32x4*)(WT + (size_t)(dr0 + n) * Kd + k0 + 8 * c) = o; }
    asm volatile("s_waitcnt lgkmcnt(0)" ::: "memory");
}
__device__ __forceinline__ void p0_tr_item8(const float* W, int ldw, int sc0, int k0, unsigned char* WT, int Kd, int dr0, float scale, LAS float* scr, int lane) {
#pragma unroll 8
    for (int i = 0; i < 64; ++i) { const int kk = 2 * i + (lane >> 5); scr[kk * 33 + (lane & 31)] = W[(size_t)(k0 + kk) * ldw + sc0 + (lane & 31)]; }
    asm volatile("s_waitcnt lgkmcnt(0)" ::: "memory");
    const int c = lane & 7;
#pragma unroll
    for (int j = 0; j < 4; ++j) { const int n = (lane >> 3) + 8 * j; const LAS float* sp = scr + (16 * c) * 33 + n;
        int w[4];
#pragma unroll
        for (int q = 0; q < 4; ++q) { int x = 0;
            x = __builtin_amdgcn_cvt_pk_fp8_f32(sp[(4 * q) * 33] * scale, sp[(4 * q + 1) * 33] * scale, x, false);
            x = __builtin_amdgcn_cvt_pk_fp8_f32(sp[(4 * q + 2) * 33] * scale, sp[(4 * q + 3) * 33] * scale, x, true); w[q] = x; }
        *(u32x4*)(WT + (size_t)(dr0 + n) * Kd + k0 + 16 * c) = (u32x4){(unsigned)w[0], (unsigned)w[1], (unsigned)w[2], (unsigned)w[3]}; }
    asm volatile("s_waitcnt lgkmcnt(0)" ::: "memory");
}
__device__ __forceinline__ int gu_src_col(int dr0) { const int pn = dr0 >> 8, bj = (dr0 >> 7) & 1, t0 = dr0 & 127; return bj * 1024 + 128 * pn + t0; }
__device__ __forceinline__ int in1_src_col(int dr0) {
    const int pn = dr0 >> 8, bj = (dr0 >> 7) & 1, t0 = dr0 & 127;
    if (pn < 4) return bj * 512 + 128 * pn + t0;
    if (pn < 8) return (bj ? 2048 : 1536) + 128 * (pn - 4) + t0;
    return 1024 + (dr0 - 2048);
}
__device__ __forceinline__ void p0_convert(const Ctx& C) {
    PH_IDS;
    LAS float* scr = (LAS float*)(C.lds + wave * 16896);
    const int gw = blockIdx.x * 8 + wave, NGW = C.G * 8;
    constexpr int KB_IN0 = F8_IN0 ? 8 : 16, KB_OUT0 = F8_OUT0 ? 12 : 24, KB_IN1 = F8_IN1 ? 8 : 16, KB_OUT1 = F8_OUT1 ? 8 : 16;
    constexpr int I_IN0 = 97 * KB_IN0, I_OUT0 = 32 * KB_OUT0, I_IN1 = 80 * KB_IN1, I_OUT1 = 32 * KB_OUT1, I_GU = 64 * 64 * 8, I_D = 64 * 32 * 8;
    constexpr int NITEMS = I_IN0 + I_OUT0 + I_IN1 + I_OUT1 + I_GU + I_D;
    for (int it = gw; it < NITEMS; it += NGW) {
        int r = it;
        if (r < I_IN0) { const int nb = r / KB_IN0, kb = r % KB_IN0; int dr0, sc0;
            if (nb < 96) { dr0 = nb * 32; sc0 = dr0; } else { dr0 = 4096; sc0 = 3072; }
            if (F8_IN0) p0_tr_item8(C.a->in[IN_EVWIN], 3616, sc0, kb * 128, (unsigned char*)(C.ws + WS_WIN0), 1024, dr0, 32.f, scr, lane);
            else p0_tr_item(C.a->in[IN_EVWIN], 3616, sc0, kb * 64, (bf16*)(C.ws + WS_WIN0), 1024, dr0, 1.f, scr, lane);
            continue; }
        r -= I_IN0;
        if (r < I_OUT0) { const int nb = r / KB_OUT0, kb = r % KB_OUT0;
            if (F8_OUT0) p0_tr_item8(C.a->in[IN_EVWOUT], 1024, nb * 32, kb * 128, (unsigned char*)(C.ws + WS_WOUT0), 1536, nb * 32, 32.f, scr, lane);
            else p0_tr_item(C.a->in[IN_EVWOUT], 1024, nb * 32, kb * 64, (bf16*)(C.ws + WS_WOUT0), 1536, nb * 32, 1.f, scr, lane);
            continue; }
        r -= I_OUT0;
        if (r < I_IN1) { const int nb = r / KB_IN1, kb = r % KB_IN1;
            if (F8_IN1) p0_tr_item8(C.a->in[IN_ODWIN], 2560, in1_src_col(nb * 32), kb * 128, (unsigned char*)(C.ws + WS_WIN1), 1024, nb * 32, 32.f, scr, lane);
            else p0_tr_item(C.a->in[IN_ODWIN], 2560, in1_src_col(nb * 32), kb * 64, (bf16*)(C.ws + WS_WIN1), 1024, nb * 32, 1.f, scr, lane);
            continue; }
        r -= I_IN1;
        if (r < I_OUT1) { const int nb = r / KB_OUT1, kb = r % KB_OUT1;
            if (F8_OUT1) p0_tr_item8(C.a->in[IN_ODWOUT], 1024, nb * 32, kb * 128, (unsigned char*)(C.ws + WS_WOUT1), 1024, nb * 32, 32.f, scr, lane);
            else p0_tr_item(C.a->in[IN_ODWOUT], 1024, nb * 32, kb * 64, (bf16*)(C.ws + WS_WOUT1), 1024, nb * 32, 1.f, scr, lane);
            continue; }
        r -= I_OUT1;
        if (r < I_GU) { const int le = r >> 9, q = r & 511, nb = q >> 3, kb = q & 7;
            p0_tr_item8(C.a->in[IN_WGU] + (size_t)le * 1024 * 2048, 2048, gu_src_col(nb * 32), kb * 128, (unsigned char*)(C.ws + WS_WGU) + (size_t)le * 2048 * 1024, 1024, nb * 32, 32.f, scr, lane); continue; }
        r -= I_GU;
        { const int le = r >> 8, q = r & 255, nb = q >> 3, kb = q & 7;
            p0_tr_item8(C.a->in[IN_WD] + (size_t)le * 1024 * 1024, 1024, nb * 32, kb * 128, (unsigned char*)(C.ws + WS_WD) + (size_t)le * 1024 * 1024, 1024, nb * 32, 32.f, scr, lane); }
    }
    { u32x4* z = (u32x4*)((unsigned char*)(C.ws + WS_WIN0) + (size_t)4128 * 1024 * (F8_IN0 ? 1 : 2)); const int n16 = 224 * 1024 * (F8_IN0 ? 1 : 2) / 16;
      for (int i = blockIdx.x * 512 + tid; i < n16; i += C.G * 512) z[i] = (u32x4){0u, 0u, 0u, 0u}; }
    { bf16* F1 = (bf16*)(C.ws + WS_F1); bf16* F2 = (bf16*)(C.ws + WS_F2);
      for (int i = blockIdx.x * 512 + tid; i < 128 * 128 + 128 * 256; i += C.G * 512) {
          if (i < 128 * 128) { const int m = i >> 7, k = i & 127; const int mb = m >> 5, rr = m & 31, g = rr >> 3, hh = (rr >> 2) & 1, ii = rr & 3;
              const int part = g & 1, ap = 16 * mb + 8 * (g >> 1) + 4 * hh + ii, pin = k >> 6, a = k & 63;
              const float th = 6.283185307179586f * (float)((a * ap) & 63) * (1.0f / 64.0f); const float cs = cosf(th), sn = sinf(th);
              const float v = (part == 0) ? (pin == 0 ? cs : -sn) : (pin == 0 ? -sn : -cs);
              F1[i] = (bf16)f2bf(v); }
          else { const int q = i - 128 * 128, m = q >> 8, k = q & 255, pin = k >> 7, b = k & 127;
              const float ps = 6.283185307179586f * (float)((b * m) & 127) * (1.0f / 128.0f);
              F2[q] = (bf16)f2bf(pin == 0 ? cosf(ps) : sinf(ps)); } } }
    __syncthreads();
}
__device__ __forceinline__ void p0_fourier_fold(const Ctx& C) {
    PH_IDS;
    LAS float* Wl = (LAS float*)C.lds;
    LAS float* tab = (LAS float*)(C.lds + 32768);
    unsigned char* WT = (unsigned char*)(C.ws + WS_WIN0);
    for (int item = blockIdx.x; item < 64; item += C.G) {
        const int kb = item >> 2, g = item & 3;
        __syncthreads();
        if (tid < 128) tab[tid] = cosf(6.283185307179586f * (float)tid * (1.0f / 128.0f));
        for (int i = tid; i < 64 * 128; i += 512) { const int kk = i >> 7, c = i & 127; Wl[i] = C.a->in[IN_EVWIN][(size_t)(kb * 64 + kk) * 3616 + 3104 + g * 128 + c]; }
        __syncthreads();
        const int cp = tid & 127, kq = tid >> 7;
        float ac[16], as[16];
#pragma unroll
        for (int i = 0; i < 16; ++i) { ac[i] = 0.f; as[i] = 0.f; }
        for (int c = 0; c < 128; ++c) { const int ph = (c * cp) & 127; const float cs = tab[ph], sn = tab[(ph + 96) & 127];
#pragma unroll
            for (int i = 0; i < 16; ++i) { const float w = Wl[(kq * 16 + i) * 128 + c]; ac[i] += w * cs; as[i] += w * sn; } }
        if (F8_IN0) {
            unsigned char* pc = WT + (size_t)(3072 + g * 128 + cp) * 1024 + kb * 64 + kq * 16;
            unsigned char* ps = WT + (size_t)(3584 + g * 128 + cp) * 1024 + kb * 64 + kq * 16;
            *(u32x4*)pc = (u32x4){pk4_fp8(ac[0], ac[1], ac[2], ac[3], 32.f), pk4_fp8(ac[4], ac[5], ac[6], ac[7], 32.f), pk4_fp8(ac[8], ac[9], ac[10], ac[11], 32.f), pk4_fp8(ac[12], ac[13], ac[14], ac[15], 32.f)};
            *(u32x4*)ps = (u32x4){pk4_fp8(as[0], as[1], as[2], as[3], 32.f), pk4_fp8(as[4], as[5], as[6], as[7], 32.f), pk4_fp8(as[8], as[9], as[10], as[11], 32.f), pk4_fp8(as[12], as[13], as[14], as[15], 32.f)};
        } else {
            bf16* pc = (bf16*)WT + (size_t)(3072 + g * 128 + cp) * 1024 + kb * 64 + kq * 16;
            bf16* ps = (bf16*)WT + (size_t)(3584 + g * 128 + cp) * 1024 + kb * 64 + kq * 16;
            *(u32x4*)pc = (u32x4){cvt_pk(ac[0], ac[1]), cvt_pk(ac[2], ac[3]), cvt_pk(ac[4], ac[5]), cvt_pk(ac[6], ac[7])}; *(u32x4*)(pc + 8) = (u32x4){cvt_pk(ac[8], ac[9]), cvt_pk(ac[10], ac[11]), cvt_pk(ac[12], ac[13]), cvt_pk(ac[14], ac[15])};
            *(u32x4*)ps = (u32x4){cvt_pk(as[0], as[1]), cvt_pk(as[2], as[3]), cvt_pk(as[4], as[5]), cvt_pk(as[6], as[7])}; *(u32x4*)(ps + 8) = (u32x4){cvt_pk(as[8], as[9]), cvt_pk(as[10], as[11]), cvt_pk(as[12], as[13]), cvt_pk(as[14], as[15])};
        }
    }
    __syncthreads();
}

__device__ __forceinline__ void p_norm0(const Ctx& C) {
    PH_IDS;
    const int gw = blockIdx.x * 8 + wave, NGW = C.G * 8;
    const int per = (MALL + NGW - 1) / NGW;
    const int r0 = gw * per, r1 = (r0 + per < MALL) ? r0 + per : MALL;
    const float* MOD = (const float*)(C.ws + WS_MOD);
    const float* g = C.a->in[IN_NMPRE];
    unsigned char* HN = (unsigned char*)(C.ws + WS_HN);
    int curb = -1; f32x4 A[4], B[4];
    for (int r = r0; r < r1; ++r) {
        const int b = (r < MTOK) ? (r >> 13) : 8;
        if (b != curb) { curb = b;
#pragma unroll
            for (int j = 0; j < 4; ++j) { const int c = 4 * lane + 256 * j;
                const f32x4 gg = *(const f32x4*)(g + c), sc = *(const f32x4*)(MOD + (size_t)b * 6144 + 1024 + c), sh = *(const f32x4*)(MOD + (size_t)b * 6144 + c);
                A[j] = gg * (sc + 1.0f); B[j] = sh; } }
        const float* xr = (r < MTOK) ? (C.a->in[IN_X] + (size_t)r * 1024) : (C.a->in[IN_CTX] + (size_t)(r - MTOK) * 1024);
        f32x4 v[4]; float ss = 0.f;
#pragma unroll
        for (int j = 0; j < 4; ++j) { v[j] = *(const f32x4*)(xr + 4 * lane + 256 * j); ss += v[j][0] * v[j][0] + v[j][1] * v[j][1] + v[j][2] * v[j][2] + v[j][3] * v[j][3]; }
        const float rstd = rsqrtf(wave_sum(ss) * (1.0f / 1024.0f) + EPS);
#pragma unroll
        for (int j = 0; j < 4; ++j) { const f32x4 h = v[j] * rstd * A[j] + B[j];
            if (F8_IN0) *(unsigned*)(HN + (size_t)r * 1024 + 4 * lane + 256 * j) = pk4_fp8(h[0], h[1], h[2], h[3], 8.f);
            else *(u32x2*)((bf16*)HN + (size_t)r * 1024 + 4 * lane + 256 * j) = (u32x2){cvt_pk(h[0], h[1]), cvt_pk(h[2], h[3])}; }
    }
}

namespace glap {
constexpr int H_BYTES = 72704;
constexpr int O_RAW = 0, O_BC = 2048, O_TOT = 34816, O_QP = 36864, O_KP = 54272;
constexpr int NUNIT = 2 * 4 * 8 * 132;
}
__device__ __forceinline__ int gla_row(int bt, int dir, int s, int i) {
    const int ii = dir ? 63 - i : i;
    if (s < 4) { const int ci = dir ? 3 - s : s; return MTOK + bt * CTXL + ci * 64 + ii; }
    const int n = s - 4, ci = dir ? 127 - n : n; return bt * SEQ + ci * 64 + ii;
}
__device__ __forceinline__ void p_gla_prep(const Ctx& C, const int pv = 0) {
    PH_IDS;
    using namespace glap;
    const int half = tid >> 8, th = tid & 255, wh = wave & 3;
    LAS unsigned char* L = C.lds + half * H_BYTES;
    const bf16* Qg = (const bf16*)(C.ws + WS_Q); const bf16* Kg = (const bf16*)(C.ws + WS_K); const bf16* LRg = (const bf16*)(C.ws + WS_LR);
    bf16* QPg = (bf16*)(C.ws + WS_GQP); bf16* KPPg = (bf16*)(C.ws + WS_GKPP); bf16* SCg = (bf16*)(C.ws + WS_GSC); float* ELg = (float*)(C.ws + WS_GEL);
    const int niter = (NUNIT + 2 * C.G - 1) / (2 * C.G);
    const int lj = th >> 2, part = th & 3;
    u32x4 nq[4], nk[4], nlr; float nup[8], nbias;
    auto unit_of = [&](int itn) -> int { const int U = (itn * C.G + (int)blockIdx.x) * 2 + half; return U < NUNIT ? U : NUNIT - 1; };
    auto issue_loads = [&](int Uc) {
        const int sstep = Uc % 132, bt = (Uc / 132) & 7, hd = (Uc / (132 * 8)) & 3, dir = Uc / (132 * 32);
#pragma unroll
        for (int q = 0; q < 4; ++q) { const int c = th + 256 * q; const int row = gla_row(bt, dir, sstep, c >> 4);
            nk[q] = *(const u32x4*)(Kg + (size_t)row * 512 + hd * 128 + (c & 15) * 8);
            nq[q] = *(const u32x4*)(Qg + (size_t)(sstep >= 4 ? row : 0) * 512 + hd * 128 + (c & 15) * 8); }
        if (th < 128) { const int r2 = gla_row(bt, dir, sstep, th >> 1); nlr = *(const u32x4*)(LRg + (size_t)r2 * 32 + dir * 16 + (th & 1) * 8); }
        const float* up = C.a->in[IN_EVGKUP] + (size_t)dir * 16 * 512 + hd * 128 + 32 * wh + (lane & 31);
#pragma unroll
        for (int q = 0; q < 8; ++q) nup[q] = up[(size_t)(8 * (lane >> 5) + q) * 512];
        nbias = C.a->in[IN_EVGKB][dir * 512 + hd * 128 + 32 * wh + (lane & 31)]; };
    issue_loads(unit_of(0));
    for (int itn = 0; itn < niter; ++itn) {
        const int U = (itn * C.G + (int)blockIdx.x) * 2 + half;
        const bool act = U < NUNIT;
        const int Uc = act ? U : NUNIT - 1;
        const int sstep = Uc % 132;
        const bool latent = sstep >= 4;
        u32x4 rq[4], rk[4], rlr = nlr;
#pragma unroll
        for (int q = 0; q < 4; ++q) { rq[q] = nq[q]; rk[q] = nk[q]; }
        bf16x8 upf; const float gbias = nbias;
        { unsigned short tmp[8];
#pragma unroll
          for (int q = 0; q < 8; ++q) tmp[q] = (unsigned short)f2bf(nup[q]);
          upf = (bf16x8){(short)tmp[0], (short)tmp[1], (short)tmp[2], (short)tmp[3], (short)tmp[4], (short)tmp[5], (short)tmp[6], (short)tmp[7]}; }
        if (itn + 1 < niter) issue_loads(unit_of(itn + 1));
        __syncthreads();
        if (th < 128) *(LAS u32x4*)(L + O_RAW + (th >> 1) * 32 + (th & 1) * 16) = rlr;
        __syncthreads();
#pragma unroll
        for (int jb = 0; jb < 2; ++jb) {
            const bf16x8 af = *(const LAS bf16x8*)(L + O_RAW + (32 * jb + (lane & 31)) * 32 + (lane >> 5) * 16);
            f32x16 z;
#pragma unroll
            for (int i = 0; i < 16; ++i) z[i] = 0.f;
            z = __builtin_amdgcn_mfma_f32_32x32x16_bf16(af, upf, z, 0, 0, 0);
#pragma unroll
            for (int r = 0; r < 16; ++r) { const int j = 32 * jb + (r & 3) + 8 * (r >> 2) + 4 * (lane >> 5); const float zz = z[r] + gbias;
                const float ls = fminf(zz, 0.f) - __logf(1.0f + __expf(-fabsf(zz)));
                *(LAS float*)(L + O_BC + (j * 128 + 32 * wh + (lane & 31)) * 4) = ls * 0.0625f; } }
        __syncthreads();
        { const int dk = th & 127;
          float run0 = 0.f, run1 = 0.f; const int g0 = th >> 7, g1 = g0 + 2;
          float v0[16], v1[16];
#pragma unroll
          for (int q = 0; q < 16; ++q) { v0[q] = *(const LAS float*)(L + O_BC + ((16 * g0 + q) * 128 + dk) * 4); v1[q] = *(const LAS float*)(L + O_BC + ((16 * g1 + q) * 128 + dk) * 4); }
#pragma unroll
          for (int q = 0; q < 16; ++q) { run0 += v0[q]; run1 += v1[q];
              *(LAS float*)(L + O_BC + ((16 * g0 + q) * 128 + dk) * 4) = run0; *(LAS float*)(L + O_BC + ((16 * g1 + q) * 128 + dk) * 4) = run1; }
          *(LAS float*)(L + O_TOT + (g0 * 128 + dk) * 4) = run0; *(LAS float*)(L + O_TOT + (g1 * 128 + dk) * 4) = run1; }
        __syncthreads();
        {
#pragma unroll
          for (int q8 = 0; q8 < 4; ++q8) {
              const int c = th + 256 * q8, cj = c >> 4, jg = cj >> 4, dkc = (c & 15) * 8;
              u32x4 oq, okpp;
#pragma unroll
              for (int hq = 0; hq < 2; ++hq) {
                  const int dk0 = dkc + 4 * hq;
                  f32x4 b = *(const LAS f32x4*)(L + O_BC + (cj * 128 + dk0) * 4), tt = (f32x4){0.f, 0.f, 0.f, 0.f};
#pragma unroll
                  for (int g2 = 0; g2 < 4; ++g2) { const f32x4 tv = *(const LAS f32x4*)(L + O_TOT + (g2 * 128 + dk0) * 4); tt += tv; if (g2 < jg) b += tv; }
                  f32x4 e1, e2, e3;
#pragma unroll
                  for (int i = 0; i < 4; ++i) { if (pv & 4) { e1[i] = b[i]; e2[i] = -b[i]; e3[i] = tt[i] - b[i]; } else { e1[i] = __expf(b[i]); e2[i] = __expf(-b[i]); e3[i] = __expf(tt[i] - b[i]); } }
                  if (cj == 0 && act && !(pv & 1)) { f32x4 el;
#pragma unroll
                      for (int i = 0; i < 4; ++i) el[i] = __expf(tt[i]);
                      *(f32x4*)(ELg + (size_t)Uc * 128 + dk0) = el; }
                  const unsigned qa = hq ? rq[q8].z : rq[q8].x, qb = hq ? rq[q8].w : rq[q8].y;
                  const unsigned ka = hq ? rk[q8].z : rk[q8].x, kb = hq ? rk[q8].w : rk[q8].y;
                  const float q0 = bf_lo(qa), q1 = bf_hi(qa), q2 = bf_lo(qb), q3 = bf_hi(qb);
                  const float k0 = bf_lo(ka), k1 = bf_hi(ka), k2 = bf_lo(kb), k3 = bf_hi(kb);
                  u32x2 o;
                  o.x = cvt_pk(q0 * e1[0], q1 * e1[1]); o.y = cvt_pk(q2 * e1[2], q3 * e1[3]); *(LAS u32x2*)(L + O_QP + cj * 272 + dk0 * 2) = o;
                  if (hq) { oq.z = o.x; oq.w = o.y; } else { oq.x = o.x; oq.y = o.y; }
                  o.x = cvt_pk(k0 * e2[0], k1 * e2[1]); o.y = cvt_pk(k2 * e2[2], k3 * e2[3]); *(LAS u32x2*)(L + O_KP + cj * 272 + dk0 * 2) = o;
                  o.x = cvt_pk(k0 * e3[0], k1 * e3[1]); o.y = cvt_pk(k2 * e3[2], k3 * e3[3]);
                  if (hq) { okpp.z = o.x; okpp.w = o.y; } else { okpp.x = o.x; okpp.y = o.y; }
              }
              if (act && !(pv & 1)) { *(u32x4*)(KPPg + (size_t)Uc * 8192 + c * 8) = okpp; if (latent) *(u32x4*)(QPg + (size_t)Uc * 8192 + c * 8) = oq; }
              else asm volatile("" :: "v"(okpp), "v"(oq));
          } }
        __syncthreads();
        if (latent && act && !(pv & 2)) {
            const int ib = wh;
            for (int jb16 = 0; jb16 <= ib; ++jb16) {
                f32x4 d = (f32x4){0.f, 0.f, 0.f, 0.f};
#pragma unroll
                for (int ks = 0; ks < 4; ++ks) {
                    const bf16x8 a = *(const LAS bf16x8*)(L + O_KP + (16 * jb16 + (lane & 15)) * 272 + (32 * ks + 8 * (lane >> 4)) * 2);
                    const bf16x8 bq = *(const LAS bf16x8*)(L + O_QP + (16 * ib + (lane & 15)) * 272 + (32 * ks + 8 * (lane >> 4)) * 2);
                    d = __builtin_amdgcn_mfma_f32_16x16x32_bf16(a, bq, d, 0, 0, 0); }
                const int i = 16 * ib + (lane & 15), j0 = 16 * jb16 + 4 * (lane >> 4);
#pragma unroll
                for (int r = 0; r < 4; ++r) if (j0 + r > i) d[r] = 0.f;
                u32x2 o; o.x = cvt_pk(d[0], d[1]); o.y = cvt_pk(d[2], d[3]);
                if (!(pv & 1)) *(u32x2*)(SCg + (size_t)Uc * 4096 + i * 64 + j0) = o; else asm volatile("" :: "v"(o));
            }
            for (int jb16 = ib + 1; jb16 < 4; ++jb16) { const int i = 16 * ib + (lane & 15), j0 = 16 * jb16 + 4 * (lane >> 4);
                if (!(pv & 1)) *(u32x2*)(SCg + (size_t)Uc * 4096 + i * 64 + j0) = (u32x2){0u, 0u}; }
        }
    }
    __syncthreads();
}
namespace gla {
constexpr int O_EL = 0, O_QP = 512, O_KPP = 17920, O_V = 38400, O_SC = 50688, IMG_BYTES = 59904, O_ST = 2 * IMG_BYTES;
constexpr int P_QP = 272, P_KPP = 320, P_V = 192, P_SC = 144, P_ST = 272, ST_BYTES = 64 * 272;
__device__ __forceinline__ bf16x8 tr8(LAS unsigned char* p0, LAS unsigned char* p1) {
    const s16x4 a = __builtin_amdgcn_ds_read_tr16_b64_v4i16((LAS s16x4*)p0);
    const s16x4 b = __builtin_amdgcn_ds_read_tr16_b64_v4i16((LAS s16x4*)p1);
    return (bf16x8){a[0], a[1], a[2], a[3], b[0], b[1], b[2], b[3]};
}
}
__device__ __forceinline__ void p_gla(const Ctx& C, const int probe = 0) {
    PH_IDS;
    using namespace gla;
    LAS unsigned char* L = C.lds;
    const int t = tid, w = wave;
    const bf16* Vg = (const bf16*)(C.ws + WS_V);
    const bf16* QPg = (const bf16*)(C.ws + WS_GQP); const bf16* KPPg = (const bf16*)(C.ws + WS_GKPP); const bf16* SCg = (const bf16*)(C.ws + WS_GSC); const float* ELg = (const float*)(C.ws + WS_GEL);
    for (int it = blockIdx.x; it < 256; it += C.G) {
        const int xx = it & 7, jj_ = it >> 3, scan = xx * 8 + (jj_ >> 2), dvs = jj_ & 3;
        const int bt = scan >> 3, hd = (scan >> 1) & 3, dir = scan & 1;
        const int ubase = ((dir * 4 + hd) * 8 + bt) * 132;
        bf16* Og = (bf16*)(C.ws + (probe ? WS_HN : (dir ? WS_OB : WS_OF)));
        __syncthreads();
        for (int i = t; i < ST_BYTES / 16; i += 512) *(LAS u32x4*)(L + O_ST + i * 16) = (u32x4){0u, 0u, 0u, 0u};
        f32x16 S;
#pragma unroll
        for (int i = 0; i < 16; ++i) S[i] = 0.f;
        const int lj = t >> 3, part = t & 7;
        u32x4 rsc, rqp0, rqp1, rkp0, rkp1, rv; f32x4 rel;
        u32x4 nsc, nqp0, nqp1, nkp0, nkp1, nv; f32x4 nel;
        auto load_step = [&](int s_) {
            const int s = probe ? 4 + (s_ & 1) : s_;
            const size_t U = (size_t)(ubase + s);
            const int row = gla_row(bt, dir, s, lj);
            nv = *(const u32x4*)(Vg + (size_t)row * 1024 + hd * 256 + dvs * 64 + part * 8);
            const bf16* kp = KPPg + U * 8192 + t * 8; nkp0 = *(const u32x4*)kp; nkp1 = *(const u32x4*)(kp + 4096);
            if (t < 32) nel = *(const f32x4*)(ELg + U * 128 + t * 4);
            if (s >= 4) { const bf16* qp = QPg + U * 8192 + t * 8; nqp0 = *(const u32x4*)qp; nqp1 = *(const u32x4*)(qp + 4096);
                nsc = *(const u32x4*)(SCg + U * 4096 + lj * 64 + part * 8); } };
        auto shift_regs = [&]() { rsc = nsc; rqp0 = nqp0; rqp1 = nqp1; rkp0 = nkp0; rkp1 = nkp1; rv = nv; rel = nel; };
        auto write_images = [&](int s, int ib_) {
            LAS unsigned char* I = L + ib_ * IMG_BYTES;
            *(LAS u32x4*)(I + O_V + lj * P_V + part * 16) = rv;
            *(LAS u32x4*)(I + O_KPP + (t >> 4) * P_KPP + (t & 15) * 16) = rkp0; *(LAS u32x4*)(I + O_KPP + (32 + (t >> 4)) * P_KPP + (t & 15) * 16) = rkp1;
            if (t < 32) *(LAS f32x4*)(I + O_EL + t * 16) = rel;
            if (s >= 4) { *(LAS u32x4*)(I + O_QP + (t >> 4) * P_QP + (t & 15) * 16) = rqp0; *(LAS u32x4*)(I + O_QP + (32 + (t >> 4)) * P_QP + (t & 15) * 16) = rqp1;
                *(LAS u32x4*)(I + O_SC + lj * P_SC + part * 16) = rsc; } };
        load_step(0); shift_regs(); write_images(0, 0);
        load_step(1); shift_regs();
        load_step(2);
        for (int s = 0; s < 132; ++s) {
            const int cur = s & 1, nx = cur ^ 1;
            const bool latent = (s >= 4);
            LAS unsigned char* I = L + cur * IMG_BYTES;
            __syncthreads();
            if (s + 1 < 132) write_images(s + 1, nx);
            shift_regs();
            if (s + 3 < 132) load_step(s + 3);
            if (latent) {
                const int ib = w >> 1;
                const int g4 = lane >> 4, q4 = (lane & 15) >> 2, p4 = lane & 3;
                const int orow = gla_row(bt, dir, s, 16 * ib + (lane & 15));
#pragma unroll
                for (int cc = 0; cc < 2; ++cc) {
                    const int c = 2 * (w & 1) + cc;
                    f32x4 d = (f32x4){0.f, 0.f, 0.f, 0.f};
#pragma unroll
                    for (int ks = 0; ks < 2; ++ks) {
                        LAS unsigned char* pa = I + O_V + (32 * ks + 8 * g4 + q4) * P_V + (16 * c + 4 * p4) * 2;
                        const bf16x8 a = gla::tr8(pa, pa + 4 * P_V);
                        const bf16x8 b = *(const LAS bf16x8*)(I + O_SC + (16 * ib + (lane & 15)) * P_SC + (32 * ks + 8 * g4) * 2);
                        d = __builtin_amdgcn_mfma_f32_16x16x32_bf16(a, b, d, 0, 0, 0); }
#pragma unroll
                    for (int ks = 0; ks < 4; ++ks) {
                        const bf16x8 a = *(const LAS bf16x8*)(L + O_ST + cur * ST_BYTES + (16 * c + (lane & 15)) * P_ST + (32 * ks + 8 * g4) * 2);
                        const bf16x8 b = *(const LAS bf16x8*)(I + O_QP + (16 * ib + (lane & 15)) * P_QP + (32 * ks + 8 * g4) * 2);
                        d = __builtin_amdgcn_mfma_f32_16x16x32_bf16(a, b, d, 0, 0, 0); }
                    u32x2 o; o.x = cvt_pk(d[0], d[1]); o.y = cvt_pk(d[2], d[3]);
                    *(u32x2*)(Og + (size_t)orow * 1024 + hd * 256 + dvs * 64 + 16 * c + 4 * g4) = o;
                }
            }
            { const int dbS = w & 3, dvb = w >> 2, hh = lane >> 5, blk = (lane >> 4) & 1, q4 = (lane & 15) >> 2, p4 = lane & 3;
#pragma unroll
              for (int g = 0; g < 4; ++g) { const f32x4 el = *(const LAS f32x4*)(I + O_EL + (32 * dbS + 8 * g + 4 * hh) * 4);
#pragma unroll
                  for (int i = 0; i < 4; ++i) S[4 * g + i] *= el[i]; }
#pragma unroll
              for (int ks = 0; ks < 4; ++ks) {
                  LAS unsigned char* pa = I + O_KPP + (16 * ks + 8 * hh + q4) * P_KPP + (32 * dbS + 16 * blk + 4 * p4) * 2;
                  LAS unsigned char* pb = I + O_V + (16 * ks + 8 * hh + q4) * P_V + (32 * dvb + 16 * blk + 4 * p4) * 2;
                  const bf16x8 a = gla::tr8(pa, pa + 4 * P_KPP);
                  const bf16x8 b = gla::tr8(pb, pb + 4 * P_V);
                  S = __builtin_amdgcn_mfma_f32_32x32x16_bf16(a, b, S, 0, 0, 0); }
#pragma unroll
              for (int g = 0; g < 4; ++g) { u32x2 o; o.x = cvt_pk(S[4 * g], S[4 * g + 1]); o.y = cvt_pk(S[4 * g + 2], S[4 * g + 3]);
                  *(LAS u32x2*)(L + O_ST + nx * ST_BYTES + (32 * dvb + (lane & 31)) * P_ST + (32 * dbS + 8 * g + 4 * hh) * 2) = o; } }
        }
    }
}

__device__ __forceinline__ void p_fft1(const Ctx& C) {
    PH_IDS;
    LAS unsigned char* L = C.lds;
    const int t = tid, w = wave, mb = w & 3, nh = w >> 2, hh = lane >> 5;
    const bf16* F1 = (const bf16*)(C.ws + WS_F1);
    bf16x8 af[8];
#pragma unroll
    for (int ks = 0; ks < 8; ++ks) af[ks] = *(const bf16x8*)(F1 + (32 * mb + (lane & 31)) * 128 + 16 * ks + 8 * hh);
    const bf16* ZC = (const bf16*)(C.ws + WS_ZC); const bf16* ZS = (const bf16*)(C.ws + WS_ZS);
    bf16* YR = (bf16*)(C.ws + WS_YR); bf16* YI = (bf16*)(C.ws + WS_YI);
    const int blk = (lane >> 4) & 1, q4 = (lane & 15) >> 2, p4 = lane & 3;
    u32x4 pv[8];
    auto fetch1 = [&](int unit) { const int bt = unit >> 8, b = (unit >> 1) & 127, chh = unit & 1; const int row = t >> 2, quarter = t & 3, pin = row >> 6, a = row & 63;
        const bf16* src = (pin ? ZS : ZC) + (size_t)(bt * SEQ + 128 * a + b) * 512 + chh * 256 + quarter * 64;
#pragma unroll
        for (int i = 0; i < 8; ++i) pv[i] = *(const u32x4*)(src + 8 * i); };
    if ((int)blockIdx.x < 2048) fetch1(blockIdx.x);
    for (int unit = blockIdx.x; unit < 2048; unit += C.G) {
        const int bt = unit >> 8, b = (unit >> 1) & 127, chh = unit & 1;
        __syncthreads();
        { const int row = t >> 2, quarter = t & 3;
#pragma unroll
          for (int i = 0; i < 8; ++i) *(LAS u32x4*)(L + row * 576 + quarter * 128 + i * 16) = pv[i]; }
        __syncthreads();
        if (unit + C.G < 2048) fetch1(unit + C.G);
#pragma unroll 1
        for (int nb = 0; nb < 4; ++nb) {
            const int c = 4 * nh + nb;
            f32x16 acc;
#pragma unroll
            for (int i = 0; i < 16; ++i) acc[i] = 0.f;
#pragma unroll
            for (int ks = 0; ks < 8; ++ks) {
                LAS unsigned char* pb = L + (16 * ks + 8 * hh + q4) * 576 + (32 * c + 16 * blk + 4 * p4) * 2;
                const bf16x8 bfr = gla::tr8(pb, pb + 4 * 576);
                acc = __builtin_amdgcn_mfma_f32_32x32x16_bf16(af[ks], bfr, acc, 0, 0, 0); }
#pragma unroll
            for (int gp = 0; gp < 2; ++gp)
#pragma unroll
                for (int i = 0; i < 4; ++i) { const int ap = 16 * mb + 8 * gp + 4 * hh + i; const float re = acc[8 * gp + i], im = acc[8 * gp + 4 + i];
                    const float ph = (float)((b * ap) & 8191) * (1.0f / 8192.0f); const float cs = __builtin_amdgcn_cosf(ph), sn = __builtin_amdgcn_sinf(ph);
                    const int so = ap * 528 + (32 * c + (lane & 31)) * 2;
                    *(LAS unsigned short*)(L + 73728 + so) = (unsigned short)f2bf(re * cs + im * sn);
                    *(LAS unsigned short*)(L + 73728 + 64 * 528 + so) = (unsigned short)f2bf(im * cs - re * sn); }
        }
        __syncthreads();
        { const int orow = t >> 2, quarter = t & 3, plane = orow >> 6, ap = orow & 63;
          bf16* dst = (plane ? YI : YR) + ((size_t)(bt * 64 + ap) * 128 + b) * 512 + chh * 256 + quarter * 64;
#pragma unroll
          for (int i = 0; i < 8; ++i) *(u32x4*)(dst + 8 * i) = *(const LAS u32x4*)(L + 73728 + orow * 528 + quarter * 128 + i * 16); }
    }
    __syncthreads();
}
__device__ __forceinline__ void p_fft2(const Ctx& C) {
    PH_IDS;
    LAS unsigned char* L = C.lds;
    const int t = tid, w = wave, mb = w & 3, nh = w >> 2, hh = lane >> 5;
    const bf16* F2 = (const bf16*)(C.ws + WS_F2);
    bf16x8 af[16];
#pragma unroll
    for (int ks = 0; ks < 16; ++ks) af[ks] = *(const bf16x8*)(F2 + (32 * mb + (lane & 31)) * 256 + 16 * ks + 8 * hh);
    const bf16* YR = (const bf16*)(C.ws + WS_YR); const bf16* YI = (const bf16*)(C.ws + WS_YI);
    unsigned char* A2 = (unsigned char*)(C.ws + WS_A2);
    const int blk = (lane >> 4) & 1, q4 = (lane & 15) >> 2, p4 = lane & 3;
    u32x4 pv[8];
    auto fetch2 = [&](int unit) { const int bt = unit >> 8, ap = (unit >> 2) & 63, cht = unit & 3; const int row = t >> 1, half = t & 1, pin = row >> 7, b = row & 127;
        const bf16* src = (pin ? YI : YR) + ((size_t)(bt * 64 + ap) * 128 + b) * 512 + cht * 128 + half * 64;
#pragma unroll
        for (int i = 0; i < 8; ++i) pv[i] = *(const u32x4*)(src + 8 * i); };
    if ((int)blockIdx.x < 2048) fetch2(blockIdx.x);
    for (int unit = blockIdx.x; unit < 2048; unit += C.G) {
        const int bt = unit >> 8, ap = (unit >> 2) & 63, cht = unit & 3;
        __syncthreads();
        { const int row = t >> 1, half = t & 1;
#pragma unroll
          for (int i = 0; i < 8; ++i) *(LAS u32x4*)(L + row * 320 + half * 128 + i * 16) = pv[i]; }
        __syncthreads();
        if (unit + C.G < 2048) fetch2(unit + C.G);
#pragma unroll 1
        for (int nb = 0; nb < 2; ++nb) {
            const int c = 2 * nh + nb;
            f32x16 acc;
#pragma unroll
            for (int i = 0; i < 16; ++i) acc[i] = 0.f;
#pragma unroll
            for (int ks = 0; ks < 16; ++ks) {
                LAS unsigned char* pb = L + (16 * ks + 8 * hh + q4) * 320 + (32 * c + 16 * blk + 4 * p4) * 2;
                const bf16x8 bfr = gla::tr8(pb, pb + 4 * 320);
                acc = __builtin_amdgcn_mfma_f32_32x32x16_bf16(af[ks], bfr, acc, 0, 0, 0); }
#pragma unroll
            for (int r = 0; r < 16; ++r) { const int bp = 32 * mb + (r & 3) + 8 * (r >> 2) + 4 * hh;
                if (F8_OUT0) *(LAS unsigned char*)(L + 81920 + bp * 144 + 32 * c + (lane & 31)) = (unsigned char)(pk4_fp8(acc[r], 0.f, 0.f, 0.f, 8.0f / 1024.0f) & 0xffu);
                else *(LAS unsigned short*)(L + 81920 + bp * 272 + (32 * c + (lane & 31)) * 2) = (unsigned short)f2bf(acc[r] * (1.0f / 1024.0f)); }
        }
        __syncthreads();
        { const int bp = t >> 2, quarter = t & 3; const size_t tok = (size_t)bt * SEQ + ap + 64 * bp;
          if (F8_OUT0) { unsigned char* dst = A2 + tok * 1536 + 1024 + cht * 128 + quarter * 32;
#pragma unroll
              for (int i = 0; i < 2; ++i) *(u32x4*)(dst + 16 * i) = *(const LAS u32x4*)(L + 81920 + bp * 144 + quarter * 32 + i * 16); }
          else { bf16* dst = (bf16*)A2 + tok * 1536 + 1024 + cht * 128 + quarter * 32;
#pragma unroll
              for (int i = 0; i < 4; ++i) *(u32x4*)(dst + 8 * i) = *(const LAS u32x4*)(L + 81920 + bp * 272 + quarter * 64 + i * 16); } }
    }
    __syncthreads();
}
__device__ __forceinline__ void p_gla_out(const Ctx& C) {
    PH_IDS;
    const int gw = blockIdx.x * 8 + wave, NGW = C.G * 8;
    const bf16* OF = (const bf16*)(C.ws + WS_OF); const bf16* OB = (const bf16*)(C.ws + WS_OB); const bf16* Rg = (const bf16*)(C.ws + WS_R);
    unsigned char* A2 = (unsigned char*)(C.ws + WS_A2);
    float gn[16];
#pragma unroll
    for (int i = 0; i < 16; ++i) gn[i] = C.a->in[IN_EVGNORM][16 * (lane & 15) + i];
    for (int r = gw; r < MTOK; r += NGW) {
        const u32x4 f0 = *(const u32x4*)(OF + (size_t)r * 1024 + 16 * lane), f1 = *(const u32x4*)(OF + (size_t)r * 1024 + 16 * lane + 8);
        const u32x4 b0 = *(const u32x4*)(OB + (size_t)r * 1024 + 16 * lane), b1 = *(const u32x4*)(OB + (size_t)r * 1024 + 16 * lane + 8);
        const u32x4 g0 = *(const u32x4*)(Rg + (size_t)r * 1024 + 16 * lane), g1 = *(const u32x4*)(Rg + (size_t)r * 1024 + 16 * lane + 8);
        float o[16], rr[16];
#pragma unroll
        for (int i = 0; i < 4; ++i) { const unsigned fa = f0[i], fb = f1[i], ba = b0[i], bb = b1[i], ga = g0[i], gb = g1[i];
            o[2 * i] = bf_lo(fa) + bf_lo(ba); o[2 * i + 1] = bf_hi(fa) + bf_hi(ba); o[8 + 2 * i] = bf_lo(fb) + bf_lo(bb); o[8 + 2 * i + 1] = bf_hi(fb) + bf_hi(bb);
            rr[2 * i] = bf_lo(ga); rr[2 * i + 1] = bf_hi(ga); rr[8 + 2 * i] = bf_lo(gb); rr[8 + 2 * i + 1] = bf_hi(gb); }
        float ss = 0.f;
#pragma unroll
        for (int i = 0; i < 16; ++i) ss += o[i] * o[i];
        ss = row16_sum(ss);
        const float rstd = rsqrtf(ss * (1.0f / 256.0f) + EPS);
        float y[16];
#pragma unroll
        for (int i = 0; i < 16; ++i) y[i] = o[i] * rstd * gn[i] * siluf_(rr[i]);
        if (F8_OUT0) *(u32x4*)(A2 + (size_t)r * 1536 + 16 * lane) = (u32x4){pk4_fp8(y[0], y[1], y[2], y[3], 8.f), pk4_fp8(y[4], y[5], y[6], y[7], 8.f), pk4_fp8(y[8], y[9], y[10], y[11], 8.f), pk4_fp8(y[12], y[13], y[14], y[15], 8.f)};
        else { bf16* a2 = (bf16*)A2 + (size_t)r * 1536 + 16 * lane;
            *(u32x4*)a2 = (u32x4){cvt_pk(y[0], y[1]), cvt_pk(y[2], y[3]), cvt_pk(y[4], y[5]), cvt_pk(y[6], y[7])}; *(u32x4*)(a2 + 8) = (u32x4){cvt_pk(y[8], y[9]), cvt_pk(y[10], y[11]), cvt_pk(y[12], y[13]), cvt_pk(y[14], y[15])}; }
    }
}

__device__ __forceinline__ void p_postmix(const Ctx& C, const int layer) {
    PH_IDS;
    LAS float* WR = (LAS float*)C.lds;
    LAS int* hist = (LAS int*)(C.lds + 131072);
    LAS float* Lg = (LAS float*)(C.lds + 131584 + wave * 2112);
    const float* rw = C.a->in[IN_RW] + (size_t)layer * 1024 * 32;
    __syncthreads();
    for (int it0 = 0; it0 < 64; it0 += 16) {
        float tmpw[16];
#pragma unroll
        for (int q = 0; q < 16; ++q) tmpw[q] = rw[tid + 512 * (it0 + q)];
#pragma unroll
        for (int q = 0; q < 16; ++q) { const int idx = tid + 512 * (it0 + q); const int c = idx >> 5, e = idx & 31; const int ln = (c & 255) >> 2, j = c >> 8, i = c & 3;
            WR[(((j * 4 + i) * 8 + (e >> 2)) * 64 + ln) * 4 + (e & 3)] = tmpw[q]; } }
    if (tid < 32) hist[tid] = 0;
    __syncthreads();
    const float* MOD = (const float*)(C.ws + WS_MOD) + (size_t)layer * 9 * 6144;
    const float* gpost = C.a->in[IN_NMPOST] + layer * 1024; const float* gffn = C.a->in[IN_NFPRE] + layer * 1024;
    const bf16* Y = (const bf16*)(C.ws + WS_Y);
    const float* xin = C.a->in[IN_X];
    bf16* XS = (bf16*)(C.ws + WS_XS);
    unsigned char* H2 = (unsigned char*)(C.ws + WS_H2);
    int* TK = (int*)(C.ws + WS_TOPK); float* GT = (float*)(C.ws + WS_GATE);
    const int rows_per_blk = MTOK / C.G, rows_per_wave = rows_per_blk / 8;
    const int r0 = blockIdx.x * rows_per_blk + wave * rows_per_wave;
    const int b = r0 >> 13;
    const float rbias = C.a->in[IN_RB][layer * 32 + ((lane >> 1) & 31)];
    float cA1[16], cA2[16], cB2[16];
#pragma unroll
    for (int j = 0; j < 4; ++j) { const int c = 4 * lane + 256 * j;
        const f32x4 gp = *(const f32x4*)(gpost + c), gm = *(const f32x4*)(MOD + (size_t)b * 6144 + 2048 + c);
        const f32x4 gf = *(const f32x4*)(gffn + c), sc = *(const f32x4*)(MOD + (size_t)b * 6144 + 4096 + c), sh = *(const f32x4*)(MOD + (size_t)b * 6144 + 3072 + c);
#pragma unroll
        for (int i = 0; i < 4; ++i) { cA1[4 * j + i] = gp[i] * gm[i]; cA2[4 * j + i] = gf[i] * (1.0f + sc[i]); cB2[4 * j + i] = sh[i]; } }
    auto ldx = [&](int r, int j) -> f32x4 {
        if (layer == 0) return *(const f32x4*)(xin + (size_t)r * 1024 + 4 * lane + 256 * j);
        const u32x2 v = *(const u32x2*)(XS + (size_t)r * 1024 + 4 * lane + 256 * j); return (f32x4){bf_lo(v.x), bf_hi(v.x), bf_lo(v.y), bf_hi(v.y)}; };
    u32x2 ny[4]; f32x4 nx[4];
#pragma unroll
    for (int j = 0; j < 4; ++j) { ny[j] = *(const u32x2*)(Y + (size_t)r0 * 1024 + 4 * lane + 256 * j); nx[j] = ldx(r0, j); }
    for (int r = r0; r < r0 + rows_per_wave; ++r) {
        float h[16];
        u32x2 cy[4]; f32x4 cx[4];
#pragma unroll
        for (int j = 0; j < 4; ++j) { cy[j] = ny[j]; cx[j] = nx[j]; }
        if (r + 1 < r0 + rows_per_wave) {
#pragma unroll
            for (int j = 0; j < 4; ++j) { ny[j] = *(const u32x2*)(Y + (size_t)(r + 1) * 1024 + 4 * lane + 256 * j); nx[j] = ldx(r + 1, j); } }
        { float ssy = 0.f; float yv[16];
#pragma unroll
          for (int j = 0; j < 4; ++j) { const u32x2 yy = cy[j];
              yv[4 * j] = bf_lo(yy.x); yv[4 * j + 1] = bf_hi(yy.x); yv[4 * j + 2] = bf_lo(yy.y); yv[4 * j + 3] = bf_hi(yy.y); }
#pragma unroll
          for (int i = 0; i < 16; ++i) ssy += yv[i] * yv[i];
          const float rstd = rsqrtf(wave_sum(ssy) * (1.0f / 1024.0f) + EPS);
          float ss1 = 0.f;
#pragma unroll
          for (int j = 0; j < 4; ++j) { const int c = 4 * lane + 256 * j;
              const f32x4 xv = cx[j];
              f32x4 o;
#pragma unroll
              for (int i = 0; i < 4; ++i) { o[i] = xv[i] + cA1[4 * j + i] * (yv[4 * j + i] * rstd); h[4 * j + i] = o[i]; ss1 += o[i] * o[i]; }
              { u32x2 xw; xw.x = cvt_pk(o[0], o[1]); xw.y = cvt_pk(o[2], o[3]); *(u32x2*)(XS + (size_t)r * 1024 + c) = xw; } }
          const float rstd1 = rsqrtf(wave_sum(ss1) * (1.0f / 1024.0f) + EPS);
#pragma unroll
          for (int j = 0; j < 4; ++j) { const int c = 4 * lane + 256 * j;
#pragma unroll
              for (int i = 0; i < 4; ++i) h[4 * j + i] = h[4 * j + i] * rstd1 * cA2[4 * j + i] + cB2[4 * j + i];
              int wv = 0;
              wv = __builtin_amdgcn_cvt_pk_fp8_f32(fminf(fmaxf(h[4 * j] * 8.0f, -440.f), 440.f), fminf(fmaxf(h[4 * j + 1] * 8.0f, -440.f), 440.f), wv, false);
              wv = __builtin_amdgcn_cvt_pk_fp8_f32(fminf(fmaxf(h[4 * j + 2] * 8.0f, -440.f), 440.f), fminf(fmaxf(h[4 * j + 3] * 8.0f, -440.f), 440.f), wv, true);
              *(int*)(H2 + (size_t)r * 1024 + c) = wv; } }
        float p[32];
#pragma unroll
        for (int e = 0; e < 32; ++e) p[e] = 0.f;
#pragma unroll
        for (int jj = 0; jj < 16; ++jj) {
#pragma unroll
            for (int eq = 0; eq < 8; ++eq) { const f32x4 wv = *(const LAS f32x4*)(WR + ((jj * 8 + eq) * 64 + lane) * 4);
#pragma unroll
                for (int i = 0; i < 4; ++i) p[4 * eq + i] += h[jj] * wv[i]; }
            asm volatile("" ::: "memory"); }
        float q16[16], q8[8], q4v[4], q2[2], q1;
#pragma unroll
        for (int k = 0; k < 16; ++k) q16[k] = swap32_sum(p[k], p[16 + k]);
#pragma unroll
        for (int k = 0; k < 8; ++k) q8[k] = swap16_sum(q16[k], q16[8 + k]);
        { const bool hi = (lane & 8) != 0;
#pragma unroll
          for (int k = 0; k < 4; ++k) { const float send = hi ? q8[k] : q8[4 + k], keep = hi ? q8[4 + k] : q8[k];
              q4v[k] = keep + __builtin_bit_cast(float, __builtin_amdgcn_update_dpp(0, __builtin_bit_cast(int, send), 0x128, 0xF, 0xF, true)); } }
        { const bool hi = (lane & 4) != 0;
#pragma unroll
          for (int k = 0; k < 2; ++k) { const float send = hi ? q4v[k] : q4v[2 + k], keep = hi ? q4v[2 + k] : q4v[k];
              int rv = __builtin_amdgcn_update_dpp(0, __builtin_bit_cast(int, send), 0x104, 0xF, 0x5, false);
              rv = __builtin_amdgcn_update_dpp(rv, __builtin_bit_cast(int, send), 0x114, 0xF, 0xA, false);
              q2[k] = keep + __builtin_bit_cast(float, rv); } }
        { const bool hi = (lane & 2) != 0; const float send = hi ? q2[0] : q2[1], keep = hi ? q2[1] : q2[0];
          q1 = keep + __builtin_bit_cast(float, __builtin_amdgcn_update_dpp(0, __builtin_bit_cast(int, send), 0x4E, 0xF, 0xF, true)); }
        q1 += __builtin_bit_cast(float, __builtin_amdgcn_update_dpp(0, __builtin_bit_cast(int, q1), 0xB1, 0xF, 0xF, true));
        const int rl = (r - r0) & 15;
        if (!(lane & 1)) Lg[rl * 33 + (lane >> 1)] = q1 + rbias;
        if (rl == 15) {
            asm volatile("s_waitcnt lgkmcnt(0)" ::: "memory");
            if (lane < 16) {
                float v0 = -3.0e38f, v1 = -3.0e38f, v2 = -3.0e38f, v3 = -3.0e38f; int i0 = 0, i1 = 0, i2 = 0, i3 = 0;
#pragma unroll
                for (int e = 0; e < 32; ++e) { const float x = Lg[lane * 33 + e];
                    const bool c0 = x > v0, c1 = x > v1, c2 = x > v2, c3 = x > v3;
                    v3 = c3 ? (c2 ? v2 : x) : v3; i3 = c3 ? (c2 ? i2 : e) : i3;
                    v2 = c2 ? (c1 ? v1 : x) : v2; i2 = c2 ? (c1 ? i1 : e) : i2;
                    v1 = c1 ? (c0 ? v0 : x) : v1; i1 = c1 ? (c0 ? i0 : e) : i1;
                    v0 = c0 ? x : v0; i0 = c0 ? e : i0; }
                const float e1 = __expf(v1 - v0), e2 = __expf(v2 - v0), e3 = __expf(v3 - v0); const float inv = 1.0f / (1.0f + e1 + e2 + e3);
                const int rr = r - 15 + lane;
                *(int4*)(TK + (size_t)rr * 4) = make_int4(i0, i1, i2, i3); *(f32x4*)(GT + (size_t)rr * 4) = (f32x4){inv, e1 * inv, e2 * inv, e3 * inv};
                __hip_atomic_fetch_add(&hist[i0], 1, __ATOMIC_RELAXED, __HIP_MEMORY_SCOPE_WORKGROUP); __hip_atomic_fetch_add(&hist[i1], 1, __ATOMIC_RELAXED, __HIP_MEMORY_SCOPE_WORKGROUP);
                __hip_atomic_fetch_add(&hist[i2], 1, __ATOMIC_RELAXED, __HIP_MEMORY_SCOPE_WORKGROUP); __hip_atomic_fetch_add(&hist[i3], 1, __ATOMIC_RELAXED, __HIP_MEMORY_SCOPE_WORKGROUP);
            }
            asm volatile("s_waitcnt lgkmcnt(0)" ::: "memory");
        }
    }
    __syncthreads();
    if (tid < 32) ((int*)(C.ws + WS_CNTBLK))[blockIdx.x * 32 + tid] = hist[tid];
    __syncthreads();
}
__device__ __forceinline__ void p_assign(const Ctx& C) {
    PH_IDS;
    LAS int* red = (LAS int*)C.lds;
    LAS int* base = (LAS int*)(C.lds + 4096);
    LAS int* total = (LAS int*)(C.lds + 4224);
    LAS int* segrow = (LAS int*)(C.lds + 4352);
    LAS int* run = (LAS int*)(C.lds + 4608);
    const int* cnt = (const int*)(C.ws + WS_CNTBLK);
    const int b = blockIdx.x;
    __syncthreads();
    { const int e = tid & 31, part = tid >> 5; int slt = 0, sall = 0;
      int vv[16];
#pragma unroll
      for (int q = 0; q < 16; ++q) vv[q] = __hip_atomic_load(cnt + (part * 16 + q) * 32 + e, __ATOMIC_RELAXED, __HIP_MEMORY_SCOPE_AGENT);
#pragma unroll
      for (int q = 0; q < 16; ++q) { sall += vv[q]; if (part * 16 + q < b) slt += vv[q]; }
      red[part * 32 + e] = slt; red[512 + part * 32 + e] = sall; }
    __syncthreads();
    if (tid < 32) { int s0 = 0, s1 = 0;
#pragma unroll
        for (int q = 0; q < 16; ++q) { s0 += red[q * 32 + tid]; s1 += red[512 + q * 32 + tid]; }
        base[tid] = s0; total[tid] = s1; run[tid] = 0; }
    __syncthreads();
    if (tid == 0) { int acc = 0; for (int e = 0; e < 32; ++e) { segrow[e] = acc * 256; if (b == 0) ((int*)(C.ws + WS_MOEINFO))[e] = acc; acc += (total[e] + 255) >> 8; } segrow[32] = acc * 256; if (b == 0) ((int*)(C.ws + WS_MOEINFO))[32] = acc; }
    __syncthreads();
    int* SP = (int*)(C.ws + WS_SLOTPOS); int* ST = (int*)(C.ws + WS_SLOTTOK); const int* TK = (const int*)(C.ws + WS_TOPK);
    const int rows_per_blk = MTOK / C.G;
    LAS int* gc = (LAS int*)(C.lds + 5120);
    int ge[2], grk[2], grow[2];
#pragma unroll
    for (int q = 0; q < 2; ++q) {
        const int g = 2 * wave + q, sidx = g * 64 + lane; grow[q] = b * rows_per_blk + (sidx >> 2);
        ge[q] = TK[(size_t)grow[q] * 4 + (sidx & 3)];
        int rk = 0, myc = 0;
        for (int ee = 0; ee < 32; ++ee) { const unsigned long long m = __ballot(ge[q] == ee);
            if (ge[q] == ee) rk = __popcll(m & ((1ull << lane) - 1ull));
            if (lane == ee) myc = __popcll(m); }
        grk[q] = rk;
        if (lane < 32) gc[g * 32 + lane] = myc;
    }
    __syncthreads();
#pragma unroll
    for (int q = 0; q < 2; ++q) {
        const int g = 2 * wave + q, sidx = g * 64 + lane; int off = 0;
        for (int gp = 0; gp < g; ++gp) off += gc[gp * 32 + ge[q]];
        const int pos = segrow[ge[q]] + base[ge[q]] + off + grk[q];
        SP[(size_t)grow[q] * 4 + (sidx & 3)] = pos; ST[pos] = grow[q];
    }
    if (b < 32) { const int e = b, tot = total[e], first = segrow[e] + tot, last = segrow[e + 1];
        for (int p = first + tid; p < last; p += 512) ST[p] = 0; }
    __syncthreads();
}

__device__ __forceinline__ void p_combine(const Ctx& C, const int layer) {
    PH_IDS;
    const int gw = blockIdx.x * 8 + wave, NGW = C.G * 8;
    const int per = MTOK / NGW;
    const float* MOD = (const float*)(C.ws + WS_MOD) + (size_t)layer * 9 * 6144;
    const float* MODN = (const float*)(C.ws + WS_MOD) + (size_t)9 * 6144;
    const float* gpost = C.a->in[IN_NFPOST] + layer * 1024; const float* gpre1 = C.a->in[IN_NMPRE] + 1024;
    const unsigned char* YS = (const unsigned char*)(C.ws + WS_YSLOT); const int* SP = (const int*)(C.ws + WS_SLOTPOS); const float* GT = (const float*)(C.ws + WS_GATE);
    float* OUT = C.a->out; bf16* XS = (bf16*)(C.ws + WS_XS); unsigned char* HN = (unsigned char*)(C.ws + WS_HN);
    int curb = -1; float cA1[16], cA2[16], cB2[16]; const int vz = vzero();
    const int rbeg = gw * per, rend = gw * per + per;
    int4 npos = *(const int4*)(SP + (size_t)(rbeg + vz) * 4); f32x4 ngt = *(const f32x4*)(GT + (size_t)(rbeg + vz) * 4);
    unsigned nys[4][4]; u32x2 nxv[4]; f32x4 cgt = ngt;
    { const int pp[4] = {npos.x, npos.y, npos.z, npos.w};
#pragma unroll
      for (int k = 0; k < 4; ++k)
#pragma unroll
          for (int j = 0; j < 4; ++j) nys[k][j] = *(const unsigned*)(YS + (size_t)pp[k] * 1024 + 4 * lane + 256 * j);
#pragma unroll
      for (int j = 0; j < 4; ++j) nxv[j] = *(const u32x2*)(XS + (size_t)rbeg * 1024 + 4 * lane + 256 * j); }
    if (rbeg + 1 < rend) { npos = *(const int4*)(SP + (size_t)(rbeg + 1 + vz) * 4); ngt = *(const f32x4*)(GT + (size_t)(rbeg + 1 + vz) * 4); }
    for (int r = rbeg; r < rend; ++r) {
        const int b = r >> 13;
        if (b != curb) { curb = b;
#pragma unroll
            for (int j = 0; j < 4; ++j) { const int c = 4 * lane + 256 * j;
                const f32x4 gp = *(const f32x4*)(gpost + c), gf = *(const f32x4*)(MOD + (size_t)b * 6144 + 5120 + c);
                const f32x4 gg = *(const f32x4*)(gpre1 + c), sc = *(const f32x4*)(MODN + (size_t)b * 6144 + 1024 + c), sh = *(const f32x4*)(MODN + (size_t)b * 6144 + c);
#pragma unroll
                for (int i = 0; i < 4; ++i) { cA1[4 * j + i] = gp[i] * gf[i]; cA2[4 * j + i] = gg[i] * (1.0f + sc[i]); cB2[4 * j + i] = sh[i]; } } }
        unsigned ys[4][4]; u32x2 xc[4]; const f32x4 gt = cgt;
#pragma unroll
        for (int k = 0; k < 4; ++k)
#pragma unroll
            for (int j = 0; j < 4; ++j) ys[k][j] = nys[k][j];
#pragma unroll
        for (int j = 0; j < 4; ++j) xc[j] = nxv[j];
        if (r + 1 < rend) {
            const int pp[4] = {npos.x, npos.y, npos.z, npos.w}; cgt = ngt;
#pragma unroll
            for (int k = 0; k < 4; ++k)
#pragma unroll
                for (int j = 0; j < 4; ++j) nys[k][j] = *(const unsigned*)(YS + (size_t)pp[k] * 1024 + 4 * lane + 256 * j);
#pragma unroll
            for (int j = 0; j < 4; ++j) nxv[j] = *(const u32x2*)(XS + (size_t)(r + 1) * 1024 + 4 * lane + 256 * j);
            if (r + 2 < rend) { npos = *(const int4*)(SP + (size_t)(r + 2 + vz) * 4); ngt = *(const f32x4*)(GT + (size_t)(r + 2 + vz) * 4); } }
        float f[16];
#pragma unroll
        for (int i = 0; i < 16; ++i) f[i] = 0.f;
#pragma unroll
        for (int k = 0; k < 4; ++k) { const float gk = gt[k] * 0.0625f;
#pragma unroll
            for (int j = 0; j < 4; ++j) { const f32v2_t lo = __builtin_amdgcn_cvt_pk_f32_fp8((int)ys[k][j], false), hi = __builtin_amdgcn_cvt_pk_f32_fp8((int)ys[k][j], true);
                f[4 * j] += gk * lo[0]; f[4 * j + 1] += gk * lo[1]; f[4 * j + 2] += gk * hi[0]; f[4 * j + 3] += gk * hi[1]; } }
        float ss = 0.f;
#pragma unroll
        for (int i = 0; i < 16; ++i) ss += f[i] * f[i];
        const float rstd = rsqrtf(wave_sum(ss) * (1.0f / 1024.0f) + EPS);
        float x2[16]; float ss2 = 0.f;
#pragma unroll
        for (int j = 0; j < 4; ++j) { const int c = 4 * lane + 256 * j;
            const f32x4 xv = (f32x4){bf_lo(xc[j].x), bf_hi(xc[j].x), bf_lo(xc[j].y), bf_hi(xc[j].y)};
            f32x4 o;
#pragma unroll
            for (int i = 0; i < 4; ++i) { o[i] = xv[i] + cA1[4 * j + i] * (f[4 * j + i] * rstd); x2[4 * j + i] = o[i]; ss2 += o[i] * o[i]; }
            if (layer == 0) { u32x2 xw; xw.x = cvt_pk(o[0], o[1]); xw.y = cvt_pk(o[2], o[3]); *(u32x2*)(XS + (size_t)r * 1024 + c) = xw; }
            else *(f32x4*)(OUT + (size_t)r * 1024 + c) = o; }
        if (layer == 0) {
            const float rstd2 = rsqrtf(wave_sum(ss2) * (1.0f / 1024.0f) + EPS);
#pragma unroll
            for (int j = 0; j < 4; ++j) { const int c = 4 * lane + 256 * j;
                float hv[4];
#pragma unroll
                for (int i = 0; i < 4; ++i) hv[i] = x2[4 * j + i] * rstd2 * cA2[4 * j + i] + cB2[4 * j + i];
                if (F8_IN1) *(unsigned*)(HN + (size_t)r * 1024 + c) = pk4_fp8(hv[0], hv[1], hv[2], hv[3], 8.f);
                else *(u32x2*)((bf16*)HN + (size_t)r * 1024 + c) = (u32x2){cvt_pk(hv[0], hv[1]), cvt_pk(hv[2], hv[3])}; }
        }
    }
}

__device__ __forceinline__ void p_conv(const Ctx& C) {
    PH_IDS;
    LAS unsigned char* L = C.lds;
    constexpr int O_X = 0;
    constexpr int O_W = 63488;
    const int w = wave;
    const bf16* GLU = (const bf16*)(C.ws + WS_GLU); const bf16* ZC1 = (const bf16*)(C.ws + WS_ZC1); const bf16* GB = (const bf16*)(C.ws + WS_GB);
    unsigned char* A2 = (unsigned char*)(C.ws + WS_A2B);
    __syncthreads();
    { float tmpw[31];
#pragma unroll
      for (int q = 0; q < 31; ++q) tmpw[q] = C.a->in[IN_ODDW][tid + 512 * q];
#pragma unroll
      for (int q = 0; q < 31; ++q) { const int i = tid + 512 * q; const int tap = i >> 9, c = i & 511; const int ln = c >> 3, half = (c >> 2) & 1, qq = c & 3;
          *(LAS float*)(L + O_W + (((tap * 2 + half) * 64 + ln) * 4 + qq) * 4) = tmpw[q]; } }
    float cb[8], lg[8], lb[8], sw0[8], sw1[8], sw2[8];
#pragma unroll
    for (int i = 0; i < 8; ++i) { const int c = 8 * lane + i; cb[i] = C.a->in[IN_ODDWB][c]; lg[i] = C.a->in[IN_ODLNG][c]; lb[i] = C.a->in[IN_ODLNB][c];
        sw0[i] = C.a->in[IN_ODSCONV][c]; sw1[i] = C.a->in[IN_ODSCONV][512 + c]; sw2[i] = C.a->in[IN_ODSCONV][1024 + c]; }
    u32x4 px[8];
    auto fetchx = [&](int unit) { const int bt = unit >> 8, t0 = (unit & 255) * 32;
#pragma unroll
        for (int q = 0; q < 8; ++q) { const int i = tid + 512 * q; const int rr = i >> 6, cc = i & 63; const int tl = t0 - 15 + rr;
            px[q] = (u32x4){0u, 0u, 0u, 0u};
            if (i < 62 * 64 && tl >= 0 && tl < SEQ) px[q] = *(const u32x4*)(GLU + (size_t)(bt * SEQ + tl) * 512 + cc * 8); } };
    if ((int)blockIdx.x < 2048) fetchx(blockIdx.x);
    for (int unit = blockIdx.x; unit < 2048; unit += C.G) {
        const int bt = unit >> 8, t0 = (unit & 255) * 32;
        __syncthreads();
#pragma unroll
        for (int q = 0; q < 8; ++q) { const int i = tid + 512 * q; if (i < 62 * 64) *(LAS u32x4*)(L + O_X + (i >> 6) * 1024 + (i & 63) * 16) = px[q]; }
        __syncthreads();
        if (unit + C.G < 2048) fetchx(unit + C.G);
        float acc[4][8];
#pragma unroll
        for (int o = 0; o < 4; ++o)
#pragma unroll
            for (int i = 0; i < 8; ++i) acc[o][i] = 0.f;
#pragma unroll 4
        for (int tap = 0; tap < 31; ++tap) {
            const f32x4 w0 = *(const LAS f32x4*)(L + O_W + ((tap * 2 + 0) * 64 + lane) * 16), w1 = *(const LAS f32x4*)(L + O_W + ((tap * 2 + 1) * 64 + lane) * 16);
#pragma unroll
            for (int o = 0; o < 4; ++o) {
                const u32x4 xr = *(const LAS u32x4*)(L + O_X + (4 * w + o + tap) * 1024 + lane * 16);
                acc[o][0] += bf_lo(xr[0]) * w0[0]; acc[o][1] += bf_hi(xr[0]) * w0[1]; acc[o][2] += bf_lo(xr[1]) * w0[2]; acc[o][3] += bf_hi(xr[1]) * w0[3];
                acc[o][4] += bf_lo(xr[2]) * w1[0]; acc[o][5] += bf_hi(xr[2]) * w1[1]; acc[o][6] += bf_lo(xr[3]) * w1[2]; acc[o][7] += bf_hi(xr[3]) * w1[3]; }
        }
        u32x4 sz0[4], sz1[4], sz2[4], sgb[4];
#pragma unroll
        for (int o = 0; o < 4; ++o) { const int tl = t0 + 4 * w + o; const size_t tok = (size_t)bt * SEQ + tl;
            sz1[o] = *(const u32x4*)(ZC1 + tok * 512 + 8 * lane); sz0[o] = (u32x4){0u, 0u, 0u, 0u}; sz2[o] = (u32x4){0u, 0u, 0u, 0u};
            if (tl >= 64) sz0[o] = *(const u32x4*)(ZC1 + (tok - 64) * 512 + 8 * lane);
            if (tl + 64 < SEQ) sz2[o] = *(const u32x4*)(ZC1 + (tok + 64) * 512 + 8 * lane);
            sgb[o] = *(const u32x4*)(GB + tok * 512 + 8 * lane); }
#pragma unroll
        for (int o = 0; o < 4; ++o) {
            const int tl = t0 + 4 * w + o; const size_t tok = (size_t)bt * SEQ + tl;
            float v[8]; float s = 0.f;
#pragma unroll
            for (int i = 0; i < 8; ++i) { v[i] = acc[o][i] + cb[i]; s += v[i]; }
            const float mu = wave_sum(s) * (1.0f / 512.0f); float q = 0.f;
#pragma unroll
            for (int i = 0; i < 8; ++i) { v[i] -= mu; q += v[i] * v[i]; }
            const float rstd = rsqrtf(wave_sum(q) * (1.0f / 512.0f) + EPS);
            float y[8];
#pragma unroll
            for (int i = 0; i < 8; ++i) y[i] = siluf_(v[i] * rstd * lg[i] + lb[i]);
            if (F8_OUT1) *(u32x2*)(A2 + tok * 1024 + 8 * lane) = (u32x2){pk4_fp8(y[0], y[1], y[2], y[3], 4.f), pk4_fp8(y[4], y[5], y[6], y[7], 4.f)};
            else *(u32x4*)((bf16*)A2 + tok * 1024 + 8 * lane) = (u32x4){cvt_pk(y[0], y[1]), cvt_pk(y[2], y[3]), cvt_pk(y[4], y[5]), cvt_pk(y[6], y[7])};
            const u32x4 z1 = sz1[o], z0 = sz0[o], z2 = sz2[o], gb = sgb[o];
            float zz[8];
#pragma unroll
            for (int i = 0; i < 4; ++i) {
                zz[2 * i] = (sw0[2 * i] * bf_lo(z0[i]) + sw1[2 * i] * bf_lo(z1[i]) + sw2[2 * i] * bf_lo(z2[i])) * bf_lo(gb[i]);
                zz[2 * i + 1] = (sw0[2 * i + 1] * bf_hi(z0[i]) + sw1[2 * i + 1] * bf_hi(z1[i]) + sw2[2 * i + 1] * bf_hi(z2[i])) * bf_hi(gb[i]); }
            if (F8_OUT1) *(u32x2*)(A2 + tok * 1024 + 512 + 8 * lane) = (u32x2){pk4_fp8(zz[0], zz[1], zz[2], zz[3], 4.f), pk4_fp8(zz[4], zz[5], zz[6], zz[7], 4.f)};
            else *(u32x4*)((bf16*)A2 + tok * 1024 + 512 + 8 * lane) = (u32x4){cvt_pk(zz[0], zz[1]), cvt_pk(zz[2], zz[3]), cvt_pk(zz[4], zz[5]), cvt_pk(zz[6], zz[7])};
        }
    }
    __syncthreads();
}

constexpr int NPHASE = 19;
#ifndef RUN_HI
#define RUN_HI NPHASE
#endif
__global__ void __launch_bounds__(512, 2) fwd_kernel(Args args) {
    extern __shared__ __attribute__((aligned(16))) unsigned char lds_raw[];
    Ctx C; C.lds = (LAS unsigned char*)lds_raw;
    C.G = gridDim.x; C.a = &args; C.ws = args.ws;
    volatile LAS unsigned* MISC = (volatile LAS unsigned*)(C.lds + MISC_OFF);
    if (threadIdx.x < 16) MISC[threadIdx.x] = 0u;
    __syncthreads();
    const int lo = args.ph_lo, hi = args.ph_hi;
    const bool multi = (hi - lo) > 1;
    XcdBarrier bar; bar.bar = (unsigned*)(C.ws + WS_CTL) + 4096; bar.x = 0; bar.st = MISC;
    if (multi) bar = xcd_barrier_post((unsigned*)(C.ws + WS_CTL) + 4096, MISC);
#ifndef PH_MASK
#define PH_MASK 0x7FFFF
#endif
#define IN(k) (((PH_MASK >> (k)) & 1) && lo <= (k) && (k) < hi)
#ifndef DUP_MASK
#define DUP_MASK 0
#endif
#ifndef GLA_PROBE
#define GLA_PROBE 0
#endif
#ifndef PROBE_NOEPI
#define PROBE_NOEPI 0
#endif
#define DUPN(k) (((DUP_MASK >> (k)) & 1) ? 2 : 1)
#define SEAM(k) do { if (IN(k) && IN((k) + 1)) xcd_barrier(bar); } while (0)
    LAS unsigned char* ring = C.lds;
    const int cid = blockIdx.x;

    if (IN(0)) for (int rep_ = 0; rep_ < DUPN(0); ++rep_) { p0_adaln(C); p0_fourier_fold(C); p0_convert(C); } SEAM(0);
    if (IN(1)) for (int rep_ = 0; rep_ < DUPN(1); ++rep_) { p_norm0(C); } SEAM(1);
    if (IN(2)) for (int rep_ = 0; rep_ < DUPN(2); ++rep_) { gm::SchedIn0 S{(const char*)(C.ws + WS_HN), (const char*)(C.ws + WS_WIN0), C.G, cid}; gm::EpiIn0 E{C.ws}; gm::gemm_phase<F8_IN0 != 0>(ring, F8_IN0 ? 1024 : 2048, S, E, 0x7C7C7C7C, 0x7A7A7A7A); } SEAM(2);
    if (IN(3)) for (int rep_ = 0; rep_ < DUPN(3); ++rep_) { p_gla_prep(C); if (GLA_PROBE == 1) p_gla_prep(C); if (GLA_PROBE >= 10) p_gla_prep(C, GLA_PROBE - 10); p_fft1(C); if (GLA_PROBE == 2) p_fft1(C); xcd_barrier(bar); p_gla(C); if (GLA_PROBE == 3) p_gla(C); if (GLA_PROBE == 4) p_gla(C, 1); } SEAM(3);
    if (IN(4)) for (int rep_ = 0; rep_ < DUPN(4); ++rep_) { p_fft2(C); p_gla_out(C); } SEAM(4);
    if (IN(5)) for (int rep_ = 0; rep_ < DUPN(5); ++rep_) { gm::SchedDense S{(const char*)(C.ws + WS_A2), (const char*)(C.ws + WS_WOUT0), F8_OUT0 ? 1536 : 3072, 256, 4, C.G, cid}; gm::EpiPlain E{(bf16*)(C.ws + WS_Y), 1024}; gm::gemm_phase<F8_OUT0 != 0>(ring, F8_OUT0 ? 1536 : 3072, S, E, 0x7C7C7C7C, 0x7A7A7A7A); } SEAM(5);
    if (IN(6)) for (int rep_ = 0; rep_ < DUPN(6); ++rep_) { p_postmix(C, 0); } SEAM(6);
    if (IN(7)) { p_assign(C); } SEAM(7);
    if (IN(8)) for (int rep_ = 0; rep_ < DUPN(8); ++rep_) { const int* tsp = (const int*)(C.ws + WS_MOEINFO); const int ln_ = otid() & 63; const int ts = __hip_atomic_load(tsp + (ln_ < 32 ? ln_ : 32), __ATOMIC_RELAXED, __HIP_MEMORY_SCOPE_AGENT);
        gm::SchedMoE S{(const char*)(C.ws + WS_H2), (const char*)(C.ws + WS_WGU), (const int*)(C.ws + WS_SLOTTOK), ts, __builtin_amdgcn_readlane(ts, 32), 8, C.G, cid, (size_t)2048 * 1024, true, args.in[IN_BGU]};
        gm::EpiGU E{(unsigned char*)(C.ws + WS_ACT), args.in[IN_BGU], PROBE_NOEPI ? rep_ : 0}; gm::gemm_phase<true>(ring, 1024, S, E, 0x7C7C7C7C, 0x7A7A7A7A); } SEAM(8);
    if (IN(9)) for (int rep_ = 0; rep_ < DUPN(9); ++rep_) { const int* tsp = (const int*)(C.ws + WS_MOEINFO); const int ln_ = otid() & 63; const int ts = __hip_atomic_load(tsp + (ln_ < 32 ? ln_ : 32), __ATOMIC_RELAXED, __HIP_MEMORY_SCOPE_AGENT);
        gm::SchedMoE S{(const char*)(C.ws + WS_ACT), (const char*)(C.ws + WS_WD), nullptr, ts, __builtin_amdgcn_readlane(ts, 32), 4, C.G, cid, (size_t)1024 * 1024, false, args.in[IN_BD]};
        gm::EpiDown E{(unsigned char*)(C.ws + WS_YSLOT), args.in[IN_BD]}; gm::gemm_phase<true>(ring, 1024, S, E, 0x7D7D7D7D, 0x7A7A7A7A); } SEAM(9);
    if (IN(10)) { p_combine(C, 0); } SEAM(10);
    if (IN(11)) for (int rep_ = 0; rep_ < DUPN(11); ++rep_) { gm::SchedDense S{(const char*)(C.ws + WS_HN), (const char*)(C.ws + WS_WIN1), F8_IN1 ? 1024 : 2048, 256, 10, C.G, cid}; gm::EpiIn1 E{C.ws}; gm::gemm_phase<F8_IN1 != 0>(ring, F8_IN1 ? 1024 : 2048, S, E, 0x7C7C7C7C, 0x7A7A7A7A); } SEAM(11);
    if (IN(12)) for (int rep_ = 0; rep_ < DUPN(12); ++rep_) { p_conv(C); } SEAM(12);
    if (IN(13)) for (int rep_ = 0; rep_ < DUPN(13); ++rep_) { gm::SchedDense S{(const char*)(C.ws + WS_A2B), (const char*)(C.ws + WS_WOUT1), F8_OUT1 ? 1024 : 2048, 256, 4, C.G, cid}; gm::EpiPlain E{(bf16*)(C.ws + WS_Y), 1024}; gm::gemm_phase<F8_OUT1 != 0>(ring, F8_OUT1 ? 1024 : 2048, S, E, 0x7D7D7D7D, 0x7A7A7A7A); } SEAM(13);
    if (IN(14)) { p_postmix(C, 1); } SEAM(14);
    if (IN(15)) { p_assign(C); } SEAM(15);
    if (IN(16)) for (int rep_ = 0; rep_ < DUPN(16); ++rep_) { const int* tsp = (const int*)(C.ws + WS_MOEINFO); const int ln_ = otid() & 63; const int ts = __hip_atomic_load(tsp + (ln_ < 32 ? ln_ : 32), __ATOMIC_RELAXED, __HIP_MEMORY_SCOPE_AGENT);
        gm::SchedMoE S{(const char*)(C.ws + WS_H2), (const char*)(C.ws + WS_WGU) + (size_t)32 * 2048 * 1024, (const int*)(C.ws + WS_SLOTTOK), ts, __builtin_amdgcn_readlane(ts, 32), 8, C.G, cid, (size_t)2048 * 1024, true, args.in[IN_BGU] + 32 * 2048};
        gm::EpiGU E{(unsigned char*)(C.ws + WS_ACT), args.in[IN_BGU] + 32 * 2048, 0}; gm::gemm_phase<true>(ring, 1024, S, E, 0x7C7C7C7C, 0x7A7A7A7A); } SEAM(16);
    if (IN(17)) for (int rep_ = 0; rep_ < DUPN(17); ++rep_) { const int* tsp = (const int*)(C.ws + WS_MOEINFO); const int ln_ = otid() & 63; const int ts = __hip_atomic_load(tsp + (ln_ < 32 ? ln_ : 32), __ATOMIC_RELAXED, __HIP_MEMORY_SCOPE_AGENT);
        gm::SchedMoE S{(const char*)(C.ws + WS_ACT), (const char*)(C.ws + WS_WD) + (size_t)32 * 1024 * 1024, nullptr, ts, __builtin_amdgcn_readlane(ts, 32), 4, C.G, cid, (size_t)1024 * 1024, false, args.in[IN_BD] + 32 * 1024};
        gm::EpiDown E{(unsigned char*)(C.ws + WS_YSLOT), args.in[IN_BD] + 32 * 1024}; gm::gemm_phase<true>(ring, 1024, S, E, 0x7D7D7D7D, 0x7A7A7A7A); } SEAM(17);
    if (IN(18)) { p_combine(C, 1); }
#ifdef DBG_COPY_OFF
    if (lo == 99) { const bf16* src = (const bf16*)(C.ws + (size_t)DBG_COPY_OFF); float* dst = args.out;
        for (size_t i = (size_t)blockIdx.x * 512 + threadIdx.x; i < (size_t)MTOK * 1024; i += (size_t)gridDim.x * 512) dst[i] = bf_lo((unsigned)src[i]); }
#endif
#undef IN
#undef SEAM
}

extern "C" void kernel_launch(void* const* d_in, const int* in_sizes, int n_in, void* d_out, int out_size, void* d_ws, size_t ws_size, hipStream_t stream) {
    static int grid = 0;
    if (grid == 0) {
        if (n_in != 28 || out_size != MTOK * D || ws_size < WS_END) { fprintf(stderr, "kernel_launch: unexpected problem (n_in %d out %d ws %zu need %zu)\n", n_in, out_size, ws_size, (size_t)WS_END); grid = -1; return; }
        int dev = 0, cus = 0, per_cu = 0;
        (void)hipGetDevice(&dev); (void)hipDeviceGetAttribute(&cus, hipDeviceAttributeMultiprocessorCount, dev);
        if (hipFuncSetAttribute((const void*)fwd_kernel, hipFuncAttributeMaxDynamicSharedMemorySize, LDS_BYTES) != hipSuccess) { fprintf(stderr, "kernel_launch: hipFuncSetAttribute failed\n"); grid = -1; return; }
        (void)hipOccupancyMaxActiveBlocksPerMultiprocessor(&per_cu, (const void*)fwd_kernel, 512, LDS_BYTES);
        (void)hipGetLastError();
        grid = cus;
        if (grid != 256 || per_cu < 1) { fprintf(stderr, "kernel_launch: needs a 256-CU device with one resident workgroup per CU (cus %d, per_cu %d)\n", cus, per_cu); grid = -1; return; }
    }
    if (grid < 0) return;
    (void)hipMemsetAsync((char*)d_ws + WS_CTL, 0, CTL_ZERO_BYTES, stream);
    Args a{};
    for (int i = 0; i < 28; ++i) a.in[i] = (const float*)d_in[i];
    a.out = (float*)d_out; a.ws = (unsigned char*)d_ws;
#if N_LAUNCH_MODE == 1
    a.ph_lo = 0; a.ph_hi = NPHASE;
    hipLaunchKernelGGL(fwd_kernel, dim3(grid), dim3(512), LDS_BYTES, stream, a);
#else
    for (int p = 0; p < RUN_HI; ++p) { a.ph_lo = p; a.ph_hi = p + 1; hipLaunchKernelGGL(fwd_kernel, dim3(grid), dim3(512), LDS_BYTES, stream, a); }
#ifdef DBG_COPY_OFF
    a.ph_lo = 99; a.ph_hi = 100; hipLaunchKernelGGL(fwd_kernel, dim3(grid), dim3(512), LDS_BYTES, stream, a);
#endif
#endif
}
```

```cpp
#include <hip/hip_runtime.h>
#include <cstdio>
#include <cstdint>

#ifndef N_LAUNCH_MODE
#define N_LAUNCH_MODE 1
#endif

#ifndef F8_IN0
#define F8_IN0 0
#endif
#ifndef F8_OUT0
#define F8_OUT0 0
#endif
#ifndef F8_IN1
#define F8_IN1 1
#endif
#ifndef F8_OUT1
#define F8_OUT1 1
#endif
#define LAS __attribute__((address_space(3)))
typedef unsigned short bf16;
typedef short bf16x8 __attribute__((ext_vector_type(8)));
typedef short s16x4 __attribute__((ext_vector_type(4)));
typedef float f32x4 __attribute__((ext_vector_type(4)));
typedef float f32x16 __attribute__((ext_vector_type(16)));
typedef unsigned u32x4 __attribute__((ext_vector_type(4)));
typedef unsigned u32x2 __attribute__((ext_vector_type(2)));

constexpr int D = 1024, NB = 8, SEQ = 8192, CTXL = 256;
constexpr int MTOK = NB * SEQ;
constexpr int MCTX = NB * CTXL;
constexpr int MALL = MTOK + MCTX;
constexpr int NE = 32, TOPK = 4;
constexpr int NSLOT_PAD = MTOK * TOPK + NE * 256;
constexpr int N_IN0 = 4352;
constexpr int N_IN1 = 2560;
constexpr float EPS = 1e-6f;

constexpr size_t MiB = 1u << 20;
constexpr size_t WS_CTL = 0, CTL_ZERO_BYTES = 65536;
constexpr size_t WS_MOD = 1 * MiB;
constexpr size_t WS_F1 = 2 * MiB;
constexpr size_t WS_F2 = 2 * MiB + 65536;
constexpr size_t WS_CNTBLK = 3 * MiB;
constexpr size_t WS_MOEINFO = 3 * MiB + 65536;
constexpr size_t WS_TOPK = 4 * MiB;
constexpr size_t WS_GATE = 5 * MiB;
constexpr size_t WS_SLOTPOS = 6 * MiB;
constexpr size_t WS_SLOTTOK = 7 * MiB;
constexpr size_t WS_WIN0 = 10 * MiB;
constexpr size_t WS_WOUT0 = 19 * MiB;
constexpr size_t WS_WIN1 = 22 * MiB;
constexpr size_t WS_WOUT1 = 27 * MiB;
constexpr size_t WS_WGU = 32 * MiB;
constexpr size_t WS_WD = 288 * MiB;
constexpr size_t WS_HN = 416 * MiB;
constexpr size_t WS_B = 548 * MiB;
constexpr size_t WS_ACT = WS_B;
constexpr size_t WS_YSLOT = WS_B + 528 * MiB;
constexpr size_t WS_Q = WS_B, WS_K = WS_B + 64 * MiB, WS_V = WS_B + 130 * MiB, WS_R = WS_B + 262 * MiB;
constexpr size_t WS_ZC = WS_B + 390 * MiB, WS_ZS = WS_B + 454 * MiB, WS_LR = WS_B + 518 * MiB;
constexpr size_t WS_OF = WS_B + 528 * MiB, WS_OB = WS_B + 656 * MiB, WS_YR = WS_B + 784 * MiB, WS_YI = WS_B + 848 * MiB;
constexpr size_t WS_A2 = WS_B;
constexpr size_t WS_Y = WS_B + 528 * MiB;
constexpr size_t WS_H2 = WS_B + 656 * MiB;
constexpr size_t WS_GLU = WS_B, WS_ZC1 = WS_B + 64 * MiB, WS_GB = WS_B + 128 * MiB, WS_A2B = WS_B + 192 * MiB;
constexpr size_t WS_XS = WS_B + 1056 * MiB;
constexpr size_t WS_GQP = WS_B + 1056 * MiB;
constexpr size_t WS_GKPP = WS_GQP + 132 * MiB;
constexpr size_t WS_GSC = WS_GKPP + 132 * MiB;
constexpr size_t WS_GEL = WS_GSC + 66 * MiB;
constexpr size_t WS_END = WS_GEL + 6 * MiB;

constexpr int LDS_BYTES = 155648;
constexpr int MISC_OFF = LDS_BYTES - 256;

__device__ __forceinline__ float bf_lo(unsigned u) { return __uint_as_float(u << 16); }
__device__ __forceinline__ float bf_hi(unsigned u) { return __uint_as_float(u & 0xffff0000u); }
typedef __bf16 bf16v2_t __attribute__((ext_vector_type(2)));
typedef float f32v2_t __attribute__((ext_vector_type(2)));
__device__ __forceinline__ unsigned cvt_pk(float lo, float hi) { const f32v2_t v = {lo, hi}; const bf16v2_t r = __builtin_convertvector(v, bf16v2_t); return __builtin_bit_cast(unsigned, r); }
__device__ __forceinline__ unsigned f2bf(float f) { unsigned u = __float_as_uint(f); return (u + 0x7fffu + ((u >> 16) & 1u)) >> 16; }
__device__ __forceinline__ float swap32_sum(float a, float b) {
    const auto r = __builtin_amdgcn_permlane32_swap(__builtin_bit_cast(unsigned, a), __builtin_bit_cast(unsigned, b), false, false);
    unsigned x = r[0], y = r[1]; asm volatile("" : "+v"(x), "+v"(y));
    return __builtin_bit_cast(float, x) + __builtin_bit_cast(float, y);
}
__device__ __forceinline__ float swap16_sum(float a, float b) {
    const auto r = __builtin_amdgcn_permlane16_swap(__builtin_bit_cast(unsigned, a), __builtin_bit_cast(unsigned, b), false, false);
    unsigned x = r[0], y = r[1]; asm volatile("" : "+v"(x), "+v"(y));
    return __builtin_bit_cast(float, x) + __builtin_bit_cast(float, y);
}
__device__ __forceinline__ float row16_sum(float v) {
    v += __builtin_bit_cast(float, __builtin_amdgcn_update_dpp(0, __builtin_bit_cast(int, v), 0xB1, 0xF, 0xF, true));
    v += __builtin_bit_cast(float, __builtin_amdgcn_update_dpp(0, __builtin_bit_cast(int, v), 0x4E, 0xF, 0xF, true));
    v += __builtin_bit_cast(float, __builtin_amdgcn_update_dpp(0, __builtin_bit_cast(int, v), 0x141, 0xF, 0xF, true));
    v += __builtin_bit_cast(float, __builtin_amdgcn_update_dpp(0, __builtin_bit_cast(int, v), 0x140, 0xF, 0xF, true));
    return v;
}
__device__ __forceinline__ float wave_sum(float v) {
    v = row16_sum(v);
    const int iv = __builtin_bit_cast(int, v);
    const float a = __builtin_bit_cast(float, __builtin_amdgcn_readlane(iv, 0)), b = __builtin_bit_cast(float, __builtin_amdgcn_readlane(iv, 16));
    const float c = __builtin_bit_cast(float, __builtin_amdgcn_readlane(iv, 32)), d = __builtin_bit_cast(float, __builtin_amdgcn_readlane(iv, 48));
    return (a + b) + (c + d);
}
__device__ __forceinline__ unsigned pk4_fp8(float a, float b, float c, float d, float sc) {
    int w = 0;
    w = __builtin_amdgcn_cvt_pk_fp8_f32(__builtin_amdgcn_fmed3f(a * sc, -440.f, 440.f), __builtin_amdgcn_fmed3f(b * sc, -440.f, 440.f), w, false);
    w = __builtin_amdgcn_cvt_pk_fp8_f32(__builtin_amdgcn_fmed3f(c * sc, -440.f, 440.f), __builtin_amdgcn_fmed3f(d * sc, -440.f, 440.f), w, true);
    return (unsigned)w;
}
__device__ __forceinline__ float sigmoidf_(float x) { return __builtin_amdgcn_rcpf(1.0f + __builtin_amdgcn_exp2f(x * -1.4426950408889634f)); }
__device__ __forceinline__ float siluf_(float x) { return x * sigmoidf_(x); }

#define XB_TMO      128
#define XB_XCNT(j)  (256  + 64 * (j))
#define XB_XSUB(j)  (1280 + 64 * (j))
#define XB_XGEN(j)  (2304 + 64 * (j))
#define XB_TOP      3328
#define XB_TOPGEN   3392
#define XCD_BAR_WORDS 3456
#define XB_SPIN_CAP (1u << 18)
__device__ __forceinline__ unsigned xb_ld(unsigned* p)              { return __hip_atomic_load(p, __ATOMIC_RELAXED, __HIP_MEMORY_SCOPE_AGENT); }
__device__ __forceinline__ unsigned xb_add(unsigned* p, unsigned v) { return __hip_atomic_fetch_add(p, v, __ATOMIC_RELAXED, __HIP_MEMORY_SCOPE_AGENT); }
__device__ __forceinline__ unsigned xb_xcc_id() { return (unsigned)__builtin_amdgcn_s_getreg((3 << 11) | 20) & 0xFu; }
#define XB_SPIN(cond, bar) do { unsigned _sp = 0; while (cond) { __builtin_amdgcn_s_sleep(1); \
    if ((++_sp & 255u) == 0u) { if (xb_ld(&(bar)[XB_TMO])) break; if (_sp > XB_SPIN_CAP) { atomicAdd(&(bar)[XB_TMO], 1u); break; } } } } while (0)
struct XcdBarrier { unsigned* bar; unsigned x; volatile LAS unsigned* st; };
__device__ __forceinline__ XcdBarrier xcd_barrier_post(unsigned* bar, volatile LAS unsigned* st) {
    XcdBarrier b; b.bar = bar; b.x = xb_xcc_id(); b.st = st;
    if (threadIdx.x == 0) (void)xb_add(&bar[XB_XCNT(b.x)], 1u);
    return b;
}
__device__ __forceinline__ void xcd_barrier_complete(unsigned* bar, unsigned x, unsigned& nloc, unsigned& nx) {
    const unsigned G = gridDim.x * gridDim.y * gridDim.z;
    unsigned sum, cnt, mine, sp = 0u;
    for (;;) {
        sum = 0u; cnt = 0u; mine = 0u;
#pragma unroll
        for (unsigned j = 0; j < 16; ++j) { const unsigned c = xb_ld(&bar[XB_XCNT(j)]); sum += c; cnt += (c > 0u) ? 1u : 0u; mine = (j == x) ? c : mine; }
        if (sum == G) break;
        __builtin_amdgcn_s_sleep(1);
        if ((++sp & 255u) == 0u) { if (xb_ld(&bar[XB_TMO])) break; if (sp > XB_SPIN_CAP) { atomicAdd(&bar[XB_TMO], 1u); break; } }
    }
    nloc = mine > 0u ? mine : 1u; nx = cnt > 0u ? cnt : 1u;
}
__device__ __forceinline__ void xcd_barrier(const XcdBarrier& b) {
    asm volatile("s_waitcnt vmcnt(0)" ::: "memory");
    __syncthreads();
    if (threadIdx.x == 0) {
        unsigned* bar = b.bar;
        __builtin_amdgcn_s_waitcnt(0);
        unsigned nloc = b.st[0], nx = b.st[1];
        if (nloc == 0u) { xcd_barrier_complete(bar, b.x, nloc, nx); b.st[0] = nloc; b.st[1] = nx; }
        const unsigned old = xb_add(&bar[XB_XSUB(b.x)], 1u);
        const unsigned gen = old / nloc;
        if (old + 1u == (gen + 1u) * nloc) {
            __builtin_amdgcn_fence(__ATOMIC_RELEASE, "agent");
            asm volatile("s_waitcnt vmcnt(0)" ::: "memory");
            const unsigned og = xb_add(&bar[XB_TOP], 1u);
            const unsigned tg = og / nx;
            if (og + 1u == (tg + 1u) * nx) xb_add(&bar[XB_TOPGEN], 1u);
            else XB_SPIN(xb_ld(&bar[XB_TOPGEN]) == tg, bar);
            __builtin_amdgcn_fence(__ATOMIC_ACQUIRE, "agent");
            xb_add(&bar[XB_XGEN(b.x)], 1u);
            asm volatile("s_waitcnt vmcnt(0)" ::: "memory");
        } else {
            XB_SPIN(xb_ld(&bar[XB_XGEN(b.x)]) == gen, bar);
            __builtin_amdgcn_fence(__ATOMIC_ACQUIRE, "agent");
            asm volatile("s_waitcnt vmcnt(0)" ::: "memory");
        }
    }
    __syncthreads();
}

struct Args {
    const float* in[28];
    float* out;
    unsigned char* ws;
    int ph_lo, ph_hi;
};
struct Ctx {
    LAS unsigned char* lds;
    int G;
    const Args* a;
    unsigned char* ws;
};
__device__ __forceinline__ int otid() { int t = (int)threadIdx.x; asm volatile("" : "+v"(t)); return t; }
__device__ __forceinline__ int vzero() { int z = 0; asm volatile("" : "+v"(z)); return z; }
#define PH_IDS const int tid = otid(), lane = tid & 63, wave = __builtin_amdgcn_readfirstlane(tid >> 6); (void)tid; (void)lane; (void)wave
#define IN_X 0
#define IN_C 1
#define IN_CTX 2
#define IN_CCTX 3
#define IN_MODW 4
#define IN_MODB 5
#define IN_NMPRE 6
#define IN_NMPOST 7
#define IN_NFPRE 8
#define IN_NFPOST 9
#define IN_EVWIN 10
#define IN_EVGKUP 11
#define IN_EVGKB 12
#define IN_EVGNORM 13
#define IN_EVWOUT 14
#define IN_ODWIN 15
#define IN_ODDW 16
#define IN_ODDWB 17
#define IN_ODLNG 18
#define IN_ODLNB 19
#define IN_ODSCONV 20
#define IN_ODWOUT 21
#define IN_RW 22
#define IN_RB 23
#define IN_WGU 24
#define IN_BGU 25
#define IN_WD 26
#define IN_BD 27

namespace gm {
constexpr int BM = 256, BK = 64, HALF = 128, HTB = HALF * BK * 2, STAGE_BYTES = 8 * HTB, NXCD = 8, WGM = 8;
constexpr int XT_OFF = 131072;
constexpr int XB_OFF = XT_OFF + 16384;
__device__ __forceinline__ int lds_byte(int r, int c) { const int st = (r >> 4) * 2 + (c >> 5), rr = r & 15, cc = c & 31, ob = rr * 64 + cc * 2; return st * 1024 + (ob ^ (((ob >> 9) & 1) << 5)); }
__device__ __forceinline__ void stage_rc(int b, int& R, int& C) { const int st = b / 1024, sb = b % 1024, swz = sb ^ (((sb >> 9) & 1) << 5); R = (st >> 1) * 16 + swz / 64; C = (st & 1) * 32 + (swz % 64) / 2; }
__device__ __forceinline__ int perm32(int rho) { const int n = rho >> 4, i = rho & 15; return 8 * (i >> 2) + 4 * n + (i & 3); }
struct Unit { int pm, pn, e; };

__device__ __forceinline__ void dense_map(int L, int nM, int nN, int& pm, int& pn) {
    const int nwg = nM * nN; int wgid = L;
    { const int q = nwg / NXCD, r = nwg % NXCD, xcd = wgid % NXCD, off = wgid / NXCD; wgid = (xcd < r ? xcd * (q + 1) : r * (q + 1) + (xcd - r) * q) + off; }
    const int nig = WGM * nN, gid = wgid / nig, fm = gid * WGM, gsz = (nM - fm) < WGM ? (nM - fm) : WGM;
    pm = fm + ((wgid % nig) % gsz); pn = (wgid % nig) / gsz;
}

typedef int i32x8 __attribute__((ext_vector_type(8)));
typedef int i32x4_ __attribute__((ext_vector_type(4)));
template <bool F8, class Epi, class Sched>
__device__ __forceinline__ void gemm_phase(LAS unsigned char* lds, const int RP, const Sched& S, const Epi& E, const int SCA = 0x7F7F7F7F, const int SCB = 0x7F7F7F7F) {
    const int tid = otid(), wid = __builtin_amdgcn_readfirstlane(tid >> 6), lane = tid & 63, wr = wid >> 2, wc = wid & 3, fr = lane & 15, fq = lane >> 4;
    const int nt = RP / 128;
    unsigned voffB[2];
#pragma unroll
    for (int i = 0; i < 2; ++i) { int R, C; stage_rc(tid * 16 + i * 8192, R, C); const int Rb = (R & ~31) + perm32(R & 31); voffB[i] = (unsigned)(Rb * RP + C * 2); }
    const size_t kstep = (size_t)128;
    const size_t hstepB = (size_t)HALF * RP;
    const unsigned ldsw = (unsigned)wid * 1024u;
    const int aoff = F8 ? lds_byte(wr * 64 + fr, (fq >> 1) * 32 + (fq & 1) * 16) : lds_byte(wr * 64 + fr, fq * 8);
    const int boff = F8 ? lds_byte(wc * 32 + fr, (fq >> 1) * 32 + (fq & 1) * 16) : lds_byte(wc * 32 + fr, fq * 8);
    constexpr int KOFF = F8 ? 16 : 1024;
#define G_SA(b, h) (((b) * 2 + (h)) * HTB)
#define G_SB(b, h) ((4 + (b) * 2 + (h)) * HTB)
#define G_STAGEB(bufoff, gbase) do { _Pragma("unroll") for (int _i = 0; _i < 2; ++_i) \
        __builtin_amdgcn_global_load_lds((const unsigned*)((const char*)(gbase) + voffB[_i]), (LAS unsigned*)(lds + (bufoff) + ldsw + _i * 8192), 16, 0, 0); } while (0)
#define G_STAGEA(bufoff, offs, h, kb) do { _Pragma("unroll") for (int _i = 0; _i < 2; ++_i) \
        __builtin_amdgcn_global_load_lds((const unsigned*)(S.abase() + (size_t)(offs)[h][_i] + (kb)), (LAS unsigned*)(lds + (bufoff) + ldsw + _i * 8192), 16, 0, 0); } while (0)
#define G_LDA(dst, b, h) do { _Pragma("unroll") for (int m = 0; m < 4; ++m) _Pragma("unroll") for (int k = 0; k < 2; ++k) dst[m][k] = *(const LAS bf16x8*)(lds + G_SA(b, h) + aoff + m * 2048 + k * KOFF); } while (0)
#define G_LDB(dst, b, h) do { _Pragma("unroll") for (int n = 0; n < 2; ++n) _Pragma("unroll") for (int k = 0; k < 2; ++k) dst[n][k] = *(const LAS bf16x8*)(lds + G_SB(b, h) + boff + n * 2048 + k * KOFF); } while (0)
#define G_CAT8(x) __builtin_shufflevector(__builtin_bit_cast(i32x4_, (x)[0]), __builtin_bit_cast(i32x4_, (x)[1]), 0, 1, 2, 3, 4, 5, 6, 7)
#define G_MMA(ai, bj, At, Bt) do { __builtin_amdgcn_s_setprio(1); \
        if constexpr (F8) { _Pragma("unroll") for (int m = 0; m < 4; ++m) _Pragma("unroll") for (int n = 0; n < 2; ++n) \
            acc[ai][bj][m][n] = __builtin_amdgcn_mfma_scale_f32_16x16x128_f8f6f4(G_CAT8(Bt[n]), G_CAT8(At[m]), acc[ai][bj][m][n], 0, 0, 0, SCB, 0, SCA); } \
        else { _Pragma("unroll") for (int m = 0; m < 4; ++m) _Pragma("unroll") for (int n = 0; n < 2; ++n) _Pragma("unroll") for (int k = 0; k < 2; ++k) \
            acc[ai][bj][m][n] = __builtin_amdgcn_mfma_f32_16x16x32_bf16(Bt[n][k], At[m][k], acc[ai][bj][m][n], 0, 0, 0); } \
        __builtin_amdgcn_s_setprio(0); } while (0)
#define G_WAIT_V(n) asm volatile("s_waitcnt vmcnt(" #n ")" ::: "memory")
#define G_WAIT_L(n) asm volatile("s_waitcnt lgkmcnt(" #n ")" ::: "memory")
#define G_BAR __builtin_amdgcn_s_barrier()
#define G_SCHED __builtin_amdgcn_sched_barrier(0)
    Unit cur, nxt; int ui = 0;
    if (!S.next(0, cur)) return;
    f32x4 acc[2][2][4][2];
#pragma unroll
    for (int a = 0; a < 2; ++a)
#pragma unroll
        for (int b = 0; b < 2; ++b)
#pragma unroll
            for (int m = 0; m < 4; ++m)
#pragma unroll
                for (int n = 0; n < 2; ++n) acc[a][b][m][n] = (f32x4){0.f, 0.f, 0.f, 0.f};
    bf16x8 At[4][2], B0[2][2], B1[2][2];
    unsigned cAo[2][2];
    S.a_off(cur, cAo);
    const char* cB = S.b_ptr(cur);
    S.prefetch_bias(cur, lds, 0, wid, lane, wc);
    G_STAGEB(G_SB(0, 0), cB); G_STAGEA(G_SA(0, 0), cAo, 0, 0); G_STAGEB(G_SB(0, 1), cB + hstepB); G_STAGEA(G_SA(0, 1), cAo, 1, 0);
    if (wr == 1) G_BAR;
    G_WAIT_V(4); G_BAR;
    G_STAGEB(G_SB(1, 0), cB + kstep); G_STAGEA(G_SA(1, 0), cAo, 0, kstep); G_STAGEB(G_SB(1, 1), cB + hstepB + kstep);
    G_WAIT_V(6); G_BAR;
    for (;;) {
        const bool has_next = S.next(ui + 1, nxt);
        const char* nB = cB;
        if (has_next) { S.prefetch_rows(nxt, lds, (ui + 1) & 1, wid, lane); S.prefetch_bias(nxt, lds, (ui + 1) & 1, wid, lane, wc); nB = S.b_ptr(nxt); }
        for (int t = 0; t < nt; t += 2) {
            const bool last = (t == nt - 2);
            const size_t k1 = (size_t)(t + 1) * kstep;
            G_LDB(B0, 0, 0); G_SCHED; G_LDA(At, 0, 0); G_STAGEA(G_SA(1, 1), cAo, 1, k1);
            if (last) { if (has_next) S.a_off_lds(nxt, lds, (ui + 1) & 1, wid, lane, cAo); cB = nB; }
            const size_t k2 = last ? 0 : (size_t)(t + 2) * kstep;
            const size_t k3 = k2 + kstep;
            const char* b2 = cB + k2; const char* b3 = b2 + kstep;
            G_WAIT_L(8); G_BAR; G_WAIT_L(0); G_MMA(0, 0, At, B0); G_BAR; G_SCHED;
            G_LDB(B1, 0, 1); G_STAGEB(G_SB(0, 0), b2);
            G_BAR; G_WAIT_L(0); G_MMA(0, 1, At, B1); G_BAR;
            G_LDA(At, 0, 1); G_STAGEA(G_SA(0, 0), cAo, 0, k2);
            G_BAR; G_WAIT_L(0); G_MMA(1, 0, At, B0); G_BAR; G_SCHED;
            G_STAGEB(G_SB(0, 1), b2 + hstepB);
            G_WAIT_V(6); G_BAR; G_MMA(1, 1, At, B1); G_BAR;
            G_LDB(B0, 1, 0); G_SCHED; G_LDA(At, 1, 0); G_STAGEA(G_SA(0, 1), cAo, 1, k2);
            G_WAIT_L(8); G_BAR; G_WAIT_L(0); G_MMA(0, 0, At, B0); G_BAR; G_SCHED;
            G_LDB(B1, 1, 1); G_STAGEB(G_SB(1, 0), b3);
            G_BAR; G_WAIT_L(0); G_MMA(0, 1, At, B1); G_BAR;
            G_LDA(At, 1, 1); G_STAGEA(G_SA(1, 0), cAo, 0, k3);
            G_BAR; G_WAIT_L(0); G_MMA(1, 0, At, B0); G_BAR; G_SCHED;
            G_STAGEB(G_SB(1, 1), b3 + hstepB);
            G_WAIT_V(6); G_BAR; G_MMA(1, 1, At, B1); G_BAR;
        }
        E(acc, cur, wr, wc, fr, fq, (const LAS float*)(lds + XB_OFF + ((ui & 1) * 8 + wid) * 256));
        if (!has_next) break;
#pragma unroll
        for (int a = 0; a < 2; ++a)
#pragma unroll
            for (int b = 0; b < 2; ++b)
#pragma unroll
                for (int m = 0; m < 4; ++m)
#pragma unroll
                    for (int n = 0; n < 2; ++n) acc[a][b][m][n] = (f32x4){0.f, 0.f, 0.f, 0.f};
        cur = nxt; ++ui;
    }
    G_WAIT_V(0);
    if (wr == 0) G_BAR;
    G_BAR;
#undef G_SA
#undef G_SB
#undef G_STAGEA
#undef G_STAGEB
#undef G_LDA
#undef G_LDB
#undef G_MMA
#undef G_CAT8
#undef G_WAIT_V
#undef G_WAIT_L
#undef G_BAR
#undef G_SCHED
}

__device__ __forceinline__ void lane_rc(int i, int& R, int& Cb) { int C; stage_rc(otid() * 16 + i * 8192, R, C); Cb = C * 2; }

struct SchedDense {
    const char* A; const char* B; int RP, nM, nN, G, c;
    __device__ __forceinline__ const char* abase() const { return A; }
    __device__ __forceinline__ bool next(int i, Unit& u) const { const long L = (long)i * G + c; if (L >= (long)nM * nN) return false; dense_map((int)L, nM, nN, u.pm, u.pn); u.e = 0; return true; }
    __device__ __forceinline__ void a_off(const Unit& u, unsigned (&o)[2][2]) const {
#pragma unroll
        for (int i = 0; i < 2; ++i) { int R, Cb; lane_rc(i, R, Cb);
#pragma unroll
            for (int h = 0; h < 2; ++h) o[h][i] = (unsigned)(u.pm * BM + h * HALF + R) * (unsigned)RP + (unsigned)Cb; }
    }
    __device__ __forceinline__ void prefetch_rows(const Unit&, LAS unsigned char*, int, int, int) const {}
    __device__ __forceinline__ void prefetch_bias(const Unit&, LAS unsigned char*, int, int, int, int) const {}
    __device__ __forceinline__ void a_off_lds(const Unit& u, LAS unsigned char*, int, int, int, unsigned (&o)[2][2]) const { a_off(u, o); }
    __device__ __forceinline__ const char* b_ptr(const Unit& u) const { return B + (size_t)u.pn * BM * RP; }
};
struct SchedIn0 {
    const char* A; const char* B; int G, c;
    __device__ __forceinline__ const char* abase() const { return A; }
    __device__ __forceinline__ bool next(int i, Unit& u) const {
        const long L = (long)i * G + c; u.e = 0;
        if (L < 256 * 17) { dense_map((int)L, 256, 17, u.pm, u.pn); return true; }
        const int r = (int)(L - 256 * 17); if (r >= 56) return false;
        u.pm = 256 + r / 7; const int q = r % 7; u.pn = (q < 6) ? (2 + q) : 16; return true;
    }
    __device__ __forceinline__ void a_off(const Unit& u, unsigned (&o)[2][2]) const {
#pragma unroll
        for (int i = 0; i < 2; ++i) { int R, Cb; lane_rc(i, R, Cb);
#pragma unroll
            for (int h = 0; h < 2; ++h) o[h][i] = (unsigned)(u.pm * BM + h * HALF + R) * (F8_IN0 ? 1024u : 2048u) + (unsigned)Cb; }
    }
    __device__ __forceinline__ void prefetch_rows(const Unit&, LAS unsigned char*, int, int, int) const {}
    __device__ __forceinline__ void prefetch_bias(const Unit&, LAS unsigned char*, int, int, int, int) const {}
    __device__ __forceinline__ void a_off_lds(const Unit& u, LAS unsigned char*, int, int, int, unsigned (&o)[2][2]) const { a_off(u, o); }
    __device__ __forceinline__ const char* b_ptr(const Unit& u) const { return B + (size_t)u.pn * BM * (F8_IN0 ? 1024 : 2048); }
};
struct SchedMoE {
    const char* A; const char* B; const int* slot_tok; int ts; int RT; int nct; int G, c; size_t bstride_e; bool gather; const float* bias;
    __device__ __forceinline__ const char* abase() const { return A; }
    __device__ __forceinline__ bool next(int i, Unit& u) const {
        const int x = c & 7, j = c >> 3; int rt, ct;
        if (nct == 8) { rt = 32 * i + 4 * x + (j & 3); ct = j >> 2; } else { rt = 64 * i + 8 * x + (j & 7); ct = j >> 3; }
        if (rt >= RT) return false;
        const unsigned long long m = __ballot(((otid() & 63) < 32) && ts <= rt);
        u.pm = rt; u.pn = ct; u.e = __builtin_amdgcn_readfirstlane(__popcll(m)) - 1; return true;
    }
    __device__ __forceinline__ void a_off(const Unit& u, unsigned (&o)[2][2]) const {
#pragma unroll
        for (int i = 0; i < 2; ++i) { int R, Cb; lane_rc(i, R, Cb);
#pragma unroll
            for (int h = 0; h < 2; ++h) { const int row = u.pm * BM + h * HALF + R; const unsigned rr = gather ? (unsigned)slot_tok[row] : (unsigned)row; o[h][i] = rr * 1024u + (unsigned)Cb; } }
    }
    __device__ __forceinline__ const char* b_ptr(const Unit& u) const { return B + (size_t)u.e * bstride_e + (size_t)u.pn * BM * 1024; }
    __device__ __forceinline__ void prefetch_rows(const Unit& u, LAS unsigned char* lds, int par, int wid, int lane) const {
        if (!gather) return;
#pragma unroll
        for (int i = 0; i < 2; ++i) { int R, Cb; lane_rc(i, R, Cb);
#pragma unroll
            for (int h = 0; h < 2; ++h) __builtin_amdgcn_global_load_lds((const unsigned*)(slot_tok + (u.pm * BM + h * HALF + R)), (LAS unsigned*)(lds + XT_OFF + ((par * 8 + wid) * 4 + h * 2 + i) * 256), 4, 0, 0); }
    }
    __device__ __forceinline__ void prefetch_bias(const Unit& u, LAS unsigned char* lds, int par, int wid, int lane, int wc) const {
        const float* src = (nct == 8) ? bias + (size_t)u.e * 2048 + (lane >> 5) * 1024 + u.pn * 128 + wc * 32 + (lane & 31)
                                      : bias + (size_t)u.e * 1024 + u.pn * 256 + (lane >> 5) * 128 + wc * 32 + (lane & 31);
        __builtin_amdgcn_global_load_lds((const unsigned*)src, (LAS unsigned*)(lds + XB_OFF + (par * 8 + wid) * 256), 4, 0, 0);
    }
    __device__ __forceinline__ void a_off_lds(const Unit& u, LAS unsigned char* lds, int par, int wid, int lane, unsigned (&o)[2][2]) const {
#pragma unroll
        for (int i = 0; i < 2; ++i) { int R, Cb; lane_rc(i, R, Cb);
#pragma unroll
            for (int h = 0; h < 2; ++h) { const unsigned rr = gather ? *(const LAS unsigned*)(lds + XT_OFF + ((par * 8 + wid) * 4 + h * 2 + i) * 256 + lane * 4) : (unsigned)(u.pm * BM + h * HALF + R); o[h][i] = rr * 1024u + (unsigned)Cb; } }
    }
};

__device__ __forceinline__ void store8(bf16* p, const f32x4& v0, const f32x4& v1) {
    u32x4 w; w.x = cvt_pk(v0[0], v0[1]); w.y = cvt_pk(v0[2], v0[3]); w.z = cvt_pk(v1[0], v1[1]); w.w = cvt_pk(v1[2], v1[3]);
    *(u32x4*)p = w;
}
struct EpiPlain {
    bf16* O; int ldc;
    __device__ __forceinline__ void operator()(const f32x4 (&acc)[2][2][4][2], const Unit& u, int wr, int wc, int fr, int fq, const LAS float* lb) const {
        const int row0 = u.pm * BM + wr * 64 + fr, col0 = u.pn * BM + wc * 32 + 8 * fq;
#pragma unroll
        for (int ai = 0; ai < 2; ++ai)
#pragma unroll
            for (int m = 0; m < 4; ++m) { bf16* rowp = O + (size_t)(row0 + ai * HALF + m * 16) * ldc + col0;
#pragma unroll
                for (int bj = 0; bj < 2; ++bj) store8(rowp + bj * HALF, acc[ai][bj][m][0], acc[ai][bj][m][1]); }
    }
};
struct EpiIn0 {
    unsigned char* ws;
    __device__ __forceinline__ void operator()(const f32x4 (&acc)[2][2][4][2], const Unit& u, int wr, int wc, int fr, int fq, const LAS float* lb) const {
        const int pn = u.pn; bf16* base; int ldc, c0;
        if (pn < 2) { base = (bf16*)(ws + WS_Q); ldc = 512; c0 = pn * 256; }
        else if (pn < 4) { base = (bf16*)(ws + WS_K); ldc = 512; c0 = (pn - 2) * 256; }
        else if (pn < 8) { base = (bf16*)(ws + WS_V); ldc = 1024; c0 = (pn - 4) * 256; }
        else if (pn < 12) { base = (bf16*)(ws + WS_R); ldc = 1024; c0 = (pn - 8) * 256; }
        else if (pn < 14) { base = (bf16*)(ws + WS_ZC); ldc = 512; c0 = (pn - 12) * 256; }
        else if (pn < 16) { base = (bf16*)(ws + WS_ZS); ldc = 512; c0 = (pn - 14) * 256; }
        else { base = (bf16*)(ws + WS_LR); ldc = 32; c0 = 0; }
        const int row0 = u.pm * BM + wr * 64 + fr, col0 = c0 + wc * 32 + 8 * fq;
        const bool lr = (pn == 16);
        if (lr && wc != 0) return;
        const float qs = (pn < 2) ? 0.08838834764831845f : 1.0f;
#pragma unroll
        for (int ai = 0; ai < 2; ++ai)
#pragma unroll
            for (int m = 0; m < 4; ++m) { bf16* rowp = base + (size_t)(row0 + ai * HALF + m * 16) * ldc + col0;
                store8(rowp, acc[ai][0][m][0] * qs, acc[ai][0][m][1] * qs);
                if (!lr) store8(rowp + HALF, acc[ai][1][m][0] * qs, acc[ai][1][m][1] * qs); }
    }
};
struct EpiIn1 {
    unsigned char* ws;
    __device__ __forceinline__ void operator()(const f32x4 (&acc)[2][2][4][2], const Unit& u, int wr, int wc, int fr, int fq, const LAS float* lb) const {
        const int pn = u.pn; const int row0 = u.pm * BM + wr * 64 + fr;
        if (pn >= 8) { bf16* O = (bf16*)(ws + WS_GB); const int col0 = (pn - 8) * 256 + wc * 32 + 8 * fq;
#pragma unroll
            for (int ai = 0; ai < 2; ++ai)
#pragma unroll
                for (int m = 0; m < 4; ++m) { bf16* rowp = O + (size_t)(row0 + ai * HALF + m * 16) * 512 + col0;
#pragma unroll
                    for (int bj = 0; bj < 2; ++bj) store8(rowp + bj * HALF, acc[ai][bj][m][0], acc[ai][bj][m][1]); }
            return; }
        const bool glu = pn < 4; bf16* O = (bf16*)(ws + (glu ? WS_GLU : WS_ZC1)); const int col0 = (pn & 3) * 128 + wc * 32 + 8 * fq;
#pragma unroll
        for (int ai = 0; ai < 2; ++ai)
#pragma unroll
            for (int m = 0; m < 4; ++m) { f32x4 o[2];
#pragma unroll
                for (int n = 0; n < 2; ++n)
#pragma unroll
                    for (int i = 0; i < 4; i += 2) { const f32v2_t a = (f32v2_t){acc[ai][0][m][n][i], acc[ai][0][m][n][i + 1]}, b = (f32v2_t){acc[ai][1][m][n][i], acc[ai][1][m][n][i + 1]};
                        f32v2_t ov;
                        if (glu) { const f32v2_t ea = b * -1.4426950408889634f; f32v2_t e; e.x = __builtin_amdgcn_exp2f(ea.x); e.y = __builtin_amdgcn_exp2f(ea.y);
                            const f32v2_t d = e + 1.0f; f32v2_t r; r.x = __builtin_amdgcn_rcpf(d.x); r.y = __builtin_amdgcn_rcpf(d.y); ov = a * r; }
                        else ov = a * b;
                        o[n][i] = ov.x; o[n][i + 1] = ov.y; }
                store8(O + (size_t)(row0 + ai * HALF + m * 16) * 512 + col0, o[0], o[1]); }
    }
};
struct EpiGU {
    unsigned char* O; const float* bgu; int probe;
    __device__ __forceinline__ void operator()(const f32x4 (&acc)[2][2][4][2], const Unit& u, int wr, int wc, int fr, int fq, const LAS float* lb) const {
        if (probe) {
#pragma unroll
            for (int a = 0; a < 2; ++a)
#pragma unroll
                for (int b = 0; b < 2; ++b)
#pragma unroll
                    for (int m = 0; m < 4; ++m)
#pragma unroll
                        for (int n = 0; n < 2; ++n) asm volatile("" :: "v"(acc[a][b][m][n]));
            return; }
        const int row0 = u.pm * BM + wr * 64 + fr, col0 = u.pn * 128 + wc * 32 + 8 * fq;
        f32x4 bgv[2], buv[2];
#pragma unroll
        for (int n = 0; n < 2; ++n) { bgv[n] = *(const LAS f32x4*)(lb + 8 * fq + 4 * n); buv[n] = *(const LAS f32x4*)(lb + 32 + 8 * fq + 4 * n); }
#pragma unroll
        for (int ai = 0; ai < 2; ++ai)
#pragma unroll
            for (int m = 0; m < 4; ++m) { f32x4 o[2];
#pragma unroll
                for (int n = 0; n < 2; ++n)
#pragma unroll
                    for (int i = 0; i < 4; i += 2) {
                        f32v2_t g = (f32v2_t){acc[ai][0][m][n][i], acc[ai][0][m][n][i + 1]} + (f32v2_t){bgv[n][i], bgv[n][i + 1]};
                        f32v2_t uu = (f32v2_t){acc[ai][1][m][n][i], acc[ai][1][m][n][i + 1]} + (f32v2_t){buv[n][i], buv[n][i + 1]};
                        g.x = fminf(g.x, 7.0f); g.y = fminf(g.y, 7.0f);
                        uu.x = __builtin_amdgcn_fmed3f(uu.x, -7.0f, 7.0f); uu.y = __builtin_amdgcn_fmed3f(uu.y, -7.0f, 7.0f);
                        const f32v2_t ea = g * (-1.702f * 1.4426950408889634f);
                        f32v2_t e; e.x = __builtin_amdgcn_exp2f(ea.x); e.y = __builtin_amdgcn_exp2f(ea.y);
                        const f32v2_t d = e + 1.0f;
                        f32v2_t r; r.x = __builtin_amdgcn_rcpf(d.x); r.y = __builtin_amdgcn_rcpf(d.y);
                        const f32v2_t t4 = uu * 4.0f + 4.0f;
                        const f32v2_t ov = (g * r) * t4;
                        o[n][i] = ov.x; o[n][i + 1] = ov.y; }
                int w0 = 0, w1 = 0;
                w0 = __builtin_amdgcn_cvt_pk_fp8_f32(o[0][0], o[0][1], w0, false); w0 = __builtin_amdgcn_cvt_pk_fp8_f32(o[0][2], o[0][3], w0, true);
                w1 = __builtin_amdgcn_cvt_pk_fp8_f32(o[1][0], o[1][1], w1, false); w1 = __builtin_amdgcn_cvt_pk_fp8_f32(o[1][2], o[1][3], w1, true);
                *(u32x2*)(O + (size_t)(row0 + ai * HALF + m * 16) * 1024 + col0) = (u32x2){(unsigned)w0, (unsigned)w1}; }
    }
};
struct EpiDown {
    unsigned char* O; const float* bd;
    __device__ __forceinline__ void operator()(const f32x4 (&acc)[2][2][4][2], const Unit& u, int wr, int wc, int fr, int fq, const LAS float* lb) const {
        const int row0 = u.pm * BM + wr * 64 + fr, col0 = u.pn * BM + wc * 32 + 8 * fq;
        f32x4 bv[2][2];
#pragma unroll
        for (int bj = 0; bj < 2; ++bj)
#pragma unroll
            for (int n = 0; n < 2; ++n) bv[bj][n] = *(const LAS f32x4*)(lb + 32 * bj + 8 * fq + 4 * n) * 16.0f;
#pragma unroll
        for (int ai = 0; ai < 2; ++ai)
#pragma unroll
            for (int m = 0; m < 4; ++m) { unsigned char* rowp = O + (size_t)(row0 + ai * HALF + m * 16) * 1024 + col0;
#pragma unroll
                for (int bj = 0; bj < 2; ++bj) { const f32x4 v0 = acc[ai][bj][m][0] * 16.0f + bv[bj][0], v1 = acc[ai][bj][m][1] * 16.0f + bv[bj][1];
                    int w0 = 0, w1 = 0;
                    w0 = __builtin_amdgcn_cvt_pk_fp8_f32(fminf(fmaxf(v0[0], -440.f), 440.f), fminf(fmaxf(v0[1], -440.f), 440.f), w0, false); w0 = __builtin_amdgcn_cvt_pk_fp8_f32(fminf(fmaxf(v0[2], -440.f), 440.f), fminf(fmaxf(v0[3], -440.f), 440.f), w0, true);
                    w1 = __builtin_amdgcn_cvt_pk_fp8_f32(fminf(fmaxf(v1[0], -440.f), 440.f), fminf(fmaxf(v1[1], -440.f), 440.f), w1, false); w1 = __builtin_amdgcn_cvt_pk_fp8_f32(fminf(fmaxf(v1[2], -440.f), 440.f), fminf(fmaxf(v1[3], -440.f), 440.f), w1, true);
                    *(u32x2*)(rowp + bj * HALF) = (u32x2){(unsigned)w0, (unsigned)w1}; } }
    }
};
}

__device__ __forceinline__ void p0_adaln(const Ctx& C) {
    PH_IDS;
    LAS float* s = (LAS float*)C.lds;
    LAS float* red = (LAS float*)(C.lds + 36864);
    const float* cc = C.a->in[IN_C]; const float* cx = C.a->in[IN_CCTX];
    { float tmpc[18];
#pragma unroll
      for (int q = 0; q < 18; ++q) { const int i = tid + 512 * q; const int b = i >> 10, k = i & 1023; tmpc[q] = (b < 8) ? cc[b * 1024 + k] : cx[k]; }
#pragma unroll
      for (int q = 0; q < 18; ++q) s[tid + 512 * q] = siluf_(tmpc[q]); }
    __syncthreads();
    float* MOD = (float*)(C.ws + WS_MOD);
    for (int item = blockIdx.x; item < 192; item += C.G) {
        const int l = item / 96, cb = item % 96, col = cb * 64 + lane;
        const float* W = C.a->in[IN_MODW] + (size_t)l * 1024 * 6144 + col;
        float acc[9];
#pragma unroll
        for (int b = 0; b < 9; ++b) acc[b] = 0.f;
        const int k0 = wave * 128;
#pragma unroll 8
        for (int k = k0; k < k0 + 128; ++k) { const float w = W[(size_t)k * 6144];
#pragma unroll
            for (int b = 0; b < 9; ++b) acc[b] += s[b * 1024 + k] * w; }
#pragma unroll
        for (int b = 0; b < 9; ++b) red[(wave * 9 + b) * 64 + lane] = acc[b];
        __syncthreads();
        for (int i = tid; i < 576; i += 512) { const int b = i >> 6, ln = i & 63; float v = 0.f;
#pragma unroll
            for (int w = 0; w < 8; ++w) v += red[(w * 9 + b) * 64 + ln];
            v += C.a->in[IN_MODB][l * 6144 + cb * 64 + ln];
            MOD[(size_t)(l * 9 + b) * 6144 + cb * 64 + ln] = v; }
        __syncthreads();
    }
}
__device__ __forceinline__ void p0_tr_item(const float* W, int ldw, int sc0, int k0, bf16* WT, int Kd, int dr0, float scale, LAS float* scr, int lane) {
#pragma unroll 8
    for (int i = 0; i < 32; ++i) { const int kk = 2 * i + (lane >> 5); scr[kk * 33 + (lane & 31)] = W[(size_t)(k0 + kk) * ldw + sc0 + (lane & 31)]; }
    asm volatile("s_waitcnt lgkmcnt(0)" ::: "memory");
    const int c = lane & 7;
#pragma unroll
    for (int j = 0; j < 4; ++j) { const int n = (lane >> 3) + 8 * j; const LAS float* sp = scr + (8 * c) * 33 + n;
        u32x4 o; o.x = cvt_pk(sp[0 * 33] * scale, sp[1 * 33] * scale); o.y = cvt_pk(sp[2 * 33] * scale, sp[3 * 33] * scale);
        o.z = cvt_pk(sp[4 * 33] * scale, sp[5 * 33] * scale); o.w = cvt_pk(sp[6 * 33] * scale, sp[7 * 33] * scale);
        *(u32x4*)(WT + (size_t)(dr0 + n) * Kd + k0 + 8 * c) = o; }
    asm volatile("s_waitcnt lgkmcnt(0)" ::: "memory");
}
__device__ __forceinline__ void p0_tr_item8(const float* W, int ldw, int sc0, int k0, unsigned char* WT, int Kd, int dr0, float scale, LAS float* scr, int lane) {
#pragma unroll 8
    for (int i = 0; i < 64; ++i) { const int kk = 2 * i + (lane >> 5); scr[kk * 33 + (lane & 31)] = W[(size_t)(k0 + kk) * ldw + sc0 + (lane & 31)]; }
    asm volatile("s_waitcnt lgkmcnt(0)" ::: "memory");
    const int c = lane & 7;
#pragma unroll
    for (int j = 0; j < 4; ++j) { const int n = (lane >> 3) + 8 * j; const LAS float* sp = scr + (16 * c) * 33 + n;
        int w[4];
#pragma unroll
        for (int q = 0; q < 4; ++q) { int x = 0;
            x = __builtin_amdgcn_cvt_pk_fp8_f32(sp[(4 * q) * 33] * scale, sp[(4 * q + 1) * 33] * scale, x, false);
            x = __builtin_amdgcn_cvt_pk_fp8_f32(sp[(4 * q + 2) * 33] * scale, sp[(4 * q + 3) * 33] * scale, x, true); w[q] = x; }
        *(u32x4*)(WT + (size_t)(dr0 + n) * Kd + k0 + 16 * c) = (u32x4){(unsigned)w[0], (unsigned)w[1], (unsigned)w[2], (unsigned)w[3]}; }
    asm volatile("s_waitcnt lgkmcnt(0)" ::: "memory");
}
__device__ __forceinline__ int gu_src_col(int dr0) { const int pn = dr0 >> 8, bj = (dr0 >> 7) & 1, t0 = dr0 & 127; return bj * 1024 + 128 * pn + t0; }
__device__ __forceinline__ int in1_src_col(int dr0) {
    const int pn = dr0 >> 8, bj = (dr0 >> 7) & 1, t0 = dr0 & 127;
    if (pn < 4) return bj * 512 + 128 * pn + t0;
    if (pn < 8) return (bj ? 2048 : 1536) + 128 * (pn - 4) + t0;
    return 1024 + (dr0 - 2048);
}
__device__ __forceinline__ void p0_convert(const Ctx& C) {
    PH_IDS;
    LAS float* scr = (LAS float*)(C.lds + wave * 16896);
    const int gw = blockIdx.x * 8 + wave, NGW = C.G * 8;
    constexpr int KB_IN0 = F8_IN0 ? 8 : 16, KB_OUT0 = F8_OUT0 ? 12 : 24, KB_IN1 = F8_IN1 ? 8 : 16, KB_OUT1 = F8_OUT1 ? 8 : 16;
    constexpr int I_IN0 = 97 * KB_IN0, I_OUT0 = 32 * KB_OUT0, I_IN1 = 80 * KB_IN1, I_OUT1 = 32 * KB_OUT1, I_GU = 64 * 64 * 8, I_D = 64 * 32 * 8;
    constexpr int NITEMS = I_IN0 + I_OUT0 + I_IN1 + I_OUT1 + I_GU + I_D;
    for (int it = gw; it < NITEMS; it += NGW) {
        int r = it;
        if (r < I_IN0) { const int nb = r / KB_IN0, kb = r % KB_IN0; int dr0, sc0;
            if (nb < 96) { dr0 = nb * 32; sc0 = dr0; } else { dr0 = 4096; sc0 = 3072; }
            if (F8_IN0) p0_tr_item8(C.a->in[IN_EVWIN], 3616, sc0, kb * 128, (unsigned char*)(C.ws + WS_WIN0), 1024, dr0, 32.f, scr, lane);
            else p0_tr_item(C.a->in[IN_EVWIN], 3616, sc0, kb * 64, (bf16*)(C.ws + WS_WIN0), 1024, dr0, 1.f, scr, lane);
            continue; }
        r -= I_IN0;
        if (r < I_OUT0) { const int nb = r / KB_OUT0, kb = r % KB_OUT0;
            if (F8_OUT0) p0_tr_item8(C.a->in[IN_EVWOUT], 1024, nb * 32, kb * 128, (unsigned char*)(C.ws + WS_WOUT0), 1536, nb * 32, 32.f, scr, lane);
            else p0_tr_item(C.a->in[IN_EVWOUT], 1024, nb * 32, kb * 64, (bf16*)(C.ws + WS_WOUT0), 1536, nb * 32, 1.f, scr, lane);
            continue; }
        r -= I_OUT0;
        if (r < I_IN1) { const int nb = r / KB_IN1, kb = r % KB_IN1;
            if (F8_IN1) p0_tr_item8(C.a->in[IN_ODWIN], 2560, in1_src_col(nb * 32), kb * 128, (unsigned char*)(C.ws + WS_WIN1), 1024, nb * 32, 32.f, scr, lane);
            else p0_tr_item(C.a->in[IN_ODWIN], 2560, in1_src_col(nb * 32), kb * 64, (bf16*)(C.ws + WS_WIN1), 1024, nb * 32, 1.f, scr, lane);
            continue; }
        r -= I_IN1;
        if (r < I_OUT1) { const int nb = r / KB_OUT1, kb = r % KB_OUT1;
            if (F8_OUT1) p0_tr_item8(C.a->in[IN_ODWOUT], 1024, nb * 32, kb * 128, (unsigned char*)(C.ws + WS_WOUT1), 1024, nb * 32, 32.f, scr, lane);
            else p0_tr_item(C.a->in[IN_ODWOUT], 1024, nb * 32, kb * 64, (bf16*)(C.ws + WS_WOUT1), 1024, nb * 32, 1.f, scr, lane);
            continue; }
        r -= I_OUT1;
        if (r < I_GU) { const int le = r >> 9, q = r & 511, nb = q >> 3, kb = q & 7;
            p0_tr_item8(C.a->in[IN_WGU] + (size_t)le * 1024 * 2048, 2048, gu_src_col(nb * 32), kb * 128, (unsigned char*)(C.ws + WS_WGU) + (size_t)le * 2048 * 1024, 1024, nb * 32, 32.f, scr, lane); continue; }
        r -= I_GU;
        { const int le = r >> 8, q = r & 255, nb = q >> 3, kb = q & 7;
            p0_tr_item8(C.a->in[IN_WD] + (size_t)le * 1024 * 1024, 1024, nb * 32, kb * 128, (unsigned char*)(C.ws + WS_WD) + (size_t)le * 1024 * 1024, 1024, nb * 32, 32.f, scr, lane); }
    }
    { u32x4* z = (u32x4*)((unsigned char*)(C.ws + WS_WIN0) + (size_t)4128 * 1024 * (F8_IN0 ? 1 : 2)); const int n16 = 224 * 1024 * (F8_IN0 ? 1 : 2) / 16;
      for (int i = blockIdx.x * 512 + tid; i < n16; i += C.G * 512) z[i] = (u32x4){0u, 0u, 0u, 0u}; }
    { bf16* F1 = (bf16*)(C.ws + WS_F1); bf16* F2 = (bf16*)(C.ws + WS_F2);
      for (int i = blockIdx.x * 512 + tid; i < 128 * 128 + 128 * 256; i += C.G * 512) {
          if (i < 128 * 128) { const int m = i >> 7, k = i & 127; const int mb = m >> 5, rr = m & 31, g = rr >> 3, hh = (rr >> 2) & 1, ii = rr & 3;
              const int part = g & 1, ap = 16 * mb + 8 * (g >> 1) + 4 * hh + ii, pin = k >> 6, a = k & 63;
              const float th = 6.283185307179586f * (float)((a * ap) & 63) * (1.0f / 64.0f); const float cs = cosf(th), sn = sinf(th);
              const float v = (part == 0) ? (pin == 0 ? cs : -sn) : (pin == 0 ? -sn : -cs);
              F1[i] = (bf16)f2bf(v); }
          else { const int q = i - 128 * 128, m = q >> 8, k = q & 255, pin = k >> 7, b = k & 127;
              const float ps = 6.283185307179586f * (float)((b * m) & 127) * (1.0f / 128.0f);
              F2[q] = (bf16)f2bf(pin == 0 ? cosf(ps) : sinf(ps)); } } }
    __syncthreads();
}
__device__ __forceinline__ void p0_fourier_fold(const Ctx& C) {
    PH_IDS;
    LAS float* Wl = (LAS float*)C.lds;
    LAS float* tab = (LAS float*)(C.lds + 32768);
    unsigned char* WT = (unsigned char*)(C.ws + WS_WIN0);
    for (int item = blockIdx.x; item < 64; item += C.G) {
        const int kb = item >> 2, g = item & 3;
        __syncthreads();
        if (tid < 128) tab[tid] = cosf(6.283185307179586f * (float)tid * (1.0f / 128.0f));
        for (int i = tid; i < 64 * 128; i += 512) { const int kk = i >> 7, c = i & 127; Wl[i] = C.a->in[IN_EVWIN][(size_t)(kb * 64 + kk) * 3616 + 3104 + g * 128 + c]; }
        __syncthreads();
        const int cp = tid & 127, kq = tid >> 7;
        float ac[16], as[16];
#pragma unroll
        for (int i = 0; i < 16; ++i) { ac[i] = 0.f; as[i] = 0.f; }
        for (int c = 0; c < 128; ++c) { const int ph = (c * cp) & 127; const float cs = tab[ph], sn = tab[(ph + 96) & 127];
#pragma unroll
            for (int i = 0; i < 16; ++i) { const float w = Wl[(kq * 16 + i) * 128 + c]; ac[i] += w * cs; as[i] += w * sn; } }
        if (F8_IN0) {
            unsigned char* pc = WT + (size_t)(3072 + g * 128 + cp) * 1024 + kb * 64 + kq * 16;
            unsigned char* ps = WT + (size_t)(3584 + g * 128 + cp) * 1024 + kb * 64 + kq * 16;
            *(u32x4*)pc = (u32x4){pk4_fp8(ac[0], ac[1], ac[2], ac[3], 32.f), pk4_fp8(ac[4], ac[5], ac[6], ac[7], 32.f), pk4_fp8(ac[8], ac[9], ac[10], ac[11], 32.f), pk4_fp8(ac[12], ac[13], ac[14], ac[15], 32.f)};
            *(u32x4*)ps = (u32x4){pk4_fp8(as[0], as[1], as[2], as[3], 32.f), pk4_fp8(as[4], as[5], as[6], as[7], 32.f), pk4_fp8(as[8], as[9], as[10], as[11], 32.f), pk4_fp8(as[12], as[13], as[14], as[15], 32.f)};
        } else {
            bf16* pc = (bf16*)WT + (size_t)(3072 + g * 128 + cp) * 1024 + kb * 64 + kq * 16;
            bf16* ps = (bf16*)WT + (size_t)(3584 + g * 128 + cp) * 1024 + kb * 64 + kq * 16;
            *(u32x4*)pc = (u32x4){cvt_pk(ac[0], ac[1]), cvt_pk(ac[2], ac[3]), cvt_pk(ac[4], ac[5]), cvt_pk(ac[6], ac[7])}; *(u32x4*)(pc + 8) = (u32x4){cvt_pk(ac[8], ac[9]), cvt_pk(ac[10], ac[11]), cvt_pk(ac[12], ac[13]), cvt_pk(ac[14], ac[15])};
            *(u32x4*)ps = (u32x4){cvt_pk(as[0], as[1]), cvt_pk(as[2], as[3]), cvt_pk(as[4], as[5]), cvt_pk(as[6], as[7])}; *(u32x4*)(ps + 8) = (u32x4){cvt_pk(as[8], as[9]), cvt_pk(as[10], as[11]), cvt_pk(as[12], as[13]), cvt_pk(as[14], as[15])};
        }
    }
    __syncthreads();
}

__device__ __forceinline__ void p_norm0(const Ctx& C) {
    PH_IDS;
    const int gw = blockIdx.x * 8 + wave, NGW = C.G * 8;
    const int per = (MALL + NGW - 1) / NGW;
    const int r0 = gw * per, r1 = (r0 + per < MALL) ? r0 + per : MALL;
    const float* MOD = (const float*)(C.ws + WS_MOD);
    const float* g = C.a->in[IN_NMPRE];
    unsigned char* HN = (unsigned char*)(C.ws + WS_HN);
    int curb = -1; f32x4 A[4], B[4];
    for (int r = r0; r < r1; ++r) {
        const int b = (r < MTOK) ? (r >> 13) : 8;
        if (b != curb) { curb = b;
#pragma unroll
            for (int j = 0; j < 4; ++j) { const int c = 4 * lane + 256 * j;
                const f32x4 gg = *(const f32x4*)(g + c), sc = *(const f32x4*)(MOD + (size_t)b * 6144 + 1024 + c), sh = *(const f32x4*)(MOD + (size_t)b * 6144 + c);
                A[j] = gg * (sc + 1.0f); B[j] = sh; } }
        const float* xr = (r < MTOK) ? (C.a->in[IN_X] + (size_t)r * 1024) : (C.a->in[IN_CTX] + (size_t)(r - MTOK) * 1024);
        f32x4 v[4]; float ss = 0.f;
#pragma unroll
        for (int j = 0; j < 4; ++j) { v[j] = *(const f32x4*)(xr + 4 * lane + 256 * j); ss += v[j][0] * v[j][0] + v[j][1] * v[j][1] + v[j][2] * v[j][2] + v[j][3] * v[j][3]; }
        const float rstd = rsqrtf(wave_sum(ss) * (1.0f / 1024.0f) + EPS);
#pragma unroll
        for (int j = 0; j < 4; ++j) { const f32x4 h = v[j] * rstd * A[j] + B[j];
            if (F8_IN0) *(unsigned*)(HN + (size_t)r * 1024 + 4 * lane + 256 * j) = pk4_fp8(h[0], h[1], h[2], h[3], 8.f);
            else *(u32x2*)((bf16*)HN + (size_t)r * 1024 + 4 * lane + 256 * j) = (u32x2){cvt_pk(h[0], h[1]), cvt_pk(h[2], h[3])}; }
    }
}

namespace glap {
constexpr int H_BYTES = 72704;
constexpr int O_RAW = 0, O_BC = 2048, O_TOT = 34816, O_QP = 36864, O_KP = 54272;
constexpr int NUNIT = 2 * 4 * 8 * 132;
}
__device__ __forceinline__ int gla_row(int bt, int dir, int s, int i) {
    const int ii = dir ? 63 - i : i;
    if (s < 4) { const int ci = dir ? 3 - s : s; return MTOK + bt * CTXL + ci * 64 + ii; }
    const int n = s - 4, ci = dir ? 127 - n : n; return bt * SEQ + ci * 64 + ii;
}
__device__ __forceinline__ void p_gla_prep(const Ctx& C, const int pv = 0) {
    PH_IDS;
    using namespace glap;
    const int half = tid >> 8, th = tid & 255, wh = wave & 3;
    LAS unsigned char* L = C.lds + half * H_BYTES;
    const bf16* Qg = (const bf16*)(C.ws + WS_Q); const bf16* Kg = (const bf16*)(C.ws + WS_K); const bf16* LRg = (const bf16*)(C.ws + WS_LR);
    bf16* QPg = (bf16*)(C.ws + WS_GQP); bf16* KPPg = (bf16*)(C.ws + WS_GKPP); bf16* SCg = (bf16*)(C.ws + WS_GSC); float* ELg = (float*)(C.ws + WS_GEL);
    const int niter = (NUNIT + 2 * C.G - 1) / (2 * C.G);
    const int lj = th >> 2, part = th & 3;
    u32x4 nq[4], nk[4], nlr; float nup[8], nbias;
    auto unit_of = [&](int itn) -> int { const int U = (itn * C.G + (int)blockIdx.x) * 2 + half; return U < NUNIT ? U : NUNIT - 1; };
    auto issue_loads = [&](int Uc) {
        const int sstep = Uc % 132, bt = (Uc / 132) & 7, hd = (Uc / (132 * 8)) & 3, dir = Uc / (132 * 32);
#pragma unroll
        for (int q = 0; q < 4; ++q) { const int c = th + 256 * q; const int row = gla_row(bt, dir, sstep, c >> 4);
            nk[q] = *(const u32x4*)(Kg + (size_t)row * 512 + hd * 128 + (c & 15) * 8);
            nq[q] = *(const u32x4*)(Qg + (size_t)(sstep >= 4 ? row : 0) * 512 + hd * 128 + (c & 15) * 8); }
        if (th < 128) { const int r2 = gla_row(bt, dir, sstep, th >> 1); nlr = *(const u32x4*)(LRg + (size_t)r2 * 32 + dir * 16 + (th & 1) * 8); }
        const float* up = C.a->in[IN_EVGKUP] + (size_t)dir * 16 * 512 + hd * 128 + 32 * wh + (lane & 31);
#pragma unroll
        for (int q = 0; q < 8; ++q) nup[q] = up[(size_t)(8 * (lane >> 5) + q) * 512];
        nbias = C.a->in[IN_EVGKB][dir * 512 + hd * 128 + 32 * wh + (lane & 31)]; };
    issue_loads(unit_of(0));
    for (int itn = 0; itn < niter; ++itn) {
        const int U = (itn * C.G + (int)blockIdx.x) * 2 + half;
        const bool act = U < NUNIT;
        const int Uc = act ? U : NUNIT - 1;
        const int sstep = Uc % 132;
        const bool latent = sstep >= 4;
        u32x4 rq[4], rk[4], rlr = nlr;
#pragma unroll
        for (int q = 0; q < 4; ++q) { rq[q] = nq[q]; rk[q] = nk[q]; }
        bf16x8 upf; const float gbias = nbias;
        { unsigned short tmp[8];
#pragma unroll
          for (int q = 0; q < 8; ++q) tmp[q] = (unsigned short)f2bf(nup[q]);
          upf = (bf16x8){(short)tmp[0], (short)tmp[1], (short)tmp[2], (short)tmp[3], (short)tmp[4], (short)tmp[5], (short)tmp[6], (short)tmp[7]}; }
        if (itn + 1 < niter) issue_loads(unit_of(itn + 1));
        __syncthreads();
        if (th < 128) *(LAS u32x4*)(L + O_RAW + (th >> 1) * 32 + (th & 1) * 16) = rlr;
        __syncthreads();
#pragma unroll
        for (int jb = 0; jb < 2; ++jb) {
            const bf16x8 af = *(const LAS bf16x8*)(L + O_RAW + (32 * jb + (lane & 31)) * 32 + (lane >> 5) * 16);
            f32x16 z;
#pragma unroll
            for (int i = 0; i < 16; ++i) z[i] = 0.f;
            z = __builtin_amdgcn_mfma_f32_32x32x16_bf16(af, upf, z, 0, 0, 0);
#pragma unroll
            for (int r = 0; r < 16; ++r) { const int j = 32 * jb + (r & 3) + 8 * (r >> 2) + 4 * (lane >> 5); const float zz = z[r] + gbias;
                const float ls = fminf(zz, 0.f) - __logf(1.0f + __expf(-fabsf(zz)));
                *(LAS float*)(L + O_BC + (j * 128 + 32 * wh + (lane & 31)) * 4) = ls * 0.0625f; } }
        __syncthreads();
        { const int dk = th & 127;
          float run0 = 0.f, run1 = 0.f; const int g0 = th >> 7, g1 = g0 + 2;
          float v0[16], v1[16];
#pragma unroll
          for (int q = 0; q < 16; ++q) { v0[q] = *(const LAS float*)(L + O_BC + ((16 * g0 + q) * 128 + dk) * 4); v1[q] = *(const LAS float*)(L + O_BC + ((16 * g1 + q) * 128 + dk) * 4); }
#pragma unroll
          for (int q = 0; q < 16; ++q) { run0 += v0[q]; run1 += v1[q];
              *(LAS float*)(L + O_BC + ((16 * g0 + q) * 128 + dk) * 4) = run0; *(LAS float*)(L + O_BC + ((16 * g1 + q) * 128 + dk) * 4) = run1; }
          *(LAS float*)(L + O_TOT + (g0 * 128 + dk) * 4) = run0; *(LAS float*)(L + O_TOT + (g1 * 128 + dk) * 4) = run1; }
        __syncthreads();
        {
#pragma unroll
          for (int q8 = 0; q8 < 4; ++q8) {
              const int c = th + 256 * q8, cj = c >> 4, jg = cj >> 4, dkc = (c & 15) * 8;
              u32x4 oq, okpp;
#pragma unroll
              for (int hq = 0; hq < 2; ++hq) {
                  const int dk0 = dkc + 4 * hq;
                  f32x4 b = *(const LAS f32x4*)(L + O_BC + (cj * 128 + dk0) * 4), tt = (f32x4){0.f, 0.f, 0.f, 0.f};
#pragma unroll
                  for (int g2 = 0; g2 < 4; ++g2) { const f32x4 tv = *(const LAS f32x4*)(L + O_TOT + (g2 * 128 + dk0) * 4); tt += tv; if (g2 < jg) b += tv; }
                  f32x4 e1, e2, e3;
#pragma unroll
                  for (int i = 0; i < 4; ++i) { if (pv & 4) { e1[i] = b[i]; e2[i] = -b[i]; e3[i] = tt[i] - b[i]; } else { e1[i] = __expf(b[i]); e2[i] = __expf(-b[i]); e3[i] = __expf(tt[i] - b[i]); } }
                  if (cj == 0 && act && !(pv & 1)) { f32x4 el;
#pragma unroll
                      for (int i = 0; i < 4; ++i) el[i] = __expf(tt[i]);
                      *(f32x4*)(ELg + (size_t)Uc * 128 + dk0) = el; }
                  const unsigned qa = hq ? rq[q8].z : rq[q8].x, qb = hq ? rq[q8].w : rq[q8].y;
                  const unsigned ka = hq ? rk[q8].z : rk[q8].x, kb = hq ? rk[q8].w : rk[q8].y;
                  const float q0 = bf_lo(qa), q1 = bf_hi(qa), q2 = bf_lo(qb), q3 = bf_hi(qb);
                  const float k0 = bf_lo(ka), k1 = bf_hi(ka), k2 = bf_lo(kb), k3 = bf_hi(kb);
                  u32x2 o;
                  o.x = cvt_pk(q0 * e1[0], q1 * e1[1]); o.y = cvt_pk(q2 * e1[2], q3 * e1[3]); *(LAS u32x2*)(L + O_QP + cj * 272 + dk0 * 2) = o;
                  if (hq) { oq.z = o.x; oq.w = o.y; } else { oq.x = o.x; oq.y = o.y; }
                  o.x = cvt_pk(k0 * e2[0], k1 * e2[1]); o.y = cvt_pk(k2 * e2[2], k3 * e2[3]); *(LAS u32x2*)(L + O_KP + cj * 272 + dk0 * 2) = o;
                  o.x = cvt_pk(k0 * e3[0], k1 * e3[1]); o.y = cvt_pk(k2 * e3[2], k3 * e3[3]);
                  if (hq) { okpp.z = o.x; okpp.w = o.y; } else { okpp.x = o.x; okpp.y = o.y; }
              }
              if (act && !(pv & 1)) { *(u32x4*)(KPPg + (size_t)Uc * 8192 + c * 8) = okpp; if (latent) *(u32x4*)(QPg + (size_t)Uc * 8192 + c * 8) = oq; }
              else asm volatile("" :: "v"(okpp), "v"(oq));
          } }
        __syncthreads();
        if (latent && act && !(pv & 2)) {
            const int ib = wh;
            for (int jb16 = 0; jb16 <= ib; ++jb16) {
                f32x4 d = (f32x4){0.f, 0.f, 0.f, 0.f};
#pragma unroll
                for (int ks = 0; ks < 4; ++ks) {
                    const bf16x8 a = *(const LAS bf16x8*)(L + O_KP + (16 * jb16 + (lane & 15)) * 272 + (32 * ks + 8 * (lane >> 4)) * 2);
                    const bf16x8 bq = *(const LAS bf16x8*)(L + O_QP + (16 * ib + (lane & 15)) * 272 + (32 * ks + 8 * (lane >> 4)) * 2);
                    d = __builtin_amdgcn_mfma_f32_16x16x32_bf16(a, bq, d, 0, 0, 0); }
                const int i = 16 * ib + (lane & 15), j0 = 16 * jb16 + 4 * (lane >> 4);
#pragma unroll
                for (int r = 0; r < 4; ++r) if (j0 + r > i) d[r] = 0.f;
                u32x2 o; o.x = cvt_pk(d[0], d[1]); o.y = cvt_pk(d[2], d[3]);
                if (!(pv & 1)) *(u32x2*)(SCg + (size_t)Uc * 4096 + i * 64 + j0) = o; else asm volatile("" :: "v"(o));
            }
            for (int jb16 = ib + 1; jb16 < 4; ++jb16) { const int i = 16 * ib + (lane & 15), j0 = 16 * jb16 + 4 * (lane >> 4);
                if (!(pv & 1)) *(u32x2*)(SCg + (size_t)Uc * 4096 + i * 64 + j0) = (u32x2){0u, 0u}; }
        }
    }
    __syncthreads();
}
namespace gla {
constexpr int O_EL = 0, O_QP = 512, O_KPP = 17920, O_V = 38400, O_SC = 50688, IMG_BYTES = 59904, O_ST = 2 * IMG_BYTES;
constexpr int P_QP = 272, P_KPP = 320, P_V = 192, P_SC = 144, P_ST = 272, ST_BYTES = 64 * 272;
__device__ __forceinline__ bf16x8 tr8(LAS unsigned char* p0, LAS unsigned char* p1) {
    const s16x4 a = __builtin_amdgcn_ds_read_tr16_b64_v4i16((LAS s16x4*)p0);
    const s16x4 b = __builtin_amdgcn_ds_read_tr16_b64_v4i16((LAS s16x4*)p1);
    return (bf16x8){a[0], a[1], a[2], a[3], b[0], b[1], b[2], b[3]};
}
}
__device__ __forceinline__ void p_gla(const Ctx& C, const int probe = 0) {
    PH_IDS;
    using namespace gla;
    LAS unsigned char* L = C.lds;
    const int t = tid, w = wave;
    const bf16* Vg = (const bf16*)(C.ws + WS_V);
    const bf16* QPg = (const bf16*)(C.ws + WS_GQP); const bf16* KPPg = (const bf16*)(C.ws + WS_GKPP); const bf16* SCg = (const bf16*)(C.ws + WS_GSC); const float* ELg = (const float*)(C.ws + WS_GEL);
    for (int it = blockIdx.x; it < 256; it += C.G) {
        const int xx = it & 7, jj_ = it >> 3, scan = xx * 8 + (jj_ >> 2), dvs = jj_ & 3;
        const int bt = scan >> 3, hd = (scan >> 1) & 3, dir = scan & 1;
        const int ubase = ((dir * 4 + hd) * 8 + bt) * 132;
        bf16* Og = (bf16*)(C.ws + (probe ? WS_HN : (dir ? WS_OB : WS_OF)));
        __syncthreads();
        for (int i = t; i < ST_BYTES / 16; i += 512) *(LAS u32x4*)(L + O_ST + i * 16) = (u32x4){0u, 0u, 0u, 0u};
        f32x16 S;
#pragma unroll
        for (int i = 0; i < 16; ++i) S[i] = 0.f;
        const int lj = t >> 3, part = t & 7;
        u32x4 rsc, rqp0, rqp1, rkp0, rkp1, rv; f32x4 rel;
        u32x4 nsc, nqp0, nqp1, nkp0, nkp1, nv; f32x4 nel;
        auto load_step = [&](int s_) {
            const int s = probe ? 4 + (s_ & 1) : s_;
            const size_t U = (size_t)(ubase + s);
            const int row = gla_row(bt, dir, s, lj);
            nv = *(const u32x4*)(Vg + (size_t)row * 1024 + hd * 256 + dvs * 64 + part * 8);
            const bf16* kp = KPPg + U * 8192 + t * 8; nkp0 = *(const u32x4*)kp; nkp1 = *(const u32x4*)(kp + 4096);
            if (t < 32) nel = *(const f32x4*)(ELg + U * 128 + t * 4);
            if (s >= 4) { const bf16* qp = QPg + U * 8192 + t * 8; nqp0 = *(const u32x4*)qp; nqp1 = *(const u32x4*)(qp + 4096);
                nsc = *(const u32x4*)(SCg + U * 4096 + lj * 64 + part * 8); } };
        auto shift_regs = [&]() { rsc = nsc; rqp0 = nqp0; rqp1 = nqp1; rkp0 = nkp0; rkp1 = nkp1; rv = nv; rel = nel; };
        auto write_images = [&](int s, int ib_) {
            LAS unsigned char* I = L + ib_ * IMG_BYTES;
            *(LAS u32x4*)(I + O_V + lj * P_V + part * 16) = rv;
            *(LAS u32x4*)(I + O_KPP + (t >> 4) * P_KPP + (t & 15) * 16) = rkp0; *(LAS u32x4*)(I + O_KPP + (32 + (t >> 4)) * P_KPP + (t & 15) * 16) = rkp1;
            if (t < 32) *(LAS f32x4*)(I + O_EL + t * 16) = rel;
            if (s >= 4) { *(LAS u32x4*)(I + O_QP + (t >> 4) * P_QP + (t & 15) * 16) = rqp0; *(LAS u32x4*)(I + O_QP + (32 + (t >> 4)) * P_QP + (t & 15) * 16) = rqp1;
                *(LAS u32x4*)(I + O_SC + lj * P_SC + part * 16) = rsc; } };
        load_step(0); shift_regs(); write_images(0, 0);
        load_step(1); shift_regs();
        load_step(2);
        for (int s = 0; s < 132; ++s) {
            const int cur = s & 1, nx = cur ^ 1;
            const bool latent = (s >= 4);
            LAS unsigned char* I = L + cur * IMG_BYTES;
            __syncthreads();
            if (s + 1 < 132) write_images(s + 1, nx);
            shift_regs();
            if (s + 3 < 132) load_step(s + 3);
            if (latent) {
                const int ib = w >> 1;
                const int g4 = lane >> 4, q4 = (lane & 15) >> 2, p4 = lane & 3;
                const int orow = gla_row(bt, dir, s, 16 * ib + (lane & 15));
#pragma unroll
                for (int cc = 0; cc < 2; ++cc) {
                    const int c = 2 * (w & 1) + cc;
                    f32x4 d = (f32x4){0.f, 0.f, 0.f, 0.f};
#pragma unroll
                    for (int ks = 0; ks < 2; ++ks) {
                        LAS unsigned char* pa = I + O_V + (32 * ks + 8 * g4 + q4) * P_V + (16 * c + 4 * p4) * 2;
                        const bf16x8 a = gla::tr8(pa, pa + 4 * P_V);
                        const bf16x8 b = *(const LAS bf16x8*)(I + O_SC + (16 * ib + (lane & 15)) * P_SC + (32 * ks + 8 * g4) * 2);
                        d = __builtin_amdgcn_mfma_f32_16x16x32_bf16(a, b, d, 0, 0, 0); }
#pragma unroll
                    for (int ks = 0; ks < 4; ++ks) {
                        const bf16x8 a = *(const LAS bf16x8*)(L + O_ST + cur * ST_BYTES + (16 * c + (lane & 15)) * P_ST + (32 * ks + 8 * g4) * 2);
                        const bf16x8 b = *(const LAS bf16x8*)(I + O_QP + (16 * ib + (lane & 15)) * P_QP + (32 * ks + 8 * g4) * 2);
                        d = __builtin_amdgcn_mfma_f32_16x16x32_bf16(a, b, d, 0, 0, 0); }
                    u32x2 o; o.x = cvt_pk(d[0], d[1]); o.y = cvt_pk(d[2], d[3]);
                    *(u32x2*)(Og + (size_t)orow * 1024 + hd * 256 + dvs * 64 + 16 * c + 4 * g4) = o;
                }
            }
            { const int dbS = w & 3, dvb = w >> 2, hh = lane >> 5, blk = (lane >> 4) & 1, q4 = (lane & 15) >> 2, p4 = lane & 3;
#pragma unroll
              for (int g = 0; g < 4; ++g) { const f32x4 el = *(const LAS f32x4*)(I + O_EL + (32 * dbS + 8 * g + 4 * hh) * 4);
#pragma unroll
                  for (int i = 0; i < 4; ++i) S[4 * g + i] *= el[i]; }
#pragma unroll
              for (int ks = 0; ks < 4; ++ks) {
                  LAS unsigned char* pa = I + O_KPP + (16 * ks + 8 * hh + q4) * P_KPP + (32 * dbS + 16 * blk + 4 * p4) * 2;
                  LAS unsigned char* pb = I + O_V + (16 * ks + 8 * hh + q4) * P_V + (32 * dvb + 16 * blk + 4 * p4) * 2;
                  const bf16x8 a = gla::tr8(pa, pa + 4 * P_KPP);
                  const bf16x8 b = gla::tr8(pb, pb + 4 * P_V);
                  S = __builtin_amdgcn_mfma_f32_32x32x16_bf16(a, b, S, 0, 0, 0); }
#pragma unroll
              for (int g = 0; g < 4; ++g) { u32x2 o; o.x = cvt_pk(S[4 * g], S[4 * g + 1]); o.y = cvt_pk(S[4 * g + 2], S[4 * g + 3]);
                  *(LAS u32x2*)(L + O_ST + nx * ST_BYTES + (32 * dvb + (lane & 31)) * P_ST + (32 * dbS + 8 * g + 4 * hh) * 2) = o; } }
        }
    }
}

__device__ __forceinline__ void p_fft1(const Ctx& C) {
    PH_IDS;
    LAS unsigned char* L = C.lds;
    const int t = tid, w = wave, mb = w & 3, nh = w >> 2, hh = lane >> 5;
    const bf16* F1 = (const bf16*)(C.ws + WS_F1);
    bf16x8 af[8];
#pragma unroll
    for (int ks = 0; ks < 8; ++ks) af[ks] = *(const bf16x8*)(F1 + (32 * mb + (lane & 31)) * 128 + 16 * ks + 8 * hh);
    const bf16* ZC = (const bf16*)(C.ws + WS_ZC); const bf16* ZS = (const bf16*)(C.ws + WS_ZS);
    bf16* YR = (bf16*)(C.ws + WS_YR); bf16* YI = (bf16*)(C.ws + WS_YI);
    const int blk = (lane >> 4) & 1, q4 = (lane & 15) >> 2, p4 = lane & 3;
    u32x4 pv[8];
    auto fetch1 = [&](int unit) { const int bt = unit >> 8, b = (unit >> 1) & 127, chh = unit & 1; const int row = t >> 2, quarter = t & 3, pin = row >> 6, a = row & 63;
        const bf16* src = (pin ? ZS : ZC) + (size_t)(bt * SEQ + 128 * a + b) * 512 + chh * 256 + quarter * 64;
#pragma unroll
        for (int i = 0; i < 8; ++i) pv[i] = *(const u32x4*)(src + 8 * i); };
    if ((int)blockIdx.x < 2048) fetch1(blockIdx.x);
    for (int unit = blockIdx.x; unit < 2048; unit += C.G) {
        const int bt = unit >> 8, b = (unit >> 1) & 127, chh = unit & 1;
        __syncthreads();
        { const int row = t >> 2, quarter = t & 3;
#pragma unroll
          for (int i = 0; i < 8; ++i) *(LAS u32x4*)(L + row * 576 + quarter * 128 + i * 16) = pv[i]; }
        __syncthreads();
        if (unit + C.G < 2048) fetch1(unit + C.G);
#pragma unroll 1
        for (int nb = 0; nb < 4; ++nb) {
            const int c = 4 * nh + nb;
            f32x16 acc;
#pragma unroll
            for (int i = 0; i < 16; ++i) acc[i] = 0.f;
#pragma unroll
            for (int ks = 0; ks < 8; ++ks) {
                LAS unsigned char* pb = L + (16 * ks + 8 * hh + q4) * 576 + (32 * c + 16 * blk + 4 * p4) * 2;
                const bf16x8 bfr = gla::tr8(pb, pb + 4 * 576);
                acc = __builtin_amdgcn_mfma_f32_32x32x16_bf16(af[ks], bfr, acc, 0, 0, 0); }
#pragma unroll
            for (int gp = 0; gp < 2; ++gp)
#pragma unroll
                for (int i = 0; i < 4; ++i) { const int ap = 16 * mb + 8 * gp + 4 * hh + i; const float re = acc[8 * gp + i], im = acc[8 * gp + 4 + i];
                    const float ph = (float)((b * ap) & 8191) * (1.0f / 8192.0f); const float cs = __builtin_amdgcn_cosf(ph), sn = __builtin_amdgcn_sinf(ph);
                    const int so = ap * 528 + (32 * c + (lane & 31)) * 2;
                    *(LAS unsigned short*)(L + 73728 + so) = (unsigned short)f2bf(re * cs + im * sn);
                    *(LAS unsigned short*)(L + 73728 + 64 * 528 + so) = (unsigned short)f2bf(im * cs - re * sn); }
        }
        __syncthreads();
        { const int orow = t >> 2, quarter = t & 3, plane = orow >> 6, ap = orow & 63;
          bf16* dst = (plane ? YI : YR) + ((size_t)(bt * 64 + ap) * 128 + b) * 512 + chh * 256 + quarter * 64;
#pragma unroll
          for (int i = 0; i < 8; ++i) *(u32x4*)(dst + 8 * i) = *(const LAS u32x4*)(L + 73728 + orow * 528 + quarter * 128 + i * 16); }
    }
    __syncthreads();
}
__device__ __forceinline__ void p_fft2(const Ctx& C) {
    PH_IDS;
    LAS unsigned char* L = C.lds;
    const int t = tid, w = wave, mb = w & 3, nh = w >> 2, hh = lane >> 5;
    const bf16* F2 = (const bf16*)(C.ws + WS_F2);
    bf16x8 af[16];
#pragma unroll
    for (int ks = 0; ks < 16; ++ks) af[ks] = *(const bf16x8*)(F2 + (32 * mb + (lane & 31)) * 256 + 16 * ks + 8 * hh);
    const bf16* YR = (const bf16*)(C.ws + WS_YR); const bf16* YI = (const bf16*)(C.ws + WS_YI);
    unsigned char* A2 = (unsigned char*)(C.ws + WS_A2);
    const int blk = (lane >> 4) & 1, q4 = (lane & 15) >> 2, p4 = lane & 3;
    u32x4 pv[8];
    auto fetch2 = [&](int unit) { const int bt = unit >> 8, ap = (unit >> 2) & 63, cht = unit & 3; const int row = t >> 1, half = t & 1, pin = row >> 7, b = row & 127;
        const bf16* src = (pin ? YI : YR) + ((size_t)(bt * 64 + ap) * 128 + b) * 512 + cht * 128 + half * 64;
#pragma unroll
        for (int i = 0; i < 8; ++i) pv[i] = *(const u32x4*)(src + 8 * i); };
    if ((int)blockIdx.x < 2048) fetch2(blockIdx.x);
    for (int unit = blockIdx.x; unit < 2048; unit += C.G) {
        const int bt = unit >> 8, ap = (unit >> 2) & 63, cht = unit & 3;
        __syncthreads();
        { const int row = t >> 1, half = t & 1;
#pragma unroll
          for (int i = 0; i < 8; ++i) *(LAS u32x4*)(L + row * 320 + half * 128 + i * 16) = pv[i]; }
        __syncthreads();
        if (unit + C.G < 2048) fetch2(unit + C.G);
#pragma unroll 1
        for (int nb = 0; nb < 2; ++nb) {
            const int c = 2 * nh + nb;
            f32x16 acc;
#pragma unroll
            for (int i = 0; i < 16; ++i) acc[i] = 0.f;
#pragma unroll
            for (int ks = 0; ks < 16; ++ks) {
                LAS unsigned char* pb = L + (16 * ks + 8 * hh + q4) * 320 + (32 * c + 16 * blk + 4 * p4) * 2;
                const bf16x8 bfr = gla::tr8(pb, pb + 4 * 320);
                acc = __builtin_amdgcn_mfma_f32_32x32x16_bf16(af[ks], bfr, acc, 0, 0, 0); }
#pragma unroll
            for (int r = 0; r < 16; ++r) { const int bp = 32 * mb + (r & 3) + 8 * (r >> 2) + 4 * hh;
                if (F8_OUT0) *(LAS unsigned char*)(L + 81920 + bp * 144 + 32 * c + (lane & 31)) = (unsigned char)(pk4_fp8(acc[r], 0.f, 0.f, 0.f, 8.0f / 1024.0f) & 0xffu);
                else *(LAS unsigned short*)(L + 81920 + bp * 272 + (32 * c + (lane & 31)) * 2) = (unsigned short)f2bf(acc[r] * (1.0f / 1024.0f)); }
        }
        __syncthreads();
        { const int bp = t >> 2, quarter = t & 3; const size_t tok = (size_t)bt * SEQ + ap + 64 * bp;
          if (F8_OUT0) { unsigned char* dst = A2 + tok * 1536 + 1024 + cht * 128 + quarter * 32;
#pragma unroll
              for (int i = 0; i < 2; ++i) *(u32x4*)(dst + 16 * i) = *(const LAS u32x4*)(L + 81920 + bp * 144 + quarter * 32 + i * 16); }
          else { bf16* dst = (bf16*)A2 + tok * 1536 + 1024 + cht * 128 + quarter * 32;
#pragma unroll
              for (int i = 0; i < 4; ++i) *(u32x4*)(dst + 8 * i) = *(const LAS u32x4*)(L + 81920 + bp * 272 + quarter * 64 + i * 16); } }
    }
    __syncthreads();
}
__device__ __forceinline__ void p_gla_out(const Ctx& C) {
    PH_IDS;
    const int gw = blockIdx.x * 8 + wave, NGW = C.G * 8;
    const bf16* OF = (const bf16*)(C.ws + WS_OF); const bf16* OB = (const bf16*)(C.ws + WS_OB); const bf16* Rg = (const bf16*)(C.ws + WS_R);
    unsigned char* A2 = (unsigned char*)(C.ws + WS_A2);
    float gn[16];
#pragma unroll
    for (int i = 0; i < 16; ++i) gn[i] = C.a->in[IN_EVGNORM][16 * (lane & 15) + i];
    for (int r = gw; r < MTOK; r += NGW) {
        const u32x4 f0 = *(const u32x4*)(OF + (size_t)r * 1024 + 16 * lane), f1 = *(const u32x4*)(OF + (size_t)r * 1024 + 16 * lane + 8);
        const u32x4 b0 = *(const u32x4*)(OB + (size_t)r * 1024 + 16 * lane), b1 = *(const u32x4*)(OB + (size_t)r * 1024 + 16 * lane + 8);
        const u32x4 g0 = *(const u32x4*)(Rg + (size_t)r * 1024 + 16 * lane), g1 = *(const u32x4*)(Rg + (size_t)r * 1024 + 16 * lane + 8);
        float o[16], rr[16];
#pragma unroll
        for (int i = 0; i < 4; ++i) { const unsigned fa = f0[i], fb = f1[i], ba = b0[i], bb = b1[i], ga = g0[i], gb = g1[i];
            o[2 * i] = bf_lo(fa) + bf_lo(ba); o[2 * i + 1] = bf_hi(fa) + bf_hi(ba); o[8 + 2 * i] = bf_lo(fb) + bf_lo(bb); o[8 + 2 * i + 1] = bf_hi(fb) + bf_hi(bb);
            rr[2 * i] = bf_lo(ga); rr[2 * i + 1] = bf_hi(ga); rr[8 + 2 * i] = bf_lo(gb); rr[8 + 2 * i + 1] = bf_hi(gb); }
        float ss = 0.f;
#pragma unroll
        for (int i = 0; i < 16; ++i) ss += o[i] * o[i];
        ss = row16_sum(ss);
        const float rstd = rsqrtf(ss * (1.0f / 256.0f) + EPS);
        float y[16];
#pragma unroll
        for (int i = 0; i < 16; ++i) y[i] = o[i] * rstd * gn[i] * siluf_(rr[i]);
        if (F8_OUT0) *(u32x4*)(A2 + (size_t)r * 1536 + 16 * lane) = (u32x4){pk4_fp8(y[0], y[1], y[2], y[3], 8.f), pk4_fp8(y[4], y[5], y[6], y[7], 8.f), pk4_fp8(y[8], y[9], y[10], y[11], 8.f), pk4_fp8(y[12], y[13], y[14], y[15], 8.f)};
        else { bf16* a2 = (bf16*)A2 + (size_t)r * 1536 + 16 * lane;
            *(u32x4*)a2 = (u32x4){cvt_pk(y[0], y[1]), cvt_pk(y[2], y[3]), cvt_pk(y[4], y[5]), cvt_pk(y[6], y[7])}; *(u32x4*)(a2 + 8) = (u32x4){cvt_pk(y[8], y[9]), cvt_pk(y[10], y[11]), cvt_pk(y[12], y[13]), cvt_pk(y[14], y[15])}; }
    }
}

__device__ __forceinline__ void p_postmix(const Ctx& C, const int layer) {
    PH_IDS;
    LAS float* WR = (LAS float*)C.lds;
    LAS int* hist = (LAS int*)(C.lds + 131072);
    LAS float* Lg = (LAS float*)(C.lds + 131584 + wave * 2112);
    const float* rw = C.a->in[IN_RW] + (size_t)layer * 1024 * 32;
    __syncthreads();
    for (int it0 = 0; it0 < 64; it0 += 16) {
        float tmpw[16];
#pragma unroll
        for (int q = 0; q < 16; ++q) tmpw[q] = rw[tid + 512 * (it0 + q)];
#pragma unroll
        for (int q = 0; q < 16; ++q) { const int idx = tid + 512 * (it0 + q); const int c = idx >> 5, e = idx & 31; const int ln = (c & 255) >> 2, j = c >> 8, i = c & 3;
            WR[(((j * 4 + i) * 8 + (e >> 2)) * 64 + ln) * 4 + (e & 3)] = tmpw[q]; } }
    if (tid < 32) hist[tid] = 0;
    __syncthreads();
    const float* MOD = (const float*)(C.ws + WS_MOD) + (size_t)layer * 9 * 6144;
    const float* gpost = C.a->in[IN_NMPOST] + layer * 1024; const float* gffn = C.a->in[IN_NFPRE] + layer * 1024;
    const bf16* Y = (const bf16*)(C.ws + WS_Y);
    const float* xin = C.a->in[IN_X];
    bf16* XS = (bf16*)(C.ws + WS_XS);
    unsigned char* H2 = (unsigned char*)(C.ws + WS_H2);
    int* TK = (int*)(C.ws + WS_TOPK); float* GT = (float*)(C.ws + WS_GATE);
    const int rows_per_blk = MTOK / C.G, rows_per_wave = rows_per_blk / 8;
    const int r0 = blockIdx.x * rows_per_blk + wave * rows_per_wave;
    const int b = r0 >> 13;
    const float rbias = C.a->in[IN_RB][layer * 32 + ((lane >> 1) & 31)];
    float cA1[16], cA2[16], cB2[16];
#pragma unroll
    for (int j = 0; j < 4; ++j) { const int c = 4 * lane + 256 * j;
        const f32x4 gp = *(const f32x4*)(gpost + c), gm = *(const f32x4*)(MOD + (size_t)b * 6144 + 2048 + c);
        const f32x4 gf = *(const f32x4*)(gffn + c), sc = *(const f32x4*)(MOD + (size_t)b * 6144 + 4096 + c), sh = *(const f32x4*)(MOD + (size_t)b * 6144 + 3072 + c);
#pragma unroll
        for (int i = 0; i < 4; ++i) { cA1[4 * j + i] = gp[i] * gm[i]; cA2[4 * j + i] = gf[i] * (1.0f + sc[i]); cB2[4 * j + i] = sh[i]; } }
    auto ldx = [&](int r, int j) -> f32x4 {
        if (layer == 0) return *(const f32x4*)(xin + (size_t)r * 1024 + 4 * lane + 256 * j);
        const u32x2 v = *(const u32x2*)(XS + (size_t)r * 1024 + 4 * lane + 256 * j); return (f32x4){bf_lo(v.x), bf_hi(v.x), bf_lo(v.y), bf_hi(v.y)}; };
    u32x2 ny[4]; f32x4 nx[4];
#pragma unroll
    for (int j = 0; j < 4; ++j) { ny[j] = *(const u32x2*)(Y + (size_t)r0 * 1024 + 4 * lane + 256 * j); nx[j] = ldx(r0, j); }
    for (int r = r0; r < r0 + rows_per_wave; ++r) {
        float h[16];
        u32x2 cy[4]; f32x4 cx[4];
#pragma unroll
        for (int j = 0; j < 4; ++j) { cy[j] = ny[j]; cx[j] = nx[j]; }
        if (r + 1 < r0 + rows_per_wave) {
#pragma unroll
            for (int j = 0; j < 4; ++j) { ny[j] = *(const u32x2*)(Y + (size_t)(r + 1) * 1024 + 4 * lane + 256 * j); nx[j] = ldx(r + 1, j); } }
        { float ssy = 0.f; float yv[16];
#pragma unroll
          for (int j = 0; j < 4; ++j) { const u32x2 yy = cy[j];
              yv[4 * j] = bf_lo(yy.x); yv[4 * j + 1] = bf_hi(yy.x); yv[4 * j + 2] = bf_lo(yy.y); yv[4 * j + 3] = bf_hi(yy.y); }
#pragma unroll
          for (int i = 0; i < 16; ++i) ssy += yv[i] * yv[i];
          const float rstd = rsqrtf(wave_sum(ssy) * (1.0f / 1024.0f) + EPS);
          float ss1 = 0.f;
#pragma unroll
          for (int j = 0; j < 4; ++j) { const int c = 4 * lane + 256 * j;
              const f32x4 xv = cx[j];
              f32x4 o;
#pragma unroll
              for (int i = 0; i < 4; ++i) { o[i] = xv[i] + cA1[4 * j + i] * (yv[4 * j + i] * rstd); h[4 * j + i] = o[i]; ss1 += o[i] * o[i]; }
              { u32x2 xw; xw.x = cvt_pk(o[0], o[1]); xw.y = cvt_pk(o[2], o[3]); *(u32x2*)(XS + (size_t)r * 1024 + c) = xw; } }
          const float rstd1 = rsqrtf(wave_sum(ss1) * (1.0f / 1024.0f) + EPS);
#pragma unroll
          for (int j = 0; j < 4; ++j) { const int c = 4 * lane + 256 * j;
#pragma unroll
              for (int i = 0; i < 4; ++i) h[4 * j + i] = h[4 * j + i] * rstd1 * cA2[4 * j + i] + cB2[4 * j + i];
              int wv = 0;
              wv = __builtin_amdgcn_cvt_pk_fp8_f32(fminf(fmaxf(h[4 * j] * 8.0f, -440.f), 440.f), fminf(fmaxf(h[4 * j + 1] * 8.0f, -440.f), 440.f), wv, false);
              wv = __builtin_amdgcn_cvt_pk_fp8_f32(fminf(fmaxf(h[4 * j + 2] * 8.0f, -440.f), 440.f), fminf(fmaxf(h[4 * j + 3] * 8.0f, -440.f), 440.f), wv, true);
              *(int*)(H2 + (size_t)r * 1024 + c) = wv; } }
        float p[32];
#pragma unroll
        for (int e = 0; e < 32; ++e) p[e] = 0.f;
        { f32x4 wb[2][8];
#pragma unroll
          for (int eq = 0; eq < 8; ++eq) wb[0][eq] = *(const LAS f32x4*)(WR + ((0 * 8 + eq) * 64 + lane) * 4);
#pragma unroll
          for (int jj = 0; jj < 16; ++jj) {
              if (jj + 1 < 16) {
#pragma unroll
                  for (int eq = 0; eq < 8; ++eq) wb[(jj + 1) & 1][eq] = *(const LAS f32x4*)(WR + (((jj + 1) * 8 + eq) * 64 + lane) * 4); }
#pragma unroll
              for (int eq = 0; eq < 8; ++eq)
#pragma unroll
                  for (int i = 0; i < 4; ++i) p[4 * eq + i] += h[jj] * wb[jj & 1][eq][i];
              asm volatile("" ::: "memory"); } }
        float q16[16], q8[8], q4v[4], q2[2], q1;
#pragma unroll
        for (int k = 0; k < 16; ++k) q16[k] = swap32_sum(p[k], p[16 + k]);
#pragma unroll
        for (int k = 0; k < 8; ++k) q8[k] = swap16_sum(q16[k], q16[8 + k]);
        { const bool hi = (lane & 8) != 0;
#pragma unroll
          for (int k = 0; k < 4; ++k) { const float send = hi ? q8[k] : q8[4 + k], keep = hi ? q8[4 + k] : q8[k];
              q4v[k] = keep + __builtin_bit_cast(float, __builtin_amdgcn_update_dpp(0, __builtin_bit_cast(int, send), 0x128, 0xF, 0xF, true)); } }
        { const bool hi = (lane & 4) != 0;
#pragma unroll
          for (int k = 0; k < 2; ++k) { const float send = hi ? q4v[k] : q4v[2 + k], keep = hi ? q4v[2 + k] : q4v[k];
              int rv = __builtin_amdgcn_update_dpp(0, __builtin_bit_cast(int, send), 0x104, 0xF, 0x5, false);
              rv = __builtin_amdgcn_update_dpp(rv, __builtin_bit_cast(int, send), 0x114, 0xF, 0xA, false);
              q2[k] = keep + __builtin_bit_cast(float, rv); } }
        { const bool hi = (lane & 2) != 0; const float send = hi ? q2[0] : q2[1], keep = hi ? q2[1] : q2[0];
          q1 = keep + __builtin_bit_cast(float, __builtin_amdgcn_update_dpp(0, __builtin_bit_cast(int, send), 0x4E, 0xF, 0xF, true)); }
        q1 += __builtin_bit_cast(float, __builtin_amdgcn_update_dpp(0, __builtin_bit_cast(int, q1), 0xB1, 0xF, 0xF, true));
        const int rl = (r - r0) & 15;
        if (!(lane & 1)) Lg[rl * 33 + (lane >> 1)] = q1 + rbias;
        if (rl == 15) {
            asm volatile("s_waitcnt lgkmcnt(0)" ::: "memory");
            if (lane < 16) {
                float v0 = -3.0e38f, v1 = -3.0e38f, v2 = -3.0e38f, v3 = -3.0e38f; int i0 = 0, i1 = 0, i2 = 0, i3 = 0;
#pragma unroll
                for (int e = 0; e < 32; ++e) { const float x = Lg[lane * 33 + e];
                    const bool c0 = x > v0, c1 = x > v1, c2 = x > v2, c3 = x > v3;
                    v3 = c3 ? (c2 ? v2 : x) : v3; i3 = c3 ? (c2 ? i2 : e) : i3;
                    v2 = c2 ? (c1 ? v1 : x) : v2; i2 = c2 ? (c1 ? i1 : e) : i2;
                    v1 = c1 ? (c0 ? v0 : x) : v1; i1 = c1 ? (c0 ? i0 : e) : i1;
                    v0 = c0 ? x : v0; i0 = c0 ? e : i0; }
                const float e1 = __expf(v1 - v0), e2 = __expf(v2 - v0), e3 = __expf(v3 - v0); const float inv = 1.0f / (1.0f + e1 + e2 + e3);
                const int rr = r - 15 + lane;
                *(int4*)(TK + (size_t)rr * 4) = make_int4(i0, i1, i2, i3); *(f32x4*)(GT + (size_t)rr * 4) = (f32x4){inv, e1 * inv, e2 * inv, e3 * inv};
                __hip_atomic_fetch_add(&hist[i0], 1, __ATOMIC_RELAXED, __HIP_MEMORY_SCOPE_WORKGROUP); __hip_atomic_fetch_add(&hist[i1], 1, __ATOMIC_RELAXED, __HIP_MEMORY_SCOPE_WORKGROUP);
                __hip_atomic_fetch_add(&hist[i2], 1, __ATOMIC_RELAXED, __HIP_MEMORY_SCOPE_WORKGROUP); __hip_atomic_fetch_add(&hist[i3], 1, __ATOMIC_RELAXED, __HIP_MEMORY_SCOPE_WORKGROUP);
            }
            asm volatile("s_waitcnt lgkmcnt(0)" ::: "memory");
        }
    }
    __syncthreads();
    if (tid < 32) ((int*)(C.ws + WS_CNTBLK))[blockIdx.x * 32 + tid] = hist[tid];
    __syncthreads();
}
__device__ __forceinline__ void p_assign(const Ctx& C) {
    PH_IDS;
    LAS int* red = (LAS int*)C.lds;
    LAS int* base = (LAS int*)(C.lds + 4096);
    LAS int* total = (LAS int*)(C.lds + 4224);
    LAS int* segrow = (LAS int*)(C.lds + 4352);
    LAS int* run = (LAS int*)(C.lds + 4608);
    const int* cnt = (const int*)(C.ws + WS_CNTBLK);
    const int b = blockIdx.x;
    __syncthreads();
    { const int e = tid & 31, part = tid >> 5; int slt = 0, sall = 0;
      int vv[16];
#pragma unroll
      for (int q = 0; q < 16; ++q) vv[q] = __hip_atomic_load(cnt + (part * 16 + q) * 32 + e, __ATOMIC_RELAXED, __HIP_MEMORY_SCOPE_AGENT);
#pragma unroll
      for (int q = 0; q < 16; ++q) { sall += vv[q]; if (part * 16 + q < b) slt += vv[q]; }
      red[part * 32 + e] = slt; red[512 + part * 32 + e] = sall; }
    __syncthreads();
    if (tid < 32) { int s0 = 0, s1 = 0;
#pragma unroll
        for (int q = 0; q < 16; ++q) { s0 += red[q * 32 + tid]; s1 += red[512 + q * 32 + tid]; }
        base[tid] = s0; total[tid] = s1; run[tid] = 0; }
    __syncthreads();
    if (tid == 0) { int acc = 0; for (int e = 0; e < 32; ++e) { segrow[e] = acc * 256; if (b == 0) ((int*)(C.ws + WS_MOEINFO))[e] = acc; acc += (total[e] + 255) >> 8; } segrow[32] = acc * 256; if (b == 0) ((int*)(C.ws + WS_MOEINFO))[32] = acc; }
    __syncthreads();
    int* SP = (int*)(C.ws + WS_SLOTPOS); int* ST = (int*)(C.ws + WS_SLOTTOK); const int* TK = (const int*)(C.ws + WS_TOPK);
    const int rows_per_blk = MTOK / C.G;
    LAS int* gc = (LAS int*)(C.lds + 5120);
    int ge[2], grk[2], grow[2];
#pragma unroll
    for (int q = 0; q < 2; ++q) {
        const int g = 2 * wave + q, sidx = g * 64 + lane; grow[q] = b * rows_per_blk + (sidx >> 2);
        ge[q] = TK[(size_t)grow[q] * 4 + (sidx & 3)];
        int rk = 0, myc = 0;
        for (int ee = 0; ee < 32; ++ee) { const unsigned long long m = __ballot(ge[q] == ee);
            if (ge[q] == ee) rk = __popcll(m & ((1ull << lane) - 1ull));
            if (lane == ee) myc = __popcll(m); }
        grk[q] = rk;
        if (lane < 32) gc[g * 32 + lane] = myc;
    }
    __syncthreads();
#pragma unroll
    for (int q = 0; q < 2; ++q) {
        const int g = 2 * wave + q, sidx = g * 64 + lane; int off = 0;
        for (int gp = 0; gp < g; ++gp) off += gc[gp * 32 + ge[q]];
        const int pos = segrow[ge[q]] + base[ge[q]] + off + grk[q];
        SP[(size_t)grow[q] * 4 + (sidx & 3)] = pos; ST[pos] = grow[q];
    }
    if (b < 32) { const int e = b, tot = total[e], first = segrow[e] + tot, last = segrow[e + 1];
        for (int p = first + tid; p < last; p += 512) ST[p] = 0; }
    __syncthreads();
}

__device__ __forceinline__ void p_combine(const Ctx& C, const int layer) {
    PH_IDS;
    const int gw = blockIdx.x * 8 + wave, NGW = C.G * 8;
    const int per = MTOK / NGW;
    const float* MOD = (const float*)(C.ws + WS_MOD) + (size_t)layer * 9 * 6144;
    const float* MODN = (const float*)(C.ws + WS_MOD) + (size_t)9 * 6144;
    const float* gpost = C.a->in[IN_NFPOST] + layer * 1024; const float* gpre1 = C.a->in[IN_NMPRE] + 1024;
    const unsigned char* YS = (const unsigned char*)(C.ws + WS_YSLOT); const int* SP = (const int*)(C.ws + WS_SLOTPOS); const float* GT = (const float*)(C.ws + WS_GATE);
    float* OUT = C.a->out; bf16* XS = (bf16*)(C.ws + WS_XS); unsigned char* HN = (unsigned char*)(C.ws + WS_HN);
    int curb = -1; float cA1[16], cA2[16], cB2[16]; const int vz = vzero();
    const int rbeg = gw * per, rend = gw * per + per;
    int4 npos = *(const int4*)(SP + (size_t)(rbeg + vz) * 4); f32x4 ngt = *(const f32x4*)(GT + (size_t)(rbeg + vz) * 4);
    unsigned nys[4][4]; u32x2 nxv[4]; f32x4 cgt = ngt;
    { const int pp[4] = {npos.x, npos.y, npos.z, npos.w};
#pragma unroll
      for (int k = 0; k < 4; ++k)
#pragma unroll
          for (int j = 0; j < 4; ++j) nys[k][j] = *(const unsigned*)(YS + (size_t)pp[k] * 1024 + 4 * lane + 256 * j);
#pragma unroll
      for (int j = 0; j < 4; ++j) nxv[j] = *(const u32x2*)(XS + (size_t)rbeg * 1024 + 4 * lane + 256 * j); }
    if (rbeg + 1 < rend) { npos = *(const int4*)(SP + (size_t)(rbeg + 1 + vz) * 4); ngt = *(const f32x4*)(GT + (size_t)(rbeg + 1 + vz) * 4); }
    for (int r = rbeg; r < rend; ++r) {
        const int b = r >> 13;
        if (b != curb) { curb = b;
#pragma unroll
            for (int j = 0; j < 4; ++j) { const int c = 4 * lane + 256 * j;
                const f32x4 gp = *(const f32x4*)(gpost + c), gf = *(const f32x4*)(MOD + (size_t)b * 6144 + 5120 + c);
                const f32x4 gg = *(const f32x4*)(gpre1 + c), sc = *(const f32x4*)(MODN + (size_t)b * 6144 + 1024 + c), sh = *(const f32x4*)(MODN + (size_t)b * 6144 + c);
#pragma unroll
                for (int i = 0; i < 4; ++i) { cA1[4 * j + i] = gp[i] * gf[i]; cA2[4 * j + i] = gg[i] * (1.0f + sc[i]); cB2[4 * j + i] = sh[i]; } } }
        unsigned ys[4][4]; u32x2 xc[4]; const f32x4 gt = cgt;
#pragma unroll
        for (int k = 0; k < 4; ++k)
#pragma unroll
            for (int j = 0; j < 4; ++j) ys[k][j] = nys[k][j];
#pragma unroll
        for (int j = 0; j < 4; ++j) xc[j] = nxv[j];
        if (r + 1 < rend) {
            const int pp[4] = {npos.x, npos.y, npos.z, npos.w}; cgt = ngt;
#pragma unroll
            for (int k = 0; k < 4; ++k)
#pragma unroll
                for (int j = 0; j < 4; ++j) nys[k][j] = *(const unsigned*)(YS + (size_t)pp[k] * 1024 + 4 * lane + 256 * j);
#pragma unroll
            for (int j = 0; j < 4; ++j) nxv[j] = *(const u32x2*)(XS + (size_t)(r + 1) * 1024 + 4 * lane + 256 * j);
            if (r + 2 < rend) { npos = *(const int4*)(SP + (size_t)(r + 2 + vz) * 4); ngt = *(const f32x4*)(GT + (size_t)(r + 2 + vz) * 4); } }
        float f[16];
#pragma unroll
        for (int i = 0; i < 16; ++i) f[i] = 0.f;
#pragma unroll
        for (int k = 0; k < 4; ++k) { const float gk = gt[k] * 0.0625f;
#pragma unroll
            for (int j = 0; j < 4; ++j) { const f32v2_t lo = __builtin_amdgcn_cvt_pk_f32_fp8((int)ys[k][j], false), hi = __builtin_amdgcn_cvt_pk_f32_fp8((int)ys[k][j], true);
                f[4 * j] += gk * lo[0]; f[4 * j + 1] += gk * lo[1]; f[4 * j + 2] += gk * hi[0]; f[4 * j + 3] += gk * hi[1]; } }
        float ss = 0.f;
#pragma unroll
        for (int i = 0; i < 16; ++i) ss += f[i] * f[i];
        const float rstd = rsqrtf(wave_sum(ss) * (1.0f / 1024.0f) + EPS);
        float x2[16]; float ss2 = 0.f;
#pragma unroll
        for (int j = 0; j < 4; ++j) { const int c = 4 * lane + 256 * j;
            const f32x4 xv = (f32x4){bf_lo(xc[j].x), bf_hi(xc[j].x), bf_lo(xc[j].y), bf_hi(xc[j].y)};
            f32x4 o;
#pragma unroll
            for (int i = 0; i < 4; ++i) { o[i] = xv[i] + cA1[4 * j + i] * (f[4 * j + i] * rstd); x2[4 * j + i] = o[i]; ss2 += o[i] * o[i]; }
            if (layer == 0) { u32x2 xw; xw.x = cvt_pk(o[0], o[1]); xw.y = cvt_pk(o[2], o[3]); *(u32x2*)(XS + (size_t)r * 1024 + c) = xw; }
            else *(f32x4*)(OUT + (size_t)r * 1024 + c) = o; }
        if (layer == 0) {
            const float rstd2 = rsqrtf(wave_sum(ss2) * (1.0f / 1024.0f) + EPS);
#pragma unroll
            for (int j = 0; j < 4; ++j) { const int c = 4 * lane + 256 * j;
                float hv[4];
#pragma unroll
                for (int i = 0; i < 4; ++i) hv[i] = x2[4 * j + i] * rstd2 * cA2[4 * j + i] + cB2[4 * j + i];
                if (F8_IN1) *(unsigned*)(HN + (size_t)r * 1024 + c) = pk4_fp8(hv[0], hv[1], hv[2], hv[3], 8.f);
                else *(u32x2*)((bf16*)HN + (size_t)r * 1024 + c) = (u32x2){cvt_pk(hv[0], hv[1]), cvt_pk(hv[2], hv[3])}; }
        }
    }
}

__device__ __forceinline__ void p_conv(const Ctx& C) {
    PH_IDS;
    LAS unsigned char* L = C.lds;
    constexpr int O_X = 0;
    constexpr int O_W = 63488;
    const int w = wave;
    const bf16* GLU = (const bf16*)(C.ws + WS_GLU); const bf16* ZC1 = (const bf16*)(C.ws + WS_ZC1); const bf16* GB = (const bf16*)(C.ws + WS_GB);
    unsigned char* A2 = (unsigned char*)(C.ws + WS_A2B);
    __syncthreads();
    { float tmpw[31];
#pragma unroll
      for (int q = 0; q < 31; ++q) tmpw[q] = C.a->in[IN_ODDW][tid + 512 * q];
#pragma unroll
      for (int q = 0; q < 31; ++q) { const int i = tid + 512 * q; const int tap = i >> 9, c = i & 511; const int ln = c >> 3, half = (c >> 2) & 1, qq = c & 3;
          *(LAS float*)(L + O_W + (((tap * 2 + half) * 64 + ln) * 4 + qq) * 4) = tmpw[q]; } }
    float cb[8], lg[8], lb[8], sw0[8], sw1[8], sw2[8];
#pragma unroll
    for (int i = 0; i < 8; ++i) { const int c = 8 * lane + i; cb[i] = C.a->in[IN_ODDWB][c]; lg[i] = C.a->in[IN_ODLNG][c]; lb[i] = C.a->in[IN_ODLNB][c];
        sw0[i] = C.a->in[IN_ODSCONV][c]; sw1[i] = C.a->in[IN_ODSCONV][512 + c]; sw2[i] = C.a->in[IN_ODSCONV][1024 + c]; }
    u32x4 px[8];
    auto fetchx = [&](int unit) { const int bt = unit >> 8, t0 = (unit & 255) * 32;
#pragma unroll
        for (int q = 0; q < 8; ++q) { const int i = tid + 512 * q; const int rr = i >> 6, cc = i & 63; const int tl = t0 - 15 + rr;
            px[q] = (u32x4){0u, 0u, 0u, 0u};
            if (i < 62 * 64 && tl >= 0 && tl < SEQ) px[q] = *(const u32x4*)(GLU + (size_t)(bt * SEQ + tl) * 512 + cc * 8); } };
    if ((int)blockIdx.x < 2048) fetchx(blockIdx.x);
    for (int unit = blockIdx.x; unit < 2048; unit += C.G) {
        const int bt = unit >> 8, t0 = (unit & 255) * 32;
        __syncthreads();
#pragma unroll
        for (int q = 0; q < 8; ++q) { const int i = tid + 512 * q; if (i < 62 * 64) *(LAS u32x4*)(L + O_X + (i >> 6) * 1024 + (i & 63) * 16) = px[q]; }
        __syncthreads();
        if (unit + C.G < 2048) fetchx(unit + C.G);
        float acc[4][8];
#pragma unroll
        for (int o = 0; o < 4; ++o)
#pragma unroll
            for (int i = 0; i < 8; ++i) acc[o][i] = 0.f;
#pragma unroll 4
        for (int tap = 0; tap < 31; ++tap) {
            const f32x4 w0 = *(const LAS f32x4*)(L + O_W + ((tap * 2 + 0) * 64 + lane) * 16), w1 = *(const LAS f32x4*)(L + O_W + ((tap * 2 + 1) * 64 + lane) * 16);
#pragma unroll
            for (int o = 0; o < 4; ++o) {
                const u32x4 xr = *(const LAS u32x4*)(L + O_X + (4 * w + o + tap) * 1024 + lane * 16);
                acc[o][0] += bf_lo(xr[0]) * w0[0]; acc[o][1] += bf_hi(xr[0]) * w0[1]; acc[o][2] += bf_lo(xr[1]) * w0[2]; acc[o][3] += bf_hi(xr[1]) * w0[3];
                acc[o][4] += bf_lo(xr[2]) * w1[0]; acc[o][5] += bf_hi(xr[2]) * w1[1]; acc[o][6] += bf_lo(xr[3]) * w1[2]; acc[o][7] += bf_hi(xr[3]) * w1[3]; }
        }
        u32x4 sz0[4], sz1[4], sz2[4], sgb[4];
#pragma unroll
        for (int o = 0; o < 4; ++o) { const int tl = t0 + 4 * w + o; const size_t tok = (size_t)bt * SEQ + tl;
            sz1[o] = *(const u32x4*)(ZC1 + tok * 512 + 8 * lane); sz0[o] = (u32x4){0u, 0u, 0u, 0u}; sz2[o] = (u32x4){0u, 0u, 0u, 0u};
            if (tl >= 64) sz0[o] = *(const u32x4*)(ZC1 + (tok - 64) * 512 + 8 * lane);
            if (tl + 64 < SEQ) sz2[o] = *(const u32x4*)(ZC1 + (tok + 64) * 512 + 8 * lane);
            sgb[o] = *(const u32x4*)(GB + tok * 512 + 8 * lane); }
#pragma unroll
        for (int o = 0; o < 4; ++o) {
            const int tl = t0 + 4 * w + o; const size_t tok = (size_t)bt * SEQ + tl;
            float v[8]; float s = 0.f;
#pragma unroll
            for (int i = 0; i < 8; ++i) { v[i] = acc[o][i] + cb[i]; s += v[i]; }
            const float mu = wave_sum(s) * (1.0f / 512.0f); float q = 0.f;
#pragma unroll
            for (int i = 0; i < 8; ++i) { v[i] -= mu; q += v[i] * v[i]; }
            const float rstd = rsqrtf(wave_sum(q) * (1.0f / 512.0f) + EPS);
            float y[8];
#pragma unroll
            for (int i = 0; i < 8; ++i) y[i] = siluf_(v[i] * rstd * lg[i] + lb[i]);
            if (F8_OUT1) *(u32x2*)(A2 + tok * 1024 + 8 * lane) = (u32x2){pk4_fp8(y[0], y[1], y[2], y[3], 4.f), pk4_fp8(y[4], y[5], y[6], y[7], 4.f)};
            else *(u32x4*)((bf16*)A2 + tok * 1024 + 8 * lane) = (u32x4){cvt_pk(y[0], y[1]), cvt_pk(y[2], y[3]), cvt_pk(y[4], y[5]), cvt_pk(y[6], y[7])};
            const u32x4 z1 = sz1[o], z0 = sz0[o], z2 = sz2[o], gb = sgb[o];
            float zz[8];
#pragma unroll
            for (int i = 0; i < 4; ++i) {
                zz[2 * i] = (sw0[2 * i] * bf_lo(z0[i]) + sw1[2 * i] * bf_lo(z1[i]) + sw2[2 * i] * bf_lo(z2[i])) * bf_lo(gb[i]);
                zz[2 * i + 1] = (sw0[2 * i + 1] * bf_hi(z0[i]) + sw1[2 * i + 1] * bf_hi(z1[i]) + sw2[2 * i + 1] * bf_hi(z2[i])) * bf_hi(gb[i]); }
            if (F8_OUT1) *(u32x2*)(A2 + tok * 1024 + 512 + 8 * lane) = (u32x2){pk4_fp8(zz[0], zz[1], zz[2], zz[3], 4.f), pk4_fp8(zz[4], zz[5], zz[6], zz[7], 4.f)};
            else *(u32x4*)((bf16*)A2 + tok * 1024 + 512 + 8 * lane) = (u32x4){cvt_pk(zz[0], zz[1]), cvt_pk(zz[2], zz[3]), cvt_pk(zz[4], zz[5]), cvt_pk(zz[6], zz[7])};
        }
    }
    __syncthreads();
}

constexpr int NPHASE = 19;
#ifndef RUN_HI
#define RUN_HI NPHASE
#endif
__global__ void __launch_bounds__(512, 2) fwd_kernel(Args args) {
    extern __shared__ __attribute__((aligned(16))) unsigned char lds_raw[];
    Ctx C; C.lds = (LAS unsigned char*)lds_raw;
    C.G = gridDim.x; C.a = &args; C.ws = args.ws;
    volatile LAS unsigned* MISC = (volatile LAS unsigned*)(C.lds + MISC_OFF);
    if (threadIdx.x < 16) MISC[threadIdx.x] = 0u;
    __syncthreads();
    const int lo = args.ph_lo, hi = args.ph_hi;
    const bool multi = (hi - lo) > 1;
    XcdBarrier bar; bar.bar = (unsigned*)(C.ws + WS_CTL) + 4096; bar.x = 0; bar.st = MISC;
    if (multi) bar = xcd_barrier_post((unsigned*)(C.ws + WS_CTL) + 4096, MISC);
#ifndef PH_MASK
#define PH_MASK 0x7FFFF
#endif
#define IN(k) (((PH_MASK >> (k)) & 1) && lo <= (k) && (k) < hi)
#ifndef DUP_MASK
#define DUP_MASK 0
#endif
#ifndef GLA_PROBE
#define GLA_PROBE 0
#endif
#ifndef PROBE_NOEPI
#define PROBE_NOEPI 0
#endif
#define DUPN(k) (((DUP_MASK >> (k)) & 1) ? 2 : 1)
#define SEAM(k) do { if (IN(k) && IN((k) + 1)) xcd_barrier(bar); } while (0)
    LAS unsigned char* ring = C.lds;
    const int cid = blockIdx.x;

    if (IN(0)) for (int rep_ = 0; rep_ < DUPN(0); ++rep_) { p0_adaln(C); p0_fourier_fold(C); p0_convert(C); } SEAM(0);
    if (IN(1)) for (int rep_ = 0; rep_ < DUPN(1); ++rep_) { p_norm0(C); } SEAM(1);
    if (IN(2)) for (int rep_ = 0; rep_ < DUPN(2); ++rep_) { gm::SchedIn0 S{(const char*)(C.ws + WS_HN), (const char*)(C.ws + WS_WIN0), C.G, cid}; gm::EpiIn0 E{C.ws}; gm::gemm_phase<F8_IN0 != 0>(ring, F8_IN0 ? 1024 : 2048, S, E, 0x7C7C7C7C, 0x7A7A7A7A); } SEAM(2);
    if (IN(3)) for (int rep_ = 0; rep_ < DUPN(3); ++rep_) { p_gla_prep(C); if (GLA_PROBE == 1) p_gla_prep(C); if (GLA_PROBE >= 10) p_gla_prep(C, GLA_PROBE - 10); p_fft1(C); if (GLA_PROBE == 2) p_fft1(C); xcd_barrier(bar); p_gla(C); if (GLA_PROBE == 3) p_gla(C); if (GLA_PROBE == 4) p_gla(C, 1); } SEAM(3);
    if (IN(4)) for (int rep_ = 0; rep_ < DUPN(4); ++rep_) { p_fft2(C); p_gla_out(C); } SEAM(4);
    if (IN(5)) for (int rep_ = 0; rep_ < DUPN(5); ++rep_) { gm::SchedDense S{(const char*)(C.ws + WS_A2), (const char*)(C.ws + WS_WOUT0), F8_OUT0 ? 1536 : 3072, 256, 4, C.G, cid}; gm::EpiPlain E{(bf16*)(C.ws + WS_Y), 1024}; gm::gemm_phase<F8_OUT0 != 0>(ring, F8_OUT0 ? 1536 : 3072, S, E, 0x7C7C7C7C, 0x7A7A7A7A); } SEAM(5);
    if (IN(6)) for (int rep_ = 0; rep_ < DUPN(6); ++rep_) { p_postmix(C, 0); } SEAM(6);
    if (IN(7)) { p_assign(C); } SEAM(7);
    if (IN(8)) for (int rep_ = 0; rep_ < DUPN(8); ++rep_) { const int* tsp = (const int*)(C.ws + WS_MOEINFO); const int ln_ = otid() & 63; const int ts = __hip_atomic_load(tsp + (ln_ < 32 ? ln_ : 32), __ATOMIC_RELAXED, __HIP_MEMORY_SCOPE_AGENT);
        gm::SchedMoE S{(const char*)(C.ws + WS_H2), (const char*)(C.ws + WS_WGU), (const int*)(C.ws + WS_SLOTTOK), ts, __builtin_amdgcn_readlane(ts, 32), 8, C.G, cid, (size_t)2048 * 1024, true, args.in[IN_BGU]};
        gm::EpiGU E{(unsigned char*)(C.ws + WS_ACT), args.in[IN_BGU], PROBE_NOEPI ? rep_ : 0}; gm::gemm_phase<true>(ring, 1024, S, E, 0x7C7C7C7C, 0x7A7A7A7A); } SEAM(8);
    if (IN(9)) for (int rep_ = 0; rep_ < DUPN(9); ++rep_) { const int* tsp = (const int*)(C.ws + WS_MOEINFO); const int ln_ = otid() & 63; const int ts = __hip_atomic_load(tsp + (ln_ < 32 ? ln_ : 32), __ATOMIC_RELAXED, __HIP_MEMORY_SCOPE_AGENT);
        gm::SchedMoE S{(const char*)(C.ws + WS_ACT), (const char*)(C.ws + WS_WD), nullptr, ts, __builtin_amdgcn_readlane(ts, 32), 4, C.G, cid, (size_t)1024 * 1024, false, args.in[IN_BD]};
        gm::EpiDown E{(unsigned char*)(C.ws + WS_YSLOT), args.in[IN_BD]}; gm::gemm_phase<true>(ring, 1024, S, E, 0x7D7D7D7D, 0x7A7A7A7A); } SEAM(9);
    if (IN(10)) { p_combine(C, 0); } SEAM(10);
    if (IN(11)) for (int rep_ = 0; rep_ < DUPN(11); ++rep_) { gm::SchedDense S{(const char*)(C.ws + WS_HN), (const char*)(C.ws + WS_WIN1), F8_IN1 ? 1024 : 2048, 256, 10, C.G, cid}; gm::EpiIn1 E{C.ws}; gm::gemm_phase<F8_IN1 != 0>(ring, F8_IN1 ? 1024 : 2048, S, E, 0x7C7C7C7C, 0x7A7A7A7A); } SEAM(11);
    if (IN(12)) for (int rep_ = 0; rep_ < DUPN(12); ++rep_) { p_conv(C); } SEAM(12);
    if (IN(13)) for (int rep_ = 0; rep_ < DUPN(13); ++rep_) { gm::SchedDense S{(const char*)(C.ws + WS_A2B), (const char*)(C.ws + WS_WOUT1), F8_OUT1 ? 1024 : 2048, 256, 4, C.G, cid}; gm::EpiPlain E{(bf16*)(C.ws + WS_Y), 1024}; gm::gemm_phase<F8_OUT1 != 0>(ring, F8_OUT1 ? 1024 : 2048, S, E, 0x7D7D7D7D, 0x7A7A7A7A); } SEAM(13);
    if (IN(14)) { p_postmix(C, 1); } SEAM(14);
    if (IN(15)) { p_assign(C); } SEAM(15);
    if (IN(16)) for (int rep_ = 0; rep_ < DUPN(16); ++rep_) { const int* tsp = (const int*)(C.ws + WS_MOEINFO); const int ln_ = otid() & 63; const int ts = __hip_atomic_load(tsp + (ln_ < 32 ? ln_ : 32), __ATOMIC_RELAXED, __HIP_MEMORY_SCOPE_AGENT);
        gm::SchedMoE S{(const char*)(C.ws + WS_H2), (const char*)(C.ws + WS_WGU) + (size_t)32 * 2048 * 1024, (const int*)(C.ws + WS_SLOTTOK), ts, __builtin_amdgcn_readlane(ts, 32), 8, C.G, cid, (size_t)2048 * 1024, true, args.in[IN_BGU] + 32 * 2048};
        gm::EpiGU E{(unsigned char*)(C.ws + WS_ACT), args.in[IN_BGU] + 32 * 2048, 0}; gm::gemm_phase<true>(ring, 1024, S, E, 0x7C7C7C7C, 0x7A7A7A7A); } SEAM(16);
    if (IN(17)) for (int rep_ = 0; rep_ < DUPN(17); ++rep_) { const int* tsp = (const int*)(C.ws + WS_MOEINFO); const int ln_ = otid() & 63; const int ts = __hip_atomic_load(tsp + (ln_ < 32 ? ln_ : 32), __ATOMIC_RELAXED, __HIP_MEMORY_SCOPE_AGENT);
        gm::SchedMoE S{(const char*)(C.ws + WS_ACT), (const char*)(C.ws + WS_WD) + (size_t)32 * 1024 * 1024, nullptr, ts, __builtin_amdgcn_readlane(ts, 32), 4, C.G, cid, (size_t)1024 * 1024, false, args.in[IN_BD] + 32 * 1024};
        gm::EpiDown E{(unsigned char*)(C.ws + WS_YSLOT), args.in[IN_BD] + 32 * 1024}; gm::gemm_phase<true>(ring, 1024, S, E, 0x7D7D7D7D, 0x7A7A7A7A); } SEAM(17);
    if (IN(18)) { p_combine(C, 1); }
#ifdef DBG_COPY_OFF
    if (lo == 99) { const bf16* src = (const bf16*)(C.ws + (size_t)DBG_COPY_OFF); float* dst = args.out;
        for (size_t i = (size_t)blockIdx.x * 512 + threadIdx.x; i < (size_t)MTOK * 1024; i += (size_t)gridDim.x * 512) dst[i] = bf_lo((unsigned)src[i]); }
#endif
#undef IN
#undef SEAM
}

extern "C" void kernel_launch(void* const* d_in, const int* in_sizes, int n_in, void* d_out, int out_size, void* d_ws, size_t ws_size, hipStream_t stream) {
    static int grid = 0;
    if (grid == 0) {
        if (n_in != 28 || out_size != MTOK * D || ws_size < WS_END) { fprintf(stderr, "kernel_launch: unexpected problem (n_in %d out %d ws %zu need %zu)\n", n_in, out_size, ws_size, (size_t)WS_END); grid = -1; return; }
        int dev = 0, cus = 0, per_cu = 0;
        (void)hipGetDevice(&dev); (void)hipDeviceGetAttribute(&cus, hipDeviceAttributeMultiprocessorCount, dev);
        if (hipFuncSetAttribute((const void*)fwd_kernel, hipFuncAttributeMaxDynamicSharedMemorySize, LDS_BYTES) != hipSuccess) { fprintf(stderr, "kernel_launch: hipFuncSetAttribute failed\n"); grid = -1; return; }
        (void)hipOccupancyMaxActiveBlocksPerMultiprocessor(&per_cu, (const void*)fwd_kernel, 512, LDS_BYTES);
        (void)hipGetLastError();
        grid = cus;
        if (grid != 256 || per_cu < 1) { fprintf(stderr, "kernel_launch: needs a 256-CU device with one resident workgroup per CU (cus %d, per_cu %d)\n", cus, per_cu); grid = -1; return; }
    }
    if (grid < 0) return;
    (void)hipMemsetAsync((char*)d_ws + WS_CTL, 0, CTL_ZERO_BYTES, stream);
    Args a{};
    for (int i = 0; i < 28; ++i) a.in[i] = (const float*)d_in[i];
    a.out = (float*)d_out; a.ws = (unsigned char*)d_ws;
#if N_LAUNCH_MODE == 1
    a.ph_lo = 0; a.ph_hi = NPHASE;
    hipLaunchKernelGGL(fwd_kernel, dim3(grid), dim3(512), LDS_BYTES, stream, a);
#else
    for (int p = 0; p < RUN_HI; ++p) { a.ph_lo = p; a.ph_hi = p + 1; hipLaunchKernelGGL(fwd_kernel, dim3(grid), dim3(512), LDS_BYTES, stream, a); }
#ifdef DBG_COPY_OFF
    a.ph_lo = 99; a.ph_hi = 100; hipLaunchKernelGGL(fwd_kernel, dim3(grid), dim3(512), LDS_BYTES, stream, a);
#endif
#endif
}
```

```cpp
#include <hip/hip_runtime.h>
#include <cstdio>
#include <cstdint>

#ifndef N_LAUNCH_MODE
#define N_LAUNCH_MODE 1
#endif

#ifndef F8_IN0
#define F8_IN0 0
#endif
#ifndef F8_OUT0
#define F8_OUT0 0
#endif
#ifndef F8_IN1
#define F8_IN1 1
#endif
#ifndef F8_OUT1
#define F8_OUT1 1
#endif
#define LAS __attribute__((address_space(3)))
typedef unsigned short bf16;
typedef short bf16x8 __attribute__((ext_vector_type(8)));
typedef short s16x4 __attribute__((ext_vector_type(4)));
typedef float f32x4 __attribute__((ext_vector_type(4)));
typedef float f32x16 __attribute__((ext_vector_type(16)));
typedef unsigned u32x4 __attribute__((ext_vector_type(4)));
typedef unsigned u32x2 __attribute__((ext_vector_type(2)));

constexpr int D = 1024, NB = 8, SEQ = 8192, CTXL = 256;
constexpr int MTOK = NB * SEQ;
constexpr int MCTX = NB * CTXL;
constexpr int MALL = MTOK + MCTX;
constexpr int NE = 32, TOPK = 4;
constexpr int NSLOT_PAD = MTOK * TOPK + NE * 256;
constexpr int N_IN0 = 3840;
constexpr int N_IN1 = 2560;
constexpr float EPS = 1e-6f;

constexpr size_t MiB = 1u << 20;
constexpr size_t WS_CTL = 0, CTL_ZERO_BYTES = 65536;
constexpr size_t WS_MOD = 1 * MiB;
constexpr size_t WS_F1 = 2 * MiB;
constexpr size_t WS_F2 = 2 * MiB + 65536;
constexpr size_t WS_CNTBLK = 3 * MiB;
constexpr size_t WS_MOEINFO = 3 * MiB + 65536;
constexpr size_t WS_TOPK = 4 * MiB;
constexpr size_t WS_GATE = 5 * MiB;
constexpr size_t WS_SLOTPOS = 6 * MiB;
constexpr size_t WS_SLOTTOK = 7 * MiB;
constexpr size_t WS_WIN0 = 10 * MiB;
constexpr size_t WS_WOUT0 = 19 * MiB;
constexpr size_t WS_WIN1 = 22 * MiB;
constexpr size_t WS_WOUT1 = 27 * MiB;
constexpr size_t WS_WGU = 32 * MiB;
constexpr size_t WS_WD = 288 * MiB;
constexpr size_t WS_HN = 416 * MiB;
constexpr size_t WS_B = 548 * MiB;
constexpr size_t WS_ACT = WS_B;
constexpr size_t WS_YSLOT = WS_B + 528 * MiB;
constexpr size_t WS_Q = WS_B, WS_K = WS_B + 64 * MiB, WS_V = WS_B + 130 * MiB, WS_R = WS_B + 262 * MiB;
constexpr size_t WS_ZC = WS_B + 390 * MiB, WS_ZS = WS_B + 454 * MiB, WS_LR = WS_B + 518 * MiB;
constexpr size_t WS_OF = WS_B + 528 * MiB, WS_OB = WS_B + 656 * MiB, WS_YR = WS_B + 784 * MiB, WS_YI = WS_B + 848 * MiB;
constexpr size_t WS_A2 = WS_B;
constexpr size_t WS_Y = WS_B + 528 * MiB;
constexpr size_t WS_H2 = WS_B + 656 * MiB;
constexpr size_t WS_GLU = WS_B, WS_ZC1 = WS_B + 64 * MiB, WS_GB = WS_B + 128 * MiB, WS_A2B = WS_B + 192 * MiB;
constexpr size_t WS_XS = WS_B + 1056 * MiB;
constexpr size_t WS_GQP = WS_B + 1056 * MiB;
constexpr size_t WS_GKPP = WS_GQP + 132 * MiB;
constexpr size_t WS_GSC = WS_GKPP + 132 * MiB;
constexpr size_t WS_GEL = WS_GSC + 66 * MiB;
constexpr size_t WS_END = WS_GEL + 6 * MiB;

constexpr int LDS_BYTES = 155648;
constexpr int MISC_OFF = LDS_BYTES - 256;

__device__ __forceinline__ float bf_lo(unsigned u) { return __uint_as_float(u << 16); }
__device__ __forceinline__ float bf_hi(unsigned u) { return __uint_as_float(u & 0xffff0000u); }
typedef __bf16 bf16v2_t __attribute__((ext_vector_type(2)));
typedef float f32v2_t __attribute__((ext_vector_type(2)));
__device__ __forceinline__ unsigned cvt_pk(float lo, float hi) { const f32v2_t v = {lo, hi}; const bf16v2_t r = __builtin_convertvector(v, bf16v2_t); return __builtin_bit_cast(unsigned, r); }
__device__ __forceinline__ unsigned f2bf(float f) { unsigned u = __float_as_uint(f); return (u + 0x7fffu + ((u >> 16) & 1u)) >> 16; }
__device__ __forceinline__ float swap32_sum(float a, float b) {
    const auto r = __builtin_amdgcn_permlane32_swap(__builtin_bit_cast(unsigned, a), __builtin_bit_cast(unsigned, b), false, false);
    unsigned x = r[0], y = r[1]; asm volatile("" : "+v"(x), "+v"(y));
    return __builtin_bit_cast(float, x) + __builtin_bit_cast(float, y);
}
__device__ __forceinline__ float swap16_sum(float a, float b) {
    const auto r = __builtin_amdgcn_permlane16_swap(__builtin_bit_cast(unsigned, a), __builtin_bit_cast(unsigned, b), false, false);
    unsigned x = r[0], y = r[1]; asm volatile("" : "+v"(x), "+v"(y));
    return __builtin_bit_cast(float, x) + __builtin_bit_cast(float, y);
}
__device__ __forceinline__ float row16_sum(float v) {
    v += __builtin_bit_cast(float, __builtin_amdgcn_update_dpp(0, __builtin_bit_cast(int, v), 0xB1, 0xF, 0xF, true));
    v += __builtin_bit_cast(float, __builtin_amdgcn_update_dpp(0, __builtin_bit_cast(int, v), 0x4E, 0xF, 0xF, true));
    v += __builtin_bit_cast(float, __builtin_amdgcn_update_dpp(0, __builtin_bit_cast(int, v), 0x141, 0xF, 0xF, true));
    v += __builtin_bit_cast(float, __builtin_amdgcn_update_dpp(0, __builtin_bit_cast(int, v), 0x140, 0xF, 0xF, true));
    return v;
}
__device__ __forceinline__ float wave_sum(float v) {
    v = row16_sum(v);
    const int iv = __builtin_bit_cast(int, v);
    const float a = __builtin_bit_cast(float, __builtin_amdgcn_readlane(iv, 0)), b = __builtin_bit_cast(float, __builtin_amdgcn_readlane(iv, 16));
    const float c = __builtin_bit_cast(float, __builtin_amdgcn_readlane(iv, 32)), d = __builtin_bit_cast(float, __builtin_amdgcn_readlane(iv, 48));
    return (a + b) + (c + d);
}
__device__ __forceinline__ unsigned pk4_fp8(float a, float b, float c, float d, float sc) {
    int w = 0;
    w = __builtin_amdgcn_cvt_pk_fp8_f32(__builtin_amdgcn_fmed3f(a * sc, -440.f, 440.f), __builtin_amdgcn_fmed3f(b * sc, -440.f, 440.f), w, false);
    w = __builtin_amdgcn_cvt_pk_fp8_f32(__builtin_amdgcn_fmed3f(c * sc, -440.f, 440.f), __builtin_amdgcn_fmed3f(d * sc, -440.f, 440.f), w, true);
    return (unsigned)w;
}
__device__ __forceinline__ float sigmoidf_(float x) { return __builtin_amdgcn_rcpf(1.0f + __builtin_amdgcn_exp2f(x * -1.4426950408889634f)); }
__device__ __forceinline__ float siluf_(float x) { return x * sigmoidf_(x); }

#define XB_TMO      128
#define XB_XCNT(j)  (256  + 64 * (j))
#define XB_XSUB(j)  (1280 + 64 * (j))
#define XB_XGEN(j)  (2304 + 64 * (j))
#define XB_TOP      3328
#define XB_TOPGEN   3392
#define XCD_BAR_WORDS 3456
#define XB_SPIN_CAP (1u << 18)
__device__ __forceinline__ unsigned xb_ld(unsigned* p)              { return __hip_atomic_load(p, __ATOMIC_RELAXED, __HIP_MEMORY_SCOPE_AGENT); }
__device__ __forceinline__ unsigned xb_add(unsigned* p, unsigned v) { return __hip_atomic_fetch_add(p, v, __ATOMIC_RELAXED, __HIP_MEMORY_SCOPE_AGENT); }
__device__ __forceinline__ unsigned xb_xcc_id() { return (unsigned)__builtin_amdgcn_s_getreg((3 << 11) | 20) & 0xFu; }
#define XB_SPIN(cond, bar) do { unsigned _sp = 0; while (cond) { __builtin_amdgcn_s_sleep(1); \
    if ((++_sp & 255u) == 0u) { if (xb_ld(&(bar)[XB_TMO])) break; if (_sp > XB_SPIN_CAP) { atomicAdd(&(bar)[XB_TMO], 1u); break; } } } } while (0)
struct XcdBarrier { unsigned* bar; unsigned x; volatile LAS unsigned* st; };
__device__ __forceinline__ XcdBarrier xcd_barrier_post(unsigned* bar, volatile LAS unsigned* st) {
    XcdBarrier b; b.bar = bar; b.x = xb_xcc_id(); b.st = st;
    if (threadIdx.x == 0) (void)xb_add(&bar[XB_XCNT(b.x)], 1u);
    return b;
}
__device__ __forceinline__ void xcd_barrier_complete(unsigned* bar, unsigned x, unsigned& nloc, unsigned& nx) {
    const unsigned G = gridDim.x * gridDim.y * gridDim.z;
    unsigned sum, cnt, mine, sp = 0u;
    for (;;) {
        sum = 0u; cnt = 0u; mine = 0u;
#pragma unroll
        for (unsigned j = 0; j < 16; ++j) { const unsigned c = xb_ld(&bar[XB_XCNT(j)]); sum += c; cnt += (c > 0u) ? 1u : 0u; mine = (j == x) ? c : mine; }
        if (sum == G) break;
        __builtin_amdgcn_s_sleep(1);
        if ((++sp & 255u) == 0u) { if (xb_ld(&bar[XB_TMO])) break; if (sp > XB_SPIN_CAP) { atomicAdd(&bar[XB_TMO], 1u); break; } }
    }
    nloc = mine > 0u ? mine : 1u; nx = cnt > 0u ? cnt : 1u;
}
__device__ __forceinline__ void xcd_barrier(const XcdBarrier& b) {
    asm volatile("s_waitcnt vmcnt(0)" ::: "memory");
    __syncthreads();
    if (threadIdx.x == 0) {
        unsigned* bar = b.bar;
        __builtin_amdgcn_s_waitcnt(0);
        unsigned nloc = b.st[0], nx = b.st[1];
        if (nloc == 0u) { xcd_barrier_complete(bar, b.x, nloc, nx); b.st[0] = nloc; b.st[1] = nx; }
        const unsigned old = xb_add(&bar[XB_XSUB(b.x)], 1u);
        const unsigned gen = old / nloc;
        if (old + 1u == (gen + 1u) * nloc) {
            __builtin_amdgcn_fence(__ATOMIC_RELEASE, "agent");
            asm volatile("s_waitcnt vmcnt(0)" ::: "memory");
            const unsigned og = xb_add(&bar[XB_TOP], 1u);
            const unsigned tg = og / nx;
            if (og + 1u == (tg + 1u) * nx) xb_add(&bar[XB_TOPGEN], 1u);
            else XB_SPIN(xb_ld(&bar[XB_TOPGEN]) == tg, bar);
            __builtin_amdgcn_fence(__ATOMIC_ACQUIRE, "agent");
            xb_add(&bar[XB_XGEN(b.x)], 1u);
            asm volatile("s_waitcnt vmcnt(0)" ::: "memory");
        } else {
            XB_SPIN(xb_ld(&bar[XB_XGEN(b.x)]) == gen, bar);
            __builtin_amdgcn_fence(__ATOMIC_ACQUIRE, "agent");
            asm volatile("s_waitcnt vmcnt(0)" ::: "memory");
        }
    }
    __syncthreads();
}

struct Args {
    const float* in[28];
    float* out;
    unsigned char* ws;
    int ph_lo, ph_hi;
};
struct Ctx {
    LAS unsigned char* lds;
    int G;
    const Args* a;
    unsigned char* ws;
};
__device__ __forceinline__ int otid() { int t = (int)threadIdx.x; asm volatile("" : "+v"(t)); return t; }
__device__ __forceinline__ int vzero() { int z = 0; asm volatile("" : "+v"(z)); return z; }
#define PH_IDS const int tid = otid(), lane = tid & 63, wave = __builtin_amdgcn_readfirstlane(tid >> 6); (void)tid; (void)lane; (void)wave
#define IN_X 0
#define IN_C 1
#define IN_CTX 2
#define IN_CCTX 3
#define IN_MODW 4
#define IN_MODB 5
#define IN_NMPRE 6
#define IN_NMPOST 7
#define IN_NFPRE 8
#define IN_NFPOST 9
#define IN_EVWIN 10
#define IN_EVGKUP 11
#define IN_EVGKB 12
#define IN_EVGNORM 13
#define IN_EVWOUT 14
#define IN_ODWIN 15
#define IN_ODDW 16
#define IN_ODDWB 17
#define IN_ODLNG 18
#define IN_ODLNB 19
#define IN_ODSCONV 20
#define IN_ODWOUT 21
#define IN_RW 22
#define IN_RB 23
#define IN_WGU 24
#define IN_BGU 25
#define IN_WD 26
#define IN_BD 27

namespace gm {
constexpr int BM = 256, BK = 64, HALF = 128, HTB = HALF * BK * 2, STAGE_BYTES = 8 * HTB, NXCD = 8, WGM = 8;
constexpr int XT_OFF = 131072;
constexpr int XB_OFF = XT_OFF + 16384;
__device__ __forceinline__ int lds_byte(int r, int c) { const int st = (r >> 4) * 2 + (c >> 5), rr = r & 15, cc = c & 31, ob = rr * 64 + cc * 2; return st * 1024 + (ob ^ (((ob >> 9) & 1) << 5)); }
__device__ __forceinline__ void stage_rc(int b, int& R, int& C) { const int st = b / 1024, sb = b % 1024, swz = sb ^ (((sb >> 9) & 1) << 5); R = (st >> 1) * 16 + swz / 64; C = (st & 1) * 32 + (swz % 64) / 2; }
__device__ __forceinline__ int perm32(int rho) { const int n = rho >> 4, i = rho & 15; return 8 * (i >> 2) + 4 * n + (i & 3); }
struct Unit { int pm, pn, e; };

__device__ __forceinline__ void dense_map(int L, int nM, int nN, int& pm, int& pn) {
    const int nwg = nM * nN; int wgid = L;
    { const int q = nwg / NXCD, r = nwg % NXCD, xcd = wgid % NXCD, off = wgid / NXCD; wgid = (xcd < r ? xcd * (q + 1) : r * (q + 1) + (xcd - r) * q) + off; }
    const int nig = WGM * nN, gid = wgid / nig, fm = gid * WGM, gsz = (nM - fm) < WGM ? (nM - fm) : WGM;
    pm = fm + ((wgid % nig) % gsz); pn = (wgid % nig) / gsz;
}

typedef int i32x8 __attribute__((ext_vector_type(8)));
typedef int i32x4_ __attribute__((ext_vector_type(4)));
template <bool F8, class Epi, class Sched>
__device__ __forceinline__ void gemm_phase(LAS unsigned char* lds, const int RP, const Sched& S, const Epi& E, const int SCA = 0x7F7F7F7F, const int SCB = 0x7F7F7F7F) {
    const int tid = otid(), wid = __builtin_amdgcn_readfirstlane(tid >> 6), lane = tid & 63, wr = wid >> 2, wc = wid & 3, fr = lane & 15, fq = lane >> 4;
    const int nt = RP / 128;
    unsigned voffB[2];
#pragma unroll
    for (int i = 0; i < 2; ++i) { int R, C; stage_rc(tid * 16 + i * 8192, R, C); const int Rb = (R & ~31) + perm32(R & 31); voffB[i] = (unsigned)(Rb * RP + C * 2); }
    const size_t kstep = (size_t)128;
    const size_t hstepB = (size_t)HALF * RP;
    const unsigned ldsw = (unsigned)wid * 1024u;
    const int aoff = F8 ? lds_byte(wr * 64 + fr, (fq >> 1) * 32 + (fq & 1) * 16) : lds_byte(wr * 64 + fr, fq * 8);
    const int boff = F8 ? lds_byte(wc * 32 + fr, (fq >> 1) * 32 + (fq & 1) * 16) : lds_byte(wc * 32 + fr, fq * 8);
    constexpr int KOFF = F8 ? 16 : 1024;
#define G_SA(b, h) (((b) * 2 + (h)) * HTB)
#define G_SB(b, h) ((4 + (b) * 2 + (h)) * HTB)
#define G_STAGEB(bufoff, gbase) do { _Pragma("unroll") for (int _i = 0; _i < 2; ++_i) \
        __builtin_amdgcn_global_load_lds((const unsigned*)((const char*)(gbase) + voffB[_i]), (LAS unsigned*)(lds + (bufoff) + ldsw + _i * 8192), 16, 0, 0); } while (0)
#define G_STAGEA(bufoff, offs, h, kb) do { _Pragma("unroll") for (int _i = 0; _i < 2; ++_i) \
        __builtin_amdgcn_global_load_lds((const unsigned*)(S.abase() + (size_t)(offs)[h][_i] + (kb)), (LAS unsigned*)(lds + (bufoff) + ldsw + _i * 8192), 16, 0, 0); } while (0)
#define G_LDA(dst, b, h) do { _Pragma("unroll") for (int m = 0; m < 4; ++m) _Pragma("unroll") for (int k = 0; k < 2; ++k) dst[m][k] = *(const LAS bf16x8*)(lds + G_SA(b, h) + aoff + m * 2048 + k * KOFF); } while (0)
#define G_LDB(dst, b, h) do { _Pragma("unroll") for (int n = 0; n < 2; ++n) _Pragma("unroll") for (int k = 0; k < 2; ++k) dst[n][k] = *(const LAS bf16x8*)(lds + G_SB(b, h) + boff + n * 2048 + k * KOFF); } while (0)
#define G_CAT8(x) __builtin_shufflevector(__builtin_bit_cast(i32x4_, (x)[0]), __builtin_bit_cast(i32x4_, (x)[1]), 0, 1, 2, 3, 4, 5, 6, 7)
#define G_MMA(ai, bj, At, Bt) do { __builtin_amdgcn_s_setprio(1); \
        if constexpr (F8) { _Pragma("unroll") for (int m = 0; m < 4; ++m) _Pragma("unroll") for (int n = 0; n < 2; ++n) \
            acc[ai][bj][m][n] = __builtin_amdgcn_mfma_scale_f32_16x16x128_f8f6f4(G_CAT8(Bt[n]), G_CAT8(At[m]), acc[ai][bj][m][n], 0, 0, 0, SCB, 0, SCA); } \
        else { _Pragma("unroll") for (int m = 0; m < 4; ++m) _Pragma("unroll") for (int n = 0; n < 2; ++n) _Pragma("unroll") for (int k = 0; k < 2; ++k) \
            acc[ai][bj][m][n] = __builtin_amdgcn_mfma_f32_16x16x32_bf16(Bt[n][k], At[m][k], acc[ai][bj][m][n], 0, 0, 0); } \
        __builtin_amdgcn_s_setprio(0); } while (0)
#define G_WAIT_V(n) asm volatile("s_waitcnt vmcnt(" #n ")" ::: "memory")
#define G_WAIT_L(n) asm volatile("s_waitcnt lgkmcnt(" #n ")" ::: "memory")
#define G_BAR __builtin_amdgcn_s_barrier()
#define G_SCHED __builtin_amdgcn_sched_barrier(0)
    Unit cur, nxt; int ui = 0;
    if (!S.next(0, cur)) return;
    f32x4 acc[2][2][4][2];
#pragma unroll
    for (int a = 0; a < 2; ++a)
#pragma unroll
        for (int b = 0; b < 2; ++b)
#pragma unroll
            for (int m = 0; m < 4; ++m)
#pragma unroll
                for (int n = 0; n < 2; ++n) acc[a][b][m][n] = (f32x4){0.f, 0.f, 0.f, 0.f};
    bf16x8 At[4][2], B0[2][2], B1[2][2];
    unsigned cAo[2][2];
    S.a_off(cur, cAo);
    const char* cB = S.b_ptr(cur);
    S.prefetch_bias(cur, lds, 0, wid, lane, wc);
    G_STAGEB(G_SB(0, 0), cB); G_STAGEA(G_SA(0, 0), cAo, 0, 0); G_STAGEB(G_SB(0, 1), cB + hstepB); G_STAGEA(G_SA(0, 1), cAo, 1, 0);
    if (wr == 1) G_BAR;
    G_WAIT_V(4); G_BAR;
    G_STAGEB(G_SB(1, 0), cB + kstep); G_STAGEA(G_SA(1, 0), cAo, 0, kstep); G_STAGEB(G_SB(1, 1), cB + hstepB + kstep);
    G_WAIT_V(6); G_BAR;
    for (;;) {
        const bool has_next = S.next(ui + 1, nxt);
        const char* nB = cB;
        if (has_next) { S.prefetch_rows(nxt, lds, (ui + 1) & 1, wid, lane); S.prefetch_bias(nxt, lds, (ui + 1) & 1, wid, lane, wc); nB = S.b_ptr(nxt); }
        for (int t = 0; t < nt; t += 2) {
            const bool last = (t == nt - 2);
            const size_t k1 = (size_t)(t + 1) * kstep;
            G_LDB(B0, 0, 0); G_SCHED; G_LDA(At, 0, 0); G_STAGEA(G_SA(1, 1), cAo, 1, k1);
            if (last) { if (has_next) S.a_off_lds(nxt, lds, (ui + 1) & 1, wid, lane, cAo); cB = nB; }
            const size_t k2 = last ? 0 : (size_t)(t + 2) * kstep;
            const size_t k3 = k2 + kstep;
            const char* b2 = cB + k2; const char* b3 = b2 + kstep;
            G_WAIT_L(8); G_BAR; G_WAIT_L(0); G_MMA(0, 0, At, B0); G_BAR; G_SCHED;
            G_LDB(B1, 0, 1); G_STAGEB(G_SB(0, 0), b2);
            G_BAR; G_WAIT_L(0); G_MMA(0, 1, At, B1); G_BAR;
            G_LDA(At, 0, 1); G_STAGEA(G_SA(0, 0), cAo, 0, k2);
            G_BAR; G_WAIT_L(0); G_MMA(1, 0, At, B0); G_BAR; G_SCHED;
            G_STAGEB(G_SB(0, 1), b2 + hstepB);
            G_WAIT_V(6); G_BAR; G_MMA(1, 1, At, B1); G_BAR;
            G_LDB(B0, 1, 0); G_SCHED; G_LDA(At, 1, 0); G_STAGEA(G_SA(0, 1), cAo, 1, k2);
            G_WAIT_L(8); G_BAR; G_WAIT_L(0); G_MMA(0, 0, At, B0); G_BAR; G_SCHED;
            G_LDB(B1, 1, 1); G_STAGEB(G_SB(1, 0), b3);
            G_BAR; G_WAIT_L(0); G_MMA(0, 1, At, B1); G_BAR;
            G_LDA(At, 1, 1); G_STAGEA(G_SA(1, 0), cAo, 0, k3);
            G_BAR; G_WAIT_L(0); G_MMA(1, 0, At, B0); G_BAR; G_SCHED;
            G_STAGEB(G_SB(1, 1), b3 + hstepB);
            G_WAIT_V(6); G_BAR; G_MMA(1, 1, At, B1); G_BAR;
        }
        E(acc, cur, wr, wc, fr, fq, (const LAS float*)(lds + XB_OFF + ((ui & 1) * 8 + wid) * 256));
        if (!has_next) break;
#pragma unroll
        for (int a = 0; a < 2; ++a)
#pragma unroll
            for (int b = 0; b < 2; ++b)
#pragma unroll
                for (int m = 0; m < 4; ++m)
#pragma unroll
                    for (int n = 0; n < 2; ++n) acc[a][b][m][n] = (f32x4){0.f, 0.f, 0.f, 0.f};
        cur = nxt; ++ui;
    }
    G_WAIT_V(0);
    if (wr == 0) G_BAR;
    G_BAR;
#undef G_SA
#undef G_SB
#undef G_STAGEA
#undef G_STAGEB
#undef G_LDA
#undef G_LDB
#undef G_MMA
#undef G_CAT8
#undef G_WAIT_V
#undef G_WAIT_L
#undef G_BAR
#undef G_SCHED
}

__device__ __forceinline__ void lane_rc(int i, int& R, int& Cb) { int C; stage_rc(otid() * 16 + i * 8192, R, C); Cb = C * 2; }

struct SchedDense {
    const char* A; const char* B; int RP, nM, nN, G, c;
    __device__ __forceinline__ const char* abase() const { return A; }
    __device__ __forceinline__ bool next(int i, Unit& u) const { const long L = (long)i * G + c; if (L >= (long)nM * nN) return false; dense_map((int)L, nM, nN, u.pm, u.pn); u.e = 0; return true; }
    __device__ __forceinline__ void a_off(const Unit& u, unsigned (&o)[2][2]) const {
#pragma unroll
        for (int i = 0; i < 2; ++i) { int R, Cb; lane_rc(i, R, Cb);
#pragma unroll
            for (int h = 0; h < 2; ++h) o[h][i] = (unsigned)(u.pm * BM + h * HALF + R) * (unsigned)RP + (unsigned)Cb; }
    }
    __device__ __forceinline__ void prefetch_rows(const Unit&, LAS unsigned char*, int, int, int) const {}
    __device__ __forceinline__ void prefetch_bias(const Unit&, LAS unsigned char*, int, int, int, int) const {}
    __device__ __forceinline__ void a_off_lds(const Unit& u, LAS unsigned char*, int, int, int, unsigned (&o)[2][2]) const { a_off(u, o); }
    __device__ __forceinline__ const char* b_ptr(const Unit& u) const { return B + (size_t)u.pn * BM * RP; }
};
struct SchedIn0 {
    const char* A; const char* B; int G, c;
    __device__ __forceinline__ const char* abase() const { return A; }
    __device__ __forceinline__ bool next(int i, Unit& u) const {
        const long L = (long)i * G + c; u.e = 0;
        if (L < 256 * 15) { dense_map((int)L, 256, 15, u.pm, u.pn); return true; }
        const int r = (int)(L - 256 * 15); if (r >= 56) return false;
        u.pm = 256 + r / 7; const int q = r % 7; u.pn = (q < 6) ? (2 + q) : 14; return true;
    }
    __device__ __forceinline__ void a_off(const Unit& u, unsigned (&o)[2][2]) const {
#pragma unroll
        for (int i = 0; i < 2; ++i) { int R, Cb; lane_rc(i, R, Cb);
#pragma unroll
            for (int h = 0; h < 2; ++h) o[h][i] = (unsigned)(u.pm * BM + h * HALF + R) * (F8_IN0 ? 1024u : 2048u) + (unsigned)Cb; }
    }
    __device__ __forceinline__ void prefetch_rows(const Unit&, LAS unsigned char*, int, int, int) const {}
    __device__ __forceinline__ void prefetch_bias(const Unit&, LAS unsigned char*, int, int, int, int) const {}
    __device__ __forceinline__ void a_off_lds(const Unit& u, LAS unsigned char*, int, int, int, unsigned (&o)[2][2]) const { a_off(u, o); }
    __device__ __forceinline__ const char* b_ptr(const Unit& u) const { return B + (size_t)u.pn * BM * (F8_IN0 ? 1024 : 2048); }
};
struct SchedMoE {
    const char* A; const char* B; const int* slot_tok; int ts; int RT; int nct; int G, c; size_t bstride_e; bool gather; const float* bias;
    __device__ __forceinline__ const char* abase() const { return A; }
    __device__ __forceinline__ bool next(int i, Unit& u) const {
        const int x = c & 7, j = c >> 3; int rt, ct;
        if (nct == 8) { rt = 32 * i + 4 * x + (j & 3); ct = j >> 2; } else { rt = 64 * i + 8 * x + (j & 7); ct = j >> 3; }
        if (rt >= RT) return false;
        const unsigned long long m = __ballot(((otid() & 63) < 32) && ts <= rt);
        u.pm = rt; u.pn = ct; u.e = __builtin_amdgcn_readfirstlane(__popcll(m)) - 1; return true;
    }
    __device__ __forceinline__ void a_off(const Unit& u, unsigned (&o)[2][2]) const {
#pragma unroll
        for (int i = 0; i < 2; ++i) { int R, Cb; lane_rc(i, R, Cb);
#pragma unroll
            for (int h = 0; h < 2; ++h) { const int row = u.pm * BM + h * HALF + R; const unsigned rr = gather ? (unsigned)slot_tok[row] : (unsigned)row; o[h][i] = rr * 1024u + (unsigned)Cb; } }
    }
    __device__ __forceinline__ const char* b_ptr(const Unit& u) const { return B + (size_t)u.e * bstride_e + (size_t)u.pn * BM * 1024; }
    __device__ __forceinline__ void prefetch_rows(const Unit& u, LAS unsigned char* lds, int par, int wid, int lane) const {
        if (!gather) return;
#pragma unroll
        for (int i = 0; i < 2; ++i) { int R, Cb; lane_rc(i, R, Cb);
#pragma unroll
            for (int h = 0; h < 2; ++h) __builtin_amdgcn_global_load_lds((const unsigned*)(slot_tok + (u.pm * BM + h * HALF + R)), (LAS unsigned*)(lds + XT_OFF + ((par * 8 + wid) * 4 + h * 2 + i) * 256), 4, 0, 0); }
    }
    __device__ __forceinline__ void prefetch_bias(const Unit& u, LAS unsigned char* lds, int par, int wid, int lane, int wc) const {
        const float* src = (nct == 8) ? bias + (size_t)u.e * 2048 + (lane >> 5) * 1024 + u.pn * 128 + wc * 32 + (lane & 31)
                                      : bias + (size_t)u.e * 1024 + u.pn * 256 + (lane >> 5) * 128 + wc * 32 + (lane & 31);
        __builtin_amdgcn_global_load_lds((const unsigned*)src, (LAS unsigned*)(lds + XB_OFF + (par * 8 + wid) * 256), 4, 0, 0);
    }
    __device__ __forceinline__ void a_off_lds(const Unit& u, LAS unsigned char* lds, int par, int wid, int lane, unsigned (&o)[2][2]) const {
#pragma unroll
        for (int i = 0; i < 2; ++i) { int R, Cb; lane_rc(i, R, Cb);
#pragma unroll
            for (int h = 0; h < 2; ++h) { const unsigned rr = gather ? *(const LAS unsigned*)(lds + XT_OFF + ((par * 8 + wid) * 4 + h * 2 + i) * 256 + lane * 4) : (unsigned)(u.pm * BM + h * HALF + R); o[h][i] = rr * 1024u + (unsigned)Cb; } }
    }
};

__device__ __forceinline__ void store8(bf16* p, const f32x4& v0, const f32x4& v1) {
    u32x4 w; w.x = cvt_pk(v0[0], v0[1]); w.y = cvt_pk(v0[2], v0[3]); w.z = cvt_pk(v1[0], v1[1]); w.w = cvt_pk(v1[2], v1[3]);
    *(u32x4*)p = w;
}
struct EpiPlain {
    bf16* O; int ldc;
    __device__ __forceinline__ void operator()(const f32x4 (&acc)[2][2][4][2], const Unit& u, int wr, int wc, int fr, int fq, const LAS float* lb) const {
        const int row0 = u.pm * BM + wr * 64 + fr, col0 = u.pn * BM + wc * 32 + 8 * fq;
#pragma unroll
        for (int ai = 0; ai < 2; ++ai)
#pragma unroll
            for (int m = 0; m < 4; ++m) { bf16* rowp = O + (size_t)(row0 + ai * HALF + m * 16) * ldc + col0;
#pragma unroll
                for (int bj = 0; bj < 2; ++bj) store8(rowp + bj * HALF, acc[ai][bj][m][0], acc[ai][bj][m][1]); }
    }
};
struct EpiIn0 {
    unsigned char* ws;
    __device__ __forceinline__ void operator()(const f32x4 (&acc)[2][2][4][2], const Unit& u, int wr, int wc, int fr, int fq, const LAS float* lb) const {
        const int pn = u.pn; bf16* base; int ldc, c0;
        if (pn < 2) { base = (bf16*)(ws + WS_Q); ldc = 512; c0 = pn * 256; }
        else if (pn < 4) { base = (bf16*)(ws + WS_K); ldc = 512; c0 = (pn - 2) * 256; }
        else if (pn < 8) { base = (bf16*)(ws + WS_V); ldc = 1024; c0 = (pn - 4) * 256; }
        else if (pn < 12) { base = (bf16*)(ws + WS_R); ldc = 1024; c0 = (pn - 8) * 256; }
        else if (pn < 14) { base = (bf16*)(ws + WS_ZC); ldc = 512; c0 = (pn - 12) * 256; }
        else { base = (bf16*)(ws + WS_LR); ldc = 32; c0 = 0; }
        const int row0 = u.pm * BM + wr * 64 + fr, col0 = c0 + wc * 32 + 8 * fq;
        const bool lr = (pn == 14);
        if (lr && wc != 0) return;
        const float qs = (pn < 2) ? 0.08838834764831845f : 1.0f;
#pragma unroll
        for (int ai = 0; ai < 2; ++ai)
#pragma unroll
            for (int m = 0; m < 4; ++m) { bf16* rowp = base + (size_t)(row0 + ai * HALF + m * 16) * ldc + col0;
                store8(rowp, acc[ai][0][m][0] * qs, acc[ai][0][m][1] * qs);
                if (!lr) store8(rowp + HALF, acc[ai][1][m][0] * qs, acc[ai][1][m][1] * qs); }
    }
};
struct EpiIn1 {
    unsigned char* ws;
    __device__ __forceinline__ void operator()(const f32x4 (&acc)[2][2][4][2], const Unit& u, int wr, int wc, int fr, int fq, const LAS float* lb) const {
        const int pn = u.pn; const int row0 = u.pm * BM + wr * 64 + fr;
        if (pn >= 8) { bf16* O = (bf16*)(ws + WS_GB); const int col0 = (pn - 8) * 256 + wc * 32 + 8 * fq;
#pragma unroll
            for (int ai = 0; ai < 2; ++ai)
#pragma unroll
                for (int m = 0; m < 4; ++m) { bf16* rowp = O + (size_t)(row0 + ai * HALF + m * 16) * 512 + col0;
#pragma unroll
                    for (int bj = 0; bj < 2; ++bj) store8(rowp + bj * HALF, acc[ai][bj][m][0], acc[ai][bj][m][1]); }
            return; }
        const bool glu = pn < 4; bf16* O = (bf16*)(ws + (glu ? WS_GLU : WS_ZC1)); const int col0 = (pn & 3) * 128 + wc * 32 + 8 * fq;
#pragma unroll
        for (int ai = 0; ai < 2; ++ai)
#pragma unroll
            for (int m = 0; m < 4; ++m) { f32x4 o[2];
#pragma unroll
                for (int n = 0; n < 2; ++n)
#pragma unroll
                    for (int i = 0; i < 4; i += 2) { const f32v2_t a = (f32v2_t){acc[ai][0][m][n][i], acc[ai][0][m][n][i + 1]}, b = (f32v2_t){acc[ai][1][m][n][i], acc[ai][1][m][n][i + 1]};
                        f32v2_t ov;
                        if (glu) { const f32v2_t ea = b * -1.4426950408889634f; f32v2_t e; e.x = __builtin_amdgcn_exp2f(ea.x); e.y = __builtin_amdgcn_exp2f(ea.y);
                            const f32v2_t d = e + 1.0f; f32v2_t r; r.x = __builtin_amdgcn_rcpf(d.x); r.y = __builtin_amdgcn_rcpf(d.y); ov = a * r; }
                        else ov = a * b;
                        o[n][i] = ov.x; o[n][i + 1] = ov.y; }
                store8(O + (size_t)(row0 + ai * HALF + m * 16) * 512 + col0, o[0], o[1]); }
    }
};
struct EpiGU {
    unsigned char* O; const float* bgu; int probe;
    __device__ __forceinline__ void operator()(const f32x4 (&acc)[2][2][4][2], const Unit& u, int wr, int wc, int fr, int fq, const LAS float* lb) const {
        if (probe) {
#pragma unroll
            for (int a = 0; a < 2; ++a)
#pragma unroll
                for (int b = 0; b < 2; ++b)
#pragma unroll
                    for (int m = 0; m < 4; ++m)
#pragma unroll
                        for (int n = 0; n < 2; ++n) asm volatile("" :: "v"(acc[a][b][m][n]));
            return; }
        const int row0 = u.pm * BM + wr * 64 + fr, col0 = u.pn * 128 + wc * 32 + 8 * fq;
        f32x4 bgv[2], buv[2];
#pragma unroll
        for (int n = 0; n < 2; ++n) { bgv[n] = *(const LAS f32x4*)(lb + 8 * fq + 4 * n); buv[n] = *(const LAS f32x4*)(lb + 32 + 8 * fq + 4 * n); }
#pragma unroll
        for (int ai = 0; ai < 2; ++ai)
#pragma unroll
            for (int m = 0; m < 4; ++m) { f32x4 o[2];
#pragma unroll
                for (int n = 0; n < 2; ++n)
#pragma unroll
                    for (int i = 0; i < 4; i += 2) {
                        f32v2_t g = (f32v2_t){acc[ai][0][m][n][i], acc[ai][0][m][n][i + 1]} + (f32v2_t){bgv[n][i], bgv[n][i + 1]};
                        f32v2_t uu = (f32v2_t){acc[ai][1][m][n][i], acc[ai][1][m][n][i + 1]} + (f32v2_t){buv[n][i], buv[n][i + 1]};
                        g.x = fminf(g.x, 7.0f); g.y = fminf(g.y, 7.0f);
                        uu.x = __builtin_amdgcn_fmed3f(uu.x, -7.0f, 7.0f); uu.y = __builtin_amdgcn_fmed3f(uu.y, -7.0f, 7.0f);
                        const f32v2_t ea = g * (-1.702f * 1.4426950408889634f);
                        f32v2_t e; e.x = __builtin_amdgcn_exp2f(ea.x); e.y = __builtin_amdgcn_exp2f(ea.y);
                        const f32v2_t d = e + 1.0f;
                        f32v2_t r; r.x = __builtin_amdgcn_rcpf(d.x); r.y = __builtin_amdgcn_rcpf(d.y);
                        const f32v2_t t4 = uu * 4.0f + 4.0f;
                        const f32v2_t ov = (g * r) * t4;
                        o[n][i] = ov.x; o[n][i + 1] = ov.y; }
                int w0 = 0, w1 = 0;
                w0 = __builtin_amdgcn_cvt_pk_fp8_f32(o[0][0], o[0][1], w0, false); w0 = __builtin_amdgcn_cvt_pk_fp8_f32(o[0][2], o[0][3], w0, true);
                w1 = __builtin_amdgcn_cvt_pk_fp8_f32(o[1][0], o[1][1], w1, false); w1 = __builtin_amdgcn_cvt_pk_fp8_f32(o[1][2], o[1][3], w1, true);
                *(u32x2*)(O + (size_t)(row0 + ai * HALF + m * 16) * 1024 + col0) = (u32x2){(unsigned)w0, (unsigned)w1}; }
    }
};
struct EpiDown {
    unsigned char* O; const float* bd;
    __device__ __forceinline__ void operator()(const f32x4 (&acc)[2][2][4][2], const Unit& u, int wr, int wc, int fr, int fq, const LAS float* lb) const {
        const int row0 = u.pm * BM + wr * 64 + fr, col0 = u.pn * BM + wc * 32 + 8 * fq;
        f32x4 bv[2][2];
#pragma unroll
        for (int bj = 0; bj < 2; ++bj)
#pragma unroll
            for (int n = 0; n < 2; ++n) bv[bj][n] = *(const LAS f32x4*)(lb + 32 * bj + 8 * fq + 4 * n) * 16.0f;
#pragma unroll
        for (int ai = 0; ai < 2; ++ai)
#pragma unroll
            for (int m = 0; m < 4; ++m) { unsigned char* rowp = O + (size_t)(row0 + ai * HALF + m * 16) * 1024 + col0;
#pragma unroll
                for (int bj = 0; bj < 2; ++bj) { const f32x4 v0 = acc[ai][bj][m][0] * 16.0f + bv[bj][0], v1 = acc[ai][bj][m][1] * 16.0f + bv[bj][1];
                    int w0 = 0, w1 = 0;
                    w0 = __builtin_amdgcn_cvt_pk_fp8_f32(fminf(fmaxf(v0[0], -440.f), 440.f), fminf(fmaxf(v0[1], -440.f), 440.f), w0, false); w0 = __builtin_amdgcn_cvt_pk_fp8_f32(fminf(fmaxf(v0[2], -440.f), 440.f), fminf(fmaxf(v0[3], -440.f), 440.f), w0, true);
                    w1 = __builtin_amdgcn_cvt_pk_fp8_f32(fminf(fmaxf(v1[0], -440.f), 440.f), fminf(fmaxf(v1[1], -440.f), 440.f), w1, false); w1 = __builtin_amdgcn_cvt_pk_fp8_f32(fminf(fmaxf(v1[2], -440.f), 440.f), fminf(fmaxf(v1[3], -440.f), 440.f), w1, true);
                    *(u32x2*)(rowp + bj * HALF) = (u32x2){(unsigned)w0, (unsigned)w1}; } }
    }
};
}

__device__ __forceinline__ void p0_adaln(const Ctx& C) {
    PH_IDS;
    LAS float* s = (LAS float*)C.lds;
    LAS float* red = (LAS float*)(C.lds + 36864);
    const float* cc = C.a->in[IN_C]; const float* cx = C.a->in[IN_CCTX];
    { float tmpc[18];
#pragma unroll
      for (int q = 0; q < 18; ++q) { const int i = tid + 512 * q; const int b = i >> 10, k = i & 1023; tmpc[q] = (b < 8) ? cc[b * 1024 + k] : cx[k]; }
#pragma unroll
      for (int q = 0; q < 18; ++q) s[tid + 512 * q] = siluf_(tmpc[q]); }
    __syncthreads();
    float* MOD = (float*)(C.ws + WS_MOD);
    for (int item = blockIdx.x; item < 192; item += C.G) {
        const int l = item / 96, cb = item % 96, col = cb * 64 + lane;
        const float* W = C.a->in[IN_MODW] + (size_t)l * 1024 * 6144 + col;
        float acc[9];
#pragma unroll
        for (int b = 0; b < 9; ++b) acc[b] = 0.f;
        const int k0 = wave * 128;
#pragma unroll 8
        for (int k = k0; k < k0 + 128; ++k) { const float w = W[(size_t)k * 6144];
#pragma unroll
            for (int b = 0; b < 9; ++b) acc[b] += s[b * 1024 + k] * w; }
#pragma unroll
        for (int b = 0; b < 9; ++b) red[(wave * 9 + b) * 64 + lane] = acc[b];
        __syncthreads();
        for (int i = tid; i < 576; i += 512) { const int b = i >> 6, ln = i & 63; float v = 0.f;
#pragma unroll
            for (int w = 0; w < 8; ++w) v += red[(w * 9 + b) * 64 + ln];
            v += C.a->in[IN_MODB][l * 6144 + cb * 64 + ln];
            MOD[(size_t)(l * 9 + b) * 6144 + cb * 64 + ln] = v; }
        __syncthreads();
    }
}
__device__ __forceinline__ void p0_tr_item(const float* W, int ldw, int sc0, int k0, bf16* WT, int Kd, int dr0, float scale, LAS float* scr, int lane) {
#pragma unroll 8
    for (int i = 0; i < 32; ++i) { const int kk = 2 * i + (lane >> 5); scr[kk * 33 + (lane & 31)] = W[(size_t)(k0 + kk) * ldw + sc0 + (lane & 31)]; }
    asm volatile("s_waitcnt lgkmcnt(0)" ::: "memory");
    const int c = lane & 7;
#pragma unroll
    for (int j = 0; j < 4; ++j) { const int n = (lane >> 3) + 8 * j; const LAS float* sp = scr + (8 * c) * 33 + n;
        u32x4 o; o.x = cvt_pk(sp[0 * 33] * scale, sp[1 * 33] * scale); o.y = cvt_pk(sp[2 * 33] * scale, sp[3 * 33] * scale);
        o.z = cvt_pk(sp[4 * 33] * scale, sp[5 * 33] * scale); o.w = cvt_pk(sp[6 * 33] * scale, sp[7 * 33] * scale);
        *(u32x4*)(WT + (size_t)(dr0 + n) * Kd + k0 + 8 * c) = o; }
    asm volatile("s_waitcnt lgkmcnt(0)" ::: "memory");
}
__device__ __forceinline__ void p0_tr_item8(const float* W, int ldw, int sc0, int k0, unsigned char* WT, int Kd, int dr0, float scale, LAS float* scr, int lane) {
#pragma unroll 8
    for (int i = 0; i < 64; ++i) { const int kk = 2 * i + (lane >> 5); scr[kk * 33 + (lane & 31)] = W[(size_t)(k0 + kk) * ldw + sc0 + (lane & 31)]; }
    asm volatile("s_waitcnt lgkmcnt(0)" ::: "memory");
    const int c = lane & 7;
#pragma unroll
    for (int j = 0; j < 4; ++j) { const int n = (lane >> 3) + 8 * j; const LAS float* sp = scr + (16 * c) * 33 + n;
        int w[4];
#pragma unroll
        for (int q = 0; q < 4; ++q) { int x = 0;
            x = __builtin_amdgcn_cvt_pk_fp8_f32(sp[(4 * q) * 33] * scale, sp[(4 * q + 1) * 33] * scale, x, false);
            x = __builtin_amdgcn_cvt_pk_fp8_f32(sp[(4 * q + 2) * 33] * scale, sp[(4 * q + 3) * 33] * scale, x, true); w[q] = x; }
        *(u32x4*)(WT + (size_t)(dr0 + n) * Kd + k0 + 16 * c) = (u32x4){(unsigned)w[0], (unsigned)w[1], (unsigned)w[2], (unsigned)w[3]}; }
    asm volatile("s_waitcnt lgkmcnt(0)" ::: "memory");
}
__device__ __forceinline__ int gu_src_col(int dr0) { const int pn = dr0 >> 8, bj = (dr0 >> 7) & 1, t0 = dr0 & 127; return bj * 1024 + 128 * pn + t0; }
__device__ __forceinline__ int in1_src_col(int dr0) {
    const int pn = dr0 >> 8, bj = (dr0 >> 7) & 1, t0 = dr0 & 127;
    if (pn < 4) return bj * 512 + 128 * pn + t0;
    if (pn < 8) return (bj ? 2048 : 1536) + 128 * (pn - 4) + t0;
    return 1024 + (dr0 - 2048);
}
__device__ __forceinline__ void p0_convert(const Ctx& C) {
    PH_IDS;
    LAS float* scr = (LAS float*)(C.lds + wave * 16896);
    const int gw = blockIdx.x * 8 + wave, NGW = C.G * 8;
    constexpr int KB_IN0 = F8_IN0 ? 8 : 16, KB_OUT0 = F8_OUT0 ? 12 : 24, KB_IN1 = F8_IN1 ? 8 : 16, KB_OUT1 = F8_OUT1 ? 8 : 16;
    constexpr int I_IN0 = 97 * KB_IN0, I_OUT0 = 32 * KB_OUT0, I_IN1 = 80 * KB_IN1, I_OUT1 = 32 * KB_OUT1, I_GU = 64 * 64 * 8, I_D = 64 * 32 * 8;
    constexpr int NITEMS = I_IN0 + I_OUT0 + I_IN1 + I_OUT1 + I_GU + I_D;
    for (int it = gw; it < NITEMS; it += NGW) {
        int r = it;
        if (r < I_IN0) { const int nb = r / KB_IN0, kb = r % KB_IN0; int dr0, sc0;
            if (nb < 96) { dr0 = nb * 32; sc0 = dr0; } else { dr0 = 3584; sc0 = 3072; }
            if (F8_IN0) p0_tr_item8(C.a->in[IN_EVWIN], 3616, sc0, kb * 128, (unsigned char*)(C.ws + WS_WIN0), 1024, dr0, 32.f, scr, lane);
            else p0_tr_item(C.a->in[IN_EVWIN], 3616, sc0, kb * 64, (bf16*)(C.ws + WS_WIN0), 1024, dr0, 1.f, scr, lane);
            continue; }
        r -= I_IN0;
        if (r < I_OUT0) { const int nb = r / KB_OUT0, kb = r % KB_OUT0;
            if (F8_OUT0) p0_tr_item8(C.a->in[IN_EVWOUT], 1024, nb * 32, kb * 128, (unsigned char*)(C.ws + WS_WOUT0), 1536, nb * 32, 32.f, scr, lane);
            else p0_tr_item(C.a->in[IN_EVWOUT], 1024, nb * 32, kb * 64, (bf16*)(C.ws + WS_WOUT0), 1536, nb * 32, 1.f, scr, lane);
            continue; }
        r -= I_OUT0;
        if (r < I_IN1) { const int nb = r / KB_IN1, kb = r % KB_IN1;
            if (F8_IN1) p0_tr_item8(C.a->in[IN_ODWIN], 2560, in1_src_col(nb * 32), kb * 128, (unsigned char*)(C.ws + WS_WIN1), 1024, nb * 32, 32.f, scr, lane);
            else p0_tr_item(C.a->in[IN_ODWIN], 2560, in1_src_col(nb * 32), kb * 64, (bf16*)(C.ws + WS_WIN1), 1024, nb * 32, 1.f, scr, lane);
            continue; }
        r -= I_IN1;
        if (r < I_OUT1) { const int nb = r / KB_OUT1, kb = r % KB_OUT1;
            if (F8_OUT1) p0_tr_item8(C.a->in[IN_ODWOUT], 1024, nb * 32, kb * 128, (unsigned char*)(C.ws + WS_WOUT1), 1024, nb * 32, 32.f, scr, lane);
            else p0_tr_item(C.a->in[IN_ODWOUT], 1024, nb * 32, kb * 64, (bf16*)(C.ws + WS_WOUT1), 1024, nb * 32, 1.f, scr, lane);
            continue; }
        r -= I_OUT1;
        if (r < I_GU) { const int le = r >> 9, q = r & 511, nb = q >> 3, kb = q & 7;
            p0_tr_item8(C.a->in[IN_WGU] + (size_t)le * 1024 * 2048, 2048, gu_src_col(nb * 32), kb * 128, (unsigned char*)(C.ws + WS_WGU) + (size_t)le * 2048 * 1024, 1024, nb * 32, 32.f, scr, lane); continue; }
        r -= I_GU;
        { const int le = r >> 8, q = r & 255, nb = q >> 3, kb = q & 7;
            p0_tr_item8(C.a->in[IN_WD] + (size_t)le * 1024 * 1024, 1024, nb * 32, kb * 128, (unsigned char*)(C.ws + WS_WD) + (size_t)le * 1024 * 1024, 1024, nb * 32, 32.f, scr, lane); }
    }
    { u32x4* z = (u32x4*)((unsigned char*)(C.ws + WS_WIN0) + (size_t)3616 * 1024 * (F8_IN0 ? 1 : 2)); const int n16 = 224 * 1024 * (F8_IN0 ? 1 : 2) / 16;
      for (int i = blockIdx.x * 512 + tid; i < n16; i += C.G * 512) z[i] = (u32x4){0u, 0u, 0u, 0u}; }
    { bf16* F1 = (bf16*)(C.ws + WS_F1); bf16* F2 = (bf16*)(C.ws + WS_F2);
      for (int i = blockIdx.x * 512 + tid; i < 128 * 128 + 128 * 256; i += C.G * 512) {
          if (i < 128 * 128) { const int m = i >> 7, k = i & 127; const int mb = m >> 5, rr = m & 31, g = rr >> 3, hh = (rr >> 2) & 1, ii = rr & 3;
              const int part = g & 1, ap = 16 * mb + 8 * (g >> 1) + 4 * hh + ii, pin = k >> 6, a = k & 63;
              const float th = 6.283185307179586f * (float)((a * ap) & 63) * (1.0f / 64.0f); const float cs = cosf(th), sn = sinf(th);
              const float v = (part == 0) ? (pin == 0 ? cs : -sn) : (pin == 0 ? -sn : -cs);
              F1[i] = (bf16)f2bf(v); }
          else { const int q = i - 128 * 128, m = q >> 8, k = q & 255, pin = k >> 7, b = k & 127;
              const float ps = 6.283185307179586f * (float)((b * m) & 127) * (1.0f / 128.0f);
              F2[q] = (bf16)f2bf(pin == 0 ? cosf(ps) : sinf(ps)); } } }
    __syncthreads();
}
__device__ __forceinline__ void p0_fourier_fold(const Ctx& C) {
    PH_IDS;
    LAS float* Wl = (LAS float*)C.lds;
    LAS float* tab = (LAS float*)(C.lds + 32768);
    unsigned char* WT = (unsigned char*)(C.ws + WS_WIN0);
    for (int item = blockIdx.x; item < 64; item += C.G) {
        const int kb = item >> 2, g = item & 3;
        __syncthreads();
        if (tid < 128) tab[tid] = cosf(6.283185307179586f * (float)tid * (1.0f / 128.0f));
        for (int i = tid; i < 64 * 128; i += 512) { const int kk = i >> 7, c = i & 127; Wl[i] = C.a->in[IN_EVWIN][(size_t)(kb * 64 + kk) * 3616 + 3104 + g * 128 + c]; }
        __syncthreads();
        const int cp = tid & 127, kq = tid >> 7; const bool isS = cp > 64; const int cq = isS ? cp - 64 : cp, shf = isS ? 96 : 0;
        float ac[16];
#pragma unroll
        for (int i = 0; i < 16; ++i) ac[i] = 0.f;
#pragma unroll 4
        for (int c = 0; c < 128; ++c) { const float tr = tab[(c * cq + shf) & 127];
#pragma unroll
            for (int i = 0; i < 16; ++i) ac[i] += Wl[(kq * 16 + i) * 128 + c] * tr; }
        if (F8_IN0) {
            unsigned char* pc = WT + (size_t)(3072 + g * 128 + cp) * 1024 + kb * 64 + kq * 16;
            *(u32x4*)pc = (u32x4){pk4_fp8(ac[0], ac[1], ac[2], ac[3], 32.f), pk4_fp8(ac[4], ac[5], ac[6], ac[7], 32.f), pk4_fp8(ac[8], ac[9], ac[10], ac[11], 32.f), pk4_fp8(ac[12], ac[13], ac[14], ac[15], 32.f)};
        } else {
            bf16* pc = (bf16*)WT + (size_t)(3072 + g * 128 + cp) * 1024 + kb * 64 + kq * 16;
            *(u32x4*)pc = (u32x4){cvt_pk(ac[0], ac[1]), cvt_pk(ac[2], ac[3]), cvt_pk(ac[4], ac[5]), cvt_pk(ac[6], ac[7])}; *(u32x4*)(pc + 8) = (u32x4){cvt_pk(ac[8], ac[9]), cvt_pk(ac[10], ac[11]), cvt_pk(ac[12], ac[13]), cvt_pk(ac[14], ac[15])};
        }
    }
    __syncthreads();
}

__device__ __forceinline__ void p_norm0(const Ctx& C) {
    PH_IDS;
    const int gw = blockIdx.x * 8 + wave, NGW = C.G * 8;
    const int per = (MALL + NGW - 1) / NGW;
    const int r0 = gw * per, r1 = (r0 + per < MALL) ? r0 + per : MALL;
    const float* MOD = (const float*)(C.ws + WS_MOD);
    const float* g = C.a->in[IN_NMPRE];
    unsigned char* HN = (unsigned char*)(C.ws + WS_HN);
    int curb = -1; f32x4 A[4], B[4];
    for (int r = r0; r < r1; ++r) {
        const int b = (r < MTOK) ? (r >> 13) : 8;
        if (b != curb) { curb = b;
#pragma unroll
            for (int j = 0; j < 4; ++j) { const int c = 4 * lane + 256 * j;
                const f32x4 gg = *(const f32x4*)(g + c), sc = *(const f32x4*)(MOD + (size_t)b * 6144 + 1024 + c), sh = *(const f32x4*)(MOD + (size_t)b * 6144 + c);
                A[j] = gg * (sc + 1.0f); B[j] = sh; } }
        const float* xr = (r < MTOK) ? (C.a->in[IN_X] + (size_t)r * 1024) : (C.a->in[IN_CTX] + (size_t)(r - MTOK) * 1024);
        f32x4 v[4]; float ss = 0.f;
#pragma unroll
        for (int j = 0; j < 4; ++j) { v[j] = *(const f32x4*)(xr + 4 * lane + 256 * j); ss += v[j][0] * v[j][0] + v[j][1] * v[j][1] + v[j][2] * v[j][2] + v[j][3] * v[j][3]; }
        const float rstd = rsqrtf(wave_sum(ss) * (1.0f / 1024.0f) + EPS);
#pragma unroll
        for (int j = 0; j < 4; ++j) { const f32x4 h = v[j] * rstd * A[j] + B[j];
            if (F8_IN0) *(unsigned*)(HN + (size_t)r * 1024 + 4 * lane + 256 * j) = pk4_fp8(h[0], h[1], h[2], h[3], 8.f);
            else *(u32x2*)((bf16*)HN + (size_t)r * 1024 + 4 * lane + 256 * j) = (u32x2){cvt_pk(h[0], h[1]), cvt_pk(h[2], h[3])}; }
    }
}

namespace glap {
constexpr int H_BYTES = 72704;
constexpr int O_RAW = 0, O_BC = 2048, O_TOT = 34816, O_QP = 36864, O_KP = 54272;
constexpr int NUNIT = 2 * 4 * 8 * 132;
}
__device__ __forceinline__ int gla_row(int bt, int dir, int s, int i) {
    const int ii = dir ? 63 - i : i;
    if (s < 4) { const int ci = dir ? 3 - s : s; return MTOK + bt * CTXL + ci * 64 + ii; }
    const int n = s - 4, ci = dir ? 127 - n : n; return bt * SEQ + ci * 64 + ii;
}
__device__ __forceinline__ void p_gla_prep(const Ctx& C, const int pv = 0) {
    PH_IDS;
    using namespace glap;
    const int half = tid >> 8, th = tid & 255, wh = wave & 3;
    LAS unsigned char* L = C.lds + half * H_BYTES;
    const bf16* Qg = (const bf16*)(C.ws + WS_Q); const bf16* Kg = (const bf16*)(C.ws + WS_K); const bf16* LRg = (const bf16*)(C.ws + WS_LR);
    bf16* QPg = (bf16*)(C.ws + WS_GQP); bf16* KPPg = (bf16*)(C.ws + WS_GKPP); bf16* SCg = (bf16*)(C.ws + WS_GSC); float* ELg = (float*)(C.ws + WS_GEL);
    const int niter = (NUNIT + 2 * C.G - 1) / (2 * C.G);
    const int lj = th >> 2, part = th & 3;
    u32x4 nq[4], nk[4], nlr; float nup[8], nbias;
    auto unit_of = [&](int itn) -> int { const int U = (itn * C.G + (int)blockIdx.x) * 2 + half; return U < NUNIT ? U : NUNIT - 1; };
    auto issue_loads = [&](int Uc) {
        const int sstep = Uc % 132, bt = (Uc / 132) & 7, hd = (Uc / (132 * 8)) & 3, dir = Uc / (132 * 32);
#pragma unroll
        for (int q = 0; q < 4; ++q) { const int c = th + 256 * q; const int row = gla_row(bt, dir, sstep, c >> 4);
            nk[q] = *(const u32x4*)(Kg + (size_t)row * 512 + hd * 128 + (c & 15) * 8);
            nq[q] = *(const u32x4*)(Qg + (size_t)(sstep >= 4 ? row : 0) * 512 + hd * 128 + (c & 15) * 8); }
        if (th < 128) { const int r2 = gla_row(bt, dir, sstep, th >> 1); nlr = *(const u32x4*)(LRg + (size_t)r2 * 32 + dir * 16 + (th & 1) * 8); }
        const float* up = C.a->in[IN_EVGKUP] + (size_t)dir * 16 * 512 + hd * 128 + 32 * wh + (lane & 31);
#pragma unroll
        for (int q = 0; q < 8; ++q) nup[q] = up[(size_t)(8 * (lane >> 5) + q) * 512];
        nbias = C.a->in[IN_EVGKB][dir * 512 + hd * 128 + 32 * wh + (lane & 31)]; };
    issue_loads(unit_of(0));
    for (int itn = 0; itn < niter; ++itn) {
        const int U = (itn * C.G + (int)blockIdx.x) * 2 + half;
        const bool act = U < NUNIT;
        const int Uc = act ? U : NUNIT - 1;
        const int sstep = Uc % 132;
        const bool latent = sstep >= 4;
        u32x4 rq[4], rk[4], rlr = nlr;
#pragma unroll
        for (int q = 0; q < 4; ++q) { rq[q] = nq[q]; rk[q] = nk[q]; }
        bf16x8 upf; const float gbias = nbias;
        { unsigned short tmp[8];
#pragma unroll
          for (int q = 0; q < 8; ++q) tmp[q] = (unsigned short)f2bf(nup[q]);
          upf = (bf16x8){(short)tmp[0], (short)tmp[1], (short)tmp[2], (short)tmp[3], (short)tmp[4], (short)tmp[5], (short)tmp[6], (short)tmp[7]}; }
        if (itn + 1 < niter) issue_loads(unit_of(itn + 1));
        __syncthreads();
        if (th < 128) *(LAS u32x4*)(L + O_RAW + (th >> 1) * 32 + (th & 1) * 16) = rlr;
        __syncthreads();
#pragma unroll
        for (int jb = 0; jb < 2; ++jb) {
            const bf16x8 af = *(const LAS bf16x8*)(L + O_RAW + (32 * jb + (lane & 31)) * 32 + (lane >> 5) * 16);
            f32x16 z;
#pragma unroll
            for (int i = 0; i < 16; ++i) z[i] = 0.f;
            z = __builtin_amdgcn_mfma_f32_32x32x16_bf16(af, upf, z, 0, 0, 0);
#pragma unroll
            for (int r = 0; r < 16; ++r) { const int j = 32 * jb + (r & 3) + 8 * (r >> 2) + 4 * (lane >> 5); const float zz = z[r] + gbias;
                const float ls = fminf(zz, 0.f) - __logf(1.0f + __expf(-fabsf(zz)));
                *(LAS float*)(L + O_BC + (j * 128 + 32 * wh + (lane & 31)) * 4) = ls * 0.0625f; } }
        __syncthreads();
        { const int dk = th & 127;
          float run0 = 0.f, run1 = 0.f; const int g0 = th >> 7, g1 = g0 + 2;
          float v0[16], v1[16];
#pragma unroll
          for (int q = 0; q < 16; ++q) { v0[q] = *(const LAS float*)(L + O_BC + ((16 * g0 + q) * 128 + dk) * 4); v1[q] = *(const LAS float*)(L + O_BC + ((16 * g1 + q) * 128 + dk) * 4); }
#pragma unroll
          for (int q = 0; q < 16; ++q) { run0 += v0[q]; run1 += v1[q];
              *(LAS float*)(L + O_BC + ((16 * g0 + q) * 128 + dk) * 4) = run0; *(LAS float*)(L + O_BC + ((16 * g1 + q) * 128 + dk) * 4) = run1; }
          *(LAS float*)(L + O_TOT + (g0 * 128 + dk) * 4) = run0; *(LAS float*)(L + O_TOT + (g1 * 128 + dk) * 4) = run1; }
        __syncthreads();
        {
#pragma unroll
          for (int q8 = 0; q8 < 4; ++q8) {
              const int c = th + 256 * q8, cj = c >> 4, jg = cj >> 4, dkc = (c & 15) * 8;
              u32x4 oq, okpp;
#pragma unroll
              for (int hq = 0; hq < 2; ++hq) {
                  const int dk0 = dkc + 4 * hq;
                  f32x4 b = *(const LAS f32x4*)(L + O_BC + (cj * 128 + dk0) * 4), tt = (f32x4){0.f, 0.f, 0.f, 0.f};
#pragma unroll
                  for (int g2 = 0; g2 < 4; ++g2) { const f32x4 tv = *(const LAS f32x4*)(L + O_TOT + (g2 * 128 + dk0) * 4); tt += tv; if (g2 < jg) b += tv; }
                  f32x4 e1, e2, e3;
#pragma unroll
                  for (int i = 0; i < 4; ++i) { if (pv & 4) { e1[i] = b[i]; e2[i] = -b[i]; e3[i] = tt[i] - b[i]; } else { e1[i] = __expf(b[i]); e2[i] = __expf(-b[i]); e3[i] = __expf(tt[i] - b[i]); } }
                  if (cj == 0 && act && !(pv & 1)) { f32x4 el;
#pragma unroll
                      for (int i = 0; i < 4; ++i) el[i] = __expf(tt[i]);
                      *(f32x4*)(ELg + (size_t)Uc * 128 + dk0) = el; }
                  const unsigned qa = hq ? rq[q8].z : rq[q8].x, qb = hq ? rq[q8].w : rq[q8].y;
                  const unsigned ka = hq ? rk[q8].z : rk[q8].x, kb = hq ? rk[q8].w : rk[q8].y;
                  const float q0 = bf_lo(qa), q1 = bf_hi(qa), q2 = bf_lo(qb), q3 = bf_hi(qb);
                  const float k0 = bf_lo(ka), k1 = bf_hi(ka), k2 = bf_lo(kb), k3 = bf_hi(kb);
                  u32x2 o;
                  o.x = cvt_pk(q0 * e1[0], q1 * e1[1]); o.y = cvt_pk(q2 * e1[2], q3 * e1[3]); *(LAS u32x2*)(L + O_QP + cj * 272 + dk0 * 2) = o;
                  if (hq) { oq.z = o.x; oq.w = o.y; } else { oq.x = o.x; oq.y = o.y; }
                  o.x = cvt_pk(k0 * e2[0], k1 * e2[1]); o.y = cvt_pk(k2 * e2[2], k3 * e2[3]); *(LAS u32x2*)(L + O_KP + cj * 272 + dk0 * 2) = o;
                  o.x = cvt_pk(k0 * e3[0], k1 * e3[1]); o.y = cvt_pk(k2 * e3[2], k3 * e3[3]);
                  if (hq) { okpp.z = o.x; okpp.w = o.y; } else { okpp.x = o.x; okpp.y = o.y; }
              }
              if (act && !(pv & 1)) { *(u32x4*)(KPPg + (size_t)Uc * 8192 + c * 8) = okpp; if (latent) *(u32x4*)(QPg + (size_t)Uc * 8192 + c * 8) = oq; }
              else asm volatile("" :: "v"(okpp), "v"(oq));
          } }
        __syncthreads();
        if (latent && act && !(pv & 2)) {
            const int ib = wh;
            for (int jb16 = 0; jb16 <= ib; ++jb16) {
                f32x4 d = (f32x4){0.f, 0.f, 0.f, 0.f};
#pragma unroll
                for (int ks = 0; ks < 4; ++ks) {
                    const bf16x8 a = *(const LAS bf16x8*)(L + O_KP + (16 * jb16 + (lane & 15)) * 272 + (32 * ks + 8 * (lane >> 4)) * 2);
                    const bf16x8 bq = *(const LAS bf16x8*)(L + O_QP + (16 * ib + (lane & 15)) * 272 + (32 * ks + 8 * (lane >> 4)) * 2);
                    d = __builtin_amdgcn_mfma_f32_16x16x32_bf16(a, bq, d, 0, 0, 0); }
                const int i = 16 * ib + (lane & 15), j0 = 16 * jb16 + 4 * (lane >> 4);
#pragma unroll
                for (int r = 0; r < 4; ++r) if (j0 + r > i) d[r] = 0.f;
                u32x2 o; o.x = cvt_pk(d[0], d[1]); o.y = cvt_pk(d[2], d[3]);
                if (!(pv & 1)) *(u32x2*)(SCg + (size_t)Uc * 4096 + i * 64 + j0) = o; else asm volatile("" :: "v"(o));
            }
            for (int jb16 = ib + 1; jb16 < 4; ++jb16) { const int i = 16 * ib + (lane & 15), j0 = 16 * jb16 + 4 * (lane >> 4);
                if (!(pv & 1)) *(u32x2*)(SCg + (size_t)Uc * 4096 + i * 64 + j0) = (u32x2){0u, 0u}; }
        }
    }
    __syncthreads();
}
namespace gla {
constexpr int O_EL = 0, O_QP = 512, O_KPP = 17920, O_V = 38400, O_SC = 50688, IMG_BYTES = 59904, O_ST = 2 * IMG_BYTES;
constexpr int P_QP = 272, P_KPP = 320, P_V = 192, P_SC = 144, P_ST = 272, ST_BYTES = 64 * 272;
__device__ __forceinline__ bf16x8 tr8(LAS unsigned char* p0, LAS unsigned char* p1) {
    const s16x4 a = __builtin_amdgcn_ds_read_tr16_b64_v4i16((LAS s16x4*)p0);
    const s16x4 b = __builtin_amdgcn_ds_read_tr16_b64_v4i16((LAS s16x4*)p1);
    return (bf16x8){a[0], a[1], a[2], a[3], b[0], b[1], b[2], b[3]};
}
}
__device__ __forceinline__ void p_gla(const Ctx& C, const int probe = 0) {
    PH_IDS;
    using namespace gla;
    LAS unsigned char* L = C.lds;
    const int t = tid, w = wave;
    const bf16* Vg = (const bf16*)(C.ws + WS_V);
    const bf16* QPg = (const bf16*)(C.ws + WS_GQP); const bf16* KPPg = (const bf16*)(C.ws + WS_GKPP); const bf16* SCg = (const bf16*)(C.ws + WS_GSC); const float* ELg = (const float*)(C.ws + WS_GEL);
    for (int it = blockIdx.x; it < 256; it += C.G) {
        const int xx = it & 7, jj_ = it >> 3, scan = xx * 8 + (jj_ >> 2), dvs = jj_ & 3;
        const int bt = scan >> 3, hd = (scan >> 1) & 3, dir = scan & 1;
        const int ubase = ((dir * 4 + hd) * 8 + bt) * 132;
        bf16* Og = (bf16*)(C.ws + (probe ? WS_HN : (dir ? WS_OB : WS_OF)));
        __syncthreads();
        for (int i = t; i < ST_BYTES / 16; i += 512) *(LAS u32x4*)(L + O_ST + i * 16) = (u32x4){0u, 0u, 0u, 0u};
        f32x16 S;
#pragma unroll
        for (int i = 0; i < 16; ++i) S[i] = 0.f;
        const int lj = t >> 3, part = t & 7;
        u32x4 rsc, rqp0, rqp1, rkp0, rkp1, rv; f32x4 rel;
        u32x4 nsc, nqp0, nqp1, nkp0, nkp1, nv; f32x4 nel;
        auto load_step = [&](int s_) {
            const int s = probe ? 4 + (s_ & 1) : s_;
            const size_t U = (size_t)(ubase + s);
            const int row = gla_row(bt, dir, s, lj);
            nv = *(const u32x4*)(Vg + (size_t)row * 1024 + hd * 256 + dvs * 64 + part * 8);
            const bf16* kp = KPPg + U * 8192 + t * 8; nkp0 = *(const u32x4*)kp; nkp1 = *(const u32x4*)(kp + 4096);
            if (t < 32) nel = *(const f32x4*)(ELg + U * 128 + t * 4);
            if (s >= 4) { const bf16* qp = QPg + U * 8192 + t * 8; nqp0 = *(const u32x4*)qp; nqp1 = *(const u32x4*)(qp + 4096);
                nsc = *(const u32x4*)(SCg + U * 4096 + lj * 64 + part * 8); } };
        auto shift_regs = [&]() { rsc = nsc; rqp0 = nqp0; rqp1 = nqp1; rkp0 = nkp0; rkp1 = nkp1; rv = nv; rel = nel; };
        auto write_images = [&](int s, int ib_) {
            LAS unsigned char* I = L + ib_ * IMG_BYTES;
            *(LAS u32x4*)(I + O_V + lj * P_V + part * 16) = rv;
            *(LAS u32x4*)(I + O_KPP + (t >> 4) * P_KPP + (t & 15) * 16) = rkp0; *(LAS u32x4*)(I + O_KPP + (32 + (t >> 4)) * P_KPP + (t & 15) * 16) = rkp1;
            if (t < 32) *(LAS f32x4*)(I + O_EL + t * 16) = rel;
            if (s >= 4) { *(LAS u32x4*)(I + O_QP + (t >> 4) * P_QP + (t & 15) * 16) = rqp0; *(LAS u32x4*)(I + O_QP + (32 + (t >> 4)) * P_QP + (t & 15) * 16) = rqp1;
                *(LAS u32x4*)(I + O_SC + lj * P_SC + part * 16) = rsc; } };
        load_step(0); shift_regs(); write_images(0, 0);
        load_step(1); shift_regs();
        load_step(2);
        for (int s = 0; s < 132; ++s) {
            const int cur = s & 1, nx = cur ^ 1;
            const bool latent = (s >= 4);
            LAS unsigned char* I = L + cur * IMG_BYTES;
            __syncthreads();
            if (s + 1 < 132) write_images(s + 1, nx);
            shift_regs();
            if (s + 3 < 132) load_step(s + 3);
            if (latent) {
                const int ib = w >> 1;
                const int g4 = lane >> 4, q4 = (lane & 15) >> 2, p4 = lane & 3;
                const int orow = gla_row(bt, dir, s, 16 * ib + (lane & 15));
#pragma unroll
                for (int cc = 0; cc < 2; ++cc) {
                    const int c = 2 * (w & 1) + cc;
                    f32x4 d = (f32x4){0.f, 0.f, 0.f, 0.f};
#pragma unroll
                    for (int ks = 0; ks < 2; ++ks) {
                        LAS unsigned char* pa = I + O_V + (32 * ks + 8 * g4 + q4) * P_V + (16 * c + 4 * p4) * 2;
                        const bf16x8 a = gla::tr8(pa, pa + 4 * P_V);
                        const bf16x8 b = *(const LAS bf16x8*)(I + O_SC + (16 * ib + (lane & 15)) * P_SC + (32 * ks + 8 * g4) * 2);
                        d = __builtin_amdgcn_mfma_f32_16x16x32_bf16(a, b, d, 0, 0, 0); }
#pragma unroll
                    for (int ks = 0; ks < 4; ++ks) {
                        const bf16x8 a = *(const LAS bf16x8*)(L + O_ST + cur * ST_BYTES + (16 * c + (lane & 15)) * P_ST + (32 * ks + 8 * g4) * 2);
                        const bf16x8 b = *(const LAS bf16x8*)(I + O_QP + (16 * ib + (lane & 15)) * P_QP + (32 * ks + 8 * g4) * 2);
                        d = __builtin_amdgcn_mfma_f32_16x16x32_bf16(a, b, d, 0, 0, 0); }
                    u32x2 o; o.x = cvt_pk(d[0], d[1]); o.y = cvt_pk(d[2], d[3]);
                    *(u32x2*)(Og + (size_t)orow * 1024 + hd * 256 + dvs * 64 + 16 * c + 4 * g4) = o;
                }
            }
            { const int dbS = w & 3, dvb = w >> 2, hh = lane >> 5, blk = (lane >> 4) & 1, q4 = (lane & 15) >> 2, p4 = lane & 3;
#pragma unroll
              for (int g = 0; g < 4; ++g) { const f32x4 el = *(const LAS f32x4*)(I + O_EL + (32 * dbS + 8 * g + 4 * hh) * 4);
#pragma unroll
                  for (int i = 0; i < 4; ++i) S[4 * g + i] *= el[i]; }
#pragma unroll
              for (int ks = 0; ks < 4; ++ks) {
                  LAS unsigned char* pa = I + O_KPP + (16 * ks + 8 * hh + q4) * P_KPP + (32 * dbS + 16 * blk + 4 * p4) * 2;
                  LAS unsigned char* pb = I + O_V + (16 * ks + 8 * hh + q4) * P_V + (32 * dvb + 16 * blk + 4 * p4) * 2;
                  const bf16x8 a = gla::tr8(pa, pa + 4 * P_KPP);
                  const bf16x8 b = gla::tr8(pb, pb + 4 * P_V);
                  S = __builtin_amdgcn_mfma_f32_32x32x16_bf16(a, b, S, 0, 0, 0); }
#pragma unroll
              for (int g = 0; g < 4; ++g) { u32x2 o; o.x = cvt_pk(S[4 * g], S[4 * g + 1]); o.y = cvt_pk(S[4 * g + 2], S[4 * g + 3]);
                  *(LAS u32x2*)(L + O_ST + nx * ST_BYTES + (32 * dvb + (lane & 31)) * P_ST + (32 * dbS + 8 * g + 4 * hh) * 2) = o; } }
        }
    }
}

__device__ __forceinline__ void p_fft1(const Ctx& C) {
    PH_IDS;
    LAS unsigned char* L = C.lds;
    const int t = tid, w = wave, mb = w & 3, nh = w >> 2, hh = lane >> 5;
    const bf16* F1 = (const bf16*)(C.ws + WS_F1);
    bf16x8 af[8];
#pragma unroll
    for (int ks = 0; ks < 8; ++ks) af[ks] = *(const bf16x8*)(F1 + (32 * mb + (lane & 31)) * 128 + 16 * ks + 8 * hh);
    const bf16* ZZ = (const bf16*)(C.ws + WS_ZC);
    bf16* YR = (bf16*)(C.ws + WS_YR); bf16* YI = (bf16*)(C.ws + WS_YI);
    const int blk = (lane >> 4) & 1, q4 = (lane & 15) >> 2, p4 = lane & 3;
    constexpr int RAWB = 73728;
    u32x4 pv[4];
    auto fetch1 = [&](int unit) { const int bt = unit >> 8, b = (unit >> 1) & 127, chh = unit & 1; const int a = t >> 3, part = t & 7;
        const bf16* src = ZZ + (size_t)(bt * SEQ + 128 * a + b) * 512 + chh * 256 + part * 32;
#pragma unroll
        for (int i = 0; i < 4; ++i) pv[i] = *(const u32x4*)(src + 8 * i); };
    if ((int)blockIdx.x < 2048) fetch1(blockIdx.x);
    for (int unit = blockIdx.x; unit < 2048; unit += C.G) {
        const int bt = unit >> 8, b = (unit >> 1) & 127, chh = unit & 1;
        __syncthreads();
        { const int a = t >> 3, part = t & 7;
#pragma unroll
          for (int i = 0; i < 4; ++i) *(LAS u32x4*)(L + RAWB + a * 528 + part * 64 + i * 16) = pv[i]; }
        __syncthreads();
        { const int row = t >> 2, quarter = t & 3, pin = row >> 6, a = row & 63, gl = quarter >> 1, half = quarter & 1;
          const LAS unsigned char* rp = L + RAWB + a * 528 + gl * 256;
#pragma unroll
          for (int ci = 0; ci < 8; ++ci) { unsigned wv[4];
#pragma unroll
              for (int j = 0; j < 8; ++j) { const int e = 8 * ci + j;
                  const int col = pin ? (half ? 128 - e : 64 + e) : (half ? (e == 0 ? 64 : 64 - e) : e);
                  unsigned v = (unsigned)*(const LAS unsigned short*)(rp + (col & 127) * 2);
                  if (pin && half) v ^= 0x8000u;
                  if (pin && e == 0) v = 0u;
                  if (j & 1) wv[j >> 1] |= v << 16; else wv[j >> 1] = v; }
              *(LAS u32x4*)(L + row * 576 + quarter * 128 + ci * 16) = (u32x4){wv[0], wv[1], wv[2], wv[3]}; } }
        __syncthreads();
        if (unit + C.G < 2048) fetch1(unit + C.G);
#pragma unroll 1
        for (int nb = 0; nb < 4; ++nb) {
            const int c = 4 * nh + nb;
            f32x16 acc;
#pragma unroll
            for (int i = 0; i < 16; ++i) acc[i] = 0.f;
#pragma unroll
            for (int ks = 0; ks < 8; ++ks) {
                LAS unsigned char* pb = L + (16 * ks + 8 * hh + q4) * 576 + (32 * c + 16 * blk + 4 * p4) * 2;
                const bf16x8 bfr = gla::tr8(pb, pb + 4 * 576);
                acc = __builtin_amdgcn_mfma_f32_32x32x16_bf16(af[ks], bfr, acc, 0, 0, 0); }
#pragma unroll
            for (int gp = 0; gp < 2; ++gp)
#pragma unroll
                for (int i = 0; i < 4; ++i) { const int ap = 16 * mb + 8 * gp + 4 * hh + i; const float re = acc[8 * gp + i], im = acc[8 * gp + 4 + i];
                    const float ph = (float)((b * ap) & 8191) * (1.0f / 8192.0f); const float cs = __builtin_amdgcn_cosf(ph), sn = __builtin_amdgcn_sinf(ph);
                    const int so = ap * 528 + (32 * c + (lane & 31)) * 2;
                    *(LAS unsigned short*)(L + 73728 + so) = (unsigned short)f2bf(re * cs + im * sn);
                    *(LAS unsigned short*)(L + 73728 + 64 * 528 + so) = (unsigned short)f2bf(im * cs - re * sn); }
        }
        __syncthreads();
        { const int orow = t >> 2, quarter = t & 3, plane = orow >> 6, ap = orow & 63;
          bf16* dst = (plane ? YI : YR) + ((size_t)(bt * 64 + ap) * 128 + b) * 512 + chh * 256 + quarter * 64;
#pragma unroll
          for (int i = 0; i < 8; ++i) *(u32x4*)(dst + 8 * i) = *(const LAS u32x4*)(L + 73728 + orow * 528 + quarter * 128 + i * 16); }
    }
    __syncthreads();
}
__device__ __forceinline__ void p_fft2(const Ctx& C) {
    PH_IDS;
    LAS unsigned char* L = C.lds;
    const int t = tid, w = wave, mb = w & 3, nh = w >> 2, hh = lane >> 5;
    const bf16* F2 = (const bf16*)(C.ws + WS_F2);
    bf16x8 af[16];
#pragma unroll
    for (int ks = 0; ks < 16; ++ks) af[ks] = *(const bf16x8*)(F2 + (32 * mb + (lane & 31)) * 256 + 16 * ks + 8 * hh);
    const bf16* YR = (const bf16*)(C.ws + WS_YR); const bf16* YI = (const bf16*)(C.ws + WS_YI);
    unsigned char* A2 = (unsigned char*)(C.ws + WS_A2);
    const int blk = (lane >> 4) & 1, q4 = (lane & 15) >> 2, p4 = lane & 3;
    u32x4 pv[8];
    auto fetch2 = [&](int unit) { const int bt = unit >> 8, ap = (unit >> 2) & 63, cht = unit & 3; const int row = t >> 1, half = t & 1, pin = row >> 7, b = row & 127;
        const bf16* src = (pin ? YI : YR) + ((size_t)(bt * 64 + ap) * 128 + b) * 512 + cht * 128 + half * 64;
#pragma unroll
        for (int i = 0; i < 8; ++i) pv[i] = *(const u32x4*)(src + 8 * i); };
    if ((int)blockIdx.x < 2048) fetch2(blockIdx.x);
    for (int unit = blockIdx.x; unit < 2048; unit += C.G) {
        const int bt = unit >> 8, ap = (unit >> 2) & 63, cht = unit & 3;
        __syncthreads();
        { const int row = t >> 1, half = t & 1;
#pragma unroll
          for (int i = 0; i < 8; ++i) *(LAS u32x4*)(L + row * 320 + half * 128 + i * 16) = pv[i]; }
        __syncthreads();
        if (unit + C.G < 2048) fetch2(unit + C.G);
#pragma unroll 1
        for (int nb = 0; nb < 2; ++nb) {
            const int c = 2 * nh + nb;
            f32x16 acc;
#pragma unroll
            for (int i = 0; i < 16; ++i) acc[i] = 0.f;
#pragma unroll
            for (int ks = 0; ks < 16; ++ks) {
                LAS unsigned char* pb = L + (16 * ks + 8 * hh + q4) * 320 + (32 * c + 16 * blk + 4 * p4) * 2;
                const bf16x8 bfr = gla::tr8(pb, pb + 4 * 320);
                acc = __builtin_amdgcn_mfma_f32_32x32x16_bf16(af[ks], bfr, acc, 0, 0, 0); }
#pragma unroll
            for (int r = 0; r < 16; ++r) { const int bp = 32 * mb + (r & 3) + 8 * (r >> 2) + 4 * hh;
                if (F8_OUT0) *(LAS unsigned char*)(L + 81920 + bp * 144 + 32 * c + (lane & 31)) = (unsigned char)(pk4_fp8(acc[r], 0.f, 0.f, 0.f, 8.0f / 1024.0f) & 0xffu);
                else *(LAS unsigned short*)(L + 81920 + bp * 272 + (32 * c + (lane & 31)) * 2) = (unsigned short)f2bf(acc[r] * (1.0f / 1024.0f)); }
        }
        __syncthreads();
        { const int bp = t >> 2, quarter = t & 3; const size_t tok = (size_t)bt * SEQ + ap + 64 * bp;
          if (F8_OUT0) { unsigned char* dst = A2 + tok * 1536 + 1024 + cht * 128 + quarter * 32;
#pragma unroll
              for (int i = 0; i < 2; ++i) *(u32x4*)(dst + 16 * i) = *(const LAS u32x4*)(L + 81920 + bp * 144 + quarter * 32 + i * 16); }
          else { bf16* dst = (bf16*)A2 + tok * 1536 + 1024 + cht * 128 + quarter * 32;
#pragma unroll
              for (int i = 0; i < 4; ++i) *(u32x4*)(dst + 8 * i) = *(const LAS u32x4*)(L + 81920 + bp * 272 + quarter * 64 + i * 16); } }
    }
    __syncthreads();
}
__device__ __forceinline__ void p_gla_out(const Ctx& C) {
    PH_IDS;
    const int gw = blockIdx.x * 8 + wave, NGW = C.G * 8;
    const bf16* OF = (const bf16*)(C.ws + WS_OF); const bf16* OB = (const bf16*)(C.ws + WS_OB); const bf16* Rg = (const bf16*)(C.ws + WS_R);
    unsigned char* A2 = (unsigned char*)(C.ws + WS_A2);
    float gn[16];
#pragma unroll
    for (int i = 0; i < 16; ++i) gn[i] = C.a->in[IN_EVGNORM][16 * (lane & 15) + i];
    for (int r = gw; r < MTOK; r += NGW) {
        const u32x4 f0 = *(const u32x4*)(OF + (size_t)r * 1024 + 16 * lane), f1 = *(const u32x4*)(OF + (size_t)r * 1024 + 16 * lane + 8);
        const u32x4 b0 = *(const u32x4*)(OB + (size_t)r * 1024 + 16 * lane), b1 = *(const u32x4*)(OB + (size_t)r * 1024 + 16 * lane + 8);
        const u32x4 g0 = *(const u32x4*)(Rg + (size_t)r * 1024 + 16 * lane), g1 = *(const u32x4*)(Rg + (size_t)r * 1024 + 16 * lane + 8);
        float o[16], rr[16];
#pragma unroll
        for (int i = 0; i < 4; ++i) { const unsigned fa = f0[i], fb = f1[i], ba = b0[i], bb = b1[i], ga = g0[i], gb = g1[i];
            o[2 * i] = bf_lo(fa) + bf_lo(ba); o[2 * i + 1] = bf_hi(fa) + bf_hi(ba); o[8 + 2 * i] = bf_lo(fb) + bf_lo(bb); o[8 + 2 * i + 1] = bf_hi(fb) + bf_hi(bb);
            rr[2 * i] = bf_lo(ga); rr[2 * i + 1] = bf_hi(ga); rr[8 + 2 * i] = bf_lo(gb); rr[8 + 2 * i + 1] = bf_hi(gb); }
        float ss = 0.f;
#pragma unroll
        for (int i = 0; i < 16; ++i) ss += o[i] * o[i];
        ss = row16_sum(ss);
        const float rstd = rsqrtf(ss * (1.0f / 256.0f) + EPS);
        float y[16];
#pragma unroll
        for (int i = 0; i < 16; ++i) y[i] = o[i] * rstd * gn[i] * siluf_(rr[i]);
        if (F8_OUT0) *(u32x4*)(A2 + (size_t)r * 1536 + 16 * lane) = (u32x4){pk4_fp8(y[0], y[1], y[2], y[3], 8.f), pk4_fp8(y[4], y[5], y[6], y[7], 8.f), pk4_fp8(y[8], y[9], y[10], y[11], 8.f), pk4_fp8(y[12], y[13], y[14], y[15], 8.f)};
        else { bf16* a2 = (bf16*)A2 + (size_t)r * 1536 + 16 * lane;
            *(u32x4*)a2 = (u32x4){cvt_pk(y[0], y[1]), cvt_pk(y[2], y[3]), cvt_pk(y[4], y[5]), cvt_pk(y[6], y[7])}; *(u32x4*)(a2 + 8) = (u32x4){cvt_pk(y[8], y[9]), cvt_pk(y[10], y[11]), cvt_pk(y[12], y[13]), cvt_pk(y[14], y[15])}; }
    }
}

__device__ __forceinline__ void p_postmix(const Ctx& C, const int layer) {
    PH_IDS;
    LAS float* WR = (LAS float*)C.lds;
    LAS int* hist = (LAS int*)(C.lds + 131072);
    LAS float* Lg = (LAS float*)(C.lds + 131584 + wave * 2112);
    const float* rw = C.a->in[IN_RW] + (size_t)layer * 1024 * 32;
    __syncthreads();
    for (int it0 = 0; it0 < 64; it0 += 16) {
        float tmpw[16];
#pragma unroll
        for (int q = 0; q < 16; ++q) tmpw[q] = rw[tid + 512 * (it0 + q)];
#pragma unroll
        for (int q = 0; q < 16; ++q) { const int idx = tid + 512 * (it0 + q); const int c = idx >> 5, e = idx & 31; const int ln = (c & 255) >> 2, j = c >> 8, i = c & 3;
            WR[(((j * 4 + i) * 8 + (e >> 2)) * 64 + ln) * 4 + (e & 3)] = tmpw[q]; } }
    if (tid < 32) hist[tid] = 0;
    __syncthreads();
    const float* MOD = (const float*)(C.ws + WS_MOD) + (size_t)layer * 9 * 6144;
    const float* gpost = C.a->in[IN_NMPOST] + layer * 1024; const float* gffn = C.a->in[IN_NFPRE] + layer * 1024;
    const bf16* Y = (const bf16*)(C.ws + WS_Y);
    const float* xin = C.a->in[IN_X];
    bf16* XS = (bf16*)(C.ws + WS_XS);
    unsigned char* H2 = (unsigned char*)(C.ws + WS_H2);
    int* TK = (int*)(C.ws + WS_TOPK); float* GT = (float*)(C.ws + WS_GATE);
    const int rows_per_blk = MTOK / C.G, rows_per_wave = rows_per_blk / 8;
    const int r0 = blockIdx.x * rows_per_blk + wave * rows_per_wave;
    const int b = r0 >> 13;
    const float rbias = C.a->in[IN_RB][layer * 32 + ((lane >> 1) & 31)];
    float cA1[16], cA2[16], cB2[16];
#pragma unroll
    for (int j = 0; j < 4; ++j) { const int c = 4 * lane + 256 * j;
        const f32x4 gp = *(const f32x4*)(gpost + c), gm = *(const f32x4*)(MOD + (size_t)b * 6144 + 2048 + c);
        const f32x4 gf = *(const f32x4*)(gffn + c), sc = *(const f32x4*)(MOD + (size_t)b * 6144 + 4096 + c), sh = *(const f32x4*)(MOD + (size_t)b * 6144 + 3072 + c);
#pragma unroll
        for (int i = 0; i < 4; ++i) { cA1[4 * j + i] = gp[i] * gm[i]; cA2[4 * j + i] = gf[i] * (1.0f + sc[i]); cB2[4 * j + i] = sh[i]; } }
    auto ldx = [&](int r, int j) -> f32x4 {
        if (layer == 0) return *(const f32x4*)(xin + (size_t)r * 1024 + 4 * lane + 256 * j);
        const u32x2 v = *(const u32x2*)(XS + (size_t)r * 1024 + 4 * lane + 256 * j); return (f32x4){bf_lo(v.x), bf_hi(v.x), bf_lo(v.y), bf_hi(v.y)}; };
    u32x2 ny[4]; f32x4 nx[4];
#pragma unroll
    for (int j = 0; j < 4; ++j) { ny[j] = *(const u32x2*)(Y + (size_t)r0 * 1024 + 4 * lane + 256 * j); nx[j] = ldx(r0, j); }
    for (int r = r0; r < r0 + rows_per_wave; ++r) {
        float h[16];
        u32x2 cy[4]; f32x4 cx[4];
#pragma unroll
        for (int j = 0; j < 4; ++j) { cy[j] = ny[j]; cx[j] = nx[j]; }
        if (r + 1 < r0 + rows_per_wave) {
#pragma unroll
            for (int j = 0; j < 4; ++j) { ny[j] = *(const u32x2*)(Y + (size_t)(r + 1) * 1024 + 4 * lane + 256 * j); nx[j] = ldx(r + 1, j); } }
        { float ssy = 0.f; float yv[16];
#pragma unroll
          for (int j = 0; j < 4; ++j) { const u32x2 yy = cy[j];
              yv[4 * j] = bf_lo(yy.x); yv[4 * j + 1] = bf_hi(yy.x); yv[4 * j + 2] = bf_lo(yy.y); yv[4 * j + 3] = bf_hi(yy.y); }
#pragma unroll
          for (int i = 0; i < 16; ++i) ssy += yv[i] * yv[i];
          const float rstd = rsqrtf(wave_sum(ssy) * (1.0f / 1024.0f) + EPS);
          float ss1 = 0.f;
#pragma unroll
          for (int j = 0; j < 4; ++j) { const int c = 4 * lane + 256 * j;
              const f32x4 xv = cx[j];
              f32x4 o;
#pragma unroll
              for (int i = 0; i < 4; ++i) { o[i] = xv[i] + cA1[4 * j + i] * (yv[4 * j + i] * rstd); h[4 * j + i] = o[i]; ss1 += o[i] * o[i]; }
              { u32x2 xw; xw.x = cvt_pk(o[0], o[1]); xw.y = cvt_pk(o[2], o[3]); *(u32x2*)(XS + (size_t)r * 1024 + c) = xw; } }
          const float rstd1 = rsqrtf(wave_sum(ss1) * (1.0f / 1024.0f) + EPS);
#pragma unroll
          for (int j = 0; j < 4; ++j) { const int c = 4 * lane + 256 * j;
#pragma unroll
              for (int i = 0; i < 4; ++i) h[4 * j + i] = h[4 * j + i] * rstd1 * cA2[4 * j + i] + cB2[4 * j + i];
              int wv = 0;
              wv = __builtin_amdgcn_cvt_pk_fp8_f32(fminf(fmaxf(h[4 * j] * 8.0f, -440.f), 440.f), fminf(fmaxf(h[4 * j + 1] * 8.0f, -440.f), 440.f), wv, false);
              wv = __builtin_amdgcn_cvt_pk_fp8_f32(fminf(fmaxf(h[4 * j + 2] * 8.0f, -440.f), 440.f), fminf(fmaxf(h[4 * j + 3] * 8.0f, -440.f), 440.f), wv, true);
              *(int*)(H2 + (size_t)r * 1024 + c) = wv; } }
        float p[32];
#pragma unroll
        for (int e = 0; e < 32; ++e) p[e] = 0.f;
        { f32x4 wb[2][8];
#pragma unroll
          for (int eq = 0; eq < 8; ++eq) wb[0][eq] = *(const LAS f32x4*)(WR + ((0 * 8 + eq) * 64 + lane) * 4);
#pragma unroll
          for (int jj = 0; jj < 16; ++jj) {
              if (jj + 1 < 16) {
#pragma unroll
                  for (int eq = 0; eq < 8; ++eq) wb[(jj + 1) & 1][eq] = *(const LAS f32x4*)(WR + (((jj + 1) * 8 + eq) * 64 + lane) * 4); }
#pragma unroll
              for (int eq = 0; eq < 8; ++eq)
#pragma unroll
                  for (int i = 0; i < 4; ++i) p[4 * eq + i] += h[jj] * wb[jj & 1][eq][i];
              asm volatile("" ::: "memory"); } }
        float q16[16], q8[8], q4v[4], q2[2], q1;
#pragma unroll
        for (int k = 0; k < 16; ++k) q16[k] = swap32_sum(p[k], p[16 + k]);
#pragma unroll
        for (int k = 0; k < 8; ++k) q8[k] = swap16_sum(q16[k], q16[8 + k]);
        { const bool hi = (lane & 8) != 0;
#pragma unroll
          for (int k = 0; k < 4; ++k) { const float send = hi ? q8[k] : q8[4 + k], keep = hi ? q8[4 + k] : q8[k];
              q4v[k] = keep + __builtin_bit_cast(float, __builtin_amdgcn_update_dpp(0, __builtin_bit_cast(int, send), 0x128, 0xF, 0xF, true)); } }
        { const bool hi = (lane & 4) != 0;
#pragma unroll
          for (int k = 0; k < 2; ++k) { const float send = hi ? q4v[k] : q4v[2 + k], keep = hi ? q4v[2 + k] : q4v[k];
              int rv = __builtin_amdgcn_update_dpp(0, __builtin_bit_cast(int, send), 0x104, 0xF, 0x5, false);
              rv = __builtin_amdgcn_update_dpp(rv, __builtin_bit_cast(int, send), 0x114, 0xF, 0xA, false);
              q2[k] = keep + __builtin_bit_cast(float, rv); } }
        { const bool hi = (lane & 2) != 0; const float send = hi ? q2[0] : q2[1], keep = hi ? q2[1] : q2[0];
          q1 = keep + __builtin_bit_cast(float, __builtin_amdgcn_update_dpp(0, __builtin_bit_cast(int, send), 0x4E, 0xF, 0xF, true)); }
        q1 += __builtin_bit_cast(float, __builtin_amdgcn_update_dpp(0, __builtin_bit_cast(int, q1), 0xB1, 0xF, 0xF, true));
        const int rl = (r - r0) & 15;
        if (!(lane & 1)) Lg[rl * 33 + (lane >> 1)] = q1 + rbias;
        if (rl == 15) {
            asm volatile("s_waitcnt lgkmcnt(0)" ::: "memory");
            if (lane < 16) {
                float v0 = -3.0e38f, v1 = -3.0e38f, v2 = -3.0e38f, v3 = -3.0e38f; int i0 = 0, i1 = 0, i2 = 0, i3 = 0;
#pragma unroll
                for (int e = 0; e < 32; ++e) { const float x = Lg[lane * 33 + e];
                    const bool c0 = x > v0, c1 = x > v1, c2 = x > v2, c3 = x > v3;
                    v3 = c3 ? (c2 ? v2 : x) : v3; i3 = c3 ? (c2 ? i2 : e) : i3;
                    v2 = c2 ? (c1 ? v1 : x) : v2; i2 = c2 ? (c1 ? i1 : e) : i2;
                    v1 = c1 ? (c0 ? v0 : x) : v1; i1 = c1 ? (c0 ? i0 : e) : i1;
                    v0 = c0 ? x : v0; i0 = c0 ? e : i0; }
                const float e1 = __expf(v1 - v0), e2 = __expf(v2 - v0), e3 = __expf(v3 - v0); const float inv = 1.0f / (1.0f + e1 + e2 + e3);
                const int rr = r - 15 + lane;
                *(int4*)(TK + (size_t)rr * 4) = make_int4(i0, i1, i2, i3); *(f32x4*)(GT + (size_t)rr * 4) = (f32x4){inv, e1 * inv, e2 * inv, e3 * inv};
                __hip_atomic_fetch_add(&hist[i0], 1, __ATOMIC_RELAXED, __HIP_MEMORY_SCOPE_WORKGROUP); __hip_atomic_fetch_add(&hist[i1], 1, __ATOMIC_RELAXED, __HIP_MEMORY_SCOPE_WORKGROUP);
                __hip_atomic_fetch_add(&hist[i2], 1, __ATOMIC_RELAXED, __HIP_MEMORY_SCOPE_WORKGROUP); __hip_atomic_fetch_add(&hist[i3], 1, __ATOMIC_RELAXED, __HIP_MEMORY_SCOPE_WORKGROUP);
            }
            asm volatile("s_waitcnt lgkmcnt(0)" ::: "memory");
        }
    }
    __syncthreads();
    if (tid < 32) ((int*)(C.ws + WS_CNTBLK))[blockIdx.x * 32 + tid] = hist[tid];
    __syncthreads();
}
__device__ __forceinline__ void p_assign(const Ctx& C) {
    PH_IDS;
    LAS int* red = (LAS int*)C.lds;
    LAS int* base = (LAS int*)(C.lds + 4096);
    LAS int* total = (LAS int*)(C.lds + 4224);
    LAS int* segrow = (LAS int*)(C.lds + 4352);
    LAS int* run = (LAS int*)(C.lds + 4608);
    const int* cnt = (const int*)(C.ws + WS_CNTBLK);
    const int b = blockIdx.x;
    __syncthreads();
    { const int e = tid & 31, part = tid >> 5; int slt = 0, sall = 0;
      int vv[16];
#pragma unroll
      for (int q = 0; q < 16; ++q) vv[q] = __hip_atomic_load(cnt + (part * 16 + q) * 32 + e, __ATOMIC_RELAXED, __HIP_MEMORY_SCOPE_AGENT);
#pragma unroll
      for (int q = 0; q < 16; ++q) { sall += vv[q]; if (part * 16 + q < b) slt += vv[q]; }
      red[part * 32 + e] = slt; red[512 + part * 32 + e] = sall; }
    __syncthreads();
    if (tid < 32) { int s0 = 0, s1 = 0;
#pragma unroll
        for (int q = 0; q < 16; ++q) { s0 += red[q * 32 + tid]; s1 += red[512 + q * 32 + tid]; }
        base[tid] = s0; total[tid] = s1; run[tid] = 0; }
    __syncthreads();
    if (tid == 0) { int acc = 0; for (int e = 0; e < 32; ++e) { segrow[e] = acc * 256; if (b == 0) ((int*)(C.ws + WS_MOEINFO))[e] = acc; acc += (total[e] + 255) >> 8; } segrow[32] = acc * 256; if (b == 0) ((int*)(C.ws + WS_MOEINFO))[32] = acc; }
    __syncthreads();
    int* SP = (int*)(C.ws + WS_SLOTPOS); int* ST = (int*)(C.ws + WS_SLOTTOK); const int* TK = (const int*)(C.ws + WS_TOPK);
    const int rows_per_blk = MTOK / C.G;
    LAS int* gc = (LAS int*)(C.lds + 5120);
    int ge[2], grk[2], grow[2];
#pragma unroll
    for (int q = 0; q < 2; ++q) {
        const int g = 2 * wave + q, sidx = g * 64 + lane; grow[q] = b * rows_per_blk + (sidx >> 2);
        ge[q] = TK[(size_t)grow[q] * 4 + (sidx & 3)];
        int rk = 0, myc = 0;
        for (int ee = 0; ee < 32; ++ee) { const unsigned long long m = __ballot(ge[q] == ee);
            if (ge[q] == ee) rk = __popcll(m & ((1ull << lane) - 1ull));
            if (lane == ee) myc = __popcll(m); }
        grk[q] = rk;
        if (lane < 32) gc[g * 32 + lane] = myc;
    }
    __syncthreads();
#pragma unroll
    for (int q = 0; q < 2; ++q) {
        const int g = 2 * wave + q, sidx = g * 64 + lane; int off = 0;
        for (int gp = 0; gp < g; ++gp) off += gc[gp * 32 + ge[q]];
        const int pos = segrow[ge[q]] + base[ge[q]] + off + grk[q];
        SP[(size_t)grow[q] * 4 + (sidx & 3)] = pos; ST[pos] = grow[q];
    }
    if (b < 32) { const int e = b, tot = total[e], first = segrow[e] + tot, last = segrow[e + 1];
        for (int p = first + tid; p < last; p += 512) ST[p] = 0; }
    __syncthreads();
}

__device__ __forceinline__ void p_combine(const Ctx& C, const int layer) {
    PH_IDS;
    const int gw = blockIdx.x * 8 + wave, NGW = C.G * 8;
    const int per = MTOK / NGW;
    const float* MOD = (const float*)(C.ws + WS_MOD) + (size_t)layer * 9 * 6144;
    const float* MODN = (const float*)(C.ws + WS_MOD) + (size_t)9 * 6144;
    const float* gpost = C.a->in[IN_NFPOST] + layer * 1024; const float* gpre1 = C.a->in[IN_NMPRE] + 1024;
    const unsigned char* YS = (const unsigned char*)(C.ws + WS_YSLOT); const int* SP = (const int*)(C.ws + WS_SLOTPOS); const float* GT = (const float*)(C.ws + WS_GATE);
    float* OUT = C.a->out; bf16* XS = (bf16*)(C.ws + WS_XS); unsigned char* HN = (unsigned char*)(C.ws + WS_HN);
    int curb = -1; float cA1[16], cA2[16], cB2[16]; const int vz = vzero();
    const int rbeg = gw * per, rend = gw * per + per;
    int4 npos = *(const int4*)(SP + (size_t)(rbeg + vz) * 4); f32x4 ngt = *(const f32x4*)(GT + (size_t)(rbeg + vz) * 4);
    unsigned nys[4][4]; u32x2 nxv[4]; f32x4 cgt = ngt;
    { const int pp[4] = {npos.x, npos.y, npos.z, npos.w};
#pragma unroll
      for (int k = 0; k < 4; ++k)
#pragma unroll
          for (int j = 0; j < 4; ++j) nys[k][j] = *(const unsigned*)(YS + (size_t)pp[k] * 1024 + 4 * lane + 256 * j);
#pragma unroll
      for (int j = 0; j < 4; ++j) nxv[j] = *(const u32x2*)(XS + (size_t)rbeg * 1024 + 4 * lane + 256 * j); }
    if (rbeg + 1 < rend) { npos = *(const int4*)(SP + (size_t)(rbeg + 1 + vz) * 4); ngt = *(const f32x4*)(GT + (size_t)(rbeg + 1 + vz) * 4); }
    for (int r = rbeg; r < rend; ++r) {
        const int b = r >> 13;
        if (b != curb) { curb = b;
#pragma unroll
            for (int j = 0; j < 4; ++j) { const int c = 4 * lane + 256 * j;
                const f32x4 gp = *(const f32x4*)(gpost + c), gf = *(const f32x4*)(MOD + (size_t)b * 6144 + 5120 + c);
                const f32x4 gg = *(const f32x4*)(gpre1 + c), sc = *(const f32x4*)(MODN + (size_t)b * 6144 + 1024 + c), sh = *(const f32x4*)(MODN + (size_t)b * 6144 + c);
#pragma unroll
                for (int i = 0; i < 4; ++i) { cA1[4 * j + i] = gp[i] * gf[i]; cA2[4 * j + i] = gg[i] * (1.0f + sc[i]); cB2[4 * j + i] = sh[i]; } } }
        unsigned ys[4][4]; u32x2 xc[4]; const f32x4 gt = cgt;
#pragma unroll
        for (int k = 0; k < 4; ++k)
#pragma unroll
            for (int j = 0; j < 4; ++j) ys[k][j] = nys[k][j];
#pragma unroll
        for (int j = 0; j < 4; ++j) xc[j] = nxv[j];
        if (r + 1 < rend) {
            const int pp[4] = {npos.x, npos.y, npos.z, npos.w}; cgt = ngt;
#pragma unroll
            for (int k = 0; k < 4; ++k)
#pragma unroll
                for (int j = 0; j < 4; ++j) nys[k][j] = *(const unsigned*)(YS + (size_t)pp[k] * 1024 + 4 * lane + 256 * j);
#pragma unroll
            for (int j = 0; j < 4; ++j) nxv[j] = *(const u32x2*)(XS + (size_t)(r + 1) * 1024 + 4 * lane + 256 * j);
            if (r + 2 < rend) { npos = *(const int4*)(SP + (size_t)(r + 2 + vz) * 4); ngt = *(const f32x4*)(GT + (size_t)(r + 2 + vz) * 4); } }
        float f[16];
#pragma unroll
        for (int i = 0; i < 16; ++i) f[i] = 0.f;
#pragma unroll
        for (int k = 0; k < 4; ++k) { const float gk = gt[k] * 0.0625f;
#pragma unroll
            for (int j = 0; j < 4; ++j) { const f32v2_t lo = __builtin_amdgcn_cvt_pk_f32_fp8((int)ys[k][j], false), hi = __builtin_amdgcn_cvt_pk_f32_fp8((int)ys[k][j], true);
                f[4 * j] += gk * lo[0]; f[4 * j + 1] += gk * lo[1]; f[4 * j + 2] += gk * hi[0]; f[4 * j + 3] += gk * hi[1]; } }
        float ss = 0.f;
#pragma unroll
        for (int i = 0; i < 16; ++i) ss += f[i] * f[i];
        const float rstd = rsqrtf(wave_sum(ss) * (1.0f / 1024.0f) + EPS);
        float x2[16]; float ss2 = 0.f;
#pragma unroll
        for (int j = 0; j < 4; ++j) { const int c = 4 * lane + 256 * j;
            const f32x4 xv = (f32x4){bf_lo(xc[j].x), bf_hi(xc[j].x), bf_lo(xc[j].y), bf_hi(xc[j].y)};
            f32x4 o;
#pragma unroll
            for (int i = 0; i < 4; ++i) { o[i] = xv[i] + cA1[4 * j + i] * (f[4 * j + i] * rstd); x2[4 * j + i] = o[i]; ss2 += o[i] * o[i]; }
            if (layer == 0) { u32x2 xw; xw.x = cvt_pk(o[0], o[1]); xw.y = cvt_pk(o[2], o[3]); *(u32x2*)(XS + (size_t)r * 1024 + c) = xw; }
            else *(f32x4*)(OUT + (size_t)r * 1024 + c) = o; }
        if (layer == 0) {
            const float rstd2 = rsqrtf(wave_sum(ss2) * (1.0f / 1024.0f) + EPS);
#pragma unroll
            for (int j = 0; j < 4; ++j) { const int c = 4 * lane + 256 * j;
                float hv[4];
#pragma unroll
                for (int i = 0; i < 4; ++i) hv[i] = x2[4 * j + i] * rstd2 * cA2[4 * j + i] + cB2[4 * j + i];
                if (F8_IN1) *(unsigned*)(HN + (size_t)r * 1024 + c) = pk4_fp8(hv[0], hv[1], hv[2], hv[3], 8.f);
                else *(u32x2*)((bf16*)HN + (size_t)r * 1024 + c) = (u32x2){cvt_pk(hv[0], hv[1]), cvt_pk(hv[2], hv[3])}; }
        }
    }
}

__device__ __forceinline__ void p_conv(const Ctx& C) {
    PH_IDS;
    LAS unsigned char* L = C.lds;
    constexpr int O_X = 0;
    constexpr int O_W = 63488;
    const int w = wave;
    const bf16* GLU = (const bf16*)(C.ws + WS_GLU); const bf16* ZC1 = (const bf16*)(C.ws + WS_ZC1); const bf16* GB = (const bf16*)(C.ws + WS_GB);
    unsigned char* A2 = (unsigned char*)(C.ws + WS_A2B);
    __syncthreads();
    { float tmpw[31];
#pragma unroll
      for (int q = 0; q < 31; ++q) tmpw[q] = C.a->in[IN_ODDW][tid + 512 * q];
#pragma unroll
      for (int q = 0; q < 31; ++q) { const int i = tid + 512 * q; const int tap = i >> 9, c = i & 511; const int ln = c >> 3, half = (c >> 2) & 1, qq = c & 3;
          *(LAS float*)(L + O_W + (((tap * 2 + half) * 64 + ln) * 4 + qq) * 4) = tmpw[q]; } }
    float cb[8], lg[8], lb[8], sw0[8], sw1[8], sw2[8];
#pragma unroll
    for (int i = 0; i < 8; ++i) { const int c = 8 * lane + i; cb[i] = C.a->in[IN_ODDWB][c]; lg[i] = C.a->in[IN_ODLNG][c]; lb[i] = C.a->in[IN_ODLNB][c];
        sw0[i] = C.a->in[IN_ODSCONV][c]; sw1[i] = C.a->in[IN_ODSCONV][512 + c]; sw2[i] = C.a->in[IN_ODSCONV][1024 + c]; }
    u32x4 px[8];
    auto fetchx = [&](int unit) { const int bt = unit >> 8, t0 = (unit & 255) * 32;
#pragma unroll
        for (int q = 0; q < 8; ++q) { const int i = tid + 512 * q; const int rr = i >> 6, cc = i & 63; const int tl = t0 - 15 + rr;
            px[q] = (u32x4){0u, 0u, 0u, 0u};
            if (i < 62 * 64 && tl >= 0 && tl < SEQ) px[q] = *(const u32x4*)(GLU + (size_t)(bt * SEQ + tl) * 512 + cc * 8); } };
    if ((int)blockIdx.x < 2048) fetchx(blockIdx.x);
    for (int unit = blockIdx.x; unit < 2048; unit += C.G) {
        const int bt = unit >> 8, t0 = (unit & 255) * 32;
        __syncthreads();
#pragma unroll
        for (int q = 0; q < 8; ++q) { const int i = tid + 512 * q; if (i < 62 * 64) *(LAS u32x4*)(L + O_X + (i >> 6) * 1024 + (i & 63) * 16) = px[q]; }
        __syncthreads();
        if (unit + C.G < 2048) fetchx(unit + C.G);
        float acc[4][8];
#pragma unroll
        for (int o = 0; o < 4; ++o)
#pragma unroll
            for (int i = 0; i < 8; ++i) acc[o][i] = 0.f;
#pragma unroll 4
        for (int tap = 0; tap < 31; ++tap) {
            const f32x4 w0 = *(const LAS f32x4*)(L + O_W + ((tap * 2 + 0) * 64 + lane) * 16), w1 = *(const LAS f32x4*)(L + O_W + ((tap * 2 + 1) * 64 + lane) * 16);
#pragma unroll
            for (int o = 0; o < 4; ++o) {
                const u32x4 xr = *(const LAS u32x4*)(L + O_X + (4 * w + o + tap) * 1024 + lane * 16);
                acc[o][0] += bf_lo(xr[0]) * w0[0]; acc[o][1] += bf_hi(xr[0]) * w0[1]; acc[o][2] += bf_lo(xr[1]) * w0[2]; acc[o][3] += bf_hi(xr[1]) * w0[3];
                acc[o][4] += bf_lo(xr[2]) * w1[0]; acc[o][5] += bf_hi(xr[2]) * w1[1]; acc[o][6] += bf_lo(xr[3]) * w1[2]; acc[o][7] += bf_hi(xr[3]) * w1[3]; }
        }
        u32x4 sz0[4], sz1[4], sz2[4], sgb[4];
#pragma unroll
        for (int o = 0; o < 4; ++o) { const int tl = t0 + 4 * w + o; const size_t tok = (size_t)bt * SEQ + tl;
            sz1[o] = *(const u32x4*)(ZC1 + tok * 512 + 8 * lane); sz0[o] = (u32x4){0u, 0u, 0u, 0u}; sz2[o] = (u32x4){0u, 0u, 0u, 0u};
            if (tl >= 64) sz0[o] = *(const u32x4*)(ZC1 + (tok - 64) * 512 + 8 * lane);
            if (tl + 64 < SEQ) sz2[o] = *(const u32x4*)(ZC1 + (tok + 64) * 512 + 8 * lane);
            sgb[o] = *(const u32x4*)(GB + tok * 512 + 8 * lane); }
#pragma unroll
        for (int o = 0; o < 4; ++o) {
            const int tl = t0 + 4 * w + o; const size_t tok = (size_t)bt * SEQ + tl;
            float v[8]; float s = 0.f;
#pragma unroll
            for (int i = 0; i < 8; ++i) { v[i] = acc[o][i] + cb[i]; s += v[i]; }
            const float mu = wave_sum(s) * (1.0f / 512.0f); float q = 0.f;
#pragma unroll
            for (int i = 0; i < 8; ++i) { v[i] -= mu; q += v[i] * v[i]; }
            const float rstd = rsqrtf(wave_sum(q) * (1.0f / 512.0f) + EPS);
            float y[8];
#pragma unroll
            for (int i = 0; i < 8; ++i) y[i] = siluf_(v[i] * rstd * lg[i] + lb[i]);
            if (F8_OUT1) *(u32x2*)(A2 + tok * 1024 + 8 * lane) = (u32x2){pk4_fp8(y[0], y[1], y[2], y[3], 4.f), pk4_fp8(y[4], y[5], y[6], y[7], 4.f)};
            else *(u32x4*)((bf16*)A2 + tok * 1024 + 8 * lane) = (u32x4){cvt_pk(y[0], y[1]), cvt_pk(y[2], y[3]), cvt_pk(y[4], y[5]), cvt_pk(y[6], y[7])};
            const u32x4 z1 = sz1[o], z0 = sz0[o], z2 = sz2[o], gb = sgb[o];
            float zz[8];
#pragma unroll
            for (int i = 0; i < 4; ++i) {
                zz[2 * i] = (sw0[2 * i] * bf_lo(z0[i]) + sw1[2 * i] * bf_lo(z1[i]) + sw2[2 * i] * bf_lo(z2[i])) * bf_lo(gb[i]);
                zz[2 * i + 1] = (sw0[2 * i + 1] * bf_hi(z0[i]) + sw1[2 * i + 1] * bf_hi(z1[i]) + sw2[2 * i + 1] * bf_hi(z2[i])) * bf_hi(gb[i]); }
            if (F8_OUT1) *(u32x2*)(A2 + tok * 1024 + 512 + 8 * lane) = (u32x2){pk4_fp8(zz[0], zz[1], zz[2], zz[3], 4.f), pk4_fp8(zz[4], zz[5], zz[6], zz[7], 4.f)};
            else *(u32x4*)((bf16*)A2 + tok * 1024 + 512 + 8 * lane) = (u32x4){cvt_pk(zz[0], zz[1]), cvt_pk(zz[2], zz[3]), cvt_pk(zz[4], zz[5]), cvt_pk(zz[6], zz[7])};
        }
    }
    __syncthreads();
}

constexpr int NPHASE = 19;
#ifndef RUN_HI
#define RUN_HI NPHASE
#endif
__global__ void __launch_bounds__(512, 2) fwd_kernel(Args args) {
    extern __shared__ __attribute__((aligned(16))) unsigned char lds_raw[];
    Ctx C; C.lds = (LAS unsigned char*)lds_raw;
    C.G = gridDim.x; C.a = &args; C.ws = args.ws;
    volatile LAS unsigned* MISC = (volatile LAS unsigned*)(C.lds + MISC_OFF);
    if (threadIdx.x < 16) MISC[threadIdx.x] = 0u;
    __syncthreads();
    const int lo = args.ph_lo, hi = args.ph_hi;
    const bool multi = (hi - lo) > 1;
    XcdBarrier bar; bar.bar = (unsigned*)(C.ws + WS_CTL) + 4096; bar.x = 0; bar.st = MISC;
    if (multi) bar = xcd_barrier_post((unsigned*)(C.ws + WS_CTL) + 4096, MISC);
#ifndef PH_MASK
#define PH_MASK 0x7FFFF
#endif
#define IN(k) (((PH_MASK >> (k)) & 1) && lo <= (k) && (k) < hi)
#ifndef DUP_MASK
#define DUP_MASK 0
#endif
#ifndef GLA_PROBE
#define GLA_PROBE 0
#endif
#ifndef PROBE_NOEPI
#define PROBE_NOEPI 0
#endif
#define DUPN(k) (((DUP_MASK >> (k)) & 1) ? 2 : 1)
#define SEAM(k) do { if (IN(k) && IN((k) + 1)) xcd_barrier(bar); } while (0)
    LAS unsigned char* ring = C.lds;
    const int cid = blockIdx.x;

    if (IN(0)) for (int rep_ = 0; rep_ < DUPN(0); ++rep_) { p0_adaln(C); p0_fourier_fold(C); p0_convert(C); } SEAM(0);
    if (IN(1)) for (int rep_ = 0; rep_ < DUPN(1); ++rep_) { p_norm0(C); } SEAM(1);
    if (IN(2)) for (int rep_ = 0; rep_ < DUPN(2); ++rep_) { gm::SchedIn0 S{(const char*)(C.ws + WS_HN), (const char*)(C.ws + WS_WIN0), C.G, cid}; gm::EpiIn0 E{C.ws}; gm::gemm_phase<F8_IN0 != 0>(ring, F8_IN0 ? 1024 : 2048, S, E, 0x7C7C7C7C, 0x7A7A7A7A); } SEAM(2);
    if (IN(3)) for (int rep_ = 0; rep_ < DUPN(3); ++rep_) { p_gla_prep(C); if (GLA_PROBE == 1) p_gla_prep(C); if (GLA_PROBE >= 10) p_gla_prep(C, GLA_PROBE - 10); p_fft1(C); if (GLA_PROBE == 2) p_fft1(C); xcd_barrier(bar); p_gla(C); if (GLA_PROBE == 3) p_gla(C); if (GLA_PROBE == 4) p_gla(C, 1); } SEAM(3);
    if (IN(4)) for (int rep_ = 0; rep_ < DUPN(4); ++rep_) { p_fft2(C); p_gla_out(C); } SEAM(4);
    if (IN(5)) for (int rep_ = 0; rep_ < DUPN(5); ++rep_) { gm::SchedDense S{(const char*)(C.ws + WS_A2), (const char*)(C.ws + WS_WOUT0), F8_OUT0 ? 1536 : 3072, 256, 4, C.G, cid}; gm::EpiPlain E{(bf16*)(C.ws + WS_Y), 1024}; gm::gemm_phase<F8_OUT0 != 0>(ring, F8_OUT0 ? 1536 : 3072, S, E, 0x7C7C7C7C, 0x7A7A7A7A); } SEAM(5);
    if (IN(6)) for (int rep_ = 0; rep_ < DUPN(6); ++rep_) { p_postmix(C, 0); } SEAM(6);
    if (IN(7)) { p_assign(C); } SEAM(7);
    if (IN(8)) for (int rep_ = 0; rep_ < DUPN(8); ++rep_) { const int* tsp = (const int*)(C.ws + WS_MOEINFO); const int ln_ = otid() & 63; const int ts = __hip_atomic_load(tsp + (ln_ < 32 ? ln_ : 32), __ATOMIC_RELAXED, __HIP_MEMORY_SCOPE_AGENT);
        gm::SchedMoE S{(const char*)(C.ws + WS_H2), (const char*)(C.ws + WS_WGU), (const int*)(C.ws + WS_SLOTTOK), ts, __builtin_amdgcn_readlane(ts, 32), 8, C.G, cid, (size_t)2048 * 1024, true, args.in[IN_BGU]};
        gm::EpiGU E{(unsigned char*)(C.ws + WS_ACT), args.in[IN_BGU], PROBE_NOEPI ? rep_ : 0}; gm::gemm_phase<true>(ring, 1024, S, E, 0x7C7C7C7C, 0x7A7A7A7A); } SEAM(8);
    if (IN(9)) for (int rep_ = 0; rep_ < DUPN(9); ++rep_) { const int* tsp = (const int*)(C.ws + WS_MOEINFO); const int ln_ = otid() & 63; const int ts = __hip_atomic_load(tsp + (ln_ < 32 ? ln_ : 32), __ATOMIC_RELAXED, __HIP_MEMORY_SCOPE_AGENT);
        gm::SchedMoE S{(const char*)(C.ws + WS_ACT), (const char*)(C.ws + WS_WD), nullptr, ts, __builtin_amdgcn_readlane(ts, 32), 4, C.G, cid, (size_t)1024 * 1024, false, args.in[IN_BD]};
        gm::EpiDown E{(unsigned char*)(C.ws + WS_YSLOT), args.in[IN_BD]}; gm::gemm_phase<true>(ring, 1024, S, E, 0x7D7D7D7D, 0x7A7A7A7A); } SEAM(9);
    if (IN(10)) { p_combine(C, 0); } SEAM(10);
    if (IN(11)) for (int rep_ = 0; rep_ < DUPN(11); ++rep_) { gm::SchedDense S{(const char*)(C.ws + WS_HN), (const char*)(C.ws + WS_WIN1), F8_IN1 ? 1024 : 2048, 256, 10, C.G, cid}; gm::EpiIn1 E{C.ws}; gm::gemm_phase<F8_IN1 != 0>(ring, F8_IN1 ? 1024 : 2048, S, E, 0x7C7C7C7C, 0x7A7A7A7A); } SEAM(11);
    if (IN(12)) for (int rep_ = 0; rep_ < DUPN(12); ++rep_) { p_conv(C); } SEAM(12);
    if (IN(13)) for (int rep_ = 0; rep_ < DUPN(13); ++rep_) { gm::SchedDense S{(const char*)(C.ws + WS_A2B), (const char*)(C.ws + WS_WOUT1), F8_OUT1 ? 1024 : 2048, 256, 4, C.G, cid}; gm::EpiPlain E{(bf16*)(C.ws + WS_Y), 1024}; gm::gemm_phase<F8_OUT1 != 0>(ring, F8_OUT1 ? 1024 : 2048, S, E, 0x7D7D7D7D, 0x7A7A7A7A); } SEAM(13);
    if (IN(14)) { p_postmix(C, 1); } SEAM(14);
    if (IN(15)) { p_assign(C); } SEAM(15);
    if (IN(16)) for (int rep_ = 0; rep_ < DUPN(16); ++rep_) { const int* tsp = (const int*)(C.ws + WS_MOEINFO); const int ln_ = otid() & 63; const int ts = __hip_atomic_load(tsp + (ln_ < 32 ? ln_ : 32), __ATOMIC_RELAXED, __HIP_MEMORY_SCOPE_AGENT);
        gm::SchedMoE S{(const char*)(C.ws + WS_H2), (const char*)(C.ws + WS_WGU) + (size_t)32 * 2048 * 1024, (const int*)(C.ws + WS_SLOTTOK), ts, __builtin_amdgcn_readlane(ts, 32), 8, C.G, cid, (size_t)2048 * 1024, true, args.in[IN_BGU] + 32 * 2048};
        gm::EpiGU E{(unsigned char*)(C.ws + WS_ACT), args.in[IN_BGU] + 32 * 2048, 0}; gm::gemm_phase<true>(ring, 1024, S, E, 0x7C7C7C7C, 0x7A7A7A7A); } SEAM(16);
    if (IN(17)) for (int rep_ = 0; rep_ < DUPN(17); ++rep_) { const int* tsp = (const int*)(C.ws + WS_MOEINFO); const int ln_ = otid() & 63; const int ts = __hip_atomic_load(tsp + (ln_ < 32 ? ln_ : 32), __ATOMIC_RELAXED, __HIP_MEMORY_SCOPE_AGENT);
        gm::SchedMoE S{(const char*)(C.ws + WS_ACT), (const char*)(C.ws + WS_WD) + (size_t)32 * 1024 * 1024, nullptr, ts, __builtin_amdgcn_readlane(ts, 32), 4, C.G, cid, (size_t)1024 * 1024, false, args.in[IN_BD] + 32 * 1024};
        gm::EpiDown E{(unsigned char*)(C.ws + WS_YSLOT), args.in[IN_BD] + 32 * 1024}; gm::gemm_phase<true>(ring, 1024, S, E, 0x7D7D7D7D, 0x7A7A7A7A); } SEAM(17);
    if (IN(18)) { p_combine(C, 1); }
#ifdef DBG_COPY_OFF
    if (lo == 99) { const bf16* src = (const bf16*)(C.ws + (size_t)DBG_COPY_OFF); float* dst = args.out;
        for (size_t i = (size_t)blockIdx.x * 512 + threadIdx.x; i < (size_t)MTOK * 1024; i += (size_t)gridDim.x * 512) dst[i] = bf_lo((unsigned)src[i]); }
#endif
#undef IN
#undef SEAM
}

extern "C" void kernel_launch(void* const* d_in, const int* in_sizes, int n_in, void* d_out, int out_size, void* d_ws, size_t ws_size, hipStream_t stream) {
    static int grid = 0;
    if (grid == 0) {
        if (n_in != 28 || out_size != MTOK * D || ws_size < WS_END) { fprintf(stderr, "kernel_launch: unexpected problem (n_in %d out %d ws %zu need %zu)\n", n_in, out_size, ws_size, (size_t)WS_END); grid = -1; return; }
        int dev = 0, cus = 0, per_cu = 0;
        (void)hipGetDevice(&dev); (void)hipDeviceGetAttribute(&cus, hipDeviceAttributeMultiprocessorCount, dev);
        if (hipFuncSetAttribute((const void*)fwd_kernel, hipFuncAttributeMaxDynamicSharedMemorySize, LDS_BYTES) != hipSuccess) { fprintf(stderr, "kernel_launch: hipFuncSetAttribute failed\n"); grid = -1; return; }
        (void)hipOccupancyMaxActiveBlocksPerMultiprocessor(&per_cu, (const void*)fwd_kernel, 512, LDS_BYTES);
        (void)hipGetLastError();
        grid = cus;
        if (grid != 256 || per_cu < 1) { fprintf(stderr, "kernel_launch: needs a 256-CU device with one resident workgroup per CU (cus %d, per_cu %d)\n", cus, per_cu); grid = -1; return; }
    }
    if (grid < 0) return;
    (void)hipMemsetAsync((char*)d_ws + WS_CTL, 0, CTL_ZERO_BYTES, stream);
    Args a{};
    for (int i = 0; i < 28; ++i) a.in[i] = (const float*)d_in[i];
    a.out = (float*)d_out; a.ws = (unsigned char*)d_ws;
#if N_LAUNCH_MODE == 1
    a.ph_lo = 0; a.ph_hi = NPHASE;
    hipLaunchKernelGGL(fwd_kernel, dim3(grid), dim3(512), LDS_BYTES, stream, a);
#else
    for (int p = 0; p < RUN_HI; ++p) { a.ph_lo = p; a.ph_hi = p + 1; hipLaunchKernelGGL(fwd_kernel, dim3(grid), dim3(512), LDS_BYTES, stream, a); }
#ifdef DBG_COPY_OFF
    a.ph_lo = 99; a.ph_hi = 100; hipLaunchKernelGGL(fwd_kernel, dim3(grid), dim3(512), LDS_BYTES, stream, a);
#endif
#endif
}
```

```cpp
#include <hip/hip_runtime.h>
#include <cstdio>
#include <cstdint>

#ifndef N_LAUNCH_MODE
#define N_LAUNCH_MODE 1
#endif

#ifndef F8_IN0
#define F8_IN0 0
#endif
#ifndef F8_OUT0
#define F8_OUT0 1
#endif
#ifndef F8_IN1
#define F8_IN1 1
#endif
#ifndef F8_OUT1
#define F8_OUT1 1
#endif
#define LAS __attribute__((address_space(3)))
typedef unsigned short bf16;
typedef short bf16x8 __attribute__((ext_vector_type(8)));
typedef short s16x4 __attribute__((ext_vector_type(4)));
typedef float f32x4 __attribute__((ext_vector_type(4)));
typedef float f32x16 __attribute__((ext_vector_type(16)));
typedef unsigned u32x4 __attribute__((ext_vector_type(4)));
typedef unsigned u32x2 __attribute__((ext_vector_type(2)));

constexpr int D = 1024, NB = 8, SEQ = 8192, CTXL = 256;
constexpr int MTOK = NB * SEQ;
constexpr int MCTX = NB * CTXL;
constexpr int MALL = MTOK + MCTX;
constexpr int NE = 32, TOPK = 4;
constexpr int NSLOT_PAD = MTOK * TOPK + NE * 256;
constexpr int N_IN0 = 3840;
constexpr int N_IN1 = 2560;
constexpr float EPS = 1e-6f;

constexpr size_t MiB = 1u << 20;
constexpr size_t WS_CTL = 0, CTL_ZERO_BYTES = 65536;
constexpr size_t WS_MOD = 1 * MiB;
constexpr size_t WS_F1 = 2 * MiB;
constexpr size_t WS_F2 = 2 * MiB + 65536;
constexpr size_t WS_CNTBLK = 3 * MiB;
constexpr size_t WS_MOEINFO = 3 * MiB + 65536;
constexpr size_t WS_TOPK = 4 * MiB;
constexpr size_t WS_GATE = 5 * MiB;
constexpr size_t WS_SLOTPOS = 6 * MiB;
constexpr size_t WS_SLOTTOK = 7 * MiB;
constexpr size_t WS_SLOTDST = 8 * MiB + 512 * 1024;
constexpr size_t WS_WIN0 = 10 * MiB;
constexpr size_t WS_WOUT0 = 19 * MiB;
constexpr size_t WS_WIN1 = 22 * MiB;
constexpr size_t WS_WOUT1 = 27 * MiB;
constexpr size_t WS_WGU = 32 * MiB;
constexpr size_t WS_WD = 288 * MiB;
constexpr size_t WS_HN = 416 * MiB;
constexpr size_t WS_B = 548 * MiB;
constexpr size_t WS_ACT = WS_B;
constexpr size_t WS_YSLOT = WS_B + 528 * MiB;
constexpr size_t WS_Q = WS_B, WS_K = WS_B + 64 * MiB, WS_V = WS_B + 130 * MiB, WS_R = WS_B + 262 * MiB;
constexpr size_t WS_ZC = WS_B + 390 * MiB, WS_ZS = WS_B + 454 * MiB, WS_LR = WS_B + 518 * MiB;
constexpr size_t WS_OF = WS_B + 528 * MiB, WS_OB = WS_B + 656 * MiB, WS_YR = WS_B + 784 * MiB, WS_YI = WS_B + 848 * MiB;
constexpr size_t WS_A2 = WS_B;
constexpr size_t WS_Y = WS_B + 528 * MiB;
constexpr size_t WS_H2 = WS_B + 656 * MiB;
constexpr size_t WS_GLU = WS_B, WS_ZC1 = WS_B + 64 * MiB, WS_GB = WS_B + 128 * MiB, WS_A2B = WS_B + 192 * MiB;
constexpr size_t WS_XS = WS_B + 1056 * MiB;
constexpr size_t WS_GQP = WS_B + 1056 * MiB;
constexpr size_t WS_GKPP = WS_GQP + 132 * MiB;
constexpr size_t WS_GSC = WS_GKPP + 132 * MiB;
constexpr size_t WS_GEL = WS_GSC + 66 * MiB;
constexpr size_t WS_END = WS_GEL + 6 * MiB;

constexpr int LDS_BYTES = 155648;
constexpr int MISC_OFF = LDS_BYTES - 256;

__device__ __forceinline__ float bf_lo(unsigned u) { return __uint_as_float(u << 16); }
__device__ __forceinline__ float bf_hi(unsigned u) { return __uint_as_float(u & 0xffff0000u); }
typedef __bf16 bf16v2_t __attribute__((ext_vector_type(2)));
typedef float f32v2_t __attribute__((ext_vector_type(2)));
__device__ __forceinline__ unsigned cvt_pk(float lo, float hi) { const f32v2_t v = {lo, hi}; const bf16v2_t r = __builtin_convertvector(v, bf16v2_t); return __builtin_bit_cast(unsigned, r); }
__device__ __forceinline__ unsigned f2bf(float f) { unsigned u = __float_as_uint(f); return (u + 0x7fffu + ((u >> 16) & 1u)) >> 16; }
__device__ __forceinline__ float swap32_sum(float a, float b) {
    const auto r = __builtin_amdgcn_permlane32_swap(__builtin_bit_cast(unsigned, a), __builtin_bit_cast(unsigned, b), false, false);
    unsigned x = r[0], y = r[1]; asm volatile("" : "+v"(x), "+v"(y));
    return __builtin_bit_cast(float, x) + __builtin_bit_cast(float, y);
}
__device__ __forceinline__ float swap16_sum(float a, float b) {
    const auto r = __builtin_amdgcn_permlane16_swap(__builtin_bit_cast(unsigned, a), __builtin_bit_cast(unsigned, b), false, false);
    unsigned x = r[0], y = r[1]; asm volatile("" : "+v"(x), "+v"(y));
    return __builtin_bit_cast(float, x) + __builtin_bit_cast(float, y);
}
__device__ __forceinline__ float row16_sum(float v) {
    v += __builtin_bit_cast(float, __builtin_amdgcn_update_dpp(0, __builtin_bit_cast(int, v), 0xB1, 0xF, 0xF, true));
    v += __builtin_bit_cast(float, __builtin_amdgcn_update_dpp(0, __builtin_bit_cast(int, v), 0x4E, 0xF, 0xF, true));
    v += __builtin_bit_cast(float, __builtin_amdgcn_update_dpp(0, __builtin_bit_cast(int, v), 0x141, 0xF, 0xF, true));
    v += __builtin_bit_cast(float, __builtin_amdgcn_update_dpp(0, __builtin_bit_cast(int, v), 0x140, 0xF, 0xF, true));
    return v;
}
__device__ __forceinline__ float wave_sum(float v) {
    v = row16_sum(v);
    const int iv = __builtin_bit_cast(int, v);
    const float a = __builtin_bit_cast(float, __builtin_amdgcn_readlane(iv, 0)), b = __builtin_bit_cast(float, __builtin_amdgcn_readlane(iv, 16));
    const float c = __builtin_bit_cast(float, __builtin_amdgcn_readlane(iv, 32)), d = __builtin_bit_cast(float, __builtin_amdgcn_readlane(iv, 48));
    return (a + b) + (c + d);
}
__device__ __forceinline__ unsigned pk4_fp8(float a, float b, float c, float d, float sc) {
    int w = 0;
    w = __builtin_amdgcn_cvt_pk_fp8_f32(__builtin_amdgcn_fmed3f(a * sc, -440.f, 440.f), __builtin_amdgcn_fmed3f(b * sc, -440.f, 440.f), w, false);
    w = __builtin_amdgcn_cvt_pk_fp8_f32(__builtin_amdgcn_fmed3f(c * sc, -440.f, 440.f), __builtin_amdgcn_fmed3f(d * sc, -440.f, 440.f), w, true);
    return (unsigned)w;
}
__device__ __forceinline__ float sigmoidf_(float x) { return __builtin_amdgcn_rcpf(1.0f + __builtin_amdgcn_exp2f(x * -1.4426950408889634f)); }
__device__ __forceinline__ float siluf_(float x) { return x * sigmoidf_(x); }

#define XB_TMO      128
#define XB_XCNT(j)  (256  + 64 * (j))
#define XB_XSUB(j)  (1280 + 64 * (j))
#define XB_XGEN(j)  (2304 + 64 * (j))
#define XB_TOP      3328
#define XB_TOPGEN   3392
#define XCD_BAR_WORDS 3456
#define XB_SPIN_CAP (1u << 18)
__device__ __forceinline__ unsigned xb_ld(unsigned* p)              { return __hip_atomic_load(p, __ATOMIC_RELAXED, __HIP_MEMORY_SCOPE_AGENT); }
__device__ __forceinline__ unsigned xb_add(unsigned* p, unsigned v) { return __hip_atomic_fetch_add(p, v, __ATOMIC_RELAXED, __HIP_MEMORY_SCOPE_AGENT); }
__device__ __forceinline__ unsigned xb_xcc_id() { return (unsigned)__builtin_amdgcn_s_getreg((3 << 11) | 20) & 0xFu; }
#define XB_SPIN(cond, bar) do { unsigned _sp = 0; while (cond) { __builtin_amdgcn_s_sleep(1); \
    if ((++_sp & 255u) == 0u) { if (xb_ld(&(bar)[XB_TMO])) break; if (_sp > XB_SPIN_CAP) { atomicAdd(&(bar)[XB_TMO], 1u); break; } } } } while (0)
struct XcdBarrier { unsigned* bar; unsigned x; volatile LAS unsigned* st; };
__device__ __forceinline__ XcdBarrier xcd_barrier_post(unsigned* bar, volatile LAS unsigned* st) {
    XcdBarrier b; b.bar = bar; b.x = xb_xcc_id(); b.st = st;
    if (threadIdx.x == 0) (void)xb_add(&bar[XB_XCNT(b.x)], 1u);
    return b;
}
__device__ __forceinline__ void xcd_barrier_complete(unsigned* bar, unsigned x, unsigned& nloc, unsigned& nx) {
    const unsigned G = gridDim.x * gridDim.y * gridDim.z;
    unsigned sum, cnt, mine, sp = 0u;
    for (;;) {
        sum = 0u; cnt = 0u; mine = 0u;
#pragma unroll
        for (unsigned j = 0; j < 16; ++j) { const unsigned c = xb_ld(&bar[XB_XCNT(j)]); sum += c; cnt += (c > 0u) ? 1u : 0u; mine = (j == x) ? c : mine; }
        if (sum == G) break;
        __builtin_amdgcn_s_sleep(1);
        if ((++sp & 255u) == 0u) { if (xb_ld(&bar[XB_TMO])) break; if (sp > XB_SPIN_CAP) { atomicAdd(&bar[XB_TMO], 1u); break; } }
    }
    nloc = mine > 0u ? mine : 1u; nx = cnt > 0u ? cnt : 1u;
}
__device__ __forceinline__ void xcd_barrier(const XcdBarrier& b) {
    asm volatile("s_waitcnt vmcnt(0)" ::: "memory");
    __syncthreads();
    if (threadIdx.x == 0) {
        unsigned* bar = b.bar;
        __builtin_amdgcn_s_waitcnt(0);
        unsigned nloc = b.st[0], nx = b.st[1];
        if (nloc == 0u) { xcd_barrier_complete(bar, b.x, nloc, nx); b.st[0] = nloc; b.st[1] = nx; }
        const unsigned old = xb_add(&bar[XB_XSUB(b.x)], 1u);
        const unsigned gen = old / nloc;
        if (old + 1u == (gen + 1u) * nloc) {
            __builtin_amdgcn_fence(__ATOMIC_RELEASE, "agent");
            asm volatile("s_waitcnt vmcnt(0)" ::: "memory");
            const unsigned og = xb_add(&bar[XB_TOP], 1u);
            const unsigned tg = og / nx;
            if (og + 1u == (tg + 1u) * nx) xb_add(&bar[XB_TOPGEN], 1u);
            else XB_SPIN(xb_ld(&bar[XB_TOPGEN]) == tg, bar);
            __builtin_amdgcn_fence(__ATOMIC_ACQUIRE, "agent");
            xb_add(&bar[XB_XGEN(b.x)], 1u);
            asm volatile("s_waitcnt vmcnt(0)" ::: "memory");
        } else {
            XB_SPIN(xb_ld(&bar[XB_XGEN(b.x)]) == gen, bar);
            __builtin_amdgcn_fence(__ATOMIC_ACQUIRE, "agent");
            asm volatile("s_waitcnt vmcnt(0)" ::: "memory");
        }
    }
    __syncthreads();
}

struct Args {
    const float* in[28];
    float* out;
    unsigned char* ws;
    int ph_lo, ph_hi;
};
struct Ctx {
    LAS unsigned char* lds;
    int G;
    const Args* a;
    unsigned char* ws;
};
__device__ __forceinline__ int otid() { int t = (int)threadIdx.x; asm volatile("" : "+v"(t)); return t; }
__device__ __forceinline__ int vzero() { int z = 0; asm volatile("" : "+v"(z)); return z; }
#define PH_IDS const int tid = otid(), lane = tid & 63, wave = __builtin_amdgcn_readfirstlane(tid >> 6); (void)tid; (void)lane; (void)wave
#define IN_X 0
#define IN_C 1
#define IN_CTX 2
#define IN_CCTX 3
#define IN_MODW 4
#define IN_MODB 5
#define IN_NMPRE 6
#define IN_NMPOST 7
#define IN_NFPRE 8
#define IN_NFPOST 9
#define IN_EVWIN 10
#define IN_EVGKUP 11
#define IN_EVGKB 12
#define IN_EVGNORM 13
#define IN_EVWOUT 14
#define IN_ODWIN 15
#define IN_ODDW 16
#define IN_ODDWB 17
#define IN_ODLNG 18
#define IN_ODLNB 19
#define IN_ODSCONV 20
#define IN_ODWOUT 21
#define IN_RW 22
#define IN_RB 23
#define IN_WGU 24
#define IN_BGU 25
#define IN_WD 26
#define IN_BD 27

namespace gm {
constexpr int BM = 256, BK = 64, HALF = 128, HTB = HALF * BK * 2, STAGE_BYTES = 8 * HTB, NXCD = 8, WGM = 8;
constexpr int XT_OFF = 131072;
constexpr int XB_OFF = XT_OFF + 16384;
__device__ __forceinline__ int lds_byte(int r, int c) { const int st = (r >> 4) * 2 + (c >> 5), rr = r & 15, cc = c & 31, ob = rr * 64 + cc * 2; return st * 1024 + (ob ^ (((ob >> 9) & 1) << 5)); }
__device__ __forceinline__ void stage_rc(int b, int& R, int& C) { const int st = b / 1024, sb = b % 1024, swz = sb ^ (((sb >> 9) & 1) << 5); R = (st >> 1) * 16 + swz / 64; C = (st & 1) * 32 + (swz % 64) / 2; }
__device__ __forceinline__ int perm32(int rho) { const int n = rho >> 4, i = rho & 15; return 8 * (i >> 2) + 4 * n + (i & 3); }
struct Unit { int pm, pn, e; };

__device__ __forceinline__ void dense_map(int L, int nM, int nN, int& pm, int& pn) {
    const int nwg = nM * nN; int wgid = L;
    { const int q = nwg / NXCD, r = nwg % NXCD, xcd = wgid % NXCD, off = wgid / NXCD; wgid = (xcd < r ? xcd * (q + 1) : r * (q + 1) + (xcd - r) * q) + off; }
    const int nig = WGM * nN, gid = wgid / nig, fm = gid * WGM, gsz = (nM - fm) < WGM ? (nM - fm) : WGM;
    pm = fm + ((wgid % nig) % gsz); pn = (wgid % nig) / gsz;
}

typedef int i32x8 __attribute__((ext_vector_type(8)));
typedef int i32x4_ __attribute__((ext_vector_type(4)));
template <bool F8, class Epi, class Sched>
__device__ __forceinline__ void gemm_phase(LAS unsigned char* lds, const int RP, const Sched& S, const Epi& E, const int SCA = 0x7F7F7F7F, const int SCB = 0x7F7F7F7F, const int pid = -1, unsigned long long* tprobe = nullptr) {
    const int tid = otid(), wid = __builtin_amdgcn_readfirstlane(tid >> 6), lane = tid & 63, wr = wid >> 2, wc = wid & 3, fr = lane & 15, fq = lane >> 4;
    const int nt = RP / 128;
    unsigned voffB[2];
#pragma unroll
    for (int i = 0; i < 2; ++i) { int R, C; stage_rc(tid * 16 + i * 8192, R, C); const int Rb = (R & ~31) + perm32(R & 31); voffB[i] = (unsigned)(Rb * RP + C * 2); }
    const size_t kstep = (size_t)128;
    const size_t hstepB = (size_t)HALF * RP;
    const unsigned ldsw = (unsigned)wid * 1024u;
    const int aoff = lds_byte(wr * 64 + fr, fq * 8);
    const int boff = lds_byte(wc * 32 + fr, fq * 8);
    constexpr int KOFF = 1024;
#define G_SA(b, h) (((b) * 2 + (h)) * HTB)
#define G_SB(b, h) ((4 + (b) * 2 + (h)) * HTB)
#define G_STAGEB(bufoff, gbase) do { _Pragma("unroll") for (int _i = 0; _i < 2; ++_i) \
        __builtin_amdgcn_global_load_lds((const unsigned*)((const char*)(gbase) + voffB[_i]), (LAS unsigned*)(lds + (bufoff) + ldsw + _i * 8192), 16, 0, 0); } while (0)
#define G_STAGEA(bufoff, offs, h, kb) do { _Pragma("unroll") for (int _i = 0; _i < 2; ++_i) \
        __builtin_amdgcn_global_load_lds((const unsigned*)(S.abase() + (size_t)(offs)[h][_i] + (kb)), (LAS unsigned*)(lds + (bufoff) + ldsw + _i * 8192), 16, 0, 0); } while (0)
#define G_LDA(dst, b, h) do { _Pragma("unroll") for (int m = 0; m < 4; ++m) _Pragma("unroll") for (int k = 0; k < 2; ++k) dst[m][k] = *(const LAS bf16x8*)(lds + G_SA(b, h) + aoff + m * 2048 + k * KOFF); } while (0)
#define G_LDB(dst, b, h) do { _Pragma("unroll") for (int n = 0; n < 2; ++n) _Pragma("unroll") for (int k = 0; k < 2; ++k) dst[n][k] = *(const LAS bf16x8*)(lds + G_SB(b, h) + boff + n * 2048 + k * KOFF); } while (0)
#define G_CAT8(x) __builtin_shufflevector(__builtin_bit_cast(i32x4_, (x)[0]), __builtin_bit_cast(i32x4_, (x)[1]), 0, 1, 2, 3, 4, 5, 6, 7)
#define G_MMA(ai, bj, At, Bt) do { __builtin_amdgcn_s_setprio(1); \
        if constexpr (F8) { _Pragma("unroll") for (int m = 0; m < 4; ++m) _Pragma("unroll") for (int n = 0; n < 2; ++n) \
            acc[ai][bj][m][n] = __builtin_amdgcn_mfma_scale_f32_16x16x128_f8f6f4(G_CAT8(Bt[n]), G_CAT8(At[m]), acc[ai][bj][m][n], 0, 0, 0, 0, 0, 0); } \
        else { _Pragma("unroll") for (int m = 0; m < 4; ++m) _Pragma("unroll") for (int n = 0; n < 2; ++n) _Pragma("unroll") for (int k = 0; k < 2; ++k) \
            acc[ai][bj][m][n] = __builtin_amdgcn_mfma_f32_16x16x32_bf16(Bt[n][k], At[m][k], acc[ai][bj][m][n], 0, 0, 0); } \
        __builtin_amdgcn_s_setprio(0); } while (0)
#define G_WAIT_V(n) asm volatile("s_waitcnt vmcnt(" #n ")" ::: "memory")
#define G_WAIT_L(n) asm volatile("s_waitcnt lgkmcnt(" #n ")" ::: "memory")
#define G_BAR __builtin_amdgcn_s_barrier()
#define G_SCHED __builtin_amdgcn_sched_barrier(0)
    Unit cur, nxt; int ui = 0;
#ifndef GP_PROBE
#define GP_PROBE 0
#endif
#ifndef GP_PROBE_PID
#define GP_PROBE_PID 8
#endif
    unsigned tp_k = 0, tp_e = 0, tp_s = 0, tp_0 = 0, tp_1 = 0;
#define TP_NOW() ((unsigned)__builtin_amdgcn_readfirstlane((int)(unsigned)wall_clock64()))
    const bool tp_on = GP_PROBE && pid == GP_PROBE_PID;
    if (tp_on) tp_0 = TP_NOW();
    if (!S.next(0, cur)) return;
    f32x4 acc[2][2][4][2];
#pragma unroll
    for (int a = 0; a < 2; ++a)
#pragma unroll
        for (int b = 0; b < 2; ++b)
#pragma unroll
            for (int m = 0; m < 4; ++m)
#pragma unroll
                for (int n = 0; n < 2; ++n) acc[a][b][m][n] = (f32x4){0.f, 0.f, 0.f, 0.f};
    bf16x8 At[4][2], B0[2][2], B1[2][2];
    unsigned cAo[2][2];
    S.a_off(cur, cAo);
    const char* cB = S.b_ptr(cur);
    S.prefetch_bias(cur, lds, 0, wid, lane, wc);
    S.prefetch_rows(cur, lds, 0, wid, lane);
    G_STAGEB(G_SB(0, 0), cB); G_STAGEA(G_SA(0, 0), cAo, 0, 0); G_STAGEB(G_SB(0, 1), cB + hstepB); G_STAGEA(G_SA(0, 1), cAo, 1, 0);
    if (wr == 1) G_BAR;
    G_WAIT_V(4); G_BAR;
    G_STAGEB(G_SB(1, 0), cB + kstep); G_STAGEA(G_SA(1, 0), cAo, 0, kstep); G_STAGEB(G_SB(1, 1), cB + hstepB + kstep);
    G_WAIT_V(6); G_BAR;
    for (;;) {
        const bool has_next = S.next(ui + 1, nxt);
        const char* nB = cB;
        if (has_next) { S.prefetch_rows(nxt, lds, (ui + 1) & 1, wid, lane); S.prefetch_bias(nxt, lds, (ui + 1) & 1, wid, lane, wc); nB = S.b_ptr(nxt); }
        if (tp_on) tp_s = TP_NOW();
        for (int t = 0; t < nt; t += 2) {
            const bool last = (t == nt - 2);
            const size_t k1 = (size_t)(t + 1) * kstep;
            G_LDB(B0, 0, 0); G_SCHED; G_LDA(At, 0, 0); G_STAGEA(G_SA(1, 1), cAo, 1, k1);
            if (last) { if (has_next) S.a_off_lds(nxt, lds, (ui + 1) & 1, wid, lane, cAo); cB = nB; }
            const size_t k2 = last ? 0 : (size_t)(t + 2) * kstep;
            const size_t k3 = k2 + kstep;
            const char* b2 = cB + k2; const char* b3 = b2 + kstep;
            G_WAIT_L(8); G_BAR; G_WAIT_L(0); G_MMA(0, 0, At, B0); G_BAR; G_SCHED;
            G_LDB(B1, 0, 1); G_STAGEB(G_SB(0, 0), b2);
            G_BAR; G_WAIT_L(0); G_MMA(0, 1, At, B1); G_BAR;
            G_LDA(At, 0, 1); G_STAGEA(G_SA(0, 0), cAo, 0, k2);
            G_BAR; G_WAIT_L(0); G_MMA(1, 0, At, B0); G_BAR; G_SCHED;
            G_STAGEB(G_SB(0, 1), b2 + hstepB);
            G_WAIT_V(6); G_BAR; G_MMA(1, 1, At, B1); G_BAR;
            G_LDB(B0, 1, 0); G_SCHED; G_LDA(At, 1, 0); G_STAGEA(G_SA(0, 1), cAo, 1, k2);
            G_WAIT_L(8); G_BAR; G_WAIT_L(0); G_MMA(0, 0, At, B0); G_BAR; G_SCHED;
            G_LDB(B1, 1, 1); G_STAGEB(G_SB(1, 0), b3);
            G_BAR; G_WAIT_L(0); G_MMA(0, 1, At, B1); G_BAR;
            G_LDA(At, 1, 1); G_STAGEA(G_SA(1, 0), cAo, 0, k3);
            G_BAR; G_WAIT_L(0); G_MMA(1, 0, At, B0); G_BAR; G_SCHED;
            G_STAGEB(G_SB(1, 1), b3 + hstepB);
            G_WAIT_V(6); G_BAR; G_MMA(1, 1, At, B1); G_BAR;
        }
        if (tp_on) { tp_1 = TP_NOW(); tp_k += tp_1 - tp_s; }
        const float osc = F8 ? __builtin_ldexpf(1.0f, ((SCA & 0xFF) - 127) + ((SCB & 0xFF) - 127)) : 1.0f;
        if constexpr (F8 && !Epi::FOLD) {
#pragma unroll
            for (int a = 0; a < 2; ++a)
#pragma unroll
                for (int b = 0; b < 2; ++b)
#pragma unroll
                    for (int m = 0; m < 4; ++m)
#pragma unroll
                        for (int n = 0; n < 2; ++n) acc[a][b][m][n] *= osc; }
        E(acc, cur, wr, wc, fr, fq, (const LAS float*)(lds + XB_OFF + ((ui & 1) * 8 + wid) * 256), (const LAS int*)(lds + XT_OFF + ((ui & 1) * 8 + wid) * 1024), osc);
        if (tp_on) tp_e += TP_NOW() - tp_1;
        if (!has_next) break;
#pragma unroll
        for (int a = 0; a < 2; ++a)
#pragma unroll
            for (int b = 0; b < 2; ++b)
#pragma unroll
                for (int m = 0; m < 4; ++m)
#pragma unroll
                    for (int n = 0; n < 2; ++n) acc[a][b][m][n] = (f32x4){0.f, 0.f, 0.f, 0.f};
        cur = nxt; ++ui;
    }
    G_WAIT_V(0);
    if (wr == 0) G_BAR;
    G_BAR;
    if (tp_on && blockIdx.x == 0 && tid == 0) { const unsigned tot = TP_NOW() - tp_0; *tprobe = (unsigned long long)((GP_PROBE == 1) ? tp_k : (GP_PROBE == 2) ? tp_e : tot); }
#undef G_SA
#undef G_SB
#undef G_STAGEA
#undef G_STAGEB
#undef G_LDA
#undef G_LDB
#undef G_MMA
#undef G_CAT8
#undef G_WAIT_V
#undef G_WAIT_L
#undef G_BAR
#undef G_SCHED
}

__device__ __forceinline__ void lane_rc(int i, int& R, int& Cb) { int C; stage_rc(otid() * 16 + i * 8192, R, C); Cb = C * 2; }

struct SchedDense {
    const char* A; const char* B; int RP, nM, nN, G, c;
    __device__ __forceinline__ const char* abase() const { return A; }
    __device__ __forceinline__ bool next(int i, Unit& u) const { const long L = (long)i * G + c; if (L >= (long)nM * nN) return false; dense_map((int)L, nM, nN, u.pm, u.pn); u.e = 0; return true; }
    __device__ __forceinline__ void a_off(const Unit& u, unsigned (&o)[2][2]) const {
#pragma unroll
        for (int i = 0; i < 2; ++i) { int R, Cb; lane_rc(i, R, Cb);
#pragma unroll
            for (int h = 0; h < 2; ++h) o[h][i] = (unsigned)(u.pm * BM + h * HALF + R) * (unsigned)RP + (unsigned)Cb; }
    }
    __device__ __forceinline__ void prefetch_rows(const Unit&, LAS unsigned char*, int, int, int) const {}
    __device__ __forceinline__ void prefetch_bias(const Unit&, LAS unsigned char*, int, int, int, int) const {}
    __device__ __forceinline__ void a_off_lds(const Unit& u, LAS unsigned char*, int, int, int, unsigned (&o)[2][2]) const { a_off(u, o); }
    __device__ __forceinline__ const char* b_ptr(const Unit& u) const { return B + (size_t)u.pn * BM * RP; }
};
struct SchedIn0 {
    const char* A; const char* B; int G, c;
    __device__ __forceinline__ const char* abase() const { return A; }
    __device__ __forceinline__ bool next(int i, Unit& u) const {
        const long L = (long)i * G + c; u.e = 0;
        if (L < 256 * 15) { dense_map((int)L, 256, 15, u.pm, u.pn); return true; }
        const int r = (int)(L - 256 * 15); if (r >= 56) return false;
        u.pm = 256 + r / 7; const int q = r % 7; u.pn = (q < 6) ? (2 + q) : 14; return true;
    }
    __device__ __forceinline__ void a_off(const Unit& u, unsigned (&o)[2][2]) const {
#pragma unroll
        for (int i = 0; i < 2; ++i) { int R, Cb; lane_rc(i, R, Cb);
#pragma unroll
            for (int h = 0; h < 2; ++h) o[h][i] = (unsigned)(u.pm * BM + h * HALF + R) * (F8_IN0 ? 1024u : 2048u) + (unsigned)Cb; }
    }
    __device__ __forceinline__ void prefetch_rows(const Unit&, LAS unsigned char*, int, int, int) const {}
    __device__ __forceinline__ void prefetch_bias(const Unit&, LAS unsigned char*, int, int, int, int) const {}
    __device__ __forceinline__ void a_off_lds(const Unit& u, LAS unsigned char*, int, int, int, unsigned (&o)[2][2]) const { a_off(u, o); }
    __device__ __forceinline__ const char* b_ptr(const Unit& u) const { return B + (size_t)u.pn * BM * (F8_IN0 ? 1024 : 2048); }
};
struct SchedMoE {
    const char* A; const char* B; const int* slot_tok; int ts; int RT; int nct; int G, c; size_t bstride_e; bool gather; const float* bias; const int* slot_dst;
    __device__ __forceinline__ const char* abase() const { return A; }
    __device__ __forceinline__ bool next(int i, Unit& u) const {
        const int x = c & 7, j = c >> 3; int rt, ct;
        if (nct == 8) { rt = 32 * i + 4 * x + (j & 3); ct = j >> 2; } else { rt = 64 * i + 8 * x + (j & 7); ct = j >> 3; }
        if (rt >= RT) return false;
        const unsigned long long m = __ballot(((otid() & 63) < 32) && ts <= rt);
        u.pm = rt; u.pn = ct; u.e = __builtin_amdgcn_readfirstlane(__popcll(m)) - 1; return true;
    }
    __device__ __forceinline__ void a_off(const Unit& u, unsigned (&o)[2][2]) const {
#pragma unroll
        for (int i = 0; i < 2; ++i) { int R, Cb; lane_rc(i, R, Cb);
#pragma unroll
            for (int h = 0; h < 2; ++h) { const int row = u.pm * BM + h * HALF + R; const unsigned rr = gather ? (unsigned)slot_tok[row] : (unsigned)row; o[h][i] = rr * 1024u + (unsigned)Cb; } }
    }
    __device__ __forceinline__ const char* b_ptr(const Unit& u) const { return B + (size_t)u.e * bstride_e + (size_t)u.pn * BM * 1024; }
    __device__ __forceinline__ void prefetch_rows(const Unit& u, LAS unsigned char* lds, int par, int wid, int lane) const {
        if (!gather) {
#pragma unroll
            for (int ai = 0; ai < 2; ++ai) __builtin_amdgcn_global_load_lds((const unsigned*)(slot_dst + (u.pm * BM + ai * HALF + (wid >> 2) * 64 + lane)), (LAS unsigned*)(lds + XT_OFF + ((par * 8 + wid) * 4 + ai) * 256), 4, 0, 0);
            return; }
#pragma unroll
        for (int i = 0; i < 2; ++i) { int R, Cb; lane_rc(i, R, Cb);
#pragma unroll
            for (int h = 0; h < 2; ++h) __builtin_amdgcn_global_load_lds((const unsigned*)(slot_tok + (u.pm * BM + h * HALF + R)), (LAS unsigned*)(lds + XT_OFF + ((par * 8 + wid) * 4 + h * 2 + i) * 256), 4, 0, 0); }
    }
    __device__ __forceinline__ void prefetch_bias(const Unit& u, LAS unsigned char* lds, int par, int wid, int lane, int wc) const {
        const float* src = (nct == 8) ? bias + (size_t)u.e * 2048 + (lane >> 5) * 1024 + u.pn * 128 + wc * 32 + (lane & 31)
                                      : bias + (size_t)u.e * 1024 + u.pn * 256 + (lane >> 5) * 128 + wc * 32 + (lane & 31);
        __builtin_amdgcn_global_load_lds((const unsigned*)src, (LAS unsigned*)(lds + XB_OFF + (par * 8 + wid) * 256), 4, 0, 0);
    }
    __device__ __forceinline__ void a_off_lds(const Unit& u, LAS unsigned char* lds, int par, int wid, int lane, unsigned (&o)[2][2]) const {
#pragma unroll
        for (int i = 0; i < 2; ++i) { int R, Cb; lane_rc(i, R, Cb);
#pragma unroll
            for (int h = 0; h < 2; ++h) { const unsigned rr = gather ? *(const LAS unsigned*)(lds + XT_OFF + ((par * 8 + wid) * 4 + h * 2 + i) * 256 + lane * 4) : (unsigned)(u.pm * BM + h * HALF + R); o[h][i] = rr * 1024u + (unsigned)Cb; } }
    }
};

__device__ __forceinline__ void store8(bf16* p, const f32x4& v0, const f32x4& v1) {
    u32x4 w; w.x = cvt_pk(v0[0], v0[1]); w.y = cvt_pk(v0[2], v0[3]); w.z = cvt_pk(v1[0], v1[1]); w.w = cvt_pk(v1[2], v1[3]);
    *(u32x4*)p = w;
}
struct EpiPlain {
    static constexpr bool FOLD = false;
    bf16* O; int ldc;
    __device__ __forceinline__ void operator()(const f32x4 (&acc)[2][2][4][2], const Unit& u, int wr, int wc, int fr, int fq, const LAS float* lb, const LAS int* xt, const float osc) const {
        const int row0 = u.pm * BM + wr * 64 + fr, col0 = u.pn * BM + wc * 32 + 8 * fq;
#pragma unroll
        for (int ai = 0; ai < 2; ++ai)
#pragma unroll
            for (int m = 0; m < 4; ++m) { bf16* rowp = O + (size_t)(row0 + ai * HALF + m * 16) * ldc + col0;
#pragma unroll
                for (int bj = 0; bj < 2; ++bj) store8(rowp + bj * HALF, acc[ai][bj][m][0], acc[ai][bj][m][1]); }
    }
};
struct EpiIn0 {
    static constexpr bool FOLD = false;
    unsigned char* ws;
    __device__ __forceinline__ void operator()(const f32x4 (&acc)[2][2][4][2], const Unit& u, int wr, int wc, int fr, int fq, const LAS float* lb, const LAS int* xt, const float osc) const {
        const int pn = u.pn; bf16* base; int ldc, c0;
        if (pn < 2) { base = (bf16*)(ws + WS_Q); ldc = 512; c0 = pn * 256; }
        else if (pn < 4) { base = (bf16*)(ws + WS_K); ldc = 512; c0 = (pn - 2) * 256; }
        else if (pn < 8) { base = (bf16*)(ws + WS_V); ldc = 1024; c0 = (pn - 4) * 256; }
        else if (pn < 12) { base = (bf16*)(ws + WS_R); ldc = 1024; c0 = (pn - 8) * 256; }
        else if (pn < 14) { base = (bf16*)(ws + WS_ZC); ldc = 512; c0 = (pn - 12) * 256; }
        else { base = (bf16*)(ws + WS_LR); ldc = 32; c0 = 0; }
        const int row0 = u.pm * BM + wr * 64 + fr, col0 = c0 + wc * 32 + 8 * fq;
        const bool lr = (pn == 14);
        if (lr && wc != 0) return;
        const float qs = (pn < 2) ? 0.08838834764831845f : 1.0f;
#pragma unroll
        for (int ai = 0; ai < 2; ++ai)
#pragma unroll
            for (int m = 0; m < 4; ++m) { bf16* rowp = base + (size_t)(row0 + ai * HALF + m * 16) * ldc + col0;
                store8(rowp, acc[ai][0][m][0] * qs, acc[ai][0][m][1] * qs);
                if (!lr) store8(rowp + HALF, acc[ai][1][m][0] * qs, acc[ai][1][m][1] * qs); }
    }
};
struct EpiIn1 {
    static constexpr bool FOLD = false;
    unsigned char* ws;
    __device__ __forceinline__ void operator()(const f32x4 (&acc)[2][2][4][2], const Unit& u, int wr, int wc, int fr, int fq, const LAS float* lb, const LAS int* xt, const float osc) const {
        const int pn = u.pn; const int row0 = u.pm * BM + wr * 64 + fr;
        if (pn >= 8) { bf16* O = (bf16*)(ws + WS_GB); const int col0 = (pn - 8) * 256 + wc * 32 + 8 * fq;
#pragma unroll
            for (int ai = 0; ai < 2; ++ai)
#pragma unroll
                for (int m = 0; m < 4; ++m) { bf16* rowp = O + (size_t)(row0 + ai * HALF + m * 16) * 512 + col0;
#pragma unroll
                    for (int bj = 0; bj < 2; ++bj) store8(rowp + bj * HALF, acc[ai][bj][m][0], acc[ai][bj][m][1]); }
            return; }
        const bool glu = pn < 4; bf16* O = (bf16*)(ws + (glu ? WS_GLU : WS_ZC1)); const int col0 = (pn & 3) * 128 + wc * 32 + 8 * fq;
#pragma unroll
        for (int ai = 0; ai < 2; ++ai)
#pragma unroll
            for (int m = 0; m < 4; ++m) { f32x4 o[2];
#pragma unroll
                for (int n = 0; n < 2; ++n)
#pragma unroll
                    for (int i = 0; i < 4; i += 2) { const f32v2_t a = (f32v2_t){acc[ai][0][m][n][i], acc[ai][0][m][n][i + 1]}, b = (f32v2_t){acc[ai][1][m][n][i], acc[ai][1][m][n][i + 1]};
                        f32v2_t ov;
                        if (glu) { const f32v2_t ea = b * -1.4426950408889634f; f32v2_t e; e.x = __builtin_amdgcn_exp2f(ea.x); e.y = __builtin_amdgcn_exp2f(ea.y);
                            const f32v2_t d = e + 1.0f; f32v2_t r; r.x = __builtin_amdgcn_rcpf(d.x); r.y = __builtin_amdgcn_rcpf(d.y); ov = a * r; }
                        else ov = a * b;
                        o[n][i] = ov.x; o[n][i + 1] = ov.y; }
                store8(O + (size_t)(row0 + ai * HALF + m * 16) * 512 + col0, o[0], o[1]); }
    }
};
struct EpiGU {
    static constexpr bool FOLD = true;
    unsigned char* O; const float* bgu; int probe;
    __device__ __forceinline__ void operator()(const f32x4 (&acc)[2][2][4][2], const Unit& u, int wr, int wc, int fr, int fq, const LAS float* lb, const LAS int* xt, const float osc) const {
        if (probe) {
#pragma unroll
            for (int a = 0; a < 2; ++a)
#pragma unroll
                for (int b = 0; b < 2; ++b)
#pragma unroll
                    for (int m = 0; m < 4; ++m)
#pragma unroll
                        for (int n = 0; n < 2; ++n) asm volatile("" :: "v"(acc[a][b][m][n]));
            return; }
        const int row0 = u.pm * BM + wr * 64 + fr, col0 = u.pn * 128 + wc * 32 + 8 * fq;
        f32x4 bgv[2], buv[2];
#pragma unroll
        for (int n = 0; n < 2; ++n) { bgv[n] = *(const LAS f32x4*)(lb + 8 * fq + 4 * n); buv[n] = *(const LAS f32x4*)(lb + 32 + 8 * fq + 4 * n); }
#pragma unroll
        for (int ai = 0; ai < 2; ++ai)
#pragma unroll
            for (int m = 0; m < 4; ++m) { f32x4 o[2];
#pragma unroll
                for (int n = 0; n < 2; ++n)
#pragma unroll
                    for (int i = 0; i < 4; i += 2) {
                        f32v2_t g = (f32v2_t){acc[ai][0][m][n][i], acc[ai][0][m][n][i + 1]} * osc + (f32v2_t){bgv[n][i], bgv[n][i + 1]};
                        f32v2_t uu = (f32v2_t){acc[ai][1][m][n][i], acc[ai][1][m][n][i + 1]} * osc + (f32v2_t){buv[n][i], buv[n][i + 1]};
                        g.x = fminf(g.x, 7.0f); g.y = fminf(g.y, 7.0f);
                        uu.x = __builtin_amdgcn_fmed3f(uu.x, -7.0f, 7.0f); uu.y = __builtin_amdgcn_fmed3f(uu.y, -7.0f, 7.0f);
                        const f32v2_t ea = g * (-1.702f * 1.4426950408889634f);
                        f32v2_t e; e.x = __builtin_amdgcn_exp2f(ea.x); e.y = __builtin_amdgcn_exp2f(ea.y);
                        const f32v2_t d = e + 1.0f;
                        f32v2_t r; r.x = __builtin_amdgcn_rcpf(d.x); r.y = __builtin_amdgcn_rcpf(d.y);
                        const f32v2_t t4 = uu * 4.0f + 4.0f;
                        const f32v2_t ov = (g * r) * t4;
                        o[n][i] = ov.x; o[n][i + 1] = ov.y; }
                int w0 = 0, w1 = 0;
                w0 = __builtin_amdgcn_cvt_pk_fp8_f32(o[0][0], o[0][1], w0, false); w0 = __builtin_amdgcn_cvt_pk_fp8_f32(o[0][2], o[0][3], w0, true);
                w1 = __builtin_amdgcn_cvt_pk_fp8_f32(o[1][0], o[1][1], w1, false); w1 = __builtin_amdgcn_cvt_pk_fp8_f32(o[1][2], o[1][3], w1, true);
                *(u32x2*)(O + (size_t)(row0 + ai * HALF + m * 16) * 1024 + col0) = (u32x2){(unsigned)w0, (unsigned)w1}; }
    }
};
struct EpiDown {
    static constexpr bool FOLD = true;
    unsigned char* O; const float* bd;
    __device__ __forceinline__ void operator()(const f32x4 (&acc)[2][2][4][2], const Unit& u, int wr, int wc, int fr, int fq, const LAS float* lb, const LAS int* xt, const float osc) const {
        const int row0 = u.pm * BM + wr * 64 + fr, col0 = u.pn * BM + wc * 32 + 8 * fq;
        f32x4 bv[2][2];
#pragma unroll
        for (int bj = 0; bj < 2; ++bj)
#pragma unroll
            for (int n = 0; n < 2; ++n) bv[bj][n] = *(const LAS f32x4*)(lb + 32 * bj + 8 * fq + 4 * n) * 16.0f;
#pragma unroll
        for (int ai = 0; ai < 2; ++ai)
#pragma unroll
            for (int m = 0; m < 4; ++m) { unsigned char* rowp = O + (size_t)xt[ai * 64 + m * 16 + fr] * 1024 + col0;
#pragma unroll
                for (int bj = 0; bj < 2; ++bj) { const f32x4 v0 = acc[ai][bj][m][0] * (16.0f * osc) + bv[bj][0], v1 = acc[ai][bj][m][1] * (16.0f * osc) + bv[bj][1];
                    int w0 = 0, w1 = 0;
                    w0 = __builtin_amdgcn_cvt_pk_fp8_f32(fminf(fmaxf(v0[0], -440.f), 440.f), fminf(fmaxf(v0[1], -440.f), 440.f), w0, false); w0 = __builtin_amdgcn_cvt_pk_fp8_f32(fminf(fmaxf(v0[2], -440.f), 440.f), fminf(fmaxf(v0[3], -440.f), 440.f), w0, true);
                    w1 = __builtin_amdgcn_cvt_pk_fp8_f32(fminf(fmaxf(v1[0], -440.f), 440.f), fminf(fmaxf(v1[1], -440.f), 440.f), w1, false); w1 = __builtin_amdgcn_cvt_pk_fp8_f32(fminf(fmaxf(v1[2], -440.f), 440.f), fminf(fmaxf(v1[3], -440.f), 440.f), w1, true);
                    *(u32x2*)(rowp + bj * HALF) = (u32x2){(unsigned)w0, (unsigned)w1}; } }
    }
};
}

__device__ __forceinline__ void p0_adaln(const Ctx& C) {
    PH_IDS;
    LAS float* s = (LAS float*)C.lds;
    LAS float* red = (LAS float*)(C.lds + 36864);
    const float* cc = C.a->in[IN_C]; const float* cx = C.a->in[IN_CCTX];
    { float tmpc[18];
#pragma unroll
      for (int q = 0; q < 18; ++q) { const int i = tid + 512 * q; const int b = i >> 10, k = i & 1023; tmpc[q] = (b < 8) ? cc[b * 1024 + k] : cx[k]; }
#pragma unroll
      for (int q = 0; q < 18; ++q) s[tid + 512 * q] = siluf_(tmpc[q]); }
    __syncthreads();
    float* MOD = (float*)(C.ws + WS_MOD);
    for (int item = blockIdx.x; item < 192; item += C.G) {
        const int l = item / 96, cb = item % 96, col = cb * 64 + lane;
        const float* W = C.a->in[IN_MODW] + (size_t)l * 1024 * 6144 + col;
        float acc[9];
#pragma unroll
        for (int b = 0; b < 9; ++b) acc[b] = 0.f;
        const int k0 = wave * 128;
#pragma unroll 8
        for (int k = k0; k < k0 + 128; ++k) { const float w = W[(size_t)k * 6144];
#pragma unroll
            for (int b = 0; b < 9; ++b) acc[b] += s[b * 1024 + k] * w; }
#pragma unroll
        for (int b = 0; b < 9; ++b) red[(wave * 9 + b) * 64 + lane] = acc[b];
        __syncthreads();
        for (int i = tid; i < 576; i += 512) { const int b = i >> 6, ln = i & 63; float v = 0.f;
#pragma unroll
            for (int w = 0; w < 8; ++w) v += red[(w * 9 + b) * 64 + ln];
            v += C.a->in[IN_MODB][l * 6144 + cb * 64 + ln];
            MOD[(size_t)(l * 9 + b) * 6144 + cb * 64 + ln] = v; }
        __syncthreads();
    }
}
__device__ __forceinline__ void p0_tr_item(const float* W, int ldw, int sc0, int k0, bf16* WT, int Kd, int dr0, float scale, LAS float* scr, int lane) {
#pragma unroll 8
    for (int i = 0; i < 32; ++i) { const int kk = 2 * i + (lane >> 5); scr[kk * 33 + (lane & 31)] = W[(size_t)(k0 + kk) * ldw + sc0 + (lane & 31)]; }
    asm volatile("s_waitcnt lgkmcnt(0)" ::: "memory");
    const int c = lane & 7;
#pragma unroll
    for (int j = 0; j < 4; ++j) { const int n = (lane >> 3) + 8 * j; const LAS float* sp = scr + (8 * c) * 33 + n;
        u32x4 o; o.x = cvt_pk(sp[0 * 33] * scale, sp[1 * 33] * scale); o.y = cvt_pk(sp[2 * 33] * scale, sp[3 * 33] * scale);
        o.z = cvt_pk(sp[4 * 33] * scale, sp[5 * 33] * scale); o.w = cvt_pk(sp[6 * 33] * scale, sp[7 * 33] * scale);
        *(u32x4*)(WT + (size_t)(dr0 + n) * Kd + k0 + 8 * c) = o; }
    asm volatile("s_waitcnt lgkmcnt(0)" ::: "memory");
}
__device__ __forceinline__ void p0_tr_item8(const float* W, int ldw, int sc0, int k0, unsigned char* WT, int Kd, int dr0, float scale, LAS float* scr, int lane) {
#pragma unroll 8
    for (int i = 0; i < 64; ++i) { const int kk = 2 * i + (lane >> 5); scr[kk * 33 + (lane & 31)] = W[(size_t)(k0 + kk) * ldw + sc0 + (lane & 31)]; }
    asm volatile("s_waitcnt lgkmcnt(0)" ::: "memory");
    const int c = lane & 7;
#pragma unroll
    for (int j = 0; j < 4; ++j) { const int n = (lane >> 3) + 8 * j; const LAS float* sp = scr + (16 * c) * 33 + n;
        int w[4];
#pragma unroll
        for (int q = 0; q < 4; ++q) { int x = 0;
            x = __builtin_amdgcn_cvt_pk_fp8_f32(sp[(4 * q) * 33] * scale, sp[(4 * q + 1) * 33] * scale, x, false);
            x = __builtin_amdgcn_cvt_pk_fp8_f32(sp[(4 * q + 2) * 33] * scale, sp[(4 * q + 3) * 33] * scale, x, true); w[q] = x; }
        *(u32x4*)(WT + (size_t)(dr0 + n) * Kd + k0 + 16 * c) = (u32x4){(unsigned)w[0], (unsigned)w[1], (unsigned)w[2], (unsigned)w[3]}; }
    asm volatile("s_waitcnt lgkmcnt(0)" ::: "memory");
}
__device__ __forceinline__ int gu_src_col(int dr0) { const int pn = dr0 >> 8, bj = (dr0 >> 7) & 1, t0 = dr0 & 127; return bj * 1024 + 128 * pn + t0; }
__device__ __forceinline__ int in1_src_col(int dr0) {
    const int pn = dr0 >> 8, bj = (dr0 >> 7) & 1, t0 = dr0 & 127;
    if (pn < 4) return bj * 512 + 128 * pn + t0;
    if (pn < 8) return (bj ? 2048 : 1536) + 128 * (pn - 4) + t0;
    return 1024 + (dr0 - 2048);
}
__device__ __forceinline__ void p0_convert(const Ctx& C) {
    PH_IDS;
    LAS float* scr = (LAS float*)(C.lds + wave * 16896);
    const int gw = blockIdx.x * 8 + wave, NGW = C.G * 8;
    constexpr int KB_IN0 = F8_IN0 ? 8 : 16, KB_OUT0 = F8_OUT0 ? 12 : 24, KB_IN1 = F8_IN1 ? 8 : 16, KB_OUT1 = F8_OUT1 ? 8 : 16;
    constexpr int I_IN0 = 97 * KB_IN0, I_OUT0 = 32 * KB_OUT0, I_IN1 = 80 * KB_IN1, I_OUT1 = 32 * KB_OUT1, I_GU = 0, I_D = 0;
    constexpr int NITEMS = I_IN0 + I_OUT0 + I_IN1 + I_OUT1 + I_GU + I_D;
    for (int it = gw; it < NITEMS; it += NGW) {
        int r = it;
        if (r < I_IN0) { const int nb = r / KB_IN0, kb = r % KB_IN0; int dr0, sc0;
            if (nb < 96) { dr0 = nb * 32; sc0 = dr0; } else { dr0 = 3584; sc0 = 3072; }
            if (F8_IN0) p0_tr_item8(C.a->in[IN_EVWIN], 3616, sc0, kb * 128, (unsigned char*)(C.ws + WS_WIN0), 1024, dr0, 32.f, scr, lane);
            else p0_tr_item(C.a->in[IN_EVWIN], 3616, sc0, kb * 64, (bf16*)(C.ws + WS_WIN0), 1024, dr0, 1.f, scr, lane);
            continue; }
        r -= I_IN0;
        if (r < I_OUT0) { const int nb = r / KB_OUT0, kb = r % KB_OUT0;
            if (F8_OUT0) p0_tr_item8(C.a->in[IN_EVWOUT], 1024, nb * 32, kb * 128, (unsigned char*)(C.ws + WS_WOUT0), 1536, nb * 32, 32.f, scr, lane);
            else p0_tr_item(C.a->in[IN_EVWOUT], 1024, nb * 32, kb * 64, (bf16*)(C.ws + WS_WOUT0), 1536, nb * 32, 1.f, scr, lane);
            continue; }
        r -= I_OUT0;
        if (r < I_IN1) { const int nb = r / KB_IN1, kb = r % KB_IN1;
            if (F8_IN1) p0_tr_item8(C.a->in[IN_ODWIN], 2560, in1_src_col(nb * 32), kb * 128, (unsigned char*)(C.ws + WS_WIN1), 1024, nb * 32, 32.f, scr, lane);
            else p0_tr_item(C.a->in[IN_ODWIN], 2560, in1_src_col(nb * 32), kb * 64, (bf16*)(C.ws + WS_WIN1), 1024, nb * 32, 1.f, scr, lane);
            continue; }
        r -= I_IN1;
        if (r < I_OUT1) { const int nb = r / KB_OUT1, kb = r % KB_OUT1;
            if (F8_OUT1) p0_tr_item8(C.a->in[IN_ODWOUT], 1024, nb * 32, kb * 128, (unsigned char*)(C.ws + WS_WOUT1), 1024, nb * 32, 32.f, scr, lane);
            else p0_tr_item(C.a->in[IN_ODWOUT], 1024, nb * 32, kb * 64, (bf16*)(C.ws + WS_WOUT1), 1024, nb * 32, 1.f, scr, lane);
            continue; }
        r -= I_OUT1;
        if (r < I_GU) { const int le = r >> 9, q = r & 511, nb = q >> 3, kb = q & 7;
            p0_tr_item8(C.a->in[IN_WGU] + (size_t)le * 1024 * 2048, 2048, gu_src_col(nb * 32), kb * 128, (unsigned char*)(C.ws + WS_WGU) + (size_t)le * 2048 * 1024, 1024, nb * 32, 32.f, scr, lane); continue; }
        r -= I_GU;
        { const int le = r >> 8, q = r & 255, nb = q >> 3, kb = q & 7;
            p0_tr_item8(C.a->in[IN_WD] + (size_t)le * 1024 * 1024, 1024, nb * 32, kb * 128, (unsigned char*)(C.ws + WS_WD) + (size_t)le * 1024 * 1024, 1024, nb * 32, 32.f, scr, lane); }
    }
    { u32x4* z = (u32x4*)((unsigned char*)(C.ws + WS_WIN0) + (size_t)3616 * 1024 * (F8_IN0 ? 1 : 2)); const int n16 = 224 * 1024 * (F8_IN0 ? 1 : 2) / 16;
      for (int i = blockIdx.x * 512 + tid; i < n16; i += C.G * 512) z[i] = (u32x4){0u, 0u, 0u, 0u}; }
    { bf16* F1 = (bf16*)(C.ws + WS_F1); bf16* F2 = (bf16*)(C.ws + WS_F2);
      for (int i = blockIdx.x * 512 + tid; i < 128 * 128 + 128 * 256; i += C.G * 512) {
          if (i < 128 * 128) { const int m = i >> 7, k = i & 127; const int mb = m >> 5, rr = m & 31, g = rr >> 3, hh = (rr >> 2) & 1, ii = rr & 3;
              const int part = g & 1, ap = 16 * mb + 8 * (g >> 1) + 4 * hh + ii, pin = k >> 6, a = k & 63;
              const float th = 6.283185307179586f * (float)((a * ap) & 63) * (1.0f / 64.0f); const float cs = cosf(th), sn = sinf(th);
              const float v = (part == 0) ? (pin == 0 ? cs : -sn) : (pin == 0 ? -sn : -cs);
              F1[i] = (bf16)f2bf(v); }
          else { const int q = i - 128 * 128, m = q >> 8, k = q & 255, pin = k >> 7, b = k & 127;
              const float ps = 6.283185307179586f * (float)((b * m) & 127) * (1.0f / 128.0f);
              F2[q] = (bf16)f2bf(pin == 0 ? cosf(ps) : sinf(ps)); } } }
    __syncthreads();
}
__device__ __forceinline__ void p0_convert_experts(const Ctx& C) {
    PH_IDS;
    constexpr int P = 260, NGU = 64 * 8 * 8, ND = 64 * 4 * 8;
    LAS float* T = (LAS float*)C.lds;
    const int c4 = tid & 63, rr = tid >> 6;
    f32x4 v[16];
    auto issue = [&](int bi) {
        const float* src; int ld, ca, cb;
        if (bi < NGU) { const int le = bi >> 6, q = bi & 63, pn = q >> 3, kb = q & 7;
            src = C.a->in[IN_WGU] + (size_t)le * 1024 * 2048 + (size_t)(kb * 128) * 2048; ld = 2048; ca = gu_src_col(pn * 256); cb = gu_src_col(pn * 256 + 128); }
        else { const int r = bi - NGU, le = r >> 5, q = r & 31, pn = q >> 3, kb = q & 7;
            src = C.a->in[IN_WD] + (size_t)le * 1024 * 1024 + (size_t)(kb * 128) * 1024; ld = 1024; ca = pn * 256; cb = pn * 256 + 128; }
        const int scol = (c4 < 32) ? ca + 4 * c4 : cb + 4 * (c4 - 32);
#pragma unroll
        for (int p = 0; p < 16; ++p) v[p] = *(const f32x4*)(src + (size_t)(p * 8 + rr) * ld + scol); };
    int bi = blockIdx.x;
    if (bi < NGU + ND) issue(bi);
    for (; bi < NGU + ND; bi += C.G) {
        unsigned char* dst; int n0, k0;
        if (bi < NGU) { const int le = bi >> 6, q = bi & 63; n0 = (q >> 3) * 256; k0 = (q & 7) * 128; dst = (unsigned char*)(C.ws + WS_WGU) + (size_t)le * 2048 * 1024; }
        else { const int r = bi - NGU, le = r >> 5, q = r & 31; n0 = (q >> 3) * 256; k0 = (q & 7) * 128; dst = (unsigned char*)(C.ws + WS_WD) + (size_t)le * 1024 * 1024; }
        __syncthreads();
#pragma unroll
        for (int p = 0; p < 16; ++p) *(LAS f32x4*)(T + (p * 8 + rr) * P + 4 * c4) = v[p];
        __syncthreads();
        if (bi + C.G < NGU + ND) issue(bi + C.G);
        const int n = tid & 255, kh = tid >> 8;
#pragma unroll
        for (int g = 0; g < 4; ++g) { int w[4];
#pragma unroll
            for (int q = 0; q < 4; ++q) { const LAS float* sp = T + (kh * 64 + g * 16 + q * 4) * P + n; int x = 0;
                x = __builtin_amdgcn_cvt_pk_fp8_f32(sp[0] * 32.f, sp[P] * 32.f, x, false);
                x = __builtin_amdgcn_cvt_pk_fp8_f32(sp[2 * P] * 32.f, sp[3 * P] * 32.f, x, true); w[q] = x; }
            *(u32x4*)(dst + (size_t)(n0 + n) * 1024 + k0 + kh * 64 + g * 16) = (u32x4){(unsigned)w[0], (unsigned)w[1], (unsigned)w[2], (unsigned)w[3]}; }
    }
    __syncthreads();
}
__device__ __forceinline__ void p0_fourier_fold(const Ctx& C) {
    PH_IDS;
    LAS float* Wl = (LAS float*)C.lds;
    LAS float* tab = (LAS float*)(C.lds + 32768);
    unsigned char* WT = (unsigned char*)(C.ws + WS_WIN0);
    for (int item = blockIdx.x; item < 64; item += C.G) {
        const int kb = item >> 2, g = item & 3;
        __syncthreads();
        if (tid < 128) tab[tid] = cosf(6.283185307179586f * (float)tid * (1.0f / 128.0f));
        for (int i = tid; i < 64 * 128; i += 512) { const int kk = i >> 7, c = i & 127; Wl[i] = C.a->in[IN_EVWIN][(size_t)(kb * 64 + kk) * 3616 + 3104 + g * 128 + c]; }
        __syncthreads();
        const int cp = tid & 127, kq = tid >> 7; const bool isS = cp > 64; const int cq = isS ? cp - 64 : cp, shf = isS ? 96 : 0;
        float ac[16];
#pragma unroll
        for (int i = 0; i < 16; ++i) ac[i] = 0.f;
#pragma unroll 4
        for (int c = 0; c < 128; ++c) { const float tr = tab[(c * cq + shf) & 127];
#pragma unroll
            for (int i = 0; i < 16; ++i) ac[i] += Wl[(kq * 16 + i) * 128 + c] * tr; }
        if (F8_IN0) {
            unsigned char* pc = WT + (size_t)(3072 + g * 128 + cp) * 1024 + kb * 64 + kq * 16;
            *(u32x4*)pc = (u32x4){pk4_fp8(ac[0], ac[1], ac[2], ac[3], 32.f), pk4_fp8(ac[4], ac[5], ac[6], ac[7], 32.f), pk4_fp8(ac[8], ac[9], ac[10], ac[11], 32.f), pk4_fp8(ac[12], ac[13], ac[14], ac[15], 32.f)};
        } else {
            bf16* pc = (bf16*)WT + (size_t)(3072 + g * 128 + cp) * 1024 + kb * 64 + kq * 16;
            *(u32x4*)pc = (u32x4){cvt_pk(ac[0], ac[1]), cvt_pk(ac[2], ac[3]), cvt_pk(ac[4], ac[5]), cvt_pk(ac[6], ac[7])}; *(u32x4*)(pc + 8) = (u32x4){cvt_pk(ac[8], ac[9]), cvt_pk(ac[10], ac[11]), cvt_pk(ac[12], ac[13]), cvt_pk(ac[14], ac[15])};
        }
    }
    __syncthreads();
}

__device__ __forceinline__ void p_norm0(const Ctx& C) {
    PH_IDS;
    const int gw = blockIdx.x * 8 + wave, NGW = C.G * 8;
    const int per = (MALL + NGW - 1) / NGW;
    const int r0 = gw * per, r1 = (r0 + per < MALL) ? r0 + per : MALL;
    const float* MOD = (const float*)(C.ws + WS_MOD);
    const float* g = C.a->in[IN_NMPRE];
    unsigned char* HN = (unsigned char*)(C.ws + WS_HN);
    int curb = -1; f32x4 A[4], B[4];
    for (int r = r0; r < r1; ++r) {
        const int b = (r < MTOK) ? (r >> 13) : 8;
        if (b != curb) { curb = b;
#pragma unroll
            for (int j = 0; j < 4; ++j) { const int c = 4 * lane + 256 * j;
                const f32x4 gg = *(const f32x4*)(g + c), sc = *(const f32x4*)(MOD + (size_t)b * 6144 + 1024 + c), sh = *(const f32x4*)(MOD + (size_t)b * 6144 + c);
                A[j] = gg * (sc + 1.0f); B[j] = sh; } }
        const float* xr = (r < MTOK) ? (C.a->in[IN_X] + (size_t)r * 1024) : (C.a->in[IN_CTX] + (size_t)(r - MTOK) * 1024);
        f32x4 v[4]; float ss = 0.f;
#pragma unroll
        for (int j = 0; j < 4; ++j) { v[j] = *(const f32x4*)(xr + 4 * lane + 256 * j); ss += v[j][0] * v[j][0] + v[j][1] * v[j][1] + v[j][2] * v[j][2] + v[j][3] * v[j][3]; }
        const float rstd = rsqrtf(wave_sum(ss) * (1.0f / 1024.0f) + EPS);
#pragma unroll
        for (int j = 0; j < 4; ++j) { const f32x4 h = v[j] * rstd * A[j] + B[j];
            if (F8_IN0) *(unsigned*)(HN + (size_t)r * 1024 + 4 * lane + 256 * j) = pk4_fp8(h[0], h[1], h[2], h[3], 8.f);
            else *(u32x2*)((bf16*)HN + (size_t)r * 1024 + 4 * lane + 256 * j) = (u32x2){cvt_pk(h[0], h[1]), cvt_pk(h[2], h[3])}; }
    }
}

namespace glap {
constexpr int H_BYTES = 72704;
constexpr int O_RAW = 0, O_BC = 2048, O_TOT = 34816, O_QP = 36864, O_KP = 54272;
constexpr int NUNIT = 2 * 4 * 8 * 132;
}
__device__ __forceinline__ int gla_row(int bt, int dir, int s, int i) {
    const int ii = dir ? 63 - i : i;
    if (s < 4) { const int ci = dir ? 3 - s : s; return MTOK + bt * CTXL + ci * 64 + ii; }
    const int n = s - 4, ci = dir ? 127 - n : n; return bt * SEQ + ci * 64 + ii;
}
__device__ __forceinline__ void p_gla_prep(const Ctx& C, const int pv = 0) {
    PH_IDS;
    using namespace glap;
    const int half = tid >> 8, th = tid & 255, wh = wave & 3;
    LAS unsigned char* L = C.lds + half * H_BYTES;
    const bf16* Qg = (const bf16*)(C.ws + WS_Q); const bf16* Kg = (const bf16*)(C.ws + WS_K); const bf16* LRg = (const bf16*)(C.ws + WS_LR);
    bf16* QPg = (bf16*)(C.ws + WS_GQP); bf16* KPPg = (bf16*)(C.ws + WS_GKPP); bf16* SCg = (bf16*)(C.ws + WS_GSC); float* ELg = (float*)(C.ws + WS_GEL);
    const int niter = (NUNIT + 2 * C.G - 1) / (2 * C.G);
    const int lj = th >> 2, part = th & 3;
    u32x4 nq[4], nk[4], nlr; float nup[8], nbias;
    auto unit_of = [&](int itn) -> int { const int U = (itn * C.G + (int)blockIdx.x) * 2 + half; return U < NUNIT ? U : NUNIT - 1; };
    auto issue_loads = [&](int Uc) {
        const int sstep = Uc % 132, bt = (Uc / 132) & 7, hd = (Uc / (132 * 8)) & 3, dir = Uc / (132 * 32);
#pragma unroll
        for (int q = 0; q < 4; ++q) { const int c = th + 256 * q; const int row = gla_row(bt, dir, sstep, c >> 4);
            nk[q] = *(const u32x4*)(Kg + (size_t)row * 512 + hd * 128 + (c & 15) * 8);
            nq[q] = *(const u32x4*)(Qg + (size_t)(sstep >= 4 ? row : 0) * 512 + hd * 128 + (c & 15) * 8); }
        if (th < 128) { const int r2 = gla_row(bt, dir, sstep, th >> 1); nlr = *(const u32x4*)(LRg + (size_t)r2 * 32 + dir * 16 + (th & 1) * 8); }
        const float* up = C.a->in[IN_EVGKUP] + (size_t)dir * 16 * 512 + hd * 128 + 32 * wh + (lane & 31);
#pragma unroll
        for (int q = 0; q < 8; ++q) nup[q] = up[(size_t)(8 * (lane >> 5) + q) * 512];
        nbias = C.a->in[IN_EVGKB][dir * 512 + hd * 128 + 32 * wh + (lane & 31)]; };
    issue_loads(unit_of(0));
    for (int itn = 0; itn < niter; ++itn) {
        const int U = (itn * C.G + (int)blockIdx.x) * 2 + half;
        const bool act = U < NUNIT;
        const int Uc = act ? U : NUNIT - 1;
        const int sstep = Uc % 132;
        const bool latent = sstep >= 4;
        u32x4 rq[4], rk[4], rlr = nlr;
#pragma unroll
        for (int q = 0; q < 4; ++q) { rq[q] = nq[q]; rk[q] = nk[q]; }
        bf16x8 upf; const float gbias = nbias;
        { unsigned short tmp[8];
#pragma unroll
          for (int q = 0; q < 8; ++q) tmp[q] = (unsigned short)f2bf(nup[q]);
          upf = (bf16x8){(short)tmp[0], (short)tmp[1], (short)tmp[2], (short)tmp[3], (short)tmp[4], (short)tmp[5], (short)tmp[6], (short)tmp[7]}; }
        if (itn + 1 < niter) issue_loads(unit_of(itn + 1));
        __syncthreads();
        if (th < 128) *(LAS u32x4*)(L + O_RAW + (th >> 1) * 32 + (th & 1) * 16) = rlr;
        __syncthreads();
#pragma unroll
        for (int jb = 0; jb < 2; ++jb) {
            const bf16x8 af = *(const LAS bf16x8*)(L + O_RAW + (32 * jb + (lane & 31)) * 32 + (lane >> 5) * 16);
            f32x16 z;
#pragma unroll
            for (int i = 0; i < 16; ++i) z[i] = 0.f;
            z = __builtin_amdgcn_mfma_f32_32x32x16_bf16(af, upf, z, 0, 0, 0);
#pragma unroll
            for (int r = 0; r < 16; ++r) { const int j = 32 * jb + (r & 3) + 8 * (r >> 2) + 4 * (lane >> 5); const float zz = z[r] + gbias;
                const float ls = fminf(zz, 0.f) - __logf(1.0f + __expf(-fabsf(zz)));
                *(LAS float*)(L + O_BC + (j * 128 + 32 * wh + (lane & 31)) * 4) = ls * 0.0625f; } }
        __syncthreads();
        { const int dk = th & 127;
          float run0 = 0.f, run1 = 0.f; const int g0 = th >> 7, g1 = g0 + 2;
          float v0[16], v1[16];
#pragma unroll
          for (int q = 0; q < 16; ++q) { v0[q] = *(const LAS float*)(L + O_BC + ((16 * g0 + q) * 128 + dk) * 4); v1[q] = *(const LAS float*)(L + O_BC + ((16 * g1 + q) * 128 + dk) * 4); }
#pragma unroll
          for (int q = 0; q < 16; ++q) { run0 += v0[q]; run1 += v1[q];
              *(LAS float*)(L + O_BC + ((16 * g0 + q) * 128 + dk) * 4) = run0; *(LAS float*)(L + O_BC + ((16 * g1 + q) * 128 + dk) * 4) = run1; }
          *(LAS float*)(L + O_TOT + (g0 * 128 + dk) * 4) = run0; *(LAS float*)(L + O_TOT + (g1 * 128 + dk) * 4) = run1; }
        __syncthreads();
        {
#pragma unroll
          for (int q8 = 0; q8 < 4; ++q8) {
              const int c = th + 256 * q8, cj = c >> 4, jg = cj >> 4, dkc = (c & 15) * 8;
              u32x4 oq, okpp;
#pragma unroll
              for (int hq = 0; hq < 2; ++hq) {
                  const int dk0 = dkc + 4 * hq;
                  f32x4 b = *(const LAS f32x4*)(L + O_BC + (cj * 128 + dk0) * 4), tt = (f32x4){0.f, 0.f, 0.f, 0.f};
#pragma unroll
                  for (int g2 = 0; g2 < 4; ++g2) { const f32x4 tv = *(const LAS f32x4*)(L + O_TOT + (g2 * 128 + dk0) * 4); tt += tv; if (g2 < jg) b += tv; }
                  f32x4 e1, e2, e3;
#pragma unroll
                  for (int i = 0; i < 4; ++i) { if (pv & 4) { e1[i] = b[i]; e2[i] = -b[i]; e3[i] = tt[i] - b[i]; } else { e1[i] = __expf(b[i]); e2[i] = __expf(-b[i]); e3[i] = __expf(tt[i] - b[i]); } }
                  if (cj == 0 && act && !(pv & 1)) { f32x4 el;
#pragma unroll
                      for (int i = 0; i < 4; ++i) el[i] = __expf(tt[i]);
                      *(f32x4*)(ELg + (size_t)Uc * 128 + dk0) = el; }
                  const unsigned qa = hq ? rq[q8].z : rq[q8].x, qb = hq ? rq[q8].w : rq[q8].y;
                  const unsigned ka = hq ? rk[q8].z : rk[q8].x, kb = hq ? rk[q8].w : rk[q8].y;
                  const float q0 = bf_lo(qa), q1 = bf_hi(qa), q2 = bf_lo(qb), q3 = bf_hi(qb);
                  const float k0 = bf_lo(ka), k1 = bf_hi(ka), k2 = bf_lo(kb), k3 = bf_hi(kb);
                  u32x2 o;
                  o.x = cvt_pk(q0 * e1[0], q1 * e1[1]); o.y = cvt_pk(q2 * e1[2], q3 * e1[3]); *(LAS u32x2*)(L + O_QP + cj * 272 + dk0 * 2) = o;
                  if (hq) { oq.z = o.x; oq.w = o.y; } else { oq.x = o.x; oq.y = o.y; }
                  o.x = cvt_pk(k0 * e2[0], k1 * e2[1]); o.y = cvt_pk(k2 * e2[2], k3 * e2[3]); *(LAS u32x2*)(L + O_KP + cj * 272 + dk0 * 2) = o;
                  o.x = cvt_pk(k0 * e3[0], k1 * e3[1]); o.y = cvt_pk(k2 * e3[2], k3 * e3[3]);
                  if (hq) { okpp.z = o.x; okpp.w = o.y; } else { okpp.x = o.x; okpp.y = o.y; }
              }
              if (act && !(pv & 1)) { *(u32x4*)(KPPg + (size_t)Uc * 8192 + c * 8) = okpp; if (latent) *(u32x4*)(QPg + (size_t)Uc * 8192 + c * 8) = oq; }
              else asm volatile("" :: "v"(okpp), "v"(oq));
          } }
        __syncthreads();
        if (latent && act && !(pv & 2)) {
            const int ib = wh;
            for (int jb16 = 0; jb16 <= ib; ++jb16) {
                f32x4 d = (f32x4){0.f, 0.f, 0.f, 0.f};
#pragma unroll
                for (int ks = 0; ks < 4; ++ks) {
                    const bf16x8 a = *(const LAS bf16x8*)(L + O_KP + (16 * jb16 + (lane & 15)) * 272 + (32 * ks + 8 * (lane >> 4)) * 2);
                    const bf16x8 bq = *(const LAS bf16x8*)(L + O_QP + (16 * ib + (lane & 15)) * 272 + (32 * ks + 8 * (lane >> 4)) * 2);
                    d = __builtin_amdgcn_mfma_f32_16x16x32_bf16(a, bq, d, 0, 0, 0); }
                const int i = 16 * ib + (lane & 15), j0 = 16 * jb16 + 4 * (lane >> 4);
#pragma unroll
                for (int r = 0; r < 4; ++r) if (j0 + r > i) d[r] = 0.f;
                u32x2 o; o.x = cvt_pk(d[0], d[1]); o.y = cvt_pk(d[2], d[3]);
                if (!(pv & 1)) *(u32x2*)(SCg + (size_t)Uc * 4096 + i * 64 + j0) = o; else asm volatile("" :: "v"(o));
            }
            for (int jb16 = ib + 1; jb16 < 4; ++jb16) { const int i = 16 * ib + (lane & 15), j0 = 16 * jb16 + 4 * (lane >> 4);
                if (!(pv & 1)) *(u32x2*)(SCg + (size_t)Uc * 4096 + i * 64 + j0) = (u32x2){0u, 0u}; }
        }
    }
    __syncthreads();
}
namespace gla {
constexpr int O_EL = 0, O_QP = 512, O_KPP = 17920, O_V = 38400, O_SC = 50688, IMG_BYTES = 59904, O_ST = 2 * IMG_BYTES;
constexpr int P_QP = 272, P_KPP = 320, P_V = 192, P_SC = 144, P_ST = 272, ST_BYTES = 64 * 272;
__device__ __forceinline__ bf16x8 tr8(LAS unsigned char* p0, LAS unsigned char* p1) {
    const s16x4 a = __builtin_amdgcn_ds_read_tr16_b64_v4i16((LAS s16x4*)p0);
    const s16x4 b = __builtin_amdgcn_ds_read_tr16_b64_v4i16((LAS s16x4*)p1);
    return (bf16x8){a[0], a[1], a[2], a[3], b[0], b[1], b[2], b[3]};
}
}
__device__ __forceinline__ void p_gla(const Ctx& C, const int probe = 0) {
    PH_IDS;
    using namespace gla;
    LAS unsigned char* L = C.lds;
    const int t = tid, w = wave;
    const bf16* Vg = (const bf16*)(C.ws + WS_V);
    const bf16* QPg = (const bf16*)(C.ws + WS_GQP); const bf16* KPPg = (const bf16*)(C.ws + WS_GKPP); const bf16* SCg = (const bf16*)(C.ws + WS_GSC); const float* ELg = (const float*)(C.ws + WS_GEL);
    for (int it = blockIdx.x; it < 256; it += C.G) {
        const int xx = it & 7, jj_ = it >> 3, scan = xx * 8 + (jj_ >> 2), dvs = jj_ & 3;
        const int bt = scan >> 3, hd = (scan >> 1) & 3, dir = scan & 1;
        const int ubase = ((dir * 4 + hd) * 8 + bt) * 132;
        bf16* Og = (bf16*)(C.ws + (probe ? WS_HN : (dir ? WS_OB : WS_OF)));
        __syncthreads();
        for (int i = t; i < ST_BYTES / 16; i += 512) *(LAS u32x4*)(L + O_ST + i * 16) = (u32x4){0u, 0u, 0u, 0u};
        f32x16 S;
#pragma unroll
        for (int i = 0; i < 16; ++i) S[i] = 0.f;
        const int lj = t >> 3, part = t & 7;
        u32x4 rsc, rqp0, rqp1, rkp0, rkp1, rv; f32x4 rel;
        u32x4 nsc, nqp0, nqp1, nkp0, nkp1, nv; f32x4 nel;
        auto load_step = [&](int s_) {
            const int s = probe ? 4 + (s_ & 1) : s_;
            const size_t U = (size_t)(ubase + s);
            const int row = gla_row(bt, dir, s, lj);
            nv = *(const u32x4*)(Vg + (size_t)row * 1024 + hd * 256 + dvs * 64 + part * 8);
            const bf16* kp = KPPg + U * 8192 + t * 8; nkp0 = *(const u32x4*)kp; nkp1 = *(const u32x4*)(kp + 4096);
            if (t < 32) nel = *(const f32x4*)(ELg + U * 128 + t * 4);
            if (s >= 4) { const bf16* qp = QPg + U * 8192 + t * 8; nqp0 = *(const u32x4*)qp; nqp1 = *(const u32x4*)(qp + 4096);
                nsc = *(const u32x4*)(SCg + U * 4096 + lj * 64 + part * 8); } };
        auto shift_regs = [&]() { rsc = nsc; rqp0 = nqp0; rqp1 = nqp1; rkp0 = nkp0; rkp1 = nkp1; rv = nv; rel = nel; };
        auto write_images = [&](int s, int ib_) {
            LAS unsigned char* I = L + ib_ * IMG_BYTES;
            *(LAS u32x4*)(I + O_V + lj * P_V + part * 16) = rv;
            *(LAS u32x4*)(I + O_KPP + (t >> 4) * P_KPP + (t & 15) * 16) = rkp0; *(LAS u32x4*)(I + O_KPP + (32 + (t >> 4)) * P_KPP + (t & 15) * 16) = rkp1;
            if (t < 32) *(LAS f32x4*)(I + O_EL + t * 16) = rel;
            if (s >= 4) { *(LAS u32x4*)(I + O_QP + (t >> 4) * P_QP + (t & 15) * 16) = rqp0; *(LAS u32x4*)(I + O_QP + (32 + (t >> 4)) * P_QP + (t & 15) * 16) = rqp1;
                *(LAS u32x4*)(I + O_SC + lj * P_SC + part * 16) = rsc; } };
        load_step(0); shift_regs(); write_images(0, 0);
        load_step(1); shift_regs();
        load_step(2);
        for (int s = 0; s < 132; ++s) {
            const int cur = s & 1, nx = cur ^ 1;
            const bool latent = (s >= 4);
            LAS unsigned char* I = L + cur * IMG_BYTES;
            __syncthreads();
            if (s + 1 < 132) write_images(s + 1, nx);
            shift_regs();
            if (s + 3 < 132) load_step(s + 3);
            if (latent) {
                const int ib = w >> 1;
                const int g4 = lane >> 4, q4 = (lane & 15) >> 2, p4 = lane & 3;
                const int orow = gla_row(bt, dir, s, 16 * ib + (lane & 15));
#pragma unroll
                for (int cc = 0; cc < 2; ++cc) {
                    const int c = 2 * (w & 1) + cc;
                    f32x4 d = (f32x4){0.f, 0.f, 0.f, 0.f};
#pragma unroll
                    for (int ks = 0; ks < 2; ++ks) {
                        LAS unsigned char* pa = I + O_V + (32 * ks + 8 * g4 + q4) * P_V + (16 * c + 4 * p4) * 2;
                        const bf16x8 a = gla::tr8(pa, pa + 4 * P_V);
                        const bf16x8 b = *(const LAS bf16x8*)(I + O_SC + (16 * ib + (lane & 15)) * P_SC + (32 * ks + 8 * g4) * 2);
                        d = __builtin_amdgcn_mfma_f32_16x16x32_bf16(a, b, d, 0, 0, 0); }
#pragma unroll
                    for (int ks = 0; ks < 4; ++ks) {
                        const bf16x8 a = *(const LAS bf16x8*)(L + O_ST + cur * ST_BYTES + (16 * c + (lane & 15)) * P_ST + (32 * ks + 8 * g4) * 2);
                        const bf16x8 b = *(const LAS bf16x8*)(I + O_QP + (16 * ib + (lane & 15)) * P_QP + (32 * ks + 8 * g4) * 2);
                        d = __builtin_amdgcn_mfma_f32_16x16x32_bf16(a, b, d, 0, 0, 0); }
                    u32x2 o; o.x = cvt_pk(d[0], d[1]); o.y = cvt_pk(d[2], d[3]);
                    *(u32x2*)(Og + (size_t)orow * 1024 + hd * 256 + dvs * 64 + 16 * c + 4 * g4) = o;
                }
            }
            { const int dbS = w & 3, dvb = w >> 2, hh = lane >> 5, blk = (lane >> 4) & 1, q4 = (lane & 15) >> 2, p4 = lane & 3;
#pragma unroll
              for (int g = 0; g < 4; ++g) { const f32x4 el = *(const LAS f32x4*)(I + O_EL + (32 * dbS + 8 * g + 4 * hh) * 4);
#pragma unroll
                  for (int i = 0; i < 4; ++i) S[4 * g + i] *= el[i]; }
#pragma unroll
              for (int ks = 0; ks < 4; ++ks) {
                  LAS unsigned char* pa = I + O_KPP + (16 * ks + 8 * hh + q4) * P_KPP + (32 * dbS + 16 * blk + 4 * p4) * 2;
                  LAS unsigned char* pb = I + O_V + (16 * ks + 8 * hh + q4) * P_V + (32 * dvb + 16 * blk + 4 * p4) * 2;
                  const bf16x8 a = gla::tr8(pa, pa + 4 * P_KPP);
                  const bf16x8 b = gla::tr8(pb, pb + 4 * P_V);
                  S = __builtin_amdgcn_mfma_f32_32x32x16_bf16(a, b, S, 0, 0, 0); }
#pragma unroll
              for (int g = 0; g < 4; ++g) { u32x2 o; o.x = cvt_pk(S[4 * g], S[4 * g + 1]); o.y = cvt_pk(S[4 * g + 2], S[4 * g + 3]);
                  *(LAS u32x2*)(L + O_ST + nx * ST_BYTES + (32 * dvb + (lane & 31)) * P_ST + (32 * dbS + 8 * g + 4 * hh) * 2) = o; } }
        }
    }
}

__device__ __forceinline__ void p_fft1(const Ctx& C) {
    PH_IDS;
    LAS unsigned char* L = C.lds;
    const int t = tid, w = wave, mb = w & 3, nh = w >> 2, hh = lane >> 5;
    const bf16* F1 = (const bf16*)(C.ws + WS_F1);
    bf16x8 af[8];
#pragma unroll
    for (int ks = 0; ks < 8; ++ks) af[ks] = *(const bf16x8*)(F1 + (32 * mb + (lane & 31)) * 128 + 16 * ks + 8 * hh);
    const bf16* ZZ = (const bf16*)(C.ws + WS_ZC);
    bf16* YR = (bf16*)(C.ws + WS_YR); bf16* YI = (bf16*)(C.ws + WS_YI);
    const int blk = (lane >> 4) & 1, q4 = (lane & 15) >> 2, p4 = lane & 3;
    constexpr int RAWB = 73728;
    u32x4 pv[4];
    auto fetch1 = [&](int unit) { const int bt = unit >> 8, b = (unit >> 1) & 127, chh = unit & 1; const int a = t >> 3, part = t & 7;
        const bf16* src = ZZ + (size_t)(bt * SEQ + 128 * a + b) * 512 + chh * 256 + part * 32;
#pragma unroll
        for (int i = 0; i < 4; ++i) pv[i] = *(const u32x4*)(src + 8 * i); };
    if ((int)blockIdx.x < 2048) fetch1(blockIdx.x);
    for (int unit = blockIdx.x; unit < 2048; unit += C.G) {
        const int bt = unit >> 8, b = (unit >> 1) & 127, chh = unit & 1;
        __syncthreads();
        { const int a = t >> 3, part = t & 7;
#pragma unroll
          for (int i = 0; i < 4; ++i) *(LAS u32x4*)(L + RAWB + a * 528 + part * 64 + i * 16) = pv[i]; }
        __syncthreads();
        { const int row = t >> 2, quarter = t & 3, pin = row >> 6, a = row & 63, gl = quarter >> 1, half = quarter & 1;
          const LAS unsigned char* rp = L + RAWB + a * 528 + gl * 256;
#pragma unroll
          for (int ci = 0; ci < 8; ++ci) { unsigned wv[4];
#pragma unroll
              for (int j = 0; j < 8; ++j) { const int e = 8 * ci + j;
                  const int col = pin ? (half ? 128 - e : 64 + e) : (half ? (e == 0 ? 64 : 64 - e) : e);
                  unsigned v = (unsigned)*(const LAS unsigned short*)(rp + (col & 127) * 2);
                  if (pin && half) v ^= 0x8000u;
                  if (pin && e == 0) v = 0u;
                  if (j & 1) wv[j >> 1] |= v << 16; else wv[j >> 1] = v; }
              *(LAS u32x4*)(L + row * 576 + quarter * 128 + ci * 16) = (u32x4){wv[0], wv[1], wv[2], wv[3]}; } }
        __syncthreads();
        if (unit + C.G < 2048) fetch1(unit + C.G);
#pragma unroll 1
        for (int nb = 0; nb < 4; ++nb) {
            const int c = 4 * nh + nb;
            f32x16 acc;
#pragma unroll
            for (int i = 0; i < 16; ++i) acc[i] = 0.f;
#pragma unroll
            for (int ks = 0; ks < 8; ++ks) {
                LAS unsigned char* pb = L + (16 * ks + 8 * hh + q4) * 576 + (32 * c + 16 * blk + 4 * p4) * 2;
                const bf16x8 bfr = gla::tr8(pb, pb + 4 * 576);
                acc = __builtin_amdgcn_mfma_f32_32x32x16_bf16(af[ks], bfr, acc, 0, 0, 0); }
#pragma unroll
            for (int gp = 0; gp < 2; ++gp)
#pragma unroll
                for (int i = 0; i < 4; ++i) { const int ap = 16 * mb + 8 * gp + 4 * hh + i; const float re = acc[8 * gp + i], im = acc[8 * gp + 4 + i];
                    const float ph = (float)((b * ap) & 8191) * (1.0f / 8192.0f); const float cs = __builtin_amdgcn_cosf(ph), sn = __builtin_amdgcn_sinf(ph);
                    const int so = ap * 528 + (32 * c + (lane & 31)) * 2;
                    *(LAS unsigned short*)(L + 73728 + so) = (unsigned short)f2bf(re * cs + im * sn);
                    *(LAS unsigned short*)(L + 73728 + 64 * 528 + so) = (unsigned short)f2bf(im * cs - re * sn); }
        }
        __syncthreads();
        { const int orow = t >> 2, quarter = t & 3, plane = orow >> 6, ap = orow & 63;
          bf16* dst = (plane ? YI : YR) + ((size_t)(bt * 64 + ap) * 128 + b) * 512 + chh * 256 + quarter * 64;
#pragma unroll
          for (int i = 0; i < 8; ++i) *(u32x4*)(dst + 8 * i) = *(const LAS u32x4*)(L + 73728 + orow * 528 + quarter * 128 + i * 16); }
    }
    __syncthreads();
}
__device__ __forceinline__ void p_fft2(const Ctx& C) {
    PH_IDS;
    LAS unsigned char* L = C.lds;
    const int t = tid, w = wave, mb = w & 3, nh = w >> 2, hh = lane >> 5;
    const bf16* F2 = (const bf16*)(C.ws + WS_F2);
    bf16x8 af[16];
#pragma unroll
    for (int ks = 0; ks < 16; ++ks) af[ks] = *(const bf16x8*)(F2 + (32 * mb + (lane & 31)) * 256 + 16 * ks + 8 * hh);
    const bf16* YR = (const bf16*)(C.ws + WS_YR); const bf16* YI = (const bf16*)(C.ws + WS_YI);
    unsigned char* A2 = (unsigned char*)(C.ws + WS_A2);
    const int blk = (lane >> 4) & 1, q4 = (lane & 15) >> 2, p4 = lane & 3;
    u32x4 pv[8];
    auto fetch2 = [&](int unit) { const int bt = unit >> 8, ap = (unit >> 2) & 63, cht = unit & 3; const int row = t >> 1, half = t & 1, pin = row >> 7, b = row & 127;
        const bf16* src = (pin ? YI : YR) + ((size_t)(bt * 64 + ap) * 128 + b) * 512 + cht * 128 + half * 64;
#pragma unroll
        for (int i = 0; i < 8; ++i) pv[i] = *(const u32x4*)(src + 8 * i); };
    if ((int)blockIdx.x < 2048) fetch2(blockIdx.x);
    for (int unit = blockIdx.x; unit < 2048; unit += C.G) {
        const int bt = unit >> 8, ap = (unit >> 2) & 63, cht = unit & 3;
        __syncthreads();
        { const int row = t >> 1, half = t & 1;
#pragma unroll
          for (int i = 0; i < 8; ++i) *(LAS u32x4*)(L + row * 320 + half * 128 + i * 16) = pv[i]; }
        __syncthreads();
        if (unit + C.G < 2048) fetch2(unit + C.G);
#pragma unroll 1
        for (int nb = 0; nb < 2; ++nb) {
            const int c = 2 * nh + nb;
            f32x16 acc;
#pragma unroll
            for (int i = 0; i < 16; ++i) acc[i] = 0.f;
#pragma unroll
            for (int ks = 0; ks < 16; ++ks) {
                LAS unsigned char* pb = L + (16 * ks + 8 * hh + q4) * 320 + (32 * c + 16 * blk + 4 * p4) * 2;
                const bf16x8 bfr = gla::tr8(pb, pb + 4 * 320);
                acc = __builtin_amdgcn_mfma_f32_32x32x16_bf16(af[ks], bfr, acc, 0, 0, 0); }
#pragma unroll
            for (int r = 0; r < 16; ++r) { const int bp = 32 * mb + (r & 3) + 8 * (r >> 2) + 4 * hh;
                if (F8_OUT0) *(LAS unsigned char*)(L + 81920 + bp * 144 + 32 * c + (lane & 31)) = (unsigned char)(pk4_fp8(acc[r], 0.f, 0.f, 0.f, 8.0f / 1024.0f) & 0xffu);
                else *(LAS unsigned short*)(L + 81920 + bp * 272 + (32 * c + (lane & 31)) * 2) = (unsigned short)f2bf(acc[r] * (1.0f / 1024.0f)); }
        }
        __syncthreads();
        { const int bp = t >> 2, quarter = t & 3; const size_t tok = (size_t)bt * SEQ + ap + 64 * bp;
          if (F8_OUT0) { unsigned char* dst = A2 + tok * 1536 + 1024 + cht * 128 + quarter * 32;
#pragma unroll
              for (int i = 0; i < 2; ++i) *(u32x4*)(dst + 16 * i) = *(const LAS u32x4*)(L + 81920 + bp * 144 + quarter * 32 + i * 16); }
          else { bf16* dst = (bf16*)A2 + tok * 1536 + 1024 + cht * 128 + quarter * 32;
#pragma unroll
              for (int i = 0; i < 4; ++i) *(u32x4*)(dst + 8 * i) = *(const LAS u32x4*)(L + 81920 + bp * 272 + quarter * 64 + i * 16); } }
    }
    __syncthreads();
}
__device__ __forceinline__ void p_gla_out(const Ctx& C) {
    PH_IDS;
    const int gw = blockIdx.x * 8 + wave, NGW = C.G * 8;
    const bf16* OF = (const bf16*)(C.ws + WS_OF); const bf16* OB = (const bf16*)(C.ws + WS_OB); const bf16* Rg = (const bf16*)(C.ws + WS_R);
    unsigned char* A2 = (unsigned char*)(C.ws + WS_A2);
    float gn[16];
#pragma unroll
    for (int i = 0; i < 16; ++i) gn[i] = C.a->in[IN_EVGNORM][16 * (lane & 15) + i];
    for (int r = gw; r < MTOK; r += NGW) {
        const u32x4 f0 = *(const u32x4*)(OF + (size_t)r * 1024 + 16 * lane), f1 = *(const u32x4*)(OF + (size_t)r * 1024 + 16 * lane + 8);
        const u32x4 b0 = *(const u32x4*)(OB + (size_t)r * 1024 + 16 * lane), b1 = *(const u32x4*)(OB + (size_t)r * 1024 + 16 * lane + 8);
        const u32x4 g0 = *(const u32x4*)(Rg + (size_t)r * 1024 + 16 * lane), g1 = *(const u32x4*)(Rg + (size_t)r * 1024 + 16 * lane + 8);
        float o[16], rr[16];
#pragma unroll
        for (int i = 0; i < 4; ++i) { const unsigned fa = f0[i], fb = f1[i], ba = b0[i], bb = b1[i], ga = g0[i], gb = g1[i];
            o[2 * i] = bf_lo(fa) + bf_lo(ba); o[2 * i + 1] = bf_hi(fa) + bf_hi(ba); o[8 + 2 * i] = bf_lo(fb) + bf_lo(bb); o[8 + 2 * i + 1] = bf_hi(fb) + bf_hi(bb);
            rr[2 * i] = bf_lo(ga); rr[2 * i + 1] = bf_hi(ga); rr[8 + 2 * i] = bf_lo(gb); rr[8 + 2 * i + 1] = bf_hi(gb); }
        float ss = 0.f;
#pragma unroll
        for (int i = 0; i < 16; ++i) ss += o[i] * o[i];
        ss = row16_sum(ss);
        const float rstd = rsqrtf(ss * (1.0f / 256.0f) + EPS);
        float y[16];
#pragma unroll
        for (int i = 0; i < 16; ++i) y[i] = o[i] * rstd * gn[i] * siluf_(rr[i]);
        if (F8_OUT0) *(u32x4*)(A2 + (size_t)r * 1536 + 16 * lane) = (u32x4){pk4_fp8(y[0], y[1], y[2], y[3], 8.f), pk4_fp8(y[4], y[5], y[6], y[7], 8.f), pk4_fp8(y[8], y[9], y[10], y[11], 8.f), pk4_fp8(y[12], y[13], y[14], y[15], 8.f)};
        else { bf16* a2 = (bf16*)A2 + (size_t)r * 1536 + 16 * lane;
            *(u32x4*)a2 = (u32x4){cvt_pk(y[0], y[1]), cvt_pk(y[2], y[3]), cvt_pk(y[4], y[5]), cvt_pk(y[6], y[7])}; *(u32x4*)(a2 + 8) = (u32x4){cvt_pk(y[8], y[9]), cvt_pk(y[10], y[11]), cvt_pk(y[12], y[13]), cvt_pk(y[14], y[15])}; }
    }
}

__device__ __forceinline__ void p_postmix(const Ctx& C, const int layer) {
    PH_IDS;
    LAS float* WR = (LAS float*)C.lds;
    LAS int* hist = (LAS int*)(C.lds + 131072);
    LAS float* Lg = (LAS float*)(C.lds + 131584 + wave * 2112);
    const float* rw = C.a->in[IN_RW] + (size_t)layer * 1024 * 32;
    __syncthreads();
    for (int it0 = 0; it0 < 64; it0 += 16) {
        float tmpw[16];
#pragma unroll
        for (int q = 0; q < 16; ++q) tmpw[q] = rw[tid + 512 * (it0 + q)];
#pragma unroll
        for (int q = 0; q < 16; ++q) { const int idx = tid + 512 * (it0 + q); const int c = idx >> 5, e = idx & 31; const int ln = (c & 255) >> 2, j = c >> 8, i = c & 3;
            WR[(((j * 4 + i) * 8 + (e >> 2)) * 64 + ln) * 4 + (e & 3)] = tmpw[q]; } }
    if (tid < 32) hist[tid] = 0;
    __syncthreads();
    const float* MOD = (const float*)(C.ws + WS_MOD) + (size_t)layer * 9 * 6144;
    const float* gpost = C.a->in[IN_NMPOST] + layer * 1024; const float* gffn = C.a->in[IN_NFPRE] + layer * 1024;
    const bf16* Y = (const bf16*)(C.ws + WS_Y);
    const float* xin = C.a->in[IN_X];
    bf16* XS = (bf16*)(C.ws + WS_XS);
    unsigned char* H2 = (unsigned char*)(C.ws + WS_H2);
    int* TK = (int*)(C.ws + WS_TOPK); float* GT = (float*)(C.ws + WS_GATE);
    const int rows_per_blk = MTOK / C.G, rows_per_wave = rows_per_blk / 8;
    const int r0 = blockIdx.x * rows_per_blk + wave * rows_per_wave;
    const int b = r0 >> 13;
    const float rbias = C.a->in[IN_RB][layer * 32 + ((lane >> 1) & 31)];
    float cA1[16], cA2[16], cB2[16];
#pragma unroll
    for (int j = 0; j < 4; ++j) { const int c = 4 * lane + 256 * j;
        const f32x4 gp = *(const f32x4*)(gpost + c), gm = *(const f32x4*)(MOD + (size_t)b * 6144 + 2048 + c);
        const f32x4 gf = *(const f32x4*)(gffn + c), sc = *(const f32x4*)(MOD + (size_t)b * 6144 + 4096 + c), sh = *(const f32x4*)(MOD + (size_t)b * 6144 + 3072 + c);
#pragma unroll
        for (int i = 0; i < 4; ++i) { cA1[4 * j + i] = gp[i] * gm[i]; cA2[4 * j + i] = gf[i] * (1.0f + sc[i]); cB2[4 * j + i] = sh[i]; } }
    auto ldx = [&](int r, int j) -> f32x4 {
        if (layer == 0) return *(const f32x4*)(xin + (size_t)r * 1024 + 4 * lane + 256 * j);
        const u32x2 v = *(const u32x2*)(XS + (size_t)r * 1024 + 4 * lane + 256 * j); return (f32x4){bf_lo(v.x), bf_hi(v.x), bf_lo(v.y), bf_hi(v.y)}; };
    u32x2 ny[4]; f32x4 nx[4];
#pragma unroll
    for (int j = 0; j < 4; ++j) { ny[j] = *(const u32x2*)(Y + (size_t)r0 * 1024 + 4 * lane + 256 * j); nx[j] = ldx(r0, j); }
    for (int r = r0; r < r0 + rows_per_wave; ++r) {
        float h[16];
        u32x2 cy[4]; f32x4 cx[4];
#pragma unroll
        for (int j = 0; j < 4; ++j) { cy[j] = ny[j]; cx[j] = nx[j]; }
        if (r + 1 < r0 + rows_per_wave) {
#pragma unroll
            for (int j = 0; j < 4; ++j) { ny[j] = *(const u32x2*)(Y + (size_t)(r + 1) * 1024 + 4 * lane + 256 * j); nx[j] = ldx(r + 1, j); } }
        { float ssy = 0.f; float yv[16];
#pragma unroll
          for (int j = 0; j < 4; ++j) { const u32x2 yy = cy[j];
              yv[4 * j] = bf_lo(yy.x); yv[4 * j + 1] = bf_hi(yy.x); yv[4 * j + 2] = bf_lo(yy.y); yv[4 * j + 3] = bf_hi(yy.y); }
#pragma unroll
          for (int i = 0; i < 16; ++i) ssy += yv[i] * yv[i];
          const float rstd = rsqrtf(wave_sum(ssy) * (1.0f / 1024.0f) + EPS);
          float ss1 = 0.f;
#pragma unroll
          for (int j = 0; j < 4; ++j) { const int c = 4 * lane + 256 * j;
              const f32x4 xv = cx[j];
              f32x4 o;
#pragma unroll
              for (int i = 0; i < 4; ++i) { o[i] = xv[i] + cA1[4 * j + i] * (yv[4 * j + i] * rstd); h[4 * j + i] = o[i]; ss1 += o[i] * o[i]; }
              { u32x2 xw; xw.x = cvt_pk(o[0], o[1]); xw.y = cvt_pk(o[2], o[3]); *(u32x2*)(XS + (size_t)r * 1024 + c) = xw; } }
          const float rstd1 = rsqrtf(wave_sum(ss1) * (1.0f / 1024.0f) + EPS);
#pragma unroll
          for (int j = 0; j < 4; ++j) { const int c = 4 * lane + 256 * j;
#pragma unroll
              for (int i = 0; i < 4; ++i) h[4 * j + i] = h[4 * j + i] * rstd1 * cA2[4 * j + i] + cB2[4 * j + i];
              int wv = 0;
              wv = __builtin_amdgcn_cvt_pk_fp8_f32(fminf(fmaxf(h[4 * j] * 8.0f, -440.f), 440.f), fminf(fmaxf(h[4 * j + 1] * 8.0f, -440.f), 440.f), wv, false);
              wv = __builtin_amdgcn_cvt_pk_fp8_f32(fminf(fmaxf(h[4 * j + 2] * 8.0f, -440.f), 440.f), fminf(fmaxf(h[4 * j + 3] * 8.0f, -440.f), 440.f), wv, true);
              *(int*)(H2 + (size_t)r * 1024 + c) = wv; } }
        float p[32];
#pragma unroll
        for (int e = 0; e < 32; ++e) p[e] = 0.f;
        { f32x4 wb[2][8];
#pragma unroll
          for (int eq = 0; eq < 8; ++eq) wb[0][eq] = *(const LAS f32x4*)(WR + ((0 * 8 + eq) * 64 + lane) * 4);
#pragma unroll
          for (int jj = 0; jj < 16; ++jj) {
              if (jj + 1 < 16) {
#pragma unroll
                  for (int eq = 0; eq < 8; ++eq) wb[(jj + 1) & 1][eq] = *(const LAS f32x4*)(WR + (((jj + 1) * 8 + eq) * 64 + lane) * 4); }
#pragma unroll
              for (int eq = 0; eq < 8; ++eq)
#pragma unroll
                  for (int i = 0; i < 4; ++i) p[4 * eq + i] += h[jj] * wb[jj & 1][eq][i];
              asm volatile("" ::: "memory"); } }
        float q16[16], q8[8], q4v[4], q2[2], q1;
#pragma unroll
        for (int k = 0; k < 16; ++k) q16[k] = swap32_sum(p[k], p[16 + k]);
#pragma unroll
        for (int k = 0; k < 8; ++k) q8[k] = swap16_sum(q16[k], q16[8 + k]);
        { const bool hi = (lane & 8) != 0;
#pragma unroll
          for (int k = 0; k < 4; ++k) { const float send = hi ? q8[k] : q8[4 + k], keep = hi ? q8[4 + k] : q8[k];
              q4v[k] = keep + __builtin_bit_cast(float, __builtin_amdgcn_update_dpp(0, __builtin_bit_cast(int, send), 0x128, 0xF, 0xF, true)); } }
        { const bool hi = (lane & 4) != 0;
#pragma unroll
          for (int k = 0; k < 2; ++k) { const float send = hi ? q4v[k] : q4v[2 + k], keep = hi ? q4v[2 + k] : q4v[k];
              int rv = __builtin_amdgcn_update_dpp(0, __builtin_bit_cast(int, send), 0x104, 0xF, 0x5, false);
              rv = __builtin_amdgcn_update_dpp(rv, __builtin_bit_cast(int, send), 0x114, 0xF, 0xA, false);
              q2[k] = keep + __builtin_bit_cast(float, rv); } }
        { const bool hi = (lane & 2) != 0; const float send = hi ? q2[0] : q2[1], keep = hi ? q2[1] : q2[0];
          q1 = keep + __builtin_bit_cast(float, __builtin_amdgcn_update_dpp(0, __builtin_bit_cast(int, send), 0x4E, 0xF, 0xF, true)); }
        q1 += __builtin_bit_cast(float, __builtin_amdgcn_update_dpp(0, __builtin_bit_cast(int, q1), 0xB1, 0xF, 0xF, true));
        const int rl = (r - r0) & 15;
        if (!(lane & 1)) Lg[rl * 33 + (lane >> 1)] = q1 + rbias;
        if (rl == 15) {
            asm volatile("s_waitcnt lgkmcnt(0)" ::: "memory");
            if (lane < 16) {
                float v0 = -3.0e38f, v1 = -3.0e38f, v2 = -3.0e38f, v3 = -3.0e38f; int i0 = 0, i1 = 0, i2 = 0, i3 = 0;
#pragma unroll
                for (int e = 0; e < 32; ++e) { const float x = Lg[lane * 33 + e];
                    const bool c0 = x > v0, c1 = x > v1, c2 = x > v2, c3 = x > v3;
                    v3 = c3 ? (c2 ? v2 : x) : v3; i3 = c3 ? (c2 ? i2 : e) : i3;
                    v2 = c2 ? (c1 ? v1 : x) : v2; i2 = c2 ? (c1 ? i1 : e) : i2;
                    v1 = c1 ? (c0 ? v0 : x) : v1; i1 = c1 ? (c0 ? i0 : e) : i1;
                    v0 = c0 ? x : v0; i0 = c0 ? e : i0; }
                const float e1 = __expf(v1 - v0), e2 = __expf(v2 - v0), e3 = __expf(v3 - v0); const float inv = 1.0f / (1.0f + e1 + e2 + e3);
                const int rr = r - 15 + lane;
                *(int4*)(TK + (size_t)rr * 4) = make_int4(i0, i1, i2, i3); *(f32x4*)(GT + (size_t)rr * 4) = (f32x4){inv, e1 * inv, e2 * inv, e3 * inv};
                __hip_atomic_fetch_add(&hist[i0], 1, __ATOMIC_RELAXED, __HIP_MEMORY_SCOPE_WORKGROUP); __hip_atomic_fetch_add(&hist[i1], 1, __ATOMIC_RELAXED, __HIP_MEMORY_SCOPE_WORKGROUP);
                __hip_atomic_fetch_add(&hist[i2], 1, __ATOMIC_RELAXED, __HIP_MEMORY_SCOPE_WORKGROUP); __hip_atomic_fetch_add(&hist[i3], 1, __ATOMIC_RELAXED, __HIP_MEMORY_SCOPE_WORKGROUP);
            }
            asm volatile("s_waitcnt lgkmcnt(0)" ::: "memory");
        }
    }
    __syncthreads();
    if (tid < 32) ((int*)(C.ws + WS_CNTBLK))[blockIdx.x * 32 + tid] = hist[tid];
    __syncthreads();
}
__device__ __forceinline__ void p_assign(const Ctx& C) {
    PH_IDS;
    LAS int* red = (LAS int*)C.lds;
    LAS int* base = (LAS int*)(C.lds + 4096);
    LAS int* total = (LAS int*)(C.lds + 4224);
    LAS int* segrow = (LAS int*)(C.lds + 4352);
    LAS int* run = (LAS int*)(C.lds + 4608);
    const int* cnt = (const int*)(C.ws + WS_CNTBLK);
    const int b = blockIdx.x;
    __syncthreads();
    { const int e = tid & 31, part = tid >> 5; int slt = 0, sall = 0;
      int vv[16];
#pragma unroll
      for (int q = 0; q < 16; ++q) vv[q] = __hip_atomic_load(cnt + (part * 16 + q) * 32 + e, __ATOMIC_RELAXED, __HIP_MEMORY_SCOPE_AGENT);
#pragma unroll
      for (int q = 0; q < 16; ++q) { sall += vv[q]; if (part * 16 + q < b) slt += vv[q]; }
      red[part * 32 + e] = slt; red[512 + part * 32 + e] = sall; }
    __syncthreads();
    if (tid < 32) { int s0 = 0, s1 = 0;
#pragma unroll
        for (int q = 0; q < 16; ++q) { s0 += red[q * 32 + tid]; s1 += red[512 + q * 32 + tid]; }
        base[tid] = s0; total[tid] = s1; run[tid] = 0; }
    __syncthreads();
    if (tid == 0) { int acc = 0; for (int e = 0; e < 32; ++e) { segrow[e] = acc * 256; if (b == 0) ((int*)(C.ws + WS_MOEINFO))[e] = acc; acc += (total[e] + 255) >> 8; } segrow[32] = acc * 256; if (b == 0) ((int*)(C.ws + WS_MOEINFO))[32] = acc; }
    __syncthreads();
    int* SP = (int*)(C.ws + WS_SLOTPOS); int* ST = (int*)(C.ws + WS_SLOTTOK); int* SD = (int*)(C.ws + WS_SLOTDST); const int* TK = (const int*)(C.ws + WS_TOPK);
    const int rows_per_blk = MTOK / C.G;
    LAS int* gc = (LAS int*)(C.lds + 5120);
    int ge[2], grk[2], grow[2];
#pragma unroll
    for (int q = 0; q < 2; ++q) {
        const int g = 2 * wave + q, sidx = g * 64 + lane; grow[q] = b * rows_per_blk + (sidx >> 2);
        ge[q] = TK[(size_t)grow[q] * 4 + (sidx & 3)];
        int rk = 0, myc = 0;
        for (int ee = 0; ee < 32; ++ee) { const unsigned long long m = __ballot(ge[q] == ee);
            if (ge[q] == ee) rk = __popcll(m & ((1ull << lane) - 1ull));
            if (lane == ee) myc = __popcll(m); }
        grk[q] = rk;
        if (lane < 32) gc[g * 32 + lane] = myc;
    }
    __syncthreads();
#pragma unroll
    for (int q = 0; q < 2; ++q) {
        const int g = 2 * wave + q, sidx = g * 64 + lane; int off = 0;
        for (int gp = 0; gp < g; ++gp) off += gc[gp * 32 + ge[q]];
        const int pos = segrow[ge[q]] + base[ge[q]] + off + grk[q];
        SP[(size_t)grow[q] * 4 + (sidx & 3)] = pos; ST[pos] = grow[q]; SD[pos] = grow[q] * 4 + (sidx & 3);
    }
    if (b < 32) { const int e = b, tot = total[e], first = segrow[e] + tot, last = segrow[e + 1];
        for (int p = first + tid; p < last; p += 512) { ST[p] = 0; SD[p] = MTOK * 4 + (p & 255); } }
    __syncthreads();
}

__device__ __forceinline__ void p_combine(const Ctx& C, const int layer) {
    PH_IDS;
    const int gw = blockIdx.x * 8 + wave, NGW = C.G * 8;
    const int per = MTOK / NGW;
    const float* MOD = (const float*)(C.ws + WS_MOD) + (size_t)layer * 9 * 6144;
    const float* MODN = (const float*)(C.ws + WS_MOD) + (size_t)9 * 6144;
    const float* gpost = C.a->in[IN_NFPOST] + layer * 1024; const float* gpre1 = C.a->in[IN_NMPRE] + 1024;
    const unsigned char* YS = (const unsigned char*)(C.ws + WS_YSLOT); const float* GT = (const float*)(C.ws + WS_GATE);
    float* OUT = C.a->out; bf16* XS = (bf16*)(C.ws + WS_XS); unsigned char* HN = (unsigned char*)(C.ws + WS_HN);
    int curb = -1; float cA1[16], cA2[16], cB2[16]; const int vz = vzero();
    const int rbeg = gw * per, rend = gw * per + per;
#define CB_LOAD(GTV, YSV, XV, RR) { GTV = *(const f32x4*)(GT + (size_t)((RR) + vz) * 4); \
        _Pragma("unroll") for (int k = 0; k < 4; ++k) _Pragma("unroll") for (int j = 0; j < 4; ++j) YSV[k][j] = *(const unsigned*)(YS + ((size_t)(RR) * 4 + k) * 1024 + 4 * lane + 256 * j); \
        _Pragma("unroll") for (int j = 0; j < 4; ++j) XV[j] = *(const u32x2*)(XS + (size_t)(RR) * 1024 + 4 * lane + 256 * j); }
    f32x4 ngt, mgt; unsigned nys[4][4], mys[4][4]; u32x2 nxv[4], mxv[4];
    CB_LOAD(ngt, nys, nxv, rbeg);
    CB_LOAD(mgt, mys, mxv, rbeg + 1);
    for (int r = rbeg; r < rend; ++r) {
        const int b = r >> 13;
        if (b != curb) { curb = b;
#pragma unroll
            for (int j = 0; j < 4; ++j) { const int c = 4 * lane + 256 * j;
                const f32x4 gp = *(const f32x4*)(gpost + c), gf = *(const f32x4*)(MOD + (size_t)b * 6144 + 5120 + c);
                const f32x4 gg = *(const f32x4*)(gpre1 + c), sc = *(const f32x4*)(MODN + (size_t)b * 6144 + 1024 + c), sh = *(const f32x4*)(MODN + (size_t)b * 6144 + c);
#pragma unroll
                for (int i = 0; i < 4; ++i) { cA1[4 * j + i] = gp[i] * gf[i]; cA2[4 * j + i] = gg[i] * (1.0f + sc[i]); cB2[4 * j + i] = sh[i]; } } }
        unsigned ys[4][4]; u32x2 xc[4]; const f32x4 gt = ngt;
#pragma unroll
        for (int k = 0; k < 4; ++k)
#pragma unroll
            for (int j = 0; j < 4; ++j) { ys[k][j] = nys[k][j]; nys[k][j] = mys[k][j]; }
#pragma unroll
        for (int j = 0; j < 4; ++j) { xc[j] = nxv[j]; nxv[j] = mxv[j]; }
        ngt = mgt;
        if (r + 2 < rend) CB_LOAD(mgt, mys, mxv, r + 2);
        float f[16];
#pragma unroll
        for (int i = 0; i < 16; ++i) f[i] = 0.f;
#pragma unroll
        for (int k = 0; k < 4; ++k) { const float gk = gt[k] * 0.0625f;
#pragma unroll
            for (int j = 0; j < 4; ++j) { const f32v2_t lo = __builtin_amdgcn_cvt_pk_f32_fp8((int)ys[k][j], false), hi = __builtin_amdgcn_cvt_pk_f32_fp8((int)ys[k][j], true);
                f[4 * j] += gk * lo[0]; f[4 * j + 1] += gk * lo[1]; f[4 * j + 2] += gk * hi[0]; f[4 * j + 3] += gk * hi[1]; } }
        float ss = 0.f;
#pragma unroll
        for (int i = 0; i < 16; ++i) ss += f[i] * f[i];
        const float rstd = rsqrtf(wave_sum(ss) * (1.0f / 1024.0f) + EPS);
        float x2[16]; float ss2 = 0.f;
#pragma unroll
        for (int j = 0; j < 4; ++j) { const int c = 4 * lane + 256 * j;
            const f32x4 xv = (f32x4){bf_lo(xc[j].x), bf_hi(xc[j].x), bf_lo(xc[j].y), bf_hi(xc[j].y)};
            f32x4 o;
#pragma unroll
            for (int i = 0; i < 4; ++i) { o[i] = xv[i] + cA1[4 * j + i] * (f[4 * j + i] * rstd); x2[4 * j + i] = o[i]; ss2 += o[i] * o[i]; }
            if (layer == 0) { u32x2 xw; xw.x = cvt_pk(o[0], o[1]); xw.y = cvt_pk(o[2], o[3]); *(u32x2*)(XS + (size_t)r * 1024 + c) = xw; }
            else *(f32x4*)(OUT + (size_t)r * 1024 + c) = o; }
        if (layer == 0) {
            const float rstd2 = rsqrtf(wave_sum(ss2) * (1.0f / 1024.0f) + EPS);
#pragma unroll
            for (int j = 0; j < 4; ++j) { const int c = 4 * lane + 256 * j;
                float hv[4];
#pragma unroll
                for (int i = 0; i < 4; ++i) hv[i] = x2[4 * j + i] * rstd2 * cA2[4 * j + i] + cB2[4 * j + i];
                if (F8_IN1) *(unsigned*)(HN + (size_t)r * 1024 + c) = pk4_fp8(hv[0], hv[1], hv[2], hv[3], 8.f);
                else *(u32x2*)((bf16*)HN + (size_t)r * 1024 + c) = (u32x2){cvt_pk(hv[0], hv[1]), cvt_pk(hv[2], hv[3])}; }
        }
    }
}

__device__ __forceinline__ void p_conv(const Ctx& C) {
    PH_IDS;
    LAS unsigned char* L = C.lds;
    constexpr int O_X = 0;
    constexpr int O_W = 63488;
    const int w = wave;
    const bf16* GLU = (const bf16*)(C.ws + WS_GLU); const bf16* ZC1 = (const bf16*)(C.ws + WS_ZC1); const bf16* GB = (const bf16*)(C.ws + WS_GB);
    unsigned char* A2 = (unsigned char*)(C.ws + WS_A2B);
    __syncthreads();
    { float tmpw[31];
#pragma unroll
      for (int q = 0; q < 31; ++q) tmpw[q] = C.a->in[IN_ODDW][tid + 512 * q];
#pragma unroll
      for (int q = 0; q < 31; ++q) { const int i = tid + 512 * q; const int tap = i >> 9, c = i & 511; const int ln = c >> 3, half = (c >> 2) & 1, qq = c & 3;
          *(LAS float*)(L + O_W + (((tap * 2 + half) * 64 + ln) * 4 + qq) * 4) = tmpw[q]; } }
    float cb[8], lg[8], lb[8], sw0[8], sw1[8], sw2[8];
#pragma unroll
    for (int i = 0; i < 8; ++i) { const int c = 8 * lane + i; cb[i] = C.a->in[IN_ODDWB][c]; lg[i] = C.a->in[IN_ODLNG][c]; lb[i] = C.a->in[IN_ODLNB][c];
        sw0[i] = C.a->in[IN_ODSCONV][c]; sw1[i] = C.a->in[IN_ODSCONV][512 + c]; sw2[i] = C.a->in[IN_ODSCONV][1024 + c]; }
    u32x4 px[8];
    auto fetchx = [&](int unit) { const int bt = unit >> 8, t0 = (unit & 255) * 32;
#pragma unroll
        for (int q = 0; q < 8; ++q) { const int i = tid + 512 * q; const int rr = i >> 6, cc = i & 63; const int tl = t0 - 15 + rr;
            px[q] = (u32x4){0u, 0u, 0u, 0u};
            if (i < 62 * 64 && tl >= 0 && tl < SEQ) px[q] = *(const u32x4*)(GLU + (size_t)(bt * SEQ + tl) * 512 + cc * 8); } };
    if ((int)blockIdx.x < 2048) fetchx(blockIdx.x);
    for (int unit = blockIdx.x; unit < 2048; unit += C.G) {
        const int bt = unit >> 8, t0 = (unit & 255) * 32;
        __syncthreads();
#pragma unroll
        for (int q = 0; q < 8; ++q) { const int i = tid + 512 * q; if (i < 62 * 64) *(LAS u32x4*)(L + O_X + (i >> 6) * 1024 + (i & 63) * 16) = px[q]; }
        __syncthreads();
        if (unit + C.G < 2048) fetchx(unit + C.G);
        float acc[4][8];
#pragma unroll
        for (int o = 0; o < 4; ++o)
#pragma unroll
            for (int i = 0; i < 8; ++i) acc[o][i] = 0.f;
#pragma unroll 4
        for (int tap = 0; tap < 31; ++tap) {
            const f32x4 w0 = *(const LAS f32x4*)(L + O_W + ((tap * 2 + 0) * 64 + lane) * 16), w1 = *(const LAS f32x4*)(L + O_W + ((tap * 2 + 1) * 64 + lane) * 16);
#pragma unroll
            for (int o = 0; o < 4; ++o) {
                const u32x4 xr = *(const LAS u32x4*)(L + O_X + (4 * w + o + tap) * 1024 + lane * 16);
                acc[o][0] += bf_lo(xr[0]) * w0[0]; acc[o][1] += bf_hi(xr[0]) * w0[1]; acc[o][2] += bf_lo(xr[1]) * w0[2]; acc[o][3] += bf_hi(xr[1]) * w0[3];
                acc[o][4] += bf_lo(xr[2]) * w1[0]; acc[o][5] += bf_hi(xr[2]) * w1[1]; acc[o][6] += bf_lo(xr[3]) * w1[2]; acc[o][7] += bf_hi(xr[3]) * w1[3]; }
        }
        u32x4 sz0[4], sz1[4], sz2[4], sgb[4];
#pragma unroll
        for (int o = 0; o < 4; ++o) { const int tl = t0 + 4 * w + o; const size_t tok = (size_t)bt * SEQ + tl;
            sz1[o] = *(const u32x4*)(ZC1 + tok * 512 + 8 * lane); sz0[o] = (u32x4){0u, 0u, 0u, 0u}; sz2[o] = (u32x4){0u, 0u, 0u, 0u};
            if (tl >= 64) sz0[o] = *(const u32x4*)(ZC1 + (tok - 64) * 512 + 8 * lane);
            if (tl + 64 < SEQ) sz2[o] = *(const u32x4*)(ZC1 + (tok + 64) * 512 + 8 * lane);
            sgb[o] = *(const u32x4*)(GB + tok * 512 + 8 * lane); }
#pragma unroll
        for (int o = 0; o < 4; ++o) {
            const int tl = t0 + 4 * w + o; const size_t tok = (size_t)bt * SEQ + tl;
            float v[8]; float s = 0.f;
#pragma unroll
            for (int i = 0; i < 8; ++i) { v[i] = acc[o][i] + cb[i]; s += v[i]; }
            const float mu = wave_sum(s) * (1.0f / 512.0f); float q = 0.f;
#pragma unroll
            for (int i = 0; i < 8; ++i) { v[i] -= mu; q += v[i] * v[i]; }
            const float rstd = rsqrtf(wave_sum(q) * (1.0f / 512.0f) + EPS);
            float y[8];
#pragma unroll
            for (int i = 0; i < 8; ++i) y[i] = siluf_(v[i] * rstd * lg[i] + lb[i]);
            if (F8_OUT1) *(u32x2*)(A2 + tok * 1024 + 8 * lane) = (u32x2){pk4_fp8(y[0], y[1], y[2], y[3], 4.f), pk4_fp8(y[4], y[5], y[6], y[7], 4.f)};
            else *(u32x4*)((bf16*)A2 + tok * 1024 + 8 * lane) = (u32x4){cvt_pk(y[0], y[1]), cvt_pk(y[2], y[3]), cvt_pk(y[4], y[5]), cvt_pk(y[6], y[7])};
            const u32x4 z1 = sz1[o], z0 = sz0[o], z2 = sz2[o], gb = sgb[o];
            float zz[8];
#pragma unroll
            for (int i = 0; i < 4; ++i) {
                zz[2 * i] = (sw0[2 * i] * bf_lo(z0[i]) + sw1[2 * i] * bf_lo(z1[i]) + sw2[2 * i] * bf_lo(z2[i])) * bf_lo(gb[i]);
                zz[2 * i + 1] = (sw0[2 * i + 1] * bf_hi(z0[i]) + sw1[2 * i + 1] * bf_hi(z1[i]) + sw2[2 * i + 1] * bf_hi(z2[i])) * bf_hi(gb[i]); }
            if (F8_OUT1) *(u32x2*)(A2 + tok * 1024 + 512 + 8 * lane) = (u32x2){pk4_fp8(zz[0], zz[1], zz[2], zz[3], 4.f), pk4_fp8(zz[4], zz[5], zz[6], zz[7], 4.f)};
            else *(u32x4*)((bf16*)A2 + tok * 1024 + 512 + 8 * lane) = (u32x4){cvt_pk(zz[0], zz[1]), cvt_pk(zz[2], zz[3]), cvt_pk(zz[4], zz[5]), cvt_pk(zz[6], zz[7])};
        }
    }
    __syncthreads();
}

constexpr int NPHASE = 19;
#ifndef RUN_HI
#define RUN_HI NPHASE
#endif
__global__ void __launch_bounds__(512, 2) fwd_kernel(Args args) {
    extern __shared__ __attribute__((aligned(16))) unsigned char lds_raw[];
    Ctx C; C.lds = (LAS unsigned char*)lds_raw;
    C.G = gridDim.x; C.a = &args; C.ws = args.ws;
    volatile LAS unsigned* MISC = (volatile LAS unsigned*)(C.lds + MISC_OFF);
    if (threadIdx.x < 16) MISC[threadIdx.x] = 0u;
    __syncthreads();
    const int lo = args.ph_lo, hi = args.ph_hi;
    const bool multi = (hi - lo) > 1;
    XcdBarrier bar; bar.bar = (unsigned*)(C.ws + WS_CTL) + 4096; bar.x = 0; bar.st = MISC;
    if (multi) bar = xcd_barrier_post((unsigned*)(C.ws + WS_CTL) + 4096, MISC);
#ifndef PH_MASK
#define PH_MASK 0x7FFFF
#endif
#define IN(k) (((PH_MASK >> (k)) & 1) && lo <= (k) && (k) < hi)
#ifndef DUP_MASK
#define DUP_MASK 0
#endif
#ifndef GLA_PROBE
#define GLA_PROBE 0
#endif
#ifndef PROBE_NOEPI
#define PROBE_NOEPI 0
#endif
#ifndef GP_AMP
#define GP_AMP 4
#endif
#define DUPN(k) (((DUP_MASK >> (k)) & 1) ? 2 : 1)
#define SEAM(k) do { if (IN(k) && IN((k) + 1)) xcd_barrier(bar); } while (0)
    LAS unsigned char* ring = C.lds;
    const int cid = blockIdx.x;

    if (IN(0)) for (int rep_ = 0; rep_ < DUPN(0); ++rep_) { p0_adaln(C); p0_fourier_fold(C); p0_convert(C); p0_convert_experts(C); } SEAM(0);
    if (IN(1)) for (int rep_ = 0; rep_ < DUPN(1); ++rep_) { p_norm0(C); } SEAM(1);
    if (IN(2)) for (int rep_ = 0; rep_ < DUPN(2); ++rep_) { gm::SchedIn0 S{(const char*)(C.ws + WS_HN), (const char*)(C.ws + WS_WIN0), C.G, cid}; gm::EpiIn0 E{C.ws}; gm::gemm_phase<F8_IN0 != 0>(ring, F8_IN0 ? 1024 : 2048, S, E, 0x7C7C7C7C, 0x7A7A7A7A, 2, (unsigned long long*)(C.ws + WS_CTL + 32768)); } SEAM(2);
    if (IN(3)) for (int rep_ = 0; rep_ < DUPN(3); ++rep_) { p_gla_prep(C); if (GLA_PROBE == 1) p_gla_prep(C); if (GLA_PROBE >= 10) p_gla_prep(C, GLA_PROBE - 10); p_fft1(C); if (GLA_PROBE == 2) p_fft1(C); xcd_barrier(bar); p_gla(C); if (GLA_PROBE == 3) p_gla(C); if (GLA_PROBE == 4) p_gla(C, 1); } SEAM(3);
    if (IN(4)) for (int rep_ = 0; rep_ < DUPN(4); ++rep_) { p_fft2(C); p_gla_out(C); } SEAM(4);
    if (IN(5)) for (int rep_ = 0; rep_ < DUPN(5); ++rep_) { gm::SchedDense S{(const char*)(C.ws + WS_A2), (const char*)(C.ws + WS_WOUT0), F8_OUT0 ? 1536 : 3072, 256, 4, C.G, cid}; gm::EpiPlain E{(bf16*)(C.ws + WS_Y), 1024}; gm::gemm_phase<F8_OUT0 != 0>(ring, F8_OUT0 ? 1536 : 3072, S, E, 0x7C7C7C7C, 0x7A7A7A7A, 5, (unsigned long long*)(C.ws + WS_CTL + 32768)); } SEAM(5);
    if (IN(6)) for (int rep_ = 0; rep_ < DUPN(6); ++rep_) { p_postmix(C, 0); } SEAM(6);
    if (IN(7)) { p_assign(C); } SEAM(7);
    if (IN(8)) for (int rep_ = 0; rep_ < DUPN(8); ++rep_) { const int* tsp = (const int*)(C.ws + WS_MOEINFO); const int ln_ = otid() & 63; const int ts = __hip_atomic_load(tsp + (ln_ < 32 ? ln_ : 32), __ATOMIC_RELAXED, __HIP_MEMORY_SCOPE_AGENT);
        gm::SchedMoE S{(const char*)(C.ws + WS_H2), (const char*)(C.ws + WS_WGU), (const int*)(C.ws + WS_SLOTTOK), ts, __builtin_amdgcn_readlane(ts, 32), 8, C.G, cid, (size_t)2048 * 1024, true, args.in[IN_BGU], nullptr};
        gm::EpiGU E{(unsigned char*)(C.ws + WS_ACT), args.in[IN_BGU], PROBE_NOEPI ? rep_ : 0}; gm::gemm_phase<true>(ring, 1024, S, E, 0x7C7C7C7C, 0x7A7A7A7A, 8, (unsigned long long*)(C.ws + WS_CTL + 32768)); } SEAM(8);
    if (IN(9)) for (int rep_ = 0; rep_ < DUPN(9); ++rep_) { const int* tsp = (const int*)(C.ws + WS_MOEINFO); const int ln_ = otid() & 63; const int ts = __hip_atomic_load(tsp + (ln_ < 32 ? ln_ : 32), __ATOMIC_RELAXED, __HIP_MEMORY_SCOPE_AGENT);
        gm::SchedMoE S{(const char*)(C.ws + WS_ACT), (const char*)(C.ws + WS_WD), nullptr, ts, __builtin_amdgcn_readlane(ts, 32), 4, C.G, cid, (size_t)1024 * 1024, false, args.in[IN_BD], (const int*)(C.ws + WS_SLOTDST)};
        gm::EpiDown E{(unsigned char*)(C.ws + WS_YSLOT), args.in[IN_BD]}; gm::gemm_phase<true>(ring, 1024, S, E, 0x7D7D7D7D, 0x7A7A7A7A, 9, (unsigned long long*)(C.ws + WS_CTL + 32768)); } SEAM(9);
    if (IN(10)) { p_combine(C, 0); } SEAM(10);
    if (IN(11)) for (int rep_ = 0; rep_ < DUPN(11); ++rep_) { gm::SchedDense S{(const char*)(C.ws + WS_HN), (const char*)(C.ws + WS_WIN1), F8_IN1 ? 1024 : 2048, 256, 10, C.G, cid}; gm::EpiIn1 E{C.ws}; gm::gemm_phase<F8_IN1 != 0>(ring, F8_IN1 ? 1024 : 2048, S, E, 0x7C7C7C7C, 0x7A7A7A7A, 11, (unsigned long long*)(C.ws + WS_CTL + 32768)); } SEAM(11);
    if (IN(12)) for (int rep_ = 0; rep_ < DUPN(12); ++rep_) { p_conv(C); } SEAM(12);
    if (IN(13)) for (int rep_ = 0; rep_ < DUPN(13); ++rep_) { gm::SchedDense S{(const char*)(C.ws + WS_A2B), (const char*)(C.ws + WS_WOUT1), F8_OUT1 ? 1024 : 2048, 256, 4, C.G, cid}; gm::EpiPlain E{(bf16*)(C.ws + WS_Y), 1024}; gm::gemm_phase<F8_OUT1 != 0>(ring, F8_OUT1 ? 1024 : 2048, S, E, 0x7D7D7D7D, 0x7A7A7A7A, 13, (unsigned long long*)(C.ws + WS_CTL + 32768)); } SEAM(13);
    if (IN(14)) { p_postmix(C, 1); } SEAM(14);
    if (IN(15)) { p_assign(C); } SEAM(15);
    if (IN(16)) for (int rep_ = 0; rep_ < DUPN(16); ++rep_) { const int* tsp = (const int*)(C.ws + WS_MOEINFO); const int ln_ = otid() & 63; const int ts = __hip_atomic_load(tsp + (ln_ < 32 ? ln_ : 32), __ATOMIC_RELAXED, __HIP_MEMORY_SCOPE_AGENT);
        gm::SchedMoE S{(const char*)(C.ws + WS_H2), (const char*)(C.ws + WS_WGU) + (size_t)32 * 2048 * 1024, (const int*)(C.ws + WS_SLOTTOK), ts, __builtin_amdgcn_readlane(ts, 32), 8, C.G, cid, (size_t)2048 * 1024, true, args.in[IN_BGU] + 32 * 2048, nullptr};
        gm::EpiGU E{(unsigned char*)(C.ws + WS_ACT), args.in[IN_BGU] + 32 * 2048, 0}; gm::gemm_phase<true>(ring, 1024, S, E, 0x7C7C7C7C, 0x7A7A7A7A, 16, (unsigned long long*)(C.ws + WS_CTL + 32768)); } SEAM(16);
    if (IN(17)) for (int rep_ = 0; rep_ < DUPN(17); ++rep_) { const int* tsp = (const int*)(C.ws + WS_MOEINFO); const int ln_ = otid() & 63; const int ts = __hip_atomic_load(tsp + (ln_ < 32 ? ln_ : 32), __ATOMIC_RELAXED, __HIP_MEMORY_SCOPE_AGENT);
        gm::SchedMoE S{(const char*)(C.ws + WS_ACT), (const char*)(C.ws + WS_WD) + (size_t)32 * 1024 * 1024, nullptr, ts, __builtin_amdgcn_readlane(ts, 32), 4, C.G, cid, (size_t)1024 * 1024, false, args.in[IN_BD] + 32 * 1024, (const int*)(C.ws + WS_SLOTDST)};
        gm::EpiDown E{(unsigned char*)(C.ws + WS_YSLOT), args.in[IN_BD] + 32 * 1024}; gm::gemm_phase<true>(ring, 1024, S, E, 0x7D7D7D7D, 0x7A7A7A7A, 17, (unsigned long long*)(C.ws + WS_CTL + 32768)); } SEAM(17);
    if (IN(18)) { p_combine(C, 1); }
#if GP_PROBE
    if (blockIdx.x == 0 && threadIdx.x == 0) { const unsigned long long v = *(volatile unsigned long long*)(C.ws + WS_CTL + 32768) * GP_AMP; const unsigned long long t0 = wall_clock64();
        while (wall_clock64() - t0 < v) __builtin_amdgcn_s_sleep(16); }
#endif
#ifdef DBG_COPY_OFF
    if (lo == 99) { const bf16* src = (const bf16*)(C.ws + (size_t)DBG_COPY_OFF); float* dst = args.out;
        for (size_t i = (size_t)blockIdx.x * 512 + threadIdx.x; i < (size_t)MTOK * 1024; i += (size_t)gridDim.x * 512) dst[i] = bf_lo((unsigned)src[i]); }
#endif
#undef IN
#undef SEAM
}

extern "C" void kernel_launch(void* const* d_in, const int* in_sizes, int n_in, void* d_out, int out_size, void* d_ws, size_t ws_size, hipStream_t stream) {
    static int grid = 0;
    if (grid == 0) {
        if (n_in != 28 || out_size != MTOK * D || ws_size < WS_END) { fprintf(stderr, "kernel_launch: unexpected problem (n_in %d out %d ws %zu need %zu)\n", n_in, out_size, ws_size, (size_t)WS_END); grid = -1; return; }
        int dev = 0, cus = 0, per_cu = 0;
        (void)hipGetDevice(&dev); (void)hipDeviceGetAttribute(&cus, hipDeviceAttributeMultiprocessorCount, dev);
        if (hipFuncSetAttribute((const void*)fwd_kernel, hipFuncAttributeMaxDynamicSharedMemorySize, LDS_BYTES) != hipSuccess) { fprintf(stderr, "kernel_launch: hipFuncSetAttribute failed\n"); grid = -1; return; }
        (void)hipOccupancyMaxActiveBlocksPerMultiprocessor(&per_cu, (const void*)fwd_kernel, 512, LDS_BYTES);
        (void)hipGetLastError();
        grid = cus;
        if (grid != 256 || per_cu < 1) { fprintf(stderr, "kernel_launch: needs a 256-CU device with one resident workgroup per CU (cus %d, per_cu %d)\n", cus, per_cu); grid = -1; return; }
    }
    if (grid < 0) return;
    (void)hipMemsetAsync((char*)d_ws + WS_CTL, 0, CTL_ZERO_BYTES, stream);
    Args a{};
    for (int i = 0; i < 28; ++i) a.in[i] = (const float*)d_in[i];
    a.out = (float*)d_out; a.ws = (unsigned char*)d_ws;
#if N_LAUNCH_MODE == 1
    a.ph_lo = 0; a.ph_hi = NPHASE;
    hipLaunchKernelGGL(fwd_kernel, dim3(grid), dim3(512), LDS_BYTES, stream, a);
#else
    for (int p = 0; p < RUN_HI; ++p) { a.ph_lo = p; a.ph_hi = p + 1; hipLaunchKernelGGL(fwd_kernel, dim3(grid), dim3(512), LDS_BYTES, stream, a); }
#ifdef DBG_COPY_OFF
    a.ph_lo = 99; a.ph_hi = 100; hipLaunchKernelGGL(fwd_kernel, dim3(grid), dim3(512), LDS_BYTES, stream, a);
#endif
#endif
}
```

```cpp
#include <hip/hip_runtime.h>
#include <cstdio>
#include <cstdint>

#ifndef N_LAUNCH_MODE
#define N_LAUNCH_MODE 1
#endif

#ifndef F8_IN0
#define F8_IN0 0
#endif
#ifndef F8_OUT0
#define F8_OUT0 1
#endif
#ifndef F8_IN1
#define F8_IN1 1
#endif
#ifndef F8_OUT1
#define F8_OUT1 1
#endif
#define LAS __attribute__((address_space(3)))
typedef unsigned short bf16;
typedef short bf16x8 __attribute__((ext_vector_type(8)));
typedef short s16x4 __attribute__((ext_vector_type(4)));
typedef float f32x4 __attribute__((ext_vector_type(4)));
typedef float f32x16 __attribute__((ext_vector_type(16)));
typedef unsigned u32x4 __attribute__((ext_vector_type(4)));
typedef unsigned u32x2 __attribute__((ext_vector_type(2)));

constexpr int D = 1024, NB = 8, SEQ = 8192, CTXL = 256;
constexpr int MTOK = NB * SEQ;
constexpr int MCTX = NB * CTXL;
constexpr int MALL = MTOK + MCTX;
constexpr int NE = 32, TOPK = 4;
constexpr int NSLOT_PAD = MTOK * TOPK + NE * 256;
constexpr int N_IN0 = 3840;
constexpr int N_IN1 = 2560;
constexpr float EPS = 1e-6f;

constexpr size_t MiB = 1u << 20;
constexpr size_t WS_CTL = 0, CTL_ZERO_BYTES = 65536;
constexpr size_t WS_MOD = 1 * MiB;
constexpr size_t WS_F1 = 2 * MiB;
constexpr size_t WS_F2 = 2 * MiB + 65536;
constexpr size_t WS_CNTBLK = 3 * MiB;
constexpr size_t WS_MOEINFO = 3 * MiB + 65536;
constexpr size_t WS_TOPK = 4 * MiB;
constexpr size_t WS_GATE = 5 * MiB;
constexpr size_t WS_SLOTPOS = 6 * MiB;
constexpr size_t WS_SLOTTOK = 7 * MiB;
constexpr size_t WS_SLOTDST = 8 * MiB + 512 * 1024;
constexpr size_t WS_WIN0 = 10 * MiB;
constexpr size_t WS_WOUT0 = 19 * MiB;
constexpr size_t WS_WIN1 = 22 * MiB;
constexpr size_t WS_WOUT1 = 27 * MiB;
constexpr size_t WS_WGU = 32 * MiB;
constexpr size_t WS_WD = 288 * MiB;
constexpr size_t WS_HN = 416 * MiB;
constexpr size_t WS_B = 548 * MiB;
constexpr size_t WS_ACT = WS_B;
constexpr size_t WS_YSLOT = WS_B + 528 * MiB;
constexpr size_t WS_Q = WS_B, WS_K = WS_B + 64 * MiB, WS_V = WS_B + 130 * MiB, WS_R = WS_B + 262 * MiB;
constexpr size_t WS_ZC = WS_B + 390 * MiB, WS_ZS = WS_B + 454 * MiB, WS_LR = WS_B + 518 * MiB;
constexpr size_t WS_OF = WS_B + 528 * MiB, WS_OB = WS_B + 656 * MiB, WS_YR = WS_B + 784 * MiB, WS_YI = WS_B + 848 * MiB;
constexpr size_t WS_A2 = WS_B;
constexpr size_t WS_Y = WS_B + 528 * MiB;
constexpr size_t WS_H2 = WS_B + 656 * MiB;
constexpr size_t WS_GLU = WS_B, WS_ZC1 = WS_B + 64 * MiB, WS_GB = WS_B + 128 * MiB, WS_A2B = WS_B + 192 * MiB;
constexpr size_t WS_XS = WS_B + 1056 * MiB;
constexpr size_t WS_GQP = WS_B + 1056 * MiB;
constexpr size_t WS_GKPP = WS_GQP + 132 * MiB;
constexpr size_t WS_GSC = WS_GKPP + 132 * MiB;
constexpr size_t WS_GEL = WS_GSC + 66 * MiB;
constexpr size_t WS_END = WS_GEL + 6 * MiB;

constexpr int LDS_BYTES = 155648;
constexpr int MISC_OFF = LDS_BYTES - 256;

__device__ __forceinline__ float bf_lo(unsigned u) { return __uint_as_float(u << 16); }
__device__ __forceinline__ float bf_hi(unsigned u) { return __uint_as_float(u & 0xffff0000u); }
typedef __bf16 bf16v2_t __attribute__((ext_vector_type(2)));
typedef float f32v2_t __attribute__((ext_vector_type(2)));
__device__ __forceinline__ unsigned cvt_pk(float lo, float hi) { const f32v2_t v = {lo, hi}; const bf16v2_t r = __builtin_convertvector(v, bf16v2_t); return __builtin_bit_cast(unsigned, r); }
__device__ __forceinline__ unsigned f2bf(float f) { unsigned u = __float_as_uint(f); return (u + 0x7fffu + ((u >> 16) & 1u)) >> 16; }
__device__ __forceinline__ float swap32_sum(float a, float b) {
    const auto r = __builtin_amdgcn_permlane32_swap(__builtin_bit_cast(unsigned, a), __builtin_bit_cast(unsigned, b), false, false);
    unsigned x = r[0], y = r[1]; asm volatile("" : "+v"(x), "+v"(y));
    return __builtin_bit_cast(float, x) + __builtin_bit_cast(float, y);
}
__device__ __forceinline__ float swap16_sum(float a, float b) {
    const auto r = __builtin_amdgcn_permlane16_swap(__builtin_bit_cast(unsigned, a), __builtin_bit_cast(unsigned, b), false, false);
    unsigned x = r[0], y = r[1]; asm volatile("" : "+v"(x), "+v"(y));
    return __builtin_bit_cast(float, x) + __builtin_bit_cast(float, y);
}
__device__ __forceinline__ float row16_sum(float v) {
    v += __builtin_bit_cast(float, __builtin_amdgcn_update_dpp(0, __builtin_bit_cast(int, v), 0xB1, 0xF, 0xF, true));
    v += __builtin_bit_cast(float, __builtin_amdgcn_update_dpp(0, __builtin_bit_cast(int, v), 0x4E, 0xF, 0xF, true));
    v += __builtin_bit_cast(float, __builtin_amdgcn_update_dpp(0, __builtin_bit_cast(int, v), 0x141, 0xF, 0xF, true));
    v += __builtin_bit_cast(float, __builtin_amdgcn_update_dpp(0, __builtin_bit_cast(int, v), 0x140, 0xF, 0xF, true));
    return v;
}
__device__ __forceinline__ float wave_sum(float v) {
    v = row16_sum(v);
    const int iv = __builtin_bit_cast(int, v);
    const float a = __builtin_bit_cast(float, __builtin_amdgcn_readlane(iv, 0)), b = __builtin_bit_cast(float, __builtin_amdgcn_readlane(iv, 16));
    const float c = __builtin_bit_cast(float, __builtin_amdgcn_readlane(iv, 32)), d = __builtin_bit_cast(float, __builtin_amdgcn_readlane(iv, 48));
    return (a + b) + (c + d);
}
__device__ __forceinline__ unsigned pk4_fp8(float a, float b, float c, float d, float sc) {
    int w = 0;
    w = __builtin_amdgcn_cvt_pk_fp8_f32(__builtin_amdgcn_fmed3f(a * sc, -440.f, 440.f), __builtin_amdgcn_fmed3f(b * sc, -440.f, 440.f), w, false);
    w = __builtin_amdgcn_cvt_pk_fp8_f32(__builtin_amdgcn_fmed3f(c * sc, -440.f, 440.f), __builtin_amdgcn_fmed3f(d * sc, -440.f, 440.f), w, true);
    return (unsigned)w;
}
__device__ __forceinline__ float sigmoidf_(float x) { return __builtin_amdgcn_rcpf(1.0f + __builtin_amdgcn_exp2f(x * -1.4426950408889634f)); }
__device__ __forceinline__ float siluf_(float x) { return x * sigmoidf_(x); }

#define XB_TMO      128
#define XB_XCNT(j)  (256  + 64 * (j))
#define XB_XSUB(j)  (1280 + 64 * (j))
#define XB_XGEN(j)  (2304 + 64 * (j))
#define XB_TOP      3328
#define XB_TOPGEN   3392
#define XCD_BAR_WORDS 3456
#define XB_SPIN_CAP (1u << 18)
__device__ __forceinline__ unsigned xb_ld(unsigned* p)              { return __hip_atomic_load(p, __ATOMIC_RELAXED, __HIP_MEMORY_SCOPE_AGENT); }
__device__ __forceinline__ unsigned xb_add(unsigned* p, unsigned v) { return __hip_atomic_fetch_add(p, v, __ATOMIC_RELAXED, __HIP_MEMORY_SCOPE_AGENT); }
__device__ __forceinline__ unsigned xb_xcc_id() { return (unsigned)__builtin_amdgcn_s_getreg((3 << 11) | 20) & 0xFu; }
#define XB_SPIN(cond, bar) do { unsigned _sp = 0; while (cond) { __builtin_amdgcn_s_sleep(1); \
    if ((++_sp & 255u) == 0u) { if (xb_ld(&(bar)[XB_TMO])) break; if (_sp > XB_SPIN_CAP) { atomicAdd(&(bar)[XB_TMO], 1u); break; } } } } while (0)
struct XcdBarrier { unsigned* bar; unsigned x; volatile LAS unsigned* st; };
__device__ __forceinline__ XcdBarrier xcd_barrier_post(unsigned* bar, volatile LAS unsigned* st) {
    XcdBarrier b; b.bar = bar; b.x = xb_xcc_id(); b.st = st;
    if (threadIdx.x == 0) (void)xb_add(&bar[XB_XCNT(b.x)], 1u);
    return b;
}
__device__ __forceinline__ void xcd_barrier_complete(unsigned* bar, unsigned x, unsigned& nloc, unsigned& nx) {
    const unsigned G = gridDim.x * gridDim.y * gridDim.z;
    unsigned sum, cnt, mine, sp = 0u;
    for (;;) {
        sum = 0u; cnt = 0u; mine = 0u;
#pragma unroll
        for (unsigned j = 0; j < 16; ++j) { const unsigned c = xb_ld(&bar[XB_XCNT(j)]); sum += c; cnt += (c > 0u) ? 1u : 0u; mine = (j == x) ? c : mine; }
        if (sum == G) break;
        __builtin_amdgcn_s_sleep(1);
        if ((++sp & 255u) == 0u) { if (xb_ld(&bar[XB_TMO])) break; if (sp > XB_SPIN_CAP) { atomicAdd(&bar[XB_TMO], 1u); break; } }
    }
    nloc = mine > 0u ? mine : 1u; nx = cnt > 0u ? cnt : 1u;
}
__device__ __forceinline__ void xcd_barrier(const XcdBarrier& b) {
    asm volatile("s_waitcnt vmcnt(0)" ::: "memory");
    __syncthreads();
    if (threadIdx.x == 0) {
        unsigned* bar = b.bar;
        __builtin_amdgcn_s_waitcnt(0);
        unsigned nloc = b.st[0], nx = b.st[1];
        if (nloc == 0u) { xcd_barrier_complete(bar, b.x, nloc, nx); b.st[0] = nloc; b.st[1] = nx; }
        const unsigned old = xb_add(&bar[XB_XSUB(b.x)], 1u);
        const unsigned gen = old / nloc;
        if (old + 1u == (gen + 1u) * nloc) {
            __builtin_amdgcn_fence(__ATOMIC_RELEASE, "agent");
            asm volatile("s_waitcnt vmcnt(0)" ::: "memory");
            const unsigned og = xb_add(&bar[XB_TOP], 1u);
            const unsigned tg = og / nx;
            if (og + 1u == (tg + 1u) * nx) xb_add(&bar[XB_TOPGEN], 1u);
            else XB_SPIN(xb_ld(&bar[XB_TOPGEN]) == tg, bar);
            __builtin_amdgcn_fence(__ATOMIC_ACQUIRE, "agent");
            xb_add(&bar[XB_XGEN(b.x)], 1u);
            asm volatile("s_waitcnt vmcnt(0)" ::: "memory");
        } else {
            XB_SPIN(xb_ld(&bar[XB_XGEN(b.x)]) == gen, bar);
            __builtin_amdgcn_fence(__ATOMIC_ACQUIRE, "agent");
            asm volatile("s_waitcnt vmcnt(0)" ::: "memory");
        }
    }
    __syncthreads();
}

struct Args {
    const float* in[28];
    float* out;
    unsigned char* ws;
    int ph_lo, ph_hi;
};
struct Ctx {
    LAS unsigned char* lds;
    int G;
    const Args* a;
    unsigned char* ws;
};
__device__ __forceinline__ int otid() { int t = (int)threadIdx.x; asm volatile("" : "+v"(t)); return t; }
__device__ __forceinline__ int vzero() { int z = 0; asm volatile("" : "+v"(z)); return z; }
#define PH_IDS const int tid = otid(), lane = tid & 63, wave = __builtin_amdgcn_readfirstlane(tid >> 6); (void)tid; (void)lane; (void)wave
#define IN_X 0
#define IN_C 1
#define IN_CTX 2
#define IN_CCTX 3
#define IN_MODW 4
#define IN_MODB 5
#define IN_NMPRE 6
#define IN_NMPOST 7
#define IN_NFPRE 8
#define IN_NFPOST 9
#define IN_EVWIN 10
#define IN_EVGKUP 11
#define IN_EVGKB 12
#define IN_EVGNORM 13
#define IN_EVWOUT 14
#define IN_ODWIN 15
#define IN_ODDW 16
#define IN_ODDWB 17
#define IN_ODLNG 18
#define IN_ODLNB 19
#define IN_ODSCONV 20
#define IN_ODWOUT 21
#define IN_RW 22
#define IN_RB 23
#define IN_WGU 24
#define IN_BGU 25
#define IN_WD 26
#define IN_BD 27

namespace gm {
constexpr int BM = 256, BK = 64, HALF = 128, HTB = HALF * BK * 2, STAGE_BYTES = 8 * HTB, NXCD = 8, WGM = 8;
constexpr int XT_OFF = 131072;
constexpr int XB_OFF = XT_OFF + 16384;
__device__ __forceinline__ int lds_byte(int r, int c) { const int st = (r >> 4) * 2 + (c >> 5), rr = r & 15, cc = c & 31, ob = rr * 64 + cc * 2; return st * 1024 + (ob ^ (((ob >> 9) & 1) << 5)); }
__device__ __forceinline__ void stage_rc(int b, int& R, int& C) { const int st = b / 1024, sb = b % 1024, swz = sb ^ (((sb >> 9) & 1) << 5); R = (st >> 1) * 16 + swz / 64; C = (st & 1) * 32 + (swz % 64) / 2; }
__device__ __forceinline__ int perm32(int rho) { const int n = rho >> 4, i = rho & 15; return 8 * (i >> 2) + 4 * n + (i & 3); }
struct Unit { int pm, pn, e; };

__device__ __forceinline__ void dense_map(int L, int nM, int nN, int& pm, int& pn) {
    const int nwg = nM * nN; int wgid = L;
    { const int q = nwg / NXCD, r = nwg % NXCD, xcd = wgid % NXCD, off = wgid / NXCD; wgid = (xcd < r ? xcd * (q + 1) : r * (q + 1) + (xcd - r) * q) + off; }
    const int nig = WGM * nN, gid = wgid / nig, fm = gid * WGM, gsz = (nM - fm) < WGM ? (nM - fm) : WGM;
    pm = fm + ((wgid % nig) % gsz); pn = (wgid % nig) / gsz;
}

typedef int i32x8 __attribute__((ext_vector_type(8)));
typedef int i32x4_ __attribute__((ext_vector_type(4)));
template <bool F8, class Epi, class Sched>
__device__ __forceinline__ void gemm_phase(LAS unsigned char* lds, const int RP, const Sched& S, const Epi& E, const int SCA = 0x7F7F7F7F, const int SCB = 0x7F7F7F7F, const int pid = -1, unsigned long long* tprobe = nullptr) {
    const int tid = otid(), wid = __builtin_amdgcn_readfirstlane(tid >> 6), lane = tid & 63, wr = wid >> 2, wc = wid & 3, fr = lane & 15, fq = lane >> 4;
    const int nt = RP / 128;
    unsigned voffB[2];
#pragma unroll
    for (int i = 0; i < 2; ++i) { int R, C; stage_rc(tid * 16 + i * 8192, R, C); const int Rb = (R & ~31) + perm32(R & 31); voffB[i] = (unsigned)(Rb * RP + C * 2); }
    const size_t kstep = (size_t)128;
    const size_t hstepB = (size_t)HALF * RP;
    const unsigned ldsw = (unsigned)wid * 1024u;
    const int aoff = lds_byte(wr * 64 + fr, fq * 8);
    const int boff = lds_byte(wc * 32 + fr, fq * 8);
    constexpr int KOFF = 1024;
#define G_SA(b, h) (((b) * 2 + (h)) * HTB)
#define G_SB(b, h) ((4 + (b) * 2 + (h)) * HTB)
#define G_STAGEB(bufoff, gbase) do { _Pragma("unroll") for (int _i = 0; _i < 2; ++_i) \
        __builtin_amdgcn_global_load_lds((const unsigned*)((const char*)(gbase) + voffB[_i]), (LAS unsigned*)(lds + (bufoff) + ldsw + _i * 8192), 16, 0, 0); } while (0)
#define G_STAGEA(bufoff, offs, h, kb) do { _Pragma("unroll") for (int _i = 0; _i < 2; ++_i) \
        __builtin_amdgcn_global_load_lds((const unsigned*)(S.abase() + (size_t)(offs)[h][_i] + (kb)), (LAS unsigned*)(lds + (bufoff) + ldsw + _i * 8192), 16, 0, 0); } while (0)
#define G_LDA(dst, b, h) do { _Pragma("unroll") for (int m = 0; m < 4; ++m) _Pragma("unroll") for (int k = 0; k < 2; ++k) dst[m][k] = *(const LAS bf16x8*)(lds + G_SA(b, h) + aoff + m * 2048 + k * KOFF); } while (0)
#define G_LDB(dst, b, h) do { _Pragma("unroll") for (int n = 0; n < 2; ++n) _Pragma("unroll") for (int k = 0; k < 2; ++k) dst[n][k] = *(const LAS bf16x8*)(lds + G_SB(b, h) + boff + n * 2048 + k * KOFF); } while (0)
#define G_CAT8(x) __builtin_shufflevector(__builtin_bit_cast(i32x4_, (x)[0]), __builtin_bit_cast(i32x4_, (x)[1]), 0, 1, 2, 3, 4, 5, 6, 7)
#define G_MMA(ai, bj, At, Bt) do { __builtin_amdgcn_s_setprio(1); \
        if constexpr (F8) { _Pragma("unroll") for (int m = 0; m < 4; ++m) _Pragma("unroll") for (int n = 0; n < 2; ++n) \
            acc[ai][bj][m][n] = __builtin_amdgcn_mfma_scale_f32_16x16x128_f8f6f4(G_CAT8(Bt[n]), G_CAT8(At[m]), acc[ai][bj][m][n], 0, 0, 0, 0, 0, 0); } \
        else { _Pragma("unroll") for (int m = 0; m < 4; ++m) _Pragma("unroll") for (int n = 0; n < 2; ++n) _Pragma("unroll") for (int k = 0; k < 2; ++k) \
            acc[ai][bj][m][n] = __builtin_amdgcn_mfma_f32_16x16x32_bf16(Bt[n][k], At[m][k], acc[ai][bj][m][n], 0, 0, 0); } \
        __builtin_amdgcn_s_setprio(0); } while (0)
#define G_WAIT_V(n) asm volatile("s_waitcnt vmcnt(" #n ")" ::: "memory")
#define G_WAIT_L(n) asm volatile("s_waitcnt lgkmcnt(" #n ")" ::: "memory")
#define G_BAR __builtin_amdgcn_s_barrier()
#define G_SCHED __builtin_amdgcn_sched_barrier(0)
    Unit cur, nxt; int ui = 0;
#ifndef GP_PROBE
#define GP_PROBE 0
#endif
#ifndef GP_PROBE_PID
#define GP_PROBE_PID 8
#endif
    unsigned tp_k = 0, tp_e = 0, tp_s = 0, tp_0 = 0, tp_1 = 0;
#define TP_NOW() ((unsigned)__builtin_amdgcn_readfirstlane((int)(unsigned)wall_clock64()))
    const bool tp_on = GP_PROBE && pid == GP_PROBE_PID;
    if (tp_on) tp_0 = TP_NOW();
    if (!S.next(0, cur)) return;
    f32x4 acc[2][2][4][2];
#pragma unroll
    for (int a = 0; a < 2; ++a)
#pragma unroll
        for (int b = 0; b < 2; ++b)
#pragma unroll
            for (int m = 0; m < 4; ++m)
#pragma unroll
                for (int n = 0; n < 2; ++n) acc[a][b][m][n] = (f32x4){0.f, 0.f, 0.f, 0.f};
    bf16x8 At[4][2], B0[2][2], B1[2][2];
    unsigned cAo[2][2];
    S.a_off(cur, cAo);
    const char* cB = S.b_ptr(cur);
    S.prefetch_bias(cur, lds, 0, wid, lane, wc);
    S.prefetch_rows(cur, lds, 0, wid, lane);
    G_STAGEB(G_SB(0, 0), cB); G_STAGEA(G_SA(0, 0), cAo, 0, 0); G_STAGEB(G_SB(0, 1), cB + hstepB); G_STAGEA(G_SA(0, 1), cAo, 1, 0);
    if (wr == 1) G_BAR;
    G_WAIT_V(4); G_BAR;
    G_STAGEB(G_SB(1, 0), cB + kstep); G_STAGEA(G_SA(1, 0), cAo, 0, kstep); G_STAGEB(G_SB(1, 1), cB + hstepB + kstep);
    G_WAIT_V(6); G_BAR;
    for (;;) {
        const bool has_next = S.next(ui + 1, nxt);
        const char* nB = cB;
        if (has_next) { S.prefetch_rows(nxt, lds, (ui + 1) & 1, wid, lane); S.prefetch_bias(nxt, lds, (ui + 1) & 1, wid, lane, wc); nB = S.b_ptr(nxt); }
        if (tp_on) tp_s = TP_NOW();
        for (int t = 0; t < nt; t += 2) {
            const bool last = (t == nt - 2);
            const size_t k1 = (size_t)(t + 1) * kstep;
            G_LDB(B0, 0, 0); G_SCHED; G_LDA(At, 0, 0); G_STAGEA(G_SA(1, 1), cAo, 1, k1);
            if (last) { if (has_next) S.a_off_lds(nxt, lds, (ui + 1) & 1, wid, lane, cAo); cB = nB; }
            const size_t k2 = last ? 0 : (size_t)(t + 2) * kstep;
            const size_t k3 = k2 + kstep;
            const char* b2 = cB + k2; const char* b3 = b2 + kstep;
            G_WAIT_L(8); G_BAR; G_WAIT_L(0); G_MMA(0, 0, At, B0); G_BAR; G_SCHED;
            G_LDB(B1, 0, 1); G_STAGEB(G_SB(0, 0), b2);
            G_BAR; G_WAIT_L(0); G_MMA(0, 1, At, B1); G_BAR;
            G_LDA(At, 0, 1); G_STAGEA(G_SA(0, 0), cAo, 0, k2);
            G_BAR; G_WAIT_L(0); G_MMA(1, 0, At, B0); G_BAR; G_SCHED;
            G_STAGEB(G_SB(0, 1), b2 + hstepB);
            G_WAIT_V(6); G_BAR; G_MMA(1, 1, At, B1); G_BAR;
            G_LDB(B0, 1, 0); G_SCHED; G_LDA(At, 1, 0); G_STAGEA(G_SA(0, 1), cAo, 1, k2);
            G_WAIT_L(8); G_BAR; G_WAIT_L(0); G_MMA(0, 0, At, B0); G_BAR; G_SCHED;
            G_LDB(B1, 1, 1); G_STAGEB(G_SB(1, 0), b3);
            G_BAR; G_WAIT_L(0); G_MMA(0, 1, At, B1); G_BAR;
            G_LDA(At, 1, 1); G_STAGEA(G_SA(1, 0), cAo, 0, k3);
            G_BAR; G_WAIT_L(0); G_MMA(1, 0, At, B0); G_BAR; G_SCHED;
            G_STAGEB(G_SB(1, 1), b3 + hstepB);
            G_WAIT_V(6); G_BAR; G_MMA(1, 1, At, B1); G_BAR;
        }
        if (tp_on) { tp_1 = TP_NOW(); tp_k += tp_1 - tp_s; }
        const float osc = F8 ? __builtin_ldexpf(1.0f, ((SCA & 0xFF) - 127) + ((SCB & 0xFF) - 127)) : 1.0f;
        if constexpr (F8 && !Epi::FOLD) {
#pragma unroll
            for (int a = 0; a < 2; ++a)
#pragma unroll
                for (int b = 0; b < 2; ++b)
#pragma unroll
                    for (int m = 0; m < 4; ++m)
#pragma unroll
                        for (int n = 0; n < 2; ++n) acc[a][b][m][n] *= osc; }
        E(acc, cur, wr, wc, fr, fq, (const LAS float*)(lds + XB_OFF + ((ui & 1) * 8 + wid) * 256), (const LAS int*)(lds + XT_OFF + ((ui & 1) * 8 + wid) * 1024), osc);
        if (tp_on) tp_e += TP_NOW() - tp_1;
        if (!has_next) break;
#pragma unroll
        for (int a = 0; a < 2; ++a)
#pragma unroll
            for (int b = 0; b < 2; ++b)
#pragma unroll
                for (int m = 0; m < 4; ++m)
#pragma unroll
                    for (int n = 0; n < 2; ++n) acc[a][b][m][n] = (f32x4){0.f, 0.f, 0.f, 0.f};
        cur = nxt; ++ui;
    }
    G_WAIT_V(0);
    if (wr == 0) G_BAR;
    G_BAR;
    if (tp_on && blockIdx.x == 0 && tid == 0) { const unsigned tot = TP_NOW() - tp_0; *tprobe = (unsigned long long)((GP_PROBE == 1) ? tp_k : (GP_PROBE == 2) ? tp_e : tot); }
#undef G_SA
#undef G_SB
#undef G_STAGEA
#undef G_STAGEB
#undef G_LDA
#undef G_LDB
#undef G_MMA
#undef G_CAT8
#undef G_WAIT_V
#undef G_WAIT_L
#undef G_BAR
#undef G_SCHED
}

__device__ __forceinline__ void lane_rc(int i, int& R, int& Cb) { int C; stage_rc(otid() * 16 + i * 8192, R, C); Cb = C * 2; }

struct SchedDense {
    const char* A; const char* B; int RP, nM, nN, G, c;
    __device__ __forceinline__ const char* abase() const { return A; }
    __device__ __forceinline__ bool next(int i, Unit& u) const { const long L = (long)i * G + c; if (L >= (long)nM * nN) return false; dense_map((int)L, nM, nN, u.pm, u.pn); u.e = 0; return true; }
    __device__ __forceinline__ void a_off(const Unit& u, unsigned (&o)[2][2]) const {
#pragma unroll
        for (int i = 0; i < 2; ++i) { int R, Cb; lane_rc(i, R, Cb);
#pragma unroll
            for (int h = 0; h < 2; ++h) o[h][i] = (unsigned)(u.pm * BM + h * HALF + R) * (unsigned)RP + (unsigned)Cb; }
    }
    __device__ __forceinline__ void prefetch_rows(const Unit&, LAS unsigned char*, int, int, int) const {}
    __device__ __forceinline__ void prefetch_bias(const Unit&, LAS unsigned char*, int, int, int, int) const {}
    __device__ __forceinline__ void a_off_lds(const Unit& u, LAS unsigned char*, int, int, int, unsigned (&o)[2][2]) const { a_off(u, o); }
    __device__ __forceinline__ const char* b_ptr(const Unit& u) const { return B + (size_t)u.pn * BM * RP; }
};
struct SchedIn0 {
    const char* A; const char* B; int G, c;
    __device__ __forceinline__ const char* abase() const { return A; }
    __device__ __forceinline__ bool next(int i, Unit& u) const {
        const long L = (long)i * G + c; u.e = 0;
        if (L < 256 * 15) { dense_map((int)L, 256, 15, u.pm, u.pn); return true; }
        const int r = (int)(L - 256 * 15); if (r >= 56) return false;
        u.pm = 256 + r / 7; const int q = r % 7; u.pn = (q < 6) ? (2 + q) : 14; return true;
    }
    __device__ __forceinline__ void a_off(const Unit& u, unsigned (&o)[2][2]) const {
#pragma unroll
        for (int i = 0; i < 2; ++i) { int R, Cb; lane_rc(i, R, Cb);
#pragma unroll
            for (int h = 0; h < 2; ++h) o[h][i] = (unsigned)(u.pm * BM + h * HALF + R) * (F8_IN0 ? 1024u : 2048u) + (unsigned)Cb; }
    }
    __device__ __forceinline__ void prefetch_rows(const Unit&, LAS unsigned char*, int, int, int) const {}
    __device__ __forceinline__ void prefetch_bias(const Unit&, LAS unsigned char*, int, int, int, int) const {}
    __device__ __forceinline__ void a_off_lds(const Unit& u, LAS unsigned char*, int, int, int, unsigned (&o)[2][2]) const { a_off(u, o); }
    __device__ __forceinline__ const char* b_ptr(const Unit& u) const { return B + (size_t)u.pn * BM * (F8_IN0 ? 1024 : 2048); }
};
struct SchedMoE {
    const char* A; const char* B; const int* slot_tok; int ts; int RT; int nct; int G, c; size_t bstride_e; bool gather; const float* bias; const int* slot_dst;
    __device__ __forceinline__ const char* abase() const { return A; }
    __device__ __forceinline__ bool next(int i, Unit& u) const {
        const int x = c & 7, j = c >> 3; int rt, ct;
        if (nct == 8) { rt = 32 * i + 4 * x + (j & 3); ct = j >> 2; } else { rt = 64 * i + 8 * x + (j & 7); ct = j >> 3; }
        if (rt >= RT) return false;
        const unsigned long long m = __ballot(((otid() & 63) < 32) && ts <= rt);
        u.pm = rt; u.pn = ct; u.e = __builtin_amdgcn_readfirstlane(__popcll(m)) - 1; return true;
    }
    __device__ __forceinline__ void a_off(const Unit& u, unsigned (&o)[2][2]) const {
#pragma unroll
        for (int i = 0; i < 2; ++i) { int R, Cb; lane_rc(i, R, Cb);
#pragma unroll
            for (int h = 0; h < 2; ++h) { const int row = u.pm * BM + h * HALF + R; const unsigned rr = gather ? (unsigned)slot_tok[row] : (unsigned)row; o[h][i] = rr * 1024u + (unsigned)Cb; } }
    }
    __device__ __forceinline__ const char* b_ptr(const Unit& u) const { return B + (size_t)u.e * bstride_e + (size_t)u.pn * BM * 1024; }
    __device__ __forceinline__ void prefetch_rows(const Unit& u, LAS unsigned char* lds, int par, int wid, int lane) const {
        if (!gather) {
#pragma unroll
            for (int ai = 0; ai < 2; ++ai) __builtin_amdgcn_global_load_lds((const unsigned*)(slot_dst + (u.pm * BM + ai * HALF + (wid >> 2) * 64 + lane)), (LAS unsigned*)(lds + XT_OFF + ((par * 8 + wid) * 4 + ai) * 256), 4, 0, 0);
            return; }
#pragma unroll
        for (int i = 0; i < 2; ++i) { int R, Cb; lane_rc(i, R, Cb);
#pragma unroll
            for (int h = 0; h < 2; ++h) __builtin_amdgcn_global_load_lds((const unsigned*)(slot_tok + (u.pm * BM + h * HALF + R)), (LAS unsigned*)(lds + XT_OFF + ((par * 8 + wid) * 4 + h * 2 + i) * 256), 4, 0, 0); }
    }
    __device__ __forceinline__ void prefetch_bias(const Unit& u, LAS unsigned char* lds, int par, int wid, int lane, int wc) const {
        const float* src = (nct == 8) ? bias + (size_t)u.e * 2048 + (lane >> 5) * 1024 + u.pn * 128 + wc * 32 + (lane & 31)
                                      : bias + (size_t)u.e * 1024 + u.pn * 256 + (lane >> 5) * 128 + wc * 32 + (lane & 31);
        __builtin_amdgcn_global_load_lds((const unsigned*)src, (LAS unsigned*)(lds + XB_OFF + (par * 8 + wid) * 256), 4, 0, 0);
    }
    __device__ __forceinline__ void a_off_lds(const Unit& u, LAS unsigned char* lds, int par, int wid, int lane, unsigned (&o)[2][2]) const {
#pragma unroll
        for (int i = 0; i < 2; ++i) { int R, Cb; lane_rc(i, R, Cb);
#pragma unroll
            for (int h = 0; h < 2; ++h) { const unsigned rr = gather ? *(const LAS unsigned*)(lds + XT_OFF + ((par * 8 + wid) * 4 + h * 2 + i) * 256 + lane * 4) : (unsigned)(u.pm * BM + h * HALF + R); o[h][i] = rr * 1024u + (unsigned)Cb; } }
    }
};

__device__ __forceinline__ void store8(bf16* p, const f32x4& v0, const f32x4& v1) {
    u32x4 w; w.x = cvt_pk(v0[0], v0[1]); w.y = cvt_pk(v0[2], v0[3]); w.z = cvt_pk(v1[0], v1[1]); w.w = cvt_pk(v1[2], v1[3]);
    *(u32x4*)p = w;
}
struct EpiPlain {
    static constexpr bool FOLD = false;
    bf16* O; int ldc;
    __device__ __forceinline__ void operator()(const f32x4 (&acc)[2][2][4][2], const Unit& u, int wr, int wc, int fr, int fq, const LAS float* lb, const LAS int* xt, const float osc) const {
        const int row0 = u.pm * BM + wr * 64 + fr, col0 = u.pn * BM + wc * 32 + 8 * fq;
#pragma unroll
        for (int ai = 0; ai < 2; ++ai)
#pragma unroll
            for (int m = 0; m < 4; ++m) { bf16* rowp = O + (size_t)(row0 + ai * HALF + m * 16) * ldc + col0;
#pragma unroll
                for (int bj = 0; bj < 2; ++bj) store8(rowp + bj * HALF, acc[ai][bj][m][0], acc[ai][bj][m][1]); }
    }
};
struct EpiIn0 {
    static constexpr bool FOLD = false;
    unsigned char* ws;
    __device__ __forceinline__ void operator()(const f32x4 (&acc)[2][2][4][2], const Unit& u, int wr, int wc, int fr, int fq, const LAS float* lb, const LAS int* xt, const float osc) const {
        const int pn = u.pn; bf16* base; int ldc, c0;
        if (pn < 2) { base = (bf16*)(ws + WS_Q); ldc = 512; c0 = pn * 256; }
        else if (pn < 4) { base = (bf16*)(ws + WS_K); ldc = 512; c0 = (pn - 2) * 256; }
        else if (pn < 8) { base = (bf16*)(ws + WS_V); ldc = 1024; c0 = (pn - 4) * 256; }
        else if (pn < 12) { base = (bf16*)(ws + WS_R); ldc = 1024; c0 = (pn - 8) * 256; }
        else if (pn < 14) { base = (bf16*)(ws + WS_ZC); ldc = 512; c0 = (pn - 12) * 256; }
        else { base = (bf16*)(ws + WS_LR); ldc = 32; c0 = 0; }
        const int row0 = u.pm * BM + wr * 64 + fr, col0 = c0 + wc * 32 + 8 * fq;
        const bool lr = (pn == 14);
        if (lr && wc != 0) return;
        const float qs = (pn < 2) ? 0.08838834764831845f : 1.0f;
#pragma unroll
        for (int ai = 0; ai < 2; ++ai)
#pragma unroll
            for (int m = 0; m < 4; ++m) { bf16* rowp = base + (size_t)(row0 + ai * HALF + m * 16) * ldc + col0;
                store8(rowp, acc[ai][0][m][0] * qs, acc[ai][0][m][1] * qs);
                if (!lr) store8(rowp + HALF, acc[ai][1][m][0] * qs, acc[ai][1][m][1] * qs); }
    }
};
struct EpiIn1 {
    static constexpr bool FOLD = false;
    unsigned char* ws;
    __device__ __forceinline__ void operator()(const f32x4 (&acc)[2][2][4][2], const Unit& u, int wr, int wc, int fr, int fq, const LAS float* lb, const LAS int* xt, const float osc) const {
        const int pn = u.pn; const int row0 = u.pm * BM + wr * 64 + fr;
        if (pn >= 8) { bf16* O = (bf16*)(ws + WS_GB); const int col0 = (pn - 8) * 256 + wc * 32 + 8 * fq;
#pragma unroll
            for (int ai = 0; ai < 2; ++ai)
#pragma unroll
                for (int m = 0; m < 4; ++m) { bf16* rowp = O + (size_t)(row0 + ai * HALF + m * 16) * 512 + col0;
#pragma unroll
                    for (int bj = 0; bj < 2; ++bj) store8(rowp + bj * HALF, acc[ai][bj][m][0], acc[ai][bj][m][1]); }
            return; }
        const bool glu = pn < 4; bf16* O = (bf16*)(ws + (glu ? WS_GLU : WS_ZC1)); const int col0 = (pn & 3) * 128 + wc * 32 + 8 * fq;
#pragma unroll
        for (int ai = 0; ai < 2; ++ai)
#pragma unroll
            for (int m = 0; m < 4; ++m) { f32x4 o[2];
#pragma unroll
                for (int n = 0; n < 2; ++n)
#pragma unroll
                    for (int i = 0; i < 4; i += 2) { const f32v2_t a = (f32v2_t){acc[ai][0][m][n][i], acc[ai][0][m][n][i + 1]}, b = (f32v2_t){acc[ai][1][m][n][i], acc[ai][1][m][n][i + 1]};
                        f32v2_t ov;
                        if (glu) { const f32v2_t ea = b * -1.4426950408889634f; f32v2_t e; e.x = __builtin_amdgcn_exp2f(ea.x); e.y = __builtin_amdgcn_exp2f(ea.y);
                            const f32v2_t d = e + 1.0f; f32v2_t r; r.x = __builtin_amdgcn_rcpf(d.x); r.y = __builtin_amdgcn_rcpf(d.y); ov = a * r; }
                        else ov = a * b;
                        o[n][i] = ov.x; o[n][i + 1] = ov.y; }
                store8(O + (size_t)(row0 + ai * HALF + m * 16) * 512 + col0, o[0], o[1]); }
    }
};
struct EpiGU {
    static constexpr bool FOLD = true;
    unsigned char* O; const float* bgu; int probe;
    __device__ __forceinline__ void operator()(const f32x4 (&acc)[2][2][4][2], const Unit& u, int wr, int wc, int fr, int fq, const LAS float* lb, const LAS int* xt, const float osc) const {
        if (probe) {
#pragma unroll
            for (int a = 0; a < 2; ++a)
#pragma unroll
                for (int b = 0; b < 2; ++b)
#pragma unroll
                    for (int m = 0; m < 4; ++m)
#pragma unroll
                        for (int n = 0; n < 2; ++n) asm volatile("" :: "v"(acc[a][b][m][n]));
            return; }
        const int row0 = u.pm * BM + wr * 64 + fr, col0 = u.pn * 128 + wc * 32 + 8 * fq;
        f32x4 bgv[2], buv[2];
#pragma unroll
        for (int n = 0; n < 2; ++n) { bgv[n] = *(const LAS f32x4*)(lb + 8 * fq + 4 * n); buv[n] = *(const LAS f32x4*)(lb + 32 + 8 * fq + 4 * n); }
#pragma unroll
        for (int ai = 0; ai < 2; ++ai)
#pragma unroll
            for (int m = 0; m < 4; ++m) { f32x4 o[2];
#pragma unroll
                for (int n = 0; n < 2; ++n)
#pragma unroll
                    for (int i = 0; i < 4; i += 2) {
                        f32v2_t g = (f32v2_t){acc[ai][0][m][n][i], acc[ai][0][m][n][i + 1]} * osc + (f32v2_t){bgv[n][i], bgv[n][i + 1]};
                        f32v2_t uu = (f32v2_t){acc[ai][1][m][n][i], acc[ai][1][m][n][i + 1]} * osc + (f32v2_t){buv[n][i], buv[n][i + 1]};
                        g.x = fminf(g.x, 7.0f); g.y = fminf(g.y, 7.0f);
                        uu.x = __builtin_amdgcn_fmed3f(uu.x, -7.0f, 7.0f); uu.y = __builtin_amdgcn_fmed3f(uu.y, -7.0f, 7.0f);
                        const f32v2_t ea = g * (-1.702f * 1.4426950408889634f);
                        f32v2_t e; e.x = __builtin_amdgcn_exp2f(ea.x); e.y = __builtin_amdgcn_exp2f(ea.y);
                        const f32v2_t d = e + 1.0f;
                        f32v2_t r; r.x = __builtin_amdgcn_rcpf(d.x); r.y = __builtin_amdgcn_rcpf(d.y);
                        const f32v2_t t4 = uu * 4.0f + 4.0f;
                        const f32v2_t ov = (g * r) * t4;
                        o[n][i] = ov.x; o[n][i + 1] = ov.y; }
                int w0 = 0, w1 = 0;
                w0 = __builtin_amdgcn_cvt_pk_fp8_f32(o[0][0], o[0][1], w0, false); w0 = __builtin_amdgcn_cvt_pk_fp8_f32(o[0][2], o[0][3], w0, true);
                w1 = __builtin_amdgcn_cvt_pk_fp8_f32(o[1][0], o[1][1], w1, false); w1 = __builtin_amdgcn_cvt_pk_fp8_f32(o[1][2], o[1][3], w1, true);
                *(u32x2*)(O + (size_t)(row0 + ai * HALF + m * 16) * 1024 + col0) = (u32x2){(unsigned)w0, (unsigned)w1}; }
    }
};
struct EpiDown {
    static constexpr bool FOLD = true;
    unsigned char* O; const float* bd;
    __device__ __forceinline__ void operator()(const f32x4 (&acc)[2][2][4][2], const Unit& u, int wr, int wc, int fr, int fq, const LAS float* lb, const LAS int* xt, const float osc) const {
        const int row0 = u.pm * BM + wr * 64 + fr, col0 = u.pn * BM + wc * 32 + 8 * fq;
        f32x4 bv[2][2];
#pragma unroll
        for (int bj = 0; bj < 2; ++bj)
#pragma unroll
            for (int n = 0; n < 2; ++n) bv[bj][n] = *(const LAS f32x4*)(lb + 32 * bj + 8 * fq + 4 * n) * 16.0f;
#pragma unroll
        for (int ai = 0; ai < 2; ++ai)
#pragma unroll
            for (int m = 0; m < 4; ++m) { unsigned char* rowp = O + (size_t)xt[ai * 64 + m * 16 + fr] * 1024 + col0;
#pragma unroll
                for (int bj = 0; bj < 2; ++bj) { const f32x4 v0 = acc[ai][bj][m][0] * (16.0f * osc) + bv[bj][0], v1 = acc[ai][bj][m][1] * (16.0f * osc) + bv[bj][1];
                    int w0 = 0, w1 = 0;
                    w0 = __builtin_amdgcn_cvt_pk_fp8_f32(fminf(fmaxf(v0[0], -440.f), 440.f), fminf(fmaxf(v0[1], -440.f), 440.f), w0, false); w0 = __builtin_amdgcn_cvt_pk_fp8_f32(fminf(fmaxf(v0[2], -440.f), 440.f), fminf(fmaxf(v0[3], -440.f), 440.f), w0, true);
                    w1 = __builtin_amdgcn_cvt_pk_fp8_f32(fminf(fmaxf(v1[0], -440.f), 440.f), fminf(fmaxf(v1[1], -440.f), 440.f), w1, false); w1 = __builtin_amdgcn_cvt_pk_fp8_f32(fminf(fmaxf(v1[2], -440.f), 440.f), fminf(fmaxf(v1[3], -440.f), 440.f), w1, true);
                    *(u32x2*)(rowp + bj * HALF) = (u32x2){(unsigned)w0, (unsigned)w1}; } }
    }
};
}

__device__ __forceinline__ void p0_adaln(const Ctx& C) {
    PH_IDS;
    LAS float* s = (LAS float*)C.lds;
    LAS float* red = (LAS float*)(C.lds + 36864);
    const float* cc = C.a->in[IN_C]; const float* cx = C.a->in[IN_CCTX];
    { float tmpc[18];
#pragma unroll
      for (int q = 0; q < 18; ++q) { const int i = tid + 512 * q; const int b = i >> 10, k = i & 1023; tmpc[q] = (b < 8) ? cc[b * 1024 + k] : cx[k]; }
#pragma unroll
      for (int q = 0; q < 18; ++q) s[tid + 512 * q] = siluf_(tmpc[q]); }
    __syncthreads();
    float* MOD = (float*)(C.ws + WS_MOD);
    for (int item = blockIdx.x; item < 192; item += C.G) {
        const int l = item / 96, cb = item % 96, col = cb * 64 + lane;
        const float* W = C.a->in[IN_MODW] + (size_t)l * 1024 * 6144 + col;
        float acc[9];
#pragma unroll
        for (int b = 0; b < 9; ++b) acc[b] = 0.f;
        const int k0 = wave * 128;
#pragma unroll 8
        for (int k = k0; k < k0 + 128; ++k) { const float w = W[(size_t)k * 6144];
#pragma unroll
            for (int b = 0; b < 9; ++b) acc[b] += s[b * 1024 + k] * w; }
#pragma unroll
        for (int b = 0; b < 9; ++b) red[(wave * 9 + b) * 64 + lane] = acc[b];
        __syncthreads();
        for (int i = tid; i < 576; i += 512) { const int b = i >> 6, ln = i & 63; float v = 0.f;
#pragma unroll
            for (int w = 0; w < 8; ++w) v += red[(w * 9 + b) * 64 + ln];
            v += C.a->in[IN_MODB][l * 6144 + cb * 64 + ln];
            MOD[(size_t)(l * 9 + b) * 6144 + cb * 64 + ln] = v; }
        __syncthreads();
    }
}
__device__ __forceinline__ void p0_tr_item(const float* W, int ldw, int sc0, int k0, bf16* WT, int Kd, int dr0, float scale, LAS float* scr, int lane) {
#pragma unroll 8
    for (int i = 0; i < 32; ++i) { const int kk = 2 * i + (lane >> 5); scr[kk * 33 + (lane & 31)] = W[(size_t)(k0 + kk) * ldw + sc0 + (lane & 31)]; }
    asm volatile("s_waitcnt lgkmcnt(0)" ::: "memory");
    const int c = lane & 7;
#pragma unroll
    for (int j = 0; j < 4; ++j) { const int n = (lane >> 3) + 8 * j; const LAS float* sp = scr + (8 * c) * 33 + n;
        u32x4 o; o.x = cvt_pk(sp[0 * 33] * scale, sp[1 * 33] * scale); o.y = cvt_pk(sp[2 * 33] * scale, sp[3 * 33] * scale);
        o.z = cvt_pk(sp[4 * 33] * scale, sp[5 * 33] * scale); o.w = cvt_pk(sp[6 * 33] * scale, sp[7 * 33] * scale);
        *(u32x4*)(WT + (size_t)(dr0 + n) * Kd + k0 + 8 * c) = o; }
    asm volatile("s_waitcnt lgkmcnt(0)" ::: "memory");
}
__device__ __forceinline__ void p0_tr_item8(const float* W, int ldw, int sc0, int k0, unsigned char* WT, int Kd, int dr0, float scale, LAS float* scr, int lane) {
#pragma unroll 8
    for (int i = 0; i < 64; ++i) { const int kk = 2 * i + (lane >> 5); scr[kk * 33 + (lane & 31)] = W[(size_t)(k0 + kk) * ldw + sc0 + (lane & 31)]; }
    asm volatile("s_waitcnt lgkmcnt(0)" ::: "memory");
    const int c = lane & 7;
#pragma unroll
    for (int j = 0; j < 4; ++j) { const int n = (lane >> 3) + 8 * j; const LAS float* sp = scr + (16 * c) * 33 + n;
        int w[4];
#pragma unroll
        for (int q = 0; q < 4; ++q) { int x = 0;
            x = __builtin_amdgcn_cvt_pk_fp8_f32(sp[(4 * q) * 33] * scale, sp[(4 * q + 1) * 33] * scale, x, false);
            x = __builtin_amdgcn_cvt_pk_fp8_f32(sp[(4 * q + 2) * 33] * scale, sp[(4 * q + 3) * 33] * scale, x, true); w[q] = x; }
        *(u32x4*)(WT + (size_t)(dr0 + n) * Kd + k0 + 16 * c) = (u32x4){(unsigned)w[0], (unsigned)w[1], (unsigned)w[2], (unsigned)w[3]}; }
    asm volatile("s_waitcnt lgkmcnt(0)" ::: "memory");
}
__device__ __forceinline__ int gu_src_col(int dr0) { const int pn = dr0 >> 8, bj = (dr0 >> 7) & 1, t0 = dr0 & 127; return bj * 1024 + 128 * pn + t0; }
__device__ __forceinline__ int in1_src_col(int dr0) {
    const int pn = dr0 >> 8, bj = (dr0 >> 7) & 1, t0 = dr0 & 127;
    if (pn < 4) return bj * 512 + 128 * pn + t0;
    if (pn < 8) return (bj ? 2048 : 1536) + 128 * (pn - 4) + t0;
    return 1024 + (dr0 - 2048);
}
__device__ __forceinline__ void p0_convert(const Ctx& C) {
    PH_IDS;
    LAS float* scr = (LAS float*)(C.lds + wave * 16896);
    const int gw = blockIdx.x * 8 + wave, NGW = C.G * 8;
    constexpr int KB_IN0 = F8_IN0 ? 8 : 16, KB_OUT0 = F8_OUT0 ? 12 : 24, KB_IN1 = F8_IN1 ? 8 : 16, KB_OUT1 = F8_OUT1 ? 8 : 16;
    constexpr int I_IN0 = 97 * KB_IN0, I_OUT0 = 32 * KB_OUT0, I_IN1 = 80 * KB_IN1, I_OUT1 = 32 * KB_OUT1, I_GU = 64 * 64 * 8, I_D = 64 * 32 * 8;
    constexpr int NITEMS = I_IN0 + I_OUT0 + I_IN1 + I_OUT1 + I_GU + I_D;
    for (int it = gw; it < NITEMS; it += NGW) {
        int r = it;
        if (r < I_IN0) { const int nb = r / KB_IN0, kb = r % KB_IN0; int dr0, sc0;
            if (nb < 96) { dr0 = nb * 32; sc0 = dr0; } else { dr0 = 3584; sc0 = 3072; }
            if (F8_IN0) p0_tr_item8(C.a->in[IN_EVWIN], 3616, sc0, kb * 128, (unsigned char*)(C.ws + WS_WIN0), 1024, dr0, 32.f, scr, lane);
            else p0_tr_item(C.a->in[IN_EVWIN], 3616, sc0, kb * 64, (bf16*)(C.ws + WS_WIN0), 1024, dr0, 1.f, scr, lane);
            continue; }
        r -= I_IN0;
        if (r < I_OUT0) { const int nb = r / KB_OUT0, kb = r % KB_OUT0;
            if (F8_OUT0) p0_tr_item8(C.a->in[IN_EVWOUT], 1024, nb * 32, kb * 128, (unsigned char*)(C.ws + WS_WOUT0), 1536, nb * 32, 32.f, scr, lane);
            else p0_tr_item(C.a->in[IN_EVWOUT], 1024, nb * 32, kb * 64, (bf16*)(C.ws + WS_WOUT0), 1536, nb * 32, 1.f, scr, lane);
            continue; }
        r -= I_OUT0;
        if (r < I_IN1) { const int nb = r / KB_IN1, kb = r % KB_IN1;
            if (F8_IN1) p0_tr_item8(C.a->in[IN_ODWIN], 2560, in1_src_col(nb * 32), kb * 128, (unsigned char*)(C.ws + WS_WIN1), 1024, nb * 32, 32.f, scr, lane);
            else p0_tr_item(C.a->in[IN_ODWIN], 2560, in1_src_col(nb * 32), kb * 64, (bf16*)(C.ws + WS_WIN1), 1024, nb * 32, 1.f, scr, lane);
            continue; }
        r -= I_IN1;
        if (r < I_OUT1) { const int nb = r / KB_OUT1, kb = r % KB_OUT1;
            if (F8_OUT1) p0_tr_item8(C.a->in[IN_ODWOUT], 1024, nb * 32, kb * 128, (unsigned char*)(C.ws + WS_WOUT1), 1024, nb * 32, 32.f, scr, lane);
            else p0_tr_item(C.a->in[IN_ODWOUT], 1024, nb * 32, kb * 64, (bf16*)(C.ws + WS_WOUT1), 1024, nb * 32, 1.f, scr, lane);
            continue; }
        r -= I_OUT1;
        if (r < I_GU) { const int le = r >> 9, q = r & 511, nb = q >> 3, kb = q & 7;
            p0_tr_item8(C.a->in[IN_WGU] + (size_t)le * 1024 * 2048, 2048, gu_src_col(nb * 32), kb * 128, (unsigned char*)(C.ws + WS_WGU) + (size_t)le * 2048 * 1024, 1024, nb * 32, 32.f, scr, lane); continue; }
        r -= I_GU;
        { const int le = r >> 8, q = r & 255, nb = q >> 3, kb = q & 7;
            p0_tr_item8(C.a->in[IN_WD] + (size_t)le * 1024 * 1024, 1024, nb * 32, kb * 128, (unsigned char*)(C.ws + WS_WD) + (size_t)le * 1024 * 1024, 1024, nb * 32, 32.f, scr, lane); }
    }
    { u32x4* z = (u32x4*)((unsigned char*)(C.ws + WS_WIN0) + (size_t)3616 * 1024 * (F8_IN0 ? 1 : 2)); const int n16 = 224 * 1024 * (F8_IN0 ? 1 : 2) / 16;
      for (int i = blockIdx.x * 512 + tid; i < n16; i += C.G * 512) z[i] = (u32x4){0u, 0u, 0u, 0u}; }
    { bf16* F1 = (bf16*)(C.ws + WS_F1); bf16* F2 = (bf16*)(C.ws + WS_F2);
      for (int i = blockIdx.x * 512 + tid; i < 128 * 128 + 128 * 256; i += C.G * 512) {
          if (i < 128 * 128) { const int m = i >> 7, k = i & 127; const int mb = m >> 5, rr = m & 31, g = rr >> 3, hh = (rr >> 2) & 1, ii = rr & 3;
              const int part = g & 1, ap = 16 * mb + 8 * (g >> 1) + 4 * hh + ii, pin = k >> 6, a = k & 63;
              const float th = 6.283185307179586f * (float)((a * ap) & 63) * (1.0f / 64.0f); const float cs = cosf(th), sn = sinf(th);
              const float v = (part == 0) ? (pin == 0 ? cs : -sn) : (pin == 0 ? -sn : -cs);
              F1[i] = (bf16)f2bf(v); }
          else { const int q = i - 128 * 128, m = q >> 8, k = q & 255, pin = k >> 7, b = k & 127;
              const float ps = 6.283185307179586f * (float)((b * m) & 127) * (1.0f / 128.0f);
              F2[q] = (bf16)f2bf(pin == 0 ? cosf(ps) : sinf(ps)); } } }
    __syncthreads();
}
__device__ __forceinline__ void p0_fourier_fold(const Ctx& C) {
    PH_IDS;
    LAS float* Wl = (LAS float*)C.lds;
    LAS float* tab = (LAS float*)(C.lds + 32768);
    unsigned char* WT = (unsigned char*)(C.ws + WS_WIN0);
    for (int item = blockIdx.x; item < 64; item += C.G) {
        const int kb = item >> 2, g = item & 3;
        __syncthreads();
        if (tid < 128) tab[tid] = cosf(6.283185307179586f * (float)tid * (1.0f / 128.0f));
        for (int i = tid; i < 64 * 128; i += 512) { const int kk = i >> 7, c = i & 127; Wl[i] = C.a->in[IN_EVWIN][(size_t)(kb * 64 + kk) * 3616 + 3104 + g * 128 + c]; }
        __syncthreads();
        const int cp = tid & 127, kq = tid >> 7; const bool isS = cp > 64; const int cq = isS ? cp - 64 : cp, shf = isS ? 96 : 0;
        float ac[16];
#pragma unroll
        for (int i = 0; i < 16; ++i) ac[i] = 0.f;
#pragma unroll 4
        for (int c = 0; c < 128; ++c) { const float tr = tab[(c * cq + shf) & 127];
#pragma unroll
            for (int i = 0; i < 16; ++i) ac[i] += Wl[(kq * 16 + i) * 128 + c] * tr; }
        if (F8_IN0) {
            unsigned char* pc = WT + (size_t)(3072 + g * 128 + cp) * 1024 + kb * 64 + kq * 16;
            *(u32x4*)pc = (u32x4){pk4_fp8(ac[0], ac[1], ac[2], ac[3], 32.f), pk4_fp8(ac[4], ac[5], ac[6], ac[7], 32.f), pk4_fp8(ac[8], ac[9], ac[10], ac[11], 32.f), pk4_fp8(ac[12], ac[13], ac[14], ac[15], 32.f)};
        } else {
            bf16* pc = (bf16*)WT + (size_t)(3072 + g * 128 + cp) * 1024 + kb * 64 + kq * 16;
            *(u32x4*)pc = (u32x4){cvt_pk(ac[0], ac[1]), cvt_pk(ac[2], ac[3]), cvt_pk(ac[4], ac[5]), cvt_pk(ac[6], ac[7])}; *(u32x4*)(pc + 8) = (u32x4){cvt_pk(ac[8], ac[9]), cvt_pk(ac[10], ac[11]), cvt_pk(ac[12], ac[13]), cvt_pk(ac[14], ac[15])};
        }
    }
    __syncthreads();
}

__device__ __forceinline__ void p_norm0(const Ctx& C) {
    PH_IDS;
    const int gw = blockIdx.x * 8 + wave, NGW = C.G * 8;
    const int per = (MALL + NGW - 1) / NGW;
    const int r0 = gw * per, r1 = (r0 + per < MALL) ? r0 + per : MALL;
    const float* MOD = (const float*)(C.ws + WS_MOD);
    const float* g = C.a->in[IN_NMPRE];
    unsigned char* HN = (unsigned char*)(C.ws + WS_HN);
    int curb = -1; f32x4 A[4], B[4];
    for (int r = r0; r < r1; ++r) {
        const int b = (r < MTOK) ? (r >> 13) : 8;
        if (b != curb) { curb = b;
#pragma unroll
            for (int j = 0; j < 4; ++j) { const int c = 4 * lane + 256 * j;
                const f32x4 gg = *(const f32x4*)(g + c), sc = *(const f32x4*)(MOD + (size_t)b * 6144 + 1024 + c), sh = *(const f32x4*)(MOD + (size_t)b * 6144 + c);
                A[j] = gg * (sc + 1.0f); B[j] = sh; } }
        const float* xr = (r < MTOK) ? (C.a->in[IN_X] + (size_t)r * 1024) : (C.a->in[IN_CTX] + (size_t)(r - MTOK) * 1024);
        f32x4 v[4]; float ss = 0.f;
#pragma unroll
        for (int j = 0; j < 4; ++j) { v[j] = *(const f32x4*)(xr + 4 * lane + 256 * j); ss += v[j][0] * v[j][0] + v[j][1] * v[j][1] + v[j][2] * v[j][2] + v[j][3] * v[j][3]; }
        const float rstd = rsqrtf(wave_sum(ss) * (1.0f / 1024.0f) + EPS);
#pragma unroll
        for (int j = 0; j < 4; ++j) { const f32x4 h = v[j] * rstd * A[j] + B[j];
            if (F8_IN0) *(unsigned*)(HN + (size_t)r * 1024 + 4 * lane + 256 * j) = pk4_fp8(h[0], h[1], h[2], h[3], 8.f);
            else *(u32x2*)((bf16*)HN + (size_t)r * 1024 + 4 * lane + 256 * j) = (u32x2){cvt_pk(h[0], h[1]), cvt_pk(h[2], h[3])}; }
    }
}

namespace glap {
constexpr int H_BYTES = 72704;
constexpr int O_RAW = 0, O_BC = 2048, O_TOT = 34816, O_QP = 36864, O_KP = 54272;
constexpr int NUNIT = 2 * 4 * 8 * 132;
}
__device__ __forceinline__ int gla_row(int bt, int dir, int s, int i) {
    const int ii = dir ? 63 - i : i;
    if (s < 4) { const int ci = dir ? 3 - s : s; return MTOK + bt * CTXL + ci * 64 + ii; }
    const int n = s - 4, ci = dir ? 127 - n : n; return bt * SEQ + ci * 64 + ii;
}
__device__ __forceinline__ void p_gla_prep(const Ctx& C, const int pv = 0) {
    PH_IDS;
    using namespace glap;
    const int half = tid >> 8, th = tid & 255, wh = wave & 3;
    LAS unsigned char* L = C.lds + half * H_BYTES;
    const bf16* Qg = (const bf16*)(C.ws + WS_Q); const bf16* Kg = (const bf16*)(C.ws + WS_K); const bf16* LRg = (const bf16*)(C.ws + WS_LR);
    bf16* QPg = (bf16*)(C.ws + WS_GQP); bf16* KPPg = (bf16*)(C.ws + WS_GKPP); bf16* SCg = (bf16*)(C.ws + WS_GSC); float* ELg = (float*)(C.ws + WS_GEL);
    const int niter = (NUNIT + 2 * C.G - 1) / (2 * C.G);
    const int lj = th >> 2, part = th & 3;
    u32x4 nq[4], nk[4], nlr; float nup[8], nbias;
    auto unit_of = [&](int itn) -> int { const int U = (itn * C.G + (int)blockIdx.x) * 2 + half; return U < NUNIT ? U : NUNIT - 1; };
    auto issue_loads = [&](int Uc) {
        const int sstep = Uc % 132, bt = (Uc / 132) & 7, hd = (Uc / (132 * 8)) & 3, dir = Uc / (132 * 32);
#pragma unroll
        for (int q = 0; q < 4; ++q) { const int c = th + 256 * q; const int row = gla_row(bt, dir, sstep, c >> 4);
            nk[q] = *(const u32x4*)(Kg + (size_t)row * 512 + hd * 128 + (c & 15) * 8);
            nq[q] = *(const u32x4*)(Qg + (size_t)(sstep >= 4 ? row : 0) * 512 + hd * 128 + (c & 15) * 8); }
        if (th < 128) { const int r2 = gla_row(bt, dir, sstep, th >> 1); nlr = *(const u32x4*)(LRg + (size_t)r2 * 32 + dir * 16 + (th & 1) * 8); }
        const float* up = C.a->in[IN_EVGKUP] + (size_t)dir * 16 * 512 + hd * 128 + 32 * wh + (lane & 31);
#pragma unroll
        for (int q = 0; q < 8; ++q) nup[q] = up[(size_t)(8 * (lane >> 5) + q) * 512];
        nbias = C.a->in[IN_EVGKB][dir * 512 + hd * 128 + 32 * wh + (lane & 31)]; };
    issue_loads(unit_of(0));
    for (int itn = 0; itn < niter; ++itn) {
        const int U = (itn * C.G + (int)blockIdx.x) * 2 + half;
        const bool act = U < NUNIT;
        const int Uc = act ? U : NUNIT - 1;
        const int sstep = Uc % 132;
        const bool latent = sstep >= 4;
        u32x4 rq[4], rk[4], rlr = nlr;
#pragma unroll
        for (int q = 0; q < 4; ++q) { rq[q] = nq[q]; rk[q] = nk[q]; }
        bf16x8 upf; const float gbias = nbias;
        { unsigned short tmp[8];
#pragma unroll
          for (int q = 0; q < 8; ++q) tmp[q] = (unsigned short)f2bf(nup[q]);
          upf = (bf16x8){(short)tmp[0], (short)tmp[1], (short)tmp[2], (short)tmp[3], (short)tmp[4], (short)tmp[5], (short)tmp[6], (short)tmp[7]}; }
        if (itn + 1 < niter) issue_loads(unit_of(itn + 1));
        __syncthreads();
        if (th < 128) *(LAS u32x4*)(L + O_RAW + (th >> 1) * 32 + (th & 1) * 16) = rlr;
        __syncthreads();
#pragma unroll
        for (int jb = 0; jb < 2; ++jb) {
            const bf16x8 af = *(const LAS bf16x8*)(L + O_RAW + (32 * jb + (lane & 31)) * 32 + (lane >> 5) * 16);
            f32x16 z;
#pragma unroll
            for (int i = 0; i < 16; ++i) z[i] = 0.f;
            z = __builtin_amdgcn_mfma_f32_32x32x16_bf16(af, upf, z, 0, 0, 0);
#pragma unroll
            for (int r = 0; r < 16; ++r) { const int j = 32 * jb + (r & 3) + 8 * (r >> 2) + 4 * (lane >> 5); const float zz = z[r] + gbias;
                const float ls = fminf(zz, 0.f) - __logf(1.0f + __expf(-fabsf(zz)));
                *(LAS float*)(L + O_BC + (j * 128 + 32 * wh + (lane & 31)) * 4) = ls * 0.0625f; } }
        __syncthreads();
        { const int dk = th & 127;
          float run0 = 0.f, run1 = 0.f; const int g0 = th >> 7, g1 = g0 + 2;
          float v0[16], v1[16];
#pragma unroll
          for (int q = 0; q < 16; ++q) { v0[q] = *(const LAS float*)(L + O_BC + ((16 * g0 + q) * 128 + dk) * 4); v1[q] = *(const LAS float*)(L + O_BC + ((16 * g1 + q) * 128 + dk) * 4); }
#pragma unroll
          for (int q = 0; q < 16; ++q) { run0 += v0[q]; run1 += v1[q];
              *(LAS float*)(L + O_BC + ((16 * g0 + q) * 128 + dk) * 4) = run0; *(LAS float*)(L + O_BC + ((16 * g1 + q) * 128 + dk) * 4) = run1; }
          *(LAS float*)(L + O_TOT + (g0 * 128 + dk) * 4) = run0; *(LAS float*)(L + O_TOT + (g1 * 128 + dk) * 4) = run1; }
        __syncthreads();
        {
#pragma unroll
          for (int q8 = 0; q8 < 4; ++q8) {
              const int c = th + 256 * q8, cj = c >> 4, jg = cj >> 4, dkc = (c & 15) * 8;
              u32x4 oq, okpp;
#pragma unroll
              for (int hq = 0; hq < 2; ++hq) {
                  const int dk0 = dkc + 4 * hq;
                  f32x4 b = *(const LAS f32x4*)(L + O_BC + (cj * 128 + dk0) * 4), tt = (f32x4){0.f, 0.f, 0.f, 0.f};
#pragma unroll
                  for (int g2 = 0; g2 < 4; ++g2) { const f32x4 tv = *(const LAS f32x4*)(L + O_TOT + (g2 * 128 + dk0) * 4); tt += tv; if (g2 < jg) b += tv; }
                  f32x4 e1, e2, e3;
#pragma unroll
                  for (int i = 0; i < 4; ++i) { if (pv & 4) { e1[i] = b[i]; e2[i] = -b[i]; e3[i] = tt[i] - b[i]; } else { e1[i] = __expf(b[i]); e2[i] = __expf(-b[i]); e3[i] = __expf(tt[i] - b[i]); } }
                  if (cj == 0 && act && !(pv & 1)) { f32x4 el;
#pragma unroll
                      for (int i = 0; i < 4; ++i) el[i] = __expf(tt[i]);
                      *(f32x4*)(ELg + (size_t)Uc * 128 + dk0) = el; }
                  const unsigned qa = hq ? rq[q8].z : rq[q8].x, qb = hq ? rq[q8].w : rq[q8].y;
                  const unsigned ka = hq ? rk[q8].z : rk[q8].x, kb = hq ? rk[q8].w : rk[q8].y;
                  const float q0 = bf_lo(qa), q1 = bf_hi(qa), q2 = bf_lo(qb), q3 = bf_hi(qb);
                  const float k0 = bf_lo(ka), k1 = bf_hi(ka), k2 = bf_lo(kb), k3 = bf_hi(kb);
                  u32x2 o;
                  o.x = cvt_pk(q0 * e1[0], q1 * e1[1]); o.y = cvt_pk(q2 * e1[2], q3 * e1[3]); *(LAS u32x2*)(L + O_QP + cj * 272 + dk0 * 2) = o;
                  if (hq) { oq.z = o.x; oq.w = o.y; } else { oq.x = o.x; oq.y = o.y; }
                  o.x = cvt_pk(k0 * e2[0], k1 * e2[1]); o.y = cvt_pk(k2 * e2[2], k3 * e2[3]); *(LAS u32x2*)(L + O_KP + cj * 272 + dk0 * 2) = o;
                  o.x = cvt_pk(k0 * e3[0], k1 * e3[1]); o.y = cvt_pk(k2 * e3[2], k3 * e3[3]);
                  if (hq) { okpp.z = o.x; okpp.w = o.y; } else { okpp.x = o.x; okpp.y = o.y; }
              }
              if (act && !(pv & 1)) { *(u32x4*)(KPPg + (size_t)Uc * 8192 + c * 8) = okpp; if (latent) *(u32x4*)(QPg + (size_t)Uc * 8192 + c * 8) = oq; }
              else asm volatile("" :: "v"(okpp), "v"(oq));
          } }
        __syncthreads();
        if (latent && act && !(pv & 2)) {
            const int ib = wh;
            for (int jb16 = 0; jb16 <= ib; ++jb16) {
                f32x4 d = (f32x4){0.f, 0.f, 0.f, 0.f};
#pragma unroll
                for (int ks = 0; ks < 4; ++ks) {
                    const bf16x8 a = *(const LAS bf16x8*)(L + O_KP + (16 * jb16 + (lane & 15)) * 272 + (32 * ks + 8 * (lane >> 4)) * 2);
                    const bf16x8 bq = *(const LAS bf16x8*)(L + O_QP + (16 * ib + (lane & 15)) * 272 + (32 * ks + 8 * (lane >> 4)) * 2);
                    d = __builtin_amdgcn_mfma_f32_16x16x32_bf16(a, bq, d, 0, 0, 0); }
                const int i = 16 * ib + (lane & 15), j0 = 16 * jb16 + 4 * (lane >> 4);
#pragma unroll
                for (int r = 0; r < 4; ++r) if (j0 + r > i) d[r] = 0.f;
                u32x2 o; o.x = cvt_pk(d[0], d[1]); o.y = cvt_pk(d[2], d[3]);
                if (!(pv & 1)) *(u32x2*)(SCg + (size_t)Uc * 4096 + i * 64 + j0) = o; else asm volatile("" :: "v"(o));
            }
            for (int jb16 = ib + 1; jb16 < 4; ++jb16) { const int i = 16 * ib + (lane & 15), j0 = 16 * jb16 + 4 * (lane >> 4);
                if (!(pv & 1)) *(u32x2*)(SCg + (size_t)Uc * 4096 + i * 64 + j0) = (u32x2){0u, 0u}; }
        }
    }
    __syncthreads();
}
namespace gla {
constexpr int O_EL = 0, O_QP = 512, O_KPP = 17920, O_V = 38400, O_SC = 50688, IMG_BYTES = 59904, O_ST = 2 * IMG_BYTES;
constexpr int P_QP = 272, P_KPP = 320, P_V = 192, P_SC = 144, P_ST = 272, ST_BYTES = 64 * 272;
__device__ __forceinline__ bf16x8 tr8(LAS unsigned char* p0, LAS unsigned char* p1) {
    const s16x4 a = __builtin_amdgcn_ds_read_tr16_b64_v4i16((LAS s16x4*)p0);
    const s16x4 b = __builtin_amdgcn_ds_read_tr16_b64_v4i16((LAS s16x4*)p1);
    return (bf16x8){a[0], a[1], a[2], a[3], b[0], b[1], b[2], b[3]};
}
}
__device__ __forceinline__ void p_gla(const Ctx& C, const int probe = 0) {
    PH_IDS;
    using namespace gla;
    LAS unsigned char* L = C.lds;
    const int t = tid, w = wave;
    const bf16* Vg = (const bf16*)(C.ws + WS_V);
    const bf16* QPg = (const bf16*)(C.ws + WS_GQP); const bf16* KPPg = (const bf16*)(C.ws + WS_GKPP); const bf16* SCg = (const bf16*)(C.ws + WS_GSC); const float* ELg = (const float*)(C.ws + WS_GEL);
    for (int it = blockIdx.x; it < 256; it += C.G) {
        const int xx = it & 7, jj_ = it >> 3, scan = xx * 8 + (jj_ >> 2), dvs = jj_ & 3;
        const int bt = scan >> 3, hd = (scan >> 1) & 3, dir = scan & 1;
        const int ubase = ((dir * 4 + hd) * 8 + bt) * 132;
        bf16* Og = (bf16*)(C.ws + (probe ? WS_HN : (dir ? WS_OB : WS_OF)));
        __syncthreads();
        for (int i = t; i < ST_BYTES / 16; i += 512) *(LAS u32x4*)(L + O_ST + i * 16) = (u32x4){0u, 0u, 0u, 0u};
        f32x16 S;
#pragma unroll
        for (int i = 0; i < 16; ++i) S[i] = 0.f;
        const int lj = t >> 3, part = t & 7;
        u32x4 rsc, rqp0, rqp1, rkp0, rkp1, rv; f32x4 rel;
        u32x4 nsc, nqp0, nqp1, nkp0, nkp1, nv; f32x4 nel;
        auto load_step = [&](int s_) {
            const int s = probe ? 4 + (s_ & 1) : s_;
            const size_t U = (size_t)(ubase + s);
            const int row = gla_row(bt, dir, s, lj);
            nv = *(const u32x4*)(Vg + (size_t)row * 1024 + hd * 256 + dvs * 64 + part * 8);
            const bf16* kp = KPPg + U * 8192 + t * 8; nkp0 = *(const u32x4*)kp; nkp1 = *(const u32x4*)(kp + 4096);
            if (t < 32) nel = *(const f32x4*)(ELg + U * 128 + t * 4);
            if (s >= 4) { const bf16* qp = QPg + U * 8192 + t * 8; nqp0 = *(const u32x4*)qp; nqp1 = *(const u32x4*)(qp + 4096);
                nsc = *(const u32x4*)(SCg + U * 4096 + lj * 64 + part * 8); } };
        auto shift_regs = [&]() { rsc = nsc; rqp0 = nqp0; rqp1 = nqp1; rkp0 = nkp0; rkp1 = nkp1; rv = nv; rel = nel; };
        auto write_images = [&](int s, int ib_) {
            LAS unsigned char* I = L + ib_ * IMG_BYTES;
            *(LAS u32x4*)(I + O_V + lj * P_V + part * 16) = rv;
            *(LAS u32x4*)(I + O_KPP + (t >> 4) * P_KPP + (t & 15) * 16) = rkp0; *(LAS u32x4*)(I + O_KPP + (32 + (t >> 4)) * P_KPP + (t & 15) * 16) = rkp1;
            if (t < 32) *(LAS f32x4*)(I + O_EL + t * 16) = rel;
            if (s >= 4) { *(LAS u32x4*)(I + O_QP + (t >> 4) * P_QP + (t & 15) * 16) = rqp0; *(LAS u32x4*)(I + O_QP + (32 + (t >> 4)) * P_QP + (t & 15) * 16) = rqp1;
                *(LAS u32x4*)(I + O_SC + lj * P_SC + part * 16) = rsc; } };
        load_step(0); shift_regs(); write_images(0, 0);
        load_step(1); shift_regs();
        load_step(2);
        for (int s = 0; s < 132; ++s) {
            const int cur = s & 1, nx = cur ^ 1;
            const bool latent = (s >= 4);
            LAS unsigned char* I = L + cur * IMG_BYTES;
            __syncthreads();
            if (s + 1 < 132) write_images(s + 1, nx);
            shift_regs();
            if (s + 3 < 132) load_step(s + 3);
            if (latent) {
                const int ib = w >> 1;
                const int g4 = lane >> 4, q4 = (lane & 15) >> 2, p4 = lane & 3;
                const int orow = gla_row(bt, dir, s, 16 * ib + (lane & 15));
#pragma unroll
                for (int cc = 0; cc < 2; ++cc) {
                    const int c = 2 * (w & 1) + cc;
                    f32x4 d = (f32x4){0.f, 0.f, 0.f, 0.f};
#pragma unroll
                    for (int ks = 0; ks < 2; ++ks) {
                        LAS unsigned char* pa = I + O_V + (32 * ks + 8 * g4 + q4) * P_V + (16 * c + 4 * p4) * 2;
                        const bf16x8 a = gla::tr8(pa, pa + 4 * P_V);
                        const bf16x8 b = *(const LAS bf16x8*)(I + O_SC + (16 * ib + (lane & 15)) * P_SC + (32 * ks + 8 * g4) * 2);
                        d = __builtin_amdgcn_mfma_f32_16x16x32_bf16(a, b, d, 0, 0, 0); }
#pragma unroll
                    for (int ks = 0; ks < 4; ++ks) {
                        const bf16x8 a = *(const LAS bf16x8*)(L + O_ST + cur * ST_BYTES + (16 * c + (lane & 15)) * P_ST + (32 * ks + 8 * g4) * 2);
                        const bf16x8 b = *(const LAS bf16x8*)(I + O_QP + (16 * ib + (lane & 15)) * P_QP + (32 * ks + 8 * g4) * 2);
                        d = __builtin_amdgcn_mfma_f32_16x16x32_bf16(a, b, d, 0, 0, 0); }
                    u32x2 o; o.x = cvt_pk(d[0], d[1]); o.y = cvt_pk(d[2], d[3]);
                    *(u32x2*)(Og + (size_t)orow * 1024 + hd * 256 + dvs * 64 + 16 * c + 4 * g4) = o;
                }
            }
            { const int dbS = w & 3, dvb = w >> 2, hh = lane >> 5, blk = (lane >> 4) & 1, q4 = (lane & 15) >> 2, p4 = lane & 3;
#pragma unroll
              for (int g = 0; g < 4; ++g) { const f32x4 el = *(const LAS f32x4*)(I + O_EL + (32 * dbS + 8 * g + 4 * hh) * 4);
#pragma unroll
                  for (int i = 0; i < 4; ++i) S[4 * g + i] *= el[i]; }
#pragma unroll
              for (int ks = 0; ks < 4; ++ks) {
                  LAS unsigned char* pa = I + O_KPP + (16 * ks + 8 * hh + q4) * P_KPP + (32 * dbS + 16 * blk + 4 * p4) * 2;
                  LAS unsigned char* pb = I + O_V + (16 * ks + 8 * hh + q4) * P_V + (32 * dvb + 16 * blk + 4 * p4) * 2;
                  const bf16x8 a = gla::tr8(pa, pa + 4 * P_KPP);
                  const bf16x8 b = gla::tr8(pb, pb + 4 * P_V);
                  S = __builtin_amdgcn_mfma_f32_32x32x16_bf16(a, b, S, 0, 0, 0); }
#pragma unroll
              for (int g = 0; g < 4; ++g) { u32x2 o; o.x = cvt_pk(S[4 * g], S[4 * g + 1]); o.y = cvt_pk(S[4 * g + 2], S[4 * g + 3]);
                  *(LAS u32x2*)(L + O_ST + nx * ST_BYTES + (32 * dvb + (lane & 31)) * P_ST + (32 * dbS + 8 * g + 4 * hh) * 2) = o; } }
        }
    }
}

__device__ __forceinline__ void p_fft1(const Ctx& C) {
    PH_IDS;
    LAS unsigned char* L = C.lds;
    const int t = tid, w = wave, mb = w & 3, nh = w >> 2, hh = lane >> 5;
    const bf16* F1 = (const bf16*)(C.ws + WS_F1);
    bf16x8 af[8];
#pragma unroll
    for (int ks = 0; ks < 8; ++ks) af[ks] = *(const bf16x8*)(F1 + (32 * mb + (lane & 31)) * 128 + 16 * ks + 8 * hh);
    const bf16* ZZ = (const bf16*)(C.ws + WS_ZC);
    bf16* YR = (bf16*)(C.ws + WS_YR); bf16* YI = (bf16*)(C.ws + WS_YI);
    const int blk = (lane >> 4) & 1, q4 = (lane & 15) >> 2, p4 = lane & 3;
    constexpr int RAWB = 73728;
    u32x4 pv[4];
    auto fetch1 = [&](int unit) { const int bt = unit >> 8, b = (unit >> 1) & 127, chh = unit & 1; const int a = t >> 3, part = t & 7;
        const bf16* src = ZZ + (size_t)(bt * SEQ + 128 * a + b) * 512 + chh * 256 + part * 32;
#pragma unroll
        for (int i = 0; i < 4; ++i) pv[i] = *(const u32x4*)(src + 8 * i); };
    if ((int)blockIdx.x < 2048) fetch1(blockIdx.x);
    for (int unit = blockIdx.x; unit < 2048; unit += C.G) {
        const int bt = unit >> 8, b = (unit >> 1) & 127, chh = unit & 1;
        __syncthreads();
        { const int a = t >> 3, part = t & 7;
#pragma unroll
          for (int i = 0; i < 4; ++i) *(LAS u32x4*)(L + RAWB + a * 528 + part * 64 + i * 16) = pv[i]; }
        __syncthreads();
        { const int row = t >> 2, quarter = t & 3, pin = row >> 6, a = row & 63, gl = quarter >> 1, half = quarter & 1;
          const LAS unsigned char* rp = L + RAWB + a * 528 + gl * 256;
#pragma unroll
          for (int ci = 0; ci < 8; ++ci) { unsigned wv[4];
#pragma unroll
              for (int j = 0; j < 8; ++j) { const int e = 8 * ci + j;
                  const int col = pin ? (half ? 128 - e : 64 + e) : (half ? (e == 0 ? 64 : 64 - e) : e);
                  unsigned v = (unsigned)*(const LAS unsigned short*)(rp + (col & 127) * 2);
                  if (pin && half) v ^= 0x8000u;
                  if (pin && e == 0) v = 0u;
                  if (j & 1) wv[j >> 1] |= v << 16; else wv[j >> 1] = v; }
              *(LAS u32x4*)(L + row * 576 + quarter * 128 + ci * 16) = (u32x4){wv[0], wv[1], wv[2], wv[3]}; } }
        __syncthreads();
        if (unit + C.G < 2048) fetch1(unit + C.G);
#pragma unroll 1
        for (int nb = 0; nb < 4; ++nb) {
            const int c = 4 * nh + nb;
            f32x16 acc;
#pragma unroll
            for (int i = 0; i < 16; ++i) acc[i] = 0.f;
#pragma unroll
            for (int ks = 0; ks < 8; ++ks) {
                LAS unsigned char* pb = L + (16 * ks + 8 * hh + q4) * 576 + (32 * c + 16 * blk + 4 * p4) * 2;
                const bf16x8 bfr = gla::tr8(pb, pb + 4 * 576);
                acc = __builtin_amdgcn_mfma_f32_32x32x16_bf16(af[ks], bfr, acc, 0, 0, 0); }
#pragma unroll
            for (int gp = 0; gp < 2; ++gp)
#pragma unroll
                for (int i = 0; i < 4; ++i) { const int ap = 16 * mb + 8 * gp + 4 * hh + i; const float re = acc[8 * gp + i], im = acc[8 * gp + 4 + i];
                    const float ph = (float)((b * ap) & 8191) * (1.0f / 8192.0f); const float cs = __builtin_amdgcn_cosf(ph), sn = __builtin_amdgcn_sinf(ph);
                    const int so = ap * 528 + (32 * c + (lane & 31)) * 2;
                    *(LAS unsigned short*)(L + 73728 + so) = (unsigned short)f2bf(re * cs + im * sn);
                    *(LAS unsigned short*)(L + 73728 + 64 * 528 + so) = (unsigned short)f2bf(im * cs - re * sn); }
        }
        __syncthreads();
        { const int orow = t >> 2, quarter = t & 3, plane = orow >> 6, ap = orow & 63;
          bf16* dst = (plane ? YI : YR) + ((size_t)(bt * 64 + ap) * 128 + b) * 512 + chh * 256 + quarter * 64;
#pragma unroll
          for (int i = 0; i < 8; ++i) *(u32x4*)(dst + 8 * i) = *(const LAS u32x4*)(L + 73728 + orow * 528 + quarter * 128 + i * 16); }
    }
    __syncthreads();
}
__device__ __forceinline__ void p_fft2(const Ctx& C) {
    PH_IDS;
    LAS unsigned char* L = C.lds;
    const int t = tid, w = wave, mb = w & 3, nh = w >> 2, hh = lane >> 5;
    const bf16* F2 = (const bf16*)(C.ws + WS_F2);
    bf16x8 af[16];
#pragma unroll
    for (int ks = 0; ks < 16; ++ks) af[ks] = *(const bf16x8*)(F2 + (32 * mb + (lane & 31)) * 256 + 16 * ks + 8 * hh);
    const bf16* YR = (const bf16*)(C.ws + WS_YR); const bf16* YI = (const bf16*)(C.ws + WS_YI);
    unsigned char* A2 = (unsigned char*)(C.ws + WS_A2);
    const int blk = (lane >> 4) & 1, q4 = (lane & 15) >> 2, p4 = lane & 3;
    u32x4 pv[8];
    auto fetch2 = [&](int unit) { const int bt = unit >> 8, ap = (unit >> 2) & 63, cht = unit & 3; const int row = t >> 1, half = t & 1, pin = row >> 7, b = row & 127;
        const bf16* src = (pin ? YI : YR) + ((size_t)(bt * 64 + ap) * 128 + b) * 512 + cht * 128 + half * 64;
#pragma unroll
        for (int i = 0; i < 8; ++i) pv[i] = *(const u32x4*)(src + 8 * i); };
    if ((int)blockIdx.x < 2048) fetch2(blockIdx.x);
    for (int unit = blockIdx.x; unit < 2048; unit += C.G) {
        const int bt = unit >> 8, ap = (unit >> 2) & 63, cht = unit & 3;
        __syncthreads();
        { const int row = t >> 1, half = t & 1;
#pragma unroll
          for (int i = 0; i < 8; ++i) *(LAS u32x4*)(L + row * 320 + half * 128 + i * 16) = pv[i]; }
        __syncthreads();
        if (unit + C.G < 2048) fetch2(unit + C.G);
#pragma unroll 1
        for (int nb = 0; nb < 2; ++nb) {
            const int c = 2 * nh + nb;
            f32x16 acc;
#pragma unroll
            for (int i = 0; i < 16; ++i) acc[i] = 0.f;
#pragma unroll
            for (int ks = 0; ks < 16; ++ks) {
                LAS unsigned char* pb = L + (16 * ks + 8 * hh + q4) * 320 + (32 * c + 16 * blk + 4 * p4) * 2;
                const bf16x8 bfr = gla::tr8(pb, pb + 4 * 320);
                acc = __builtin_amdgcn_mfma_f32_32x32x16_bf16(af[ks], bfr, acc, 0, 0, 0); }
#pragma unroll
            for (int r = 0; r < 16; ++r) { const int bp = 32 * mb + (r & 3) + 8 * (r >> 2) + 4 * hh;
                if (F8_OUT0) *(LAS unsigned char*)(L + 81920 + bp * 144 + 32 * c + (lane & 31)) = (unsigned char)(pk4_fp8(acc[r], 0.f, 0.f, 0.f, 8.0f / 1024.0f) & 0xffu);
                else *(LAS unsigned short*)(L + 81920 + bp * 272 + (32 * c + (lane & 31)) * 2) = (unsigned short)f2bf(acc[r] * (1.0f / 1024.0f)); }
        }
        __syncthreads();
        { const int bp = t >> 2, quarter = t & 3; const size_t tok = (size_t)bt * SEQ + ap + 64 * bp;
          if (F8_OUT0) { unsigned char* dst = A2 + tok * 1536 + 1024 + cht * 128 + quarter * 32;
#pragma unroll
              for (int i = 0; i < 2; ++i) *(u32x4*)(dst + 16 * i) = *(const LAS u32x4*)(L + 81920 + bp * 144 + quarter * 32 + i * 16); }
          else { bf16* dst = (bf16*)A2 + tok * 1536 + 1024 + cht * 128 + quarter * 32;
#pragma unroll
              for (int i = 0; i < 4; ++i) *(u32x4*)(dst + 8 * i) = *(const LAS u32x4*)(L + 81920 + bp * 272 + quarter * 64 + i * 16); } }
    }
    __syncthreads();
}
__device__ __forceinline__ void p_gla_out(const Ctx& C) {
    PH_IDS;
    const int gw = blockIdx.x * 8 + wave, NGW = C.G * 8;
    const bf16* OF = (const bf16*)(C.ws + WS_OF); const bf16* OB = (const bf16*)(C.ws + WS_OB); const bf16* Rg = (const bf16*)(C.ws + WS_R);
    unsigned char* A2 = (unsigned char*)(C.ws + WS_A2);
    float gn[16];
#pragma unroll
    for (int i = 0; i < 16; ++i) gn[i] = C.a->in[IN_EVGNORM][16 * (lane & 15) + i];
    for (int r = gw; r < MTOK; r += NGW) {
        const u32x4 f0 = *(const u32x4*)(OF + (size_t)r * 1024 + 16 * lane), f1 = *(const u32x4*)(OF + (size_t)r * 1024 + 16 * lane + 8);
        const u32x4 b0 = *(const u32x4*)(OB + (size_t)r * 1024 + 16 * lane), b1 = *(const u32x4*)(OB + (size_t)r * 1024 + 16 * lane + 8);
        const u32x4 g0 = *(const u32x4*)(Rg + (size_t)r * 1024 + 16 * lane), g1 = *(const u32x4*)(Rg + (size_t)r * 1024 + 16 * lane + 8);
        float o[16], rr[16];
#pragma unroll
        for (int i = 0; i < 4; ++i) { const unsigned fa = f0[i], fb = f1[i], ba = b0[i], bb = b1[i], ga = g0[i], gb = g1[i];
            o[2 * i] = bf_lo(fa) + bf_lo(ba); o[2 * i + 1] = bf_hi(fa) + bf_hi(ba); o[8 + 2 * i] = bf_lo(fb) + bf_lo(bb); o[8 + 2 * i + 1] = bf_hi(fb) + bf_hi(bb);
            rr[2 * i] = bf_lo(ga); rr[2 * i + 1] = bf_hi(ga); rr[8 + 2 * i] = bf_lo(gb); rr[8 + 2 * i + 1] = bf_hi(gb); }
        float ss = 0.f;
#pragma unroll
        for (int i = 0; i < 16; ++i) ss += o[i] * o[i];
        ss = row16_sum(ss);
        const float rstd = rsqrtf(ss * (1.0f / 256.0f) + EPS);
        float y[16];
#pragma unroll
        for (int i = 0; i < 16; ++i) y[i] = o[i] * rstd * gn[i] * siluf_(rr[i]);
        if (F8_OUT0) *(u32x4*)(A2 + (size_t)r * 1536 + 16 * lane) = (u32x4){pk4_fp8(y[0], y[1], y[2], y[3], 8.f), pk4_fp8(y[4], y[5], y[6], y[7], 8.f), pk4_fp8(y[8], y[9], y[10], y[11], 8.f), pk4_fp8(y[12], y[13], y[14], y[15], 8.f)};
        else { bf16* a2 = (bf16*)A2 + (size_t)r * 1536 + 16 * lane;
            *(u32x4*)a2 = (u32x4){cvt_pk(y[0], y[1]), cvt_pk(y[2], y[3]), cvt_pk(y[4], y[5]), cvt_pk(y[6], y[7])}; *(u32x4*)(a2 + 8) = (u32x4){cvt_pk(y[8], y[9]), cvt_pk(y[10], y[11]), cvt_pk(y[12], y[13]), cvt_pk(y[14], y[15])}; }
    }
}

__device__ __forceinline__ void p_postmix(const Ctx& C, const int layer) {
    PH_IDS;
    LAS float* WR = (LAS float*)C.lds;
    LAS int* hist = (LAS int*)(C.lds + 131072);
    LAS float* Lg = (LAS float*)(C.lds + 131584 + wave * 2112);
    const float* rw = C.a->in[IN_RW] + (size_t)layer * 1024 * 32;
    __syncthreads();
    for (int it0 = 0; it0 < 64; it0 += 16) {
        float tmpw[16];
#pragma unroll
        for (int q = 0; q < 16; ++q) tmpw[q] = rw[tid + 512 * (it0 + q)];
#pragma unroll
        for (int q = 0; q < 16; ++q) { const int idx = tid + 512 * (it0 + q); const int c = idx >> 5, e = idx & 31; const int ln = (c & 255) >> 2, j = c >> 8, i = c & 3;
            WR[(((j * 4 + i) * 8 + (e >> 2)) * 64 + ln) * 4 + (e & 3)] = tmpw[q]; } }
    if (tid < 32) hist[tid] = 0;
    __syncthreads();
    const float* MOD = (const float*)(C.ws + WS_MOD) + (size_t)layer * 9 * 6144;
    const float* gpost = C.a->in[IN_NMPOST] + layer * 1024; const float* gffn = C.a->in[IN_NFPRE] + layer * 1024;
    const bf16* Y = (const bf16*)(C.ws + WS_Y);
    const float* xin = C.a->in[IN_X];
    bf16* XS = (bf16*)(C.ws + WS_XS);
    unsigned char* H2 = (unsigned char*)(C.ws + WS_H2);
    int* TK = (int*)(C.ws + WS_TOPK); float* GT = (float*)(C.ws + WS_GATE);
    const int rows_per_blk = MTOK / C.G, rows_per_wave = rows_per_blk / 8;
    const int r0 = blockIdx.x * rows_per_blk + wave * rows_per_wave;
    const int b = r0 >> 13;
    const float rbias = C.a->in[IN_RB][layer * 32 + ((lane >> 1) & 31)];
    float cA1[16], cA2[16], cB2[16];
#pragma unroll
    for (int j = 0; j < 4; ++j) { const int c = 4 * lane + 256 * j;
        const f32x4 gp = *(const f32x4*)(gpost + c), gm = *(const f32x4*)(MOD + (size_t)b * 6144 + 2048 + c);
        const f32x4 gf = *(const f32x4*)(gffn + c), sc = *(const f32x4*)(MOD + (size_t)b * 6144 + 4096 + c), sh = *(const f32x4*)(MOD + (size_t)b * 6144 + 3072 + c);
#pragma unroll
        for (int i = 0; i < 4; ++i) { cA1[4 * j + i] = gp[i] * gm[i]; cA2[4 * j + i] = gf[i] * (1.0f + sc[i]); cB2[4 * j + i] = sh[i]; } }
    auto ldx = [&](int r, int j) -> f32x4 {
        if (layer == 0) return *(const f32x4*)(xin + (size_t)r * 1024 + 4 * lane + 256 * j);
        const u32x2 v = *(const u32x2*)(XS + (size_t)r * 1024 + 4 * lane + 256 * j); return (f32x4){bf_lo(v.x), bf_hi(v.x), bf_lo(v.y), bf_hi(v.y)}; };
    u32x2 ny[4]; f32x4 nx[4];
#pragma unroll
    for (int j = 0; j < 4; ++j) { ny[j] = *(const u32x2*)(Y + (size_t)r0 * 1024 + 4 * lane + 256 * j); nx[j] = ldx(r0, j); }
    for (int r = r0; r < r0 + rows_per_wave; ++r) {
        float h[16];
        u32x2 cy[4]; f32x4 cx[4];
#pragma unroll
        for (int j = 0; j < 4; ++j) { cy[j] = ny[j]; cx[j] = nx[j]; }
        if (r + 1 < r0 + rows_per_wave) {
#pragma unroll
            for (int j = 0; j < 4; ++j) { ny[j] = *(const u32x2*)(Y + (size_t)(r + 1) * 1024 + 4 * lane + 256 * j); nx[j] = ldx(r + 1, j); } }
        { float ssy = 0.f; float yv[16];
#pragma unroll
          for (int j = 0; j < 4; ++j) { const u32x2 yy = cy[j];
              yv[4 * j] = bf_lo(yy.x); yv[4 * j + 1] = bf_hi(yy.x); yv[4 * j + 2] = bf_lo(yy.y); yv[4 * j + 3] = bf_hi(yy.y); }
#pragma unroll
          for (int i = 0; i < 16; ++i) ssy += yv[i] * yv[i];
          const float rstd = rsqrtf(wave_sum(ssy) * (1.0f / 1024.0f) + EPS);
          float ss1 = 0.f;
#pragma unroll
          for (int j = 0; j < 4; ++j) { const int c = 4 * lane + 256 * j;
              const f32x4 xv = cx[j];
              f32x4 o;
#pragma unroll
              for (int i = 0; i < 4; ++i) { o[i] = xv[i] + cA1[4 * j + i] * (yv[4 * j + i] * rstd); h[4 * j + i] = o[i]; ss1 += o[i] * o[i]; }
              { u32x2 xw; xw.x = cvt_pk(o[0], o[1]); xw.y = cvt_pk(o[2], o[3]); *(u32x2*)(XS + (size_t)r * 1024 + c) = xw; } }
          const float rstd1 = rsqrtf(wave_sum(ss1) * (1.0f / 1024.0f) + EPS);
#pragma unroll
          for (int j = 0; j < 4; ++j) { const int c = 4 * lane + 256 * j;
#pragma unroll
              for (int i = 0; i < 4; ++i) h[4 * j + i] = h[4 * j + i] * rstd1 * cA2[4 * j + i] + cB2[4 * j + i];
              int wv = 0;
              wv = __builtin_amdgcn_cvt_pk_fp8_f32(fminf(fmaxf(h[4 * j] * 8.0f, -440.f), 440.f), fminf(fmaxf(h[4 * j + 1] * 8.0f, -440.f), 440.f), wv, false);
              wv = __builtin_amdgcn_cvt_pk_fp8_f32(fminf(fmaxf(h[4 * j + 2] * 8.0f, -440.f), 440.f), fminf(fmaxf(h[4 * j + 3] * 8.0f, -440.f), 440.f), wv, true);
              *(int*)(H2 + (size_t)r * 1024 + c) = wv; } }
        float p[32];
#pragma unroll
        for (int e = 0; e < 32; ++e) p[e] = 0.f;
        { f32x4 wb[2][8];
#pragma unroll
          for (int eq = 0; eq < 8; ++eq) wb[0][eq] = *(const LAS f32x4*)(WR + ((0 * 8 + eq) * 64 + lane) * 4);
#pragma unroll
          for (int jj = 0; jj < 16; ++jj) {
              if (jj + 1 < 16) {
#pragma unroll
                  for (int eq = 0; eq < 8; ++eq) wb[(jj + 1) & 1][eq] = *(const LAS f32x4*)(WR + (((jj + 1) * 8 + eq) * 64 + lane) * 4); }
#pragma unroll
              for (int eq = 0; eq < 8; ++eq)
#pragma unroll
                  for (int i = 0; i < 4; ++i) p[4 * eq + i] += h[jj] * wb[jj & 1][eq][i];
              asm volatile("" ::: "memory"); } }
        float q16[16], q8[8], q4v[4], q2[2], q1;
#pragma unroll
        for (int k = 0; k < 16; ++k) q16[k] = swap32_sum(p[k], p[16 + k]);
#pragma unroll
        for (int k = 0; k < 8; ++k) q8[k] = swap16_sum(q16[k], q16[8 + k]);
        { const bool hi = (lane & 8) != 0;
#pragma unroll
          for (int k = 0; k < 4; ++k) { const float send = hi ? q8[k] : q8[4 + k], keep = hi ? q8[4 + k] : q8[k];
              q4v[k] = keep + __builtin_bit_cast(float, __builtin_amdgcn_update_dpp(0, __builtin_bit_cast(int, send), 0x128, 0xF, 0xF, true)); } }
        { const bool hi = (lane & 4) != 0;
#pragma unroll
          for (int k = 0; k < 2; ++k) { const float send = hi ? q4v[k] : q4v[2 + k], keep = hi ? q4v[2 + k] : q4v[k];
              int rv = __builtin_amdgcn_update_dpp(0, __builtin_bit_cast(int, send), 0x104, 0xF, 0x5, false);
              rv = __builtin_amdgcn_update_dpp(rv, __builtin_bit_cast(int, send), 0x114, 0xF, 0xA, false);
              q2[k] = keep + __builtin_bit_cast(float, rv); } }
        { const bool hi = (lane & 2) != 0; const float send = hi ? q2[0] : q2[1], keep = hi ? q2[1] : q2[0];
          q1 = keep + __builtin_bit_cast(float, __builtin_amdgcn_update_dpp(0, __builtin_bit_cast(int, send), 0x4E, 0xF, 0xF, true)); }
        q1 += __builtin_bit_cast(float, __builtin_amdgcn_update_dpp(0, __builtin_bit_cast(int, q1), 0xB1, 0xF, 0xF, true));
        const int rl = (r - r0) & 15;
        if (!(lane & 1)) Lg[rl * 33 + (lane >> 1)] = q1 + rbias;
        if (rl == 15) {
            asm volatile("s_waitcnt lgkmcnt(0)" ::: "memory");
            if (lane < 16) {
                float v0 = -3.0e38f, v1 = -3.0e38f, v2 = -3.0e38f, v3 = -3.0e38f; int i0 = 0, i1 = 0, i2 = 0, i3 = 0;
#pragma unroll
                for (int e = 0; e < 32; ++e) { const float x = Lg[lane * 33 + e];
                    const bool c0 = x > v0, c1 = x > v1, c2 = x > v2, c3 = x > v3;
                    v3 = c3 ? (c2 ? v2 : x) : v3; i3 = c3 ? (c2 ? i2 : e) : i3;
                    v2 = c2 ? (c1 ? v1 : x) : v2; i2 = c2 ? (c1 ? i1 : e) : i2;
                    v1 = c1 ? (c0 ? v0 : x) : v1; i1 = c1 ? (c0 ? i0 : e) : i1;
                    v0 = c0 ? x : v0; i0 = c0 ? e : i0; }
                const float e1 = __expf(v1 - v0), e2 = __expf(v2 - v0), e3 = __expf(v3 - v0); const float inv = 1.0f / (1.0f + e1 + e2 + e3);
                const int rr = r - 15 + lane;
                *(int4*)(TK + (size_t)rr * 4) = make_int4(i0, i1, i2, i3); *(f32x4*)(GT + (size_t)rr * 4) = (f32x4){inv, e1 * inv, e2 * inv, e3 * inv};
                __hip_atomic_fetch_add(&hist[i0], 1, __ATOMIC_RELAXED, __HIP_MEMORY_SCOPE_WORKGROUP); __hip_atomic_fetch_add(&hist[i1], 1, __ATOMIC_RELAXED, __HIP_MEMORY_SCOPE_WORKGROUP);
                __hip_atomic_fetch_add(&hist[i2], 1, __ATOMIC_RELAXED, __HIP_MEMORY_SCOPE_WORKGROUP); __hip_atomic_fetch_add(&hist[i3], 1, __ATOMIC_RELAXED, __HIP_MEMORY_SCOPE_WORKGROUP);
            }
            asm volatile("s_waitcnt lgkmcnt(0)" ::: "memory");
        }
    }
    __syncthreads();
    if (tid < 32) ((int*)(C.ws + WS_CNTBLK))[blockIdx.x * 32 + tid] = hist[tid];
    __syncthreads();
}
__device__ __forceinline__ void p_assign(const Ctx& C) {
    PH_IDS;
    LAS int* red = (LAS int*)C.lds;
    LAS int* base = (LAS int*)(C.lds + 4096);
    LAS int* total = (LAS int*)(C.lds + 4224);
    LAS int* segrow = (LAS int*)(C.lds + 4352);
    LAS int* run = (LAS int*)(C.lds + 4608);
    const int* cnt = (const int*)(C.ws + WS_CNTBLK);
    const int b = blockIdx.x;
    __syncthreads();
    { const int e = tid & 31, part = tid >> 5; int slt = 0, sall = 0;
      int vv[16];
#pragma unroll
      for (int q = 0; q < 16; ++q) vv[q] = __hip_atomic_load(cnt + (part * 16 + q) * 32 + e, __ATOMIC_RELAXED, __HIP_MEMORY_SCOPE_AGENT);
#pragma unroll
      for (int q = 0; q < 16; ++q) { sall += vv[q]; if (part * 16 + q < b) slt += vv[q]; }
      red[part * 32 + e] = slt; red[512 + part * 32 + e] = sall; }
    __syncthreads();
    if (tid < 32) { int s0 = 0, s1 = 0;
#pragma unroll
        for (int q = 0; q < 16; ++q) { s0 += red[q * 32 + tid]; s1 += red[512 + q * 32 + tid]; }
        base[tid] = s0; total[tid] = s1; run[tid] = 0; }
    __syncthreads();
    if (tid == 0) { int acc = 0; for (int e = 0; e < 32; ++e) { segrow[e] = acc * 256; if (b == 0) ((int*)(C.ws + WS_MOEINFO))[e] = acc; acc += (total[e] + 255) >> 8; } segrow[32] = acc * 256; if (b == 0) ((int*)(C.ws + WS_MOEINFO))[32] = acc; }
    __syncthreads();
    int* SP = (int*)(C.ws + WS_SLOTPOS); int* ST = (int*)(C.ws + WS_SLOTTOK); int* SD = (int*)(C.ws + WS_SLOTDST); const int* TK = (const int*)(C.ws + WS_TOPK);
    const int rows_per_blk = MTOK / C.G;
    LAS int* gc = (LAS int*)(C.lds + 5120);
    int ge[2], grk[2], grow[2];
#pragma unroll
    for (int q = 0; q < 2; ++q) {
        const int g = 2 * wave + q, sidx = g * 64 + lane; grow[q] = b * rows_per_blk + (sidx >> 2);
        ge[q] = TK[(size_t)grow[q] * 4 + (sidx & 3)];
        int rk = 0, myc = 0;
        for (int ee = 0; ee < 32; ++ee) { const unsigned long long m = __ballot(ge[q] == ee);
            if (ge[q] == ee) rk = __popcll(m & ((1ull << lane) - 1ull));
            if (lane == ee) myc = __popcll(m); }
        grk[q] = rk;
        if (lane < 32) gc[g * 32 + lane] = myc;
    }
    __syncthreads();
#pragma unroll
    for (int q = 0; q < 2; ++q) {
        const int g = 2 * wave + q, sidx = g * 64 + lane; int off = 0;
        for (int gp = 0; gp < g; ++gp) off += gc[gp * 32 + ge[q]];
        const int pos = segrow[ge[q]] + base[ge[q]] + off + grk[q];
        SP[(size_t)grow[q] * 4 + (sidx & 3)] = pos; ST[pos] = grow[q]; SD[pos] = grow[q] * 4 + (sidx & 3);
    }
    if (b < 32) { const int e = b, tot = total[e], first = segrow[e] + tot, last = segrow[e + 1];
        for (int p = first + tid; p < last; p += 512) { ST[p] = 0; SD[p] = MTOK * 4 + (p & 255); } }
    __syncthreads();
}

__device__ __forceinline__ void p_combine(const Ctx& C, const int layer) {
    PH_IDS;
    const int gw = blockIdx.x * 8 + wave, NGW = C.G * 8;
    const int per = MTOK / NGW;
    const float* MOD = (const float*)(C.ws + WS_MOD) + (size_t)layer * 9 * 6144;
    const float* MODN = (const float*)(C.ws + WS_MOD) + (size_t)9 * 6144;
    const float* gpost = C.a->in[IN_NFPOST] + layer * 1024; const float* gpre1 = C.a->in[IN_NMPRE] + 1024;
    const unsigned char* YS = (const unsigned char*)(C.ws + WS_YSLOT); const float* GT = (const float*)(C.ws + WS_GATE);
    float* OUT = C.a->out; bf16* XS = (bf16*)(C.ws + WS_XS); unsigned char* HN = (unsigned char*)(C.ws + WS_HN);
    int curb = -1; float cA1[16], cA2[16], cB2[16]; const int vz = vzero();
    const int rbeg = gw * per, rend = gw * per + per;
#define CB_LOAD(GTV, YSV, XV, RR) { GTV = *(const f32x4*)(GT + (size_t)((RR) + vz) * 4); \
        _Pragma("unroll") for (int k = 0; k < 4; ++k) _Pragma("unroll") for (int j = 0; j < 4; ++j) YSV[k][j] = *(const unsigned*)(YS + ((size_t)(RR) * 4 + k) * 1024 + 4 * lane + 256 * j); \
        _Pragma("unroll") for (int j = 0; j < 4; ++j) XV[j] = *(const u32x2*)(XS + (size_t)(RR) * 1024 + 4 * lane + 256 * j); }
    f32x4 ngt, mgt; unsigned nys[4][4], mys[4][4]; u32x2 nxv[4], mxv[4];
    CB_LOAD(ngt, nys, nxv, rbeg);
    CB_LOAD(mgt, mys, mxv, rbeg + 1);
    for (int r = rbeg; r < rend; ++r) {
        const int b = r >> 13;
        if (b != curb) { curb = b;
#pragma unroll
            for (int j = 0; j < 4; ++j) { const int c = 4 * lane + 256 * j;
                const f32x4 gp = *(const f32x4*)(gpost + c), gf = *(const f32x4*)(MOD + (size_t)b * 6144 + 5120 + c);
                const f32x4 gg = *(const f32x4*)(gpre1 + c), sc = *(const f32x4*)(MODN + (size_t)b * 6144 + 1024 + c), sh = *(const f32x4*)(MODN + (size_t)b * 6144 + c);
#pragma unroll
                for (int i = 0; i < 4; ++i) { cA1[4 * j + i] = gp[i] * gf[i]; cA2[4 * j + i] = gg[i] * (1.0f + sc[i]); cB2[4 * j + i] = sh[i]; } } }
        unsigned ys[4][4]; u32x2 xc[4]; const f32x4 gt = ngt;
#pragma unroll
        for (int k = 0; k < 4; ++k)
#pragma unroll
            for (int j = 0; j < 4; ++j) { ys[k][j] = nys[k][j]; nys[k][j] = mys[k][j]; }
#pragma unroll
        for (int j = 0; j < 4; ++j) { xc[j] = nxv[j]; nxv[j] = mxv[j]; }
        ngt = mgt;
        if (r + 2 < rend) CB_LOAD(mgt, mys, mxv, r + 2);
        float f[16];
#pragma unroll
        for (int i = 0; i < 16; ++i) f[i] = 0.f;
#pragma unroll
        for (int k = 0; k < 4; ++k) { const float gk = gt[k] * 0.0625f;
#pragma unroll
            for (int j = 0; j < 4; ++j) { const f32v2_t lo = __builtin_amdgcn_cvt_pk_f32_fp8((int)ys[k][j], false), hi = __builtin_amdgcn_cvt_pk_f32_fp8((int)ys[k][j], true);
                f[4 * j] += gk * lo[0]; f[4 * j + 1] += gk * lo[1]; f[4 * j + 2] += gk * hi[0]; f[4 * j + 3] += gk * hi[1]; } }
        float ss = 0.f;
#pragma unroll
        for (int i = 0; i < 16; ++i) ss += f[i] * f[i];
        const float rstd = rsqrtf(wave_sum(ss) * (1.0f / 1024.0f) + EPS);
        float x2[16]; float ss2 = 0.f;
#pragma unroll
        for (int j = 0; j < 4; ++j) { const int c = 4 * lane + 256 * j;
            const f32x4 xv = (f32x4){bf_lo(xc[j].x), bf_hi(xc[j].x), bf_lo(xc[j].y), bf_hi(xc[j].y)};
            f32x4 o;
#pragma unroll
            for (int i = 0; i < 4; ++i) { o[i] = xv[i] + cA1[4 * j + i] * (f[4 * j + i] * rstd); x2[4 * j + i] = o[i]; ss2 += o[i] * o[i]; }
            if (layer == 0) { u32x2 xw; xw.x = cvt_pk(o[0], o[1]); xw.y = cvt_pk(o[2], o[3]); *(u32x2*)(XS + (size_t)r * 1024 + c) = xw; }
            else *(f32x4*)(OUT + (size_t)r * 1024 + c) = o; }
        if (layer == 0) {
            const float rstd2 = rsqrtf(wave_sum(ss2) * (1.0f / 1024.0f) + EPS);
#pragma unroll
            for (int j = 0; j < 4; ++j) { const int c = 4 * lane + 256 * j;
                float hv[4];
#pragma unroll
                for (int i = 0; i < 4; ++i) hv[i] = x2[4 * j + i] * rstd2 * cA2[4 * j + i] + cB2[4 * j + i];
                if (F8_IN1) *(unsigned*)(HN + (size_t)r * 1024 + c) = pk4_fp8(hv[0], hv[1], hv[2], hv[3], 8.f);
                else *(u32x2*)((bf16*)HN + (size_t)r * 1024 + c) = (u32x2){cvt_pk(hv[0], hv[1]), cvt_pk(hv[2], hv[3])}; }
        }
    }
}

__device__ __forceinline__ void p_conv(const Ctx& C) {
    PH_IDS;
    LAS unsigned char* L = C.lds;
    constexpr int O_X = 0;
    constexpr int O_W = 63488;
    const int w = wave;
    const bf16* GLU = (const bf16*)(C.ws + WS_GLU); const bf16* ZC1 = (const bf16*)(C.ws + WS_ZC1); const bf16* GB = (const bf16*)(C.ws + WS_GB);
    unsigned char* A2 = (unsigned char*)(C.ws + WS_A2B);
    __syncthreads();
    { float tmpw[31];
#pragma unroll
      for (int q = 0; q < 31; ++q) tmpw[q] = C.a->in[IN_ODDW][tid + 512 * q];
#pragma unroll
      for (int q = 0; q < 31; ++q) { const int i = tid + 512 * q; const int tap = i >> 9, c = i & 511; const int ln = c >> 3, half = (c >> 2) & 1, qq = c & 3;
          *(LAS float*)(L + O_W + (((tap * 2 + half) * 64 + ln) * 4 + qq) * 4) = tmpw[q]; } }
    float cb[8], lg[8], lb[8], sw0[8], sw1[8], sw2[8];
#pragma unroll
    for (int i = 0; i < 8; ++i) { const int c = 8 * lane + i; cb[i] = C.a->in[IN_ODDWB][c]; lg[i] = C.a->in[IN_ODLNG][c]; lb[i] = C.a->in[IN_ODLNB][c];
        sw0[i] = C.a->in[IN_ODSCONV][c]; sw1[i] = C.a->in[IN_ODSCONV][512 + c]; sw2[i] = C.a->in[IN_ODSCONV][1024 + c]; }
    u32x4 px[8];
    auto fetchx = [&](int unit) { const int bt = unit >> 8, t0 = (unit & 255) * 32;
#pragma unroll
        for (int q = 0; q < 8; ++q) { const int i = tid + 512 * q; const int rr = i >> 6, cc = i & 63; const int tl = t0 - 15 + rr;
            px[q] = (u32x4){0u, 0u, 0u, 0u};
            if (i < 62 * 64 && tl >= 0 && tl < SEQ) px[q] = *(const u32x4*)(GLU + (size_t)(bt * SEQ + tl) * 512 + cc * 8); } };
    if ((int)blockIdx.x < 2048) fetchx(blockIdx.x);
    for (int unit = blockIdx.x; unit < 2048; unit += C.G) {
        const int bt = unit >> 8, t0 = (unit & 255) * 32;
        __syncthreads();
#pragma unroll
        for (int q = 0; q < 8; ++q) { const int i = tid + 512 * q; if (i < 62 * 64) *(LAS u32x4*)(L + O_X + (i >> 6) * 1024 + (i & 63) * 16) = px[q]; }
        __syncthreads();
        if (unit + C.G < 2048) fetchx(unit + C.G);
        float acc[4][8];
#pragma unroll
        for (int o = 0; o < 4; ++o)
#pragma unroll
            for (int i = 0; i < 8; ++i) acc[o][i] = 0.f;
#pragma unroll 4
        for (int tap = 0; tap < 31; ++tap) {
            const f32x4 w0 = *(const LAS f32x4*)(L + O_W + ((tap * 2 + 0) * 64 + lane) * 16), w1 = *(const LAS f32x4*)(L + O_W + ((tap * 2 + 1) * 64 + lane) * 16);
#pragma unroll
            for (int o = 0; o < 4; ++o) {
                const u32x4 xr = *(const LAS u32x4*)(L + O_X + (4 * w + o + tap) * 1024 + lane * 16);
                acc[o][0] += bf_lo(xr[0]) * w0[0]; acc[o][1] += bf_hi(xr[0]) * w0[1]; acc[o][2] += bf_lo(xr[1]) * w0[2]; acc[o][3] += bf_hi(xr[1]) * w0[3];
                acc[o][4] += bf_lo(xr[2]) * w1[0]; acc[o][5] += bf_hi(xr[2]) * w1[1]; acc[o][6] += bf_lo(xr[3]) * w1[2]; acc[o][7] += bf_hi(xr[3]) * w1[3]; }
        }
        u32x4 sz0[4], sz1[4], sz2[4], sgb[4];
#pragma unroll
        for (int o = 0; o < 4; ++o) { const int tl = t0 + 4 * w + o; const size_t tok = (size_t)bt * SEQ + tl;
            sz1[o] = *(const u32x4*)(ZC1 + tok * 512 + 8 * lane); sz0[o] = (u32x4){0u, 0u, 0u, 0u}; sz2[o] = (u32x4){0u, 0u, 0u, 0u};
            if (tl >= 64) sz0[o] = *(const u32x4*)(ZC1 + (tok - 64) * 512 + 8 * lane);
            if (tl + 64 < SEQ) sz2[o] = *(const u32x4*)(ZC1 + (tok + 64) * 512 + 8 * lane);
            sgb[o] = *(const u32x4*)(GB + tok * 512 + 8 * lane); }
#pragma unroll
        for (int o = 0; o < 4; ++o) {
            const int tl = t0 + 4 * w + o; const size_t tok = (size_t)bt * SEQ + tl;
            float v[8]; float s = 0.f;
#pragma unroll
            for (int i = 0; i < 8; ++i) { v[i] = acc[o][i] + cb[i]; s += v[i]; }
            const float mu = wave_sum(s) * (1.0f / 512.0f); float q = 0.f;
#pragma unroll
            for (int i = 0; i < 8; ++i) { v[i] -= mu; q += v[i] * v[i]; }
            const float rstd = rsqrtf(wave_sum(q) * (1.0f / 512.0f) + EPS);
            float y[8];
#pragma unroll
            for (int i = 0; i < 8; ++i) y[i] = siluf_(v[i] * rstd * lg[i] + lb[i]);
            if (F8_OUT1) *(u32x2*)(A2 + tok * 1024 + 8 * lane) = (u32x2){pk4_fp8(y[0], y[1], y[2], y[3], 4.f), pk4_fp8(y[4], y[5], y[6], y[7], 4.f)};
            else *(u32x4*)((bf16*)A2 + tok * 1024 + 8 * lane) = (u32x4){cvt_pk(y[0], y[1]), cvt_pk(y[2], y[3]), cvt_pk(y[4], y[5]), cvt_pk(y[6], y[7])};
            const u32x4 z1 = sz1[o], z0 = sz0[o], z2 = sz2[o], gb = sgb[o];
            float zz[8];
#pragma unroll
            for (int i = 0; i < 4; ++i) {
                zz[2 * i] = (sw0[2 * i] * bf_lo(z0[i]) + sw1[2 * i] * bf_lo(z1[i]) + sw2[2 * i] * bf_lo(z2[i])) * bf_lo(gb[i]);
                zz[2 * i + 1] = (sw0[2 * i + 1] * bf_hi(z0[i]) + sw1[2 * i + 1] * bf_hi(z1[i]) + sw2[2 * i + 1] * bf_hi(z2[i])) * bf_hi(gb[i]); }
            if (F8_OUT1) *(u32x2*)(A2 + tok * 1024 + 512 + 8 * lane) = (u32x2){pk4_fp8(zz[0], zz[1], zz[2], zz[3], 4.f), pk4_fp8(zz[4], zz[5], zz[6], zz[7], 4.f)};
            else *(u32x4*)((bf16*)A2 + tok * 1024 + 512 + 8 * lane) = (u32x4){cvt_pk(zz[0], zz[1]), cvt_pk(zz[2], zz[3]), cvt_pk(zz[4], zz[5]), cvt_pk(zz[6], zz[7])};
        }
    }
    __syncthreads();
}

constexpr int NPHASE = 19;
#ifndef RUN_HI
#define RUN_HI NPHASE
#endif
__global__ void __launch_bounds__(512, 2) fwd_kernel(Args args) {
    extern __shared__ __attribute__((aligned(16))) unsigned char lds_raw[];
    Ctx C; C.lds = (LAS unsigned char*)lds_raw;
    C.G = gridDim.x; C.a = &args; C.ws = args.ws;
    volatile LAS unsigned* MISC = (volatile LAS unsigned*)(C.lds + MISC_OFF);
    if (threadIdx.x < 16) MISC[threadIdx.x] = 0u;
    __syncthreads();
    const int lo = args.ph_lo, hi = args.ph_hi;
    const bool multi = (hi - lo) > 1;
    XcdBarrier bar; bar.bar = (unsigned*)(C.ws + WS_CTL) + 4096; bar.x = 0; bar.st = MISC;
    if (multi) bar = xcd_barrier_post((unsigned*)(C.ws + WS_CTL) + 4096, MISC);
#ifndef PH_MASK
#define PH_MASK 0x7FFFF
#endif
#define IN(k) (((PH_MASK >> (k)) & 1) && lo <= (k) && (k) < hi)
#ifndef DUP_MASK
#define DUP_MASK 0
#endif
#ifndef GLA_PROBE
#define GLA_PROBE 0
#endif
#ifndef PROBE_NOEPI
#define PROBE_NOEPI 0
#endif
#ifndef GP_AMP
#define GP_AMP 4
#endif
#define DUPN(k) (((DUP_MASK >> (k)) & 1) ? 2 : 1)
#define SEAM(k) do { if (IN(k) && IN((k) + 1)) xcd_barrier(bar); } while (0)
    LAS unsigned char* ring = C.lds;
    const int cid = blockIdx.x;

    if (IN(0)) for (int rep_ = 0; rep_ < DUPN(0); ++rep_) { p0_adaln(C); p0_fourier_fold(C); p0_convert(C); } SEAM(0);
    if (IN(1)) for (int rep_ = 0; rep_ < DUPN(1); ++rep_) { p_norm0(C); } SEAM(1);
    if (IN(2)) for (int rep_ = 0; rep_ < DUPN(2); ++rep_) { gm::SchedIn0 S{(const char*)(C.ws + WS_HN), (const char*)(C.ws + WS_WIN0), C.G, cid}; gm::EpiIn0 E{C.ws}; gm::gemm_phase<F8_IN0 != 0>(ring, F8_IN0 ? 1024 : 2048, S, E, 0x7C7C7C7C, 0x7A7A7A7A, 2, (unsigned long long*)(C.ws + WS_CTL + 32768)); } SEAM(2);
    if (IN(3)) for (int rep_ = 0; rep_ < DUPN(3); ++rep_) { p_gla_prep(C); if (GLA_PROBE == 1) p_gla_prep(C); if (GLA_PROBE >= 10) p_gla_prep(C, GLA_PROBE - 10); p_fft1(C); if (GLA_PROBE == 2) p_fft1(C); xcd_barrier(bar); p_gla(C); if (GLA_PROBE == 3) p_gla(C); if (GLA_PROBE == 4) p_gla(C, 1); } SEAM(3);
    if (IN(4)) for (int rep_ = 0; rep_ < DUPN(4); ++rep_) { p_fft2(C); p_gla_out(C); } SEAM(4);
    if (IN(5)) for (int rep_ = 0; rep_ < DUPN(5); ++rep_) { gm::SchedDense S{(const char*)(C.ws + WS_A2), (const char*)(C.ws + WS_WOUT0), F8_OUT0 ? 1536 : 3072, 256, 4, C.G, cid}; gm::EpiPlain E{(bf16*)(C.ws + WS_Y), 1024}; gm::gemm_phase<F8_OUT0 != 0>(ring, F8_OUT0 ? 1536 : 3072, S, E, 0x7C7C7C7C, 0x7A7A7A7A, 5, (unsigned long long*)(C.ws + WS_CTL + 32768)); } SEAM(5);
    if (IN(6)) for (int rep_ = 0; rep_ < DUPN(6); ++rep_) { p_postmix(C, 0); } SEAM(6);
    if (IN(7)) { p_assign(C); } SEAM(7);
    if (IN(8)) for (int rep_ = 0; rep_ < DUPN(8); ++rep_) { const int* tsp = (const int*)(C.ws + WS_MOEINFO); const int ln_ = otid() & 63; const int ts = __hip_atomic_load(tsp + (ln_ < 32 ? ln_ : 32), __ATOMIC_RELAXED, __HIP_MEMORY_SCOPE_AGENT);
        gm::SchedMoE S{(const char*)(C.ws + WS_H2), (const char*)(C.ws + WS_WGU), (const int*)(C.ws + WS_SLOTTOK), ts, __builtin_amdgcn_readlane(ts, 32), 8, C.G, cid, (size_t)2048 * 1024, true, args.in[IN_BGU], nullptr};
        gm::EpiGU E{(unsigned char*)(C.ws + WS_ACT), args.in[IN_BGU], PROBE_NOEPI ? rep_ : 0}; gm::gemm_phase<true>(ring, 1024, S, E, 0x7C7C7C7C, 0x7A7A7A7A, 8, (unsigned long long*)(C.ws + WS_CTL + 32768)); } SEAM(8);
    if (IN(9)) for (int rep_ = 0; rep_ < DUPN(9); ++rep_) { const int* tsp = (const int*)(C.ws + WS_MOEINFO); const int ln_ = otid() & 63; const int ts = __hip_atomic_load(tsp + (ln_ < 32 ? ln_ : 32), __ATOMIC_RELAXED, __HIP_MEMORY_SCOPE_AGENT);
        gm::SchedMoE S{(const char*)(C.ws + WS_ACT), (const char*)(C.ws + WS_WD), nullptr, ts, __builtin_amdgcn_readlane(ts, 32), 4, C.G, cid, (size_t)1024 * 1024, false, args.in[IN_BD], (const int*)(C.ws + WS_SLOTDST)};
        gm::EpiDown E{(unsigned char*)(C.ws + WS_YSLOT), args.in[IN_BD]}; gm::gemm_phase<true>(ring, 1024, S, E, 0x7D7D7D7D, 0x7A7A7A7A, 9, (unsigned long long*)(C.ws + WS_CTL + 32768)); } SEAM(9);
    if (IN(10)) { p_combine(C, 0); } SEAM(10);
    if (IN(11)) for (int rep_ = 0; rep_ < DUPN(11); ++rep_) { gm::SchedDense S{(const char*)(C.ws + WS_HN), (const char*)(C.ws + WS_WIN1), F8_IN1 ? 1024 : 2048, 256, 10, C.G, cid}; gm::EpiIn1 E{C.ws}; gm::gemm_phase<F8_IN1 != 0>(ring, F8_IN1 ? 1024 : 2048, S, E, 0x7C7C7C7C, 0x7A7A7A7A, 11, (unsigned long long*)(C.ws + WS_CTL + 32768)); } SEAM(11);
    if (IN(12)) for (int rep_ = 0; rep_ < DUPN(12); ++rep_) { p_conv(C); } SEAM(12);
    if (IN(13)) for (int rep_ = 0; rep_ < DUPN(13); ++rep_) { gm::SchedDense S{(const char*)(C.ws + WS_A2B), (const char*)(C.ws + WS_WOUT1), F8_OUT1 ? 1024 : 2048, 256, 4, C.G, cid}; gm::EpiPlain E{(bf16*)(C.ws + WS_Y), 1024}; gm::gemm_phase<F8_OUT1 != 0>(ring, F8_OUT1 ? 1024 : 2048, S, E, 0x7D7D7D7D, 0x7A7A7A7A, 13, (unsigned long long*)(C.ws + WS_CTL + 32768)); } SEAM(13);
    if (IN(14)) { p_postmix(C, 1); } SEAM(14);
    if (IN(15)) { p_assign(C); } SEAM(15);
    if (IN(16)) for (int rep_ = 0; rep_ < DUPN(16); ++rep_) { const int* tsp = (const int*)(C.ws + WS_MOEINFO); const int ln_ = otid() & 63; const int ts = __hip_atomic_load(tsp + (ln_ < 32 ? ln_ : 32), __ATOMIC_RELAXED, __HIP_MEMORY_SCOPE_AGENT);
        gm::SchedMoE S{(const char*)(C.ws + WS_H2), (const char*)(C.ws + WS_WGU) + (size_t)32 * 2048 * 1024, (const int*)(C.ws + WS_SLOTTOK), ts, __builtin_amdgcn_readlane(ts, 32), 8, C.G, cid, (size_t)2048 * 1024, true, args.in[IN_BGU] + 32 * 2048, nullptr};
        gm::EpiGU E{(unsigned char*)(C.ws + WS_ACT), args.in[IN_BGU] + 32 * 2048, 0}; gm::gemm_phase<true>(ring, 1024, S, E, 0x7C7C7C7C, 0x7A7A7A7A, 16, (unsigned long long*)(C.ws + WS_CTL + 32768)); } SEAM(16);
    if (IN(17)) for (int rep_ = 0; rep_ < DUPN(17); ++rep_) { const int* tsp = (const int*)(C.ws + WS_MOEINFO); const int ln_ = otid() & 63; const int ts = __hip_atomic_load(tsp + (ln_ < 32 ? ln_ : 32), __ATOMIC_RELAXED, __HIP_MEMORY_SCOPE_AGENT);
        gm::SchedMoE S{(const char*)(C.ws + WS_ACT), (const char*)(C.ws + WS_WD) + (size_t)32 * 1024 * 1024, nullptr, ts, __builtin_amdgcn_readlane(ts, 32), 4, C.G, cid, (size_t)1024 * 1024, false, args.in[IN_BD] + 32 * 1024, (const int*)(C.ws + WS_SLOTDST)};
        gm::EpiDown E{(unsigned char*)(C.ws + WS_YSLOT), args.in[IN_BD] + 32 * 1024}; gm::gemm_phase<true>(ring, 1024, S, E, 0x7D7D7D7D, 0x7A7A7A7A, 17, (unsigned long long*)(C.ws + WS_CTL + 32768)); } SEAM(17);
    if (IN(18)) { p_combine(C, 1); }
#if GP_PROBE
    if (blockIdx.x == 0 && threadIdx.x == 0) { const unsigned long long v = *(volatile unsigned long long*)(C.ws + WS_CTL + 32768) * GP_AMP; const unsigned long long t0 = wall_clock64();
        while (wall_clock64() - t0 < v) __builtin_amdgcn_s_sleep(16); }
#endif
#ifdef DBG_COPY_OFF
    if (lo == 99) { const bf16* src = (const bf16*)(C.ws + (size_t)DBG_COPY_OFF); float* dst = args.out;
        for (size_t i = (size_t)blockIdx.x * 512 + threadIdx.x; i < (size_t)MTOK * 1024; i += (size_t)gridDim.x * 512) dst[i] = bf_lo((unsigned)src[i]); }
#endif
#undef IN
#undef SEAM
}

extern "C" void kernel_launch(void* const* d_in, const int* in_sizes, int n_in, void* d_out, int out_size, void* d_ws, size_t ws_size, hipStream_t stream) {
    static int grid = 0;
    if (grid == 0) {
        if (n_in != 28 || out_size != MTOK * D || ws_size < WS_END) { fprintf(stderr, "kernel_launch: unexpected problem (n_in %d out %d ws %zu need %zu)\n", n_in, out_size, ws_size, (size_t)WS_END); grid = -1; return; }
        int dev = 0, cus = 0, per_cu = 0;
        (void)hipGetDevice(&dev); (void)hipDeviceGetAttribute(&cus, hipDeviceAttributeMultiprocessorCount, dev);
        if (hipFuncSetAttribute((const void*)fwd_kernel, hipFuncAttributeMaxDynamicSharedMemorySize, LDS_BYTES) != hipSuccess) { fprintf(stderr, "kernel_launch: hipFuncSetAttribute failed\n"); grid = -1; return; }
        (void)hipOccupancyMaxActiveBlocksPerMultiprocessor(&per_cu, (const void*)fwd_kernel, 512, LDS_BYTES);
        (void)hipGetLastError();
        grid = cus;
        if (grid != 256 || per_cu < 1) { fprintf(stderr, "kernel_launch: needs a 256-CU device with one resident workgroup per CU (cus %d, per_cu %d)\n", cus, per_cu); grid = -1; return; }
    }
    if (grid < 0) return;
    (void)hipMemsetAsync((char*)d_ws + WS_CTL, 0, CTL_ZERO_BYTES, stream);
    Args a{};
    for (int i = 0; i < 28; ++i) a.in[i] = (const float*)d_in[i];
    a.out = (float*)d_out; a.ws = (unsigned char*)d_ws;
#if N_LAUNCH_MODE == 1
    a.ph_lo = 0; a.ph_hi = NPHASE;
    hipLaunchKernelGGL(fwd_kernel, dim3(grid), dim3(512), LDS_BYTES, stream, a);
#else
    for (int p = 0; p < RUN_HI; ++p) { a.ph_lo = p; a.ph_hi = p + 1; hipLaunchKernelGGL(fwd_kernel, dim3(grid), dim3(512), LDS_BYTES, stream, a); }
#ifdef DBG_COPY_OFF
    a.ph_lo = 99; a.ph_hi = 100; hipLaunchKernelGGL(fwd_kernel, dim3(grid), dim3(512), LDS_BYTES, stream, a);
#endif
#endif
}
```

```cpp
#include <hip/hip_runtime.h>
#include <cstdio>
#include <cstdint>

#ifndef N_LAUNCH_MODE
#define N_LAUNCH_MODE 1
#endif

#ifndef F8_IN0
#define F8_IN0 0
#endif
#ifndef F8_OUT0
#define F8_OUT0 1
#endif
#ifndef F8_IN1
#define F8_IN1 1
#endif
#ifndef F8_OUT1
#define F8_OUT1 1
#endif
#define LAS __attribute__((address_space(3)))
typedef unsigned short bf16;
typedef short bf16x8 __attribute__((ext_vector_type(8)));
typedef short s16x4 __attribute__((ext_vector_type(4)));
typedef float f32x4 __attribute__((ext_vector_type(4)));
typedef float f32x16 __attribute__((ext_vector_type(16)));
typedef unsigned u32x4 __attribute__((ext_vector_type(4)));
typedef unsigned u32x2 __attribute__((ext_vector_type(2)));

constexpr int D = 1024, NB = 8, SEQ = 8192, CTXL = 256;
constexpr int MTOK = NB * SEQ;
constexpr int MCTX = NB * CTXL;
constexpr int MALL = MTOK + MCTX;
constexpr int NE = 32, TOPK = 4;
constexpr int NSLOT_PAD = MTOK * TOPK + NE * 256;
constexpr int N_IN0 = 3840;
constexpr int N_IN1 = 2560;
constexpr float EPS = 1e-6f;

constexpr size_t MiB = 1u << 20;
constexpr size_t WS_CTL = 0, CTL_ZERO_BYTES = 65536;
constexpr size_t WS_MOD = 1 * MiB;
constexpr size_t WS_F1 = 2 * MiB;
constexpr size_t WS_F2 = 2 * MiB + 65536;
constexpr size_t WS_CNTBLK = 3 * MiB;
constexpr size_t WS_MOEINFO = 3 * MiB + 65536;
constexpr size_t WS_TOPK = 4 * MiB;
constexpr size_t WS_GATE = 5 * MiB;
constexpr size_t WS_SLOTPOS = 6 * MiB;
constexpr size_t WS_SLOTTOK = 7 * MiB;
constexpr size_t WS_SLOTDST = 8 * MiB + 512 * 1024;
constexpr size_t WS_WIN0 = 10 * MiB;
constexpr size_t WS_WOUT0 = 19 * MiB;
constexpr size_t WS_WIN1 = 22 * MiB;
constexpr size_t WS_WOUT1 = 27 * MiB;
constexpr size_t WS_WGU = 32 * MiB;
constexpr size_t WS_WD = 288 * MiB;
constexpr size_t WS_HN = 416 * MiB;
constexpr size_t WS_B = 548 * MiB;
constexpr size_t WS_ACT = WS_B;
constexpr size_t WS_YSLOT = WS_B + 528 * MiB;
constexpr size_t WS_Q = WS_B, WS_K = WS_B + 64 * MiB, WS_V = WS_B + 130 * MiB, WS_R = WS_B + 262 * MiB;
constexpr size_t WS_ZC = WS_B + 390 * MiB, WS_ZS = WS_B + 454 * MiB, WS_LR = WS_B + 518 * MiB;
constexpr size_t WS_OF = WS_B + 528 * MiB, WS_OB = WS_B + 656 * MiB, WS_YR = WS_B + 784 * MiB, WS_YI = WS_B + 848 * MiB;
constexpr size_t WS_A2 = WS_B;
constexpr size_t WS_Y = WS_B + 528 * MiB;
constexpr size_t WS_H2 = WS_B + 656 * MiB;
constexpr size_t WS_GLU = WS_B, WS_ZC1 = WS_B + 64 * MiB, WS_GB = WS_B + 128 * MiB, WS_A2B = WS_B + 192 * MiB;
constexpr size_t WS_XS = WS_B + 1056 * MiB;
constexpr size_t WS_GQP = WS_B + 1056 * MiB;
constexpr size_t WS_GKPP = WS_GQP + 132 * MiB;
constexpr size_t WS_GSC = WS_GKPP + 132 * MiB;
constexpr size_t WS_GEL = WS_GSC + 66 * MiB;
constexpr size_t WS_END = WS_GEL + 6 * MiB;

constexpr int LDS_BYTES = 155648;
constexpr int MISC_OFF = LDS_BYTES - 256;

__device__ __forceinline__ float bf_lo(unsigned u) { return __uint_as_float(u << 16); }
__device__ __forceinline__ float bf_hi(unsigned u) { return __uint_as_float(u & 0xffff0000u); }
typedef __bf16 bf16v2_t __attribute__((ext_vector_type(2)));
typedef float f32v2_t __attribute__((ext_vector_type(2)));
__device__ __forceinline__ unsigned cvt_pk(float lo, float hi) { const f32v2_t v = {lo, hi}; const bf16v2_t r = __builtin_convertvector(v, bf16v2_t); return __builtin_bit_cast(unsigned, r); }
__device__ __forceinline__ unsigned f2bf(float f) { unsigned u = __float_as_uint(f); return (u + 0x7fffu + ((u >> 16) & 1u)) >> 16; }
__device__ __forceinline__ float swap32_sum(float a, float b) {
    const auto r = __builtin_amdgcn_permlane32_swap(__builtin_bit_cast(unsigned, a), __builtin_bit_cast(unsigned, b), false, false);
    unsigned x = r[0], y = r[1]; asm volatile("" : "+v"(x), "+v"(y));
    return __builtin_bit_cast(float, x) + __builtin_bit_cast(float, y);
}
__device__ __forceinline__ float swap16_sum(float a, float b) {
    const auto r = __builtin_amdgcn_permlane16_swap(__builtin_bit_cast(unsigned, a), __builtin_bit_cast(unsigned, b), false, false);
    unsigned x = r[0], y = r[1]; asm volatile("" : "+v"(x), "+v"(y));
    return __builtin_bit_cast(float, x) + __builtin_bit_cast(float, y);
}
__device__ __forceinline__ float row16_sum(float v) {
    v += __builtin_bit_cast(float, __builtin_amdgcn_update_dpp(0, __builtin_bit_cast(int, v), 0xB1, 0xF, 0xF, true));
    v += __builtin_bit_cast(float, __builtin_amdgcn_update_dpp(0, __builtin_bit_cast(int, v), 0x4E, 0xF, 0xF, true));
    v += __builtin_bit_cast(float, __builtin_amdgcn_update_dpp(0, __builtin_bit_cast(int, v), 0x141, 0xF, 0xF, true));
    v += __builtin_bit_cast(float, __builtin_amdgcn_update_dpp(0, __builtin_bit_cast(int, v), 0x140, 0xF, 0xF, true));
    return v;
}
__device__ __forceinline__ float wave_sum(float v) {
    v = row16_sum(v);
    const int iv = __builtin_bit_cast(int, v);
    const float a = __builtin_bit_cast(float, __builtin_amdgcn_readlane(iv, 0)), b = __builtin_bit_cast(float, __builtin_amdgcn_readlane(iv, 16));
    const float c = __builtin_bit_cast(float, __builtin_amdgcn_readlane(iv, 32)), d = __builtin_bit_cast(float, __builtin_amdgcn_readlane(iv, 48));
    return (a + b) + (c + d);
}
__device__ __forceinline__ unsigned pk4_fp8(float a, float b, float c, float d, float sc) {
    int w = 0;
    w = __builtin_amdgcn_cvt_pk_fp8_f32(__builtin_amdgcn_fmed3f(a * sc, -440.f, 440.f), __builtin_amdgcn_fmed3f(b * sc, -440.f, 440.f), w, false);
    w = __builtin_amdgcn_cvt_pk_fp8_f32(__builtin_amdgcn_fmed3f(c * sc, -440.f, 440.f), __builtin_amdgcn_fmed3f(d * sc, -440.f, 440.f), w, true);
    return (unsigned)w;
}
__device__ __forceinline__ float sigmoidf_(float x) { return __builtin_amdgcn_rcpf(1.0f + __builtin_amdgcn_exp2f(x * -1.4426950408889634f)); }
__device__ __forceinline__ float siluf_(float x) { return x * sigmoidf_(x); }

#define XB_TMO      128
#define XB_XCNT(j)  (256  + 64 * (j))
#define XB_XSUB(j)  (1280 + 64 * (j))
#define XB_XGEN(j)  (2304 + 64 * (j))
#define XB_TOP      3328
#define XB_TOPGEN   3392
#define XCD_BAR_WORDS 3456
#define XB_SPIN_CAP (1u << 18)
__device__ __forceinline__ unsigned xb_ld(unsigned* p)              { return __hip_atomic_load(p, __ATOMIC_RELAXED, __HIP_MEMORY_SCOPE_AGENT); }
__device__ __forceinline__ unsigned xb_add(unsigned* p, unsigned v) { return __hip_atomic_fetch_add(p, v, __ATOMIC_RELAXED, __HIP_MEMORY_SCOPE_AGENT); }
__device__ __forceinline__ unsigned xb_xcc_id() { return (unsigned)__builtin_amdgcn_s_getreg((3 << 11) | 20) & 0xFu; }
#define XB_SPIN(cond, bar) do { unsigned _sp = 0; while (cond) { __builtin_amdgcn_s_sleep(1); \
    if ((++_sp & 255u) == 0u) { if (xb_ld(&(bar)[XB_TMO])) break; if (_sp > XB_SPIN_CAP) { atomicAdd(&(bar)[XB_TMO], 1u); break; } } } } while (0)
struct XcdBarrier { unsigned* bar; unsigned x; volatile LAS unsigned* st; };
__device__ __forceinline__ XcdBarrier xcd_barrier_post(unsigned* bar, volatile LAS unsigned* st) {
    XcdBarrier b; b.bar = bar; b.x = xb_xcc_id(); b.st = st;
    if (threadIdx.x == 0) (void)xb_add(&bar[XB_XCNT(b.x)], 1u);
    return b;
}
__device__ __forceinline__ void xcd_barrier_complete(unsigned* bar, unsigned x, unsigned& nloc, unsigned& nx) {
    const unsigned G = gridDim.x * gridDim.y * gridDim.z;
    unsigned sum, cnt, mine, sp = 0u;
    for (;;) {
        sum = 0u; cnt = 0u; mine = 0u;
#pragma unroll
        for (unsigned j = 0; j < 16; ++j) { const unsigned c = xb_ld(&bar[XB_XCNT(j)]); sum += c; cnt += (c > 0u) ? 1u : 0u; mine = (j == x) ? c : mine; }
        if (sum == G) break;
        __builtin_amdgcn_s_sleep(1);
        if ((++sp & 255u) == 0u) { if (xb_ld(&bar[XB_TMO])) break; if (sp > XB_SPIN_CAP) { atomicAdd(&bar[XB_TMO], 1u); break; } }
    }
    nloc = mine > 0u ? mine : 1u; nx = cnt > 0u ? cnt : 1u;
}
__device__ __forceinline__ void xcd_barrier(const XcdBarrier& b) {
    asm volatile("s_waitcnt vmcnt(0)" ::: "memory");
    __syncthreads();
    if (threadIdx.x == 0) {
        unsigned* bar = b.bar;
        __builtin_amdgcn_s_waitcnt(0);
        unsigned nloc = b.st[0], nx = b.st[1];
        if (nloc == 0u) { xcd_barrier_complete(bar, b.x, nloc, nx); b.st[0] = nloc; b.st[1] = nx; }
        const unsigned old = xb_add(&bar[XB_XSUB(b.x)], 1u);
        const unsigned gen = old / nloc;
        if (old + 1u == (gen + 1u) * nloc) {
            __builtin_amdgcn_fence(__ATOMIC_RELEASE, "agent");
            asm volatile("s_waitcnt vmcnt(0)" ::: "memory");
            const unsigned og = xb_add(&bar[XB_TOP], 1u);
            const unsigned tg = og / nx;
            if (og + 1u == (tg + 1u) * nx) xb_add(&bar[XB_TOPGEN], 1u);
            else XB_SPIN(xb_ld(&bar[XB_TOPGEN]) == tg, bar);
            __builtin_amdgcn_fence(__ATOMIC_ACQUIRE, "agent");
            xb_add(&bar[XB_XGEN(b.x)], 1u);
            asm volatile("s_waitcnt vmcnt(0)" ::: "memory");
        } else {
            XB_SPIN(xb_ld(&bar[XB_XGEN(b.x)]) == gen, bar);
            __builtin_amdgcn_fence(__ATOMIC_ACQUIRE, "agent");
            asm volatile("s_waitcnt vmcnt(0)" ::: "memory");
        }
    }
    __syncthreads();
}

struct Args {
    const float* in[28];
    float* out;
    unsigned char* ws;
    int ph_lo, ph_hi;
};
struct Ctx {
    LAS unsigned char* lds;
    int G;
    const Args* a;
    unsigned char* ws;
};
__device__ __forceinline__ int otid() { int t = (int)threadIdx.x; asm volatile("" : "+v"(t)); return t; }
__device__ __forceinline__ int vzero() { int z = 0; asm volatile("" : "+v"(z)); return z; }
#define PH_IDS const int tid = otid(), lane = tid & 63, wave = __builtin_amdgcn_readfirstlane(tid >> 6); (void)tid; (void)lane; (void)wave
#define IN_X 0
#define IN_C 1
#define IN_CTX 2
#define IN_CCTX 3
#define IN_MODW 4
#define IN_MODB 5
#define IN_NMPRE 6
#define IN_NMPOST 7
#define IN_NFPRE 8
#define IN_NFPOST 9
#define IN_EVWIN 10
#define IN_EVGKUP 11
#define IN_EVGKB 12
#define IN_EVGNORM 13
#define IN_EVWOUT 14
#define IN_ODWIN 15
#define IN_ODDW 16
#define IN_ODDWB 17
#define IN_ODLNG 18
#define IN_ODLNB 19
#define IN_ODSCONV 20
#define IN_ODWOUT 21
#define IN_RW 22
#define IN_RB 23
#define IN_WGU 24
#define IN_BGU 25
#define IN_WD 26
#define IN_BD 27

namespace gm {
constexpr int BM = 256, BK = 64, HALF = 128, HTB = HALF * BK * 2, STAGE_BYTES = 8 * HTB, NXCD = 8, WGM = 8;
constexpr int XT_OFF = 131072;
constexpr int XB_OFF = XT_OFF + 16384;
__device__ __forceinline__ int lds_byte(int r, int c) { const int st = (r >> 4) * 2 + (c >> 5), rr = r & 15, cc = c & 31, ob = rr * 64 + cc * 2; return st * 1024 + (ob ^ (((ob >> 9) & 1) << 5)); }
__device__ __forceinline__ void stage_rc(int b, int& R, int& C) { const int st = b / 1024, sb = b % 1024, swz = sb ^ (((sb >> 9) & 1) << 5); R = (st >> 1) * 16 + swz / 64; C = (st & 1) * 32 + (swz % 64) / 2; }
__device__ __forceinline__ int perm32(int rho) { const int n = rho >> 4, i = rho & 15; return 8 * (i >> 2) + 4 * n + (i & 3); }
struct Unit { int pm, pn, e; };

__device__ __forceinline__ void dense_map(int L, int nM, int nN, int& pm, int& pn) {
    const int nwg = nM * nN; int wgid = L;
    { const int q = nwg / NXCD, r = nwg % NXCD, xcd = wgid % NXCD, off = wgid / NXCD; wgid = (xcd < r ? xcd * (q + 1) : r * (q + 1) + (xcd - r) * q) + off; }
    const int nig = WGM * nN, gid = wgid / nig, fm = gid * WGM, gsz = (nM - fm) < WGM ? (nM - fm) : WGM;
    pm = fm + ((wgid % nig) % gsz); pn = (wgid % nig) / gsz;
}

typedef int i32x8 __attribute__((ext_vector_type(8)));
typedef int i32x4_ __attribute__((ext_vector_type(4)));
template <bool F8, class Epi, class Sched>
__device__ __forceinline__ void gemm_phase(LAS unsigned char* lds, const int RP, const Sched& S, const Epi& E, const int SCA = 0x7F7F7F7F, const int SCB = 0x7F7F7F7F, const int pid = -1, unsigned long long* tprobe = nullptr) {
    const int tid = otid(), wid = __builtin_amdgcn_readfirstlane(tid >> 6), lane = tid & 63, wr = wid >> 2, wc = wid & 3, fr = lane & 15, fq = lane >> 4;
    const int nt = RP / 128;
    unsigned voffB[2];
#pragma unroll
    for (int i = 0; i < 2; ++i) { int R, C; stage_rc(tid * 16 + i * 8192, R, C); const int Rb = (R & ~31) + perm32(R & 31); voffB[i] = (unsigned)(Rb * RP + C * 2); }
    const size_t kstep = (size_t)128;
    const size_t hstepB = (size_t)HALF * RP;
    const unsigned ldsw = (unsigned)wid * 1024u;
    const int aoff = lds_byte(wr * 64 + fr, fq * 8);
    const int boff = lds_byte(wc * 32 + fr, fq * 8);
    constexpr int KOFF = 1024;
#define G_SA(b, h) (((b) * 2 + (h)) * HTB)
#define G_SB(b, h) ((4 + (b) * 2 + (h)) * HTB)
#define G_STAGEB(bufoff, gbase) do { _Pragma("unroll") for (int _i = 0; _i < 2; ++_i) \
        __builtin_amdgcn_global_load_lds((const unsigned*)((const char*)(gbase) + voffB[_i]), (LAS unsigned*)(lds + (bufoff) + ldsw + _i * 8192), 16, 0, 0); } while (0)
#define G_STAGEA(bufoff, offs, h, kb) do { _Pragma("unroll") for (int _i = 0; _i < 2; ++_i) \
        __builtin_amdgcn_global_load_lds((const unsigned*)(S.abase() + (size_t)(offs)[h][_i] + (kb)), (LAS unsigned*)(lds + (bufoff) + ldsw + _i * 8192), 16, 0, 0); } while (0)
#define G_LDA(dst, b, h) do { _Pragma("unroll") for (int m = 0; m < 4; ++m) _Pragma("unroll") for (int k = 0; k < 2; ++k) dst[m][k] = *(const LAS bf16x8*)(lds + G_SA(b, h) + aoff + m * 2048 + k * KOFF); } while (0)
#define G_LDB(dst, b, h) do { _Pragma("unroll") for (int n = 0; n < 2; ++n) _Pragma("unroll") for (int k = 0; k < 2; ++k) dst[n][k] = *(const LAS bf16x8*)(lds + G_SB(b, h) + boff + n * 2048 + k * KOFF); } while (0)
#define G_CAT8(x) __builtin_shufflevector(__builtin_bit_cast(i32x4_, (x)[0]), __builtin_bit_cast(i32x4_, (x)[1]), 0, 1, 2, 3, 4, 5, 6, 7)
#define G_MMA(ai, bj, At, Bt) do { __builtin_amdgcn_s_setprio(1); \
        if constexpr (F8) { _Pragma("unroll") for (int m = 0; m < 4; ++m) _Pragma("unroll") for (int n = 0; n < 2; ++n) \
            acc[ai][bj][m][n] = __builtin_amdgcn_mfma_scale_f32_16x16x128_f8f6f4(G_CAT8(Bt[n]), G_CAT8(At[m]), acc[ai][bj][m][n], 0, 0, 0, 0, 0, 0); } \
        else { _Pragma("unroll") for (int m = 0; m < 4; ++m) _Pragma("unroll") for (int n = 0; n < 2; ++n) _Pragma("unroll") for (int k = 0; k < 2; ++k) \
            acc[ai][bj][m][n] = __builtin_amdgcn_mfma_f32_16x16x32_bf16(Bt[n][k], At[m][k], acc[ai][bj][m][n], 0, 0, 0); } \
        __builtin_amdgcn_s_setprio(0); } while (0)
#define G_WAIT_V(n) asm volatile("s_waitcnt vmcnt(" #n ")" ::: "memory")
#define G_WAIT_L(n) asm volatile("s_waitcnt lgkmcnt(" #n ")" ::: "memory")
#define G_BAR __builtin_amdgcn_s_barrier()
#define G_SCHED __builtin_amdgcn_sched_barrier(0)
    Unit cur, nxt; int ui = 0;
#ifndef GP_PROBE
#define GP_PROBE 0
#endif
#ifndef GP_PROBE_PID
#define GP_PROBE_PID 8
#endif
    unsigned tp_k = 0, tp_e = 0, tp_s = 0, tp_0 = 0, tp_1 = 0;
#define TP_NOW() ((unsigned)__builtin_amdgcn_readfirstlane((int)(unsigned)wall_clock64()))
    const bool tp_on = GP_PROBE && pid == GP_PROBE_PID;
    if (tp_on) tp_0 = TP_NOW();
    if (!S.next(0, cur)) return;
    f32x4 acc[2][2][4][2];
#pragma unroll
    for (int a = 0; a < 2; ++a)
#pragma unroll
        for (int b = 0; b < 2; ++b)
#pragma unroll
            for (int m = 0; m < 4; ++m)
#pragma unroll
                for (int n = 0; n < 2; ++n) acc[a][b][m][n] = (f32x4){0.f, 0.f, 0.f, 0.f};
    bf16x8 At[4][2], B0[2][2], B1[2][2];
    unsigned cAo[2][2];
    S.a_off(cur, cAo);
    const char* cB = S.b_ptr(cur);
    S.prefetch_bias(cur, lds, 0, wid, lane, wc);
    S.prefetch_rows(cur, lds, 0, wid, lane);
    G_STAGEB(G_SB(0, 0), cB); G_STAGEA(G_SA(0, 0), cAo, 0, 0); G_STAGEB(G_SB(0, 1), cB + hstepB); G_STAGEA(G_SA(0, 1), cAo, 1, 0);
    if (wr == 1) G_BAR;
    G_WAIT_V(4); G_BAR;
    G_STAGEB(G_SB(1, 0), cB + kstep); G_STAGEA(G_SA(1, 0), cAo, 0, kstep); G_STAGEB(G_SB(1, 1), cB + hstepB + kstep);
    G_WAIT_V(6); G_BAR;
    for (;;) {
        const bool has_next = S.next(ui + 1, nxt);
        const char* nB = cB;
        if (has_next) { S.prefetch_rows(nxt, lds, (ui + 1) & 1, wid, lane); S.prefetch_bias(nxt, lds, (ui + 1) & 1, wid, lane, wc); nB = S.b_ptr(nxt); }
        if (tp_on) tp_s = TP_NOW();
        for (int t = 0; t < nt; t += 2) {
            const bool last = (t == nt - 2);
            const size_t k1 = (size_t)(t + 1) * kstep;
            G_LDB(B0, 0, 0); G_SCHED; G_LDA(At, 0, 0); G_STAGEA(G_SA(1, 1), cAo, 1, k1);
            if (last) { if (has_next) S.a_off_lds(nxt, lds, (ui + 1) & 1, wid, lane, cAo); cB = nB; }
            const size_t k2 = last ? 0 : (size_t)(t + 2) * kstep;
            const size_t k3 = k2 + kstep;
            const char* b2 = cB + k2; const char* b3 = b2 + kstep;
            G_WAIT_L(8); G_BAR; G_WAIT_L(0); G_MMA(0, 0, At, B0); G_BAR; G_SCHED;
            G_LDB(B1, 0, 1); G_STAGEB(G_SB(0, 0), b2);
            G_BAR; G_WAIT_L(0); G_MMA(0, 1, At, B1); G_BAR;
            G_LDA(At, 0, 1); G_STAGEA(G_SA(0, 0), cAo, 0, k2);
            G_BAR; G_WAIT_L(0); G_MMA(1, 0, At, B0); G_BAR; G_SCHED;
            G_STAGEB(G_SB(0, 1), b2 + hstepB);
            G_WAIT_V(6); G_BAR; G_MMA(1, 1, At, B1); G_BAR;
            G_LDB(B0, 1, 0); G_SCHED; G_LDA(At, 1, 0); G_STAGEA(G_SA(0, 1), cAo, 1, k2);
            G_WAIT_L(8); G_BAR; G_WAIT_L(0); G_MMA(0, 0, At, B0); G_BAR; G_SCHED;
            G_LDB(B1, 1, 1); G_STAGEB(G_SB(1, 0), b3);
            G_BAR; G_WAIT_L(0); G_MMA(0, 1, At, B1); G_BAR;
            G_LDA(At, 1, 1); G_STAGEA(G_SA(1, 0), cAo, 0, k3);
            G_BAR; G_WAIT_L(0); G_MMA(1, 0, At, B0); G_BAR; G_SCHED;
            G_STAGEB(G_SB(1, 1), b3 + hstepB);
            G_WAIT_V(6); G_BAR; G_MMA(1, 1, At, B1); G_BAR;
        }
        if (tp_on) { tp_1 = TP_NOW(); tp_k += tp_1 - tp_s; }
        const float osc = F8 ? __builtin_ldexpf(1.0f, ((SCA & 0xFF) - 127) + ((SCB & 0xFF) - 127)) : 1.0f;
        if constexpr (F8 && !Epi::FOLD) {
#pragma unroll
            for (int a = 0; a < 2; ++a)
#pragma unroll
                for (int b = 0; b < 2; ++b)
#pragma unroll
                    for (int m = 0; m < 4; ++m)
#pragma unroll
                        for (int n = 0; n < 2; ++n) acc[a][b][m][n] *= osc; }
        E(acc, cur, wr, wc, fr, fq, (const LAS float*)(lds + XB_OFF + ((ui & 1) * 8 + wid) * 256), (const LAS int*)(lds + XT_OFF + ((ui & 1) * 8 + wid) * 1024), osc);
        if (tp_on) tp_e += TP_NOW() - tp_1;
        if (!has_next) break;
#pragma unroll
        for (int a = 0; a < 2; ++a)
#pragma unroll
            for (int b = 0; b < 2; ++b)
#pragma unroll
                for (int m = 0; m < 4; ++m)
#pragma unroll
                    for (int n = 0; n < 2; ++n) acc[a][b][m][n] = (f32x4){0.f, 0.f, 0.f, 0.f};
        cur = nxt; ++ui;
    }
    G_WAIT_V(0);
    if (wr == 0) G_BAR;
    G_BAR;
    if (tp_on && blockIdx.x == 0 && tid == 0) { const unsigned tot = TP_NOW() - tp_0; *tprobe = (unsigned long long)((GP_PROBE == 1) ? tp_k : (GP_PROBE == 2) ? tp_e : tot); }
#undef G_SA
#undef G_SB
#undef G_STAGEA
#undef G_STAGEB
#undef G_LDA
#undef G_LDB
#undef G_MMA
#undef G_CAT8
#undef G_WAIT_V
#undef G_WAIT_L
#undef G_BAR
#undef G_SCHED
}

__device__ __forceinline__ void lane_rc(int i, int& R, int& Cb) { int C; stage_rc(otid() * 16 + i * 8192, R, C); Cb = C * 2; }

struct SchedDense {
    const char* A; const char* B; int RP, nM, nN, G, c;
    __device__ __forceinline__ const char* abase() const { return A; }
    __device__ __forceinline__ bool next(int i, Unit& u) const { const long L = (long)i * G + c; if (L >= (long)nM * nN) return false; dense_map((int)L, nM, nN, u.pm, u.pn); u.e = 0; return true; }
    __device__ __forceinline__ void a_off(const Unit& u, unsigned (&o)[2][2]) const {
#pragma unroll
        for (int i = 0; i < 2; ++i) { int R, Cb; lane_rc(i, R, Cb);
#pragma unroll
            for (int h = 0; h < 2; ++h) o[h][i] = (unsigned)(u.pm * BM + h * HALF + R) * (unsigned)RP + (unsigned)Cb; }
    }
    __device__ __forceinline__ void prefetch_rows(const Unit&, LAS unsigned char*, int, int, int) const {}
    __device__ __forceinline__ void prefetch_bias(const Unit&, LAS unsigned char*, int, int, int, int) const {}
    __device__ __forceinline__ void a_off_lds(const Unit& u, LAS unsigned char*, int, int, int, unsigned (&o)[2][2]) const { a_off(u, o); }
    __device__ __forceinline__ const char* b_ptr(const Unit& u) const { return B + (size_t)u.pn * BM * RP; }
};
struct SchedIn0 {
    const char* A; const char* B; int G, c;
    __device__ __forceinline__ const char* abase() const { return A; }
    __device__ __forceinline__ bool next(int i, Unit& u) const {
        const long L = (long)i * G + c; u.e = 0;
        if (L < 256 * 15) { dense_map((int)L, 256, 15, u.pm, u.pn); return true; }
        const int r = (int)(L - 256 * 15); if (r >= 56) return false;
        u.pm = 256 + r / 7; const int q = r % 7; u.pn = (q < 6) ? (2 + q) : 14; return true;
    }
    __device__ __forceinline__ void a_off(const Unit& u, unsigned (&o)[2][2]) const {
#pragma unroll
        for (int i = 0; i < 2; ++i) { int R, Cb; lane_rc(i, R, Cb);
#pragma unroll
            for (int h = 0; h < 2; ++h) o[h][i] = (unsigned)(u.pm * BM + h * HALF + R) * (F8_IN0 ? 1024u : 2048u) + (unsigned)Cb; }
    }
    __device__ __forceinline__ void prefetch_rows(const Unit&, LAS unsigned char*, int, int, int) const {}
    __device__ __forceinline__ void prefetch_bias(const Unit&, LAS unsigned char*, int, int, int, int) const {}
    __device__ __forceinline__ void a_off_lds(const Unit& u, LAS unsigned char*, int, int, int, unsigned (&o)[2][2]) const { a_off(u, o); }
    __device__ __forceinline__ const char* b_ptr(const Unit& u) const { return B + (size_t)u.pn * BM * (F8_IN0 ? 1024 : 2048); }
};
struct SchedMoE {
    const char* A; const char* B; const int* slot_tok; int ts; int RT; int nct; int G, c; size_t bstride_e; bool gather; const float* bias; const int* slot_dst;
    __device__ __forceinline__ const char* abase() const { return A; }
    __device__ __forceinline__ bool next(int i, Unit& u) const {
        const int x = c & 7, j = c >> 3; int rt, ct;
        if (nct == 8) { rt = 32 * i + 4 * x + (j & 3); ct = j >> 2; } else { rt = 64 * i + 8 * x + (j & 7); ct = j >> 3; }
        if (rt >= RT) return false;
        const unsigned long long m = __ballot(((otid() & 63) < 32) && ts <= rt);
        u.pm = rt; u.pn = ct; u.e = __builtin_amdgcn_readfirstlane(__popcll(m)) - 1; return true;
    }
    __device__ __forceinline__ void a_off(const Unit& u, unsigned (&o)[2][2]) const {
#pragma unroll
        for (int i = 0; i < 2; ++i) { int R, Cb; lane_rc(i, R, Cb);
#pragma unroll
            for (int h = 0; h < 2; ++h) { const int row = u.pm * BM + h * HALF + R; const unsigned rr = gather ? (unsigned)slot_tok[row] : (unsigned)row; o[h][i] = rr * 1024u + (unsigned)Cb; } }
    }
    __device__ __forceinline__ const char* b_ptr(const Unit& u) const { return B + (size_t)u.e * bstride_e + (size_t)u.pn * BM * 1024; }
    __device__ __forceinline__ void prefetch_rows(const Unit& u, LAS unsigned char* lds, int par, int wid, int lane) const {
        if (!gather) { if (!slot_dst) return;
#pragma unroll
            for (int ai = 0; ai < 2; ++ai) __builtin_amdgcn_global_load_lds((const unsigned*)(slot_dst + (u.pm * BM + ai * HALF + (wid >> 2) * 64 + lane)), (LAS unsigned*)(lds + XT_OFF + ((par * 8 + wid) * 4 + ai) * 256), 4, 0, 0);
            return; }
#pragma unroll
        for (int i = 0; i < 2; ++i) { int R, Cb; lane_rc(i, R, Cb);
#pragma unroll
            for (int h = 0; h < 2; ++h) __builtin_amdgcn_global_load_lds((const unsigned*)(slot_tok + (u.pm * BM + h * HALF + R)), (LAS unsigned*)(lds + XT_OFF + ((par * 8 + wid) * 4 + h * 2 + i) * 256), 4, 0, 0); }
    }
    __device__ __forceinline__ void prefetch_bias(const Unit& u, LAS unsigned char* lds, int par, int wid, int lane, int wc) const {
        const float* src = (nct == 8) ? bias + (size_t)u.e * 2048 + (lane >> 5) * 1024 + u.pn * 128 + wc * 32 + (lane & 31)
                                      : bias + (size_t)u.e * 1024 + u.pn * 256 + (lane >> 5) * 128 + wc * 32 + (lane & 31);
        __builtin_amdgcn_global_load_lds((const unsigned*)src, (LAS unsigned*)(lds + XB_OFF + (par * 8 + wid) * 256), 4, 0, 0);
    }
    __device__ __forceinline__ void a_off_lds(const Unit& u, LAS unsigned char* lds, int par, int wid, int lane, unsigned (&o)[2][2]) const {
#pragma unroll
        for (int i = 0; i < 2; ++i) { int R, Cb; lane_rc(i, R, Cb);
#pragma unroll
            for (int h = 0; h < 2; ++h) { const unsigned rr = gather ? *(const LAS unsigned*)(lds + XT_OFF + ((par * 8 + wid) * 4 + h * 2 + i) * 256 + lane * 4) : (unsigned)(u.pm * BM + h * HALF + R); o[h][i] = rr * 1024u + (unsigned)Cb; } }
    }
};

__device__ __forceinline__ void store8(bf16* p, const f32x4& v0, const f32x4& v1) {
    u32x4 w; w.x = cvt_pk(v0[0], v0[1]); w.y = cvt_pk(v0[2], v0[3]); w.z = cvt_pk(v1[0], v1[1]); w.w = cvt_pk(v1[2], v1[3]);
    *(u32x4*)p = w;
}
struct EpiPlain {
    static constexpr bool FOLD = false;
    bf16* O; int ldc;
    __device__ __forceinline__ void operator()(const f32x4 (&acc)[2][2][4][2], const Unit& u, int wr, int wc, int fr, int fq, const LAS float* lb, const LAS int* xt, const float osc) const {
        const int row0 = u.pm * BM + wr * 64 + fr, col0 = u.pn * BM + wc * 32 + 8 * fq;
#pragma unroll
        for (int ai = 0; ai < 2; ++ai)
#pragma unroll
            for (int m = 0; m < 4; ++m) { bf16* rowp = O + (size_t)(row0 + ai * HALF + m * 16) * ldc + col0;
#pragma unroll
                for (int bj = 0; bj < 2; ++bj) store8(rowp + bj * HALF, acc[ai][bj][m][0], acc[ai][bj][m][1]); }
    }
};
struct EpiIn0 {
    static constexpr bool FOLD = false;
    unsigned char* ws;
    __device__ __forceinline__ void operator()(const f32x4 (&acc)[2][2][4][2], const Unit& u, int wr, int wc, int fr, int fq, const LAS float* lb, const LAS int* xt, const float osc) const {
        const int pn = u.pn; bf16* base; int ldc, c0;
        if (pn < 2) { base = (bf16*)(ws + WS_Q); ldc = 512; c0 = pn * 256; }
        else if (pn < 4) { base = (bf16*)(ws + WS_K); ldc = 512; c0 = (pn - 2) * 256; }
        else if (pn < 8) { base = (bf16*)(ws + WS_V); ldc = 1024; c0 = (pn - 4) * 256; }
        else if (pn < 12) { base = (bf16*)(ws + WS_R); ldc = 1024; c0 = (pn - 8) * 256; }
        else if (pn < 14) { base = (bf16*)(ws + WS_ZC); ldc = 512; c0 = (pn - 12) * 256; }
        else { base = (bf16*)(ws + WS_LR); ldc = 32; c0 = 0; }
        const int row0 = u.pm * BM + wr * 64 + fr, col0 = c0 + wc * 32 + 8 * fq;
        const bool lr = (pn == 14);
        if (lr && wc != 0) return;
        const float qs = (pn < 2) ? 0.08838834764831845f : 1.0f;
#pragma unroll
        for (int ai = 0; ai < 2; ++ai)
#pragma unroll
            for (int m = 0; m < 4; ++m) { bf16* rowp = base + (size_t)(row0 + ai * HALF + m * 16) * ldc + col0;
                store8(rowp, acc[ai][0][m][0] * qs, acc[ai][0][m][1] * qs);
                if (!lr) store8(rowp + HALF, acc[ai][1][m][0] * qs, acc[ai][1][m][1] * qs); }
    }
};
struct EpiIn1 {
    static constexpr bool FOLD = false;
    unsigned char* ws;
    __device__ __forceinline__ void operator()(const f32x4 (&acc)[2][2][4][2], const Unit& u, int wr, int wc, int fr, int fq, const LAS float* lb, const LAS int* xt, const float osc) const {
        const int pn = u.pn; const int row0 = u.pm * BM + wr * 64 + fr;
        if (pn >= 8) { bf16* O = (bf16*)(ws + WS_GB); const int col0 = (pn - 8) * 256 + wc * 32 + 8 * fq;
#pragma unroll
            for (int ai = 0; ai < 2; ++ai)
#pragma unroll
                for (int m = 0; m < 4; ++m) { bf16* rowp = O + (size_t)(row0 + ai * HALF + m * 16) * 512 + col0;
#pragma unroll
                    for (int bj = 0; bj < 2; ++bj) store8(rowp + bj * HALF, acc[ai][bj][m][0], acc[ai][bj][m][1]); }
            return; }
        const bool glu = pn < 4; bf16* O = (bf16*)(ws + (glu ? WS_GLU : WS_ZC1)); const int col0 = (pn & 3) * 128 + wc * 32 + 8 * fq;
#pragma unroll
        for (int ai = 0; ai < 2; ++ai)
#pragma unroll
            for (int m = 0; m < 4; ++m) { f32x4 o[2];
#pragma unroll
                for (int n = 0; n < 2; ++n)
#pragma unroll
                    for (int i = 0; i < 4; i += 2) { const f32v2_t a = (f32v2_t){acc[ai][0][m][n][i], acc[ai][0][m][n][i + 1]}, b = (f32v2_t){acc[ai][1][m][n][i], acc[ai][1][m][n][i + 1]};
                        f32v2_t ov;
                        if (glu) { const f32v2_t ea = b * -1.4426950408889634f; f32v2_t e; e.x = __builtin_amdgcn_exp2f(ea.x); e.y = __builtin_amdgcn_exp2f(ea.y);
                            const f32v2_t d = e + 1.0f; f32v2_t r; r.x = __builtin_amdgcn_rcpf(d.x); r.y = __builtin_amdgcn_rcpf(d.y); ov = a * r; }
                        else ov = a * b;
                        o[n][i] = ov.x; o[n][i + 1] = ov.y; }
                store8(O + (size_t)(row0 + ai * HALF + m * 16) * 512 + col0, o[0], o[1]); }
    }
};
struct EpiGU {
    static constexpr bool FOLD = true;
    unsigned char* O; const float* bgu; int probe;
    __device__ __forceinline__ void operator()(const f32x4 (&acc)[2][2][4][2], const Unit& u, int wr, int wc, int fr, int fq, const LAS float* lb, const LAS int* xt, const float osc) const {
        if (probe) {
#pragma unroll
            for (int a = 0; a < 2; ++a)
#pragma unroll
                for (int b = 0; b < 2; ++b)
#pragma unroll
                    for (int m = 0; m < 4; ++m)
#pragma unroll
                        for (int n = 0; n < 2; ++n) asm volatile("" :: "v"(acc[a][b][m][n]));
            return; }
        const int row0 = u.pm * BM + wr * 64 + fr, col0 = u.pn * 128 + wc * 32 + 8 * fq;
        f32x4 bgv[2], buv[2];
#pragma unroll
        for (int n = 0; n < 2; ++n) { bgv[n] = *(const LAS f32x4*)(lb + 8 * fq + 4 * n); buv[n] = *(const LAS f32x4*)(lb + 32 + 8 * fq + 4 * n); }
#pragma unroll
        for (int ai = 0; ai < 2; ++ai)
#pragma unroll
            for (int m = 0; m < 4; ++m) { f32x4 o[2];
#pragma unroll
                for (int n = 0; n < 2; ++n)
#pragma unroll
                    for (int i = 0; i < 4; i += 2) {
                        f32v2_t g = (f32v2_t){acc[ai][0][m][n][i], acc[ai][0][m][n][i + 1]} * osc + (f32v2_t){bgv[n][i], bgv[n][i + 1]};
                        f32v2_t uu = (f32v2_t){acc[ai][1][m][n][i], acc[ai][1][m][n][i + 1]} * osc + (f32v2_t){buv[n][i], buv[n][i + 1]};
                        g.x = fminf(g.x, 7.0f); g.y = fminf(g.y, 7.0f);
                        uu.x = __builtin_amdgcn_fmed3f(uu.x, -7.0f, 7.0f); uu.y = __builtin_amdgcn_fmed3f(uu.y, -7.0f, 7.0f);
                        const f32v2_t ea = g * (-1.702f * 1.4426950408889634f);
                        f32v2_t e; e.x = __builtin_amdgcn_exp2f(ea.x); e.y = __builtin_amdgcn_exp2f(ea.y);
                        const f32v2_t d = e + 1.0f;
                        f32v2_t r; r.x = __builtin_amdgcn_rcpf(d.x); r.y = __builtin_amdgcn_rcpf(d.y);
                        const f32v2_t t4 = uu * 4.0f + 4.0f;
                        const f32v2_t ov = (g * r) * t4;
                        o[n][i] = ov.x; o[n][i + 1] = ov.y; }
                int w0 = 0, w1 = 0;
                w0 = __builtin_amdgcn_cvt_pk_fp8_f32(o[0][0], o[0][1], w0, false); w0 = __builtin_amdgcn_cvt_pk_fp8_f32(o[0][2], o[0][3], w0, true);
                w1 = __builtin_amdgcn_cvt_pk_fp8_f32(o[1][0], o[1][1], w1, false); w1 = __builtin_amdgcn_cvt_pk_fp8_f32(o[1][2], o[1][3], w1, true);
                *(u32x2*)(O + (size_t)(row0 + ai * HALF + m * 16) * 1024 + col0) = (u32x2){(unsigned)w0, (unsigned)w1}; }
    }
};
struct EpiDown {
    static constexpr bool FOLD = true;
    unsigned char* O; const float* bd;
    __device__ __forceinline__ void operator()(const f32x4 (&acc)[2][2][4][2], const Unit& u, int wr, int wc, int fr, int fq, const LAS float* lb, const LAS int* xt, const float osc) const {
        const int row0 = u.pm * BM + wr * 64 + fr, col0 = u.pn * BM + wc * 32 + 8 * fq;
        f32x4 bv[2][2];
#pragma unroll
        for (int bj = 0; bj < 2; ++bj)
#pragma unroll
            for (int n = 0; n < 2; ++n) bv[bj][n] = *(const LAS f32x4*)(lb + 32 * bj + 8 * fq + 4 * n) * 16.0f;
#pragma unroll
        for (int ai = 0; ai < 2; ++ai)
#pragma unroll
            for (int m = 0; m < 4; ++m) { unsigned char* rowp = O + (size_t)(row0 + ai * HALF + m * 16) * 1024 + col0;
#pragma unroll
                for (int bj = 0; bj < 2; ++bj) { const f32x4 v0 = acc[ai][bj][m][0] * (16.0f * osc) + bv[bj][0], v1 = acc[ai][bj][m][1] * (16.0f * osc) + bv[bj][1];
                    int w0 = 0, w1 = 0;
                    w0 = __builtin_amdgcn_cvt_pk_fp8_f32(fminf(fmaxf(v0[0], -440.f), 440.f), fminf(fmaxf(v0[1], -440.f), 440.f), w0, false); w0 = __builtin_amdgcn_cvt_pk_fp8_f32(fminf(fmaxf(v0[2], -440.f), 440.f), fminf(fmaxf(v0[3], -440.f), 440.f), w0, true);
                    w1 = __builtin_amdgcn_cvt_pk_fp8_f32(fminf(fmaxf(v1[0], -440.f), 440.f), fminf(fmaxf(v1[1], -440.f), 440.f), w1, false); w1 = __builtin_amdgcn_cvt_pk_fp8_f32(fminf(fmaxf(v1[2], -440.f), 440.f), fminf(fmaxf(v1[3], -440.f), 440.f), w1, true);
                    *(u32x2*)(rowp + bj * HALF) = (u32x2){(unsigned)w0, (unsigned)w1}; } }
    }
};
}

__device__ __forceinline__ void p0_adaln(const Ctx& C) {
    PH_IDS;
    LAS float* s = (LAS float*)C.lds;
    LAS float* red = (LAS float*)(C.lds + 36864);
    const float* cc = C.a->in[IN_C]; const float* cx = C.a->in[IN_CCTX];
    { float tmpc[18];
#pragma unroll
      for (int q = 0; q < 18; ++q) { const int i = tid + 512 * q; const int b = i >> 10, k = i & 1023; tmpc[q] = (b < 8) ? cc[b * 1024 + k] : cx[k]; }
#pragma unroll
      for (int q = 0; q < 18; ++q) s[tid + 512 * q] = siluf_(tmpc[q]); }
    __syncthreads();
    float* MOD = (float*)(C.ws + WS_MOD);
    for (int item = blockIdx.x; item < 192; item += C.G) {
        const int l = item / 96, cb = item % 96, col = cb * 64 + lane;
        const float* W = C.a->in[IN_MODW] + (size_t)l * 1024 * 6144 + col;
        float acc[9];
#pragma unroll
        for (int b = 0; b < 9; ++b) acc[b] = 0.f;
        const int k0 = wave * 128;
#pragma unroll 8
        for (int k = k0; k < k0 + 128; ++k) { const float w = W[(size_t)k * 6144];
#pragma unroll
            for (int b = 0; b < 9; ++b) acc[b] += s[b * 1024 + k] * w; }
#pragma unroll
        for (int b = 0; b < 9; ++b) red[(wave * 9 + b) * 64 + lane] = acc[b];
        __syncthreads();
        for (int i = tid; i < 576; i += 512) { const int b = i >> 6, ln = i & 63; float v = 0.f;
#pragma unroll
            for (int w = 0; w < 8; ++w) v += red[(w * 9 + b) * 64 + ln];
            v += C.a->in[IN_MODB][l * 6144 + cb * 64 + ln];
            MOD[(size_t)(l * 9 + b) * 6144 + cb * 64 + ln] = v; }
        __syncthreads();
    }
}
__device__ __forceinline__ void p0_tr_item(const float* W, int ldw, int sc0, int k0, bf16* WT, int Kd, int dr0, float scale, LAS float* scr, int lane) {
#pragma unroll 8
    for (int i = 0; i < 32; ++i) { const int kk = 2 * i + (lane >> 5); scr[kk * 33 + (lane & 31)] = W[(size_t)(k0 + kk) * ldw + sc0 + (lane & 31)]; }
    asm volatile("s_waitcnt lgkmcnt(0)" ::: "memory");
    const int c = lane & 7;
#pragma unroll
    for (int j = 0; j < 4; ++j) { const int n = (lane >> 3) + 8 * j; const LAS float* sp = scr + (8 * c) * 33 + n;
        u32x4 o; o.x = cvt_pk(sp[0 * 33] * scale, sp[1 * 33] * scale); o.y = cvt_pk(sp[2 * 33] * scale, sp[3 * 33] * scale);
        o.z = cvt_pk(sp[4 * 33] * scale, sp[5 * 33] * scale); o.w = cvt_pk(sp[6 * 33] * scale, sp[7 * 33] * scale);
        *(u32x4*)(WT + (size_t)(dr0 + n) * Kd + k0 + 8 * c) = o; }
    asm volatile("s_waitcnt lgkmcnt(0)" ::: "memory");
}
__device__ __forceinline__ void p0_tr_item8(const float* W, int ldw, int sc0, int k0, unsigned char* WT, int Kd, int dr0, float scale, LAS float* scr, int lane) {
#pragma unroll 8
    for (int i = 0; i < 64; ++i) { const int kk = 2 * i + (lane >> 5); scr[kk * 33 + (lane & 31)] = W[(size_t)(k0 + kk) * ldw + sc0 + (lane & 31)]; }
    asm volatile("s_waitcnt lgkmcnt(0)" ::: "memory");
    const int c = lane & 7;
#pragma unroll
    for (int j = 0; j < 4; ++j) { const int n = (lane >> 3) + 8 * j; const LAS float* sp = scr + (16 * c) * 33 + n;
        int w[4];
#pragma unroll
        for (int q = 0; q < 4; ++q) { int x = 0;
            x = __builtin_amdgcn_cvt_pk_fp8_f32(sp[(4 * q) * 33] * scale, sp[(4 * q + 1) * 33] * scale, x, false);
            x = __builtin_amdgcn_cvt_pk_fp8_f32(sp[(4 * q + 2) * 33] * scale, sp[(4 * q + 3) * 33] * scale, x, true); w[q] = x; }
        *(u32x4*)(WT + (size_t)(dr0 + n) * Kd + k0 + 16 * c) = (u32x4){(unsigned)w[0], (unsigned)w[1], (unsigned)w[2], (unsigned)w[3]}; }
    asm volatile("s_waitcnt lgkmcnt(0)" ::: "memory");
}
__device__ __forceinline__ int gu_src_col(int dr0) { const int pn = dr0 >> 8, bj = (dr0 >> 7) & 1, t0 = dr0 & 127; return bj * 1024 + 128 * pn + t0; }
__device__ __forceinline__ int in1_src_col(int dr0) {
    const int pn = dr0 >> 8, bj = (dr0 >> 7) & 1, t0 = dr0 & 127;
    if (pn < 4) return bj * 512 + 128 * pn + t0;
    if (pn < 8) return (bj ? 2048 : 1536) + 128 * (pn - 4) + t0;
    return 1024 + (dr0 - 2048);
}
__device__ __forceinline__ void p0_convert(const Ctx& C) {
    PH_IDS;
    LAS float* scr = (LAS float*)(C.lds + wave * 16896);
    const int gw = blockIdx.x * 8 + wave, NGW = C.G * 8;
    constexpr int KB_IN0 = F8_IN0 ? 8 : 16, KB_OUT0 = F8_OUT0 ? 12 : 24, KB_IN1 = F8_IN1 ? 8 : 16, KB_OUT1 = F8_OUT1 ? 8 : 16;
    constexpr int I_IN0 = 97 * KB_IN0, I_OUT0 = 32 * KB_OUT0, I_IN1 = 80 * KB_IN1, I_OUT1 = 32 * KB_OUT1, I_GU = 64 * 64 * 8, I_D = 64 * 32 * 8;
    constexpr int NITEMS = I_IN0 + I_OUT0 + I_IN1 + I_OUT1 + I_GU + I_D;
    for (int it = gw; it < NITEMS; it += NGW) {
        int r = it;
        if (r < I_IN0) { const int nb = r / KB_IN0, kb = r % KB_IN0; int dr0, sc0;
            if (nb < 96) { dr0 = nb * 32; sc0 = dr0; } else { dr0 = 3584; sc0 = 3072; }
            if (F8_IN0) p0_tr_item8(C.a->in[IN_EVWIN], 3616, sc0, kb * 128, (unsigned char*)(C.ws + WS_WIN0), 1024, dr0, 32.f, scr, lane);
            else p0_tr_item(C.a->in[IN_EVWIN], 3616, sc0, kb * 64, (bf16*)(C.ws + WS_WIN0), 1024, dr0, 1.f, scr, lane);
            continue; }
        r -= I_IN0;
        if (r < I_OUT0) { const int nb = r / KB_OUT0, kb = r % KB_OUT0;
            if (F8_OUT0) p0_tr_item8(C.a->in[IN_EVWOUT], 1024, nb * 32, kb * 128, (unsigned char*)(C.ws + WS_WOUT0), 1536, nb * 32, 32.f, scr, lane);
            else p0_tr_item(C.a->in[IN_EVWOUT], 1024, nb * 32, kb * 64, (bf16*)(C.ws + WS_WOUT0), 1536, nb * 32, 1.f, scr, lane);
            continue; }
        r -= I_OUT0;
        if (r < I_IN1) { const int nb = r / KB_IN1, kb = r % KB_IN1;
            if (F8_IN1) p0_tr_item8(C.a->in[IN_ODWIN], 2560, in1_src_col(nb * 32), kb * 128, (unsigned char*)(C.ws + WS_WIN1), 1024, nb * 32, 32.f, scr, lane);
            else p0_tr_item(C.a->in[IN_ODWIN], 2560, in1_src_col(nb * 32), kb * 64, (bf16*)(C.ws + WS_WIN1), 1024, nb * 32, 1.f, scr, lane);
            continue; }
        r -= I_IN1;
        if (r < I_OUT1) { const int nb = r / KB_OUT1, kb = r % KB_OUT1;
            if (F8_OUT1) p0_tr_item8(C.a->in[IN_ODWOUT], 1024, nb * 32, kb * 128, (unsigned char*)(C.ws + WS_WOUT1), 1024, nb * 32, 32.f, scr, lane);
            else p0_tr_item(C.a->in[IN_ODWOUT], 1024, nb * 32, kb * 64, (bf16*)(C.ws + WS_WOUT1), 1024, nb * 32, 1.f, scr, lane);
            continue; }
        r -= I_OUT1;
        if (r < I_GU) { const int le = r >> 9, q = r & 511, nb = q >> 3, kb = q & 7;
            p0_tr_item8(C.a->in[IN_WGU] + (size_t)le * 1024 * 2048, 2048, gu_src_col(nb * 32), kb * 128, (unsigned char*)(C.ws + WS_WGU) + (size_t)le * 2048 * 1024, 1024, nb * 32, 32.f, scr, lane); continue; }
        r -= I_GU;
        { const int le = r >> 8, q = r & 255, nb = q >> 3, kb = q & 7;
            p0_tr_item8(C.a->in[IN_WD] + (size_t)le * 1024 * 1024, 1024, nb * 32, kb * 128, (unsigned char*)(C.ws + WS_WD) + (size_t)le * 1024 * 1024, 1024, nb * 32, 32.f, scr, lane); }
    }
    { u32x4* z = (u32x4*)((unsigned char*)(C.ws + WS_WIN0) + (size_t)3616 * 1024 * (F8_IN0 ? 1 : 2)); const int n16 = 224 * 1024 * (F8_IN0 ? 1 : 2) / 16;
      for (int i = blockIdx.x * 512 + tid; i < n16; i += C.G * 512) z[i] = (u32x4){0u, 0u, 0u, 0u}; }
    { bf16* F1 = (bf16*)(C.ws + WS_F1); bf16* F2 = (bf16*)(C.ws + WS_F2);
      for (int i = blockIdx.x * 512 + tid; i < 128 * 128 + 128 * 256; i += C.G * 512) {
          if (i < 128 * 128) { const int m = i >> 7, k = i & 127; const int mb = m >> 5, rr = m & 31, g = rr >> 3, hh = (rr >> 2) & 1, ii = rr & 3;
              const int part = g & 1, ap = 16 * mb + 8 * (g >> 1) + 4 * hh + ii, pin = k >> 6, a = k & 63;
              const float th = 6.283185307179586f * (float)((a * ap) & 63) * (1.0f / 64.0f); const float cs = cosf(th), sn = sinf(th);
              const float v = (part == 0) ? (pin == 0 ? cs : -sn) : (pin == 0 ? -sn : -cs);
              F1[i] = (bf16)f2bf(v); }
          else { const int q = i - 128 * 128, m = q >> 8, k = q & 255, pin = k >> 7, b = k & 127;
              const float ps = 6.283185307179586f * (float)((b * m) & 127) * (1.0f / 128.0f);
              F2[q] = (bf16)f2bf(pin == 0 ? cosf(ps) : sinf(ps)); } } }
    __syncthreads();
}
__device__ __forceinline__ void p0_fourier_fold(const Ctx& C) {
    PH_IDS;
    LAS float* Wl = (LAS float*)C.lds;
    LAS float* tab = (LAS float*)(C.lds + 32768);
    unsigned char* WT = (unsigned char*)(C.ws + WS_WIN0);
    for (int item = blockIdx.x; item < 64; item += C.G) {
        const int kb = item >> 2, g = item & 3;
        __syncthreads();
        if (tid < 128) tab[tid] = cosf(6.283185307179586f * (float)tid * (1.0f / 128.0f));
        for (int i = tid; i < 64 * 128; i += 512) { const int kk = i >> 7, c = i & 127; Wl[i] = C.a->in[IN_EVWIN][(size_t)(kb * 64 + kk) * 3616 + 3104 + g * 128 + c]; }
        __syncthreads();
        const int cp = tid & 127, kq = tid >> 7; const bool isS = cp > 64; const int cq = isS ? cp - 64 : cp, shf = isS ? 96 : 0;
        float ac[16];
#pragma unroll
        for (int i = 0; i < 16; ++i) ac[i] = 0.f;
#pragma unroll 4
        for (int c = 0; c < 128; ++c) { const float tr = tab[(c * cq + shf) & 127];
#pragma unroll
            for (int i = 0; i < 16; ++i) ac[i] += Wl[(kq * 16 + i) * 128 + c] * tr; }
        if (F8_IN0) {
            unsigned char* pc = WT + (size_t)(3072 + g * 128 + cp) * 1024 + kb * 64 + kq * 16;
            *(u32x4*)pc = (u32x4){pk4_fp8(ac[0], ac[1], ac[2], ac[3], 32.f), pk4_fp8(ac[4], ac[5], ac[6], ac[7], 32.f), pk4_fp8(ac[8], ac[9], ac[10], ac[11], 32.f), pk4_fp8(ac[12], ac[13], ac[14], ac[15], 32.f)};
        } else {
            bf16* pc = (bf16*)WT + (size_t)(3072 + g * 128 + cp) * 1024 + kb * 64 + kq * 16;
            *(u32x4*)pc = (u32x4){cvt_pk(ac[0], ac[1]), cvt_pk(ac[2], ac[3]), cvt_pk(ac[4], ac[5]), cvt_pk(ac[6], ac[7])}; *(u32x4*)(pc + 8) = (u32x4){cvt_pk(ac[8], ac[9]), cvt_pk(ac[10], ac[11]), cvt_pk(ac[12], ac[13]), cvt_pk(ac[14], ac[15])};
        }
    }
    __syncthreads();
}

__device__ __forceinline__ void p_norm0(const Ctx& C) {
    PH_IDS;
    const int gw = blockIdx.x * 8 + wave, NGW = C.G * 8;
    const int per = (MALL + NGW - 1) / NGW;
    const int r0 = gw * per, r1 = (r0 + per < MALL) ? r0 + per : MALL;
    const float* MOD = (const float*)(C.ws + WS_MOD);
    const float* g = C.a->in[IN_NMPRE];
    unsigned char* HN = (unsigned char*)(C.ws + WS_HN);
    int curb = -1; f32x4 A[4], B[4];
    for (int r = r0; r < r1; ++r) {
        const int b = (r < MTOK) ? (r >> 13) : 8;
        if (b != curb) { curb = b;
#pragma unroll
            for (int j = 0; j < 4; ++j) { const int c = 4 * lane + 256 * j;
                const f32x4 gg = *(const f32x4*)(g + c), sc = *(const f32x4*)(MOD + (size_t)b * 6144 + 1024 + c), sh = *(const f32x4*)(MOD + (size_t)b * 6144 + c);
                A[j] = gg * (sc + 1.0f); B[j] = sh; } }
        const float* xr = (r < MTOK) ? (C.a->in[IN_X] + (size_t)r * 1024) : (C.a->in[IN_CTX] + (size_t)(r - MTOK) * 1024);
        f32x4 v[4]; float ss = 0.f;
#pragma unroll
        for (int j = 0; j < 4; ++j) { v[j] = *(const f32x4*)(xr + 4 * lane + 256 * j); ss += v[j][0] * v[j][0] + v[j][1] * v[j][1] + v[j][2] * v[j][2] + v[j][3] * v[j][3]; }
        const float rstd = rsqrtf(wave_sum(ss) * (1.0f / 1024.0f) + EPS);
#pragma unroll
        for (int j = 0; j < 4; ++j) { const f32x4 h = v[j] * rstd * A[j] + B[j];
            if (F8_IN0) *(unsigned*)(HN + (size_t)r * 1024 + 4 * lane + 256 * j) = pk4_fp8(h[0], h[1], h[2], h[3], 8.f);
            else *(u32x2*)((bf16*)HN + (size_t)r * 1024 + 4 * lane + 256 * j) = (u32x2){cvt_pk(h[0], h[1]), cvt_pk(h[2], h[3])}; }
    }
}

namespace glap {
constexpr int H_BYTES = 72704;
constexpr int O_RAW = 0, O_BC = 2048, O_TOT = 34816, O_QP = 36864, O_KP = 54272;
constexpr int NUNIT = 2 * 4 * 8 * 132;
}
__device__ __forceinline__ int gla_row(int bt, int dir, int s, int i) {
    const int ii = dir ? 63 - i : i;
    if (s < 4) { const int ci = dir ? 3 - s : s; return MTOK + bt * CTXL + ci * 64 + ii; }
    const int n = s - 4, ci = dir ? 127 - n : n; return bt * SEQ + ci * 64 + ii;
}
__device__ __forceinline__ void p_gla_prep(const Ctx& C, const int pv = 0) {
    PH_IDS;
    using namespace glap;
    const int half = tid >> 8, th = tid & 255, wh = wave & 3;
    LAS unsigned char* L = C.lds + half * H_BYTES;
    const bf16* Qg = (const bf16*)(C.ws + WS_Q); const bf16* Kg = (const bf16*)(C.ws + WS_K); const bf16* LRg = (const bf16*)(C.ws + WS_LR);
    bf16* QPg = (bf16*)(C.ws + WS_GQP); bf16* KPPg = (bf16*)(C.ws + WS_GKPP); bf16* SCg = (bf16*)(C.ws + WS_GSC); float* ELg = (float*)(C.ws + WS_GEL);
    const int niter = (NUNIT + 2 * C.G - 1) / (2 * C.G);
    const int lj = th >> 2, part = th & 3;
    u32x4 nq[4], nk[4], nlr; float nup[8], nbias;
    auto unit_of = [&](int itn) -> int { const int U = (itn * C.G + (int)blockIdx.x) * 2 + half; return U < NUNIT ? U : NUNIT - 1; };
    auto issue_loads = [&](int Uc) {
        const int sstep = Uc % 132, bt = (Uc / 132) & 7, hd = (Uc / (132 * 8)) & 3, dir = Uc / (132 * 32);
#pragma unroll
        for (int q = 0; q < 4; ++q) { const int c = th + 256 * q; const int row = gla_row(bt, dir, sstep, c >> 4);
            nk[q] = *(const u32x4*)(Kg + (size_t)row * 512 + hd * 128 + (c & 15) * 8);
            nq[q] = *(const u32x4*)(Qg + (size_t)(sstep >= 4 ? row : 0) * 512 + hd * 128 + (c & 15) * 8); }
        if (th < 128) { const int r2 = gla_row(bt, dir, sstep, th >> 1); nlr = *(const u32x4*)(LRg + (size_t)r2 * 32 + dir * 16 + (th & 1) * 8); }
        const float* up = C.a->in[IN_EVGKUP] + (size_t)dir * 16 * 512 + hd * 128 + 32 * wh + (lane & 31);
#pragma unroll
        for (int q = 0; q < 8; ++q) nup[q] = up[(size_t)(8 * (lane >> 5) + q) * 512];
        nbias = C.a->in[IN_EVGKB][dir * 512 + hd * 128 + 32 * wh + (lane & 31)]; };
    issue_loads(unit_of(0));
    for (int itn = 0; itn < niter; ++itn) {
        const int U = (itn * C.G + (int)blockIdx.x) * 2 + half;
        const bool act = U < NUNIT;
        const int Uc = act ? U : NUNIT - 1;
        const int sstep = Uc % 132;
        const bool latent = sstep >= 4;
        u32x4 rq[4], rk[4], rlr = nlr;
#pragma unroll
        for (int q = 0; q < 4; ++q) { rq[q] = nq[q]; rk[q] = nk[q]; }
        bf16x8 upf; const float gbias = nbias;
        { unsigned short tmp[8];
#pragma unroll
          for (int q = 0; q < 8; ++q) tmp[q] = (unsigned short)f2bf(nup[q]);
          upf = (bf16x8){(short)tmp[0], (short)tmp[1], (short)tmp[2], (short)tmp[3], (short)tmp[4], (short)tmp[5], (short)tmp[6], (short)tmp[7]}; }
        if (itn + 1 < niter) issue_loads(unit_of(itn + 1));
        __syncthreads();
        if (th < 128) *(LAS u32x4*)(L + O_RAW + (th >> 1) * 32 + (th & 1) * 16) = rlr;
        __syncthreads();
#pragma unroll
        for (int jb = 0; jb < 2; ++jb) {
            const bf16x8 af = *(const LAS bf16x8*)(L + O_RAW + (32 * jb + (lane & 31)) * 32 + (lane >> 5) * 16);
            f32x16 z;
#pragma unroll
            for (int i = 0; i < 16; ++i) z[i] = 0.f;
            z = __builtin_amdgcn_mfma_f32_32x32x16_bf16(af, upf, z, 0, 0, 0);
#pragma unroll
            for (int r = 0; r < 16; ++r) { const int j = 32 * jb + (r & 3) + 8 * (r >> 2) + 4 * (lane >> 5); const float zz = z[r] + gbias;
                const float ls = fminf(zz, 0.f) - __logf(1.0f + __expf(-fabsf(zz)));
                *(LAS float*)(L + O_BC + (j * 128 + 32 * wh + (lane & 31)) * 4) = ls * 0.0625f; } }
        __syncthreads();
        { const int dk = th & 127;
          float run0 = 0.f, run1 = 0.f; const int g0 = th >> 7, g1 = g0 + 2;
          float v0[16], v1[16];
#pragma unroll
          for (int q = 0; q < 16; ++q) { v0[q] = *(const LAS float*)(L + O_BC + ((16 * g0 + q) * 128 + dk) * 4); v1[q] = *(const LAS float*)(L + O_BC + ((16 * g1 + q) * 128 + dk) * 4); }
#pragma unroll
          for (int q = 0; q < 16; ++q) { run0 += v0[q]; run1 += v1[q];
              *(LAS float*)(L + O_BC + ((16 * g0 + q) * 128 + dk) * 4) = run0; *(LAS float*)(L + O_BC + ((16 * g1 + q) * 128 + dk) * 4) = run1; }
          *(LAS float*)(L + O_TOT + (g0 * 128 + dk) * 4) = run0; *(LAS float*)(L + O_TOT + (g1 * 128 + dk) * 4) = run1; }
        __syncthreads();
        {
#pragma unroll
          for (int q8 = 0; q8 < 4; ++q8) {
              const int c = th + 256 * q8, cj = c >> 4, jg = cj >> 4, dkc = (c & 15) * 8;
              u32x4 oq, okpp;
#pragma unroll
              for (int hq = 0; hq < 2; ++hq) {
                  const int dk0 = dkc + 4 * hq;
                  f32x4 b = *(const LAS f32x4*)(L + O_BC + (cj * 128 + dk0) * 4), tt = (f32x4){0.f, 0.f, 0.f, 0.f};
#pragma unroll
                  for (int g2 = 0; g2 < 4; ++g2) { const f32x4 tv = *(const LAS f32x4*)(L + O_TOT + (g2 * 128 + dk0) * 4); tt += tv; if (g2 < jg) b += tv; }
                  f32x4 e1, e2, e3;
#pragma unroll
                  for (int i = 0; i < 4; ++i) { if (pv & 4) { e1[i] = b[i]; e2[i] = -b[i]; e3[i] = tt[i] - b[i]; } else { e1[i] = __expf(b[i]); e2[i] = __expf(-b[i]); e3[i] = __expf(tt[i] - b[i]); } }
                  if (cj == 0 && act && !(pv & 1)) { f32x4 el;
#pragma unroll
                      for (int i = 0; i < 4; ++i) el[i] = __expf(tt[i]);
                      *(f32x4*)(ELg + (size_t)Uc * 128 + dk0) = el; }
                  const unsigned qa = hq ? rq[q8].z : rq[q8].x, qb = hq ? rq[q8].w : rq[q8].y;
                  const unsigned ka = hq ? rk[q8].z : rk[q8].x, kb = hq ? rk[q8].w : rk[q8].y;
                  const float q0 = bf_lo(qa), q1 = bf_hi(qa), q2 = bf_lo(qb), q3 = bf_hi(qb);
                  const float k0 = bf_lo(ka), k1 = bf_hi(ka), k2 = bf_lo(kb), k3 = bf_hi(kb);
                  u32x2 o;
                  o.x = cvt_pk(q0 * e1[0], q1 * e1[1]); o.y = cvt_pk(q2 * e1[2], q3 * e1[3]); *(LAS u32x2*)(L + O_QP + cj * 272 + dk0 * 2) = o;
                  if (hq) { oq.z = o.x; oq.w = o.y; } else { oq.x = o.x; oq.y = o.y; }
                  o.x = cvt_pk(k0 * e2[0], k1 * e2[1]); o.y = cvt_pk(k2 * e2[2], k3 * e2[3]); *(LAS u32x2*)(L + O_KP + cj * 272 + dk0 * 2) = o;
                  o.x = cvt_pk(k0 * e3[0], k1 * e3[1]); o.y = cvt_pk(k2 * e3[2], k3 * e3[3]);
                  if (hq) { okpp.z = o.x; okpp.w = o.y; } else { okpp.x = o.x; okpp.y = o.y; }
              }
              if (act && !(pv & 1)) { *(u32x4*)(KPPg + (size_t)Uc * 8192 + c * 8) = okpp; if (latent) *(u32x4*)(QPg + (size_t)Uc * 8192 + c * 8) = oq; }
              else asm volatile("" :: "v"(okpp), "v"(oq));
          } }
        __syncthreads();
        if (latent && act && !(pv & 2)) {
            const int ib = wh;
            for (int jb16 = 0; jb16 <= ib; ++jb16) {
                f32x4 d = (f32x4){0.f, 0.f, 0.f, 0.f};
#pragma unroll
                for (int ks = 0; ks < 4; ++ks) {
                    const bf16x8 a = *(const LAS bf16x8*)(L + O_KP + (16 * jb16 + (lane & 15)) * 272 + (32 * ks + 8 * (lane >> 4)) * 2);
                    const bf16x8 bq = *(const LAS bf16x8*)(L + O_QP + (16 * ib + (lane & 15)) * 272 + (32 * ks + 8 * (lane >> 4)) * 2);
                    d = __builtin_amdgcn_mfma_f32_16x16x32_bf16(a, bq, d, 0, 0, 0); }
                const int i = 16 * ib + (lane & 15), j0 = 16 * jb16 + 4 * (lane >> 4);
#pragma unroll
                for (int r = 0; r < 4; ++r) if (j0 + r > i) d[r] = 0.f;
                u32x2 o; o.x = cvt_pk(d[0], d[1]); o.y = cvt_pk(d[2], d[3]);
                if (!(pv & 1)) *(u32x2*)(SCg + (size_t)Uc * 4096 + i * 64 + j0) = o; else asm volatile("" :: "v"(o));
            }
            for (int jb16 = ib + 1; jb16 < 4; ++jb16) { const int i = 16 * ib + (lane & 15), j0 = 16 * jb16 + 4 * (lane >> 4);
                if (!(pv & 1)) *(u32x2*)(SCg + (size_t)Uc * 4096 + i * 64 + j0) = (u32x2){0u, 0u}; }
        }
    }
    __syncthreads();
}
namespace gla {
constexpr int O_EL = 0, O_QP = 512, O_KPP = 17920, O_V = 38400, O_SC = 50688, IMG_BYTES = 59904, O_ST = 2 * IMG_BYTES;
constexpr int P_QP = 272, P_KPP = 320, P_V = 192, P_SC = 144, P_ST = 272, ST_BYTES = 64 * 272;
__device__ __forceinline__ bf16x8 tr8(LAS unsigned char* p0, LAS unsigned char* p1) {
    const s16x4 a = __builtin_amdgcn_ds_read_tr16_b64_v4i16((LAS s16x4*)p0);
    const s16x4 b = __builtin_amdgcn_ds_read_tr16_b64_v4i16((LAS s16x4*)p1);
    return (bf16x8){a[0], a[1], a[2], a[3], b[0], b[1], b[2], b[3]};
}
}
__device__ __forceinline__ void p_gla(const Ctx& C, const int probe = 0) {
    PH_IDS;
    using namespace gla;
    LAS unsigned char* L = C.lds;
    const int t = tid, w = wave;
    const bf16* Vg = (const bf16*)(C.ws + WS_V);
    const bf16* QPg = (const bf16*)(C.ws + WS_GQP); const bf16* KPPg = (const bf16*)(C.ws + WS_GKPP); const bf16* SCg = (const bf16*)(C.ws + WS_GSC); const float* ELg = (const float*)(C.ws + WS_GEL);
    for (int it = blockIdx.x; it < 256; it += C.G) {
        const int xx = it & 7, jj_ = it >> 3, scan = xx * 8 + (jj_ >> 2), dvs = jj_ & 3;
        const int bt = scan >> 3, hd = (scan >> 1) & 3, dir = scan & 1;
        const int ubase = ((dir * 4 + hd) * 8 + bt) * 132;
        bf16* Og = (bf16*)(C.ws + (probe ? WS_HN : (dir ? WS_OB : WS_OF)));
        __syncthreads();
        for (int i = t; i < ST_BYTES / 16; i += 512) *(LAS u32x4*)(L + O_ST + i * 16) = (u32x4){0u, 0u, 0u, 0u};
        f32x16 S;
#pragma unroll
        for (int i = 0; i < 16; ++i) S[i] = 0.f;
        const int lj = t >> 3, part = t & 7;
        u32x4 rsc, rqp0, rqp1, rkp0, rkp1, rv; f32x4 rel;
        u32x4 nsc, nqp0, nqp1, nkp0, nkp1, nv; f32x4 nel;
        auto load_step = [&](int s_) {
            const int s = probe ? 4 + (s_ & 1) : s_;
            const size_t U = (size_t)(ubase + s);
            const int row = gla_row(bt, dir, s, lj);
            nv = *(const u32x4*)(Vg + (size_t)row * 1024 + hd * 256 + dvs * 64 + part * 8);
            const bf16* kp = KPPg + U * 8192 + t * 8; nkp0 = *(const u32x4*)kp; nkp1 = *(const u32x4*)(kp + 4096);
            if (t < 32) nel = *(const f32x4*)(ELg + U * 128 + t * 4);
            if (s >= 4) { const bf16* qp = QPg + U * 8192 + t * 8; nqp0 = *(const u32x4*)qp; nqp1 = *(const u32x4*)(qp + 4096);
                nsc = *(const u32x4*)(SCg + U * 4096 + lj * 64 + part * 8); } };
        auto shift_regs = [&]() { rsc = nsc; rqp0 = nqp0; rqp1 = nqp1; rkp0 = nkp0; rkp1 = nkp1; rv = nv; rel = nel; };
        auto write_images = [&](int s, int ib_) {
            LAS unsigned char* I = L + ib_ * IMG_BYTES;
            *(LAS u32x4*)(I + O_V + lj * P_V + part * 16) = rv;
            *(LAS u32x4*)(I + O_KPP + (t >> 4) * P_KPP + (t & 15) * 16) = rkp0; *(LAS u32x4*)(I + O_KPP + (32 + (t >> 4)) * P_KPP + (t & 15) * 16) = rkp1;
            if (t < 32) *(LAS f32x4*)(I + O_EL + t * 16) = rel;
            if (s >= 4) { *(LAS u32x4*)(I + O_QP + (t >> 4) * P_QP + (t & 15) * 16) = rqp0; *(LAS u32x4*)(I + O_QP + (32 + (t >> 4)) * P_QP + (t & 15) * 16) = rqp1;
                *(LAS u32x4*)(I + O_SC + lj * P_SC + part * 16) = rsc; } };
        load_step(0); shift_regs(); write_images(0, 0);
        load_step(1); shift_regs();
        load_step(2);
        for (int s = 0; s < 132; ++s) {
            const int cur = s & 1, nx = cur ^ 1;
            const bool latent = (s >= 4);
            LAS unsigned char* I = L + cur * IMG_BYTES;
            __syncthreads();
            if (s + 1 < 132) write_images(s + 1, nx);
            shift_regs();
            if (s + 3 < 132) load_step(s + 3);
            if (latent) {
                const int ib = w >> 1;
                const int g4 = lane >> 4, q4 = (lane & 15) >> 2, p4 = lane & 3;
                const int orow = gla_row(bt, dir, s, 16 * ib + (lane & 15));
#pragma unroll
                for (int cc = 0; cc < 2; ++cc) {
                    const int c = 2 * (w & 1) + cc;
                    f32x4 d = (f32x4){0.f, 0.f, 0.f, 0.f};
#pragma unroll
                    for (int ks = 0; ks < 2; ++ks) {
                        LAS unsigned char* pa = I + O_V + (32 * ks + 8 * g4 + q4) * P_V + (16 * c + 4 * p4) * 2;
                        const bf16x8 a = gla::tr8(pa, pa + 4 * P_V);
                        const bf16x8 b = *(const LAS bf16x8*)(I + O_SC + (16 * ib + (lane & 15)) * P_SC + (32 * ks + 8 * g4) * 2);
                        d = __builtin_amdgcn_mfma_f32_16x16x32_bf16(a, b, d, 0, 0, 0); }
#pragma unroll
                    for (int ks = 0; ks < 4; ++ks) {
                        const bf16x8 a = *(const LAS bf16x8*)(L + O_ST + cur * ST_BYTES + (16 * c + (lane & 15)) * P_ST + (32 * ks + 8 * g4) * 2);
                        const bf16x8 b = *(const LAS bf16x8*)(I + O_QP + (16 * ib + (lane & 15)) * P_QP + (32 * ks + 8 * g4) * 2);
                        d = __builtin_amdgcn_mfma_f32_16x16x32_bf16(a, b, d, 0, 0, 0); }
                    u32x2 o; o.x = cvt_pk(d[0], d[1]); o.y = cvt_pk(d[2], d[3]);
                    *(u32x2*)(Og + (size_t)orow * 1024 + hd * 256 + dvs * 64 + 16 * c + 4 * g4) = o;
                }
            }
            { const int dbS = w & 3, dvb = w >> 2, hh = lane >> 5, blk = (lane >> 4) & 1, q4 = (lane & 15) >> 2, p4 = lane & 3;
#pragma unroll
              for (int g = 0; g < 4; ++g) { const f32x4 el = *(const LAS f32x4*)(I + O_EL + (32 * dbS + 8 * g + 4 * hh) * 4);
#pragma unroll
                  for (int i = 0; i < 4; ++i) S[4 * g + i] *= el[i]; }
#pragma unroll
              for (int ks = 0; ks < 4; ++ks) {
                  LAS unsigned char* pa = I + O_KPP + (16 * ks + 8 * hh + q4) * P_KPP + (32 * dbS + 16 * blk + 4 * p4) * 2;
                  LAS unsigned char* pb = I + O_V + (16 * ks + 8 * hh + q4) * P_V + (32 * dvb + 16 * blk + 4 * p4) * 2;
                  const bf16x8 a = gla::tr8(pa, pa + 4 * P_KPP);
                  const bf16x8 b = gla::tr8(pb, pb + 4 * P_V);
                  S = __builtin_amdgcn_mfma_f32_32x32x16_bf16(a, b, S, 0, 0, 0); }
#pragma unroll
              for (int g = 0; g < 4; ++g) { u32x2 o; o.x = cvt_pk(S[4 * g], S[4 * g + 1]); o.y = cvt_pk(S[4 * g + 2], S[4 * g + 3]);
                  *(LAS u32x2*)(L + O_ST + nx * ST_BYTES + (32 * dvb + (lane & 31)) * P_ST + (32 * dbS + 8 * g + 4 * hh) * 2) = o; } }
        }
    }
}

__device__ __forceinline__ void p_fft1(const Ctx& C) {
    PH_IDS;
    LAS unsigned char* L = C.lds;
    const int t = tid, w = wave, mb = w & 3, nh = w >> 2, hh = lane >> 5;
    const bf16* F1 = (const bf16*)(C.ws + WS_F1);
    bf16x8 af[8];
#pragma unroll
    for (int ks = 0; ks < 8; ++ks) af[ks] = *(const bf16x8*)(F1 + (32 * mb + (lane & 31)) * 128 + 16 * ks + 8 * hh);
    const bf16* ZZ = (const bf16*)(C.ws + WS_ZC);
    bf16* YR = (bf16*)(C.ws + WS_YR); bf16* YI = (bf16*)(C.ws + WS_YI);
    const int blk = (lane >> 4) & 1, q4 = (lane & 15) >> 2, p4 = lane & 3;
    constexpr int RAWB = 73728;
    u32x4 pv[4];
    auto fetch1 = [&](int unit) { const int bt = unit >> 8, b = (unit >> 1) & 127, chh = unit & 1; const int a = t >> 3, part = t & 7;
        const bf16* src = ZZ + (size_t)(bt * SEQ + 128 * a + b) * 512 + chh * 256 + part * 32;
#pragma unroll
        for (int i = 0; i < 4; ++i) pv[i] = *(const u32x4*)(src + 8 * i); };
    if ((int)blockIdx.x < 2048) fetch1(blockIdx.x);
    for (int unit = blockIdx.x; unit < 2048; unit += C.G) {
        const int bt = unit >> 8, b = (unit >> 1) & 127, chh = unit & 1;
        __syncthreads();
        { const int a = t >> 3, part = t & 7;
#pragma unroll
          for (int i = 0; i < 4; ++i) *(LAS u32x4*)(L + RAWB + a * 528 + part * 64 + i * 16) = pv[i]; }
        __syncthreads();
        { const int row = t >> 2, quarter = t & 3, pin = row >> 6, a = row & 63, gl = quarter >> 1, half = quarter & 1;
          const LAS unsigned char* rp = L + RAWB + a * 528 + gl * 256;
#pragma unroll
          for (int ci = 0; ci < 8; ++ci) { unsigned wv[4];
#pragma unroll
              for (int j = 0; j < 8; ++j) { const int e = 8 * ci + j;
                  const int col = pin ? (half ? 128 - e : 64 + e) : (half ? (e == 0 ? 64 : 64 - e) : e);
                  unsigned v = (unsigned)*(const LAS unsigned short*)(rp + (col & 127) * 2);
                  if (pin && half) v ^= 0x8000u;
                  if (pin && e == 0) v = 0u;
                  if (j & 1) wv[j >> 1] |= v << 16; else wv[j >> 1] = v; }
              *(LAS u32x4*)(L + row * 576 + quarter * 128 + ci * 16) = (u32x4){wv[0], wv[1], wv[2], wv[3]}; } }
        __syncthreads();
        if (unit + C.G < 2048) fetch1(unit + C.G);
#pragma unroll 1
        for (int nb = 0; nb < 4; ++nb) {
            const int c = 4 * nh + nb;
            f32x16 acc;
#pragma unroll
            for (int i = 0; i < 16; ++i) acc[i] = 0.f;
#pragma unroll
            for (int ks = 0; ks < 8; ++ks) {
                LAS unsigned char* pb = L + (16 * ks + 8 * hh + q4) * 576 + (32 * c + 16 * blk + 4 * p4) * 2;
                const bf16x8 bfr = gla::tr8(pb, pb + 4 * 576);
                acc = __builtin_amdgcn_mfma_f32_32x32x16_bf16(af[ks], bfr, acc, 0, 0, 0); }
#pragma unroll
            for (int gp = 0; gp < 2; ++gp)
#pragma unroll
                for (int i = 0; i < 4; ++i) { const int ap = 16 * mb + 8 * gp + 4 * hh + i; const float re = acc[8 * gp + i], im = acc[8 * gp + 4 + i];
                    const float ph = (float)((b * ap) & 8191) * (1.0f / 8192.0f); const float cs = __builtin_amdgcn_cosf(ph), sn = __builtin_amdgcn_sinf(ph);
                    const int so = ap * 528 + (32 * c + (lane & 31)) * 2;
                    *(LAS unsigned short*)(L + 73728 + so) = (unsigned short)f2bf(re * cs + im * sn);
                    *(LAS unsigned short*)(L + 73728 + 64 * 528 + so) = (unsigned short)f2bf(im * cs - re * sn); }
        }
        __syncthreads();
        { const int orow = t >> 2, quarter = t & 3, plane = orow >> 6, ap = orow & 63;
          bf16* dst = (plane ? YI : YR) + ((size_t)(bt * 64 + ap) * 128 + b) * 512 + chh * 256 + quarter * 64;
#pragma unroll
          for (int i = 0; i < 8; ++i) *(u32x4*)(dst + 8 * i) = *(const LAS u32x4*)(L + 73728 + orow * 528 + quarter * 128 + i * 16); }
    }
    __syncthreads();
}
__device__ __forceinline__ void p_fft2(const Ctx& C) {
    PH_IDS;
    LAS unsigned char* L = C.lds;
    const int t = tid, w = wave, mb = w & 3, nh = w >> 2, hh = lane >> 5;
    const bf16* F2 = (const bf16*)(C.ws + WS_F2);
    bf16x8 af[16];
#pragma unroll
    for (int ks = 0; ks < 16; ++ks) af[ks] = *(const bf16x8*)(F2 + (32 * mb + (lane & 31)) * 256 + 16 * ks + 8 * hh);
    const bf16* YR = (const bf16*)(C.ws + WS_YR); const bf16* YI = (const bf16*)(C.ws + WS_YI);
    unsigned char* A2 = (unsigned char*)(C.ws + WS_A2);
    const int blk = (lane >> 4) & 1, q4 = (lane & 15) >> 2, p4 = lane & 3;
    u32x4 pv[8];
    auto fetch2 = [&](int unit) { const int bt = unit >> 8, ap = (unit >> 2) & 63, cht = unit & 3; const int row = t >> 1, half = t & 1, pin = row >> 7, b = row & 127;
        const bf16* src = (pin ? YI : YR) + ((size_t)(bt * 64 + ap) * 128 + b) * 512 + cht * 128 + half * 64;
#pragma unroll
        for (int i = 0; i < 8; ++i) pv[i] = *(const u32x4*)(src + 8 * i); };
    if ((int)blockIdx.x < 2048) fetch2(blockIdx.x);
    for (int unit = blockIdx.x; unit < 2048; unit += C.G) {
        const int bt = unit >> 8, ap = (unit >> 2) & 63, cht = unit & 3;
        __syncthreads();
        { const int row = t >> 1, half = t & 1;
#pragma unroll
          for (int i = 0; i < 8; ++i) *(LAS u32x4*)(L + row * 320 + half * 128 + i * 16) = pv[i]; }
        __syncthreads();
        if (unit + C.G < 2048) fetch2(unit + C.G);
#pragma unroll 1
        for (int nb = 0; nb < 2; ++nb) {
            const int c = 2 * nh + nb;
            f32x16 acc;
#pragma unroll
            for (int i = 0; i < 16; ++i) acc[i] = 0.f;
#pragma unroll
            for (int ks = 0; ks < 16; ++ks) {
                LAS unsigned char* pb = L + (16 * ks + 8 * hh + q4) * 320 + (32 * c + 16 * blk + 4 * p4) * 2;
                const bf16x8 bfr = gla::tr8(pb, pb + 4 * 320);
                acc = __builtin_amdgcn_mfma_f32_32x32x16_bf16(af[ks], bfr, acc, 0, 0, 0); }
#pragma unroll
            for (int r = 0; r < 16; ++r) { const int bp = 32 * mb + (r & 3) + 8 * (r >> 2) + 4 * hh;
                if (F8_OUT0) *(LAS unsigned char*)(L + 81920 + bp * 144 + 32 * c + (lane & 31)) = (unsigned char)(pk4_fp8(acc[r], 0.f, 0.f, 0.f, 8.0f / 1024.0f) & 0xffu);
                else *(LAS unsigned short*)(L + 81920 + bp * 272 + (32 * c + (lane & 31)) * 2) = (unsigned short)f2bf(acc[r] * (1.0f / 1024.0f)); }
        }
        __syncthreads();
        { const int bp = t >> 2, quarter = t & 3; const size_t tok = (size_t)bt * SEQ + ap + 64 * bp;
          if (F8_OUT0) { unsigned char* dst = A2 + tok * 1536 + 1024 + cht * 128 + quarter * 32;
#pragma unroll
              for (int i = 0; i < 2; ++i) *(u32x4*)(dst + 16 * i) = *(const LAS u32x4*)(L + 81920 + bp * 144 + quarter * 32 + i * 16); }
          else { bf16* dst = (bf16*)A2 + tok * 1536 + 1024 + cht * 128 + quarter * 32;
#pragma unroll
              for (int i = 0; i < 4; ++i) *(u32x4*)(dst + 8 * i) = *(const LAS u32x4*)(L + 81920 + bp * 272 + quarter * 64 + i * 16); } }
    }
    __syncthreads();
}
__device__ __forceinline__ void p_gla_out(const Ctx& C) {
    PH_IDS;
    const int gw = blockIdx.x * 8 + wave, NGW = C.G * 8;
    const bf16* OF = (const bf16*)(C.ws + WS_OF); const bf16* OB = (const bf16*)(C.ws + WS_OB); const bf16* Rg = (const bf16*)(C.ws + WS_R);
    unsigned char* A2 = (unsigned char*)(C.ws + WS_A2);
    float gn[16];
#pragma unroll
    for (int i = 0; i < 16; ++i) gn[i] = C.a->in[IN_EVGNORM][16 * (lane & 15) + i];
    for (int r = gw; r < MTOK; r += NGW) {
        const u32x4 f0 = *(const u32x4*)(OF + (size_t)r * 1024 + 16 * lane), f1 = *(const u32x4*)(OF + (size_t)r * 1024 + 16 * lane + 8);
        const u32x4 b0 = *(const u32x4*)(OB + (size_t)r * 1024 + 16 * lane), b1 = *(const u32x4*)(OB + (size_t)r * 1024 + 16 * lane + 8);
        const u32x4 g0 = *(const u32x4*)(Rg + (size_t)r * 1024 + 16 * lane), g1 = *(const u32x4*)(Rg + (size_t)r * 1024 + 16 * lane + 8);
        float o[16], rr[16];
#pragma unroll
        for (int i = 0; i < 4; ++i) { const unsigned fa = f0[i], fb = f1[i], ba = b0[i], bb = b1[i], ga = g0[i], gb = g1[i];
            o[2 * i] = bf_lo(fa) + bf_lo(ba); o[2 * i + 1] = bf_hi(fa) + bf_hi(ba); o[8 + 2 * i] = bf_lo(fb) + bf_lo(bb); o[8 + 2 * i + 1] = bf_hi(fb) + bf_hi(bb);
            rr[2 * i] = bf_lo(ga); rr[2 * i + 1] = bf_hi(ga); rr[8 + 2 * i] = bf_lo(gb); rr[8 + 2 * i + 1] = bf_hi(gb); }
        float ss = 0.f;
#pragma unroll
        for (int i = 0; i < 16; ++i) ss += o[i] * o[i];
        ss = row16_sum(ss);
        const float rstd = rsqrtf(ss * (1.0f / 256.0f) + EPS);
        float y[16];
#pragma unroll
        for (int i = 0; i < 16; ++i) y[i] = o[i] * rstd * gn[i] * siluf_(rr[i]);
        if (F8_OUT0) *(u32x4*)(A2 + (size_t)r * 1536 + 16 * lane) = (u32x4){pk4_fp8(y[0], y[1], y[2], y[3], 8.f), pk4_fp8(y[4], y[5], y[6], y[7], 8.f), pk4_fp8(y[8], y[9], y[10], y[11], 8.f), pk4_fp8(y[12], y[13], y[14], y[15], 8.f)};
        else { bf16* a2 = (bf16*)A2 + (size_t)r * 1536 + 16 * lane;
            *(u32x4*)a2 = (u32x4){cvt_pk(y[0], y[1]), cvt_pk(y[2], y[3]), cvt_pk(y[4], y[5]), cvt_pk(y[6], y[7])}; *(u32x4*)(a2 + 8) = (u32x4){cvt_pk(y[8], y[9]), cvt_pk(y[10], y[11]), cvt_pk(y[12], y[13]), cvt_pk(y[14], y[15])}; }
    }
}

__device__ __forceinline__ void p_postmix(const Ctx& C, const int layer) {
    PH_IDS;
    LAS float* WR = (LAS float*)C.lds;
    LAS int* hist = (LAS int*)(C.lds + 131072);
    LAS float* Lg = (LAS float*)(C.lds + 131584 + wave * 2112);
    const float* rw = C.a->in[IN_RW] + (size_t)layer * 1024 * 32;
    __syncthreads();
    for (int it0 = 0; it0 < 64; it0 += 16) {
        float tmpw[16];
#pragma unroll
        for (int q = 0; q < 16; ++q) tmpw[q] = rw[tid + 512 * (it0 + q)];
#pragma unroll
        for (int q = 0; q < 16; ++q) { const int idx = tid + 512 * (it0 + q); const int c = idx >> 5, e = idx & 31; const int ln = (c & 255) >> 2, j = c >> 8, i = c & 3;
            WR[(((j * 4 + i) * 8 + (e >> 2)) * 64 + ln) * 4 + (e & 3)] = tmpw[q]; } }
    if (tid < 32) hist[tid] = 0;
    __syncthreads();
    const float* MOD = (const float*)(C.ws + WS_MOD) + (size_t)layer * 9 * 6144;
    const float* gpost = C.a->in[IN_NMPOST] + layer * 1024; const float* gffn = C.a->in[IN_NFPRE] + layer * 1024;
    const bf16* Y = (const bf16*)(C.ws + WS_Y);
    const float* xin = C.a->in[IN_X];
    bf16* XS = (bf16*)(C.ws + WS_XS);
    unsigned char* H2 = (unsigned char*)(C.ws + WS_H2);
    int* TK = (int*)(C.ws + WS_TOPK); float* GT = (float*)(C.ws + WS_GATE);
    const int rows_per_blk = MTOK / C.G, rows_per_wave = rows_per_blk / 8;
    const int r0 = blockIdx.x * rows_per_blk + wave * rows_per_wave;
    const int b = r0 >> 13;
    const float rbias = C.a->in[IN_RB][layer * 32 + ((lane >> 1) & 31)];
    float cA1[16], cA2[16], cB2[16];
#pragma unroll
    for (int j = 0; j < 4; ++j) { const int c = 4 * lane + 256 * j;
        const f32x4 gp = *(const f32x4*)(gpost + c), gm = *(const f32x4*)(MOD + (size_t)b * 6144 + 2048 + c);
        const f32x4 gf = *(const f32x4*)(gffn + c), sc = *(const f32x4*)(MOD + (size_t)b * 6144 + 4096 + c), sh = *(const f32x4*)(MOD + (size_t)b * 6144 + 3072 + c);
#pragma unroll
        for (int i = 0; i < 4; ++i) { cA1[4 * j + i] = gp[i] * gm[i]; cA2[4 * j + i] = gf[i] * (1.0f + sc[i]); cB2[4 * j + i] = sh[i]; } }
    auto ldx = [&](int r, int j) -> f32x4 {
        if (layer == 0) return *(const f32x4*)(xin + (size_t)r * 1024 + 4 * lane + 256 * j);
        const u32x2 v = *(const u32x2*)(XS + (size_t)r * 1024 + 4 * lane + 256 * j); return (f32x4){bf_lo(v.x), bf_hi(v.x), bf_lo(v.y), bf_hi(v.y)}; };
    u32x2 ny[4]; f32x4 nx[4];
#pragma unroll
    for (int j = 0; j < 4; ++j) { ny[j] = *(const u32x2*)(Y + (size_t)r0 * 1024 + 4 * lane + 256 * j); nx[j] = ldx(r0, j); }
    for (int r = r0; r < r0 + rows_per_wave; ++r) {
        float h[16];
        u32x2 cy[4]; f32x4 cx[4];
#pragma unroll
        for (int j = 0; j < 4; ++j) { cy[j] = ny[j]; cx[j] = nx[j]; }
        if (r + 1 < r0 + rows_per_wave) {
#pragma unroll
            for (int j = 0; j < 4; ++j) { ny[j] = *(const u32x2*)(Y + (size_t)(r + 1) * 1024 + 4 * lane + 256 * j); nx[j] = ldx(r + 1, j); } }
        { float ssy = 0.f; float yv[16];
#pragma unroll
          for (int j = 0; j < 4; ++j) { const u32x2 yy = cy[j];
              yv[4 * j] = bf_lo(yy.x); yv[4 * j + 1] = bf_hi(yy.x); yv[4 * j + 2] = bf_lo(yy.y); yv[4 * j + 3] = bf_hi(yy.y); }
#pragma unroll
          for (int i = 0; i < 16; ++i) ssy += yv[i] * yv[i];
          const float rstd = rsqrtf(wave_sum(ssy) * (1.0f / 1024.0f) + EPS);
          float ss1 = 0.f;
#pragma unroll
          for (int j = 0; j < 4; ++j) { const int c = 4 * lane + 256 * j;
              const f32x4 xv = cx[j];
              f32x4 o;
#pragma unroll
              for (int i = 0; i < 4; ++i) { o[i] = xv[i] + cA1[4 * j + i] * (yv[4 * j + i] * rstd); h[4 * j + i] = o[i]; ss1 += o[i] * o[i]; }
              { u32x2 xw; xw.x = cvt_pk(o[0], o[1]); xw.y = cvt_pk(o[2], o[3]); *(u32x2*)(XS + (size_t)r * 1024 + c) = xw; } }
          const float rstd1 = rsqrtf(wave_sum(ss1) * (1.0f / 1024.0f) + EPS);
#pragma unroll
          for (int j = 0; j < 4; ++j) { const int c = 4 * lane + 256 * j;
#pragma unroll
              for (int i = 0; i < 4; ++i) h[4 * j + i] = h[4 * j + i] * rstd1 * cA2[4 * j + i] + cB2[4 * j + i];
              int wv = 0;
              wv = __builtin_amdgcn_cvt_pk_fp8_f32(fminf(fmaxf(h[4 * j] * 8.0f, -440.f), 440.f), fminf(fmaxf(h[4 * j + 1] * 8.0f, -440.f), 440.f), wv, false);
              wv = __builtin_amdgcn_cvt_pk_fp8_f32(fminf(fmaxf(h[4 * j + 2] * 8.0f, -440.f), 440.f), fminf(fmaxf(h[4 * j + 3] * 8.0f, -440.f), 440.f), wv, true);
              *(int*)(H2 + (size_t)r * 1024 + c) = wv; } }
        float p[32];
#pragma unroll
        for (int e = 0; e < 32; ++e) p[e] = 0.f;
        { f32x4 wb[2][8];
#pragma unroll
          for (int eq = 0; eq < 8; ++eq) wb[0][eq] = *(const LAS f32x4*)(WR + ((0 * 8 + eq) * 64 + lane) * 4);
#pragma unroll
          for (int jj = 0; jj < 16; ++jj) {
              if (jj + 1 < 16) {
#pragma unroll
                  for (int eq = 0; eq < 8; ++eq) wb[(jj + 1) & 1][eq] = *(const LAS f32x4*)(WR + (((jj + 1) * 8 + eq) * 64 + lane) * 4); }
#pragma unroll
              for (int eq = 0; eq < 8; ++eq)
#pragma unroll
                  for (int i = 0; i < 4; ++i) p[4 * eq + i] += h[jj] * wb[jj & 1][eq][i];
              asm volatile("" ::: "memory"); } }
        float q16[16], q8[8], q4v[4], q2[2], q1;
#pragma unroll
        for (int k = 0; k < 16; ++k) q16[k] = swap32_sum(p[k], p[16 + k]);
#pragma unroll
        for (int k = 0; k < 8; ++k) q8[k] = swap16_sum(q16[k], q16[8 + k]);
        { const bool hi = (lane & 8) != 0;
#pragma unroll
          for (int k = 0; k < 4; ++k) { const float send = hi ? q8[k] : q8[4 + k], keep = hi ? q8[4 + k] : q8[k];
              q4v[k] = keep + __builtin_bit_cast(float, __builtin_amdgcn_update_dpp(0, __builtin_bit_cast(int, send), 0x128, 0xF, 0xF, true)); } }
        { const bool hi = (lane & 4) != 0;
#pragma unroll
          for (int k = 0; k < 2; ++k) { const float send = hi ? q4v[k] : q4v[2 + k], keep = hi ? q4v[2 + k] : q4v[k];
              int rv = __builtin_amdgcn_update_dpp(0, __builtin_bit_cast(int, send), 0x104, 0xF, 0x5, false);
              rv = __builtin_amdgcn_update_dpp(rv, __builtin_bit_cast(int, send), 0x114, 0xF, 0xA, false);
              q2[k] = keep + __builtin_bit_cast(float, rv); } }
        { const bool hi = (lane & 2) != 0; const float send = hi ? q2[0] : q2[1], keep = hi ? q2[1] : q2[0];
          q1 = keep + __builtin_bit_cast(float, __builtin_amdgcn_update_dpp(0, __builtin_bit_cast(int, send), 0x4E, 0xF, 0xF, true)); }
        q1 += __builtin_bit_cast(float, __builtin_amdgcn_update_dpp(0, __builtin_bit_cast(int, q1), 0xB1, 0xF, 0xF, true));
        const int rl = (r - r0) & 15;
        if (!(lane & 1)) Lg[rl * 33 + (lane >> 1)] = q1 + rbias;
        if (rl == 15) {
            asm volatile("s_waitcnt lgkmcnt(0)" ::: "memory");
            if (lane < 16) {
                float v0 = -3.0e38f, v1 = -3.0e38f, v2 = -3.0e38f, v3 = -3.0e38f; int i0 = 0, i1 = 0, i2 = 0, i3 = 0;
#pragma unroll
                for (int e = 0; e < 32; ++e) { const float x = Lg[lane * 33 + e];
                    const bool c0 = x > v0, c1 = x > v1, c2 = x > v2, c3 = x > v3;
                    v3 = c3 ? (c2 ? v2 : x) : v3; i3 = c3 ? (c2 ? i2 : e) : i3;
                    v2 = c2 ? (c1 ? v1 : x) : v2; i2 = c2 ? (c1 ? i1 : e) : i2;
                    v1 = c1 ? (c0 ? v0 : x) : v1; i1 = c1 ? (c0 ? i0 : e) : i1;
                    v0 = c0 ? x : v0; i0 = c0 ? e : i0; }
                const float e1 = __expf(v1 - v0), e2 = __expf(v2 - v0), e3 = __expf(v3 - v0); const float inv = 1.0f / (1.0f + e1 + e2 + e3);
                const int rr = r - 15 + lane;
                *(int4*)(TK + (size_t)rr * 4) = make_int4(i0, i1, i2, i3); *(f32x4*)(GT + (size_t)rr * 4) = (f32x4){inv, e1 * inv, e2 * inv, e3 * inv};
                __hip_atomic_fetch_add(&hist[i0], 1, __ATOMIC_RELAXED, __HIP_MEMORY_SCOPE_WORKGROUP); __hip_atomic_fetch_add(&hist[i1], 1, __ATOMIC_RELAXED, __HIP_MEMORY_SCOPE_WORKGROUP);
                __hip_atomic_fetch_add(&hist[i2], 1, __ATOMIC_RELAXED, __HIP_MEMORY_SCOPE_WORKGROUP); __hip_atomic_fetch_add(&hist[i3], 1, __ATOMIC_RELAXED, __HIP_MEMORY_SCOPE_WORKGROUP);
            }
            asm volatile("s_waitcnt lgkmcnt(0)" ::: "memory");
        }
    }
    __syncthreads();
    if (tid < 32) ((int*)(C.ws + WS_CNTBLK))[blockIdx.x * 32 + tid] = hist[tid];
    __syncthreads();
}
__device__ __forceinline__ void p_assign(const Ctx& C) {
    PH_IDS;
    LAS int* red = (LAS int*)C.lds;
    LAS int* base = (LAS int*)(C.lds + 4096);
    LAS int* total = (LAS int*)(C.lds + 4224);
    LAS int* segrow = (LAS int*)(C.lds + 4352);
    LAS int* run = (LAS int*)(C.lds + 4608);
    const int* cnt = (const int*)(C.ws + WS_CNTBLK);
    const int b = blockIdx.x;
    __syncthreads();
    { const int e = tid & 31, part = tid >> 5; int slt = 0, sall = 0;
      int vv[16];
#pragma unroll
      for (int q = 0; q < 16; ++q) vv[q] = __hip_atomic_load(cnt + (part * 16 + q) * 32 + e, __ATOMIC_RELAXED, __HIP_MEMORY_SCOPE_AGENT);
#pragma unroll
      for (int q = 0; q < 16; ++q) { sall += vv[q]; if (part * 16 + q < b) slt += vv[q]; }
      red[part * 32 + e] = slt; red[512 + part * 32 + e] = sall; }
    __syncthreads();
    if (tid < 32) { int s0 = 0, s1 = 0;
#pragma unroll
        for (int q = 0; q < 16; ++q) { s0 += red[q * 32 + tid]; s1 += red[512 + q * 32 + tid]; }
        base[tid] = s0; total[tid] = s1; run[tid] = 0; }
    __syncthreads();
    if (tid == 0) { int acc = 0; for (int e = 0; e < 32; ++e) { segrow[e] = acc * 256; if (b == 0) ((int*)(C.ws + WS_MOEINFO))[e] = acc; acc += (total[e] + 255) >> 8; } segrow[32] = acc * 256; if (b == 0) ((int*)(C.ws + WS_MOEINFO))[32] = acc; }
    __syncthreads();
    int* SP = (int*)(C.ws + WS_SLOTPOS); int* ST = (int*)(C.ws + WS_SLOTTOK); int* SD = (int*)(C.ws + WS_SLOTDST); const int* TK = (const int*)(C.ws + WS_TOPK);
    const int rows_per_blk = MTOK / C.G;
    LAS int* gc = (LAS int*)(C.lds + 5120);
    int ge[2], grk[2], grow[2];
#pragma unroll
    for (int q = 0; q < 2; ++q) {
        const int g = 2 * wave + q, sidx = g * 64 + lane; grow[q] = b * rows_per_blk + (sidx >> 2);
        ge[q] = TK[(size_t)grow[q] * 4 + (sidx & 3)];
        int rk = 0, myc = 0;
        for (int ee = 0; ee < 32; ++ee) { const unsigned long long m = __ballot(ge[q] == ee);
            if (ge[q] == ee) rk = __popcll(m & ((1ull << lane) - 1ull));
            if (lane == ee) myc = __popcll(m); }
        grk[q] = rk;
        if (lane < 32) gc[g * 32 + lane] = myc;
    }
    __syncthreads();
#pragma unroll
    for (int q = 0; q < 2; ++q) {
        const int g = 2 * wave + q, sidx = g * 64 + lane; int off = 0;
        for (int gp = 0; gp < g; ++gp) off += gc[gp * 32 + ge[q]];
        const int pos = segrow[ge[q]] + base[ge[q]] + off + grk[q];
        SP[(size_t)grow[q] * 4 + (sidx & 3)] = pos; ST[pos] = grow[q]; SD[pos] = grow[q] * 4 + (sidx & 3);
    }
    if (b < 32) { const int e = b, tot = total[e], first = segrow[e] + tot, last = segrow[e + 1];
        for (int p = first + tid; p < last; p += 512) { ST[p] = 0; SD[p] = MTOK * 4 + (p & 255); } }
    __syncthreads();
}

__device__ __forceinline__ void p_combine(const Ctx& C, const int layer) {
    PH_IDS;
    const int gw = blockIdx.x * 8 + wave, NGW = C.G * 8;
    const int per = MTOK / NGW;
    const float* MOD = (const float*)(C.ws + WS_MOD) + (size_t)layer * 9 * 6144;
    const float* MODN = (const float*)(C.ws + WS_MOD) + (size_t)9 * 6144;
    const float* gpost = C.a->in[IN_NFPOST] + layer * 1024; const float* gpre1 = C.a->in[IN_NMPRE] + 1024;
    const unsigned char* YS = (const unsigned char*)(C.ws + WS_YSLOT); const int* SP = (const int*)(C.ws + WS_SLOTPOS); const float* GT = (const float*)(C.ws + WS_GATE);
    float* OUT = C.a->out; bf16* XS = (bf16*)(C.ws + WS_XS); unsigned char* HN = (unsigned char*)(C.ws + WS_HN);
    int curb = -1; float cA1[16], cA2[16], cB2[16]; const int vz = vzero();
    const int rbeg = gw * per, rend = gw * per + per;
    int4 npos = *(const int4*)(SP + (size_t)(rbeg + vz) * 4); f32x4 ngt = *(const f32x4*)(GT + (size_t)(rbeg + vz) * 4);
    unsigned nys[4][4]; u32x2 nxv[4]; f32x4 cgt = ngt;
    { const int pp[4] = {npos.x, npos.y, npos.z, npos.w};
#pragma unroll
      for (int k = 0; k < 4; ++k)
#pragma unroll
          for (int j = 0; j < 4; ++j) nys[k][j] = *(const unsigned*)(YS + (size_t)pp[k] * 1024 + 4 * lane + 256 * j);
#pragma unroll
      for (int j = 0; j < 4; ++j) nxv[j] = *(const u32x2*)(XS + (size_t)rbeg * 1024 + 4 * lane + 256 * j); }
    if (rbeg + 1 < rend) { npos = *(const int4*)(SP + (size_t)(rbeg + 1 + vz) * 4); ngt = *(const f32x4*)(GT + (size_t)(rbeg + 1 + vz) * 4); }
    for (int r = rbeg; r < rend; ++r) {
        const int b = r >> 13;
        if (b != curb) { curb = b;
#pragma unroll
            for (int j = 0; j < 4; ++j) { const int c = 4 * lane + 256 * j;
                const f32x4 gp = *(const f32x4*)(gpost + c), gf = *(const f32x4*)(MOD + (size_t)b * 6144 + 5120 + c);
                const f32x4 gg = *(const f32x4*)(gpre1 + c), sc = *(const f32x4*)(MODN + (size_t)b * 6144 + 1024 + c), sh = *(const f32x4*)(MODN + (size_t)b * 6144 + c);
#pragma unroll
                for (int i = 0; i < 4; ++i) { cA1[4 * j + i] = gp[i] * gf[i]; cA2[4 * j + i] = gg[i] * (1.0f + sc[i]); cB2[4 * j + i] = sh[i]; } } }
        unsigned ys[4][4]; u32x2 xc[4]; const f32x4 gt = cgt;
#pragma unroll
        for (int k = 0; k < 4; ++k)
#pragma unroll
            for (int j = 0; j < 4; ++j) ys[k][j] = nys[k][j];
#pragma unroll
        for (int j = 0; j < 4; ++j) xc[j] = nxv[j];
        if (r + 1 < rend) {
            const int pp[4] = {npos.x, npos.y, npos.z, npos.w}; cgt = ngt;
#pragma unroll
            for (int k = 0; k < 4; ++k)
#pragma unroll
                for (int j = 0; j < 4; ++j) nys[k][j] = *(const unsigned*)(YS + (size_t)pp[k] * 1024 + 4 * lane + 256 * j);
#pragma unroll
            for (int j = 0; j < 4; ++j) nxv[j] = *(const u32x2*)(XS + (size_t)(r + 1) * 1024 + 4 * lane + 256 * j);
            if (r + 2 < rend) { npos = *(const int4*)(SP + (size_t)(r + 2 + vz) * 4); ngt = *(const f32x4*)(GT + (size_t)(r + 2 + vz) * 4); } }
        float f[16];
#pragma unroll
        for (int i = 0; i < 16; ++i) f[i] = 0.f;
#pragma unroll
        for (int k = 0; k < 4; ++k) { const float gk = gt[k] * 0.0625f;
#pragma unroll
            for (int j = 0; j < 4; ++j) { const f32v2_t lo = __builtin_amdgcn_cvt_pk_f32_fp8((int)ys[k][j], false), hi = __builtin_amdgcn_cvt_pk_f32_fp8((int)ys[k][j], true);
                f[4 * j] += gk * lo[0]; f[4 * j + 1] += gk * lo[1]; f[4 * j + 2] += gk * hi[0]; f[4 * j + 3] += gk * hi[1]; } }
        float ss = 0.f;
#pragma unroll
        for (int i = 0; i < 16; ++i) ss += f[i] * f[i];
        const float rstd = rsqrtf(wave_sum(ss) * (1.0f / 1024.0f) + EPS);
        float x2[16]; float ss2 = 0.f;
#pragma unroll
        for (int j = 0; j < 4; ++j) { const int c = 4 * lane + 256 * j;
            const f32x4 xv = (f32x4){bf_lo(xc[j].x), bf_hi(xc[j].x), bf_lo(xc[j].y), bf_hi(xc[j].y)};
            f32x4 o;
#pragma unroll
            for (int i = 0; i < 4; ++i) { o[i] = xv[i] + cA1[4 * j + i] * (f[4 * j + i] * rstd); x2[4 * j + i] = o[i]; ss2 += o[i] * o[i]; }
            if (layer == 0) { u32x2 xw; xw.x = cvt_pk(o[0], o[1]); xw.y = cvt_pk(o[2], o[3]); *(u32x2*)(XS + (size_t)r * 1024 + c) = xw; }
            else *(f32x4*)(OUT + (size_t)r * 1024 + c) = o; }
        if (layer == 0) {
            const float rstd2 = rsqrtf(wave_sum(ss2) * (1.0f / 1024.0f) + EPS);
#pragma unroll
            for (int j = 0; j < 4; ++j) { const int c = 4 * lane + 256 * j;
                float hv[4];
#pragma unroll
                for (int i = 0; i < 4; ++i) hv[i] = x2[4 * j + i] * rstd2 * cA2[4 * j + i] + cB2[4 * j + i];
                if (F8_IN1) *(unsigned*)(HN + (size_t)r * 1024 + c) = pk4_fp8(hv[0], hv[1], hv[2], hv[3], 8.f);
                else *(u32x2*)((bf16*)HN + (size_t)r * 1024 + c) = (u32x2){cvt_pk(hv[0], hv[1]), cvt_pk(hv[2], hv[3])}; }
        }
    }
}

__device__ __forceinline__ void p_conv(const Ctx& C) {
    PH_IDS;
    LAS unsigned char* L = C.lds;
    constexpr int O_X = 0;
    constexpr int O_W = 63488;
    const int w = wave;
    const bf16* GLU = (const bf16*)(C.ws + WS_GLU); const bf16* ZC1 = (const bf16*)(C.ws + WS_ZC1); const bf16* GB = (const bf16*)(C.ws + WS_GB);
    unsigned char* A2 = (unsigned char*)(C.ws + WS_A2B);
    __syncthreads();
    { float tmpw[31];
#pragma unroll
      for (int q = 0; q < 31; ++q) tmpw[q] = C.a->in[IN_ODDW][tid + 512 * q];
#pragma unroll
      for (int q = 0; q < 31; ++q) { const int i = tid + 512 * q; const int tap = i >> 9, c = i & 511; const int ln = c >> 3, half = (c >> 2) & 1, qq = c & 3;
          *(LAS float*)(L + O_W + (((tap * 2 + half) * 64 + ln) * 4 + qq) * 4) = tmpw[q]; } }
    float cb[8], lg[8], lb[8], sw0[8], sw1[8], sw2[8];
#pragma unroll
    for (int i = 0; i < 8; ++i) { const int c = 8 * lane + i; cb[i] = C.a->in[IN_ODDWB][c]; lg[i] = C.a->in[IN_ODLNG][c]; lb[i] = C.a->in[IN_ODLNB][c];
        sw0[i] = C.a->in[IN_ODSCONV][c]; sw1[i] = C.a->in[IN_ODSCONV][512 + c]; sw2[i] = C.a->in[IN_ODSCONV][1024 + c]; }
    u32x4 px[8];
    auto fetchx = [&](int unit) { const int bt = unit >> 8, t0 = (unit & 255) * 32;
#pragma unroll
        for (int q = 0; q < 8; ++q) { const int i = tid + 512 * q; const int rr = i >> 6, cc = i & 63; const int tl = t0 - 15 + rr;
            px[q] = (u32x4){0u, 0u, 0u, 0u};
            if (i < 62 * 64 && tl >= 0 && tl < SEQ) px[q] = *(const u32x4*)(GLU + (size_t)(bt * SEQ + tl) * 512 + cc * 8); } };
    if ((int)blockIdx.x < 2048) fetchx(blockIdx.x);
    for (int unit = blockIdx.x; unit < 2048; unit += C.G) {
        const int bt = unit >> 8, t0 = (unit & 255) * 32;
        __syncthreads();
#pragma unroll
        for (int q = 0; q < 8; ++q) { const int i = tid + 512 * q; if (i < 62 * 64) *(LAS u32x4*)(L + O_X + (i >> 6) * 1024 + (i & 63) * 16) = px[q]; }
        __syncthreads();
        if (unit + C.G < 2048) fetchx(unit + C.G);
        float acc[4][8];
#pragma unroll
        for (int o = 0; o < 4; ++o)
#pragma unroll
            for (int i = 0; i < 8; ++i) acc[o][i] = 0.f;
#pragma unroll 4
        for (int tap = 0; tap < 31; ++tap) {
            const f32x4 w0 = *(const LAS f32x4*)(L + O_W + ((tap * 2 + 0) * 64 + lane) * 16), w1 = *(const LAS f32x4*)(L + O_W + ((tap * 2 + 1) * 64 + lane) * 16);
#pragma unroll
            for (int o = 0; o < 4; ++o) {
                const u32x4 xr = *(const LAS u32x4*)(L + O_X + (4 * w + o + tap) * 1024 + lane * 16);
                acc[o][0] += bf_lo(xr[0]) * w0[0]; acc[o][1] += bf_hi(xr[0]) * w0[1]; acc[o][2] += bf_lo(xr[1]) * w0[2]; acc[o][3] += bf_hi(xr[1]) * w0[3];
                acc[o][4] += bf_lo(xr[2]) * w1[0]; acc[o][5] += bf_hi(xr[2]) * w1[1]; acc[o][6] += bf_lo(xr[3]) * w1[2]; acc[o][7] += bf_hi(xr[3]) * w1[3]; }
        }
        u32x4 sz0[4], sz1[4], sz2[4], sgb[4];
#pragma unroll
        for (int o = 0; o < 4; ++o) { const int tl = t0 + 4 * w + o; const size_t tok = (size_t)bt * SEQ + tl;
            sz1[o] = *(const u32x4*)(ZC1 + tok * 512 + 8 * lane); sz0[o] = (u32x4){0u, 0u, 0u, 0u}; sz2[o] = (u32x4){0u, 0u, 0u, 0u};
            if (tl >= 64) sz0[o] = *(const u32x4*)(ZC1 + (tok - 64) * 512 + 8 * lane);
            if (tl + 64 < SEQ) sz2[o] = *(const u32x4*)(ZC1 + (tok + 64) * 512 + 8 * lane);
            sgb[o] = *(const u32x4*)(GB + tok * 512 + 8 * lane); }
#pragma unroll
        for (int o = 0; o < 4; ++o) {
            const int tl = t0 + 4 * w + o; const size_t tok = (size_t)bt * SEQ + tl;
            float v[8]; float s = 0.f;
#pragma unroll
            for (int i = 0; i < 8; ++i) { v[i] = acc[o][i] + cb[i]; s += v[i]; }
            const float mu = wave_sum(s) * (1.0f / 512.0f); float q = 0.f;
#pragma unroll
            for (int i = 0; i < 8; ++i) { v[i] -= mu; q += v[i] * v[i]; }
            const float rstd = rsqrtf(wave_sum(q) * (1.0f / 512.0f) + EPS);
            float y[8];
#pragma unroll
            for (int i = 0; i < 8; ++i) y[i] = siluf_(v[i] * rstd * lg[i] + lb[i]);
            if (F8_OUT1) *(u32x2*)(A2 + tok * 1024 + 8 * lane) = (u32x2){pk4_fp8(y[0], y[1], y[2], y[3], 4.f), pk4_fp8(y[4], y[5], y[6], y[7], 4.f)};
            else *(u32x4*)((bf16*)A2 + tok * 1024 + 8 * lane) = (u32x4){cvt_pk(y[0], y[1]), cvt_pk(y[2], y[3]), cvt_pk(y[4], y[5]), cvt_pk(y[6], y[7])};
            const u32x4 z1 = sz1[o], z0 = sz0[o], z2 = sz2[o], gb = sgb[o];
            float zz[8];
#pragma unroll
            for (int i = 0; i < 4; ++i) {
                zz[2 * i] = (sw0[2 * i] * bf_lo(z0[i]) + sw1[2 * i] * bf_lo(z1[i]) + sw2[2 * i] * bf_lo(z2[i])) * bf_lo(gb[i]);
                zz[2 * i + 1] = (sw0[2 * i + 1] * bf_hi(z0[i]) + sw1[2 * i + 1] * bf_hi(z1[i]) + sw2[2 * i + 1] * bf_hi(z2[i])) * bf_hi(gb[i]); }
            if (F8_OUT1) *(u32x2*)(A2 + tok * 1024 + 512 + 8 * lane) = (u32x2){pk4_fp8(zz[0], zz[1], zz[2], zz[3], 4.f), pk4_fp8(zz[4], zz[5], zz[6], zz[7], 4.f)};
            else *(u32x4*)((bf16*)A2 + tok * 1024 + 512 + 8 * lane) = (u32x4){cvt_pk(zz[0], zz[1]), cvt_pk(zz[2], zz[3]), cvt_pk(zz[4], zz[5]), cvt_pk(zz[6], zz[7])};
        }
    }
    __syncthreads();
}

constexpr int NPHASE = 19;
#ifndef RUN_HI
#define RUN_HI NPHASE
#endif
__global__ void __launch_bounds__(512, 2) fwd_kernel(Args args) {
    extern __shared__ __attribute__((aligned(16))) unsigned char lds_raw[];
    Ctx C; C.lds = (LAS unsigned char*)lds_raw;
    C.G = gridDim.x; C.a = &args; C.ws = args.ws;
    volatile LAS unsigned* MISC = (volatile LAS unsigned*)(C.lds + MISC_OFF);
    if (threadIdx.x < 16) MISC[threadIdx.x] = 0u;
    __syncthreads();
    const int lo = args.ph_lo, hi = args.ph_hi;
    const bool multi = (hi - lo) > 1;
    XcdBarrier bar; bar.bar = (unsigned*)(C.ws + WS_CTL) + 4096; bar.x = 0; bar.st = MISC;
    if (multi) bar = xcd_barrier_post((unsigned*)(C.ws + WS_CTL) + 4096, MISC);
#ifndef PH_MASK
#define PH_MASK 0x7FFFF
#endif
#define IN(k) (((PH_MASK >> (k)) & 1) && lo <= (k) && (k) < hi)
#ifndef DUP_MASK
#define DUP_MASK 0
#endif
#ifndef GLA_PROBE
#define GLA_PROBE 0
#endif
#ifndef PROBE_NOEPI
#define PROBE_NOEPI 0
#endif
#ifndef GP_AMP
#define GP_AMP 4
#endif
#define DUPN(k) (((DUP_MASK >> (k)) & 1) ? 2 : 1)
#define SEAM(k) do { if (IN(k) && IN((k) + 1)) xcd_barrier(bar); } while (0)
    LAS unsigned char* ring = C.lds;
    const int cid = blockIdx.x;

    if (IN(0)) for (int rep_ = 0; rep_ < DUPN(0); ++rep_) { p0_adaln(C); p0_fourier_fold(C); p0_convert(C); } SEAM(0);
    if (IN(1)) for (int rep_ = 0; rep_ < DUPN(1); ++rep_) { p_norm0(C); } SEAM(1);
    if (IN(2)) for (int rep_ = 0; rep_ < DUPN(2); ++rep_) { gm::SchedIn0 S{(const char*)(C.ws + WS_HN), (const char*)(C.ws + WS_WIN0), C.G, cid}; gm::EpiIn0 E{C.ws}; gm::gemm_phase<F8_IN0 != 0>(ring, F8_IN0 ? 1024 : 2048, S, E, 0x7C7C7C7C, 0x7A7A7A7A, 2, (unsigned long long*)(C.ws + WS_CTL + 32768)); } SEAM(2);
    if (IN(3)) for (int rep_ = 0; rep_ < DUPN(3); ++rep_) { p_gla_prep(C); if (GLA_PROBE == 1) p_gla_prep(C); if (GLA_PROBE >= 10) p_gla_prep(C, GLA_PROBE - 10); p_fft1(C); if (GLA_PROBE == 2) p_fft1(C); xcd_barrier(bar); p_gla(C); if (GLA_PROBE == 3) p_gla(C); if (GLA_PROBE == 4) p_gla(C, 1); } SEAM(3);
    if (IN(4)) for (int rep_ = 0; rep_ < DUPN(4); ++rep_) { p_fft2(C); p_gla_out(C); } SEAM(4);
    if (IN(5)) for (int rep_ = 0; rep_ < DUPN(5); ++rep_) { gm::SchedDense S{(const char*)(C.ws + WS_A2), (const char*)(C.ws + WS_WOUT0), F8_OUT0 ? 1536 : 3072, 256, 4, C.G, cid}; gm::EpiPlain E{(bf16*)(C.ws + WS_Y), 1024}; gm::gemm_phase<F8_OUT0 != 0>(ring, F8_OUT0 ? 1536 : 3072, S, E, 0x7C7C7C7C, 0x7A7A7A7A, 5, (unsigned long long*)(C.ws + WS_CTL + 32768)); } SEAM(5);
    if (IN(6)) for (int rep_ = 0; rep_ < DUPN(6); ++rep_) { p_postmix(C, 0); } SEAM(6);
    if (IN(7)) { p_assign(C); } SEAM(7);
    if (IN(8)) for (int rep_ = 0; rep_ < DUPN(8); ++rep_) { const int* tsp = (const int*)(C.ws + WS_MOEINFO); const int ln_ = otid() & 63; const int ts = __hip_atomic_load(tsp + (ln_ < 32 ? ln_ : 32), __ATOMIC_RELAXED, __HIP_MEMORY_SCOPE_AGENT);
        gm::SchedMoE S{(const char*)(C.ws + WS_H2), (const char*)(C.ws + WS_WGU), (const int*)(C.ws + WS_SLOTTOK), ts, __builtin_amdgcn_readlane(ts, 32), 8, C.G, cid, (size_t)2048 * 1024, true, args.in[IN_BGU], nullptr};
        gm::EpiGU E{(unsigned char*)(C.ws + WS_ACT), args.in[IN_BGU], PROBE_NOEPI ? rep_ : 0}; gm::gemm_phase<true>(ring, 1024, S, E, 0x7C7C7C7C, 0x7A7A7A7A, 8, (unsigned long long*)(C.ws + WS_CTL + 32768)); } SEAM(8);
    if (IN(9)) for (int rep_ = 0; rep_ < DUPN(9); ++rep_) { const int* tsp = (const int*)(C.ws + WS_MOEINFO); const int ln_ = otid() & 63; const int ts = __hip_atomic_load(tsp + (ln_ < 32 ? ln_ : 32), __ATOMIC_RELAXED, __HIP_MEMORY_SCOPE_AGENT);
        gm::SchedMoE S{(const char*)(C.ws + WS_ACT), (const char*)(C.ws + WS_WD), nullptr, ts, __builtin_amdgcn_readlane(ts, 32), 4, C.G, cid, (size_t)1024 * 1024, false, args.in[IN_BD], nullptr};
        gm::EpiDown E{(unsigned char*)(C.ws + WS_YSLOT), args.in[IN_BD]}; gm::gemm_phase<true>(ring, 1024, S, E, 0x7D7D7D7D, 0x7A7A7A7A, 9, (unsigned long long*)(C.ws + WS_CTL + 32768)); } SEAM(9);
    if (IN(10)) { p_combine(C, 0); } SEAM(10);
    if (IN(11)) for (int rep_ = 0; rep_ < DUPN(11); ++rep_) { gm::SchedDense S{(const char*)(C.ws + WS_HN), (const char*)(C.ws + WS_WIN1), F8_IN1 ? 1024 : 2048, 256, 10, C.G, cid}; gm::EpiIn1 E{C.ws}; gm::gemm_phase<F8_IN1 != 0>(ring, F8_IN1 ? 1024 : 2048, S, E, 0x7C7C7C7C, 0x7A7A7A7A, 11, (unsigned long long*)(C.ws + WS_CTL + 32768)); } SEAM(11);
    if (IN(12)) for (int rep_ = 0; rep_ < DUPN(12); ++rep_) { p_conv(C); } SEAM(12);
    if (IN(13)) for (int rep_ = 0; rep_ < DUPN(13); ++rep_) { gm::SchedDense S{(const char*)(C.ws + WS_A2B), (const char*)(C.ws + WS_WOUT1), F8_OUT1 ? 1024 : 2048, 256, 4, C.G, cid}; gm::EpiPlain E{(bf16*)(C.ws + WS_Y), 1024}; gm::gemm_phase<F8_OUT1 != 0>(ring, F8_OUT1 ? 1024 : 2048, S, E, 0x7D7D7D7D, 0x7A7A7A7A, 13, (unsigned long long*)(C.ws + WS_CTL + 32768)); } SEAM(13);
    if (IN(14)) { p_postmix(C, 1); } SEAM(14);
    if (IN(15)) { p_assign(C); } SEAM(15);
    if (IN(16)) for (int rep_ = 0; rep_ < DUPN(16); ++rep_) { const int* tsp = (const int*)(C.ws + WS_MOEINFO); const int ln_ = otid() & 63; const int ts = __hip_atomic_load(tsp + (ln_ < 32 ? ln_ : 32), __ATOMIC_RELAXED, __HIP_MEMORY_SCOPE_AGENT);
        gm::SchedMoE S{(const char*)(C.ws + WS_H2), (const char*)(C.ws + WS_WGU) + (size_t)32 * 2048 * 1024, (const int*)(C.ws + WS_SLOTTOK), ts, __builtin_amdgcn_readlane(ts, 32), 8, C.G, cid, (size_t)2048 * 1024, true, args.in[IN_BGU] + 32 * 2048, nullptr};
        gm::EpiGU E{(unsigned char*)(C.ws + WS_ACT), args.in[IN_BGU] + 32 * 2048, 0}; gm::gemm_phase<true>(ring, 1024, S, E, 0x7C7C7C7C, 0x7A7A7A7A, 16, (unsigned long long*)(C.ws + WS_CTL + 32768)); } SEAM(16);
    if (IN(17)) for (int rep_ = 0; rep_ < DUPN(17); ++rep_) { const int* tsp = (const int*)(C.ws + WS_MOEINFO); const int ln_ = otid() & 63; const int ts = __hip_atomic_load(tsp + (ln_ < 32 ? ln_ : 32), __ATOMIC_RELAXED, __HIP_MEMORY_SCOPE_AGENT);
        gm::SchedMoE S{(const char*)(C.ws + WS_ACT), (const char*)(C.ws + WS_WD) + (size_t)32 * 1024 * 1024, nullptr, ts, __builtin_amdgcn_readlane(ts, 32), 4, C.G, cid, (size_t)1024 * 1024, false, args.in[IN_BD] + 32 * 1024, nullptr};
        gm::EpiDown E{(unsigned char*)(C.ws + WS_YSLOT), args.in[IN_BD] + 32 * 1024}; gm::gemm_phase<true>(ring, 1024, S, E, 0x7D7D7D7D, 0x7A7A7A7A, 17, (unsigned long long*)(C.ws + WS_CTL + 32768)); } SEAM(17);
    if (IN(18)) { p_combine(C, 1); }
#if GP_PROBE
    if (blockIdx.x == 0 && threadIdx.x == 0) { const unsigned long long v = *(volatile unsigned long long*)(C.ws + WS_CTL + 32768) * GP_AMP; const unsigned long long t0 = wall_clock64();
        while (wall_clock64() - t0 < v) __builtin_amdgcn_s_sleep(16); }
#endif
#ifdef DBG_COPY_OFF
    if (lo == 99) { const bf16* src = (const bf16*)(C.ws + (size_t)DBG_COPY_OFF); float* dst = args.out;
        for (size_t i = (size_t)blockIdx.x * 512 + threadIdx.x; i < (size_t)MTOK * 1024; i += (size_t)gridDim.x * 512) dst[i] = bf_lo((unsigned)src[i]); }
#endif
#undef IN
#undef SEAM
}

extern "C" void kernel_launch(void* const* d_in, const int* in_sizes, int n_in, void* d_out, int out_size, void* d_ws, size_t ws_size, hipStream_t stream) {
    static int grid = 0;
    if (grid == 0) {
        if (n_in != 28 || out_size != MTOK * D || ws_size < WS_END) { fprintf(stderr, "kernel_launch: unexpected problem (n_in %d out %d ws %zu need %zu)\n", n_in, out_size, ws_size, (size_t)WS_END); grid = -1; return; }
        int dev = 0, cus = 0, per_cu = 0;
        (void)hipGetDevice(&dev); (void)hipDeviceGetAttribute(&cus, hipDeviceAttributeMultiprocessorCount, dev);
        if (hipFuncSetAttribute((const void*)fwd_kernel, hipFuncAttributeMaxDynamicSharedMemorySize, LDS_BYTES) != hipSuccess) { fprintf(stderr, "kernel_launch: hipFuncSetAttribute failed\n"); grid = -1; return; }
        (void)hipOccupancyMaxActiveBlocksPerMultiprocessor(&per_cu, (const void*)fwd_kernel, 512, LDS_BYTES);
        (void)hipGetLastError();
        grid = cus;
        if (grid != 256 || per_cu < 1) { fprintf(stderr, "kernel_launch: needs a 256-CU device with one resident workgroup per CU (cus %d, per_cu %d)\n", cus, per_cu); grid = -1; return; }
    }
    if (grid < 0) return;
    (void)hipMemsetAsync((char*)d_ws + WS_CTL, 0, CTL_ZERO_BYTES, stream);
    Args a{};
    for (int i = 0; i < 28; ++i) a.in[i] = (const float*)d_in[i];
    a.out = (float*)d_out; a.ws = (unsigned char*)d_ws;
#if N_LAUNCH_MODE == 1
    a.ph_lo = 0; a.ph_hi = NPHASE;
    hipLaunchKernelGGL(fwd_kernel, dim3(grid), dim3(512), LDS_BYTES, stream, a);
#else
    for (int p = 0; p < RUN_HI; ++p) { a.ph_lo = p; a.ph_hi = p + 1; hipLaunchKernelGGL(fwd_kernel, dim3(grid), dim3(512), LDS_BYTES, stream, a); }
#ifdef DBG_COPY_OFF
    a.ph_lo = 99; a.ph_hi = 100; hipLaunchKernelGGL(fwd_kernel, dim3(grid), dim3(512), LDS_BYTES, stream, a);
#endif
#endif
}
```

```cpp
#include <hip/hip_runtime.h>
#include <cstdio>
#include <cstdint>

#ifndef N_LAUNCH_MODE
#define N_LAUNCH_MODE 1
#endif

#ifndef F8_IN0
#define F8_IN0 0
#endif
#ifndef F8_OUT0
#define F8_OUT0 1
#endif
#ifndef F8_IN1
#define F8_IN1 1
#endif
#ifndef F8_OUT1
#define F8_OUT1 1
#endif
#define LAS __attribute__((address_space(3)))
typedef unsigned short bf16;
typedef short bf16x8 __attribute__((ext_vector_type(8)));
typedef short s16x4 __attribute__((ext_vector_type(4)));
typedef float f32x4 __attribute__((ext_vector_type(4)));
typedef float f32x16 __attribute__((ext_vector_type(16)));
typedef unsigned u32x4 __attribute__((ext_vector_type(4)));
typedef unsigned u32x2 __attribute__((ext_vector_type(2)));

constexpr int D = 1024, NB = 8, SEQ = 8192, CTXL = 256;
constexpr int MTOK = NB * SEQ;
constexpr int MCTX = NB * CTXL;
constexpr int MALL = MTOK + MCTX;
constexpr int NE = 32, TOPK = 4;
constexpr int NSLOT_PAD = MTOK * TOPK + NE * 256;
constexpr int N_IN0 = 3840;
constexpr int N_IN1 = 2560;
constexpr float EPS = 1e-6f;

constexpr size_t MiB = 1u << 20;
constexpr size_t WS_CTL = 0, CTL_ZERO_BYTES = 65536;
constexpr size_t WS_MOD = 1 * MiB;
constexpr size_t WS_F1 = 2 * MiB;
constexpr size_t WS_F2 = 2 * MiB + 65536;
constexpr size_t WS_CNTBLK = 3 * MiB;
constexpr size_t WS_MOEINFO = 3 * MiB + 65536;
constexpr size_t WS_TOPK = 4 * MiB;
constexpr size_t WS_GATE = 5 * MiB;
constexpr size_t WS_SLOTPOS = 6 * MiB;
constexpr size_t WS_SLOTTOK = 7 * MiB;
constexpr size_t WS_SLOTDST = 8 * MiB + 512 * 1024;
constexpr size_t WS_WIN0 = 10 * MiB;
constexpr size_t WS_WOUT0 = 19 * MiB;
constexpr size_t WS_WIN1 = 22 * MiB;
constexpr size_t WS_WOUT1 = 27 * MiB;
constexpr size_t WS_WGU = 32 * MiB;
constexpr size_t WS_WD = 288 * MiB;
constexpr size_t WS_HN = 416 * MiB;
constexpr size_t WS_B = 548 * MiB;
constexpr size_t WS_ACT = WS_B;
constexpr size_t WS_YSLOT = WS_B + 528 * MiB;
constexpr size_t WS_Q = WS_B, WS_K = WS_B + 64 * MiB, WS_V = WS_B + 130 * MiB, WS_R = WS_B + 262 * MiB;
constexpr size_t WS_ZC = WS_B + 390 * MiB, WS_ZS = WS_B + 454 * MiB, WS_LR = WS_B + 518 * MiB;
constexpr size_t WS_OF = WS_B + 528 * MiB, WS_OB = WS_B + 656 * MiB, WS_YR = WS_B + 784 * MiB, WS_YI = WS_B + 848 * MiB;
constexpr size_t WS_A2 = WS_B;
constexpr size_t WS_Y = WS_B + 528 * MiB;
constexpr size_t WS_H2 = WS_B + 656 * MiB;
constexpr size_t WS_GLU = WS_B, WS_ZC1 = WS_B + 64 * MiB, WS_GB = WS_B + 128 * MiB, WS_A2B = WS_B + 192 * MiB;
constexpr size_t WS_XS = WS_B + 1056 * MiB;
constexpr size_t WS_GQP = WS_B + 1056 * MiB;
constexpr size_t WS_GKPP = WS_GQP + 132 * MiB;
constexpr size_t WS_GSC = WS_GKPP + 132 * MiB;
constexpr size_t WS_GEL = WS_GSC + 66 * MiB;
constexpr size_t WS_END = WS_GEL + 6 * MiB;

constexpr int LDS_BYTES = 155648;
constexpr int MISC_OFF = LDS_BYTES - 256;

__device__ __forceinline__ float bf_lo(unsigned u) { return __uint_as_float(u << 16); }
__device__ __forceinline__ float bf_hi(unsigned u) { return __uint_as_float(u & 0xffff0000u); }
typedef __bf16 bf16v2_t __attribute__((ext_vector_type(2)));
typedef float f32v2_t __attribute__((ext_vector_type(2)));
__device__ __forceinline__ unsigned cvt_pk(float lo, float hi) { const f32v2_t v = {lo, hi}; const bf16v2_t r = __builtin_convertvector(v, bf16v2_t); return __builtin_bit_cast(unsigned, r); }
__device__ __forceinline__ unsigned f2bf(float f) { unsigned u = __float_as_uint(f); return (u + 0x7fffu + ((u >> 16) & 1u)) >> 16; }
__device__ __forceinline__ float swap32_sum(float a, float b) {
    const auto r = __builtin_amdgcn_permlane32_swap(__builtin_bit_cast(unsigned, a), __builtin_bit_cast(unsigned, b), false, false);
    unsigned x = r[0], y = r[1]; asm volatile("" : "+v"(x), "+v"(y));
    return __builtin_bit_cast(float, x) + __builtin_bit_cast(float, y);
}
__device__ __forceinline__ float swap16_sum(float a, float b) {
    const auto r = __builtin_amdgcn_permlane16_swap(__builtin_bit_cast(unsigned, a), __builtin_bit_cast(unsigned, b), false, false);
    unsigned x = r[0], y = r[1]; asm volatile("" : "+v"(x), "+v"(y));
    return __builtin_bit_cast(float, x) + __builtin_bit_cast(float, y);
}
__device__ __forceinline__ float row16_sum(float v) {
    v += __builtin_bit_cast(float, __builtin_amdgcn_update_dpp(0, __builtin_bit_cast(int, v), 0xB1, 0xF, 0xF, true));
    v += __builtin_bit_cast(float, __builtin_amdgcn_update_dpp(0, __builtin_bit_cast(int, v), 0x4E, 0xF, 0xF, true));
    v += __builtin_bit_cast(float, __builtin_amdgcn_update_dpp(0, __builtin_bit_cast(int, v), 0x141, 0xF, 0xF, true));
    v += __builtin_bit_cast(float, __builtin_amdgcn_update_dpp(0, __builtin_bit_cast(int, v), 0x140, 0xF, 0xF, true));
    return v;
}
__device__ __forceinline__ float wave_sum(float v) {
    v = row16_sum(v);
    const int iv = __builtin_bit_cast(int, v);
    const float a = __builtin_bit_cast(float, __builtin_amdgcn_readlane(iv, 0)), b = __builtin_bit_cast(float, __builtin_amdgcn_readlane(iv, 16));
    const float c = __builtin_bit_cast(float, __builtin_amdgcn_readlane(iv, 32)), d = __builtin_bit_cast(float, __builtin_amdgcn_readlane(iv, 48));
    return (a + b) + (c + d);
}
__device__ __forceinline__ unsigned pk4_fp8(float a, float b, float c, float d, float sc) {
    int w = 0;
    w = __builtin_amdgcn_cvt_pk_fp8_f32(__builtin_amdgcn_fmed3f(a * sc, -440.f, 440.f), __builtin_amdgcn_fmed3f(b * sc, -440.f, 440.f), w, false);
    w = __builtin_amdgcn_cvt_pk_fp8_f32(__builtin_amdgcn_fmed3f(c * sc, -440.f, 440.f), __builtin_amdgcn_fmed3f(d * sc, -440.f, 440.f), w, true);
    return (unsigned)w;
}
__device__ __forceinline__ float sigmoidf_(float x) { return __builtin_amdgcn_rcpf(1.0f + __builtin_amdgcn_exp2f(x * -1.4426950408889634f)); }
__device__ __forceinline__ float siluf_(float x) { return x * sigmoidf_(x); }

#define XB_TMO      128
#define XB_XCNT(j)  (256  + 64 * (j))
#define XB_XSUB(j)  (1280 + 64 * (j))
#define XB_XGEN(j)  (2304 + 64 * (j))
#define XB_TOP      3328
#define XB_TOPGEN   3392
#define XCD_BAR_WORDS 3456
#define XB_SPIN_CAP (1u << 18)
__device__ __forceinline__ unsigned xb_ld(unsigned* p)              { return __hip_atomic_load(p, __ATOMIC_RELAXED, __HIP_MEMORY_SCOPE_AGENT); }
__device__ __forceinline__ unsigned xb_add(unsigned* p, unsigned v) { return __hip_atomic_fetch_add(p, v, __ATOMIC_RELAXED, __HIP_MEMORY_SCOPE_AGENT); }
__device__ __forceinline__ unsigned xb_xcc_id() { return (unsigned)__builtin_amdgcn_s_getreg((3 << 11) | 20) & 0xFu; }
#define XB_SPIN(cond, bar) do { unsigned _sp = 0; while (cond) { __builtin_amdgcn_s_sleep(1); \
    if ((++_sp & 255u) == 0u) { if (xb_ld(&(bar)[XB_TMO])) break; if (_sp > XB_SPIN_CAP) { atomicAdd(&(bar)[XB_TMO], 1u); break; } } } } while (0)
struct XcdBarrier { unsigned* bar; unsigned x; volatile LAS unsigned* st; };
__device__ __forceinline__ XcdBarrier xcd_barrier_post(unsigned* bar, volatile LAS unsigned* st) {
    XcdBarrier b; b.bar = bar; b.x = xb_xcc_id(); b.st = st;
    if (threadIdx.x == 0) (void)xb_add(&bar[XB_XCNT(b.x)], 1u);
    return b;
}
__device__ __forceinline__ void xcd_barrier_complete(unsigned* bar, unsigned x, unsigned& nloc, unsigned& nx) {
    const unsigned G = gridDim.x * gridDim.y * gridDim.z;
    unsigned sum, cnt, mine, sp = 0u;
    for (;;) {
        sum = 0u; cnt = 0u; mine = 0u;
#pragma unroll
        for (unsigned j = 0; j < 16; ++j) { const unsigned c = xb_ld(&bar[XB_XCNT(j)]); sum += c; cnt += (c > 0u) ? 1u : 0u; mine = (j == x) ? c : mine; }
        if (sum == G) break;
        __builtin_amdgcn_s_sleep(1);
        if ((++sp & 255u) == 0u) { if (xb_ld(&bar[XB_TMO])) break; if (sp > XB_SPIN_CAP) { atomicAdd(&bar[XB_TMO], 1u); break; } }
    }
    nloc = mine > 0u ? mine : 1u; nx = cnt > 0u ? cnt : 1u;
}
__device__ __forceinline__ void xcd_barrier(const XcdBarrier& b) {
    asm volatile("s_waitcnt vmcnt(0)" ::: "memory");
    __syncthreads();
    if (threadIdx.x == 0) {
        unsigned* bar = b.bar;
        __builtin_amdgcn_s_waitcnt(0);
        unsigned nloc = b.st[0], nx = b.st[1];
        if (nloc == 0u) { xcd_barrier_complete(bar, b.x, nloc, nx); b.st[0] = nloc; b.st[1] = nx; }
        const unsigned old = xb_add(&bar[XB_XSUB(b.x)], 1u);
        const unsigned gen = old / nloc;
        if (old + 1u == (gen + 1u) * nloc) {
            __builtin_amdgcn_fence(__ATOMIC_RELEASE, "agent");
            asm volatile("s_waitcnt vmcnt(0)" ::: "memory");
            const unsigned og = xb_add(&bar[XB_TOP], 1u);
            const unsigned tg = og / nx;
            if (og + 1u == (tg + 1u) * nx) xb_add(&bar[XB_TOPGEN], 1u);
            else XB_SPIN(xb_ld(&bar[XB_TOPGEN]) == tg, bar);
            __builtin_amdgcn_fence(__ATOMIC_ACQUIRE, "agent");
            xb_add(&bar[XB_XGEN(b.x)], 1u);
            asm volatile("s_waitcnt vmcnt(0)" ::: "memory");
        } else {
            XB_SPIN(xb_ld(&bar[XB_XGEN(b.x)]) == gen, bar);
            __builtin_amdgcn_fence(__ATOMIC_ACQUIRE, "agent");
            asm volatile("s_waitcnt vmcnt(0)" ::: "memory");
        }
    }
    __syncthreads();
}

struct Args {
    const float* in[28];
    float* out;
    unsigned char* ws;
    int ph_lo, ph_hi;
};
struct Ctx {
    LAS unsigned char* lds;
    int G;
    const Args* a;
    unsigned char* ws;
};
__device__ __forceinline__ int otid() { int t = (int)threadIdx.x; asm volatile("" : "+v"(t)); return t; }
__device__ __forceinline__ int vzero() { int z = 0; asm volatile("" : "+v"(z)); return z; }
#define PH_IDS const int tid = otid(), lane = tid & 63, wave = __builtin_amdgcn_readfirstlane(tid >> 6); (void)tid; (void)lane; (void)wave
#define IN_X 0
#define IN_C 1
#define IN_CTX 2
#define IN_CCTX 3
#define IN_MODW 4
#define IN_MODB 5
#define IN_NMPRE 6
#define IN_NMPOST 7
#define IN_NFPRE 8
#define IN_NFPOST 9
#define IN_EVWIN 10
#define IN_EVGKUP 11
#define IN_EVGKB 12
#define IN_EVGNORM 13
#define IN_EVWOUT 14
#define IN_ODWIN 15
#define IN_ODDW 16
#define IN_ODDWB 17
#define IN_ODLNG 18
#define IN_ODLNB 19
#define IN_ODSCONV 20
#define IN_ODWOUT 21
#define IN_RW 22
#define IN_RB 23
#define IN_WGU 24
#define IN_BGU 25
#define IN_WD 26
#define IN_BD 27

namespace gm {
constexpr int BM = 256, BK = 64, HALF = 128, HTB = HALF * BK * 2, STAGE_BYTES = 8 * HTB, NXCD = 8, WGM = 8;
constexpr int XT_OFF = 131072;
constexpr int XB_OFF = XT_OFF + 16384;
__device__ __forceinline__ int lds_byte(int r, int c) { const int st = (r >> 4) * 2 + (c >> 5), rr = r & 15, cc = c & 31, ob = rr * 64 + cc * 2; return st * 1024 + (ob ^ (((ob >> 9) & 1) << 5)); }
__device__ __forceinline__ void stage_rc(int b, int& R, int& C) { const int st = b / 1024, sb = b % 1024, swz = sb ^ (((sb >> 9) & 1) << 5); R = (st >> 1) * 16 + swz / 64; C = (st & 1) * 32 + (swz % 64) / 2; }
__device__ __forceinline__ int perm32(int rho) { const int n = rho >> 4, i = rho & 15; return 8 * (i >> 2) + 4 * n + (i & 3); }
struct Unit { int pm, pn, e; };

__device__ __forceinline__ void dense_map(int L, int nM, int nN, int& pm, int& pn) {
    const int nwg = nM * nN; int wgid = L;
    { const int q = nwg / NXCD, r = nwg % NXCD, xcd = wgid % NXCD, off = wgid / NXCD; wgid = (xcd < r ? xcd * (q + 1) : r * (q + 1) + (xcd - r) * q) + off; }
    const int nig = WGM * nN, gid = wgid / nig, fm = gid * WGM, gsz = (nM - fm) < WGM ? (nM - fm) : WGM;
    pm = fm + ((wgid % nig) % gsz); pn = (wgid % nig) / gsz;
}

typedef int i32x8 __attribute__((ext_vector_type(8)));
typedef int i32x4_ __attribute__((ext_vector_type(4)));
template <bool F8, class Epi, class Sched>
__device__ __forceinline__ void gemm_phase(LAS unsigned char* lds, const int RP, const Sched& S, const Epi& E, const int SCA = 0x7F7F7F7F, const int SCB = 0x7F7F7F7F, const int pid = -1, unsigned long long* tprobe = nullptr) {
    const int tid = otid(), wid = __builtin_amdgcn_readfirstlane(tid >> 6), lane = tid & 63, wr = wid >> 2, wc = wid & 3, fr = lane & 15, fq = lane >> 4;
    const int nt = RP / 128;
    unsigned voffB[2];
#pragma unroll
    for (int i = 0; i < 2; ++i) { int R, C; stage_rc(tid * 16 + i * 8192, R, C); const int Rb = (R & ~31) + perm32(R & 31); voffB[i] = (unsigned)(Rb * RP + C * 2); }
    const size_t kstep = (size_t)128;
    const size_t hstepB = (size_t)HALF * RP;
    const unsigned ldsw = (unsigned)wid * 1024u;
    const int aoff = lds_byte(wr * 64 + fr, fq * 8);
    const int boff = lds_byte(wc * 32 + fr, fq * 8);
    constexpr int KOFF = 1024;
#define G_SA(b, h) (((b) * 2 + (h)) * HTB)
#define G_SB(b, h) ((4 + (b) * 2 + (h)) * HTB)
#define G_STAGEB(bufoff, gbase) do { _Pragma("unroll") for (int _i = 0; _i < 2; ++_i) \
        __builtin_amdgcn_global_load_lds((const unsigned*)((const char*)(gbase) + voffB[_i]), (LAS unsigned*)(lds + (bufoff) + ldsw + _i * 8192), 16, 0, 0); } while (0)
#define G_STAGEA(bufoff, offs, h, kb) do { _Pragma("unroll") for (int _i = 0; _i < 2; ++_i) \
        __builtin_amdgcn_global_load_lds((const unsigned*)(S.abase() + (size_t)(offs)[h][_i] + (kb)), (LAS unsigned*)(lds + (bufoff) + ldsw + _i * 8192), 16, 0, 0); } while (0)
#define G_LDA(dst, b, h) do { _Pragma("unroll") for (int m = 0; m < 4; ++m) _Pragma("unroll") for (int k = 0; k < 2; ++k) dst[m][k] = *(const LAS bf16x8*)(lds + G_SA(b, h) + aoff + m * 2048 + k * KOFF); } while (0)
#define G_LDB(dst, b, h) do { _Pragma("unroll") for (int n = 0; n < 2; ++n) _Pragma("unroll") for (int k = 0; k < 2; ++k) dst[n][k] = *(const LAS bf16x8*)(lds + G_SB(b, h) + boff + n * 2048 + k * KOFF); } while (0)
#define G_CAT8(x) __builtin_shufflevector(__builtin_bit_cast(i32x4_, (x)[0]), __builtin_bit_cast(i32x4_, (x)[1]), 0, 1, 2, 3, 4, 5, 6, 7)
#define G_MMA(ai, bj, At, Bt) do { __builtin_amdgcn_s_setprio(1); \
        if constexpr (F8) { _Pragma("unroll") for (int m = 0; m < 4; ++m) _Pragma("unroll") for (int n = 0; n < 2; ++n) \
            acc[ai][bj][m][n] = __builtin_amdgcn_mfma_scale_f32_16x16x128_f8f6f4(G_CAT8(Bt[n]), G_CAT8(At[m]), acc[ai][bj][m][n], 0, 0, 0, 0, 0, 0); } \
        else { _Pragma("unroll") for (int m = 0; m < 4; ++m) _Pragma("unroll") for (int n = 0; n < 2; ++n) _Pragma("unroll") for (int k = 0; k < 2; ++k) \
            acc[ai][bj][m][n] = __builtin_amdgcn_mfma_f32_16x16x32_bf16(Bt[n][k], At[m][k], acc[ai][bj][m][n], 0, 0, 0); } \
        __builtin_amdgcn_s_setprio(0); } while (0)
#define G_WAIT_V(n) asm volatile("s_waitcnt vmcnt(" #n ")" ::: "memory")
#define G_WAIT_L(n) asm volatile("s_waitcnt lgkmcnt(" #n ")" ::: "memory")
#define G_BAR __builtin_amdgcn_s_barrier()
#define G_SCHED __builtin_amdgcn_sched_barrier(0)
    Unit cur, nxt; int ui = 0;
#ifndef GP_PROBE
#define GP_PROBE 0
#endif
#ifndef GP_PROBE_PID
#define GP_PROBE_PID 8
#endif
    unsigned tp_k = 0, tp_e = 0, tp_s = 0, tp_0 = 0, tp_1 = 0;
#define TP_NOW() ((unsigned)__builtin_amdgcn_readfirstlane((int)(unsigned)wall_clock64()))
    const bool tp_on = GP_PROBE && pid == GP_PROBE_PID;
    if (tp_on) tp_0 = TP_NOW();
    if (!S.next(0, cur)) return;
    f32x4 acc[2][2][4][2];
#pragma unroll
    for (int a = 0; a < 2; ++a)
#pragma unroll
        for (int b = 0; b < 2; ++b)
#pragma unroll
            for (int m = 0; m < 4; ++m)
#pragma unroll
                for (int n = 0; n < 2; ++n) acc[a][b][m][n] = (f32x4){0.f, 0.f, 0.f, 0.f};
    bf16x8 At[4][2], B0[2][2], B1[2][2];
    unsigned cAo[2][2];
    S.a_off(cur, cAo);
    const char* cB = S.b_ptr(cur);
    S.prefetch_bias(cur, lds, 0, wid, lane, wc);
    S.prefetch_rows(cur, lds, 0, wid, lane);
    G_STAGEB(G_SB(0, 0), cB); G_STAGEA(G_SA(0, 0), cAo, 0, 0); G_STAGEB(G_SB(0, 1), cB + hstepB); G_STAGEA(G_SA(0, 1), cAo, 1, 0);
    if (wr == 1) G_BAR;
    G_WAIT_V(4); G_BAR;
    G_STAGEB(G_SB(1, 0), cB + kstep); G_STAGEA(G_SA(1, 0), cAo, 0, kstep); G_STAGEB(G_SB(1, 1), cB + hstepB + kstep);
    G_WAIT_V(6); G_BAR;
    for (;;) {
        const bool has_next = S.next(ui + 1, nxt);
        const char* nB = cB;
        if (has_next) { S.prefetch_rows(nxt, lds, (ui + 1) & 1, wid, lane); S.prefetch_bias(nxt, lds, (ui + 1) & 1, wid, lane, wc); nB = S.b_ptr(nxt); }
        if (tp_on) tp_s = TP_NOW();
        for (int t = 0; t < nt; t += 2) {
            const bool last = (t == nt - 2);
            const size_t k1 = (size_t)(t + 1) * kstep;
            G_LDB(B0, 0, 0); G_SCHED; G_LDA(At, 0, 0); G_STAGEA(G_SA(1, 1), cAo, 1, k1);
            if (last) { if (has_next) S.a_off_lds(nxt, lds, (ui + 1) & 1, wid, lane, cAo); cB = nB; }
            const size_t k2 = last ? 0 : (size_t)(t + 2) * kstep;
            const size_t k3 = k2 + kstep;
            const char* b2 = cB + k2; const char* b3 = b2 + kstep;
            G_WAIT_L(8); G_BAR; G_WAIT_L(0); G_MMA(0, 0, At, B0); G_BAR; G_SCHED;
            G_LDB(B1, 0, 1); G_STAGEB(G_SB(0, 0), b2);
            G_BAR; G_WAIT_L(0); G_MMA(0, 1, At, B1); G_BAR;
            G_LDA(At, 0, 1); G_STAGEA(G_SA(0, 0), cAo, 0, k2);
            G_BAR; G_WAIT_L(0); G_MMA(1, 0, At, B0); G_BAR; G_SCHED;
            G_STAGEB(G_SB(0, 1), b2 + hstepB);
            G_WAIT_V(6); G_BAR; G_MMA(1, 1, At, B1); G_BAR;
            G_LDB(B0, 1, 0); G_SCHED; G_LDA(At, 1, 0); G_STAGEA(G_SA(0, 1), cAo, 1, k2);
            G_WAIT_L(8); G_BAR; G_WAIT_L(0); G_MMA(0, 0, At, B0); G_BAR; G_SCHED;
            G_LDB(B1, 1, 1); G_STAGEB(G_SB(1, 0), b3);
            G_BAR; G_WAIT_L(0); G_MMA(0, 1, At, B1); G_BAR;
            G_LDA(At, 1, 1); G_STAGEA(G_SA(1, 0), cAo, 0, k3);
            G_BAR; G_WAIT_L(0); G_MMA(1, 0, At, B0); G_BAR; G_SCHED;
            G_STAGEB(G_SB(1, 1), b3 + hstepB);
            G_WAIT_V(6); G_BAR; G_MMA(1, 1, At, B1); G_BAR;
        }
        if (tp_on) { tp_1 = TP_NOW(); tp_k += tp_1 - tp_s; }
        const float osc = F8 ? __builtin_ldexpf(1.0f, ((SCA & 0xFF) - 127) + ((SCB & 0xFF) - 127)) : 1.0f;
        if constexpr (F8 && !Epi::FOLD) {
#pragma unroll
            for (int a = 0; a < 2; ++a)
#pragma unroll
                for (int b = 0; b < 2; ++b)
#pragma unroll
                    for (int m = 0; m < 4; ++m)
#pragma unroll
                        for (int n = 0; n < 2; ++n) acc[a][b][m][n] *= osc; }
        E(acc, cur, wr, wc, fr, fq, (const LAS float*)(lds + XB_OFF + ((ui & 1) * 8 + wid) * 256), (const LAS int*)(lds + XT_OFF + ((ui & 1) * 8 + wid) * 1024), osc);
        if (tp_on) tp_e += TP_NOW() - tp_1;
        if (!has_next) break;
#pragma unroll
        for (int a = 0; a < 2; ++a)
#pragma unroll
            for (int b = 0; b < 2; ++b)
#pragma unroll
                for (int m = 0; m < 4; ++m)
#pragma unroll
                    for (int n = 0; n < 2; ++n) acc[a][b][m][n] = (f32x4){0.f, 0.f, 0.f, 0.f};
        cur = nxt; ++ui;
    }
    G_WAIT_V(0);
    if (wr == 0) G_BAR;
    G_BAR;
    if (tp_on && blockIdx.x == 0 && tid == 0) { const unsigned tot = TP_NOW() - tp_0; *tprobe = (unsigned long long)((GP_PROBE == 1) ? tp_k : (GP_PROBE == 2) ? tp_e : tot); }
#undef G_SA
#undef G_SB
#undef G_STAGEA
#undef G_STAGEB
#undef G_LDA
#undef G_LDB
#undef G_MMA
#undef G_CAT8
#undef G_WAIT_V
#undef G_WAIT_L
#undef G_BAR
#undef G_SCHED
}

__device__ __forceinline__ void lane_rc(int i, int& R, int& Cb) { int C; stage_rc(otid() * 16 + i * 8192, R, C); Cb = C * 2; }

struct SchedDense {
    const char* A; const char* B; int RP, nM, nN, G, c;
    __device__ __forceinline__ const char* abase() const { return A; }
    __device__ __forceinline__ bool next(int i, Unit& u) const { const long L = (long)i * G + c; if (L >= (long)nM * nN) return false; dense_map((int)L, nM, nN, u.pm, u.pn); u.e = 0; return true; }
    __device__ __forceinline__ void a_off(const Unit& u, unsigned (&o)[2][2]) const {
#pragma unroll
        for (int i = 0; i < 2; ++i) { int R, Cb; lane_rc(i, R, Cb);
#pragma unroll
            for (int h = 0; h < 2; ++h) o[h][i] = (unsigned)(u.pm * BM + h * HALF + R) * (unsigned)RP + (unsigned)Cb; }
    }
    __device__ __forceinline__ void prefetch_rows(const Unit&, LAS unsigned char*, int, int, int) const {}
    __device__ __forceinline__ void prefetch_bias(const Unit&, LAS unsigned char*, int, int, int, int) const {}
    __device__ __forceinline__ void a_off_lds(const Unit& u, LAS unsigned char*, int, int, int, unsigned (&o)[2][2]) const { a_off(u, o); }
    __device__ __forceinline__ const char* b_ptr(const Unit& u) const { return B + (size_t)u.pn * BM * RP; }
};
struct SchedIn0 {
    const char* A; const char* B; int G, c;
    __device__ __forceinline__ const char* abase() const { return A; }
    __device__ __forceinline__ bool next(int i, Unit& u) const {
        const long L = (long)i * G + c; u.e = 0;
        if (L < 256 * 15) { dense_map((int)L, 256, 15, u.pm, u.pn); return true; }
        const int r = (int)(L - 256 * 15); if (r >= 56) return false;
        u.pm = 256 + r / 7; const int q = r % 7; u.pn = (q < 6) ? (2 + q) : 14; return true;
    }
    __device__ __forceinline__ void a_off(const Unit& u, unsigned (&o)[2][2]) const {
#pragma unroll
        for (int i = 0; i < 2; ++i) { int R, Cb; lane_rc(i, R, Cb);
#pragma unroll
            for (int h = 0; h < 2; ++h) o[h][i] = (unsigned)(u.pm * BM + h * HALF + R) * (F8_IN0 ? 1024u : 2048u) + (unsigned)Cb; }
    }
    __device__ __forceinline__ void prefetch_rows(const Unit&, LAS unsigned char*, int, int, int) const {}
    __device__ __forceinline__ void prefetch_bias(const Unit&, LAS unsigned char*, int, int, int, int) const {}
    __device__ __forceinline__ void a_off_lds(const Unit& u, LAS unsigned char*, int, int, int, unsigned (&o)[2][2]) const { a_off(u, o); }
    __device__ __forceinline__ const char* b_ptr(const Unit& u) const { return B + (size_t)u.pn * BM * (F8_IN0 ? 1024 : 2048); }
};
struct SchedMoE {
    const char* A; const char* B; const int* slot_tok; int ts; int RT; int nct; int G, c; size_t bstride_e; bool gather; const float* bias; const int* slot_dst;
    __device__ __forceinline__ const char* abase() const { return A; }
    __device__ __forceinline__ bool next(int i, Unit& u) const {
        const int x = c & 7, j = c >> 3; int rt, ct;
        if (nct == 8) { rt = 32 * i + 4 * x + (j & 3); ct = j >> 2; } else { rt = 64 * i + 8 * x + (j & 7); ct = j >> 3; }
        if (rt >= RT) return false;
        const unsigned long long m = __ballot(((otid() & 63) < 32) && ts <= rt);
        u.pm = rt; u.pn = ct; u.e = __builtin_amdgcn_readfirstlane(__popcll(m)) - 1; return true;
    }
    __device__ __forceinline__ void a_off(const Unit& u, unsigned (&o)[2][2]) const {
#pragma unroll
        for (int i = 0; i < 2; ++i) { int R, Cb; lane_rc(i, R, Cb);
#pragma unroll
            for (int h = 0; h < 2; ++h) { const int row = u.pm * BM + h * HALF + R; const unsigned rr = gather ? (unsigned)slot_tok[row] : (unsigned)row; o[h][i] = rr * 1024u + (unsigned)Cb; } }
    }
    __device__ __forceinline__ const char* b_ptr(const Unit& u) const { return B + (size_t)u.e * bstride_e + (size_t)u.pn * BM * 1024; }
    __device__ __forceinline__ void prefetch_rows(const Unit& u, LAS unsigned char* lds, int par, int wid, int lane) const {
        if (!gather) { if (!slot_dst) return;
#pragma unroll
            for (int ai = 0; ai < 2; ++ai) __builtin_amdgcn_global_load_lds((const unsigned*)(slot_dst + (u.pm * BM + ai * HALF + (wid >> 2) * 64 + lane)), (LAS unsigned*)(lds + XT_OFF + ((par * 8 + wid) * 4 + ai) * 256), 4, 0, 0);
            return; }
#pragma unroll
        for (int i = 0; i < 2; ++i) { int R, Cb; lane_rc(i, R, Cb);
#pragma unroll
            for (int h = 0; h < 2; ++h) __builtin_amdgcn_global_load_lds((const unsigned*)(slot_tok + (u.pm * BM + h * HALF + R)), (LAS unsigned*)(lds + XT_OFF + ((par * 8 + wid) * 4 + h * 2 + i) * 256), 4, 0, 0); }
    }
    __device__ __forceinline__ void prefetch_bias(const Unit& u, LAS unsigned char* lds, int par, int wid, int lane, int wc) const {
        const float* src = (nct == 8) ? bias + (size_t)u.e * 2048 + (lane >> 5) * 1024 + u.pn * 128 + wc * 32 + (lane & 31)
                                      : bias + (size_t)u.e * 1024 + u.pn * 256 + (lane >> 5) * 128 + wc * 32 + (lane & 31);
        __builtin_amdgcn_global_load_lds((const unsigned*)src, (LAS unsigned*)(lds + XB_OFF + (par * 8 + wid) * 256), 4, 0, 0);
    }
    __device__ __forceinline__ void a_off_lds(const Unit& u, LAS unsigned char* lds, int par, int wid, int lane, unsigned (&o)[2][2]) const {
#pragma unroll
        for (int i = 0; i < 2; ++i) { int R, Cb; lane_rc(i, R, Cb);
#pragma unroll
            for (int h = 0; h < 2; ++h) { const unsigned rr = gather ? *(const LAS unsigned*)(lds + XT_OFF + ((par * 8 + wid) * 4 + h * 2 + i) * 256 + lane * 4) : (unsigned)(u.pm * BM + h * HALF + R); o[h][i] = rr * 1024u + (unsigned)Cb; } }
    }
};

__device__ __forceinline__ void store8(bf16* p, const f32x4& v0, const f32x4& v1) {
    u32x4 w; w.x = cvt_pk(v0[0], v0[1]); w.y = cvt_pk(v0[2], v0[3]); w.z = cvt_pk(v1[0], v1[1]); w.w = cvt_pk(v1[2], v1[3]);
    *(u32x4*)p = w;
}
struct EpiPlain {
    static constexpr bool FOLD = false;
    bf16* O; int ldc;
    __device__ __forceinline__ void operator()(const f32x4 (&acc)[2][2][4][2], const Unit& u, int wr, int wc, int fr, int fq, const LAS float* lb, const LAS int* xt, const float osc) const {
        const int row0 = u.pm * BM + wr * 64 + fr, col0 = u.pn * BM + wc * 32 + 8 * fq;
#pragma unroll
        for (int ai = 0; ai < 2; ++ai)
#pragma unroll
            for (int m = 0; m < 4; ++m) { bf16* rowp = O + (size_t)(row0 + ai * HALF + m * 16) * ldc + col0;
#pragma unroll
                for (int bj = 0; bj < 2; ++bj) store8(rowp + bj * HALF, acc[ai][bj][m][0], acc[ai][bj][m][1]); }
    }
};
struct EpiIn0 {
    static constexpr bool FOLD = false;
    unsigned char* ws;
    __device__ __forceinline__ void operator()(const f32x4 (&acc)[2][2][4][2], const Unit& u, int wr, int wc, int fr, int fq, const LAS float* lb, const LAS int* xt, const float osc) const {
        const int pn = u.pn; bf16* base; int ldc, c0;
        if (pn < 2) { base = (bf16*)(ws + WS_Q); ldc = 512; c0 = pn * 256; }
        else if (pn < 4) { base = (bf16*)(ws + WS_K); ldc = 512; c0 = (pn - 2) * 256; }
        else if (pn < 8) { base = (bf16*)(ws + WS_V); ldc = 1024; c0 = (pn - 4) * 256; }
        else if (pn < 12) { base = (bf16*)(ws + WS_R); ldc = 1024; c0 = (pn - 8) * 256; }
        else if (pn < 14) { base = (bf16*)(ws + WS_ZC); ldc = 512; c0 = (pn - 12) * 256; }
        else { base = (bf16*)(ws + WS_LR); ldc = 32; c0 = 0; }
        const int row0 = u.pm * BM + wr * 64 + fr, col0 = c0 + wc * 32 + 8 * fq;
        const bool lr = (pn == 14);
        if (lr && wc != 0) return;
        const float qs = (pn < 2) ? 0.08838834764831845f : 1.0f;
#pragma unroll
        for (int ai = 0; ai < 2; ++ai)
#pragma unroll
            for (int m = 0; m < 4; ++m) { bf16* rowp = base + (size_t)(row0 + ai * HALF + m * 16) * ldc + col0;
                store8(rowp, acc[ai][0][m][0] * qs, acc[ai][0][m][1] * qs);
                if (!lr) store8(rowp + HALF, acc[ai][1][m][0] * qs, acc[ai][1][m][1] * qs); }
    }
};
struct EpiIn1 {
    static constexpr bool FOLD = false;
    unsigned char* ws;
    __device__ __forceinline__ void operator()(const f32x4 (&acc)[2][2][4][2], const Unit& u, int wr, int wc, int fr, int fq, const LAS float* lb, const LAS int* xt, const float osc) const {
        const int pn = u.pn; const int row0 = u.pm * BM + wr * 64 + fr;
        if (pn >= 8) { bf16* O = (bf16*)(ws + WS_GB); const int col0 = (pn - 8) * 256 + wc * 32 + 8 * fq;
#pragma unroll
            for (int ai = 0; ai < 2; ++ai)
#pragma unroll
                for (int m = 0; m < 4; ++m) { bf16* rowp = O + (size_t)(row0 + ai * HALF + m * 16) * 512 + col0;
#pragma unroll
                    for (int bj = 0; bj < 2; ++bj) store8(rowp + bj * HALF, acc[ai][bj][m][0], acc[ai][bj][m][1]); }
            return; }
        const bool glu = pn < 4; bf16* O = (bf16*)(ws + (glu ? WS_GLU : WS_ZC1)); const int col0 = (pn & 3) * 128 + wc * 32 + 8 * fq;
#pragma unroll
        for (int ai = 0; ai < 2; ++ai)
#pragma unroll
            for (int m = 0; m < 4; ++m) { f32x4 o[2];
#pragma unroll
                for (int n = 0; n < 2; ++n)
#pragma unroll
                    for (int i = 0; i < 4; i += 2) { const f32v2_t a = (f32v2_t){acc[ai][0][m][n][i], acc[ai][0][m][n][i + 1]}, b = (f32v2_t){acc[ai][1][m][n][i], acc[ai][1][m][n][i + 1]};
                        f32v2_t ov;
                        if (glu) { const f32v2_t ea = b * -1.4426950408889634f; f32v2_t e; e.x = __builtin_amdgcn_exp2f(ea.x); e.y = __builtin_amdgcn_exp2f(ea.y);
                            const f32v2_t d = e + 1.0f; f32v2_t r; r.x = __builtin_amdgcn_rcpf(d.x); r.y = __builtin_amdgcn_rcpf(d.y); ov = a * r; }
                        else ov = a * b;
                        o[n][i] = ov.x; o[n][i + 1] = ov.y; }
                store8(O + (size_t)(row0 + ai * HALF + m * 16) * 512 + col0, o[0], o[1]); }
    }
};
struct EpiGU {
    static constexpr bool FOLD = true;
    unsigned char* O; const float* bgu; int probe;
    __device__ __forceinline__ void operator()(const f32x4 (&acc)[2][2][4][2], const Unit& u, int wr, int wc, int fr, int fq, const LAS float* lb, const LAS int* xt, const float osc) const {
        if (probe) {
#pragma unroll
            for (int a = 0; a < 2; ++a)
#pragma unroll
                for (int b = 0; b < 2; ++b)
#pragma unroll
                    for (int m = 0; m < 4; ++m)
#pragma unroll
                        for (int n = 0; n < 2; ++n) asm volatile("" :: "v"(acc[a][b][m][n]));
            return; }
        const int row0 = u.pm * BM + wr * 64 + fr, col0 = u.pn * 128 + wc * 32 + 8 * fq;
        f32x4 bgv[2], buv[2];
#pragma unroll
        for (int n = 0; n < 2; ++n) { bgv[n] = *(const LAS f32x4*)(lb + 8 * fq + 4 * n); buv[n] = *(const LAS f32x4*)(lb + 32 + 8 * fq + 4 * n); }
#pragma unroll
        for (int ai = 0; ai < 2; ++ai)
#pragma unroll
            for (int m = 0; m < 4; ++m) { f32x4 o[2];
#pragma unroll
                for (int n = 0; n < 2; ++n)
#pragma unroll
                    for (int i = 0; i < 4; i += 2) {
                        f32v2_t g = (f32v2_t){acc[ai][0][m][n][i], acc[ai][0][m][n][i + 1]} * osc + (f32v2_t){bgv[n][i], bgv[n][i + 1]};
                        f32v2_t uu = (f32v2_t){acc[ai][1][m][n][i], acc[ai][1][m][n][i + 1]} * osc + (f32v2_t){buv[n][i], buv[n][i + 1]};
                        g.x = fminf(g.x, 7.0f); g.y = fminf(g.y, 7.0f);
                        uu.x = __builtin_amdgcn_fmed3f(uu.x, -7.0f, 7.0f); uu.y = __builtin_amdgcn_fmed3f(uu.y, -7.0f, 7.0f);
                        const f32v2_t ea = g * (-1.702f * 1.4426950408889634f);
                        f32v2_t e; e.x = __builtin_amdgcn_exp2f(ea.x); e.y = __builtin_amdgcn_exp2f(ea.y);
                        const f32v2_t d = e + 1.0f;
                        f32v2_t r; r.x = __builtin_amdgcn_rcpf(d.x); r.y = __builtin_amdgcn_rcpf(d.y);
                        const f32v2_t t4 = uu * 4.0f + 4.0f;
                        const f32v2_t ov = (g * r) * t4;
                        o[n][i] = ov.x; o[n][i + 1] = ov.y; }
                int w0 = 0, w1 = 0;
                w0 = __builtin_amdgcn_cvt_pk_fp8_f32(o[0][0], o[0][1], w0, false); w0 = __builtin_amdgcn_cvt_pk_fp8_f32(o[0][2], o[0][3], w0, true);
                w1 = __builtin_amdgcn_cvt_pk_fp8_f32(o[1][0], o[1][1], w1, false); w1 = __builtin_amdgcn_cvt_pk_fp8_f32(o[1][2], o[1][3], w1, true);
                *(u32x2*)(O + (size_t)(row0 + ai * HALF + m * 16) * 1024 + col0) = (u32x2){(unsigned)w0, (unsigned)w1}; }
    }
};
struct EpiDown {
    static constexpr bool FOLD = true;
    unsigned char* O; const float* bd;
    __device__ __forceinline__ void operator()(const f32x4 (&acc)[2][2][4][2], const Unit& u, int wr, int wc, int fr, int fq, const LAS float* lb, const LAS int* xt, const float osc) const {
        const int row0 = u.pm * BM + wr * 64 + fr, col0 = u.pn * BM + wc * 32 + 8 * fq;
        f32x4 bv[2][2];
#pragma unroll
        for (int bj = 0; bj < 2; ++bj)
#pragma unroll
            for (int n = 0; n < 2; ++n) bv[bj][n] = *(const LAS f32x4*)(lb + 32 * bj + 8 * fq + 4 * n) * 16.0f;
#pragma unroll
        for (int ai = 0; ai < 2; ++ai)
#pragma unroll
            for (int m = 0; m < 4; ++m) { unsigned char* rowp = O + (size_t)(row0 + ai * HALF + m * 16) * 1024 + col0;
#pragma unroll
                for (int bj = 0; bj < 2; ++bj) { const f32x4 v0 = acc[ai][bj][m][0] * (16.0f * osc) + bv[bj][0], v1 = acc[ai][bj][m][1] * (16.0f * osc) + bv[bj][1];
                    int w0 = 0, w1 = 0;
                    w0 = __builtin_amdgcn_cvt_pk_fp8_f32(fminf(fmaxf(v0[0], -440.f), 440.f), fminf(fmaxf(v0[1], -440.f), 440.f), w0, false); w0 = __builtin_amdgcn_cvt_pk_fp8_f32(fminf(fmaxf(v0[2], -440.f), 440.f), fminf(fmaxf(v0[3], -440.f), 440.f), w0, true);
                    w1 = __builtin_amdgcn_cvt_pk_fp8_f32(fminf(fmaxf(v1[0], -440.f), 440.f), fminf(fmaxf(v1[1], -440.f), 440.f), w1, false); w1 = __builtin_amdgcn_cvt_pk_fp8_f32(fminf(fmaxf(v1[2], -440.f), 440.f), fminf(fmaxf(v1[3], -440.f), 440.f), w1, true);
                    *(u32x2*)(rowp + bj * HALF) = (u32x2){(unsigned)w0, (unsigned)w1}; } }
    }
};
}

__device__ __forceinline__ void p0_adaln(const Ctx& C) {
    PH_IDS;
    LAS float* s = (LAS float*)C.lds;
    LAS float* red = (LAS float*)(C.lds + 36864);
    const float* cc = C.a->in[IN_C]; const float* cx = C.a->in[IN_CCTX];
    { float tmpc[18];
#pragma unroll
      for (int q = 0; q < 18; ++q) { const int i = tid + 512 * q; const int b = i >> 10, k = i & 1023; tmpc[q] = (b < 8) ? cc[b * 1024 + k] : cx[k]; }
#pragma unroll
      for (int q = 0; q < 18; ++q) s[tid + 512 * q] = siluf_(tmpc[q]); }
    __syncthreads();
    float* MOD = (float*)(C.ws + WS_MOD);
    for (int item = blockIdx.x; item < 192; item += C.G) {
        const int l = item / 96, cb = item % 96, col = cb * 64 + lane;
        const float* W = C.a->in[IN_MODW] + (size_t)l * 1024 * 6144 + col;
        float acc[9];
#pragma unroll
        for (int b = 0; b < 9; ++b) acc[b] = 0.f;
        const int k0 = wave * 128;
#pragma unroll 32
        for (int k = k0; k < k0 + 128; ++k) { const float w = W[(size_t)k * 6144];
#pragma unroll
            for (int b = 0; b < 9; ++b) acc[b] += s[b * 1024 + k] * w; }
#pragma unroll
        for (int b = 0; b < 9; ++b) red[(wave * 9 + b) * 64 + lane] = acc[b];
        __syncthreads();
        for (int i = tid; i < 576; i += 512) { const int b = i >> 6, ln = i & 63; float v = 0.f;
#pragma unroll
            for (int w = 0; w < 8; ++w) v += red[(w * 9 + b) * 64 + ln];
            v += C.a->in[IN_MODB][l * 6144 + cb * 64 + ln];
            MOD[(size_t)(l * 9 + b) * 6144 + cb * 64 + ln] = v; }
        __syncthreads();
    }
}
__device__ __forceinline__ void p0_tr_item(const float* W, int ldw, int sc0, int k0, bf16* WT, int Kd, int dr0, float scale, LAS float* scr, int lane) {
#pragma unroll 8
    for (int i = 0; i < 32; ++i) { const int kk = 2 * i + (lane >> 5); scr[kk * 33 + (lane & 31)] = W[(size_t)(k0 + kk) * ldw + sc0 + (lane & 31)]; }
    asm volatile("s_waitcnt lgkmcnt(0)" ::: "memory");
    const int c = lane & 7;
#pragma unroll
    for (int j = 0; j < 4; ++j) { const int n = (lane >> 3) + 8 * j; const LAS float* sp = scr + (8 * c) * 33 + n;
        u32x4 o; o.x = cvt_pk(sp[0 * 33] * scale, sp[1 * 33] * scale); o.y = cvt_pk(sp[2 * 33] * scale, sp[3 * 33] * scale);
        o.z = cvt_pk(sp[4 * 33] * scale, sp[5 * 33] * scale); o.w = cvt_pk(sp[6 * 33] * scale, sp[7 * 33] * scale);
        *(u32x4*)(WT + (size_t)(dr0 + n) * Kd + k0 + 8 * c) = o; }
    asm volatile("s_waitcnt lgkmcnt(0)" ::: "memory");
}
__device__ __forceinline__ void p0_tr_item8(const float* W, int ldw, int sc0, int k0, unsigned char* WT, int Kd, int dr0, float scale, LAS float* scr, int lane) {
#pragma unroll 8
    for (int i = 0; i < 64; ++i) { const int kk = 2 * i + (lane >> 5); scr[kk * 33 + (lane & 31)] = W[(size_t)(k0 + kk) * ldw + sc0 + (lane & 31)]; }
    asm volatile("s_waitcnt lgkmcnt(0)" ::: "memory");
    const int c = lane & 7;
#pragma unroll
    for (int j = 0; j < 4; ++j) { const int n = (lane >> 3) + 8 * j; const LAS float* sp = scr + (16 * c) * 33 + n;
        int w[4];
#pragma unroll
        for (int q = 0; q < 4; ++q) { int x = 0;
            x = __builtin_amdgcn_cvt_pk_fp8_f32(sp[(4 * q) * 33] * scale, sp[(4 * q + 1) * 33] * scale, x, false);
            x = __builtin_amdgcn_cvt_pk_fp8_f32(sp[(4 * q + 2) * 33] * scale, sp[(4 * q + 3) * 33] * scale, x, true); w[q] = x; }
        *(u32x4*)(WT + (size_t)(dr0 + n) * Kd + k0 + 16 * c) = (u32x4){(unsigned)w[0], (unsigned)w[1], (unsigned)w[2], (unsigned)w[3]}; }
    asm volatile("s_waitcnt lgkmcnt(0)" ::: "memory");
}
__device__ __forceinline__ int gu_src_col(int dr0) { const int pn = dr0 >> 8, bj = (dr0 >> 7) & 1, t0 = dr0 & 127; return bj * 1024 + 128 * pn + t0; }
__device__ __forceinline__ int in1_src_col(int dr0) {
    const int pn = dr0 >> 8, bj = (dr0 >> 7) & 1, t0 = dr0 & 127;
    if (pn < 4) return bj * 512 + 128 * pn + t0;
    if (pn < 8) return (bj ? 2048 : 1536) + 128 * (pn - 4) + t0;
    return 1024 + (dr0 - 2048);
}
__device__ __forceinline__ void p0_convert(const Ctx& C) {
    PH_IDS;
    LAS float* scr = (LAS float*)(C.lds + wave * 16896);
    const int gw = blockIdx.x * 8 + wave, NGW = C.G * 8;
    constexpr int KB_IN0 = F8_IN0 ? 8 : 16, KB_OUT0 = F8_OUT0 ? 12 : 24, KB_IN1 = F8_IN1 ? 8 : 16, KB_OUT1 = F8_OUT1 ? 8 : 16;
    constexpr int I_IN0 = 97 * KB_IN0, I_OUT0 = 32 * KB_OUT0, I_IN1 = 80 * KB_IN1, I_OUT1 = 32 * KB_OUT1, I_GU = 64 * 64 * 8, I_D = 64 * 32 * 8;
    constexpr int NITEMS = I_IN0 + I_OUT0 + I_IN1 + I_OUT1 + I_GU + I_D;
    for (int it = gw; it < NITEMS; it += NGW) {
        int r = it;
        if (r < I_IN0) { const int nb = r / KB_IN0, kb = r % KB_IN0; int dr0, sc0;
            if (nb < 96) { dr0 = nb * 32; sc0 = dr0; } else { dr0 = 3584; sc0 = 3072; }
            if (F8_IN0) p0_tr_item8(C.a->in[IN_EVWIN], 3616, sc0, kb * 128, (unsigned char*)(C.ws + WS_WIN0), 1024, dr0, 32.f, scr, lane);
            else p0_tr_item(C.a->in[IN_EVWIN], 3616, sc0, kb * 64, (bf16*)(C.ws + WS_WIN0), 1024, dr0, 1.f, scr, lane);
            continue; }
        r -= I_IN0;
        if (r < I_OUT0) { const int nb = r / KB_OUT0, kb = r % KB_OUT0;
            if (F8_OUT0) p0_tr_item8(C.a->in[IN_EVWOUT], 1024, nb * 32, kb * 128, (unsigned char*)(C.ws + WS_WOUT0), 1536, nb * 32, 32.f, scr, lane);
            else p0_tr_item(C.a->in[IN_EVWOUT], 1024, nb * 32, kb * 64, (bf16*)(C.ws + WS_WOUT0), 1536, nb * 32, 1.f, scr, lane);
            continue; }
        r -= I_OUT0;
        if (r < I_IN1) { const int nb = r / KB_IN1, kb = r % KB_IN1;
            if (F8_IN1) p0_tr_item8(C.a->in[IN_ODWIN], 2560, in1_src_col(nb * 32), kb * 128, (unsigned char*)(C.ws + WS_WIN1), 1024, nb * 32, 32.f, scr, lane);
            else p0_tr_item(C.a->in[IN_ODWIN], 2560, in1_src_col(nb * 32), kb * 64, (bf16*)(C.ws + WS_WIN1), 1024, nb * 32, 1.f, scr, lane);
            continue; }
        r -= I_IN1;
        if (r < I_OUT1) { const int nb = r / KB_OUT1, kb = r % KB_OUT1;
            if (F8_OUT1) p0_tr_item8(C.a->in[IN_ODWOUT], 1024, nb * 32, kb * 128, (unsigned char*)(C.ws + WS_WOUT1), 1024, nb * 32, 32.f, scr, lane);
            else p0_tr_item(C.a->in[IN_ODWOUT], 1024, nb * 32, kb * 64, (bf16*)(C.ws + WS_WOUT1), 1024, nb * 32, 1.f, scr, lane);
            continue; }
        r -= I_OUT1;
        if (r < I_GU) { const int le = r >> 9, q = r & 511, nb = q >> 3, kb = q & 7;
            p0_tr_item8(C.a->in[IN_WGU] + (size_t)le * 1024 * 2048, 2048, gu_src_col(nb * 32), kb * 128, (unsigned char*)(C.ws + WS_WGU) + (size_t)le * 2048 * 1024, 1024, nb * 32, 32.f, scr, lane); continue; }
        r -= I_GU;
        { const int le = r >> 8, q = r & 255, nb = q >> 3, kb = q & 7;
            p0_tr_item8(C.a->in[IN_WD] + (size_t)le * 1024 * 1024, 1024, nb * 32, kb * 128, (unsigned char*)(C.ws + WS_WD) + (size_t)le * 1024 * 1024, 1024, nb * 32, 32.f, scr, lane); }
    }
    { u32x4* z = (u32x4*)((unsigned char*)(C.ws + WS_WIN0) + (size_t)3616 * 1024 * (F8_IN0 ? 1 : 2)); const int n16 = 224 * 1024 * (F8_IN0 ? 1 : 2) / 16;
      for (int i = blockIdx.x * 512 + tid; i < n16; i += C.G * 512) z[i] = (u32x4){0u, 0u, 0u, 0u}; }
    { bf16* F1 = (bf16*)(C.ws + WS_F1); bf16* F2 = (bf16*)(C.ws + WS_F2);
      for (int i = blockIdx.x * 512 + tid; i < 128 * 128 + 128 * 256; i += C.G * 512) {
          if (i < 128 * 128) { const int m = i >> 7, k = i & 127; const int mb = m >> 5, rr = m & 31, g = rr >> 3, hh = (rr >> 2) & 1, ii = rr & 3;
              const int part = g & 1, ap = 16 * mb + 8 * (g >> 1) + 4 * hh + ii, pin = k >> 6, a = k & 63;
              const float th = 6.283185307179586f * (float)((a * ap) & 63) * (1.0f / 64.0f); const float cs = cosf(th), sn = sinf(th);
              const float v = (part == 0) ? (pin == 0 ? cs : -sn) : (pin == 0 ? -sn : -cs);
              F1[i] = (bf16)f2bf(v); }
          else { const int q = i - 128 * 128, m = q >> 8, k = q & 255, pin = k >> 7, b = k & 127;
              const float ps = 6.283185307179586f * (float)((b * m) & 127) * (1.0f / 128.0f);
              F2[q] = (bf16)f2bf(pin == 0 ? cosf(ps) : sinf(ps)); } } }
    __syncthreads();
}
__device__ __forceinline__ void p0_fourier_fold(const Ctx& C) {
    PH_IDS;
    LAS float* Wl = (LAS float*)C.lds;
    LAS float* tab = (LAS float*)(C.lds + 32768);
    unsigned char* WT = (unsigned char*)(C.ws + WS_WIN0);
    for (int item = (C.G >= 256 ? (int)blockIdx.x - 192 : (int)blockIdx.x); item >= 0 && item < 64; item += C.G) {
        const int kb = item >> 2, g = item & 3;
        __syncthreads();
        if (tid < 128) tab[tid] = cosf(6.283185307179586f * (float)tid * (1.0f / 128.0f));
        for (int i = tid; i < 64 * 128; i += 512) { const int kk = i >> 7, c = i & 127; Wl[i] = C.a->in[IN_EVWIN][(size_t)(kb * 64 + kk) * 3616 + 3104 + g * 128 + c]; }
        __syncthreads();
        const int cp = tid & 127, kq = tid >> 7; const bool isS = cp > 64; const int cq = isS ? cp - 64 : cp, shf = isS ? 96 : 0;
        float ac[16];
#pragma unroll
        for (int i = 0; i < 16; ++i) ac[i] = 0.f;
#pragma unroll 4
        for (int c = 0; c < 128; ++c) { const float tr = tab[(c * cq + shf) & 127];
#pragma unroll
            for (int i = 0; i < 16; ++i) ac[i] += Wl[(kq * 16 + i) * 128 + c] * tr; }
        if (F8_IN0) {
            unsigned char* pc = WT + (size_t)(3072 + g * 128 + cp) * 1024 + kb * 64 + kq * 16;
            *(u32x4*)pc = (u32x4){pk4_fp8(ac[0], ac[1], ac[2], ac[3], 32.f), pk4_fp8(ac[4], ac[5], ac[6], ac[7], 32.f), pk4_fp8(ac[8], ac[9], ac[10], ac[11], 32.f), pk4_fp8(ac[12], ac[13], ac[14], ac[15], 32.f)};
        } else {
            bf16* pc = (bf16*)WT + (size_t)(3072 + g * 128 + cp) * 1024 + kb * 64 + kq * 16;
            *(u32x4*)pc = (u32x4){cvt_pk(ac[0], ac[1]), cvt_pk(ac[2], ac[3]), cvt_pk(ac[4], ac[5]), cvt_pk(ac[6], ac[7])}; *(u32x4*)(pc + 8) = (u32x4){cvt_pk(ac[8], ac[9]), cvt_pk(ac[10], ac[11]), cvt_pk(ac[12], ac[13]), cvt_pk(ac[14], ac[15])};
        }
    }
    __syncthreads();
}

__device__ __forceinline__ void p_norm0(const Ctx& C) {
    PH_IDS;
    const int gw = blockIdx.x * 8 + wave, NGW = C.G * 8;
    const int per = (MALL + NGW - 1) / NGW;
    const int r0 = gw * per, r1 = (r0 + per < MALL) ? r0 + per : MALL;
    const float* MOD = (const float*)(C.ws + WS_MOD);
    const float* g = C.a->in[IN_NMPRE];
    unsigned char* HN = (unsigned char*)(C.ws + WS_HN);
    int curb = -1; f32x4 A[4], B[4];
    for (int r = r0; r < r1; ++r) {
        const int b = (r < MTOK) ? (r >> 13) : 8;
        if (b != curb) { curb = b;
#pragma unroll
            for (int j = 0; j < 4; ++j) { const int c = 4 * lane + 256 * j;
                const f32x4 gg = *(const f32x4*)(g + c), sc = *(const f32x4*)(MOD + (size_t)b * 6144 + 1024 + c), sh = *(const f32x4*)(MOD + (size_t)b * 6144 + c);
                A[j] = gg * (sc + 1.0f); B[j] = sh; } }
        const float* xr = (r < MTOK) ? (C.a->in[IN_X] + (size_t)r * 1024) : (C.a->in[IN_CTX] + (size_t)(r - MTOK) * 1024);
        f32x4 v[4]; float ss = 0.f;
#pragma unroll
        for (int j = 0; j < 4; ++j) { v[j] = *(const f32x4*)(xr + 4 * lane + 256 * j); ss += v[j][0] * v[j][0] + v[j][1] * v[j][1] + v[j][2] * v[j][2] + v[j][3] * v[j][3]; }
        const float rstd = rsqrtf(wave_sum(ss) * (1.0f / 1024.0f) + EPS);
#pragma unroll
        for (int j = 0; j < 4; ++j) { const f32x4 h = v[j] * rstd * A[j] + B[j];
            if (F8_IN0) *(unsigned*)(HN + (size_t)r * 1024 + 4 * lane + 256 * j) = pk4_fp8(h[0], h[1], h[2], h[3], 8.f);
            else *(u32x2*)((bf16*)HN + (size_t)r * 1024 + 4 * lane + 256 * j) = (u32x2){cvt_pk(h[0], h[1]), cvt_pk(h[2], h[3])}; }
    }
}

namespace glap {
constexpr int H_BYTES = 72704;
constexpr int O_RAW = 0, O_BC = 2048, O_TOT = 34816, O_QP = 36864, O_KP = 54272;
constexpr int NUNIT = 2 * 4 * 8 * 132;
}
__device__ __forceinline__ int gla_row(int bt, int dir, int s, int i) {
    const int ii = dir ? 63 - i : i;
    if (s < 4) { const int ci = dir ? 3 - s : s; return MTOK + bt * CTXL + ci * 64 + ii; }
    const int n = s - 4, ci = dir ? 127 - n : n; return bt * SEQ + ci * 64 + ii;
}
__device__ __forceinline__ void p_gla_prep(const Ctx& C, const int pv = 0) {
    PH_IDS;
    using namespace glap;
    const int half = tid >> 8, th = tid & 255, wh = wave & 3;
    LAS unsigned char* L = C.lds + half * H_BYTES;
    const bf16* Qg = (const bf16*)(C.ws + WS_Q); const bf16* Kg = (const bf16*)(C.ws + WS_K); const bf16* LRg = (const bf16*)(C.ws + WS_LR);
    bf16* QPg = (bf16*)(C.ws + WS_GQP); bf16* KPPg = (bf16*)(C.ws + WS_GKPP); bf16* SCg = (bf16*)(C.ws + WS_GSC); float* ELg = (float*)(C.ws + WS_GEL);
    const int niter = (NUNIT + 2 * C.G - 1) / (2 * C.G);
    const int lj = th >> 2, part = th & 3;
    u32x4 nq[4], nk[4], nlr; float nup[8], nbias;
    auto unit_of = [&](int itn) -> int { const int U = (itn * C.G + (int)blockIdx.x) * 2 + half; return U < NUNIT ? U : NUNIT - 1; };
    auto issue_loads = [&](int Uc) {
        const int sstep = Uc % 132, bt = (Uc / 132) & 7, hd = (Uc / (132 * 8)) & 3, dir = Uc / (132 * 32);
#pragma unroll
        for (int q = 0; q < 4; ++q) { const int c = th + 256 * q; const int row = gla_row(bt, dir, sstep, c >> 4);
            nk[q] = *(const u32x4*)(Kg + (size_t)row * 512 + hd * 128 + (c & 15) * 8);
            nq[q] = *(const u32x4*)(Qg + (size_t)(sstep >= 4 ? row : 0) * 512 + hd * 128 + (c & 15) * 8); }
        if (th < 128) { const int r2 = gla_row(bt, dir, sstep, th >> 1); nlr = *(const u32x4*)(LRg + (size_t)r2 * 32 + dir * 16 + (th & 1) * 8); }
        const float* up = C.a->in[IN_EVGKUP] + (size_t)dir * 16 * 512 + hd * 128 + 32 * wh + (lane & 31);
#pragma unroll
        for (int q = 0; q < 8; ++q) nup[q] = up[(size_t)(8 * (lane >> 5) + q) * 512];
        nbias = C.a->in[IN_EVGKB][dir * 512 + hd * 128 + 32 * wh + (lane & 31)]; };
    issue_loads(unit_of(0));
    for (int itn = 0; itn < niter; ++itn) {
        const int U = (itn * C.G + (int)blockIdx.x) * 2 + half;
        const bool act = U < NUNIT;
        const int Uc = act ? U : NUNIT - 1;
        const int sstep = Uc % 132;
        const bool latent = sstep >= 4;
        u32x4 rq[4], rk[4], rlr = nlr;
#pragma unroll
        for (int q = 0; q < 4; ++q) { rq[q] = nq[q]; rk[q] = nk[q]; }
        bf16x8 upf; const float gbias = nbias;
        { unsigned short tmp[8];
#pragma unroll
          for (int q = 0; q < 8; ++q) tmp[q] = (unsigned short)f2bf(nup[q]);
          upf = (bf16x8){(short)tmp[0], (short)tmp[1], (short)tmp[2], (short)tmp[3], (short)tmp[4], (short)tmp[5], (short)tmp[6], (short)tmp[7]}; }
        if (itn + 1 < niter) issue_loads(unit_of(itn + 1));
        __syncthreads();
        if (th < 128) *(LAS u32x4*)(L + O_RAW + (th >> 1) * 32 + (th & 1) * 16) = rlr;
        __syncthreads();
#pragma unroll
        for (int jb = 0; jb < 2; ++jb) {
            const bf16x8 af = *(const LAS bf16x8*)(L + O_RAW + (32 * jb + (lane & 31)) * 32 + (lane >> 5) * 16);
            f32x16 z;
#pragma unroll
            for (int i = 0; i < 16; ++i) z[i] = 0.f;
            z = __builtin_amdgcn_mfma_f32_32x32x16_bf16(af, upf, z, 0, 0, 0);
#pragma unroll
            for (int r = 0; r < 16; ++r) { const int j = 32 * jb + (r & 3) + 8 * (r >> 2) + 4 * (lane >> 5); const float zz = z[r] + gbias;
                const float ls = fminf(zz, 0.f) - __logf(1.0f + __expf(-fabsf(zz)));
                *(LAS float*)(L + O_BC + (j * 128 + 32 * wh + (lane & 31)) * 4) = ls * 0.0625f; } }
        __syncthreads();
        { const int dk = th & 127;
          float run0 = 0.f, run1 = 0.f; const int g0 = th >> 7, g1 = g0 + 2;
          float v0[16], v1[16];
#pragma unroll
          for (int q = 0; q < 16; ++q) { v0[q] = *(const LAS float*)(L + O_BC + ((16 * g0 + q) * 128 + dk) * 4); v1[q] = *(const LAS float*)(L + O_BC + ((16 * g1 + q) * 128 + dk) * 4); }
#pragma unroll
          for (int q = 0; q < 16; ++q) { run0 += v0[q]; run1 += v1[q];
              *(LAS float*)(L + O_BC + ((16 * g0 + q) * 128 + dk) * 4) = run0; *(LAS float*)(L + O_BC + ((16 * g1 + q) * 128 + dk) * 4) = run1; }
          *(LAS float*)(L + O_TOT + (g0 * 128 + dk) * 4) = run0; *(LAS float*)(L + O_TOT + (g1 * 128 + dk) * 4) = run1; }
        __syncthreads();
        {
#pragma unroll
          for (int q8 = 0; q8 < 4; ++q8) {
              const int c = th + 256 * q8, cj = c >> 4, jg = cj >> 4, dkc = (c & 15) * 8;
              u32x4 oq, okpp;
#pragma unroll
              for (int hq = 0; hq < 2; ++hq) {
                  const int dk0 = dkc + 4 * hq;
                  f32x4 b = *(const LAS f32x4*)(L + O_BC + (cj * 128 + dk0) * 4), tt = (f32x4){0.f, 0.f, 0.f, 0.f};
#pragma unroll
                  for (int g2 = 0; g2 < 4; ++g2) { const f32x4 tv = *(const LAS f32x4*)(L + O_TOT + (g2 * 128 + dk0) * 4); tt += tv; if (g2 < jg) b += tv; }
                  f32x4 e1, e2, e3;
#pragma unroll
                  for (int i = 0; i < 4; ++i) { if (pv & 4) { e1[i] = b[i]; e2[i] = -b[i]; e3[i] = tt[i] - b[i]; } else { e1[i] = __expf(b[i]); e2[i] = __expf(-b[i]); e3[i] = __expf(tt[i] - b[i]); } }
                  if (cj == 0 && act && !(pv & 1)) { f32x4 el;
#pragma unroll
                      for (int i = 0; i < 4; ++i) el[i] = __expf(tt[i]);
                      *(f32x4*)(ELg + (size_t)Uc * 128 + dk0) = el; }
                  const unsigned qa = hq ? rq[q8].z : rq[q8].x, qb = hq ? rq[q8].w : rq[q8].y;
                  const unsigned ka = hq ? rk[q8].z : rk[q8].x, kb = hq ? rk[q8].w : rk[q8].y;
                  const float q0 = bf_lo(qa), q1 = bf_hi(qa), q2 = bf_lo(qb), q3 = bf_hi(qb);
                  const float k0 = bf_lo(ka), k1 = bf_hi(ka), k2 = bf_lo(kb), k3 = bf_hi(kb);
                  u32x2 o;
                  o.x = cvt_pk(q0 * e1[0], q1 * e1[1]); o.y = cvt_pk(q2 * e1[2], q3 * e1[3]); *(LAS u32x2*)(L + O_QP + cj * 272 + dk0 * 2) = o;
                  if (hq) { oq.z = o.x; oq.w = o.y; } else { oq.x = o.x; oq.y = o.y; }
                  o.x = cvt_pk(k0 * e2[0], k1 * e2[1]); o.y = cvt_pk(k2 * e2[2], k3 * e2[3]); *(LAS u32x2*)(L + O_KP + cj * 272 + dk0 * 2) = o;
                  o.x = cvt_pk(k0 * e3[0], k1 * e3[1]); o.y = cvt_pk(k2 * e3[2], k3 * e3[3]);
                  if (hq) { okpp.z = o.x; okpp.w = o.y; } else { okpp.x = o.x; okpp.y = o.y; }
              }
              if (act && !(pv & 1)) { *(u32x4*)(KPPg + (size_t)Uc * 8192 + c * 8) = okpp; if (latent) *(u32x4*)(QPg + (size_t)Uc * 8192 + c * 8) = oq; }
              else asm volatile("" :: "v"(okpp), "v"(oq));
          } }
        __syncthreads();
        if (latent && act && !(pv & 2)) {
            const int ib = wh;
            for (int jb16 = 0; jb16 <= ib; ++jb16) {
                f32x4 d = (f32x4){0.f, 0.f, 0.f, 0.f};
#pragma unroll
                for (int ks = 0; ks < 4; ++ks) {
                    const bf16x8 a = *(const LAS bf16x8*)(L + O_KP + (16 * jb16 + (lane & 15)) * 272 + (32 * ks + 8 * (lane >> 4)) * 2);
                    const bf16x8 bq = *(const LAS bf16x8*)(L + O_QP + (16 * ib + (lane & 15)) * 272 + (32 * ks + 8 * (lane >> 4)) * 2);
                    d = __builtin_amdgcn_mfma_f32_16x16x32_bf16(a, bq, d, 0, 0, 0); }
                const int i = 16 * ib + (lane & 15), j0 = 16 * jb16 + 4 * (lane >> 4);
#pragma unroll
                for (int r = 0; r < 4; ++r) if (j0 + r > i) d[r] = 0.f;
                u32x2 o; o.x = cvt_pk(d[0], d[1]); o.y = cvt_pk(d[2], d[3]);
                if (!(pv & 1)) *(u32x2*)(SCg + (size_t)Uc * 4096 + i * 64 + j0) = o; else asm volatile("" :: "v"(o));
            }
            for (int jb16 = ib + 1; jb16 < 4; ++jb16) { const int i = 16 * ib + (lane & 15), j0 = 16 * jb16 + 4 * (lane >> 4);
                if (!(pv & 1)) *(u32x2*)(SCg + (size_t)Uc * 4096 + i * 64 + j0) = (u32x2){0u, 0u}; }
        }
    }
    __syncthreads();
}
namespace gla {
constexpr int O_EL = 0, O_QP = 512, O_KPP = 17920, O_V = 38400, O_SC = 50688, IMG_BYTES = 59904, O_ST = 2 * IMG_BYTES;
constexpr int P_QP = 272, P_KPP = 320, P_V = 192, P_SC = 144, P_ST = 272, ST_BYTES = 64 * 272;
__device__ __forceinline__ bf16x8 tr8(LAS unsigned char* p0, LAS unsigned char* p1) {
    const s16x4 a = __builtin_amdgcn_ds_read_tr16_b64_v4i16((LAS s16x4*)p0);
    const s16x4 b = __builtin_amdgcn_ds_read_tr16_b64_v4i16((LAS s16x4*)p1);
    return (bf16x8){a[0], a[1], a[2], a[3], b[0], b[1], b[2], b[3]};
}
}
__device__ __forceinline__ void p_gla(const Ctx& C, const int probe = 0) {
    PH_IDS;
    using namespace gla;
    LAS unsigned char* L = C.lds;
    const int t = tid, w = wave;
    const bf16* Vg = (const bf16*)(C.ws + WS_V);
    const bf16* QPg = (const bf16*)(C.ws + WS_GQP); const bf16* KPPg = (const bf16*)(C.ws + WS_GKPP); const bf16* SCg = (const bf16*)(C.ws + WS_GSC); const float* ELg = (const float*)(C.ws + WS_GEL);
    for (int it = blockIdx.x; it < 256; it += C.G) {
        const int xx = it & 7, jj_ = it >> 3, scan = xx * 8 + (jj_ >> 2), dvs = jj_ & 3;
        const int bt = scan >> 3, hd = (scan >> 1) & 3, dir = scan & 1;
        const int ubase = ((dir * 4 + hd) * 8 + bt) * 132;
        bf16* Og = (bf16*)(C.ws + (probe ? WS_HN : (dir ? WS_OB : WS_OF)));
        __syncthreads();
        for (int i = t; i < ST_BYTES / 16; i += 512) *(LAS u32x4*)(L + O_ST + i * 16) = (u32x4){0u, 0u, 0u, 0u};
        f32x16 S;
#pragma unroll
        for (int i = 0; i < 16; ++i) S[i] = 0.f;
        const int lj = t >> 3, part = t & 7;
        u32x4 rsc, rqp0, rqp1, rkp0, rkp1, rv; f32x4 rel;
        u32x4 nsc, nqp0, nqp1, nkp0, nkp1, nv; f32x4 nel;
        auto load_step = [&](int s_) {
            const int s = probe ? 4 + (s_ & 1) : s_;
            const size_t U = (size_t)(ubase + s);
            const int row = gla_row(bt, dir, s, lj);
            nv = *(const u32x4*)(Vg + (size_t)row * 1024 + hd * 256 + dvs * 64 + part * 8);
            const bf16* kp = KPPg + U * 8192 + t * 8; nkp0 = *(const u32x4*)kp; nkp1 = *(const u32x4*)(kp + 4096);
            if (t < 32) nel = *(const f32x4*)(ELg + U * 128 + t * 4);
            if (s >= 4) { const bf16* qp = QPg + U * 8192 + t * 8; nqp0 = *(const u32x4*)qp; nqp1 = *(const u32x4*)(qp + 4096);
                nsc = *(const u32x4*)(SCg + U * 4096 + lj * 64 + part * 8); } };
        auto shift_regs = [&]() { rsc = nsc; rqp0 = nqp0; rqp1 = nqp1; rkp0 = nkp0; rkp1 = nkp1; rv = nv; rel = nel; };
        auto write_images = [&](int s, int ib_) {
            LAS unsigned char* I = L + ib_ * IMG_BYTES;
            *(LAS u32x4*)(I + O_V + lj * P_V + part * 16) = rv;
            *(LAS u32x4*)(I + O_KPP + (t >> 4) * P_KPP + (t & 15) * 16) = rkp0; *(LAS u32x4*)(I + O_KPP + (32 + (t >> 4)) * P_KPP + (t & 15) * 16) = rkp1;
            if (t < 32) *(LAS f32x4*)(I + O_EL + t * 16) = rel;
            if (s >= 4) { *(LAS u32x4*)(I + O_QP + (t >> 4) * P_QP + (t & 15) * 16) = rqp0; *(LAS u32x4*)(I + O_QP + (32 + (t >> 4)) * P_QP + (t & 15) * 16) = rqp1;
                *(LAS u32x4*)(I + O_SC + lj * P_SC + part * 16) = rsc; } };
        load_step(0); shift_regs(); write_images(0, 0);
        load_step(1); shift_regs();
        load_step(2);
        for (int s = 0; s < 132; ++s) {
            const int cur = s & 1, nx = cur ^ 1;
            const bool latent = (s >= 4);
            LAS unsigned char* I = L + cur * IMG_BYTES;
            __syncthreads();
            if (s + 1 < 132) write_images(s + 1, nx);
            shift_regs();
            if (s + 3 < 132) load_step(s + 3);
            if (latent) {
                const int ib = w >> 1;
                const int g4 = lane >> 4, q4 = (lane & 15) >> 2, p4 = lane & 3;
                const int orow = gla_row(bt, dir, s, 16 * ib + (lane & 15));
#pragma unroll
                for (int cc = 0; cc < 2; ++cc) {
                    const int c = 2 * (w & 1) + cc;
                    f32x4 d = (f32x4){0.f, 0.f, 0.f, 0.f};
#pragma unroll
                    for (int ks = 0; ks < 2; ++ks) {
                        LAS unsigned char* pa = I + O_V + (32 * ks + 8 * g4 + q4) * P_V + (16 * c + 4 * p4) * 2;
                        const bf16x8 a = gla::tr8(pa, pa + 4 * P_V);
                        const bf16x8 b = *(const LAS bf16x8*)(I + O_SC + (16 * ib + (lane & 15)) * P_SC + (32 * ks + 8 * g4) * 2);
                        d = __builtin_amdgcn_mfma_f32_16x16x32_bf16(a, b, d, 0, 0, 0); }
#pragma unroll
                    for (int ks = 0; ks < 4; ++ks) {
                        const bf16x8 a = *(const LAS bf16x8*)(L + O_ST + cur * ST_BYTES + (16 * c + (lane & 15)) * P_ST + (32 * ks + 8 * g4) * 2);
                        const bf16x8 b = *(const LAS bf16x8*)(I + O_QP + (16 * ib + (lane & 15)) * P_QP + (32 * ks + 8 * g4) * 2);
                        d = __builtin_amdgcn_mfma_f32_16x16x32_bf16(a, b, d, 0, 0, 0); }
                    u32x2 o; o.x = cvt_pk(d[0], d[1]); o.y = cvt_pk(d[2], d[3]);
                    *(u32x2*)(Og + (size_t)orow * 1024 + hd * 256 + dvs * 64 + 16 * c + 4 * g4) = o;
                }
            }
            { const int dbS = w & 3, dvb = w >> 2, hh = lane >> 5, blk = (lane >> 4) & 1, q4 = (lane & 15) >> 2, p4 = lane & 3;
#pragma unroll
              for (int g = 0; g < 4; ++g) { const f32x4 el = *(const LAS f32x4*)(I + O_EL + (32 * dbS + 8 * g + 4 * hh) * 4);
#pragma unroll
                  for (int i = 0; i < 4; ++i) S[4 * g + i] *= el[i]; }
#pragma unroll
              for (int ks = 0; ks < 4; ++ks) {
                  LAS unsigned char* pa = I + O_KPP + (16 * ks + 8 * hh + q4) * P_KPP + (32 * dbS + 16 * blk + 4 * p4) * 2;
                  LAS unsigned char* pb = I + O_V + (16 * ks + 8 * hh + q4) * P_V + (32 * dvb + 16 * blk + 4 * p4) * 2;
                  const bf16x8 a = gla::tr8(pa, pa + 4 * P_KPP);
                  const bf16x8 b = gla::tr8(pb, pb + 4 * P_V);
                  S = __builtin_amdgcn_mfma_f32_32x32x16_bf16(a, b, S, 0, 0, 0); }
#pragma unroll
              for (int g = 0; g < 4; ++g) { u32x2 o; o.x = cvt_pk(S[4 * g], S[4 * g + 1]); o.y = cvt_pk(S[4 * g + 2], S[4 * g + 3]);
                  *(LAS u32x2*)(L + O_ST + nx * ST_BYTES + (32 * dvb + (lane & 31)) * P_ST + (32 * dbS + 8 * g + 4 * hh) * 2) = o; } }
        }
    }
}

__device__ __forceinline__ void p_fft1(const Ctx& C) {
    PH_IDS;
    LAS unsigned char* L = C.lds;
    const int t = tid, w = wave, mb = w & 3, nh = w >> 2, hh = lane >> 5;
    const bf16* F1 = (const bf16*)(C.ws + WS_F1);
    bf16x8 af[8];
#pragma unroll
    for (int ks = 0; ks < 8; ++ks) af[ks] = *(const bf16x8*)(F1 + (32 * mb + (lane & 31)) * 128 + 16 * ks + 8 * hh);
    const bf16* ZZ = (const bf16*)(C.ws + WS_ZC);
    bf16* YR = (bf16*)(C.ws + WS_YR); bf16* YI = (bf16*)(C.ws + WS_YI);
    const int blk = (lane >> 4) & 1, q4 = (lane & 15) >> 2, p4 = lane & 3;
    constexpr int RAWB = 73728;
    u32x4 pv[4];
    auto fetch1 = [&](int unit) { const int bt = unit >> 8, b = (unit >> 1) & 127, chh = unit & 1; const int a = t >> 3, part = t & 7;
        const bf16* src = ZZ + (size_t)(bt * SEQ + 128 * a + b) * 512 + chh * 256 + part * 32;
#pragma unroll
        for (int i = 0; i < 4; ++i) pv[i] = *(const u32x4*)(src + 8 * i); };
    if ((int)blockIdx.x < 2048) fetch1(blockIdx.x);
    for (int unit = blockIdx.x; unit < 2048; unit += C.G) {
        const int bt = unit >> 8, b = (unit >> 1) & 127, chh = unit & 1;
        __syncthreads();
        { const int a = t >> 3, part = t & 7;
#pragma unroll
          for (int i = 0; i < 4; ++i) *(LAS u32x4*)(L + RAWB + a * 528 + part * 64 + i * 16) = pv[i]; }
        __syncthreads();
        { const int row = t >> 2, quarter = t & 3, pin = row >> 6, a = row & 63, gl = quarter >> 1, half = quarter & 1;
          const LAS unsigned char* rp = L + RAWB + a * 528 + gl * 256;
#pragma unroll
          for (int ci = 0; ci < 8; ++ci) { unsigned wv[4];
#pragma unroll
              for (int j = 0; j < 8; ++j) { const int e = 8 * ci + j;
                  const int col = pin ? (half ? 128 - e : 64 + e) : (half ? (e == 0 ? 64 : 64 - e) : e);
                  unsigned v = (unsigned)*(const LAS unsigned short*)(rp + (col & 127) * 2);
                  if (pin && half) v ^= 0x8000u;
                  if (pin && e == 0) v = 0u;
                  if (j & 1) wv[j >> 1] |= v << 16; else wv[j >> 1] = v; }
              *(LAS u32x4*)(L + row * 576 + quarter * 128 + ci * 16) = (u32x4){wv[0], wv[1], wv[2], wv[3]}; } }
        __syncthreads();
        if (unit + C.G < 2048) fetch1(unit + C.G);
#pragma unroll 1
        for (int nb = 0; nb < 4; ++nb) {
            const int c = 4 * nh + nb;
            f32x16 acc;
#pragma unroll
            for (int i = 0; i < 16; ++i) acc[i] = 0.f;
#pragma unroll
            for (int ks = 0; ks < 8; ++ks) {
                LAS unsigned char* pb = L + (16 * ks + 8 * hh + q4) * 576 + (32 * c + 16 * blk + 4 * p4) * 2;
                const bf16x8 bfr = gla::tr8(pb, pb + 4 * 576);
                acc = __builtin_amdgcn_mfma_f32_32x32x16_bf16(af[ks], bfr, acc, 0, 0, 0); }
#pragma unroll
            for (int gp = 0; gp < 2; ++gp)
#pragma unroll
                for (int i = 0; i < 4; ++i) { const int ap = 16 * mb + 8 * gp + 4 * hh + i; const float re = acc[8 * gp + i], im = acc[8 * gp + 4 + i];
                    const float ph = (float)((b * ap) & 8191) * (1.0f / 8192.0f); const float cs = __builtin_amdgcn_cosf(ph), sn = __builtin_amdgcn_sinf(ph);
                    const int so = ap * 528 + (32 * c + (lane & 31)) * 2;
                    *(LAS unsigned short*)(L + 73728 + so) = (unsigned short)f2bf(re * cs + im * sn);
                    *(LAS unsigned short*)(L + 73728 + 64 * 528 + so) = (unsigned short)f2bf(im * cs - re * sn); }
        }
        __syncthreads();
        { const int orow = t >> 2, quarter = t & 3, plane = orow >> 6, ap = orow & 63;
          bf16* dst = (plane ? YI : YR) + ((size_t)(bt * 64 + ap) * 128 + b) * 512 + chh * 256 + quarter * 64;
#pragma unroll
          for (int i = 0; i < 8; ++i) *(u32x4*)(dst + 8 * i) = *(const LAS u32x4*)(L + 73728 + orow * 528 + quarter * 128 + i * 16); }
    }
    __syncthreads();
}
__device__ __forceinline__ void p_fft2(const Ctx& C) {
    PH_IDS;
    LAS unsigned char* L = C.lds;
    const int t = tid, w = wave, mb = w & 3, nh = w >> 2, hh = lane >> 5;
    const bf16* F2 = (const bf16*)(C.ws + WS_F2);
    bf16x8 af[16];
#pragma unroll
    for (int ks = 0; ks < 16; ++ks) af[ks] = *(const bf16x8*)(F2 + (32 * mb + (lane & 31)) * 256 + 16 * ks + 8 * hh);
    const bf16* YR = (const bf16*)(C.ws + WS_YR); const bf16* YI = (const bf16*)(C.ws + WS_YI);
    unsigned char* A2 = (unsigned char*)(C.ws + WS_A2);
    const int blk = (lane >> 4) & 1, q4 = (lane & 15) >> 2, p4 = lane & 3;
    u32x4 pv[8];
    auto fetch2 = [&](int unit) { const int bt = unit >> 8, ap = (unit >> 2) & 63, cht = unit & 3; const int row = t >> 1, half = t & 1, pin = row >> 7, b = row & 127;
        const bf16* src = (pin ? YI : YR) + ((size_t)(bt * 64 + ap) * 128 + b) * 512 + cht * 128 + half * 64;
#pragma unroll
        for (int i = 0; i < 8; ++i) pv[i] = *(const u32x4*)(src + 8 * i); };
    if ((int)blockIdx.x < 2048) fetch2(blockIdx.x);
    for (int unit = blockIdx.x; unit < 2048; unit += C.G) {
        const int bt = unit >> 8, ap = (unit >> 2) & 63, cht = unit & 3;
        __syncthreads();
        { const int row = t >> 1, half = t & 1;
#pragma unroll
          for (int i = 0; i < 8; ++i) *(LAS u32x4*)(L + row * 320 + half * 128 + i * 16) = pv[i]; }
        __syncthreads();
        if (unit + C.G < 2048) fetch2(unit + C.G);
#pragma unroll 1
        for (int nb = 0; nb < 2; ++nb) {
            const int c = 2 * nh + nb;
            f32x16 acc;
#pragma unroll
            for (int i = 0; i < 16; ++i) acc[i] = 0.f;
#pragma unroll
            for (int ks = 0; ks < 16; ++ks) {
                LAS unsigned char* pb = L + (16 * ks + 8 * hh + q4) * 320 + (32 * c + 16 * blk + 4 * p4) * 2;
                const bf16x8 bfr = gla::tr8(pb, pb + 4 * 320);
                acc = __builtin_amdgcn_mfma_f32_32x32x16_bf16(af[ks], bfr, acc, 0, 0, 0); }
#pragma unroll
            for (int r = 0; r < 16; ++r) { const int bp = 32 * mb + (r & 3) + 8 * (r >> 2) + 4 * hh;
                if (F8_OUT0) *(LAS unsigned char*)(L + 81920 + bp * 144 + 32 * c + (lane & 31)) = (unsigned char)(pk4_fp8(acc[r], 0.f, 0.f, 0.f, 8.0f / 1024.0f) & 0xffu);
                else *(LAS unsigned short*)(L + 81920 + bp * 272 + (32 * c + (lane & 31)) * 2) = (unsigned short)f2bf(acc[r] * (1.0f / 1024.0f)); }
        }
        __syncthreads();
        { const int bp = t >> 2, quarter = t & 3; const size_t tok = (size_t)bt * SEQ + ap + 64 * bp;
          if (F8_OUT0) { unsigned char* dst = A2 + tok * 1536 + 1024 + cht * 128 + quarter * 32;
#pragma unroll
              for (int i = 0; i < 2; ++i) *(u32x4*)(dst + 16 * i) = *(const LAS u32x4*)(L + 81920 + bp * 144 + quarter * 32 + i * 16); }
          else { bf16* dst = (bf16*)A2 + tok * 1536 + 1024 + cht * 128 + quarter * 32;
#pragma unroll
              for (int i = 0; i < 4; ++i) *(u32x4*)(dst + 8 * i) = *(const LAS u32x4*)(L + 81920 + bp * 272 + quarter * 64 + i * 16); } }
    }
    __syncthreads();
}
__device__ __forceinline__ void p_gla_out(const Ctx& C) {
    PH_IDS;
    const int gw = blockIdx.x * 8 + wave, NGW = C.G * 8;
    const bf16* OF = (const bf16*)(C.ws + WS_OF); const bf16* OB = (const bf16*)(C.ws + WS_OB); const bf16* Rg = (const bf16*)(C.ws + WS_R);
    unsigned char* A2 = (unsigned char*)(C.ws + WS_A2);
    float gn[16];
#pragma unroll
    for (int i = 0; i < 16; ++i) gn[i] = C.a->in[IN_EVGNORM][16 * (lane & 15) + i];
    for (int r = gw; r < MTOK; r += NGW) {
        const u32x4 f0 = *(const u32x4*)(OF + (size_t)r * 1024 + 16 * lane), f1 = *(const u32x4*)(OF + (size_t)r * 1024 + 16 * lane + 8);
        const u32x4 b0 = *(const u32x4*)(OB + (size_t)r * 1024 + 16 * lane), b1 = *(const u32x4*)(OB + (size_t)r * 1024 + 16 * lane + 8);
        const u32x4 g0 = *(const u32x4*)(Rg + (size_t)r * 1024 + 16 * lane), g1 = *(const u32x4*)(Rg + (size_t)r * 1024 + 16 * lane + 8);
        float o[16], rr[16];
#pragma unroll
        for (int i = 0; i < 4; ++i) { const unsigned fa = f0[i], fb = f1[i], ba = b0[i], bb = b1[i], ga = g0[i], gb = g1[i];
            o[2 * i] = bf_lo(fa) + bf_lo(ba); o[2 * i + 1] = bf_hi(fa) + bf_hi(ba); o[8 + 2 * i] = bf_lo(fb) + bf_lo(bb); o[8 + 2 * i + 1] = bf_hi(fb) + bf_hi(bb);
            rr[2 * i] = bf_lo(ga); rr[2 * i + 1] = bf_hi(ga); rr[8 + 2 * i] = bf_lo(gb); rr[8 + 2 * i + 1] = bf_hi(gb); }
        float ss = 0.f;
#pragma unroll
        for (int i = 0; i < 16; ++i) ss += o[i] * o[i];
        ss = row16_sum(ss);
        const float rstd = rsqrtf(ss * (1.0f / 256.0f) + EPS);
        float y[16];
#pragma unroll
        for (int i = 0; i < 16; ++i) y[i] = o[i] * rstd * gn[i] * siluf_(rr[i]);
        if (F8_OUT0) *(u32x4*)(A2 + (size_t)r * 1536 + 16 * lane) = (u32x4){pk4_fp8(y[0], y[1], y[2], y[3], 8.f), pk4_fp8(y[4], y[5], y[6], y[7], 8.f), pk4_fp8(y[8], y[9], y[10], y[11], 8.f), pk4_fp8(y[12], y[13], y[14], y[15], 8.f)};
        else { bf16* a2 = (bf16*)A2 + (size_t)r * 1536 + 16 * lane;
            *(u32x4*)a2 = (u32x4){cvt_pk(y[0], y[1]), cvt_pk(y[2], y[3]), cvt_pk(y[4], y[5]), cvt_pk(y[6], y[7])}; *(u32x4*)(a2 + 8) = (u32x4){cvt_pk(y[8], y[9]), cvt_pk(y[10], y[11]), cvt_pk(y[12], y[13]), cvt_pk(y[14], y[15])}; }
    }
}

__device__ __forceinline__ void p_postmix(const Ctx& C, const int layer) {
    PH_IDS;
    LAS float* WR = (LAS float*)C.lds;
    LAS int* hist = (LAS int*)(C.lds + 131072);
    LAS float* Lg = (LAS float*)(C.lds + 131584 + wave * 2112);
    const float* rw = C.a->in[IN_RW] + (size_t)layer * 1024 * 32;
    __syncthreads();
    for (int it0 = 0; it0 < 64; it0 += 16) {
        float tmpw[16];
#pragma unroll
        for (int q = 0; q < 16; ++q) tmpw[q] = rw[tid + 512 * (it0 + q)];
#pragma unroll
        for (int q = 0; q < 16; ++q) { const int idx = tid + 512 * (it0 + q); const int c = idx >> 5, e = idx & 31; const int ln = (c & 255) >> 2, j = c >> 8, i = c & 3;
            WR[(((j * 4 + i) * 8 + (e >> 2)) * 64 + ln) * 4 + (e & 3)] = tmpw[q]; } }
    if (tid < 32) hist[tid] = 0;
    __syncthreads();
    const float* MOD = (const float*)(C.ws + WS_MOD) + (size_t)layer * 9 * 6144;
    const float* gpost = C.a->in[IN_NMPOST] + layer * 1024; const float* gffn = C.a->in[IN_NFPRE] + layer * 1024;
    const bf16* Y = (const bf16*)(C.ws + WS_Y);
    const float* xin = C.a->in[IN_X];
    bf16* XS = (bf16*)(C.ws + WS_XS);
    unsigned char* H2 = (unsigned char*)(C.ws + WS_H2);
    int* TK = (int*)(C.ws + WS_TOPK); float* GT = (float*)(C.ws + WS_GATE);
    const int rows_per_blk = MTOK / C.G, rows_per_wave = rows_per_blk / 8;
    const int r0 = blockIdx.x * rows_per_blk + wave * rows_per_wave;
    const int b = r0 >> 13;
    const float rbias = C.a->in[IN_RB][layer * 32 + ((lane >> 1) & 31)];
    float cA1[16], cA2[16], cB2[16];
#pragma unroll
    for (int j = 0; j < 4; ++j) { const int c = 4 * lane + 256 * j;
        const f32x4 gp = *(const f32x4*)(gpost + c), gm = *(const f32x4*)(MOD + (size_t)b * 6144 + 2048 + c);
        const f32x4 gf = *(const f32x4*)(gffn + c), sc = *(const f32x4*)(MOD + (size_t)b * 6144 + 4096 + c), sh = *(const f32x4*)(MOD + (size_t)b * 6144 + 3072 + c);
#pragma unroll
        for (int i = 0; i < 4; ++i) { cA1[4 * j + i] = gp[i] * gm[i]; cA2[4 * j + i] = gf[i] * (1.0f + sc[i]); cB2[4 * j + i] = sh[i]; } }
    auto ldx = [&](int r, int j) -> f32x4 {
        if (layer == 0) return *(const f32x4*)(xin + (size_t)r * 1024 + 4 * lane + 256 * j);
        const u32x2 v = *(const u32x2*)(XS + (size_t)r * 1024 + 4 * lane + 256 * j); return (f32x4){bf_lo(v.x), bf_hi(v.x), bf_lo(v.y), bf_hi(v.y)}; };
    u32x2 ny[4]; f32x4 nx[4];
#pragma unroll
    for (int j = 0; j < 4; ++j) { ny[j] = *(const u32x2*)(Y + (size_t)r0 * 1024 + 4 * lane + 256 * j); nx[j] = ldx(r0, j); }
    for (int r = r0; r < r0 + rows_per_wave; ++r) {
        float h[16];
        u32x2 cy[4]; f32x4 cx[4];
#pragma unroll
        for (int j = 0; j < 4; ++j) { cy[j] = ny[j]; cx[j] = nx[j]; }
        if (r + 1 < r0 + rows_per_wave) {
#pragma unroll
            for (int j = 0; j < 4; ++j) { ny[j] = *(const u32x2*)(Y + (size_t)(r + 1) * 1024 + 4 * lane + 256 * j); nx[j] = ldx(r + 1, j); } }
        { float ssy = 0.f; float yv[16];
#pragma unroll
          for (int j = 0; j < 4; ++j) { const u32x2 yy = cy[j];
              yv[4 * j] = bf_lo(yy.x); yv[4 * j + 1] = bf_hi(yy.x); yv[4 * j + 2] = bf_lo(yy.y); yv[4 * j + 3] = bf_hi(yy.y); }
#pragma unroll
          for (int i = 0; i < 16; ++i) ssy += yv[i] * yv[i];
          const float rstd = rsqrtf(wave_sum(ssy) * (1.0f / 1024.0f) + EPS);
          float ss1 = 0.f;
#pragma unroll
          for (int j = 0; j < 4; ++j) { const int c = 4 * lane + 256 * j;
              const f32x4 xv = cx[j];
              f32x4 o;
#pragma unroll
              for (int i = 0; i < 4; ++i) { o[i] = xv[i] + cA1[4 * j + i] * (yv[4 * j + i] * rstd); h[4 * j + i] = o[i]; ss1 += o[i] * o[i]; }
              { u32x2 xw; xw.x = cvt_pk(o[0], o[1]); xw.y = cvt_pk(o[2], o[3]); *(u32x2*)(XS + (size_t)r * 1024 + c) = xw; } }
          const float rstd1 = rsqrtf(wave_sum(ss1) * (1.0f / 1024.0f) + EPS);
#pragma unroll
          for (int j = 0; j < 4; ++j) { const int c = 4 * lane + 256 * j;
#pragma unroll
              for (int i = 0; i < 4; ++i) h[4 * j + i] = h[4 * j + i] * rstd1 * cA2[4 * j + i] + cB2[4 * j + i];
              int wv = 0;
              wv = __builtin_amdgcn_cvt_pk_fp8_f32(fminf(fmaxf(h[4 * j] * 8.0f, -440.f), 440.f), fminf(fmaxf(h[4 * j + 1] * 8.0f, -440.f), 440.f), wv, false);
              wv = __builtin_amdgcn_cvt_pk_fp8_f32(fminf(fmaxf(h[4 * j + 2] * 8.0f, -440.f), 440.f), fminf(fmaxf(h[4 * j + 3] * 8.0f, -440.f), 440.f), wv, true);
              *(int*)(H2 + (size_t)r * 1024 + c) = wv; } }
        float p[32];
#pragma unroll
        for (int e = 0; e < 32; ++e) p[e] = 0.f;
        { f32x4 wb[2][8];
#pragma unroll
          for (int eq = 0; eq < 8; ++eq) wb[0][eq] = *(const LAS f32x4*)(WR + ((0 * 8 + eq) * 64 + lane) * 4);
#pragma unroll
          for (int jj = 0; jj < 16; ++jj) {
              if (jj + 1 < 16) {
#pragma unroll
                  for (int eq = 0; eq < 8; ++eq) wb[(jj + 1) & 1][eq] = *(const LAS f32x4*)(WR + (((jj + 1) * 8 + eq) * 64 + lane) * 4); }
#pragma unroll
              for (int eq = 0; eq < 8; ++eq)
#pragma unroll
                  for (int i = 0; i < 4; ++i) p[4 * eq + i] += h[jj] * wb[jj & 1][eq][i];
              asm volatile("" ::: "memory"); } }
        float q16[16], q8[8], q4v[4], q2[2], q1;
#pragma unroll
        for (int k = 0; k < 16; ++k) q16[k] = swap32_sum(p[k], p[16 + k]);
#pragma unroll
        for (int k = 0; k < 8; ++k) q8[k] = swap16_sum(q16[k], q16[8 + k]);
        { const bool hi = (lane & 8) != 0;
#pragma unroll
          for (int k = 0; k < 4; ++k) { const float send = hi ? q8[k] : q8[4 + k], keep = hi ? q8[4 + k] : q8[k];
              q4v[k] = keep + __builtin_bit_cast(float, __builtin_amdgcn_update_dpp(0, __builtin_bit_cast(int, send), 0x128, 0xF, 0xF, true)); } }
        { const bool hi = (lane & 4) != 0;
#pragma unroll
          for (int k = 0; k < 2; ++k) { const float send = hi ? q4v[k] : q4v[2 + k], keep = hi ? q4v[2 + k] : q4v[k];
              int rv = __builtin_amdgcn_update_dpp(0, __builtin_bit_cast(int, send), 0x104, 0xF, 0x5, false);
              rv = __builtin_amdgcn_update_dpp(rv, __builtin_bit_cast(int, send), 0x114, 0xF, 0xA, false);
              q2[k] = keep + __builtin_bit_cast(float, rv); } }
        { const bool hi = (lane & 2) != 0; const float send = hi ? q2[0] : q2[1], keep = hi ? q2[1] : q2[0];
          q1 = keep + __builtin_bit_cast(float, __builtin_amdgcn_update_dpp(0, __builtin_bit_cast(int, send), 0x4E, 0xF, 0xF, true)); }
        q1 += __builtin_bit_cast(float, __builtin_amdgcn_update_dpp(0, __builtin_bit_cast(int, q1), 0xB1, 0xF, 0xF, true));
        const int rl = (r - r0) & 15;
        if (!(lane & 1)) Lg[rl * 33 + (lane >> 1)] = q1 + rbias;
        if (rl == 15) {
            asm volatile("s_waitcnt lgkmcnt(0)" ::: "memory");
            if (lane < 16) {
                float v0 = -3.0e38f, v1 = -3.0e38f, v2 = -3.0e38f, v3 = -3.0e38f; int i0 = 0, i1 = 0, i2 = 0, i3 = 0;
#pragma unroll
                for (int e = 0; e < 32; ++e) { const float x = Lg[lane * 33 + e];
                    const bool c0 = x > v0, c1 = x > v1, c2 = x > v2, c3 = x > v3;
                    v3 = c3 ? (c2 ? v2 : x) : v3; i3 = c3 ? (c2 ? i2 : e) : i3;
                    v2 = c2 ? (c1 ? v1 : x) : v2; i2 = c2 ? (c1 ? i1 : e) : i2;
                    v1 = c1 ? (c0 ? v0 : x) : v1; i1 = c1 ? (c0 ? i0 : e) : i1;
                    v0 = c0 ? x : v0; i0 = c0 ? e : i0; }
                const float e1 = __expf(v1 - v0), e2 = __expf(v2 - v0), e3 = __expf(v3 - v0); const float inv = 1.0f / (1.0f + e1 + e2 + e3);
                const int rr = r - 15 + lane;
                *(int4*)(TK + (size_t)rr * 4) = make_int4(i0, i1, i2, i3); *(f32x4*)(GT + (size_t)rr * 4) = (f32x4){inv, e1 * inv, e2 * inv, e3 * inv};
                __hip_atomic_fetch_add(&hist[i0], 1, __ATOMIC_RELAXED, __HIP_MEMORY_SCOPE_WORKGROUP); __hip_atomic_fetch_add(&hist[i1], 1, __ATOMIC_RELAXED, __HIP_MEMORY_SCOPE_WORKGROUP);
                __hip_atomic_fetch_add(&hist[i2], 1, __ATOMIC_RELAXED, __HIP_MEMORY_SCOPE_WORKGROUP); __hip_atomic_fetch_add(&hist[i3], 1, __ATOMIC_RELAXED, __HIP_MEMORY_SCOPE_WORKGROUP);
            }
            asm volatile("s_waitcnt lgkmcnt(0)" ::: "memory");
        }
    }
    __syncthreads();
    if (tid < 32) ((int*)(C.ws + WS_CNTBLK))[blockIdx.x * 32 + tid] = hist[tid];
    __syncthreads();
}
__device__ __forceinline__ void p_assign(const Ctx& C) {
    PH_IDS;
    LAS int* red = (LAS int*)C.lds;
    LAS int* base = (LAS int*)(C.lds + 4096);
    LAS int* total = (LAS int*)(C.lds + 4224);
    LAS int* segrow = (LAS int*)(C.lds + 4352);
    LAS int* run = (LAS int*)(C.lds + 4608);
    const int* cnt = (const int*)(C.ws + WS_CNTBLK);
    const int b = blockIdx.x;
    __syncthreads();
    { const int e = tid & 31, part = tid >> 5; int slt = 0, sall = 0;
      int vv[16];
#pragma unroll
      for (int q = 0; q < 16; ++q) vv[q] = __hip_atomic_load(cnt + (part * 16 + q) * 32 + e, __ATOMIC_RELAXED, __HIP_MEMORY_SCOPE_AGENT);
#pragma unroll
      for (int q = 0; q < 16; ++q) { sall += vv[q]; if (part * 16 + q < b) slt += vv[q]; }
      red[part * 32 + e] = slt; red[512 + part * 32 + e] = sall; }
    __syncthreads();
    if (tid < 32) { int s0 = 0, s1 = 0;
#pragma unroll
        for (int q = 0; q < 16; ++q) { s0 += red[q * 32 + tid]; s1 += red[512 + q * 32 + tid]; }
        base[tid] = s0; total[tid] = s1; run[tid] = 0; }
    __syncthreads();
    if (tid == 0) { int acc = 0; for (int e = 0; e < 32; ++e) { segrow[e] = acc * 256; if (b == 0) ((int*)(C.ws + WS_MOEINFO))[e] = acc; acc += (total[e] + 255) >> 8; } segrow[32] = acc * 256; if (b == 0) ((int*)(C.ws + WS_MOEINFO))[32] = acc; }
    __syncthreads();
    int* SP = (int*)(C.ws + WS_SLOTPOS); int* ST = (int*)(C.ws + WS_SLOTTOK); int* SD = (int*)(C.ws + WS_SLOTDST); const int* TK = (const int*)(C.ws + WS_TOPK);
    const int rows_per_blk = MTOK / C.G;
    LAS int* gc = (LAS int*)(C.lds + 5120);
    int ge[2], grk[2], grow[2];
#pragma unroll
    for (int q = 0; q < 2; ++q) {
        const int g = 2 * wave + q, sidx = g * 64 + lane; grow[q] = b * rows_per_blk + (sidx >> 2);
        ge[q] = TK[(size_t)grow[q] * 4 + (sidx & 3)];
        int rk = 0, myc = 0;
        for (int ee = 0; ee < 32; ++ee) { const unsigned long long m = __ballot(ge[q] == ee);
            if (ge[q] == ee) rk = __popcll(m & ((1ull << lane) - 1ull));
            if (lane == ee) myc = __popcll(m); }
        grk[q] = rk;
        if (lane < 32) gc[g * 32 + lane] = myc;
    }
    __syncthreads();
#pragma unroll
    for (int q = 0; q < 2; ++q) {
        const int g = 2 * wave + q, sidx = g * 64 + lane; int off = 0;
        for (int gp = 0; gp < g; ++gp) off += gc[gp * 32 + ge[q]];
        const int pos = segrow[ge[q]] + base[ge[q]] + off + grk[q];
        SP[(size_t)grow[q] * 4 + (sidx & 3)] = pos; ST[pos] = grow[q]; SD[pos] = grow[q] * 4 + (sidx & 3);
    }
    if (b < 32) { const int e = b, tot = total[e], first = segrow[e] + tot, last = segrow[e + 1];
        for (int p = first + tid; p < last; p += 512) { ST[p] = 0; SD[p] = MTOK * 4 + (p & 255); } }
    __syncthreads();
}

__device__ __forceinline__ void p_combine(const Ctx& C, const int layer) {
    PH_IDS;
    const int gw = blockIdx.x * 8 + wave, NGW = C.G * 8;
    const int per = MTOK / NGW;
    const float* MOD = (const float*)(C.ws + WS_MOD) + (size_t)layer * 9 * 6144;
    const float* MODN = (const float*)(C.ws + WS_MOD) + (size_t)9 * 6144;
    const float* gpost = C.a->in[IN_NFPOST] + layer * 1024; const float* gpre1 = C.a->in[IN_NMPRE] + 1024;
    const unsigned char* YS = (const unsigned char*)(C.ws + WS_YSLOT); const int* SP = (const int*)(C.ws + WS_SLOTPOS); const float* GT = (const float*)(C.ws + WS_GATE);
    float* OUT = C.a->out; bf16* XS = (bf16*)(C.ws + WS_XS); unsigned char* HN = (unsigned char*)(C.ws + WS_HN);
    int curb = -1; float cA1[16], cA2[16], cB2[16]; const int vz = vzero();
    const int rbeg = gw * per, rend = gw * per + per;
    int4 npos = *(const int4*)(SP + (size_t)(rbeg + vz) * 4); f32x4 ngt = *(const f32x4*)(GT + (size_t)(rbeg + vz) * 4);
    unsigned nys[4][4]; u32x2 nxv[4]; f32x4 cgt = ngt;
    { const int pp[4] = {npos.x, npos.y, npos.z, npos.w};
#pragma unroll
      for (int k = 0; k < 4; ++k)
#pragma unroll
          for (int j = 0; j < 4; ++j) nys[k][j] = *(const unsigned*)(YS + (size_t)pp[k] * 1024 + 4 * lane + 256 * j);
#pragma unroll
      for (int j = 0; j < 4; ++j) nxv[j] = *(const u32x2*)(XS + (size_t)rbeg * 1024 + 4 * lane + 256 * j); }
    if (rbeg + 1 < rend) { npos = *(const int4*)(SP + (size_t)(rbeg + 1 + vz) * 4); ngt = *(const f32x4*)(GT + (size_t)(rbeg + 1 + vz) * 4); }
    for (int r = rbeg; r < rend; ++r) {
        const int b = r >> 13;
        if (b != curb) { curb = b;
#pragma unroll
            for (int j = 0; j < 4; ++j) { const int c = 4 * lane + 256 * j;
                const f32x4 gp = *(const f32x4*)(gpost + c), gf = *(const f32x4*)(MOD + (size_t)b * 6144 + 5120 + c);
                const f32x4 gg = *(const f32x4*)(gpre1 + c), sc = *(const f32x4*)(MODN + (size_t)b * 6144 + 1024 + c), sh = *(const f32x4*)(MODN + (size_t)b * 6144 + c);
#pragma unroll
                for (int i = 0; i < 4; ++i) { cA1[4 * j + i] = gp[i] * gf[i]; cA2[4 * j + i] = gg[i] * (1.0f + sc[i]); cB2[4 * j + i] = sh[i]; } } }
        unsigned ys[4][4]; u32x2 xc[4]; const f32x4 gt = cgt;
#pragma unroll
        for (int k = 0; k < 4; ++k)
#pragma unroll
            for (int j = 0; j < 4; ++j) ys[k][j] = nys[k][j];
#pragma unroll
        for (int j = 0; j < 4; ++j) xc[j] = nxv[j];
        if (r + 1 < rend) {
            const int pp[4] = {npos.x, npos.y, npos.z, npos.w}; cgt = ngt;
#pragma unroll
            for (int k = 0; k < 4; ++k)
#pragma unroll
                for (int j = 0; j < 4; ++j) nys[k][j] = *(const unsigned*)(YS + (size_t)pp[k] * 1024 + 4 * lane + 256 * j);
#pragma unroll
            for (int j = 0; j < 4; ++j) nxv[j] = *(const u32x2*)(XS + (size_t)(r + 1) * 1024 + 4 * lane + 256 * j);
            if (r + 2 < rend) { npos = *(const int4*)(SP + (size_t)(r + 2 + vz) * 4); ngt = *(const f32x4*)(GT + (size_t)(r + 2 + vz) * 4); } }
        float f[16];
#pragma unroll
        for (int i = 0; i < 16; ++i) f[i] = 0.f;
#pragma unroll
        for (int k = 0; k < 4; ++k) { const float gk = gt[k] * 0.0625f;
#pragma unroll
            for (int j = 0; j < 4; ++j) { const f32v2_t lo = __builtin_amdgcn_cvt_pk_f32_fp8((int)ys[k][j], false), hi = __builtin_amdgcn_cvt_pk_f32_fp8((int)ys[k][j], true);
                f[4 * j] += gk * lo[0]; f[4 * j + 1] += gk * lo[1]; f[4 * j + 2] += gk * hi[0]; f[4 * j + 3] += gk * hi[1]; } }
        float ss = 0.f;
#pragma unroll
        for (int i = 0; i < 16; ++i) ss += f[i] * f[i];
        const float rstd = rsqrtf(wave_sum(ss) * (1.0f / 1024.0f) + EPS);
        float x2[16]; float ss2 = 0.f;
#pragma unroll
        for (int j = 0; j < 4; ++j) { const int c = 4 * lane + 256 * j;
            const f32x4 xv = (f32x4){bf_lo(xc[j].x), bf_hi(xc[j].x), bf_lo(xc[j].y), bf_hi(xc[j].y)};
            f32x4 o;
#pragma unroll
            for (int i = 0; i < 4; ++i) { o[i] = xv[i] + cA1[4 * j + i] * (f[4 * j + i] * rstd); x2[4 * j + i] = o[i]; ss2 += o[i] * o[i]; }
            if (layer == 0) { u32x2 xw; xw.x = cvt_pk(o[0], o[1]); xw.y = cvt_pk(o[2], o[3]); *(u32x2*)(XS + (size_t)r * 1024 + c) = xw; }
            else *(f32x4*)(OUT + (size_t)r * 1024 + c) = o; }
        if (layer == 0) {
            const float rstd2 = rsqrtf(wave_sum(ss2) * (1.0f / 1024.0f) + EPS);
#pragma unroll
            for (int j = 0; j < 4; ++j) { const int c = 4 * lane + 256 * j;
                float hv[4];
#pragma unroll
                for (int i = 0; i < 4; ++i) hv[i] = x2[4 * j + i] * rstd2 * cA2[4 * j + i] + cB2[4 * j + i];
                if (F8_IN1) *(unsigned*)(HN + (size_t)r * 1024 + c) = pk4_fp8(hv[0], hv[1], hv[2], hv[3], 8.f);
                else *(u32x2*)((bf16*)HN + (size_t)r * 1024 + c) = (u32x2){cvt_pk(hv[0], hv[1]), cvt_pk(hv[2], hv[3])}; }
        }
    }
}

__device__ __forceinline__ void p_conv(const Ctx& C) {
    PH_IDS;
    LAS unsigned char* L = C.lds;
    constexpr int O_X = 0;
    constexpr int O_W = 63488;
    const int w = wave;
    const bf16* GLU = (const bf16*)(C.ws + WS_GLU); const bf16* ZC1 = (const bf16*)(C.ws + WS_ZC1); const bf16* GB = (const bf16*)(C.ws + WS_GB);
    unsigned char* A2 = (unsigned char*)(C.ws + WS_A2B);
    __syncthreads();
    { float tmpw[31];
#pragma unroll
      for (int q = 0; q < 31; ++q) tmpw[q] = C.a->in[IN_ODDW][tid + 512 * q];
#pragma unroll
      for (int q = 0; q < 31; ++q) { const int i = tid + 512 * q; const int tap = i >> 9, c = i & 511; const int ln = c >> 3, half = (c >> 2) & 1, qq = c & 3;
          *(LAS float*)(L + O_W + (((tap * 2 + half) * 64 + ln) * 4 + qq) * 4) = tmpw[q]; } }
    float cb[8], lg[8], lb[8], sw0[8], sw1[8], sw2[8];
#pragma unroll
    for (int i = 0; i < 8; ++i) { const int c = 8 * lane + i; cb[i] = C.a->in[IN_ODDWB][c]; lg[i] = C.a->in[IN_ODLNG][c]; lb[i] = C.a->in[IN_ODLNB][c];
        sw0[i] = C.a->in[IN_ODSCONV][c]; sw1[i] = C.a->in[IN_ODSCONV][512 + c]; sw2[i] = C.a->in[IN_ODSCONV][1024 + c]; }
    u32x4 px[8];
    auto fetchx = [&](int unit) { const int bt = unit >> 8, t0 = (unit & 255) * 32;
#pragma unroll
        for (int q = 0; q < 8; ++q) { const int i = tid + 512 * q; const int rr = i >> 6, cc = i & 63; const int tl = t0 - 15 + rr;
            px[q] = (u32x4){0u, 0u, 0u, 0u};
            if (i < 62 * 64 && tl >= 0 && tl < SEQ) px[q] = *(const u32x4*)(GLU + (size_t)(bt * SEQ + tl) * 512 + cc * 8); } };
    if ((int)blockIdx.x < 2048) fetchx(blockIdx.x);
    for (int unit = blockIdx.x; unit < 2048; unit += C.G) {
        const int bt = unit >> 8, t0 = (unit & 255) * 32;
        __syncthreads();
#pragma unroll
        for (int q = 0; q < 8; ++q) { const int i = tid + 512 * q; if (i < 62 * 64) *(LAS u32x4*)(L + O_X + (i >> 6) * 1024 + (i & 63) * 16) = px[q]; }
        __syncthreads();
        if (unit + C.G < 2048) fetchx(unit + C.G);
        float acc[4][8];
#pragma unroll
        for (int o = 0; o < 4; ++o)
#pragma unroll
            for (int i = 0; i < 8; ++i) acc[o][i] = 0.f;
#pragma unroll 4
        for (int tap = 0; tap < 31; ++tap) {
            const f32x4 w0 = *(const LAS f32x4*)(L + O_W + ((tap * 2 + 0) * 64 + lane) * 16), w1 = *(const LAS f32x4*)(L + O_W + ((tap * 2 + 1) * 64 + lane) * 16);
#pragma unroll
            for (int o = 0; o < 4; ++o) {
                const u32x4 xr = *(const LAS u32x4*)(L + O_X + (4 * w + o + tap) * 1024 + lane * 16);
                acc[o][0] += bf_lo(xr[0]) * w0[0]; acc[o][1] += bf_hi(xr[0]) * w0[1]; acc[o][2] += bf_lo(xr[1]) * w0[2]; acc[o][3] += bf_hi(xr[1]) * w0[3];
                acc[o][4] += bf_lo(xr[2]) * w1[0]; acc[o][5] += bf_hi(xr[2]) * w1[1]; acc[o][6] += bf_lo(xr[3]) * w1[2]; acc[o][7] += bf_hi(xr[3]) * w1[3]; }
        }
        u32x4 sz0[4], sz1[4], sz2[4], sgb[4];
#pragma unroll
        for (int o = 0; o < 4; ++o) { const int tl = t0 + 4 * w + o; const size_t tok = (size_t)bt * SEQ + tl;
            sz1[o] = *(const u32x4*)(ZC1 + tok * 512 + 8 * lane); sz0[o] = (u32x4){0u, 0u, 0u, 0u}; sz2[o] = (u32x4){0u, 0u, 0u, 0u};
            if (tl >= 64) sz0[o] = *(const u32x4*)(ZC1 + (tok - 64) * 512 + 8 * lane);
            if (tl + 64 < SEQ) sz2[o] = *(const u32x4*)(ZC1 + (tok + 64) * 512 + 8 * lane);
            sgb[o] = *(const u32x4*)(GB + tok * 512 + 8 * lane); }
#pragma unroll
        for (int o = 0; o < 4; ++o) {
            const int tl = t0 + 4 * w + o; const size_t tok = (size_t)bt * SEQ + tl;
            float v[8]; float s = 0.f;
#pragma unroll
            for (int i = 0; i < 8; ++i) { v[i] = acc[o][i] + cb[i]; s += v[i]; }
            const float mu = wave_sum(s) * (1.0f / 512.0f); float q = 0.f;
#pragma unroll
            for (int i = 0; i < 8; ++i) { v[i] -= mu; q += v[i] * v[i]; }
            const float rstd = rsqrtf(wave_sum(q) * (1.0f / 512.0f) + EPS);
            float y[8];
#pragma unroll
            for (int i = 0; i < 8; ++i) y[i] = siluf_(v[i] * rstd * lg[i] + lb[i]);
            if (F8_OUT1) *(u32x2*)(A2 + tok * 1024 + 8 * lane) = (u32x2){pk4_fp8(y[0], y[1], y[2], y[3], 4.f), pk4_fp8(y[4], y[5], y[6], y[7], 4.f)};
            else *(u32x4*)((bf16*)A2 + tok * 1024 + 8 * lane) = (u32x4){cvt_pk(y[0], y[1]), cvt_pk(y[2], y[3]), cvt_pk(y[4], y[5]), cvt_pk(y[6], y[7])};
            const u32x4 z1 = sz1[o], z0 = sz0[o], z2 = sz2[o], gb = sgb[o];
            float zz[8];
#pragma unroll
            for (int i = 0; i < 4; ++i) {
                zz[2 * i] = (sw0[2 * i] * bf_lo(z0[i]) + sw1[2 * i] * bf_lo(z1[i]) + sw2[2 * i] * bf_lo(z2[i])) * bf_lo(gb[i]);
                zz[2 * i + 1] = (sw0[2 * i + 1] * bf_hi(z0[i]) + sw1[2 * i + 1] * bf_hi(z1[i]) + sw2[2 * i + 1] * bf_hi(z2[i])) * bf_hi(gb[i]); }
            if (F8_OUT1) *(u32x2*)(A2 + tok * 1024 + 512 + 8 * lane) = (u32x2){pk4_fp8(zz[0], zz[1], zz[2], zz[3], 4.f), pk4_fp8(zz[4], zz[5], zz[6], zz[7], 4.f)};
            else *(u32x4*)((bf16*)A2 + tok * 1024 + 512 + 8 * lane) = (u32x4){cvt_pk(zz[0], zz[1]), cvt_pk(zz[2], zz[3]), cvt_pk(zz[4], zz[5]), cvt_pk(zz[6], zz[7])};
        }
    }
    __syncthreads();
}

constexpr int NPHASE = 19;
#ifndef RUN_HI
#define RUN_HI NPHASE
#endif
__global__ void __launch_bounds__(512, 2) fwd_kernel(Args args) {
    extern __shared__ __attribute__((aligned(16))) unsigned char lds_raw[];
    Ctx C; C.lds = (LAS unsigned char*)lds_raw;
    C.G = gridDim.x; C.a = &args; C.ws = args.ws;
    volatile LAS unsigned* MISC = (volatile LAS unsigned*)(C.lds + MISC_OFF);
    if (threadIdx.x < 16) MISC[threadIdx.x] = 0u;
    __syncthreads();
    const int lo = args.ph_lo, hi = args.ph_hi;
    const bool multi = (hi - lo) > 1;
    XcdBarrier bar; bar.bar = (unsigned*)(C.ws + WS_CTL) + 4096; bar.x = 0; bar.st = MISC;
    if (multi) bar = xcd_barrier_post((unsigned*)(C.ws + WS_CTL) + 4096, MISC);
#ifndef PH_MASK
#define PH_MASK 0x7FFFF
#endif
#define IN(k) (((PH_MASK >> (k)) & 1) && lo <= (k) && (k) < hi)
#ifndef DUP_MASK
#define DUP_MASK 0
#endif
#ifndef GLA_PROBE
#define GLA_PROBE 0
#endif
#ifndef PROBE_NOEPI
#define PROBE_NOEPI 0
#endif
#ifndef GP_AMP
#define GP_AMP 4
#endif
#define DUPN(k) (((DUP_MASK >> (k)) & 1) ? 2 : 1)
#define SEAM(k) do { if (IN(k) && IN((k) + 1)) xcd_barrier(bar); } while (0)
    LAS unsigned char* ring = C.lds;
    const int cid = blockIdx.x;

    if (IN(0)) for (int rep_ = 0; rep_ < DUPN(0); ++rep_) { p0_adaln(C); p0_fourier_fold(C); p0_convert(C); } SEAM(0);
    if (IN(1)) for (int rep_ = 0; rep_ < DUPN(1); ++rep_) { p_norm0(C); } SEAM(1);
    if (IN(2)) for (int rep_ = 0; rep_ < DUPN(2); ++rep_) { gm::SchedIn0 S{(const char*)(C.ws + WS_HN), (const char*)(C.ws + WS_WIN0), C.G, cid}; gm::EpiIn0 E{C.ws}; gm::gemm_phase<F8_IN0 != 0>(ring, F8_IN0 ? 1024 : 2048, S, E, 0x7C7C7C7C, 0x7A7A7A7A, 2, (unsigned long long*)(C.ws + WS_CTL + 32768)); } SEAM(2);
    if (IN(3)) for (int rep_ = 0; rep_ < DUPN(3); ++rep_) { p_gla_prep(C); if (GLA_PROBE == 1) p_gla_prep(C); if (GLA_PROBE >= 10) p_gla_prep(C, GLA_PROBE - 10); p_fft1(C); if (GLA_PROBE == 2) p_fft1(C); xcd_barrier(bar); p_gla(C); if (GLA_PROBE == 3) p_gla(C); if (GLA_PROBE == 4) p_gla(C, 1); } SEAM(3);
    if (IN(4)) for (int rep_ = 0; rep_ < DUPN(4); ++rep_) { p_fft2(C); p_gla_out(C); } SEAM(4);
    if (IN(5)) for (int rep_ = 0; rep_ < DUPN(5); ++rep_) { gm::SchedDense S{(const char*)(C.ws + WS_A2), (const char*)(C.ws + WS_WOUT0), F8_OUT0 ? 1536 : 3072, 256, 4, C.G, cid}; gm::EpiPlain E{(bf16*)(C.ws + WS_Y), 1024}; gm::gemm_phase<F8_OUT0 != 0>(ring, F8_OUT0 ? 1536 : 3072, S, E, 0x7C7C7C7C, 0x7A7A7A7A, 5, (unsigned long long*)(C.ws + WS_CTL + 32768)); } SEAM(5);
    if (IN(6)) for (int rep_ = 0; rep_ < DUPN(6); ++rep_) { p_postmix(C, 0); } SEAM(6);
    if (IN(7)) { p_assign(C); } SEAM(7);
    if (IN(8)) for (int rep_ = 0; rep_ < DUPN(8); ++rep_) { const int* tsp = (const int*)(C.ws + WS_MOEINFO); const int ln_ = otid() & 63; const int ts = __hip_atomic_load(tsp + (ln_ < 32 ? ln_ : 32), __ATOMIC_RELAXED, __HIP_MEMORY_SCOPE_AGENT);
        gm::SchedMoE S{(const char*)(C.ws + WS_H2), (const char*)(C.ws + WS_WGU), (const int*)(C.ws + WS_SLOTTOK), ts, __builtin_amdgcn_readlane(ts, 32), 8, C.G, cid, (size_t)2048 * 1024, true, args.in[IN_BGU], nullptr};
        gm::EpiGU E{(unsigned char*)(C.ws + WS_ACT), args.in[IN_BGU], PROBE_NOEPI ? rep_ : 0}; gm::gemm_phase<true>(ring, 1024, S, E, 0x7C7C7C7C, 0x7A7A7A7A, 8, (unsigned long long*)(C.ws + WS_CTL + 32768)); } SEAM(8);
    if (IN(9)) for (int rep_ = 0; rep_ < DUPN(9); ++rep_) { const int* tsp = (const int*)(C.ws + WS_MOEINFO); const int ln_ = otid() & 63; const int ts = __hip_atomic_load(tsp + (ln_ < 32 ? ln_ : 32), __ATOMIC_RELAXED, __HIP_MEMORY_SCOPE_AGENT);
        gm::SchedMoE S{(const char*)(C.ws + WS_ACT), (const char*)(C.ws + WS_WD), nullptr, ts, __builtin_amdgcn_readlane(ts, 32), 4, C.G, cid, (size_t)1024 * 1024, false, args.in[IN_BD], nullptr};
        gm::EpiDown E{(unsigned char*)(C.ws + WS_YSLOT), args.in[IN_BD]}; gm::gemm_phase<true>(ring, 1024, S, E, 0x7D7D7D7D, 0x7A7A7A7A, 9, (unsigned long long*)(C.ws + WS_CTL + 32768)); } SEAM(9);
    if (IN(10)) { p_combine(C, 0); } SEAM(10);
    if (IN(11)) for (int rep_ = 0; rep_ < DUPN(11); ++rep_) { gm::SchedDense S{(const char*)(C.ws + WS_HN), (const char*)(C.ws + WS_WIN1), F8_IN1 ? 1024 : 2048, 256, 10, C.G, cid}; gm::EpiIn1 E{C.ws}; gm::gemm_phase<F8_IN1 != 0>(ring, F8_IN1 ? 1024 : 2048, S, E, 0x7C7C7C7C, 0x7A7A7A7A, 11, (unsigned long long*)(C.ws + WS_CTL + 32768)); } SEAM(11);
    if (IN(12)) for (int rep_ = 0; rep_ < DUPN(12); ++rep_) { p_conv(C); } SEAM(12);
    if (IN(13)) for (int rep_ = 0; rep_ < DUPN(13); ++rep_) { gm::SchedDense S{(const char*)(C.ws + WS_A2B), (const char*)(C.ws + WS_WOUT1), F8_OUT1 ? 1024 : 2048, 256, 4, C.G, cid}; gm::EpiPlain E{(bf16*)(C.ws + WS_Y), 1024}; gm::gemm_phase<F8_OUT1 != 0>(ring, F8_OUT1 ? 1024 : 2048, S, E, 0x7D7D7D7D, 0x7A7A7A7A, 13, (unsigned long long*)(C.ws + WS_CTL + 32768)); } SEAM(13);
    if (IN(14)) { p_postmix(C, 1); } SEAM(14);
    if (IN(15)) { p_assign(C); } SEAM(15);
    if (IN(16)) for (int rep_ = 0; rep_ < DUPN(16); ++rep_) { const int* tsp = (const int*)(C.ws + WS_MOEINFO); const int ln_ = otid() & 63; const int ts = __hip_atomic_load(tsp + (ln_ < 32 ? ln_ : 32), __ATOMIC_RELAXED, __HIP_MEMORY_SCOPE_AGENT);
        gm::SchedMoE S{(const char*)(C.ws + WS_H2), (const char*)(C.ws + WS_WGU) + (size_t)32 * 2048 * 1024, (const int*)(C.ws + WS_SLOTTOK), ts, __builtin_amdgcn_readlane(ts, 32), 8, C.G, cid, (size_t)2048 * 1024, true, args.in[IN_BGU] + 32 * 2048, nullptr};
        gm::EpiGU E{(unsigned char*)(C.ws + WS_ACT), args.in[IN_BGU] + 32 * 2048, 0}; gm::gemm_phase<true>(ring, 1024, S, E, 0x7C7C7C7C, 0x7A7A7A7A, 16, (unsigned long long*)(C.ws + WS_CTL + 32768)); } SEAM(16);
    if (IN(17)) for (int rep_ = 0; rep_ < DUPN(17); ++rep_) { const int* tsp = (const int*)(C.ws + WS_MOEINFO); const int ln_ = otid() & 63; const int ts = __hip_atomic_load(tsp + (ln_ < 32 ? ln_ : 32), __ATOMIC_RELAXED, __HIP_MEMORY_SCOPE_AGENT);
        gm::SchedMoE S{(const char*)(C.ws + WS_ACT), (const char*)(C.ws + WS_WD) + (size_t)32 * 1024 * 1024, nullptr, ts, __builtin_amdgcn_readlane(ts, 32), 4, C.G, cid, (size_t)1024 * 1024, false, args.in[IN_BD] + 32 * 1024, nullptr};
        gm::EpiDown E{(unsigned char*)(C.ws + WS_YSLOT), args.in[IN_BD] + 32 * 1024}; gm::gemm_phase<true>(ring, 1024, S, E, 0x7D7D7D7D, 0x7A7A7A7A, 17, (unsigned long long*)(C.ws + WS_CTL + 32768)); } SEAM(17);
    if (IN(18)) { p_combine(C, 1); }
#if GP_PROBE
    if (blockIdx.x == 0 && threadIdx.x == 0) { const unsigned long long v = *(volatile unsigned long long*)(C.ws + WS_CTL + 32768) * GP_AMP; const unsigned long long t0 = wall_clock64();
        while (wall_clock64() - t0 < v) __builtin_amdgcn_s_sleep(16); }
#endif
#ifdef DBG_COPY_OFF
    if (lo == 99) { const bf16* src = (const bf16*)(C.ws + (size_t)DBG_COPY_OFF); float* dst = args.out;
        for (size_t i = (size_t)blockIdx.x * 512 + threadIdx.x; i < (size_t)MTOK * 1024; i += (size_t)gridDim.x * 512) dst[i] = bf_lo((unsigned)src[i]); }
#endif
#undef IN
#undef SEAM
}

extern "C" void kernel_launch(void* const* d_in, const int* in_sizes, int n_in, void* d_out, int out_size, void* d_ws, size_t ws_size, hipStream_t stream) {
    static int grid = 0;
    if (grid == 0) {
        if (n_in != 28 || out_size != MTOK * D || ws_size < WS_END) { fprintf(stderr, "kernel_launch: unexpected problem (n_in %d out %d ws %zu need %zu)\n", n_in, out_size, ws_size, (size_t)WS_END); grid = -1; return; }
        int dev = 0, cus = 0, per_cu = 0;
        (void)hipGetDevice(&dev); (void)hipDeviceGetAttribute(&cus, hipDeviceAttributeMultiprocessorCount, dev);
        if (hipFuncSetAttribute((const void*)fwd_kernel, hipFuncAttributeMaxDynamicSharedMemorySize, LDS_BYTES) != hipSuccess) { fprintf(stderr, "kernel_launch: hipFuncSetAttribute failed\n"); grid = -1; return; }
        (void)hipOccupancyMaxActiveBlocksPerMultiprocessor(&per_cu, (const void*)fwd_kernel, 512, LDS_BYTES);
        (void)hipGetLastError();
        grid = cus;
        if (grid != 256 || per_cu < 1) { fprintf(stderr, "kernel_launch: needs a 256-CU device with one resident workgroup per CU (cus %d, per_cu %d)\n", cus, per_cu); grid = -1; return; }
    }
    if (grid < 0) return;
    (void)hipMemsetAsync((char*)d_ws + WS_CTL, 0, CTL_ZERO_BYTES, stream);
    Args a{};
    for (int i = 0; i < 28; ++i) a.in[i] = (const float*)d_in[i];
    a.out = (float*)d_out; a.ws = (unsigned char*)d_ws;
#if N_LAUNCH_MODE == 1
    a.ph_lo = 0; a.ph_hi = NPHASE;
    hipLaunchKernelGGL(fwd_kernel, dim3(grid), dim3(512), LDS_BYTES, stream, a);
#else
    for (int p = 0; p < RUN_HI; ++p) { a.ph_lo = p; a.ph_hi = p + 1; hipLaunchKernelGGL(fwd_kernel, dim3(grid), dim3(512), LDS_BYTES, stream, a); }
#ifdef DBG_COPY_OFF
    a.ph_lo = 99; a.ph_hi = 100; hipLaunchKernelGGL(fwd_kernel, dim3(grid), dim3(512), LDS_BYTES, stream, a);
#endif
#endif
}
```

```cpp
#include <hip/hip_runtime.h>
#include <cstdio>
#include <cstdint>

#ifndef N_LAUNCH_MODE
#define N_LAUNCH_MODE 1
#endif

#ifndef F8_IN0
#define F8_IN0 0
#endif
#ifndef F8_OUT0
#define F8_OUT0 1
#endif
#ifndef IN0_F8_TILES
#define IN0_F8_TILES 0x0FF0
#endif
#ifndef F8_IN1
#define F8_IN1 1
#endif
#ifndef F8_OUT1
#define F8_OUT1 1
#endif
#define LAS __attribute__((address_space(3)))
typedef unsigned short bf16;
typedef short bf16x8 __attribute__((ext_vector_type(8)));
typedef short s16x4 __attribute__((ext_vector_type(4)));
typedef float f32x4 __attribute__((ext_vector_type(4)));
typedef float f32x16 __attribute__((ext_vector_type(16)));
typedef unsigned u32x4 __attribute__((ext_vector_type(4)));
typedef unsigned u32x2 __attribute__((ext_vector_type(2)));

constexpr int D = 1024, NB = 8, SEQ = 8192, CTXL = 256;
constexpr int MTOK = NB * SEQ;
constexpr int MCTX = NB * CTXL;
constexpr int MALL = MTOK + MCTX;
constexpr int NE = 32, TOPK = 4;
constexpr int NSLOT_PAD = MTOK * TOPK + NE * 256;
constexpr int N_IN0 = 3840;
constexpr int N_IN1 = 2560;
constexpr float EPS = 1e-6f;

constexpr size_t MiB = 1u << 20;
constexpr size_t WS_CTL = 0, CTL_ZERO_BYTES = 65536;
constexpr size_t WS_MOD = 1 * MiB;
constexpr size_t WS_F1 = 2 * MiB;
constexpr size_t WS_F2 = 2 * MiB + 65536;
constexpr size_t WS_CNTBLK = 3 * MiB;
constexpr size_t WS_MOEINFO = 3 * MiB + 65536;
constexpr size_t WS_TOPK = 4 * MiB;
constexpr size_t WS_GATE = 5 * MiB;
constexpr size_t WS_SLOTPOS = 6 * MiB;
constexpr size_t WS_SLOTTOK = 7 * MiB;
constexpr size_t WS_SLOTDST = 8 * MiB + 512 * 1024;
constexpr size_t WS_WIN0 = 10 * MiB;
constexpr size_t WS_WOUT0 = 19 * MiB;
constexpr size_t WS_WIN1 = 22 * MiB;
constexpr size_t WS_WOUT1 = 27 * MiB;
constexpr size_t WS_WIN0F8 = 28 * MiB;
constexpr size_t WS_WGU = 32 * MiB;
constexpr size_t WS_WD = 288 * MiB;
constexpr size_t WS_HN = 416 * MiB;
constexpr size_t WS_B = 548 * MiB;
constexpr size_t WS_ACT = WS_B;
constexpr size_t WS_YSLOT = WS_B + 528 * MiB;
constexpr size_t WS_Q = WS_B, WS_K = WS_B + 64 * MiB, WS_V = WS_B + 130 * MiB, WS_R = WS_B + 262 * MiB;
constexpr size_t WS_ZC = WS_B + 390 * MiB, WS_ZS = WS_B + 454 * MiB, WS_LR = WS_B + 518 * MiB;
constexpr size_t WS_OF = WS_B + 528 * MiB, WS_OB = WS_B + 656 * MiB, WS_YR = WS_B + 784 * MiB, WS_YI = WS_B + 848 * MiB;
constexpr size_t WS_HN8 = WS_B + 528 * MiB;
constexpr size_t WS_A2 = WS_B;
constexpr size_t WS_Y = WS_B + 528 * MiB;
constexpr size_t WS_H2 = WS_B + 656 * MiB;
constexpr size_t WS_GLU = WS_B, WS_ZC1 = WS_B + 64 * MiB, WS_GB = WS_B + 128 * MiB, WS_A2B = WS_B + 192 * MiB;
constexpr size_t WS_XS = WS_B + 1056 * MiB;
constexpr size_t WS_GQP = WS_B + 1056 * MiB;
constexpr size_t WS_GKPP = WS_GQP + 132 * MiB;
constexpr size_t WS_GSC = WS_GKPP + 132 * MiB;
constexpr size_t WS_GEL = WS_GSC + 66 * MiB;
constexpr size_t WS_END = WS_GEL + 6 * MiB;

constexpr int LDS_BYTES = 155648;
constexpr int MISC_OFF = LDS_BYTES - 256;

__device__ __forceinline__ float bf_lo(unsigned u) { return __uint_as_float(u << 16); }
__device__ __forceinline__ float bf_hi(unsigned u) { return __uint_as_float(u & 0xffff0000u); }
typedef __bf16 bf16v2_t __attribute__((ext_vector_type(2)));
typedef float f32v2_t __attribute__((ext_vector_type(2)));
__device__ __forceinline__ unsigned cvt_pk(float lo, float hi) { const f32v2_t v = {lo, hi}; const bf16v2_t r = __builtin_convertvector(v, bf16v2_t); return __builtin_bit_cast(unsigned, r); }
__device__ __forceinline__ unsigned f2bf(float f) { unsigned u = __float_as_uint(f); return (u + 0x7fffu + ((u >> 16) & 1u)) >> 16; }
__device__ __forceinline__ float swap32_sum(float a, float b) {
    const auto r = __builtin_amdgcn_permlane32_swap(__builtin_bit_cast(unsigned, a), __builtin_bit_cast(unsigned, b), false, false);
    unsigned x = r[0], y = r[1]; asm volatile("" : "+v"(x), "+v"(y));
    return __builtin_bit_cast(float, x) + __builtin_bit_cast(float, y);
}
__device__ __forceinline__ void swap16_pair(unsigned& a, unsigned& b) {
    const auto r = __builtin_amdgcn_permlane16_swap(a, b, false, false);
    unsigned x = r[0], y = r[1]; asm volatile("" : "+v"(x), "+v"(y));
    a = x; b = y;
}
__device__ __forceinline__ float swap16_sum(float a, float b) {
    const auto r = __builtin_amdgcn_permlane16_swap(__builtin_bit_cast(unsigned, a), __builtin_bit_cast(unsigned, b), false, false);
    unsigned x = r[0], y = r[1]; asm volatile("" : "+v"(x), "+v"(y));
    return __builtin_bit_cast(float, x) + __builtin_bit_cast(float, y);
}
__device__ __forceinline__ float row16_sum(float v) {
    v += __builtin_bit_cast(float, __builtin_amdgcn_update_dpp(0, __builtin_bit_cast(int, v), 0xB1, 0xF, 0xF, true));
    v += __builtin_bit_cast(float, __builtin_amdgcn_update_dpp(0, __builtin_bit_cast(int, v), 0x4E, 0xF, 0xF, true));
    v += __builtin_bit_cast(float, __builtin_amdgcn_update_dpp(0, __builtin_bit_cast(int, v), 0x141, 0xF, 0xF, true));
    v += __builtin_bit_cast(float, __builtin_amdgcn_update_dpp(0, __builtin_bit_cast(int, v), 0x140, 0xF, 0xF, true));
    return v;
}
__device__ __forceinline__ float wave_sum(float v) {
    v = row16_sum(v);
    const int iv = __builtin_bit_cast(int, v);
    const float a = __builtin_bit_cast(float, __builtin_amdgcn_readlane(iv, 0)), b = __builtin_bit_cast(float, __builtin_amdgcn_readlane(iv, 16));
    const float c = __builtin_bit_cast(float, __builtin_amdgcn_readlane(iv, 32)), d = __builtin_bit_cast(float, __builtin_amdgcn_readlane(iv, 48));
    return (a + b) + (c + d);
}
__device__ __forceinline__ unsigned pk4_fp8(float a, float b, float c, float d, float sc) {
    int w = 0;
    w = __builtin_amdgcn_cvt_pk_fp8_f32(__builtin_amdgcn_fmed3f(a * sc, -440.f, 440.f), __builtin_amdgcn_fmed3f(b * sc, -440.f, 440.f), w, false);
    w = __builtin_amdgcn_cvt_pk_fp8_f32(__builtin_amdgcn_fmed3f(c * sc, -440.f, 440.f), __builtin_amdgcn_fmed3f(d * sc, -440.f, 440.f), w, true);
    return (unsigned)w;
}
__device__ __forceinline__ float sigmoidf_(float x) { return __builtin_amdgcn_rcpf(1.0f + __builtin_amdgcn_exp2f(x * -1.4426950408889634f)); }
__device__ __forceinline__ float siluf_(float x) { return x * sigmoidf_(x); }

#define XB_TMO      128
#define XB_XCNT(j)  (256  + 64 * (j))
#define XB_XSUB(j)  (1280 + 64 * (j))
#define XB_XGEN(j)  (2304 + 64 * (j))
#define XB_TOP      3328
#define XB_TOPGEN   3392
#define XCD_BAR_WORDS 3456
#define XB_SPIN_CAP (1u << 18)
__device__ __forceinline__ unsigned xb_ld(unsigned* p)              { return __hip_atomic_load(p, __ATOMIC_RELAXED, __HIP_MEMORY_SCOPE_AGENT); }
__device__ __forceinline__ unsigned xb_add(unsigned* p, unsigned v) { return __hip_atomic_fetch_add(p, v, __ATOMIC_RELAXED, __HIP_MEMORY_SCOPE_AGENT); }
__device__ __forceinline__ unsigned xb_xcc_id() { return (unsigned)__builtin_amdgcn_s_getreg((3 << 11) | 20) & 0xFu; }
#define XB_SPIN(cond, bar) do { unsigned _sp = 0; while (cond) { __builtin_amdgcn_s_sleep(1); \
    if ((++_sp & 255u) == 0u) { if (xb_ld(&(bar)[XB_TMO])) break; if (_sp > XB_SPIN_CAP) { atomicAdd(&(bar)[XB_TMO], 1u); break; } } } } while (0)
struct XcdBarrier { unsigned* bar; unsigned x; volatile LAS unsigned* st; };
__device__ __forceinline__ XcdBarrier xcd_barrier_post(unsigned* bar, volatile LAS unsigned* st) {
    XcdBarrier b; b.bar = bar; b.x = xb_xcc_id(); b.st = st;
    if (threadIdx.x == 0) (void)xb_add(&bar[XB_XCNT(b.x)], 1u);
    return b;
}
__device__ __forceinline__ void xcd_barrier_complete(unsigned* bar, unsigned x, unsigned& nloc, unsigned& nx) {
    const unsigned G = gridDim.x * gridDim.y * gridDim.z;
    unsigned sum, cnt, mine, sp = 0u;
    for (;;) {
        sum = 0u; cnt = 0u; mine = 0u;
#pragma unroll
        for (unsigned j = 0; j < 16; ++j) { const unsigned c = xb_ld(&bar[XB_XCNT(j)]); sum += c; cnt += (c > 0u) ? 1u : 0u; mine = (j == x) ? c : mine; }
        if (sum == G) break;
        __builtin_amdgcn_s_sleep(1);
        if ((++sp & 255u) == 0u) { if (xb_ld(&bar[XB_TMO])) break; if (sp > XB_SPIN_CAP) { atomicAdd(&bar[XB_TMO], 1u); break; } }
    }
    nloc = mine > 0u ? mine : 1u; nx = cnt > 0u ? cnt : 1u;
}
__device__ __forceinline__ void xcd_barrier(const XcdBarrier& b) {
    asm volatile("s_waitcnt vmcnt(0)" ::: "memory");
    __syncthreads();
    if (threadIdx.x == 0) {
        unsigned* bar = b.bar;
        __builtin_amdgcn_s_waitcnt(0);
        unsigned nloc = b.st[0], nx = b.st[1];
        if (nloc == 0u) { xcd_barrier_complete(bar, b.x, nloc, nx); b.st[0] = nloc; b.st[1] = nx; }
        const unsigned old = xb_add(&bar[XB_XSUB(b.x)], 1u);
        const unsigned gen = old / nloc;
        if (old + 1u == (gen + 1u) * nloc) {
            __builtin_amdgcn_fence(__ATOMIC_RELEASE, "agent");
            asm volatile("s_waitcnt vmcnt(0)" ::: "memory");
            const unsigned og = xb_add(&bar[XB_TOP], 1u);
            const unsigned tg = og / nx;
            if (og + 1u == (tg + 1u) * nx) xb_add(&bar[XB_TOPGEN], 1u);
            else XB_SPIN(xb_ld(&bar[XB_TOPGEN]) == tg, bar);
            __builtin_amdgcn_fence(__ATOMIC_ACQUIRE, "agent");
            xb_add(&bar[XB_XGEN(b.x)], 1u);
            asm volatile("s_waitcnt vmcnt(0)" ::: "memory");
        } else {
            XB_SPIN(xb_ld(&bar[XB_XGEN(b.x)]) == gen, bar);
            __builtin_amdgcn_fence(__ATOMIC_ACQUIRE, "agent");
            asm volatile("s_waitcnt vmcnt(0)" ::: "memory");
        }
    }
    __syncthreads();
}

struct Args {
    const float* in[28];
    float* out;
    unsigned char* ws;
    int ph_lo, ph_hi;
};
struct Ctx {
    LAS unsigned char* lds;
    int G;
    const Args* a;
    unsigned char* ws;
};
__device__ __forceinline__ int otid() { int t = (int)threadIdx.x; asm volatile("" : "+v"(t)); return t; }
__device__ __forceinline__ int vzero() { int z = 0; asm volatile("" : "+v"(z)); return z; }
#define PH_IDS const int tid = otid(), lane = tid & 63, wave = __builtin_amdgcn_readfirstlane(tid >> 6); (void)tid; (void)lane; (void)wave
#define IN_X 0
#define IN_C 1
#define IN_CTX 2
#define IN_CCTX 3
#define IN_MODW 4
#define IN_MODB 5
#define IN_NMPRE 6
#define IN_NMPOST 7
#define IN_NFPRE 8
#define IN_NFPOST 9
#define IN_EVWIN 10
#define IN_EVGKUP 11
#define IN_EVGKB 12
#define IN_EVGNORM 13
#define IN_EVWOUT 14
#define IN_ODWIN 15
#define IN_ODDW 16
#define IN_ODDWB 17
#define IN_ODLNG 18
#define IN_ODLNB 19
#define IN_ODSCONV 20
#define IN_ODWOUT 21
#define IN_RW 22
#define IN_RB 23
#define IN_WGU 24
#define IN_BGU 25
#define IN_WD 26
#define IN_BD 27

namespace gm {
constexpr int BM = 256, BK = 64, HALF = 128, HTB = HALF * BK * 2, STAGE_BYTES = 8 * HTB, NXCD = 8, WGM = 8;
constexpr int XT_OFF = 131072;
constexpr int XB_OFF = XT_OFF + 16384;
__device__ __forceinline__ int lds_byte(int r, int c) { const int st = (r >> 4) * 2 + (c >> 5), rr = r & 15, cc = c & 31, ob = rr * 64 + cc * 2; return st * 1024 + (ob ^ (((ob >> 9) & 1) << 5)); }
__device__ __forceinline__ void stage_rc(int b, int& R, int& C) { const int st = b / 1024, sb = b % 1024, swz = sb ^ (((sb >> 9) & 1) << 5); R = (st >> 1) * 16 + swz / 64; C = (st & 1) * 32 + (swz % 64) / 2; }
__device__ __forceinline__ int perm32(int rho) { const int n = rho >> 4, i = rho & 15; return 8 * (i >> 2) + 4 * n + (i & 3); }
struct Unit { int pm, pn, e; };

__device__ __forceinline__ void dense_map(int L, int nM, int nN, int& pm, int& pn) {
    const int nwg = nM * nN; int wgid = L;
    { const int q = nwg / NXCD, r = nwg % NXCD, xcd = wgid % NXCD, off = wgid / NXCD; wgid = (xcd < r ? xcd * (q + 1) : r * (q + 1) + (xcd - r) * q) + off; }
    const int nig = WGM * nN, gid = wgid / nig, fm = gid * WGM, gsz = (nM - fm) < WGM ? (nM - fm) : WGM;
    pm = fm + ((wgid % nig) % gsz); pn = (wgid % nig) / gsz;
}

typedef int i32x8 __attribute__((ext_vector_type(8)));
typedef int i32x4_ __attribute__((ext_vector_type(4)));
template <bool F8, class Epi, class Sched>
__device__ __forceinline__ void gemm_phase(LAS unsigned char* lds, const int RP, const Sched& S, const Epi& E, const int SCA = 0x7F7F7F7F, const int SCB = 0x7F7F7F7F, const int pid = -1, unsigned long long* tprobe = nullptr) {
    const int tid = otid(), wid = __builtin_amdgcn_readfirstlane(tid >> 6), lane = tid & 63, wr = wid >> 2, wc = wid & 3, fr = lane & 15, fq = lane >> 4;
    const int nt = RP / 128;
    unsigned voffB[2];
#pragma unroll
    for (int i = 0; i < 2; ++i) { int R, C; stage_rc(tid * 16 + i * 8192, R, C); const int Rb = (R & ~31) + perm32(R & 31); voffB[i] = (unsigned)(Rb * RP + C * 2); }
    const size_t kstep = (size_t)128;
    const size_t hstepB = (size_t)HALF * RP;
    const unsigned ldsw = (unsigned)wid * 1024u;
    const int aoff = lds_byte(wr * 64 + fr, fq * 8);
    const int boff = lds_byte(wc * 32 + fr, fq * 8);
    constexpr int KOFF = 1024;
#define G_SA(b, h) (((b) * 2 + (h)) * HTB)
#define G_SB(b, h) ((4 + (b) * 2 + (h)) * HTB)
#define G_STAGEB(bufoff, gbase) do { _Pragma("unroll") for (int _i = 0; _i < 2; ++_i) \
        __builtin_amdgcn_global_load_lds((const unsigned*)((const char*)(gbase) + voffB[_i]), (LAS unsigned*)(lds + (bufoff) + ldsw + _i * 8192), 16, 0, 0); } while (0)
#define G_STAGEA(bufoff, offs, h, kb) do { _Pragma("unroll") for (int _i = 0; _i < 2; ++_i) \
        __builtin_amdgcn_global_load_lds((const unsigned*)(S.abase() + (size_t)(offs)[h][_i] + (kb)), (LAS unsigned*)(lds + (bufoff) + ldsw + _i * 8192), 16, 0, 0); } while (0)
#define G_LDA(dst, b, h) do { _Pragma("unroll") for (int m = 0; m < 4; ++m) _Pragma("unroll") for (int k = 0; k < 2; ++k) dst[m][k] = *(const LAS bf16x8*)(lds + G_SA(b, h) + aoff + m * 2048 + k * KOFF); } while (0)
#define G_LDB(dst, b, h) do { _Pragma("unroll") for (int n = 0; n < 2; ++n) _Pragma("unroll") for (int k = 0; k < 2; ++k) dst[n][k] = *(const LAS bf16x8*)(lds + G_SB(b, h) + boff + n * 2048 + k * KOFF); } while (0)
#define G_CAT8(x) __builtin_shufflevector(__builtin_bit_cast(i32x4_, (x)[0]), __builtin_bit_cast(i32x4_, (x)[1]), 0, 1, 2, 3, 4, 5, 6, 7)
#define G_MMA(ai, bj, At, Bt) do { __builtin_amdgcn_s_setprio(1); \
        if constexpr (F8) { _Pragma("unroll") for (int m = 0; m < 4; ++m) _Pragma("unroll") for (int n = 0; n < 2; ++n) \
            acc[ai][bj][m][n] = __builtin_amdgcn_mfma_scale_f32_16x16x128_f8f6f4(G_CAT8(Bt[n]), G_CAT8(At[m]), acc[ai][bj][m][n], 0, 0, 0, 0, 0, 0); } \
        else { _Pragma("unroll") for (int m = 0; m < 4; ++m) _Pragma("unroll") for (int n = 0; n < 2; ++n) _Pragma("unroll") for (int k = 0; k < 2; ++k) \
            acc[ai][bj][m][n] = __builtin_amdgcn_mfma_f32_16x16x32_bf16(Bt[n][k], At[m][k], acc[ai][bj][m][n], 0, 0, 0); } \
        __builtin_amdgcn_s_setprio(0); } while (0)
#define G_WAIT_V(n) asm volatile("s_waitcnt vmcnt(" #n ")" ::: "memory")
#define G_WAIT_L(n) asm volatile("s_waitcnt lgkmcnt(" #n ")" ::: "memory")
#define G_BAR __builtin_amdgcn_s_barrier()
#define G_SCHED __builtin_amdgcn_sched_barrier(0)
    Unit cur, nxt; int ui = 0;
#ifndef GP_PROBE
#define GP_PROBE 0
#endif
#ifndef GP_PROBE_PID
#define GP_PROBE_PID 8
#endif
    unsigned tp_k = 0, tp_e = 0, tp_s = 0, tp_0 = 0, tp_1 = 0;
#define TP_NOW() ((unsigned)__builtin_amdgcn_readfirstlane((int)(unsigned)wall_clock64()))
    const bool tp_on = GP_PROBE && pid == GP_PROBE_PID;
    if (tp_on) tp_0 = TP_NOW();
    if (!S.next(0, cur)) return;
    f32x4 acc[2][2][4][2];
#pragma unroll
    for (int a = 0; a < 2; ++a)
#pragma unroll
        for (int b = 0; b < 2; ++b)
#pragma unroll
            for (int m = 0; m < 4; ++m)
#pragma unroll
                for (int n = 0; n < 2; ++n) acc[a][b][m][n] = (f32x4){0.f, 0.f, 0.f, 0.f};
    bf16x8 At[4][2], B0[2][2], B1[2][2];
    unsigned cAo[2][2];
    S.a_off(cur, cAo);
    const char* cB = S.b_ptr(cur);
    S.prefetch_bias(cur, lds, 0, wid, lane, wc);
    S.prefetch_rows(cur, lds, 0, wid, lane);
    G_STAGEB(G_SB(0, 0), cB); G_STAGEA(G_SA(0, 0), cAo, 0, 0); G_STAGEB(G_SB(0, 1), cB + hstepB); G_STAGEA(G_SA(0, 1), cAo, 1, 0);
    if (wr == 1) G_BAR;
    G_WAIT_V(4); G_BAR;
    G_STAGEB(G_SB(1, 0), cB + kstep); G_STAGEA(G_SA(1, 0), cAo, 0, kstep); G_STAGEB(G_SB(1, 1), cB + hstepB + kstep);
    G_WAIT_V(6); G_BAR;
    for (;;) {
        const bool has_next = S.next(ui + 1, nxt);
        const char* nB = cB;
        if (has_next) { S.prefetch_rows(nxt, lds, (ui + 1) & 1, wid, lane); S.prefetch_bias(nxt, lds, (ui + 1) & 1, wid, lane, wc); nB = S.b_ptr(nxt); }
        if (tp_on) tp_s = TP_NOW();
        for (int t = 0; t < nt; t += 2) {
            const bool last = (t == nt - 2);
            const size_t k1 = (size_t)(t + 1) * kstep;
            G_LDB(B0, 0, 0); G_SCHED; G_LDA(At, 0, 0); G_STAGEA(G_SA(1, 1), cAo, 1, k1);
            if (last) { if (has_next) S.a_off_lds(nxt, lds, (ui + 1) & 1, wid, lane, cAo); cB = nB; }
            const size_t k2 = last ? 0 : (size_t)(t + 2) * kstep;
            const size_t k3 = k2 + kstep;
            const char* b2 = cB + k2; const char* b3 = b2 + kstep;
            G_WAIT_L(8); G_BAR; G_WAIT_L(0); G_MMA(0, 0, At, B0); G_BAR; G_SCHED;
            G_LDB(B1, 0, 1); G_STAGEB(G_SB(0, 0), b2);
            G_BAR; G_WAIT_L(0); G_MMA(0, 1, At, B1); G_BAR;
            G_LDA(At, 0, 1); G_STAGEA(G_SA(0, 0), cAo, 0, k2);
            G_BAR; G_WAIT_L(0); G_MMA(1, 0, At, B0); G_BAR; G_SCHED;
            G_STAGEB(G_SB(0, 1), b2 + hstepB);
            G_WAIT_V(6); G_BAR; G_MMA(1, 1, At, B1); G_BAR;
            G_LDB(B0, 1, 0); G_SCHED; G_LDA(At, 1, 0); G_STAGEA(G_SA(0, 1), cAo, 1, k2);
            G_WAIT_L(8); G_BAR; G_WAIT_L(0); G_MMA(0, 0, At, B0); G_BAR; G_SCHED;
            G_LDB(B1, 1, 1); G_STAGEB(G_SB(1, 0), b3);
            G_BAR; G_WAIT_L(0); G_MMA(0, 1, At, B1); G_BAR;
            G_LDA(At, 1, 1); G_STAGEA(G_SA(1, 0), cAo, 0, k3);
            G_BAR; G_WAIT_L(0); G_MMA(1, 0, At, B0); G_BAR; G_SCHED;
            G_STAGEB(G_SB(1, 1), b3 + hstepB);
            G_WAIT_V(6); G_BAR; G_MMA(1, 1, At, B1); G_BAR;
        }
        if (tp_on) { tp_1 = TP_NOW(); tp_k += tp_1 - tp_s; }
        const float osc = F8 ? __builtin_ldexpf(1.0f, ((SCA & 0xFF) - 127) + ((SCB & 0xFF) - 127)) : 1.0f;
        if constexpr (F8 && !Epi::FOLD) {
#pragma unroll
            for (int a = 0; a < 2; ++a)
#pragma unroll
                for (int b = 0; b < 2; ++b)
#pragma unroll
                    for (int m = 0; m < 4; ++m)
#pragma unroll
                        for (int n = 0; n < 2; ++n) acc[a][b][m][n] *= osc; }
        E(acc, cur, wr, wc, fr, fq, (const LAS float*)(lds + XB_OFF + ((ui & 1) * 8 + wid) * 256), (const LAS int*)(lds + XT_OFF + ((ui & 1) * 8 + wid) * 1024), osc);
        if (tp_on) tp_e += TP_NOW() - tp_1;
        if (!has_next) break;
#pragma unroll
        for (int a = 0; a < 2; ++a)
#pragma unroll
            for (int b = 0; b < 2; ++b)
#pragma unroll
                for (int m = 0; m < 4; ++m)
#pragma unroll
                    for (int n = 0; n < 2; ++n) acc[a][b][m][n] = (f32x4){0.f, 0.f, 0.f, 0.f};
        cur = nxt; ++ui;
    }
    G_WAIT_V(0);
    if (wr == 0) G_BAR;
    G_BAR;
    if (tp_on && blockIdx.x == 0 && tid == 0) { const unsigned tot = TP_NOW() - tp_0; *tprobe = (unsigned long long)((GP_PROBE == 1) ? tp_k : (GP_PROBE == 2) ? tp_e : tot); }
#undef G_SA
#undef G_SB
#undef G_STAGEA
#undef G_STAGEB
#undef G_LDA
#undef G_LDB
#undef G_MMA
#undef G_CAT8
#undef G_WAIT_V
#undef G_WAIT_L
#undef G_BAR
#undef G_SCHED
}

__device__ __forceinline__ void lane_rc(int i, int& R, int& Cb) { int C; stage_rc(otid() * 16 + i * 8192, R, C); Cb = C * 2; }

struct SchedDense {
    const char* A; const char* B; int RP, nM, nN, G, c;
    __device__ __forceinline__ const char* abase() const { return A; }
    __device__ __forceinline__ bool next(int i, Unit& u) const { const long L = (long)i * G + c; if (L >= (long)nM * nN) return false; dense_map((int)L, nM, nN, u.pm, u.pn); u.e = 0; return true; }
    __device__ __forceinline__ void a_off(const Unit& u, unsigned (&o)[2][2]) const {
#pragma unroll
        for (int i = 0; i < 2; ++i) { int R, Cb; lane_rc(i, R, Cb);
#pragma unroll
            for (int h = 0; h < 2; ++h) o[h][i] = (unsigned)(u.pm * BM + h * HALF + R) * (unsigned)RP + (unsigned)Cb; }
    }
    __device__ __forceinline__ void prefetch_rows(const Unit&, LAS unsigned char*, int, int, int) const {}
    __device__ __forceinline__ void prefetch_bias(const Unit&, LAS unsigned char*, int, int, int, int) const {}
    __device__ __forceinline__ void a_off_lds(const Unit& u, LAS unsigned char*, int, int, int, unsigned (&o)[2][2]) const { a_off(u, o); }
    __device__ __forceinline__ const char* b_ptr(const Unit& u) const { return B + (size_t)u.pn * BM * RP; }
};
struct SchedIn0 {
    const char* A; const char* B; int G, c;
    __device__ __forceinline__ const char* abase() const { return A; }
    __device__ __forceinline__ bool next(int i, Unit& u) const {
        const long L = (long)i * G + c; u.e = 0;
        if (L < 256 * 15) { dense_map((int)L, 256, 15, u.pm, u.pn); return true; }
        const int r = (int)(L - 256 * 15); if (r >= 56) return false;
        u.pm = 256 + r / 7; const int q = r % 7; u.pn = (q < 6) ? (2 + q) : 14; return true;
    }
    __device__ __forceinline__ void a_off(const Unit& u, unsigned (&o)[2][2]) const {
#pragma unroll
        for (int i = 0; i < 2; ++i) { int R, Cb; lane_rc(i, R, Cb);
#pragma unroll
            for (int h = 0; h < 2; ++h) o[h][i] = (unsigned)(u.pm * BM + h * HALF + R) * (F8_IN0 ? 1024u : 2048u) + (unsigned)Cb; }
    }
    __device__ __forceinline__ void prefetch_rows(const Unit&, LAS unsigned char*, int, int, int) const {}
    __device__ __forceinline__ void prefetch_bias(const Unit&, LAS unsigned char*, int, int, int, int) const {}
    __device__ __forceinline__ void a_off_lds(const Unit& u, LAS unsigned char*, int, int, int, unsigned (&o)[2][2]) const { a_off(u, o); }
    __device__ __forceinline__ const char* b_ptr(const Unit& u) const { return B + (size_t)u.pn * BM * (F8_IN0 ? 1024 : 2048); }
};
constexpr unsigned long long in0_tile_tab(unsigned mask) { unsigned long long t = 0; int n = 0; for (int pn = 0; pn < 15; ++pn) if ((mask >> pn) & 1) { t |= (unsigned long long)pn << (4 * n); ++n; } return t; }
constexpr int in0_tile_cnt(unsigned mask) { int n = 0; for (int pn = 0; pn < 15; ++pn) n += (mask >> pn) & 1; return n; }
template <unsigned MASK, bool F8, bool CTX, bool REDEAL = false>
struct SchedIn0Sub {
    static constexpr unsigned long long TAB = in0_tile_tab(MASK); static constexpr int NT = in0_tile_cnt(MASK); static constexpr unsigned PITCH = F8 ? 1024u : 2048u;
    const char* A; const char* B; int G, c;
    __device__ __forceinline__ const char* abase() const { return A; }
    __device__ __forceinline__ bool next(int i, Unit& u) const {
        long L = (long)i * G + c; u.e = 0;
        if (!CTX && REDEAL && G == 256) {
            const int full = NT - 1;
            if (i < full) L = (long)i * 256 + c;
            else if (i == full) { if (c < 56) return false; L = (long)full * 256 + (c - 56); }
            else if (i == full + 1) { if (c < 56 || c >= 112) return false; L = (long)full * 256 + 200 + (c - 56); }
            else return false; }
        if (L < 256 * NT) { int idx; dense_map((int)L, 256, NT, u.pm, idx); u.pn = (int)((TAB >> (4 * idx)) & 15ull); return true; }
        if (!CTX) return false;
        const int r = (int)(L - 256 * NT); if (r >= 56) return false;
        u.pm = 256 + r / 7; const int q = r % 7; u.pn = (q < 6) ? (2 + q) : 14; return true;
    }
    __device__ __forceinline__ void a_off(const Unit& u, unsigned (&o)[2][2]) const {
#pragma unroll
        for (int i = 0; i < 2; ++i) { int R, Cb; lane_rc(i, R, Cb);
#pragma unroll
            for (int h = 0; h < 2; ++h) o[h][i] = (unsigned)(u.pm * BM + h * HALF + R) * PITCH + (unsigned)Cb; }
    }
    __device__ __forceinline__ void prefetch_rows(const Unit&, LAS unsigned char*, int, int, int) const {}
    __device__ __forceinline__ void prefetch_bias(const Unit&, LAS unsigned char*, int, int, int, int) const {}
    __device__ __forceinline__ void a_off_lds(const Unit& u, LAS unsigned char*, int, int, int, unsigned (&o)[2][2]) const { a_off(u, o); }
    __device__ __forceinline__ const char* b_ptr(const Unit& u) const { return B + (size_t)u.pn * BM * PITCH; }
};
struct SchedMoE {
    const char* A; const char* B; const int* slot_tok; int ts; int RT; int nct; int G, c; size_t bstride_e; bool gather; const float* bias; const int* slot_dst;
    __device__ __forceinline__ const char* abase() const { return A; }
    __device__ __forceinline__ bool next(int i, Unit& u) const {
        const int x = c & 7, j = c >> 3; int rt, ct;
        if (nct == 8) { rt = 32 * i + 4 * x + (j & 3); ct = j >> 2; } else { rt = 64 * i + 8 * x + (j & 7); ct = j >> 3; }
        if (rt >= RT) return false;
        const unsigned long long m = __ballot(((otid() & 63) < 32) && ts <= rt);
        u.pm = rt; u.pn = ct; u.e = __builtin_amdgcn_readfirstlane(__popcll(m)) - 1; return true;
    }
    __device__ __forceinline__ void a_off(const Unit& u, unsigned (&o)[2][2]) const {
#pragma unroll
        for (int i = 0; i < 2; ++i) { int R, Cb; lane_rc(i, R, Cb);
#pragma unroll
            for (int h = 0; h < 2; ++h) { const int row = u.pm * BM + h * HALF + R; const unsigned rr = gather ? (unsigned)slot_tok[row] : (unsigned)row; o[h][i] = rr * 1024u + (unsigned)Cb; } }
    }
    __device__ __forceinline__ const char* b_ptr(const Unit& u) const { return B + (size_t)u.e * bstride_e + (size_t)u.pn * BM * 1024; }
    __device__ __forceinline__ void prefetch_rows(const Unit& u, LAS unsigned char* lds, int par, int wid, int lane) const {
        if (!gather) { if (!slot_dst) return;
#pragma unroll
            for (int ai = 0; ai < 2; ++ai) __builtin_amdgcn_global_load_lds((const unsigned*)(slot_dst + (u.pm * BM + ai * HALF + (wid >> 2) * 64 + lane)), (LAS unsigned*)(lds + XT_OFF + ((par * 8 + wid) * 4 + ai) * 256), 4, 0, 0);
            return; }
        { const int g = lane >> 4;
          __builtin_amdgcn_global_load_lds((const unsigned*)(slot_tok + (u.pm * BM + (g >> 1) * HALF + 16 * ((wid >> 1) + 4 * (g & 1)) + (lane & 15))), (LAS unsigned*)(lds + XT_OFF + (par * 8 + wid) * 1024), 4, 0, 0); }
    }
    __device__ __forceinline__ void prefetch_bias(const Unit& u, LAS unsigned char* lds, int par, int wid, int lane, int wc) const {
        const float* src = (nct == 8) ? bias + (size_t)u.e * 2048 + (lane >> 5) * 1024 + u.pn * 128 + wc * 32 + (lane & 31)
                                      : bias + (size_t)u.e * 1024 + u.pn * 256 + (lane >> 5) * 128 + wc * 32 + (lane & 31);
        __builtin_amdgcn_global_load_lds((const unsigned*)src, (LAS unsigned*)(lds + XB_OFF + (par * 8 + wid) * 256), 4, 0, 0);
    }
    __device__ __forceinline__ void a_off_lds(const Unit& u, LAS unsigned char* lds, int par, int wid, int lane, unsigned (&o)[2][2]) const {
#pragma unroll
        for (int i = 0; i < 2; ++i) { int R, Cb; lane_rc(i, R, Cb);
#pragma unroll
            for (int h = 0; h < 2; ++h) { const unsigned rr = gather ? *(const LAS unsigned*)(lds + XT_OFF + (par * 8 + wid) * 1024 + ((h * 2 + i) * 16 + (lane >> 2)) * 4) : (unsigned)(u.pm * BM + h * HALF + R); o[h][i] = rr * 1024u + (unsigned)Cb; } }
    }
};

__device__ __forceinline__ void store8(bf16* p, const f32x4& v0, const f32x4& v1) {
    u32x4 w; w.x = cvt_pk(v0[0], v0[1]); w.y = cvt_pk(v0[2], v0[3]); w.z = cvt_pk(v1[0], v1[1]); w.w = cvt_pk(v1[2], v1[3]);
    *(u32x4*)p = w;
}
struct EpiPlain {
    static constexpr bool FOLD = false;
    bf16* O; int ldc;
    __device__ __forceinline__ void operator()(const f32x4 (&acc)[2][2][4][2], const Unit& u, int wr, int wc, int fr, int fq, const LAS float* lb, const LAS int* xt, const float osc) const {
        const int row0 = u.pm * BM + wr * 64 + fr, col0 = u.pn * BM + wc * 32 + 8 * fq;
#pragma unroll
        for (int ai = 0; ai < 2; ++ai)
#pragma unroll
            for (int m = 0; m < 4; ++m) { bf16* rowp = O + (size_t)(row0 + ai * HALF + m * 16) * ldc + col0;
#pragma unroll
                for (int bj = 0; bj < 2; ++bj) store8(rowp + bj * HALF, acc[ai][bj][m][0], acc[ai][bj][m][1]); }
    }
};
struct EpiIn0 {
    static constexpr bool FOLD = false;
    unsigned char* ws;
    __device__ __forceinline__ void operator()(const f32x4 (&acc)[2][2][4][2], const Unit& u, int wr, int wc, int fr, int fq, const LAS float* lb, const LAS int* xt, const float osc) const {
        const int pn = u.pn; bf16* base; int ldc, c0;
        if (pn < 2) { base = (bf16*)(ws + WS_Q); ldc = 512; c0 = pn * 256; }
        else if (pn < 4) { base = (bf16*)(ws + WS_K); ldc = 512; c0 = (pn - 2) * 256; }
        else if (pn < 8) { base = (bf16*)(ws + WS_V); ldc = 1024; c0 = (pn - 4) * 256; }
        else if (pn < 12) { base = (bf16*)(ws + WS_R); ldc = 1024; c0 = (pn - 8) * 256; }
        else if (pn < 14) { base = (bf16*)(ws + WS_ZC); ldc = 512; c0 = (pn - 12) * 256; }
        else { base = (bf16*)(ws + WS_LR); ldc = 32; c0 = 0; }
        const int row0 = u.pm * BM + wr * 64 + fr, col0 = c0 + wc * 32 + 8 * fq;
        const bool lr = (pn == 14);
        if (lr && wc != 0) return;
        const float qs = (pn < 2) ? 0.08838834764831845f : 1.0f;
#pragma unroll
        for (int ai = 0; ai < 2; ++ai)
#pragma unroll
            for (int m = 0; m < 4; ++m) { bf16* rowp = base + (size_t)(row0 + ai * HALF + m * 16) * ldc + col0;
                store8(rowp, acc[ai][0][m][0] * qs, acc[ai][0][m][1] * qs);
                if (!lr) store8(rowp + HALF, acc[ai][1][m][0] * qs, acc[ai][1][m][1] * qs); }
    }
};
struct EpiIn1 {
    static constexpr bool FOLD = false;
    unsigned char* ws;
    __device__ __forceinline__ void operator()(const f32x4 (&acc)[2][2][4][2], const Unit& u, int wr, int wc, int fr, int fq, const LAS float* lb, const LAS int* xt, const float osc) const {
        const int pn = u.pn; const int row0 = u.pm * BM + wr * 64 + fr;
        if (pn >= 8) { bf16* O = (bf16*)(ws + WS_GB); const int col0 = (pn - 8) * 256 + wc * 32 + 8 * fq;
#pragma unroll
            for (int ai = 0; ai < 2; ++ai)
#pragma unroll
                for (int m = 0; m < 4; ++m) { bf16* rowp = O + (size_t)(row0 + ai * HALF + m * 16) * 512 + col0;
#pragma unroll
                    for (int bj = 0; bj < 2; ++bj) store8(rowp + bj * HALF, acc[ai][bj][m][0], acc[ai][bj][m][1]); }
            return; }
        const bool glu = pn < 4; bf16* O = (bf16*)(ws + (glu ? WS_GLU : WS_ZC1)); const int col0 = (pn & 3) * 128 + wc * 32 + 8 * fq;
#pragma unroll
        for (int ai = 0; ai < 2; ++ai)
#pragma unroll
            for (int m = 0; m < 4; ++m) { f32x4 o[2];
#pragma unroll
                for (int n = 0; n < 2; ++n)
#pragma unroll
                    for (int i = 0; i < 4; i += 2) { const f32v2_t a = (f32v2_t){acc[ai][0][m][n][i], acc[ai][0][m][n][i + 1]}, b = (f32v2_t){acc[ai][1][m][n][i], acc[ai][1][m][n][i + 1]};
                        f32v2_t ov;
                        if (glu) { const f32v2_t ea = b * -1.4426950408889634f; f32v2_t e; e.x = __builtin_amdgcn_exp2f(ea.x); e.y = __builtin_amdgcn_exp2f(ea.y);
                            const f32v2_t d = e + 1.0f; f32v2_t r; r.x = __builtin_amdgcn_rcpf(d.x); r.y = __builtin_amdgcn_rcpf(d.y); ov = a * r; }
                        else ov = a * b;
                        o[n][i] = ov.x; o[n][i + 1] = ov.y; }
                store8(O + (size_t)(row0 + ai * HALF + m * 16) * 512 + col0, o[0], o[1]); }
    }
};
struct EpiGU {
    static constexpr bool FOLD = true;
    unsigned char* O; const float* bgu; int probe;
    __device__ __forceinline__ void operator()(const f32x4 (&acc)[2][2][4][2], const Unit& u, int wr, int wc, int fr, int fq, const LAS float* lb, const LAS int* xt, const float osc) const {
        if (probe) {
#pragma unroll
            for (int a = 0; a < 2; ++a)
#pragma unroll
                for (int b = 0; b < 2; ++b)
#pragma unroll
                    for (int m = 0; m < 4; ++m)
#pragma unroll
                        for (int n = 0; n < 2; ++n) asm volatile("" :: "v"(acc[a][b][m][n]));
            return; }
        const int row0 = u.pm * BM + wr * 64 + fr + 16 * (fq & 1), col0 = u.pn * 128 + wc * 32 + 16 * (fq >> 1);
        f32x4 bgv[2], buv[2];
#pragma unroll
        for (int n = 0; n < 2; ++n) { bgv[n] = *(const LAS f32x4*)(lb + 8 * fq + 4 * n); buv[n] = *(const LAS f32x4*)(lb + 32 + 8 * fq + 4 * n); }
#pragma unroll
        for (int ai = 0; ai < 2; ++ai)
#pragma unroll
            for (int mp = 0; mp < 2; ++mp) { unsigned wq[2][2];
#pragma unroll
              for (int mm = 0; mm < 2; ++mm) { const int m = 2 * mp + mm; f32x4 o[2];
#pragma unroll
                for (int n = 0; n < 2; ++n)
#pragma unroll
                    for (int i = 0; i < 4; i += 2) {
                        f32v2_t g = (f32v2_t){acc[ai][0][m][n][i], acc[ai][0][m][n][i + 1]} * osc + (f32v2_t){bgv[n][i], bgv[n][i + 1]};
                        f32v2_t uu = (f32v2_t){acc[ai][1][m][n][i], acc[ai][1][m][n][i + 1]} * osc + (f32v2_t){buv[n][i], buv[n][i + 1]};
                        g.x = fminf(g.x, 7.0f); g.y = fminf(g.y, 7.0f);
                        uu.x = __builtin_amdgcn_fmed3f(uu.x, -7.0f, 7.0f); uu.y = __builtin_amdgcn_fmed3f(uu.y, -7.0f, 7.0f);
                        const f32v2_t ea = g * (-1.702f * 1.4426950408889634f);
                        f32v2_t e; e.x = __builtin_amdgcn_exp2f(ea.x); e.y = __builtin_amdgcn_exp2f(ea.y);
                        const f32v2_t d = e + 1.0f;
                        f32v2_t r; r.x = __builtin_amdgcn_rcpf(d.x); r.y = __builtin_amdgcn_rcpf(d.y);
                        const f32v2_t t4 = uu * 4.0f + 4.0f;
                        const f32v2_t ov = (g * r) * t4;
                        o[n][i] = ov.x; o[n][i + 1] = ov.y; }
                int w0 = 0, w1 = 0;
                w0 = __builtin_amdgcn_cvt_pk_fp8_f32(o[0][0], o[0][1], w0, false); w0 = __builtin_amdgcn_cvt_pk_fp8_f32(o[0][2], o[0][3], w0, true);
                w1 = __builtin_amdgcn_cvt_pk_fp8_f32(o[1][0], o[1][1], w1, false); w1 = __builtin_amdgcn_cvt_pk_fp8_f32(o[1][2], o[1][3], w1, true);
                wq[mm][0] = (unsigned)w0; wq[mm][1] = (unsigned)w1; }
              swap16_pair(wq[0][0], wq[1][0]); swap16_pair(wq[0][1], wq[1][1]);
              *(u32x4*)(O + (size_t)(row0 + ai * HALF + mp * 32) * 1024 + col0) = (u32x4){wq[0][0], wq[0][1], wq[1][0], wq[1][1]}; }
    }
};
struct EpiDown {
    static constexpr bool FOLD = true;
    unsigned char* O; const float* bd;
    __device__ __forceinline__ void operator()(const f32x4 (&acc)[2][2][4][2], const Unit& u, int wr, int wc, int fr, int fq, const LAS float* lb, const LAS int* xt, const float osc) const {
        const int row0 = u.pm * BM + wr * 64 + fr + 16 * (fq & 1), col0 = u.pn * BM + wc * 32 + 16 * (fq >> 1);
        f32x4 bv[2][2];
#pragma unroll
        for (int bj = 0; bj < 2; ++bj)
#pragma unroll
            for (int n = 0; n < 2; ++n) bv[bj][n] = *(const LAS f32x4*)(lb + 32 * bj + 8 * fq + 4 * n) * 16.0f;
#pragma unroll
        for (int ai = 0; ai < 2; ++ai)
#pragma unroll
            for (int mp = 0; mp < 2; ++mp) { unsigned char* rowp = O + (size_t)(row0 + ai * HALF + mp * 32) * 1024 + col0;
#pragma unroll
                for (int bj = 0; bj < 2; ++bj) { unsigned wq[2][2];
#pragma unroll
                    for (int mm = 0; mm < 2; ++mm) { const int m = 2 * mp + mm;
                        const f32x4 v0 = acc[ai][bj][m][0] * (16.0f * osc) + bv[bj][0], v1 = acc[ai][bj][m][1] * (16.0f * osc) + bv[bj][1];
                        int w0 = 0, w1 = 0;
                        w0 = __builtin_amdgcn_cvt_pk_fp8_f32(fminf(fmaxf(v0[0], -440.f), 440.f), fminf(fmaxf(v0[1], -440.f), 440.f), w0, false); w0 = __builtin_amdgcn_cvt_pk_fp8_f32(fminf(fmaxf(v0[2], -440.f), 440.f), fminf(fmaxf(v0[3], -440.f), 440.f), w0, true);
                        w1 = __builtin_amdgcn_cvt_pk_fp8_f32(fminf(fmaxf(v1[0], -440.f), 440.f), fminf(fmaxf(v1[1], -440.f), 440.f), w1, false); w1 = __builtin_amdgcn_cvt_pk_fp8_f32(fminf(fmaxf(v1[2], -440.f), 440.f), fminf(fmaxf(v1[3], -440.f), 440.f), w1, true);
                        wq[mm][0] = (unsigned)w0; wq[mm][1] = (unsigned)w1; }
                    swap16_pair(wq[0][0], wq[1][0]); swap16_pair(wq[0][1], wq[1][1]);
                    *(u32x4*)(rowp + bj * HALF) = (u32x4){wq[0][0], wq[0][1], wq[1][0], wq[1][1]}; } }
    }
};
}

__device__ __forceinline__ void p0_adaln(const Ctx& C) {
    PH_IDS;
    LAS float* s = (LAS float*)C.lds;
    LAS float* red = (LAS float*)(C.lds + 36864);
    const float* cc = C.a->in[IN_C]; const float* cx = C.a->in[IN_CCTX];
    { float tmpc[18];
#pragma unroll
      for (int q = 0; q < 18; ++q) { const int i = tid + 512 * q; const int b = i >> 10, k = i & 1023; tmpc[q] = (b < 8) ? cc[b * 1024 + k] : cx[k]; }
#pragma unroll
      for (int q = 0; q < 18; ++q) s[tid + 512 * q] = siluf_(tmpc[q]); }
    __syncthreads();
    float* MOD = (float*)(C.ws + WS_MOD);
    for (int item = blockIdx.x; item < 192; item += C.G) {
        const int l = item / 96, cb = item % 96, col = cb * 64 + lane;
        const float* W = C.a->in[IN_MODW] + (size_t)l * 1024 * 6144 + col;
        float acc[9];
#pragma unroll
        for (int b = 0; b < 9; ++b) acc[b] = 0.f;
        const int k0 = wave * 128;
#pragma unroll 128
        for (int k = k0; k < k0 + 128; ++k) { const float w = W[(size_t)k * 6144];
#pragma unroll
            for (int b = 0; b < 9; ++b) acc[b] += s[b * 1024 + k] * w; }
#pragma unroll
        for (int b = 0; b < 9; ++b) red[(wave * 9 + b) * 64 + lane] = acc[b];
        __syncthreads();
        for (int i = tid; i < 576; i += 512) { const int b = i >> 6, ln = i & 63; float v = 0.f;
#pragma unroll
            for (int w = 0; w < 8; ++w) v += red[(w * 9 + b) * 64 + ln];
            v += C.a->in[IN_MODB][l * 6144 + cb * 64 + ln];
            MOD[(size_t)(l * 9 + b) * 6144 + cb * 64 + ln] = v; }
        __syncthreads();
    }
}
__device__ __forceinline__ void p0_tr_item(const float* W, int ldw, int sc0, int k0, bf16* WT, int Kd, int dr0, float scale, LAS float* scr, int lane) {
#pragma unroll 8
    for (int i = 0; i < 32; ++i) { const int kk = 2 * i + (lane >> 5); scr[kk * 33 + (lane & 31)] = W[(size_t)(k0 + kk) * ldw + sc0 + (lane & 31)]; }
    asm volatile("s_waitcnt lgkmcnt(0)" ::: "memory");
    const int c = lane & 7;
#pragma unroll
    for (int j = 0; j < 4; ++j) { const int n = (lane >> 3) + 8 * j; const LAS float* sp = scr + (8 * c) * 33 + n;
        u32x4 o; o.x = cvt_pk(sp[0 * 33] * scale, sp[1 * 33] * scale); o.y = cvt_pk(sp[2 * 33] * scale, sp[3 * 33] * scale);
        o.z = cvt_pk(sp[4 * 33] * scale, sp[5 * 33] * scale); o.w = cvt_pk(sp[6 * 33] * scale, sp[7 * 33] * scale);
        *(u32x4*)(WT + (size_t)(dr0 + n) * Kd + k0 + 8 * c) = o; }
    asm volatile("s_waitcnt lgkmcnt(0)" ::: "memory");
}
__device__ __forceinline__ void p0_tr_item8(const float* W, int ldw, int sc0, int k0, unsigned char* WT, int Kd, int dr0, float scale, LAS float* scr, int lane) {
#pragma unroll 8
    for (int i = 0; i < 64; ++i) { const int kk = 2 * i + (lane >> 5); scr[kk * 33 + (lane & 31)] = W[(size_t)(k0 + kk) * ldw + sc0 + (lane & 31)]; }
    asm volatile("s_waitcnt lgkmcnt(0)" ::: "memory");
    const int c = lane & 7;
#pragma unroll
    for (int j = 0; j < 4; ++j) { const int n = (lane >> 3) + 8 * j; const LAS float* sp = scr + (16 * c) * 33 + n;
        int w[4];
#pragma unroll
        for (int q = 0; q < 4; ++q) { int x = 0;
            x = __builtin_amdgcn_cvt_pk_fp8_f32(sp[(4 * q) * 33] * scale, sp[(4 * q + 1) * 33] * scale, x, false);
            x = __builtin_amdgcn_cvt_pk_fp8_f32(sp[(4 * q + 2) * 33] * scale, sp[(4 * q + 3) * 33] * scale, x, true); w[q] = x; }
        *(u32x4*)(WT + (size_t)(dr0 + n) * Kd + k0 + 16 * c) = (u32x4){(unsigned)w[0], (unsigned)w[1], (unsigned)w[2], (unsigned)w[3]}; }
    asm volatile("s_waitcnt lgkmcnt(0)" ::: "memory");
}
__device__ __forceinline__ int gu_src_col(int dr0) { const int pn = dr0 >> 8, bj = (dr0 >> 7) & 1, t0 = dr0 & 127; return bj * 1024 + 128 * pn + t0; }
__device__ __forceinline__ int in1_src_col(int dr0) {
    const int pn = dr0 >> 8, bj = (dr0 >> 7) & 1, t0 = dr0 & 127;
    if (pn < 4) return bj * 512 + 128 * pn + t0;
    if (pn < 8) return (bj ? 2048 : 1536) + 128 * (pn - 4) + t0;
    return 1024 + (dr0 - 2048);
}
__device__ __forceinline__ void p0_convert(const Ctx& C) {
    PH_IDS;
    LAS float* scr = (LAS float*)(C.lds + wave * 16896);
    const int gw = blockIdx.x * 8 + wave, NGW = C.G * 8;
    constexpr int KB_IN0 = F8_IN0 ? 8 : 16, KB_OUT0 = F8_OUT0 ? 12 : 24, KB_IN1 = F8_IN1 ? 8 : 16, KB_OUT1 = F8_OUT1 ? 8 : 16;
    constexpr int I_IN0 = 97 * KB_IN0, I_OUT0 = 32 * KB_OUT0, I_IN1 = 80 * KB_IN1, I_OUT1 = 32 * KB_OUT1, I_GU = 64 * 64 * 8, I_D = 64 * 32 * 8;
    constexpr int I_IN0F8 = (!F8_IN0 && IN0_F8_TILES) ? 96 * 8 : 0;
    constexpr int NITEMS = I_IN0 + I_OUT0 + I_IN1 + I_OUT1 + I_GU + I_D + I_IN0F8;
    for (int it = gw; it < NITEMS; it += NGW) {
        int r = it;
        if (r < I_IN0) { const int nb = r / KB_IN0, kb = r % KB_IN0; int dr0, sc0;
            if (nb < 96) { dr0 = nb * 32; sc0 = dr0; } else { dr0 = 3584; sc0 = 3072; }
            if (F8_IN0) p0_tr_item8(C.a->in[IN_EVWIN], 3616, sc0, kb * 128, (unsigned char*)(C.ws + WS_WIN0), 1024, dr0, 32.f, scr, lane);
            else p0_tr_item(C.a->in[IN_EVWIN], 3616, sc0, kb * 64, (bf16*)(C.ws + WS_WIN0), 1024, dr0, 1.f, scr, lane);
            continue; }
        r -= I_IN0;
        if (r < I_OUT0) { const int nb = r / KB_OUT0, kb = r % KB_OUT0;
            if (F8_OUT0) p0_tr_item8(C.a->in[IN_EVWOUT], 1024, nb * 32, kb * 128, (unsigned char*)(C.ws + WS_WOUT0), 1536, nb * 32, 32.f, scr, lane);
            else p0_tr_item(C.a->in[IN_EVWOUT], 1024, nb * 32, kb * 64, (bf16*)(C.ws + WS_WOUT0), 1536, nb * 32, 1.f, scr, lane);
            continue; }
        r -= I_OUT0;
        if (r < I_IN1) { const int nb = r / KB_IN1, kb = r % KB_IN1;
            if (F8_IN1) p0_tr_item8(C.a->in[IN_ODWIN], 2560, in1_src_col(nb * 32), kb * 128, (unsigned char*)(C.ws + WS_WIN1), 1024, nb * 32, 32.f, scr, lane);
            else p0_tr_item(C.a->in[IN_ODWIN], 2560, in1_src_col(nb * 32), kb * 64, (bf16*)(C.ws + WS_WIN1), 1024, nb * 32, 1.f, scr, lane);
            continue; }
        r -= I_IN1;
        if (r < I_OUT1) { const int nb = r / KB_OUT1, kb = r % KB_OUT1;
            if (F8_OUT1) p0_tr_item8(C.a->in[IN_ODWOUT], 1024, nb * 32, kb * 128, (unsigned char*)(C.ws + WS_WOUT1), 1024, nb * 32, 32.f, scr, lane);
            else p0_tr_item(C.a->in[IN_ODWOUT], 1024, nb * 32, kb * 64, (bf16*)(C.ws + WS_WOUT1), 1024, nb * 32, 1.f, scr, lane);
            continue; }
        r -= I_OUT1;
        if (r < I_IN0F8) { const int nb = r >> 3, kb = r & 7;
            p0_tr_item8(C.a->in[IN_EVWIN], 3616, nb * 32, kb * 128, (unsigned char*)(C.ws + WS_WIN0F8), 1024, nb * 32, 32.f, scr, lane); continue; }
        r -= I_IN0F8;
        if (r < I_GU) { const int le = r >> 9, q = r & 511, nb = q >> 3, kb = q & 7;
            p0_tr_item8(C.a->in[IN_WGU] + (size_t)le * 1024 * 2048, 2048, gu_src_col(nb * 32), kb * 128, (unsigned char*)(C.ws + WS_WGU) + (size_t)le * 2048 * 1024, 1024, nb * 32, 32.f, scr, lane); continue; }
        r -= I_GU;
        { const int le = r >> 8, q = r & 255, nb = q >> 3, kb = q & 7;
            p0_tr_item8(C.a->in[IN_WD] + (size_t)le * 1024 * 1024, 1024, nb * 32, kb * 128, (unsigned char*)(C.ws + WS_WD) + (size_t)le * 1024 * 1024, 1024, nb * 32, 32.f, scr, lane); }
    }
    { u32x4* z = (u32x4*)((unsigned char*)(C.ws + WS_WIN0) + (size_t)3616 * 1024 * (F8_IN0 ? 1 : 2)); const int n16 = 224 * 1024 * (F8_IN0 ? 1 : 2) / 16;
      for (int i = blockIdx.x * 512 + tid; i < n16; i += C.G * 512) z[i] = (u32x4){0u, 0u, 0u, 0u}; }
    { bf16* F1 = (bf16*)(C.ws + WS_F1); bf16* F2 = (bf16*)(C.ws + WS_F2);
      for (int i = blockIdx.x * 512 + tid; i < 128 * 128 + 128 * 256; i += C.G * 512) {
          if (i < 128 * 128) { const int m = i >> 7, k = i & 127; const int mb = m >> 5, rr = m & 31, g = rr >> 3, hh = (rr >> 2) & 1, ii = rr & 3;
              const int part = g & 1, ap = 16 * mb + 8 * (g >> 1) + 4 * hh + ii, pin = k >> 6, a = k & 63;
              const float th = 6.283185307179586f * (float)((a * ap) & 63) * (1.0f / 64.0f); const float cs = cosf(th), sn = sinf(th);
              const float v = (part == 0) ? (pin == 0 ? cs : -sn) : (pin == 0 ? -sn : -cs);
              F1[i] = (bf16)f2bf(v); }
          else { const int q = i - 128 * 128, m = q >> 8, k = q & 255, pin = k >> 7, b = k & 127;
              const float ps = 6.283185307179586f * (float)((b * m) & 127) * (1.0f / 128.0f);
              F2[q] = (bf16)f2bf(pin == 0 ? cosf(ps) : sinf(ps)); } } }
    __syncthreads();
}
__device__ __forceinline__ void p0_fourier_fold(const Ctx& C) {
    PH_IDS;
    LAS float* Wl = (LAS float*)C.lds;
    LAS float* tab = (LAS float*)(C.lds + 32768);
    unsigned char* WT = (unsigned char*)(C.ws + WS_WIN0);
    for (int item = (C.G >= 256 ? (int)blockIdx.x - 192 : (int)blockIdx.x); item >= 0 && item < 64; item += C.G) {
        const int kb = item >> 2, g = item & 3;
        __syncthreads();
        if (tid < 128) tab[tid] = cosf(6.283185307179586f * (float)tid * (1.0f / 128.0f));
        { float tw[16];
#pragma unroll
          for (int q = 0; q < 16; ++q) { const int i = tid + 512 * q; const int kk = i >> 7, c = i & 127; tw[q] = C.a->in[IN_EVWIN][(size_t)(kb * 64 + kk) * 3616 + 3104 + g * 128 + c]; }
#pragma unroll
          for (int q = 0; q < 16; ++q) Wl[tid + 512 * q] = tw[q]; }
        __syncthreads();
        const int cp = tid & 127, kq = tid >> 7; const bool isS = cp > 64; const int cq = isS ? cp - 64 : cp, shf = isS ? 96 : 0;
        float ac[16];
#pragma unroll
        for (int i = 0; i < 16; ++i) ac[i] = 0.f;
#pragma unroll 8
        for (int c = 0; c < 128; ++c) { const float tr = tab[(c * cq + shf) & 127];
#pragma unroll
            for (int i = 0; i < 16; ++i) ac[i] += Wl[(kq * 16 + i) * 128 + c] * tr; }
        if (F8_IN0) {
            unsigned char* pc = WT + (size_t)(3072 + g * 128 + cp) * 1024 + kb * 64 + kq * 16;
            *(u32x4*)pc = (u32x4){pk4_fp8(ac[0], ac[1], ac[2], ac[3], 32.f), pk4_fp8(ac[4], ac[5], ac[6], ac[7], 32.f), pk4_fp8(ac[8], ac[9], ac[10], ac[11], 32.f), pk4_fp8(ac[12], ac[13], ac[14], ac[15], 32.f)};
        } else {
            bf16* pc = (bf16*)WT + (size_t)(3072 + g * 128 + cp) * 1024 + kb * 64 + kq * 16;
            *(u32x4*)pc = (u32x4){cvt_pk(ac[0], ac[1]), cvt_pk(ac[2], ac[3]), cvt_pk(ac[4], ac[5]), cvt_pk(ac[6], ac[7])}; *(u32x4*)(pc + 8) = (u32x4){cvt_pk(ac[8], ac[9]), cvt_pk(ac[10], ac[11]), cvt_pk(ac[12], ac[13]), cvt_pk(ac[14], ac[15])};
            if (IN0_F8_TILES & 0x3000) { unsigned char* p8 = (unsigned char*)(C.ws + WS_WIN0F8) + (size_t)(3072 + g * 128 + cp) * 1024 + kb * 64 + kq * 16;
                *(u32x4*)p8 = (u32x4){pk4_fp8(ac[0], ac[1], ac[2], ac[3], 32.f), pk4_fp8(ac[4], ac[5], ac[6], ac[7], 32.f), pk4_fp8(ac[8], ac[9], ac[10], ac[11], 32.f), pk4_fp8(ac[12], ac[13], ac[14], ac[15], 32.f)}; }
        }
    }
    __syncthreads();
}

__device__ __forceinline__ void p_norm0(const Ctx& C) {
    PH_IDS;
    const int gw = blockIdx.x * 8 + wave, NGW = C.G * 8;
    const int per = (MALL + NGW - 1) / NGW;
    const int r0 = gw * per, r1 = (r0 + per < MALL) ? r0 + per : MALL;
    const float* MOD = (const float*)(C.ws + WS_MOD);
    const float* g = C.a->in[IN_NMPRE];
    unsigned char* HN = (unsigned char*)(C.ws + WS_HN);
    int curb = -1; f32x4 A[4], B[4];
    for (int r = r0; r < r1; ++r) {
        const int b = (r < MTOK) ? (r >> 13) : 8;
        if (b != curb) { curb = b;
#pragma unroll
            for (int j = 0; j < 4; ++j) { const int c = 4 * lane + 256 * j;
                const f32x4 gg = *(const f32x4*)(g + c), sc = *(const f32x4*)(MOD + (size_t)b * 6144 + 1024 + c), sh = *(const f32x4*)(MOD + (size_t)b * 6144 + c);
                A[j] = gg * (sc + 1.0f); B[j] = sh; } }
        const float* xr = (r < MTOK) ? (C.a->in[IN_X] + (size_t)r * 1024) : (C.a->in[IN_CTX] + (size_t)(r - MTOK) * 1024);
        f32x4 v[4]; float ss = 0.f;
#pragma unroll
        for (int j = 0; j < 4; ++j) { v[j] = *(const f32x4*)(xr + 4 * lane + 256 * j); ss += v[j][0] * v[j][0] + v[j][1] * v[j][1] + v[j][2] * v[j][2] + v[j][3] * v[j][3]; }
        const float rstd = rsqrtf(wave_sum(ss) * (1.0f / 1024.0f) + EPS);
#pragma unroll
        for (int j = 0; j < 4; ++j) { const f32x4 h = v[j] * rstd * A[j] + B[j];
            if (F8_IN0) *(unsigned*)(HN + (size_t)r * 1024 + 4 * lane + 256 * j) = pk4_fp8(h[0], h[1], h[2], h[3], 8.f);
            else *(u32x2*)((bf16*)HN + (size_t)r * 1024 + 4 * lane + 256 * j) = (u32x2){cvt_pk(h[0], h[1]), cvt_pk(h[2], h[3])};
            if (!F8_IN0 && IN0_F8_TILES && r < MTOK) *(unsigned*)((unsigned char*)(C.ws + WS_HN8) + (size_t)r * 1024 + 4 * lane + 256 * j) = pk4_fp8(h[0], h[1], h[2], h[3], 8.f); }
    }
}

namespace glap {
constexpr int H_BYTES = 72704;
constexpr int O_RAW = 0, O_BC = 2048, O_TOT = 34816, O_QP = 36864, O_KP = 54272;
constexpr int NUNIT = 2 * 4 * 8 * 132;
}
__device__ __forceinline__ int gla_row(int bt, int dir, int s, int i) {
    const int ii = dir ? 63 - i : i;
    if (s < 4) { const int ci = dir ? 3 - s : s; return MTOK + bt * CTXL + ci * 64 + ii; }
    const int n = s - 4, ci = dir ? 127 - n : n; return bt * SEQ + ci * 64 + ii;
}
__device__ __forceinline__ void p_gla_prep(const Ctx& C, const int pv = 0) {
    PH_IDS;
    using namespace glap;
    const int half = tid >> 8, th = tid & 255, wh = wave & 3;
    LAS unsigned char* L = C.lds + half * H_BYTES;
    const bf16* Qg = (const bf16*)(C.ws + WS_Q); const bf16* Kg = (const bf16*)(C.ws + WS_K); const bf16* LRg = (const bf16*)(C.ws + WS_LR);
    bf16* QPg = (bf16*)(C.ws + WS_GQP); bf16* KPPg = (bf16*)(C.ws + WS_GKPP); bf16* SCg = (bf16*)(C.ws + WS_GSC); float* ELg = (float*)(C.ws + WS_GEL);
    const int niter = (NUNIT + 2 * C.G - 1) / (2 * C.G);
    const int lj = th >> 2, part = th & 3;
    u32x4 nq[4], nk[4], nlr; float nup[8], nbias;
    auto unit_of = [&](int itn) -> int { const int U = (itn * C.G + (int)blockIdx.x) * 2 + half; return U < NUNIT ? U : NUNIT - 1; };
    auto issue_loads = [&](int Uc) {
        const int sstep = Uc % 132, bt = (Uc / 132) & 7, hd = (Uc / (132 * 8)) & 3, dir = Uc / (132 * 32);
#pragma unroll
        for (int q = 0; q < 4; ++q) { const int c = th + 256 * q; const int row = gla_row(bt, dir, sstep, c >> 4);
            nk[q] = *(const u32x4*)(Kg + (size_t)row * 512 + hd * 128 + (c & 15) * 8);
            nq[q] = *(const u32x4*)(Qg + (size_t)(sstep >= 4 ? row : 0) * 512 + hd * 128 + (c & 15) * 8); }
        if (th < 128) { const int r2 = gla_row(bt, dir, sstep, th >> 1); nlr = *(const u32x4*)(LRg + (size_t)r2 * 32 + dir * 16 + (th & 1) * 8); }
        const float* up = C.a->in[IN_EVGKUP] + (size_t)dir * 16 * 512 + hd * 128 + 32 * wh + (lane & 31);
#pragma unroll
        for (int q = 0; q < 8; ++q) nup[q] = up[(size_t)(8 * (lane >> 5) + q) * 512];
        nbias = C.a->in[IN_EVGKB][dir * 512 + hd * 128 + 32 * wh + (lane & 31)]; };
    issue_loads(unit_of(0));
    for (int itn = 0; itn < niter; ++itn) {
        const int U = (itn * C.G + (int)blockIdx.x) * 2 + half;
        const bool act = U < NUNIT;
        const int Uc = act ? U : NUNIT - 1;
        const int sstep = Uc % 132;
        const bool latent = sstep >= 4;
        u32x4 rq[4], rk[4], rlr = nlr;
#pragma unroll
        for (int q = 0; q < 4; ++q) { rq[q] = nq[q]; rk[q] = nk[q]; }
        bf16x8 upf; const float gbias = nbias;
        { unsigned short tmp[8];
#pragma unroll
          for (int q = 0; q < 8; ++q) tmp[q] = (unsigned short)f2bf(nup[q]);
          upf = (bf16x8){(short)tmp[0], (short)tmp[1], (short)tmp[2], (short)tmp[3], (short)tmp[4], (short)tmp[5], (short)tmp[6], (short)tmp[7]}; }
        if (itn + 1 < niter) issue_loads(unit_of(itn + 1));
        __syncthreads();
        if (th < 128) *(LAS u32x4*)(L + O_RAW + (th >> 1) * 32 + (th & 1) * 16) = rlr;
        __syncthreads();
#pragma unroll
        for (int jb = 0; jb < 2; ++jb) {
            const bf16x8 af = *(const LAS bf16x8*)(L + O_RAW + (32 * jb + (lane & 31)) * 32 + (lane >> 5) * 16);
            f32x16 z;
#pragma unroll
            for (int i = 0; i < 16; ++i) z[i] = 0.f;
            z = __builtin_amdgcn_mfma_f32_32x32x16_bf16(af, upf, z, 0, 0, 0);
#pragma unroll
            for (int r = 0; r < 16; ++r) { const int j = 32 * jb + (r & 3) + 8 * (r >> 2) + 4 * (lane >> 5); const float zz = z[r] + gbias;
                const float ls = fminf(zz, 0.f) - __logf(1.0f + __expf(-fabsf(zz)));
                *(LAS float*)(L + O_BC + (j * 128 + 32 * wh + (lane & 31)) * 4) = ls * 0.0625f; } }
        __syncthreads();
        { const int dk = th & 127;
          float run0 = 0.f, run1 = 0.f; const int g0 = th >> 7, g1 = g0 + 2;
          float v0[16], v1[16];
#pragma unroll
          for (int q = 0; q < 16; ++q) { v0[q] = *(const LAS float*)(L + O_BC + ((16 * g0 + q) * 128 + dk) * 4); v1[q] = *(const LAS float*)(L + O_BC + ((16 * g1 + q) * 128 + dk) * 4); }
#pragma unroll
          for (int q = 0; q < 16; ++q) { run0 += v0[q]; run1 += v1[q];
              *(LAS float*)(L + O_BC + ((16 * g0 + q) * 128 + dk) * 4) = run0; *(LAS float*)(L + O_BC + ((16 * g1 + q) * 128 + dk) * 4) = run1; }
          *(LAS float*)(L + O_TOT + (g0 * 128 + dk) * 4) = run0; *(LAS float*)(L + O_TOT + (g1 * 128 + dk) * 4) = run1; }
        __syncthreads();
        {
#pragma unroll
          for (int q8 = 0; q8 < 4; ++q8) {
              const int c = th + 256 * q8, cj = c >> 4, jg = cj >> 4, dkc = (c & 15) * 8;
              u32x4 oq, okpp;
#pragma unroll
              for (int hq = 0; hq < 2; ++hq) {
                  const int dk0 = dkc + 4 * hq;
                  f32x4 b = *(const LAS f32x4*)(L + O_BC + (cj * 128 + dk0) * 4), tt = (f32x4){0.f, 0.f, 0.f, 0.f};
#pragma unroll
                  for (int g2 = 0; g2 < 4; ++g2) { const f32x4 tv = *(const LAS f32x4*)(L + O_TOT + (g2 * 128 + dk0) * 4); tt += tv; if (g2 < jg) b += tv; }
                  f32x4 e1, e2, e3;
#pragma unroll
                  for (int i = 0; i < 4; ++i) { if (pv & 4) { e1[i] = b[i]; e2[i] = -b[i]; e3[i] = tt[i] - b[i]; } else { e1[i] = __expf(b[i]); e2[i] = __expf(-b[i]); e3[i] = __expf(tt[i] - b[i]); } }
                  if (cj == 0 && act && !(pv & 1)) { f32x4 el;
#pragma unroll
                      for (int i = 0; i < 4; ++i) el[i] = __expf(tt[i]);
                      *(f32x4*)(ELg + (size_t)Uc * 128 + dk0) = el; }
                  const unsigned qa = hq ? rq[q8].z : rq[q8].x, qb = hq ? rq[q8].w : rq[q8].y;
                  const unsigned ka = hq ? rk[q8].z : rk[q8].x, kb = hq ? rk[q8].w : rk[q8].y;
                  const float q0 = bf_lo(qa), q1 = bf_hi(qa), q2 = bf_lo(qb), q3 = bf_hi(qb);
                  const float k0 = bf_lo(ka), k1 = bf_hi(ka), k2 = bf_lo(kb), k3 = bf_hi(kb);
                  u32x2 o;
                  o.x = cvt_pk(q0 * e1[0], q1 * e1[1]); o.y = cvt_pk(q2 * e1[2], q3 * e1[3]); *(LAS u32x2*)(L + O_QP + cj * 272 + dk0 * 2) = o;
                  if (hq) { oq.z = o.x; oq.w = o.y; } else { oq.x = o.x; oq.y = o.y; }
                  o.x = cvt_pk(k0 * e2[0], k1 * e2[1]); o.y = cvt_pk(k2 * e2[2], k3 * e2[3]); *(LAS u32x2*)(L + O_KP + cj * 272 + dk0 * 2) = o;
                  o.x = cvt_pk(k0 * e3[0], k1 * e3[1]); o.y = cvt_pk(k2 * e3[2], k3 * e3[3]);
                  if (hq) { okpp.z = o.x; okpp.w = o.y; } else { okpp.x = o.x; okpp.y = o.y; }
              }
              if (act && !(pv & 1)) { *(u32x4*)(KPPg + (size_t)Uc * 8192 + c * 8) = okpp; if (latent) *(u32x4*)(QPg + (size_t)Uc * 8192 + c * 8) = oq; }
              else asm volatile("" :: "v"(okpp), "v"(oq));
          } }
        __syncthreads();
        if (latent && act && !(pv & 2)) {
            const int ib = wh;
            for (int jb16 = 0; jb16 <= ib; ++jb16) {
                f32x4 d = (f32x4){0.f, 0.f, 0.f, 0.f};
#pragma unroll
                for (int ks = 0; ks < 4; ++ks) {
                    const bf16x8 a = *(const LAS bf16x8*)(L + O_KP + (16 * jb16 + (lane & 15)) * 272 + (32 * ks + 8 * (lane >> 4)) * 2);
                    const bf16x8 bq = *(const LAS bf16x8*)(L + O_QP + (16 * ib + (lane & 15)) * 272 + (32 * ks + 8 * (lane >> 4)) * 2);
                    d = __builtin_amdgcn_mfma_f32_16x16x32_bf16(a, bq, d, 0, 0, 0); }
                const int i = 16 * ib + (lane & 15), j0 = 16 * jb16 + 4 * (lane >> 4);
#pragma unroll
                for (int r = 0; r < 4; ++r) if (j0 + r > i) d[r] = 0.f;
                u32x2 o; o.x = cvt_pk(d[0], d[1]); o.y = cvt_pk(d[2], d[3]);
                if (!(pv & 1)) *(u32x2*)(SCg + (size_t)Uc * 4096 + i * 64 + j0) = o; else asm volatile("" :: "v"(o));
            }
            for (int jb16 = ib + 1; jb16 < 4; ++jb16) { const int i = 16 * ib + (lane & 15), j0 = 16 * jb16 + 4 * (lane >> 4);
                if (!(pv & 1)) *(u32x2*)(SCg + (size_t)Uc * 4096 + i * 64 + j0) = (u32x2){0u, 0u}; }
        }
    }
    __syncthreads();
}
namespace gla {
constexpr int O_EL = 0, O_QP = 512, O_KPP = 17920, O_V = 38400, O_SC = 50688, IMG_BYTES = 59904, O_ST = 2 * IMG_BYTES;
constexpr int P_QP = 272, P_KPP = 320, P_V = 192, P_SC = 144, P_ST = 272, ST_BYTES = 64 * 272;
__device__ __forceinline__ bf16x8 tr8(LAS unsigned char* p0, LAS unsigned char* p1) {
    const s16x4 a = __builtin_amdgcn_ds_read_tr16_b64_v4i16((LAS s16x4*)p0);
    const s16x4 b = __builtin_amdgcn_ds_read_tr16_b64_v4i16((LAS s16x4*)p1);
    return (bf16x8){a[0], a[1], a[2], a[3], b[0], b[1], b[2], b[3]};
}
}
__device__ __forceinline__ void p_gla(const Ctx& C, const int probe = 0) {
    PH_IDS;
    using namespace gla;
    LAS unsigned char* L = C.lds;
    const int t = tid, w = wave;
    const bf16* Vg = (const bf16*)(C.ws + WS_V);
    const bf16* QPg = (const bf16*)(C.ws + WS_GQP); const bf16* KPPg = (const bf16*)(C.ws + WS_GKPP); const bf16* SCg = (const bf16*)(C.ws + WS_GSC); const float* ELg = (const float*)(C.ws + WS_GEL);
    for (int it = blockIdx.x; it < 256; it += C.G) {
        const int xx = it & 7, jj_ = it >> 3, scan = xx * 8 + (jj_ >> 2), dvs = jj_ & 3;
        const int bt = scan >> 3, hd = (scan >> 1) & 3, dir = scan & 1;
        const int ubase = ((dir * 4 + hd) * 8 + bt) * 132;
        bf16* Og = (bf16*)(C.ws + (probe ? WS_HN : (dir ? WS_OB : WS_OF)));
        __syncthreads();
        for (int i = t; i < ST_BYTES / 16; i += 512) *(LAS u32x4*)(L + O_ST + i * 16) = (u32x4){0u, 0u, 0u, 0u};
        f32x16 S;
#pragma unroll
        for (int i = 0; i < 16; ++i) S[i] = 0.f;
        const int lj = t >> 3, part = t & 7;
        struct StepRegs { u32x4 sc, qp0, qp1, kp0, kp1, v; f32x4 el; };
        StepRegs RA, RB;
        auto load_step = [&](int s_, StepRegs& R) {
            const int s = probe ? 4 + (s_ & 1) : s_;
            const size_t U = (size_t)(ubase + s);
            const int row = gla_row(bt, dir, s, lj);
            R.v = *(const u32x4*)(Vg + (size_t)row * 1024 + hd * 256 + dvs * 64 + part * 8);
            const bf16* kp = KPPg + U * 8192 + t * 8; R.kp0 = *(const u32x4*)kp; R.kp1 = *(const u32x4*)(kp + 4096);
            if (t < 32) R.el = *(const f32x4*)(ELg + U * 128 + t * 4);
            if (s >= 4) { const bf16* qp = QPg + U * 8192 + t * 8; R.qp0 = *(const u32x4*)qp; R.qp1 = *(const u32x4*)(qp + 4096);
                R.sc = *(const u32x4*)(SCg + U * 4096 + lj * 64 + part * 8); } };
        auto write_images = [&](int s, int ib_, const StepRegs& R) {
            LAS unsigned char* I = L + ib_ * IMG_BYTES;
            *(LAS u32x4*)(I + O_V + lj * P_V + part * 16) = R.v;
            *(LAS u32x4*)(I + O_KPP + (t >> 4) * P_KPP + (t & 15) * 16) = R.kp0; *(LAS u32x4*)(I + O_KPP + (32 + (t >> 4)) * P_KPP + (t & 15) * 16) = R.kp1;
            if (t < 32) *(LAS f32x4*)(I + O_EL + t * 16) = R.el;
            if (s >= 4) { *(LAS u32x4*)(I + O_QP + (t >> 4) * P_QP + (t & 15) * 16) = R.qp0; *(LAS u32x4*)(I + O_QP + (32 + (t >> 4)) * P_QP + (t & 15) * 16) = R.qp1;
                *(LAS u32x4*)(I + O_SC + lj * P_SC + part * 16) = R.sc; } };
        load_step(0, RB); write_images(0, 0, RB);
        load_step(1, RA);
        load_step(2, RB);
        auto step_body = [&](const int s, StepRegs& R) {
            const int cur = s & 1, nx = cur ^ 1;
            const bool latent = (s >= 4);
            LAS unsigned char* I = L + cur * IMG_BYTES;
            __syncthreads();
            if (s + 1 < 132) write_images(s + 1, nx, R);
            if (s + 3 < 132) load_step(s + 3, R);
            { const int dbS = w & 3, dvb = w >> 2, hh = lane >> 5, blk = (lane >> 4) & 1, q4 = (lane & 15) >> 2, p4 = lane & 3;
#pragma unroll
              for (int g = 0; g < 4; ++g) { const f32x4 el = *(const LAS f32x4*)(I + O_EL + (32 * dbS + 8 * g + 4 * hh) * 4);
#pragma unroll
                  for (int i = 0; i < 4; ++i) S[4 * g + i] *= el[i]; }
#pragma unroll
              for (int ks = 0; ks < 4; ++ks) {
                  LAS unsigned char* pa = I + O_KPP + (16 * ks + 8 * hh + q4) * P_KPP + (32 * dbS + 16 * blk + 4 * p4) * 2;
                  LAS unsigned char* pb = I + O_V + (16 * ks + 8 * hh + q4) * P_V + (32 * dvb + 16 * blk + 4 * p4) * 2;
                  const bf16x8 a = gla::tr8(pa, pa + 4 * P_KPP);
                  const bf16x8 b = gla::tr8(pb, pb + 4 * P_V);
                  S = __builtin_amdgcn_mfma_f32_32x32x16_bf16(a, b, S, 0, 0, 0); }
#pragma unroll
              for (int g = 0; g < 4; ++g) { u32x2 o; o.x = cvt_pk(S[4 * g], S[4 * g + 1]); o.y = cvt_pk(S[4 * g + 2], S[4 * g + 3]);
                  *(LAS u32x2*)(L + O_ST + nx * ST_BYTES + (32 * dvb + (lane & 31)) * P_ST + (32 * dbS + 8 * g + 4 * hh) * 2) = o; } }
            if (latent) {
                const int ib = w >> 1;
                const int g4 = lane >> 4, q4 = (lane & 15) >> 2, p4 = lane & 3;
                const int orow = gla_row(bt, dir, s, 16 * ib + (lane & 15));
#pragma unroll
                for (int cc = 0; cc < 2; ++cc) {
                    const int c = 2 * (w & 1) + cc;
                    f32x4 d = (f32x4){0.f, 0.f, 0.f, 0.f};
#pragma unroll
                    for (int ks = 0; ks < 2; ++ks) {
                        LAS unsigned char* pa = I + O_V + (32 * ks + 8 * g4 + q4) * P_V + (16 * c + 4 * p4) * 2;
                        const bf16x8 a = gla::tr8(pa, pa + 4 * P_V);
                        const bf16x8 b = *(const LAS bf16x8*)(I + O_SC + (16 * ib + (lane & 15)) * P_SC + (32 * ks + 8 * g4) * 2);
                        d = __builtin_amdgcn_mfma_f32_16x16x32_bf16(a, b, d, 0, 0, 0); }
#pragma unroll
                    for (int ks = 0; ks < 4; ++ks) {
                        const bf16x8 a = *(const LAS bf16x8*)(L + O_ST + cur * ST_BYTES + (16 * c + (lane & 15)) * P_ST + (32 * ks + 8 * g4) * 2);
                        const bf16x8 b = *(const LAS bf16x8*)(I + O_QP + (16 * ib + (lane & 15)) * P_QP + (32 * ks + 8 * g4) * 2);
                        d = __builtin_amdgcn_mfma_f32_16x16x32_bf16(a, b, d, 0, 0, 0); }
                    u32x2 o; o.x = cvt_pk(d[0], d[1]); o.y = cvt_pk(d[2], d[3]);
                    *(u32x2*)(Og + (size_t)orow * 1024 + hd * 256 + dvs * 64 + 16 * c + 4 * g4) = o;
                }
            }
        };
        for (int s = 0; s < 132; s += 2) { step_body(s, RA); step_body(s + 1, RB); }
    }
}

__device__ __forceinline__ void p_fft1(const Ctx& C) {
    PH_IDS;
    LAS unsigned char* L = C.lds;
    const int t = tid, w = wave, mb = w & 3, nh = w >> 2, hh = lane >> 5;
    const bf16* F1 = (const bf16*)(C.ws + WS_F1);
    bf16x8 af[8];
#pragma unroll
    for (int ks = 0; ks < 8; ++ks) af[ks] = *(const bf16x8*)(F1 + (32 * mb + (lane & 31)) * 128 + 16 * ks + 8 * hh);
    const bf16* ZZ = (const bf16*)(C.ws + WS_ZC);
    bf16* YR = (bf16*)(C.ws + WS_YR); bf16* YI = (bf16*)(C.ws + WS_YI);
    const int blk = (lane >> 4) & 1, q4 = (lane & 15) >> 2, p4 = lane & 3;
    constexpr int RAWB = 73728;
    u32x4 pv[4];
    auto fetch1 = [&](int unit) { const int bt = unit >> 8, b = (unit >> 1) & 127, chh = unit & 1; const int a = t >> 3, part = t & 7;
        const bf16* src = ZZ + (size_t)(bt * SEQ + 128 * a + b) * 512 + chh * 256 + part * 32;
#pragma unroll
        for (int i = 0; i < 4; ++i) pv[i] = *(const u32x4*)(src + 8 * i); };
    if ((int)blockIdx.x < 2048) fetch1(blockIdx.x);
    for (int unit = blockIdx.x; unit < 2048; unit += C.G) {
        const int bt = unit >> 8, b = (unit >> 1) & 127, chh = unit & 1;
        __syncthreads();
        { const int a = t >> 3, part = t & 7;
#pragma unroll
          for (int i = 0; i < 4; ++i) *(LAS u32x4*)(L + RAWB + a * 528 + part * 64 + i * 16) = pv[i]; }
        __syncthreads();
        { const int row = t >> 2, quarter = t & 3, pin = row >> 6, a = row & 63, gl = quarter >> 1, half = quarter & 1;
          const LAS unsigned char* rp = L + RAWB + a * 528 + gl * 256 + pin * 128;
#pragma unroll
          for (int ci = 0; ci < 8; ++ci) { u32x4 o;
              if (!half) { o = *(const LAS u32x4*)(rp + ci * 16); if (pin && ci == 0) o.x &= 0xffff0000u; }
              else { const u32x4 av = *(const LAS u32x4*)(rp + (7 - ci) * 16); const unsigned b0 = *(const LAS unsigned*)(rp + (8 - ci) * 16);
                  o.x = __builtin_amdgcn_perm(av.w, b0, 0x07060100u); o.y = __builtin_amdgcn_perm(av.z, av.w, 0x07060100u);
                  o.z = __builtin_amdgcn_perm(av.y, av.z, 0x07060100u); o.w = __builtin_amdgcn_perm(av.x, av.y, 0x07060100u);
                  if (pin) { o.x ^= 0x80008000u; o.y ^= 0x80008000u; o.z ^= 0x80008000u; o.w ^= 0x80008000u; if (ci == 0) o.x &= 0xffff0000u; } }
              *(LAS u32x4*)(L + row * 576 + quarter * 128 + ci * 16) = o; } }
        __syncthreads();
        if (unit + C.G < 2048) fetch1(unit + C.G);
#pragma unroll 1
        for (int nb = 0; nb < 4; ++nb) {
            const int c = 4 * nh + nb;
            f32x16 acc;
#pragma unroll
            for (int i = 0; i < 16; ++i) acc[i] = 0.f;
#pragma unroll
            for (int ks = 0; ks < 8; ++ks) {
                LAS unsigned char* pb = L + (16 * ks + 8 * hh + q4) * 576 + (32 * c + 16 * blk + 4 * p4) * 2;
                const bf16x8 bfr = gla::tr8(pb, pb + 4 * 576);
                acc = __builtin_amdgcn_mfma_f32_32x32x16_bf16(af[ks], bfr, acc, 0, 0, 0); }
#pragma unroll
            for (int gp = 0; gp < 2; ++gp)
#pragma unroll
                for (int i = 0; i < 4; ++i) { const int ap = 16 * mb + 8 * gp + 4 * hh + i; const float re = acc[8 * gp + i], im = acc[8 * gp + 4 + i];
                    const float ph = (float)((b * ap) & 8191) * (1.0f / 8192.0f); const float cs = __builtin_amdgcn_cosf(ph), sn = __builtin_amdgcn_sinf(ph);
                    const int so = ap * 528 + (32 * c + (lane & 31)) * 2;
                    *(LAS unsigned short*)(L + 73728 + so) = (unsigned short)f2bf(re * cs + im * sn);
                    *(LAS unsigned short*)(L + 73728 + 64 * 528 + so) = (unsigned short)f2bf(im * cs - re * sn); }
        }
        __syncthreads();
        { const int orow = t >> 2, quarter = t & 3, plane = orow >> 6, ap = orow & 63;
          bf16* dst = (plane ? YI : YR) + ((size_t)(bt * 64 + ap) * 128 + b) * 512 + chh * 256 + quarter * 64;
#pragma unroll
          for (int i = 0; i < 8; ++i) *(u32x4*)(dst + 8 * i) = *(const LAS u32x4*)(L + 73728 + orow * 528 + quarter * 128 + i * 16); }
    }
    __syncthreads();
}
__device__ __forceinline__ void p_fft2(const Ctx& C) {
    PH_IDS;
    LAS unsigned char* L = C.lds;
    const int t = tid, w = wave, mb = w & 3, nh = w >> 2, hh = lane >> 5;
    const bf16* F2 = (const bf16*)(C.ws + WS_F2);
    bf16x8 af[16];
#pragma unroll
    for (int ks = 0; ks < 16; ++ks) af[ks] = *(const bf16x8*)(F2 + (32 * mb + (lane & 31)) * 256 + 16 * ks + 8 * hh);
    const bf16* YR = (const bf16*)(C.ws + WS_YR); const bf16* YI = (const bf16*)(C.ws + WS_YI);
    unsigned char* A2 = (unsigned char*)(C.ws + WS_A2);
    const int blk = (lane >> 4) & 1, q4 = (lane & 15) >> 2, p4 = lane & 3;
    u32x4 pv[8];
    auto fetch2 = [&](int unit) { const int bt = unit >> 8, ap = (unit >> 2) & 63, cht = unit & 3; const int row = t >> 1, half = t & 1, pin = row >> 7, b = row & 127;
        const bf16* src = (pin ? YI : YR) + ((size_t)(bt * 64 + ap) * 128 + b) * 512 + cht * 128 + half * 64;
#pragma unroll
        for (int i = 0; i < 8; ++i) pv[i] = *(const u32x4*)(src + 8 * i); };
    if ((int)blockIdx.x < 2048) fetch2(blockIdx.x);
    for (int unit = blockIdx.x; unit < 2048; unit += C.G) {
        const int bt = unit >> 8, ap = (unit >> 2) & 63, cht = unit & 3;
        __syncthreads();
        { const int row = t >> 1, half = t & 1;
#pragma unroll
          for (int i = 0; i < 8; ++i) *(LAS u32x4*)(L + row * 320 + half * 128 + i * 16) = pv[i]; }
        __syncthreads();
        if (unit + C.G < 2048) fetch2(unit + C.G);
#pragma unroll 1
        for (int nb = 0; nb < 2; ++nb) {
            const int c = 2 * nh + nb;
            f32x16 acc;
#pragma unroll
            for (int i = 0; i < 16; ++i) acc[i] = 0.f;
#pragma unroll
            for (int ks = 0; ks < 16; ++ks) {
                LAS unsigned char* pb = L + (16 * ks + 8 * hh + q4) * 320 + (32 * c + 16 * blk + 4 * p4) * 2;
                const bf16x8 bfr = gla::tr8(pb, pb + 4 * 320);
                acc = __builtin_amdgcn_mfma_f32_32x32x16_bf16(af[ks], bfr, acc, 0, 0, 0); }
#pragma unroll
            for (int r = 0; r < 16; ++r) { const int bp = 32 * mb + (r & 3) + 8 * (r >> 2) + 4 * hh;
                if (F8_OUT0) *(LAS unsigned char*)(L + 81920 + bp * 144 + 32 * c + (lane & 31)) = (unsigned char)(pk4_fp8(acc[r], 0.f, 0.f, 0.f, 8.0f / 1024.0f) & 0xffu);
                else *(LAS unsigned short*)(L + 81920 + bp * 272 + (32 * c + (lane & 31)) * 2) = (unsigned short)f2bf(acc[r] * (1.0f / 1024.0f)); }
        }
        __syncthreads();
        { const int bp = t >> 2, quarter = t & 3; const size_t tok = (size_t)bt * SEQ + ap + 64 * bp;
          if (F8_OUT0) { unsigned char* dst = A2 + tok * 1536 + 1024 + cht * 128 + quarter * 32;
#pragma unroll
              for (int i = 0; i < 2; ++i) *(u32x4*)(dst + 16 * i) = *(const LAS u32x4*)(L + 81920 + bp * 144 + quarter * 32 + i * 16); }
          else { bf16* dst = (bf16*)A2 + tok * 1536 + 1024 + cht * 128 + quarter * 32;
#pragma unroll
              for (int i = 0; i < 4; ++i) *(u32x4*)(dst + 8 * i) = *(const LAS u32x4*)(L + 81920 + bp * 272 + quarter * 64 + i * 16); } }
    }
    __syncthreads();
}
__device__ __forceinline__ void p_gla_out(const Ctx& C) {
    PH_IDS;
    const int gw = blockIdx.x * 8 + wave, NGW = C.G * 8;
    const bf16* OF = (const bf16*)(C.ws + WS_OF); const bf16* OB = (const bf16*)(C.ws + WS_OB); const bf16* Rg = (const bf16*)(C.ws + WS_R);
    unsigned char* A2 = (unsigned char*)(C.ws + WS_A2);
    float gn[16];
#pragma unroll
    for (int i = 0; i < 16; ++i) gn[i] = C.a->in[IN_EVGNORM][16 * (lane & 15) + i];
    for (int r = gw; r < MTOK; r += NGW) {
        const u32x4 f0 = *(const u32x4*)(OF + (size_t)r * 1024 + 16 * lane), f1 = *(const u32x4*)(OF + (size_t)r * 1024 + 16 * lane + 8);
        const u32x4 b0 = *(const u32x4*)(OB + (size_t)r * 1024 + 16 * lane), b1 = *(const u32x4*)(OB + (size_t)r * 1024 + 16 * lane + 8);
        const u32x4 g0 = *(const u32x4*)(Rg + (size_t)r * 1024 + 16 * lane), g1 = *(const u32x4*)(Rg + (size_t)r * 1024 + 16 * lane + 8);
        float o[16], rr[16];
#pragma unroll
        for (int i = 0; i < 4; ++i) { const unsigned fa = f0[i], fb = f1[i], ba = b0[i], bb = b1[i], ga = g0[i], gb = g1[i];
            o[2 * i] = bf_lo(fa) + bf_lo(ba); o[2 * i + 1] = bf_hi(fa) + bf_hi(ba); o[8 + 2 * i] = bf_lo(fb) + bf_lo(bb); o[8 + 2 * i + 1] = bf_hi(fb) + bf_hi(bb);
            rr[2 * i] = bf_lo(ga); rr[2 * i + 1] = bf_hi(ga); rr[8 + 2 * i] = bf_lo(gb); rr[8 + 2 * i + 1] = bf_hi(gb); }
        float ss = 0.f;
#pragma unroll
        for (int i = 0; i < 16; ++i) ss += o[i] * o[i];
        ss = row16_sum(ss);
        const float rstd = rsqrtf(ss * (1.0f / 256.0f) + EPS);
        float y[16];
#pragma unroll
        for (int i = 0; i < 16; ++i) y[i] = o[i] * rstd * gn[i] * siluf_(rr[i]);
        if (F8_OUT0) *(u32x4*)(A2 + (size_t)r * 1536 + 16 * lane) = (u32x4){pk4_fp8(y[0], y[1], y[2], y[3], 8.f), pk4_fp8(y[4], y[5], y[6], y[7], 8.f), pk4_fp8(y[8], y[9], y[10], y[11], 8.f), pk4_fp8(y[12], y[13], y[14], y[15], 8.f)};
        else { bf16* a2 = (bf16*)A2 + (size_t)r * 1536 + 16 * lane;
            *(u32x4*)a2 = (u32x4){cvt_pk(y[0], y[1]), cvt_pk(y[2], y[3]), cvt_pk(y[4], y[5]), cvt_pk(y[6], y[7])}; *(u32x4*)(a2 + 8) = (u32x4){cvt_pk(y[8], y[9]), cvt_pk(y[10], y[11]), cvt_pk(y[12], y[13]), cvt_pk(y[14], y[15])}; }
    }
}

__device__ __forceinline__ void p_postmix(const Ctx& C, const int layer) {
    PH_IDS;
    constexpr int HT_PITCH = 2080;
    LAS unsigned char* HTh = C.lds;
    LAS unsigned char* HTl = C.lds + 33280;
    LAS float* PART = (LAS float*)(C.lds + 66560);
    LAS int* hist = (LAS int*)(C.lds + 99328);
    LAS float* Lg = (LAS float*)(C.lds + 99840 + wave * 2112);
    LAS float* CC = (LAS float*)(C.lds + 116736);
    const float* rw = C.a->in[IN_RW] + (size_t)layer * 1024 * 32;
    __syncthreads();
    if (tid < 32) hist[tid] = 0;
    const float* MOD = (const float*)(C.ws + WS_MOD) + (size_t)layer * 9 * 6144;
    const float* gpost = C.a->in[IN_NMPOST] + layer * 1024; const float* gffn = C.a->in[IN_NFPRE] + layer * 1024;
    const bf16* Y = (const bf16*)(C.ws + WS_Y);
    const float* xin = C.a->in[IN_X];
    bf16* XS = (bf16*)(C.ws + WS_XS);
    unsigned char* H2 = (unsigned char*)(C.ws + WS_H2);
    int* TK = (int*)(C.ws + WS_TOPK); float* GT = (float*)(C.ws + WS_GATE);
    const int rows_per_blk = MTOK / C.G, rows_per_wave = rows_per_blk / 8;
    const int r0 = blockIdx.x * rows_per_blk + wave * rows_per_wave;
    const int b = r0 >> 13;
    const float rbias = C.a->in[IN_RB][layer * 32 + (lane & 31)];
    for (int c = tid; c < 1024; c += 512) {
        CC[c] = gpost[c] * MOD[(size_t)b * 6144 + 2048 + c]; CC[1024 + c] = gffn[c] * (1.0f + MOD[(size_t)b * 6144 + 4096 + c]); CC[2048 + c] = MOD[(size_t)b * 6144 + 3072 + c]; }
    bf16x8 wh[4][2], wl[4][2];
#pragma unroll
    for (int sx = 0; sx < 4; ++sx)
#pragma unroll
        for (int hf = 0; hf < 2; ++hf) { float wv[8];
#pragma unroll
            for (int i = 0; i < 8; ++i) wv[i] = rw[(wave * 128 + 32 * sx + 8 * (lane >> 4) + i) * 32 + 16 * hf + (lane & 15)];
            unsigned hi[4], lo[4];
#pragma unroll
            for (int q = 0; q < 4; ++q) { hi[q] = cvt_pk(wv[2 * q], wv[2 * q + 1]); lo[q] = cvt_pk(wv[2 * q] - bf_lo(hi[q]), wv[2 * q + 1] - bf_hi(hi[q])); }
            wh[sx][hf] = __builtin_bit_cast(bf16x8, (u32x4){hi[0], hi[1], hi[2], hi[3]}); wl[sx][hf] = __builtin_bit_cast(bf16x8, (u32x4){lo[0], lo[1], lo[2], lo[3]}); }
    __syncthreads();
    auto ldx = [&](int r, int j) -> f32x4 {
        if (layer == 0) return *(const f32x4*)(xin + (size_t)r * 1024 + 4 * lane + 256 * j);
        const u32x2 v = *(const u32x2*)(XS + (size_t)r * 1024 + 4 * lane + 256 * j); return (f32x4){__uint_as_float(v.x), __uint_as_float(v.y), 0.f, 0.f}; };
    auto cvx = [&](const f32x4& raw) -> f32x4 {
        if (layer == 0) return raw;
        const unsigned a = __float_as_uint(raw[0]), b2 = __float_as_uint(raw[1]); return (f32x4){bf_lo(a), bf_hi(a), bf_lo(b2), bf_hi(b2)}; };
    u32x2 ny[4]; f32x4 nx[4];
#pragma unroll
    for (int j = 0; j < 4; ++j) { ny[j] = *(const u32x2*)(Y + (size_t)r0 * 1024 + 4 * lane + 256 * j); nx[j] = ldx(r0, j); }
    for (int st = 0; st < rows_per_wave / 2; ++st) {
#pragma unroll
        for (int ri = 0; ri < 2; ++ri) { const int r = r0 + 2 * st + ri;
        float h[16];
        u32x2 cy[4]; f32x4 cx[4];
#pragma unroll
        for (int j = 0; j < 4; ++j) { cy[j] = ny[j]; cx[j] = nx[j]; }
        if (r + 1 < r0 + rows_per_wave) {
#pragma unroll
            for (int j = 0; j < 4; ++j) { ny[j] = *(const u32x2*)(Y + (size_t)(r + 1) * 1024 + 4 * lane + 256 * j); nx[j] = ldx(r + 1, j); } }
        { float ssy = 0.f; float yv[16];
#pragma unroll
          for (int j = 0; j < 4; ++j) { const u32x2 yy = cy[j];
              yv[4 * j] = bf_lo(yy.x); yv[4 * j + 1] = bf_hi(yy.x); yv[4 * j + 2] = bf_lo(yy.y); yv[4 * j + 3] = bf_hi(yy.y); }
#pragma unroll
          for (int i = 0; i < 16; ++i) ssy += yv[i] * yv[i];
          const float rstd = rsqrtf(wave_sum(ssy) * (1.0f / 1024.0f) + EPS);
          float ss1 = 0.f;
#pragma unroll
          for (int j = 0; j < 4; ++j) { const int c = 4 * lane + 256 * j;
              const f32x4 xv = cvx(cx[j]); const f32x4 ca1 = *(const LAS f32x4*)(CC + c);
              f32x4 o;
#pragma unroll
              for (int i = 0; i < 4; ++i) { o[i] = xv[i] + ca1[i] * (yv[4 * j + i] * rstd); h[4 * j + i] = o[i]; ss1 += o[i] * o[i]; }
              { u32x2 xw; xw.x = cvt_pk(o[0], o[1]); xw.y = cvt_pk(o[2], o[3]); *(u32x2*)(XS + (size_t)r * 1024 + c) = xw; } }
          const float rstd1 = rsqrtf(wave_sum(ss1) * (1.0f / 1024.0f) + EPS);
#pragma unroll
          for (int j = 0; j < 4; ++j) { const int c = 4 * lane + 256 * j;
              const f32x4 ca2 = *(const LAS f32x4*)(CC + 1024 + c), cb2 = *(const LAS f32x4*)(CC + 2048 + c);
#pragma unroll
              for (int i = 0; i < 4; ++i) h[4 * j + i] = h[4 * j + i] * rstd1 * ca2[i] + cb2[i];
              int wv = 0;
              wv = __builtin_amdgcn_cvt_pk_fp8_f32(fminf(fmaxf(h[4 * j] * 8.0f, -440.f), 440.f), fminf(fmaxf(h[4 * j + 1] * 8.0f, -440.f), 440.f), wv, false);
              wv = __builtin_amdgcn_cvt_pk_fp8_f32(fminf(fmaxf(h[4 * j + 2] * 8.0f, -440.f), 440.f), fminf(fmaxf(h[4 * j + 3] * 8.0f, -440.f), 440.f), wv, true);
              *(int*)(H2 + (size_t)r * 1024 + c) = wv; } }
#pragma unroll
        for (int j = 0; j < 4; ++j) { const unsigned h01 = cvt_pk(h[4 * j], h[4 * j + 1]), h23 = cvt_pk(h[4 * j + 2], h[4 * j + 3]);
            const unsigned l01 = cvt_pk(h[4 * j] - bf_lo(h01), h[4 * j + 1] - bf_hi(h01)), l23 = cvt_pk(h[4 * j + 2] - bf_lo(h23), h[4 * j + 3] - bf_hi(h23));
            const int off = (2 * wave + ri) * HT_PITCH + (4 * lane + 256 * j) * 2;
            *(LAS u32x2*)(HTh + off) = (u32x2){h01, h23}; *(LAS u32x2*)(HTl + off) = (u32x2){l01, l23}; }
        }
        __syncthreads();
        { f32x4 d0 = (f32x4){0.f, 0.f, 0.f, 0.f}, d1 = (f32x4){0.f, 0.f, 0.f, 0.f};
          const int aoff = (lane & 15) * HT_PITCH + (wave * 128 + 8 * (lane >> 4)) * 2;
#pragma unroll
          for (int sx = 0; sx < 4; ++sx) { const bf16x8 ah = *(const LAS bf16x8*)(HTh + aoff + sx * 64), al = *(const LAS bf16x8*)(HTl + aoff + sx * 64);
              d0 = __builtin_amdgcn_mfma_f32_16x16x32_bf16(ah, wh[sx][0], d0, 0, 0, 0); d1 = __builtin_amdgcn_mfma_f32_16x16x32_bf16(ah, wh[sx][1], d1, 0, 0, 0);
              d0 = __builtin_amdgcn_mfma_f32_16x16x32_bf16(ah, wl[sx][0], d0, 0, 0, 0); d1 = __builtin_amdgcn_mfma_f32_16x16x32_bf16(ah, wl[sx][1], d1, 0, 0, 0);
              d0 = __builtin_amdgcn_mfma_f32_16x16x32_bf16(al, wh[sx][0], d0, 0, 0, 0); d1 = __builtin_amdgcn_mfma_f32_16x16x32_bf16(al, wh[sx][1], d1, 0, 0, 0); }
          LAS float* pp = PART + ((st & 1) * 8 + wave) * 512 + (4 * (lane >> 4)) * 32 + (lane & 15);
#pragma unroll
          for (int i = 0; i < 4; ++i) { pp[i * 32] = d0[i]; pp[i * 32 + 16] = d1[i]; } }
        __syncthreads();
        { const int ri = lane >> 5, e = lane & 31; float lg = rbias;
#pragma unroll
          for (int v = 0; v < 8; ++v) lg += PART[((st & 1) * 8 + v) * 512 + (2 * wave + ri) * 32 + e];
          Lg[((2 * st + ri) & 15) * 33 + e] = lg; }
        { const int r = r0 + 2 * st + 1; const int rl = (r - r0) & 15;
        if (rl == 15) {
            asm volatile("s_waitcnt lgkmcnt(0)" ::: "memory");
            const int ln2 = otid() & 63;
            if (ln2 < 16) {
                float v0 = -3.0e38f, v1 = -3.0e38f, v2 = -3.0e38f, v3 = -3.0e38f; int i0 = 0, i1 = 0, i2 = 0, i3 = 0;
#pragma unroll
                for (int e = 0; e < 32; ++e) { const float x = Lg[ln2 * 33 + e];
                    const bool c0 = x > v0, c1 = x > v1, c2 = x > v2, c3 = x > v3;
                    v3 = c3 ? (c2 ? v2 : x) : v3; i3 = c3 ? (c2 ? i2 : e) : i3;
                    v2 = c2 ? (c1 ? v1 : x) : v2; i2 = c2 ? (c1 ? i1 : e) : i2;
                    v1 = c1 ? (c0 ? v0 : x) : v1; i1 = c1 ? (c0 ? i0 : e) : i1;
                    v0 = c0 ? x : v0; i0 = c0 ? e : i0; }
                const float e1 = __expf(v1 - v0), e2 = __expf(v2 - v0), e3 = __expf(v3 - v0); const float inv = 1.0f / (1.0f + e1 + e2 + e3);
                const int rr = r - 15 + ln2;
                *(int4*)(TK + (size_t)rr * 4) = make_int4(i0, i1, i2, i3); *(f32x4*)(GT + (size_t)rr * 4) = (f32x4){inv, e1 * inv, e2 * inv, e3 * inv};
                __hip_atomic_fetch_add(&hist[i0], 1, __ATOMIC_RELAXED, __HIP_MEMORY_SCOPE_WORKGROUP); __hip_atomic_fetch_add(&hist[i1], 1, __ATOMIC_RELAXED, __HIP_MEMORY_SCOPE_WORKGROUP);
                __hip_atomic_fetch_add(&hist[i2], 1, __ATOMIC_RELAXED, __HIP_MEMORY_SCOPE_WORKGROUP); __hip_atomic_fetch_add(&hist[i3], 1, __ATOMIC_RELAXED, __HIP_MEMORY_SCOPE_WORKGROUP);
            }
            asm volatile("s_waitcnt lgkmcnt(0)" ::: "memory");
        }
            }
    }
    __syncthreads();
    if (tid < 32) ((int*)(C.ws + WS_CNTBLK))[blockIdx.x * 32 + tid] = hist[tid];
    __syncthreads();
}
__device__ __forceinline__ void p_assign(const Ctx& C) {
    PH_IDS;
    LAS int* red = (LAS int*)C.lds;
    LAS int* base = (LAS int*)(C.lds + 4096);
    LAS int* total = (LAS int*)(C.lds + 4224);
    LAS int* segrow = (LAS int*)(C.lds + 4352);
    LAS int* run = (LAS int*)(C.lds + 4608);
    const int* cnt = (const int*)(C.ws + WS_CNTBLK);
    const int b = blockIdx.x;
    __syncthreads();
    { const int e = tid & 31, part = tid >> 5; int slt = 0, sall = 0;
      int vv[16];
#pragma unroll
      for (int q = 0; q < 16; ++q) vv[q] = __hip_atomic_load(cnt + (part * 16 + q) * 32 + e, __ATOMIC_RELAXED, __HIP_MEMORY_SCOPE_AGENT);
#pragma unroll
      for (int q = 0; q < 16; ++q) { sall += vv[q]; if (part * 16 + q < b) slt += vv[q]; }
      red[part * 32 + e] = slt; red[512 + part * 32 + e] = sall; }
    __syncthreads();
    if (tid < 32) { int s0 = 0, s1 = 0;
#pragma unroll
        for (int q = 0; q < 16; ++q) { s0 += red[q * 32 + tid]; s1 += red[512 + q * 32 + tid]; }
        base[tid] = s0; total[tid] = s1; run[tid] = 0; }
    __syncthreads();
    if (tid == 0) { int acc = 0; for (int e = 0; e < 32; ++e) { segrow[e] = acc * 256; if (b == 0) ((int*)(C.ws + WS_MOEINFO))[e] = acc; acc += (total[e] + 255) >> 8; } segrow[32] = acc * 256; if (b == 0) ((int*)(C.ws + WS_MOEINFO))[32] = acc; }
    __syncthreads();
    int* SP = (int*)(C.ws + WS_SLOTPOS); int* ST = (int*)(C.ws + WS_SLOTTOK); int* SD = (int*)(C.ws + WS_SLOTDST); const int* TK = (const int*)(C.ws + WS_TOPK);
    const int rows_per_blk = MTOK / C.G;
    LAS int* gc = (LAS int*)(C.lds + 5120);
    int ge[2], grk[2], grow[2];
#pragma unroll
    for (int q = 0; q < 2; ++q) {
        const int g = 2 * wave + q, sidx = g * 64 + lane; grow[q] = b * rows_per_blk + (sidx >> 2);
        ge[q] = TK[(size_t)grow[q] * 4 + (sidx & 3)];
        int rk = 0, myc = 0;
        for (int ee = 0; ee < 32; ++ee) { const unsigned long long m = __ballot(ge[q] == ee);
            if (ge[q] == ee) rk = __popcll(m & ((1ull << lane) - 1ull));
            if (lane == ee) myc = __popcll(m); }
        grk[q] = rk;
        if (lane < 32) gc[g * 32 + lane] = myc;
    }
    __syncthreads();
#pragma unroll
    for (int q = 0; q < 2; ++q) {
        const int g = 2 * wave + q, sidx = g * 64 + lane; int off = 0;
        for (int gp = 0; gp < g; ++gp) off += gc[gp * 32 + ge[q]];
        const int pos = segrow[ge[q]] + base[ge[q]] + off + grk[q];
        SP[(size_t)grow[q] * 4 + (sidx & 3)] = pos; ST[pos] = grow[q]; SD[pos] = grow[q] * 4 + (sidx & 3);
    }
    if (b < 32) { const int e = b, tot = total[e], first = segrow[e] + tot, last = segrow[e + 1];
        for (int p = first + tid; p < last; p += 512) { ST[p] = 0; SD[p] = MTOK * 4 + (p & 255); } }
    __syncthreads();
}

__device__ __forceinline__ void p_combine(const Ctx& C, const int layer) {
    PH_IDS;
    const int gw = blockIdx.x * 8 + wave, NGW = C.G * 8;
    const int per = MTOK / NGW;
    const float* MOD = (const float*)(C.ws + WS_MOD) + (size_t)layer * 9 * 6144;
    const float* MODN = (const float*)(C.ws + WS_MOD) + (size_t)9 * 6144;
    const float* gpost = C.a->in[IN_NFPOST] + layer * 1024; const float* gpre1 = C.a->in[IN_NMPRE] + 1024;
    const unsigned char* YS = (const unsigned char*)(C.ws + WS_YSLOT); const int* SP = (const int*)(C.ws + WS_SLOTPOS); const float* GT = (const float*)(C.ws + WS_GATE);
    float* OUT = C.a->out; bf16* XS = (bf16*)(C.ws + WS_XS); unsigned char* HN = (unsigned char*)(C.ws + WS_HN);
    int curb = -1; float cA1[16], cA2[16], cB2[16]; const int vz = vzero();
    const int rbeg = gw * per, rend = gw * per + per;
    int4 npos = *(const int4*)(SP + (size_t)(rbeg + vz) * 4); f32x4 ngt = *(const f32x4*)(GT + (size_t)(rbeg + vz) * 4);
    unsigned nys[4][4]; u32x2 nxv[4]; f32x4 cgt = ngt;
    { const int pp[4] = {npos.x, npos.y, npos.z, npos.w};
#pragma unroll
      for (int k = 0; k < 4; ++k)
#pragma unroll
          for (int j = 0; j < 4; ++j) nys[k][j] = *(const unsigned*)(YS + (size_t)pp[k] * 1024 + 4 * lane + 256 * j);
#pragma unroll
      for (int j = 0; j < 4; ++j) nxv[j] = *(const u32x2*)(XS + (size_t)rbeg * 1024 + 4 * lane + 256 * j); }
    if (rbeg + 1 < rend) { npos = *(const int4*)(SP + (size_t)(rbeg + 1 + vz) * 4); ngt = *(const f32x4*)(GT + (size_t)(rbeg + 1 + vz) * 4); }
    for (int r = rbeg; r < rend; ++r) {
        const int b = r >> 13;
        if (b != curb) { curb = b;
#pragma unroll
            for (int j = 0; j < 4; ++j) { const int c = 4 * lane + 256 * j;
                const f32x4 gp = *(const f32x4*)(gpost + c), gf = *(const f32x4*)(MOD + (size_t)b * 6144 + 5120 + c);
                const f32x4 gg = *(const f32x4*)(gpre1 + c), sc = *(const f32x4*)(MODN + (size_t)b * 6144 + 1024 + c), sh = *(const f32x4*)(MODN + (size_t)b * 6144 + c);
#pragma unroll
                for (int i = 0; i < 4; ++i) { cA1[4 * j + i] = gp[i] * gf[i]; cA2[4 * j + i] = gg[i] * (1.0f + sc[i]); cB2[4 * j + i] = sh[i]; } } }
        unsigned ys[4][4]; u32x2 xc[4]; const f32x4 gt = cgt;
#pragma unroll
        for (int k = 0; k < 4; ++k)
#pragma unroll
            for (int j = 0; j < 4; ++j) ys[k][j] = nys[k][j];
#pragma unroll
        for (int j = 0; j < 4; ++j) xc[j] = nxv[j];
        if (r + 1 < rend) {
            const int pp[4] = {npos.x, npos.y, npos.z, npos.w}; cgt = ngt;
#pragma unroll
            for (int k = 0; k < 4; ++k)
#pragma unroll
                for (int j = 0; j < 4; ++j) nys[k][j] = *(const unsigned*)(YS + (size_t)pp[k] * 1024 + 4 * lane + 256 * j);
#pragma unroll
            for (int j = 0; j < 4; ++j) nxv[j] = *(const u32x2*)(XS + (size_t)(r + 1) * 1024 + 4 * lane + 256 * j);
            if (r + 2 < rend) { npos = *(const int4*)(SP + (size_t)(r + 2 + vz) * 4); ngt = *(const f32x4*)(GT + (size_t)(r + 2 + vz) * 4); } }
        float f[16];
#pragma unroll
        for (int i = 0; i < 16; ++i) f[i] = 0.f;
#pragma unroll
        for (int k = 0; k < 4; ++k) { const float gk = gt[k] * 0.0625f;
#pragma unroll
            for (int j = 0; j < 4; ++j) { const f32v2_t lo = __builtin_amdgcn_cvt_pk_f32_fp8((int)ys[k][j], false), hi = __builtin_amdgcn_cvt_pk_f32_fp8((int)ys[k][j], true);
                f[4 * j] += gk * lo[0]; f[4 * j + 1] += gk * lo[1]; f[4 * j + 2] += gk * hi[0]; f[4 * j + 3] += gk * hi[1]; } }
        float ss = 0.f;
#pragma unroll
        for (int i = 0; i < 16; ++i) ss += f[i] * f[i];
        const float rstd = rsqrtf(wave_sum(ss) * (1.0f / 1024.0f) + EPS);
        float x2[16]; float ss2 = 0.f;
#pragma unroll
        for (int j = 0; j < 4; ++j) { const int c = 4 * lane + 256 * j;
            const f32x4 xv = (f32x4){bf_lo(xc[j].x), bf_hi(xc[j].x), bf_lo(xc[j].y), bf_hi(xc[j].y)};
            f32x4 o;
#pragma unroll
            for (int i = 0; i < 4; ++i) { o[i] = xv[i] + cA1[4 * j + i] * (f[4 * j + i] * rstd); x2[4 * j + i] = o[i]; ss2 += o[i] * o[i]; }
            if (layer == 0) { u32x2 xw; xw.x = cvt_pk(o[0], o[1]); xw.y = cvt_pk(o[2], o[3]); *(u32x2*)(XS + (size_t)r * 1024 + c) = xw; }
            else *(f32x4*)(OUT + (size_t)r * 1024 + c) = o; }
        if (layer == 0) {
            const float rstd2 = rsqrtf(wave_sum(ss2) * (1.0f / 1024.0f) + EPS);
#pragma unroll
            for (int j = 0; j < 4; ++j) { const int c = 4 * lane + 256 * j;
                float hv[4];
#pragma unroll
                for (int i = 0; i < 4; ++i) hv[i] = x2[4 * j + i] * rstd2 * cA2[4 * j + i] + cB2[4 * j + i];
                if (F8_IN1) *(unsigned*)(HN + (size_t)r * 1024 + c) = pk4_fp8(hv[0], hv[1], hv[2], hv[3], 8.f);
                else *(u32x2*)((bf16*)HN + (size_t)r * 1024 + c) = (u32x2){cvt_pk(hv[0], hv[1]), cvt_pk(hv[2], hv[3])}; }
        }
    }
}

__device__ __forceinline__ void p_conv(const Ctx& C) {
    PH_IDS;
    LAS unsigned char* L = C.lds;
    constexpr int O_X = 0;
    constexpr int O_W = 63488;
    const int w = wave;
    const bf16* GLU = (const bf16*)(C.ws + WS_GLU); const bf16* ZC1 = (const bf16*)(C.ws + WS_ZC1); const bf16* GB = (const bf16*)(C.ws + WS_GB);
    unsigned char* A2 = (unsigned char*)(C.ws + WS_A2B);
    __syncthreads();
    { float tmpw[31];
#pragma unroll
      for (int q = 0; q < 31; ++q) tmpw[q] = C.a->in[IN_ODDW][tid + 512 * q];
#pragma unroll
      for (int q = 0; q < 31; ++q) { const int i = tid + 512 * q; const int tap = i >> 9, c = i & 511; const int ln = c >> 3, half = (c >> 2) & 1, qq = c & 3;
          *(LAS float*)(L + O_W + (((tap * 2 + half) * 64 + ln) * 4 + qq) * 4) = tmpw[q]; } }
    float cb[8], lg[8], lb[8], sw0[8], sw1[8], sw2[8];
#pragma unroll
    for (int i = 0; i < 8; ++i) { const int c = 8 * lane + i; cb[i] = C.a->in[IN_ODDWB][c]; lg[i] = C.a->in[IN_ODLNG][c]; lb[i] = C.a->in[IN_ODLNB][c];
        sw0[i] = C.a->in[IN_ODSCONV][c]; sw1[i] = C.a->in[IN_ODSCONV][512 + c]; sw2[i] = C.a->in[IN_ODSCONV][1024 + c]; }
    u32x4 px[8];
    auto fetchx = [&](int unit) { const int bt = unit >> 8, t0 = (unit & 255) * 32;
#pragma unroll
        for (int q = 0; q < 8; ++q) { const int i = tid + 512 * q; const int rr = i >> 6, cc = i & 63; const int tl = t0 - 15 + rr;
            px[q] = (u32x4){0u, 0u, 0u, 0u};
            if (i < 62 * 64 && tl >= 0 && tl < SEQ) px[q] = *(const u32x4*)(GLU + (size_t)(bt * SEQ + tl) * 512 + cc * 8); } };
    if ((int)blockIdx.x < 2048) fetchx(blockIdx.x);
    for (int unit = blockIdx.x; unit < 2048; unit += C.G) {
        const int bt = unit >> 8, t0 = (unit & 255) * 32;
        __syncthreads();
#pragma unroll
        for (int q = 0; q < 8; ++q) { const int i = tid + 512 * q; if (i < 62 * 64) *(LAS u32x4*)(L + O_X + (i >> 6) * 1024 + (i & 63) * 16) = px[q]; }
        __syncthreads();
        if (unit + C.G < 2048) fetchx(unit + C.G);
        float acc[4][8];
#pragma unroll
        for (int o = 0; o < 4; ++o)
#pragma unroll
            for (int i = 0; i < 8; ++i) acc[o][i] = 0.f;
#pragma unroll 4
        for (int tap = 0; tap < 31; ++tap) {
            const f32x4 w0 = *(const LAS f32x4*)(L + O_W + ((tap * 2 + 0) * 64 + lane) * 16), w1 = *(const LAS f32x4*)(L + O_W + ((tap * 2 + 1) * 64 + lane) * 16);
#pragma unroll
            for (int o = 0; o < 4; ++o) {
                const u32x4 xr = *(const LAS u32x4*)(L + O_X + (4 * w + o + tap) * 1024 + lane * 16);
                acc[o][0] += bf_lo(xr[0]) * w0[0]; acc[o][1] += bf_hi(xr[0]) * w0[1]; acc[o][2] += bf_lo(xr[1]) * w0[2]; acc[o][3] += bf_hi(xr[1]) * w0[3];
                acc[o][4] += bf_lo(xr[2]) * w1[0]; acc[o][5] += bf_hi(xr[2]) * w1[1]; acc[o][6] += bf_lo(xr[3]) * w1[2]; acc[o][7] += bf_hi(xr[3]) * w1[3]; }
        }
        u32x4 sz0[4], sz1[4], sz2[4], sgb[4];
#pragma unroll
        for (int o = 0; o < 4; ++o) { const int tl = t0 + 4 * w + o; const size_t tok = (size_t)bt * SEQ + tl;
            sz1[o] = *(const u32x4*)(ZC1 + tok * 512 + 8 * lane); sz0[o] = (u32x4){0u, 0u, 0u, 0u}; sz2[o] = (u32x4){0u, 0u, 0u, 0u};
            if (tl >= 64) sz0[o] = *(const u32x4*)(ZC1 + (tok - 64) * 512 + 8 * lane);
            if (tl + 64 < SEQ) sz2[o] = *(const u32x4*)(ZC1 + (tok + 64) * 512 + 8 * lane);
            sgb[o] = *(const u32x4*)(GB + tok * 512 + 8 * lane); }
#pragma unroll
        for (int o = 0; o < 4; ++o) {
            const int tl = t0 + 4 * w + o; const size_t tok = (size_t)bt * SEQ + tl;
            float v[8]; float s = 0.f;
#pragma unroll
            for (int i = 0; i < 8; ++i) { v[i] = acc[o][i] + cb[i]; s += v[i]; }
            const float mu = wave_sum(s) * (1.0f / 512.0f); float q = 0.f;
#pragma unroll
            for (int i = 0; i < 8; ++i) { v[i] -= mu; q += v[i] * v[i]; }
            const float rstd = rsqrtf(wave_sum(q) * (1.0f / 512.0f) + EPS);
            float y[8];
#pragma unroll
            for (int i = 0; i < 8; ++i) y[i] = siluf_(v[i] * rstd * lg[i] + lb[i]);
            if (F8_OUT1) *(u32x2*)(A2 + tok * 1024 + 8 * lane) = (u32x2){pk4_fp8(y[0], y[1], y[2], y[3], 4.f), pk4_fp8(y[4], y[5], y[6], y[7], 4.f)};
            else *(u32x4*)((bf16*)A2 + tok * 1024 + 8 * lane) = (u32x4){cvt_pk(y[0], y[1]), cvt_pk(y[2], y[3]), cvt_pk(y[4], y[5]), cvt_pk(y[6], y[7])};
            const u32x4 z1 = sz1[o], z0 = sz0[o], z2 = sz2[o], gb = sgb[o];
            float zz[8];
#pragma unroll
            for (int i = 0; i < 4; ++i) {
                zz[2 * i] = (sw0[2 * i] * bf_lo(z0[i]) + sw1[2 * i] * bf_lo(z1[i]) + sw2[2 * i] * bf_lo(z2[i])) * bf_lo(gb[i]);
                zz[2 * i + 1] = (sw0[2 * i + 1] * bf_hi(z0[i]) + sw1[2 * i + 1] * bf_hi(z1[i]) + sw2[2 * i + 1] * bf_hi(z2[i])) * bf_hi(gb[i]); }
            if (F8_OUT1) *(u32x2*)(A2 + tok * 1024 + 512 + 8 * lane) = (u32x2){pk4_fp8(zz[0], zz[1], zz[2], zz[3], 4.f), pk4_fp8(zz[4], zz[5], zz[6], zz[7], 4.f)};
            else *(u32x4*)((bf16*)A2 + tok * 1024 + 512 + 8 * lane) = (u32x4){cvt_pk(zz[0], zz[1]), cvt_pk(zz[2], zz[3]), cvt_pk(zz[4], zz[5]), cvt_pk(zz[6], zz[7])};
        }
    }
    __syncthreads();
}

constexpr int NPHASE = 19;
#ifndef RUN_HI
#define RUN_HI NPHASE
#endif
__global__ void __launch_bounds__(512, 2) fwd_kernel(Args args) {
    extern __shared__ __attribute__((aligned(16))) unsigned char lds_raw[];
    Ctx C; C.lds = (LAS unsigned char*)lds_raw;
    C.G = gridDim.x; C.a = &args; C.ws = args.ws;
    volatile LAS unsigned* MISC = (volatile LAS unsigned*)(C.lds + MISC_OFF);
    if (threadIdx.x < 16) MISC[threadIdx.x] = 0u;
    __syncthreads();
    const int lo = args.ph_lo, hi = args.ph_hi;
    const bool multi = (hi - lo) > 1;
    XcdBarrier bar; bar.bar = (unsigned*)(C.ws + WS_CTL) + 4096; bar.x = 0; bar.st = MISC;
    if (multi) bar = xcd_barrier_post((unsigned*)(C.ws + WS_CTL) + 4096, MISC);
#ifndef PH_MASK
#define PH_MASK 0x7FFFF
#endif
#define IN(k) (((PH_MASK >> (k)) & 1) && lo <= (k) && (k) < hi)
#ifndef DUP_MASK
#define DUP_MASK 0
#endif
#ifndef GLA_PROBE
#define GLA_PROBE 0
#endif
#ifndef PROBE_NOEPI
#define PROBE_NOEPI 0
#endif
#ifndef GP_AMP
#define GP_AMP 4
#endif
#define DUPN(k) (((DUP_MASK >> (k)) & 1) ? 2 : 1)
#define SEAM(k) do { if (IN(k) && IN((k) + 1)) xcd_barrier(bar); } while (0)
    LAS unsigned char* ring = C.lds;
    const int cid = blockIdx.x;

    if (IN(0)) for (int rep_ = 0; rep_ < DUPN(0); ++rep_) { p0_adaln(C); p0_fourier_fold(C); p0_convert(C); } SEAM(0);
    if (IN(1)) for (int rep_ = 0; rep_ < DUPN(1); ++rep_) { p_norm0(C); } SEAM(1);
    if (IN(2)) for (int rep_ = 0; rep_ < DUPN(2); ++rep_) {
        if (F8_IN0 || !IN0_F8_TILES) { gm::SchedIn0 S{(const char*)(C.ws + WS_HN), (const char*)(C.ws + WS_WIN0), C.G, cid}; gm::EpiIn0 E{C.ws}; gm::gemm_phase<F8_IN0 != 0>(ring, F8_IN0 ? 1024 : 2048, S, E, 0x7C7C7C7C, 0x7A7A7A7A, 2, (unsigned long long*)(C.ws + WS_CTL + 32768)); }
        else {
            gm::EpiIn0 E{C.ws};
            { gm::SchedIn0Sub<(0x7FFFu & ~(unsigned)IN0_F8_TILES), false, true> S{(const char*)(C.ws + WS_HN), (const char*)(C.ws + WS_WIN0), C.G, cid}; gm::gemm_phase<false>(ring, 2048, S, E, 0x7C7C7C7C, 0x7A7A7A7A, 2, (unsigned long long*)(C.ws + WS_CTL + 32768)); }
            { gm::SchedIn0Sub<(unsigned)IN0_F8_TILES, true, false, true> S{(const char*)(C.ws + WS_HN8), (const char*)(C.ws + WS_WIN0F8), C.G, cid}; gm::gemm_phase<true>(ring, 1024, S, E, 0x7C7C7C7C, 0x7A7A7A7A, 2, (unsigned long long*)(C.ws + WS_CTL + 32768)); } }
    } SEAM(2);
    if (IN(3)) for (int rep_ = 0; rep_ < DUPN(3); ++rep_) { p_gla_prep(C); if (GLA_PROBE == 1) p_gla_prep(C); if (GLA_PROBE >= 10) p_gla_prep(C, GLA_PROBE - 10); p_fft1(C); if (GLA_PROBE == 2) p_fft1(C); xcd_barrier(bar); p_gla(C); if (GLA_PROBE == 3) p_gla(C); if (GLA_PROBE == 4) p_gla(C, 1); } SEAM(3);
    if (IN(4)) for (int rep_ = 0; rep_ < DUPN(4); ++rep_) { p_fft2(C); p_gla_out(C); } SEAM(4);
    if (IN(5)) for (int rep_ = 0; rep_ < DUPN(5); ++rep_) { gm::SchedDense S{(const char*)(C.ws + WS_A2), (const char*)(C.ws + WS_WOUT0), F8_OUT0 ? 1536 : 3072, 256, 4, C.G, cid}; gm::EpiPlain E{(bf16*)(C.ws + WS_Y), 1024}; gm::gemm_phase<F8_OUT0 != 0>(ring, F8_OUT0 ? 1536 : 3072, S, E, 0x7C7C7C7C, 0x7A7A7A7A, 5, (unsigned long long*)(C.ws + WS_CTL + 32768)); } SEAM(5);
    if (IN(6)) for (int rep_ = 0; rep_ < DUPN(6); ++rep_) { p_postmix(C, 0); } SEAM(6);
    if (IN(7)) { p_assign(C); } SEAM(7);
    if (IN(8)) for (int rep_ = 0; rep_ < DUPN(8); ++rep_) { const int* tsp = (const int*)(C.ws + WS_MOEINFO); const int ln_ = otid() & 63; const int ts = __hip_atomic_load(tsp + (ln_ < 32 ? ln_ : 32), __ATOMIC_RELAXED, __HIP_MEMORY_SCOPE_AGENT);
        gm::SchedMoE S{(const char*)(C.ws + WS_H2), (const char*)(C.ws + WS_WGU), (const int*)(C.ws + WS_SLOTTOK), ts, __builtin_amdgcn_readlane(ts, 32), 8, C.G, cid, (size_t)2048 * 1024, true, args.in[IN_BGU], nullptr};
        gm::EpiGU E{(unsigned char*)(C.ws + WS_ACT), args.in[IN_BGU], PROBE_NOEPI ? rep_ : 0}; gm::gemm_phase<true>(ring, 1024, S, E, 0x7C7C7C7C, 0x7A7A7A7A, 8, (unsigned long long*)(C.ws + WS_CTL + 32768)); } SEAM(8);
    if (IN(9)) for (int rep_ = 0; rep_ < DUPN(9); ++rep_) { const int* tsp = (const int*)(C.ws + WS_MOEINFO); const int ln_ = otid() & 63; const int ts = __hip_atomic_load(tsp + (ln_ < 32 ? ln_ : 32), __ATOMIC_RELAXED, __HIP_MEMORY_SCOPE_AGENT);
        gm::SchedMoE S{(const char*)(C.ws + WS_ACT), (const char*)(C.ws + WS_WD), nullptr, ts, __builtin_amdgcn_readlane(ts, 32), 4, C.G, cid, (size_t)1024 * 1024, false, args.in[IN_BD], nullptr};
        gm::EpiDown E{(unsigned char*)(C.ws + WS_YSLOT), args.in[IN_BD]}; gm::gemm_phase<true>(ring, 1024, S, E, 0x7D7D7D7D, 0x7A7A7A7A, 9, (unsigned long long*)(C.ws + WS_CTL + 32768)); } SEAM(9);
    if (IN(10)) { p_combine(C, 0); } SEAM(10);
    if (IN(11)) for (int rep_ = 0; rep_ < DUPN(11); ++rep_) { gm::SchedDense S{(const char*)(C.ws + WS_HN), (const char*)(C.ws + WS_WIN1), F8_IN1 ? 1024 : 2048, 256, 10, C.G, cid}; gm::EpiIn1 E{C.ws}; gm::gemm_phase<F8_IN1 != 0>(ring, F8_IN1 ? 1024 : 2048, S, E, 0x7C7C7C7C, 0x7A7A7A7A, 11, (unsigned long long*)(C.ws + WS_CTL + 32768)); } SEAM(11);
    if (IN(12)) for (int rep_ = 0; rep_ < DUPN(12); ++rep_) { p_conv(C); } SEAM(12);
    if (IN(13)) for (int rep_ = 0; rep_ < DUPN(13); ++rep_) { gm::SchedDense S{(const char*)(C.ws + WS_A2B), (const char*)(C.ws + WS_WOUT1), F8_OUT1 ? 1024 : 2048, 256, 4, C.G, cid}; gm::EpiPlain E{(bf16*)(C.ws + WS_Y), 1024}; gm::gemm_phase<F8_OUT1 != 0>(ring, F8_OUT1 ? 1024 : 2048, S, E, 0x7D7D7D7D, 0x7A7A7A7A, 13, (unsigned long long*)(C.ws + WS_CTL + 32768)); } SEAM(13);
    if (IN(14)) { p_postmix(C, 1); } SEAM(14);
    if (IN(15)) { p_assign(C); } SEAM(15);
    if (IN(16)) for (int rep_ = 0; rep_ < DUPN(16); ++rep_) { const int* tsp = (const int*)(C.ws + WS_MOEINFO); const int ln_ = otid() & 63; const int ts = __hip_atomic_load(tsp + (ln_ < 32 ? ln_ : 32), __ATOMIC_RELAXED, __HIP_MEMORY_SCOPE_AGENT);
        gm::SchedMoE S{(const char*)(C.ws + WS_H2), (const char*)(C.ws + WS_WGU) + (size_t)32 * 2048 * 1024, (const int*)(C.ws + WS_SLOTTOK), ts, __builtin_amdgcn_readlane(ts, 32), 8, C.G, cid, (size_t)2048 * 1024, true, args.in[IN_BGU] + 32 * 2048, nullptr};
        gm::EpiGU E{(unsigned char*)(C.ws + WS_ACT), args.in[IN_BGU] + 32 * 2048, 0}; gm::gemm_phase<true>(ring, 1024, S, E, 0x7C7C7C7C, 0x7A7A7A7A, 16, (unsigned long long*)(C.ws + WS_CTL + 32768)); } SEAM(16);
    if (IN(17)) for (int rep_ = 0; rep_ < DUPN(17); ++rep_) { const int* tsp = (const int*)(C.ws + WS_MOEINFO); const int ln_ = otid() & 63; const int ts = __hip_atomic_load(tsp + (ln_ < 32 ? ln_ : 32), __ATOMIC_RELAXED, __HIP_MEMORY_SCOPE_AGENT);
        gm::SchedMoE S{(const char*)(C.ws + WS_ACT), (const char*)(C.ws + WS_WD) + (size_t)32 * 1024 * 1024, nullptr, ts, __builtin_amdgcn_readlane(ts, 32), 4, C.G, cid, (size_t)1024 * 1024, false, args.in[IN_BD] + 32 * 1024, nullptr};
        gm::EpiDown E{(unsigned char*)(C.ws + WS_YSLOT), args.in[IN_BD] + 32 * 1024}; gm::gemm_phase<true>(ring, 1024, S, E, 0x7D7D7D7D, 0x7A7A7A7A, 17, (unsigned long long*)(C.ws + WS_CTL + 32768)); } SEAM(17);
    if (IN(18)) { p_combine(C, 1); }
#if GP_PROBE
    if (blockIdx.x == 0 && threadIdx.x == 0) { const unsigned long long v = *(volatile unsigned long long*)(C.ws + WS_CTL + 32768) * GP_AMP; const unsigned long long t0 = wall_clock64();
        while (wall_clock64() - t0 < v) __builtin_amdgcn_s_sleep(16); }
#endif
#ifdef DBG_COPY_OFF
    if (lo == 99) { const bf16* src = (const bf16*)(C.ws + (size_t)DBG_COPY_OFF); float* dst = args.out;
        for (size_t i = (size_t)blockIdx.x * 512 + threadIdx.x; i < (size_t)MTOK * 1024; i += (size_t)gridDim.x * 512) dst[i] = bf_lo((unsigned)src[i]); }
#endif
#undef IN
#undef SEAM
}

extern "C" void kernel_launch(void* const* d_in, const int* in_sizes, int n_in, void* d_out, int out_size, void* d_ws, size_t ws_size, hipStream_t stream) {
    static int grid = 0;
    if (grid == 0) {
        if (n_in != 28 || out_size != MTOK * D || ws_size < WS_END) { fprintf(stderr, "kernel_launch: unexpected problem (n_in %d out %d ws %zu need %zu)\n", n_in, out_size, ws_size, (size_t)WS_END); grid = -1; return; }
        int dev = 0, cus = 0, per_cu = 0;
        (void)hipGetDevice(&dev); (void)hipDeviceGetAttribute(&cus, hipDeviceAttributeMultiprocessorCount, dev);
        if (hipFuncSetAttribute((const void*)fwd_kernel, hipFuncAttributeMaxDynamicSharedMemorySize, LDS_BYTES) != hipSuccess) { fprintf(stderr, "kernel_launch: hipFuncSetAttribute failed\n"); grid = -1; return; }
        (void)hipOccupancyMaxActiveBlocksPerMultiprocessor(&per_cu, (const void*)fwd_kernel, 512, LDS_BYTES);
        (void)hipGetLastError();
        grid = cus;
        if (grid != 256 || per_cu < 1) { fprintf(stderr, "kernel_launch: needs a 256-CU device with one resident workgroup per CU (cus %d, per_cu %d)\n", cus, per_cu); grid = -1; return; }
    }
    if (grid < 0) return;
    (void)hipMemsetAsync((char*)d_ws + WS_CTL, 0, CTL_ZERO_BYTES, stream);
    Args a{};
    for (int i = 0; i < 28; ++i) a.in[i] = (const float*)d_in[i];
    a.out = (float*)d_out; a.ws = (unsigned char*)d_ws;
#if N_LAUNCH_MODE == 1
    a.ph_lo = 0; a.ph_hi = NPHASE;
    hipLaunchKernelGGL(fwd_kernel, dim3(grid), dim3(512), LDS_BYTES, stream, a);
#else
    for (int p = 0; p < RUN_HI; ++p) { a.ph_lo = p; a.ph_hi = p + 1; hipLaunchKernelGGL(fwd_kernel, dim3(grid), dim3(512), LDS_BYTES, stream, a); }
#ifdef DBG_COPY_OFF
    a.ph_lo = 99; a.ph_hi = 100; hipLaunchKernelGGL(fwd_kernel, dim3(grid), dim3(512), LDS_BYTES, stream, a);
#endif
#endif
}
```
